# Optimizing an MI355X kernel written in HIP

```python
import jax, jax.numpy as jnp
from jax import lax
import numpy as np

D_MODEL = 1024
BATCH = 2
SEQ = 8192
DEPTH = 1

GRID_W = 64
CTX_LEN = 256
D_MIX = D_MODEL
NA_WIDTH = D_MIX // 2
NA_HEADS = 8
NA_HEAD_DIM = NA_WIDTH // NA_HEADS
NA_KH_MAX = 8
NA_KW = 16
SGU_WIDTH = D_MIX - NA_WIDTH
SGU_GROUPS = 4
SGU_GROUP_DIM = SGU_WIDTH // SGU_GROUPS
CHUNK = 128
N_EXPERTS = 32
TOP_K = 4
D_FF_EXPERT = D_MODEL
SWIGLU_LIMIT = 7.0
SWIGLU_ALPHA = 1.702
LN_EPS = 1e-5
DEEPNORM_ALPHA = (2.0 * DEPTH) ** 0.25
DEEPNORM_BETA = (8.0 * DEPTH) ** -0.25
Q_OFF = 0
K_OFF = NA_WIDTH
V_OFF = 2 * NA_WIDTH
U_OFF = 3 * NA_WIDTH
D_IN = U_OFF + 2 * SGU_WIDTH

kernel_name = "hybrid_natten_sgu_moe_dit_block"


def layer_norm(x, g=None, b=None):
    xf = x.astype(jnp.float32)
    mu = jnp.mean(xf, axis=-1, keepdims=True)
    var = jnp.mean(jnp.square(xf - mu), axis=-1, keepdims=True)
    y = (xf - mu) * lax.rsqrt(var + LN_EPS)
    if g is not None:
        y = y * g.astype(jnp.float32) + b.astype(jnp.float32)
    return y.astype(x.dtype)


def ada_params(cond, ada_w, ada_b):
    m = jax.nn.silu(cond) @ ada_w + ada_b
    return jnp.split(m, 6, axis=-1)


def modulate(h, shift, scale):
    return layer_norm(h) * (1 + scale) + shift


def split_heads(t):
    b, l, _ = t.shape
    return t.reshape(b, l, NA_HEADS, NA_HEAD_DIM)


def neighbourhood_attention(q, k, v, k_ctx, v_ctx, rpb):
    b, s, h, dh = q.shape
    rows = s // GRID_W
    kh = min(NA_KH_MAX, rows)
    kw = NA_KW
    scale = dh ** -0.5
    qg = q.reshape(b, rows, GRID_W, h, dh)
    kg = k.reshape(b, rows, GRID_W, h, dh)
    vg = v.reshape(b, rows, GRID_W, h, dh)
    col = jnp.arange(GRID_W)
    col_start = jnp.clip(col - kw // 2, 0, GRID_W - kw)
    col_idx = col_start[:, None] + jnp.arange(kw)[None, :]
    dc_idx = col_idx - col[:, None] + (NA_KW - 1)

    def row_block(r):
        rs = jnp.clip(r - kh // 2, 0, rows - kh)
        k_rows = lax.dynamic_slice_in_dim(kg, rs, kh, axis=1)
        v_rows = lax.dynamic_slice_in_dim(vg, rs, kh, axis=1)
        k_nb = k_rows[:, :, col_idx]
        v_nb = v_rows[:, :, col_idx]
        q_r = lax.dynamic_index_in_dim(qg, r, axis=1, keepdims=False)
        dr_idx = rs + jnp.arange(kh) - r + (NA_KH_MAX - 1)
        bias = rpb[:, dr_idx[None, :, None], dc_idx[:, None, :]]
        s_nb = jnp.einsum('bwhd,biwjhd->bhwij', q_r, k_nb).astype(jnp.float32) * scale \
            + bias.astype(jnp.float32)
        s_ctx = jnp.einsum('bwhd,bchd->bhwc', q_r, k_ctx).astype(jnp.float32) * scale
        scores = jnp.concatenate([s_nb.reshape(b, h, GRID_W, kh * kw), s_ctx], axis=-1)
        p = jax.nn.softmax(scores, axis=-1).astype(q.dtype)
        p_nb = p[..., :kh * kw].reshape(b, h, GRID_W, kh, kw)
        p_ctx = p[..., kh * kw:]
        return jnp.einsum('bhwij,biwjhd->bwhd', p_nb, v_nb) + jnp.einsum('bhwc,bchd->bwhd', p_ctx, v_ctx)

    out = lax.map(row_block, jnp.arange(rows))
    return jnp.moveaxis(out, 0, 1).reshape(b, s, h * dh)


def context_attention(q, k, v):
    b, l, h, dh = q.shape
    s = jnp.einsum('bqhd,bkhd->bhqk', q, k).astype(jnp.float32) * (dh ** -0.5)
    p = jax.nn.softmax(s, axis=-1).astype(q.dtype)
    return jnp.einsum('bhqk,bkhd->bqhd', p, v).reshape(b, l, h * dh)


def spatial_gating(z, ln_g, ln_b, w_s, b_s):
    b, l, _ = z.shape
    u, g = jnp.split(z, 2, axis=-1)
    g = layer_norm(g, ln_g, ln_b)
    g = g.reshape(b, l // CHUNK, CHUNK, SGU_GROUPS, SGU_GROUP_DIM)
    g = jnp.einsum('gij,bnjgc->bnigc', w_s, g) + b_s.T[None, None, :, :, None]
    return u * g.reshape(b, l, SGU_WIDTH)


def moe_ffn(h, router_w, router_b, w_gu, b_gu, w_down, b_down):
    shp = h.shape
    t = h.reshape(-1, shp[-1])
    logits = (t @ router_w + router_b).astype(jnp.float32)
    top_vals, top_idx = lax.top_k(logits, TOP_K)
    gates = jax.nn.softmax(top_vals, axis=-1)
    combine = jnp.sum(jax.nn.one_hot(top_idx, N_EXPERTS, dtype=jnp.float32) * gates[..., None],
                      axis=1).astype(t.dtype)

    def expert_step(acc, xs):
        wgu, bgu, wd, bd, wgt = xs
        gu = t @ wgu + bgu
        gate = jnp.minimum(gu[:, :D_FF_EXPERT], SWIGLU_LIMIT)
        lin = jnp.clip(gu[:, D_FF_EXPERT:], -SWIGLU_LIMIT, SWIGLU_LIMIT)
        y = ((lin + 1) * (gate * jax.nn.sigmoid(SWIGLU_ALPHA * gate))) @ wd + bd
        return acc + wgt[:, None] * y, None

    out, _ = lax.scan(expert_step, jnp.zeros_like(t), (w_gu, b_gu, w_down, b_down, combine.T))
    return out.reshape(shp)


def hybrid_layer(x, ctx, c, c_ctx, ada_w, ada_b, w_in, rpb, sgu_ln_g, sgu_ln_b, sgu_w, sgu_b,
                 w_out, ln1_g, ln1_b, ln2_g, ln2_b, router_w, router_b,
                 exp_w_gu, exp_b_gu, exp_w_down, exp_b_down, last):
    sh1, sc1, g1, sh2, sc2, g2 = ada_params(c[:, None, :], ada_w, ada_b)
    csh1, csc1, cg1, csh2, csc2, cg2 = ada_params(c_ctx, ada_w, ada_b)

    hc = modulate(ctx, csh1, csc1)
    if last:
        kv_c = hc @ w_in[:, K_OFF:U_OFF]
        k_c, v_c = split_heads(kv_c[..., :NA_WIDTH]), split_heads(kv_c[..., NA_WIDTH:])
    else:
        proj_c = hc @ w_in
        q_c = split_heads(proj_c[..., Q_OFF:K_OFF])
        k_c = split_heads(proj_c[..., K_OFF:V_OFF])
        v_c = split_heads(proj_c[..., V_OFF:U_OFF])
        att_c = context_attention(q_c, k_c, v_c)
        sgu_c = spatial_gating(jax.nn.gelu(proj_c[..., U_OFF:]), sgu_ln_g, sgu_ln_b, sgu_w, sgu_b)
        mix_c = jnp.concatenate([att_c, sgu_c], axis=-1) @ w_out

    hx = modulate(x, sh1, sc1)
    proj_x = hx @ w_in
    q_x = split_heads(proj_x[..., Q_OFF:K_OFF])
    k_x = split_heads(proj_x[..., K_OFF:V_OFF])
    v_x = split_heads(proj_x[..., V_OFF:U_OFF])
    att_x = neighbourhood_attention(q_x, k_x, v_x, k_c, v_c, rpb)
    sgu_x = spatial_gating(jax.nn.gelu(proj_x[..., U_OFF:]), sgu_ln_g, sgu_ln_b, sgu_w, sgu_b)
    mix_x = jnp.concatenate([att_x, sgu_x], axis=-1) @ w_out
    x = layer_norm(DEEPNORM_ALPHA * x + g1 * mix_x, ln1_g, ln1_b)
    ffn_x = moe_ffn(modulate(x, sh2, sc2), router_w, router_b, exp_w_gu, exp_b_gu, exp_w_down, exp_b_down)
    x = layer_norm(DEEPNORM_ALPHA * x + g2 * ffn_x, ln2_g, ln2_b)

    if not last:
        ctx = layer_norm(DEEPNORM_ALPHA * ctx + cg1 * mix_c, ln1_g, ln1_b)
        ffn_c = moe_ffn(modulate(ctx, csh2, csc2), router_w, router_b, exp_w_gu, exp_b_gu,
                        exp_w_down, exp_b_down)
        ctx = layer_norm(DEEPNORM_ALPHA * ctx + cg2 * ffn_c, ln2_g, ln2_b)
    return x, ctx


def setup_inputs(seed: int = 0) -> dict:
    key = jax.random.key(seed)
    ks = jax.random.split(key, 24)
    f32 = jnp.float32

    def nrm(k, shape, std):
        return jax.random.normal(k, shape, f32) * std

    L = DEPTH
    return {
        "x": nrm(ks[0], (BATCH, SEQ, D_MODEL), 1.0),
        "c": nrm(ks[1], (BATCH, D_MODEL), 1.0),
        "ctx": nrm(ks[2], (BATCH, CTX_LEN, D_MODEL), 1.0),
        "c_ctx": nrm(ks[3], (D_MODEL,), 1.0),
        "ada_w": nrm(ks[4], (L, D_MODEL, 6 * D_MODEL), 0.5 * D_MODEL ** -0.5),
        "ada_b": nrm(ks[5], (L, 6 * D_MODEL), 0.02),
        "w_in": nrm(ks[6], (L, D_MODEL, D_IN), D_MODEL ** -0.5),
        "rpb": nrm(ks[7], (L, NA_HEADS, 2 * NA_KH_MAX - 1, 2 * NA_KW - 1), 0.1),
        "sgu_ln_g": 1.0 + nrm(ks[8], (L, SGU_WIDTH), 0.01),
        "sgu_ln_b": nrm(ks[9], (L, SGU_WIDTH), 0.01),
        "sgu_w": nrm(ks[10], (L, SGU_GROUPS, CHUNK, CHUNK), CHUNK ** -0.5),
        "sgu_b": 1.0 + nrm(ks[11], (L, SGU_GROUPS, CHUNK), 0.1),
        "w_out": nrm(ks[12], (L, D_MIX, D_MODEL), DEEPNORM_BETA * D_MIX ** -0.5),
        "ln1_g": 1.0 + nrm(ks[13], (L, D_MODEL), 0.01),
        "ln1_b": nrm(ks[14], (L, D_MODEL), 0.01),
        "ln2_g": 1.0 + nrm(ks[15], (L, D_MODEL), 0.01),
        "ln2_b": nrm(ks[16], (L, D_MODEL), 0.01),
        "router_w": nrm(ks[17], (L, D_MODEL, N_EXPERTS), D_MODEL ** -0.5),
        "router_b": nrm(ks[18], (L, N_EXPERTS), 0.01),
        "exp_w_gu": nrm(ks[19], (L, N_EXPERTS, D_MODEL, 2 * D_FF_EXPERT), D_MODEL ** -0.5),
        "exp_b_gu": nrm(ks[20], (L, N_EXPERTS, 2 * D_FF_EXPERT), 0.01),
        "exp_w_down": nrm(ks[21], (L, N_EXPERTS, D_FF_EXPERT, D_MODEL), DEEPNORM_BETA * D_FF_EXPERT ** -0.5),
        "exp_b_down": nrm(ks[22], (L, N_EXPERTS, D_MODEL), 0.01),
    }


def reference(x, c, ctx, c_ctx, ada_w, ada_b, w_in, rpb, sgu_ln_g, sgu_ln_b, sgu_w, sgu_b,
              w_out, ln1_g, ln1_b, ln2_g, ln2_b, router_w, router_b,
              exp_w_gu, exp_b_gu, exp_w_down, exp_b_down):
    for i in range(DEPTH):
        x, ctx = hybrid_layer(
            x, ctx, c, c_ctx, ada_w[i], ada_b[i], w_in[i], rpb[i], sgu_ln_g[i], sgu_ln_b[i],
            sgu_w[i], sgu_b[i], w_out[i], ln1_g[i], ln1_b[i], ln2_g[i], ln2_b[i],
            router_w[i], router_b[i], exp_w_gu[i], exp_b_gu[i], exp_w_down[i], exp_b_down[i],
            last=(i == DEPTH - 1))
    return x
```

```cpp
#include <hip/hip_runtime.h>
#include <stdint.h>
#include <stdio.h>

namespace {
constexpr int D = 1024, NB = 2, S = 8192, M = NB * S, GW = 64, ROWS = 128, CTX = 256, NH = 8, KH = 8, KW = 16;
constexpr int NE = 32, TOPK = 4, DFF = 1024, DIN = 2560, NPAIR = M * TOPK;
constexpr float EPS = 1e-5f;
constexpr float DN_ALPHA = 1.189207115002721f;

__device__ __forceinline__ float wsum(float v) {
#pragma unroll
    for (int o = 32; o; o >>= 1) v += __shfl_xor(v, o);
    return v;
}
__device__ __forceinline__ float wmax(float v) {
#pragma unroll
    for (int o = 32; o; o >>= 1) v = fmaxf(v, __shfl_xor(v, o));
    return v;
}
__device__ __forceinline__ float gelu_tanh(float x) {
    const float k = 0.7978845608028654f;
    return 0.5f * x * (1.f + tanhf(k * (x + 0.044715f * x * x * x)));
}

__global__ __launch_bounds__(256) void k_ada(const float* c, const float* c_ctx, const float* ada_w, const float* ada_b, float* mod) {
    const int j = blockIdx.x * 256 + threadIdx.x, which = blockIdx.y;
    const float* cv = which < 2 ? c + which * D : c_ctx;
    float acc = 0.f;
    for (int k = 0; k < D; ++k) { const float v = cv[k]; acc += (v / (1.f + expf(-v))) * ada_w[(size_t)k * 6144 + j]; }
    mod[which * 6144 + j] = acc + ada_b[j];
}

__global__ __launch_bounds__(256) void k_lnmod(const float* x, const float* shift, const float* scale, int rows_per_batch, int cond_stride, float* out, int nrows) {
    const int row = blockIdx.x * 4 + (threadIdx.x >> 6), lane = threadIdx.x & 63;
    if (row >= nrows) return;
    const int b = row / rows_per_batch;
    const float* xr = x + (size_t)row * D;
    float v[16], s = 0.f;
#pragma unroll
    for (int i = 0; i < 16; ++i) { v[i] = xr[lane + 64 * i]; s += v[i]; }
    const float mean = wsum(s) * (1.f / D);
    float q = 0.f;
#pragma unroll
    for (int i = 0; i < 16; ++i) { v[i] -= mean; q += v[i] * v[i]; }
    const float rstd = rsqrtf(wsum(q) * (1.f / D) + EPS);
#pragma unroll
    for (int i = 0; i < 16; ++i) { const int col = lane + 64 * i; out[(size_t)row * D + col] = v[i] * rstd * (1.f + scale[b * cond_stride + col]) + shift[b * cond_stride + col]; }
}

template <int MODE>
__global__ __launch_bounds__(256) void k_gemm(const float* A, int lda, const float* Bm, int ldb, float* C, int ldc, int Mrows, int K,
                                              const float* bias, const int* list, const int* cnt, const int* off) {
    __shared__ float As[16][68];
    __shared__ float Bs[16][64];
    __shared__ float Bs2[16][64];
    const int tid = threadIdx.x, tx = tid & 15, ty = tid >> 4;
    const int m0 = blockIdx.y * 64, n0 = blockIdx.x * 64;
    int e = 0, rows = Mrows, cbase = 0;
    if (MODE != 0) { e = blockIdx.z; rows = cnt[e]; cbase = off[e]; if (m0 >= rows) return; Bm += (size_t)e * K * ldb; bias += (size_t)e * ldb; }
    const int lr = tid >> 2, lk = (tid & 3) * 4;
    int arow;
    {
        const int m = m0 + lr;
        if (MODE == 0) arow = m < rows ? m : 0;
        else if (MODE == 1) arow = m < rows ? (list[cbase + m] >> 2) : 0;
        else arow = m < rows ? cbase + m : 0;
    }
    const float* ap = A + (size_t)arow * lda + lk;
    const int bk = tid >> 4, bn = (tid & 15) * 4;
    float acc[4][4] = {}, acc2[4][4] = {};
    for (int k0 = 0; k0 < K; k0 += 16) {
        const float4 av = *(const float4*)(ap + k0);
        As[lk + 0][lr] = av.x; As[lk + 1][lr] = av.y; As[lk + 2][lr] = av.z; As[lk + 3][lr] = av.w;
        *(float4*)&Bs[bk][bn] = *(const float4*)(Bm + (size_t)(k0 + bk) * ldb + n0 + bn);
        if (MODE == 1) *(float4*)&Bs2[bk][bn] = *(const float4*)(Bm + (size_t)(k0 + bk) * ldb + 1024 + n0 + bn);
        __syncthreads();
#pragma unroll
        for (int kk = 0; kk < 16; ++kk) {
            float a[4], b[4], b2[4];
#pragma unroll
            for (int i = 0; i < 4; ++i) a[i] = As[kk][ty * 4 + i];
#pragma unroll
            for (int j = 0; j < 4; ++j) { b[j] = Bs[kk][tx * 4 + j]; if (MODE == 1) b2[j] = Bs2[kk][tx * 4 + j]; }
#pragma unroll
            for (int i = 0; i < 4; ++i)
#pragma unroll
                for (int j = 0; j < 4; ++j) { acc[i][j] += a[i] * b[j]; if (MODE == 1) acc2[i][j] += a[i] * b2[j]; }
        }
        __syncthreads();
    }
#pragma unroll
    for (int i = 0; i < 4; ++i) {
        const int m = m0 + ty * 4 + i;
        if (m >= rows) continue;
        float* cp = C + (size_t)(cbase + m) * ldc + n0 + tx * 4;
#pragma unroll
        for (int j = 0; j < 4; ++j) {
            const int n = n0 + tx * 4 + j;
            float v = acc[i][j] + (bias ? bias[n] : 0.f);
            if (MODE == 1) {
                const float g = fminf(v, 7.f);
                const float l = fminf(fmaxf(acc2[i][j] + bias[1024 + n], -7.f), 7.f);
                v = (l + 1.f) * (g / (1.f + expf(-1.702f * g)));
            }
            cp[j] = v;
        }
    }
}

__global__ __launch_bounds__(256) void k_attn(const float* proj, const float* kvc, const float* rpb, float* mixin) {
    __shared__ float sq[4][64];
    __shared__ float sp[4][384];
    const int w = threadIdx.x >> 6, lane = threadIdx.x & 63;
    const int gid = blockIdx.x * 4 + w;
    const int h = gid & 7, tok = gid >> 3, b = tok / S, t = tok % S, r = t / GW, c = t % GW;
    const int rs = min(max(r - KH / 2, 0), ROWS - KH), cs = min(max(c - KW / 2, 0), GW - KW);
    sq[w][lane] = proj[(size_t)tok * DIN + h * 64 + lane];
    __syncthreads();
    float sc[6];
    float mx = -1e30f;
#pragma unroll
    for (int i = 0; i < 6; ++i) {
        const int kk = lane + 64 * i;
        const float* kp; float bias = 0.f;
        if (kk < 128) {
            const int ki = kk >> 4, kj = kk & 15;
            kp = proj + (size_t)(b * S + (rs + ki) * GW + cs + kj) * DIN + 512 + h * 64;
            bias = rpb[(h * 15 + (rs + ki - r + 7)) * 31 + (cs + kj - c + 15)];
        } else {
            kp = kvc + (size_t)(b * CTX + (kk - 128)) * 1024 + h * 64;
        }
        float d = 0.f;
        for (int dd = 0; dd < 64; dd += 4) { const float4 kv = *(const float4*)(kp + dd); d += sq[w][dd] * kv.x + sq[w][dd + 1] * kv.y + sq[w][dd + 2] * kv.z + sq[w][dd + 3] * kv.w; }
        sc[i] = d * 0.125f + bias;
        mx = fmaxf(mx, sc[i]);
    }
    mx = wmax(mx);
    float sum = 0.f;
#pragma unroll
    for (int i = 0; i < 6; ++i) { const float p = expf(sc[i] - mx); sum += p; sp[w][lane + 64 * i] = p; }
    sum = wsum(sum);
    __syncthreads();
    float acc = 0.f;
    for (int kk = 0; kk < 384; ++kk) {
        const float* vp;
        if (kk < 128) { const int ki = kk >> 4, kj = kk & 15; vp = proj + (size_t)(b * S + (rs + ki) * GW + cs + kj) * DIN + 1024 + h * 64; }
        else vp = kvc + (size_t)(b * CTX + (kk - 128)) * 1024 + 512 + h * 64;
        acc += sp[w][kk] * vp[lane];
    }
    mixin[(size_t)tok * 1024 + h * 64 + lane] = acc / sum;
}

__global__ __launch_bounds__(256) void k_sgu_ln(const float* proj, const float* lg, const float* lb, float* gln) {
    const int tok = blockIdx.x * 4 + (threadIdx.x >> 6), lane = threadIdx.x & 63;
    float v[8], s = 0.f;
#pragma unroll
    for (int i = 0; i < 8; ++i) { v[i] = gelu_tanh(proj[(size_t)tok * DIN + 2048 + lane + 64 * i]); s += v[i]; }
    const float mean = wsum(s) * (1.f / 512.f);
    float q = 0.f;
#pragma unroll
    for (int i = 0; i < 8; ++i) { v[i] -= mean; q += v[i] * v[i]; }
    const float rstd = rsqrtf(wsum(q) * (1.f / 512.f) + EPS);
#pragma unroll
    for (int i = 0; i < 8; ++i) { const int col = lane + 64 * i; gln[(size_t)tok * 512 + col] = v[i] * rstd * lg[col] + lb[col]; }
}
__global__ __launch_bounds__(256) void k_sgu_mix(const float* proj, const float* gln, const float* sw, const float* sb, float* mixin) {
    const int idx = blockIdx.x * 256 + threadIdx.x;
    const int tok = idx >> 9, ch = idx & 511, grp = ch >> 7, i = tok & 127, base = tok - i;
    const float* wrow = sw + (size_t)(grp * 128 + i) * 128;
    float acc = 0.f;
    for (int j = 0; j < 128; ++j) acc += wrow[j] * gln[(size_t)(base + j) * 512 + ch];
    acc += sb[grp * 128 + i];
    mixin[(size_t)tok * 1024 + 512 + ch] = gelu_tanh(proj[(size_t)tok * DIN + 1536 + ch]) * acc;
}

__global__ __launch_bounds__(256) void k_ln1route(const float* x, const float* mix, const float* mod, const float* l1g, const float* l1b, const float* rw, const float* rb,
                           float* x1, float* h2, int* topi, float* topg) {
    const int tok = blockIdx.x * 4 + (threadIdx.x >> 6), lane = threadIdx.x & 63, b = tok / S;
    const float* g1 = mod + b * 6144 + 2 * 1024; const float* sh2 = mod + b * 6144 + 3 * 1024; const float* sc2 = mod + b * 6144 + 4 * 1024;
    float v[16], s = 0.f;
#pragma unroll
    for (int i = 0; i < 16; ++i) { const int col = lane + 64 * i; v[i] = DN_ALPHA * x[(size_t)tok * D + col] + g1[col] * mix[(size_t)tok * D + col]; s += v[i]; }
    float mean = wsum(s) * (1.f / D), q = 0.f;
#pragma unroll
    for (int i = 0; i < 16; ++i) { v[i] -= mean; q += v[i] * v[i]; }
    float rstd = rsqrtf(wsum(q) * (1.f / D) + EPS);
    s = 0.f;
#pragma unroll
    for (int i = 0; i < 16; ++i) { const int col = lane + 64 * i; v[i] = v[i] * rstd * l1g[col] + l1b[col]; x1[(size_t)tok * D + col] = v[i]; s += v[i]; }
    mean = wsum(s) * (1.f / D); q = 0.f;
#pragma unroll
    for (int i = 0; i < 16; ++i) { v[i] -= mean; q += v[i] * v[i]; }
    rstd = rsqrtf(wsum(q) * (1.f / D) + EPS);
    float lg[NE];
#pragma unroll
    for (int e = 0; e < NE; ++e) lg[e] = 0.f;
#pragma unroll
    for (int i = 0; i < 16; ++i) {
        const int col = lane + 64 * i;
        v[i] = v[i] * rstd * (1.f + sc2[col]) + sh2[col];
        h2[(size_t)tok * D + col] = v[i];
        const float* wr = rw + (size_t)col * NE;
#pragma unroll
        for (int e = 0; e < NE; ++e) lg[e] += v[i] * wr[e];
    }
#pragma unroll
    for (int e = 0; e < NE; ++e) lg[e] = wsum(lg[e]) + rb[e];
    int bi[TOPK]; float bv[TOPK];
    unsigned used = 0u;
#pragma unroll
    for (int k = 0; k < TOPK; ++k) {
        float best = -3.0e38f; int bidx = 0;
#pragma unroll
        for (int e = 0; e < NE; ++e) { const bool ok = !((used >> e) & 1u) && lg[e] > best; best = ok ? lg[e] : best; bidx = ok ? e : bidx; }
        used |= 1u << bidx; bi[k] = bidx; bv[k] = best;
    }
    float den = 0.f, pe[TOPK];
#pragma unroll
    for (int k = 0; k < TOPK; ++k) { pe[k] = expf(bv[k] - bv[0]); den += pe[k]; }
    if (lane == 0) {
#pragma unroll
        for (int k = 0; k < TOPK; ++k) { topi[tok * TOPK + k] = bi[k]; topg[tok * TOPK + k] = pe[k] / den; }
    }
}

__global__ __launch_bounds__(1024) void k_count(const int* topi, int* cnt) {
    __shared__ int sh[1024];
    const int e = blockIdx.x, t = threadIdx.x;
    int c = 0;
    for (int i = 0; i < 64; ++i) c += (topi[t * 64 + i] == e);
    sh[t] = c; __syncthreads();
    for (int o = 512; o; o >>= 1) { if (t < o) sh[t] += sh[t + o]; __syncthreads(); }
    if (t == 0) cnt[e] = sh[0];
}
__global__ __launch_bounds__(1024) void k_group(const int* topi, const int* cnt, int* off, int* list, int* pos) {
    __shared__ int sh[1024];
    const int e = blockIdx.x, t = threadIdx.x;
    int base = 0;
    for (int i = 0; i < e; ++i) base += cnt[i];
    if (t == 0) off[e] = base;
    int c = 0;
    for (int i = 0; i < 64; ++i) c += (topi[t * 64 + i] == e);
    sh[t] = c; __syncthreads();
    if (t == 0) { int run = 0; for (int i = 0; i < 1024; ++i) { const int x = sh[i]; sh[i] = run; run += x; } }
    __syncthreads();
    int p = base + sh[t];
    for (int i = 0; i < 64; ++i) { const int pr = t * 64 + i; if (topi[pr] == e) { list[p] = pr; pos[pr] = p; ++p; } }
}
__global__ __launch_bounds__(256) void k_combine(const float* y, const int* pos, const float* topg, float* ffn) {
    const int idx = blockIdx.x * 256 + threadIdx.x, tok = idx >> 10, n = idx & 1023;
    float acc = 0.f;
#pragma unroll
    for (int k = 0; k < TOPK; ++k) acc += topg[tok * TOPK + k] * y[(size_t)pos[tok * TOPK + k] * D + n];
    ffn[idx] = acc;
}
__global__ __launch_bounds__(256) void k_final(const float* x1, const float* ffn, const float* mod, const float* l2g, const float* l2b, float* out) {
    const int tok = blockIdx.x * 4 + (threadIdx.x >> 6), lane = threadIdx.x & 63, b = tok / S;
    const float* g2 = mod + b * 6144 + 5 * 1024;
    float v[16], s = 0.f;
#pragma unroll
    for (int i = 0; i < 16; ++i) { const int col = lane + 64 * i; v[i] = DN_ALPHA * x1[(size_t)tok * D + col] + g2[col] * ffn[(size_t)tok * D + col]; s += v[i]; }
    const float mean = wsum(s) * (1.f / D);
    float q = 0.f;
#pragma unroll
    for (int i = 0; i < 16; ++i) { v[i] -= mean; q += v[i] * v[i]; }
    const float rstd = rsqrtf(wsum(q) * (1.f / D) + EPS);
#pragma unroll
    for (int i = 0; i < 16; ++i) { const int col = lane + 64 * i; out[(size_t)tok * D + col] = v[i] * rstd * l2g[col] + l2b[col]; }
}
}

extern "C" void kernel_launch(void* const* d_in, const int* in_sizes, int n_in, void* d_out, int out_size, void* d_ws, size_t ws_size, hipStream_t stream) {
    const float* x = (const float*)d_in[0]; const float* c = (const float*)d_in[1]; const float* ctx = (const float*)d_in[2]; const float* c_ctx = (const float*)d_in[3];
    const float* ada_w = (const float*)d_in[4]; const float* ada_b = (const float*)d_in[5]; const float* w_in = (const float*)d_in[6]; const float* rpb = (const float*)d_in[7];
    const float* sgu_ln_g = (const float*)d_in[8]; const float* sgu_ln_b = (const float*)d_in[9]; const float* sgu_w = (const float*)d_in[10]; const float* sgu_b = (const float*)d_in[11];
    const float* w_out = (const float*)d_in[12]; const float* ln1_g = (const float*)d_in[13]; const float* ln1_b = (const float*)d_in[14]; const float* ln2_g = (const float*)d_in[15];
    const float* ln2_b = (const float*)d_in[16]; const float* router_w = (const float*)d_in[17]; const float* router_b = (const float*)d_in[18];
    const float* w_gu = (const float*)d_in[19]; const float* b_gu = (const float*)d_in[20]; const float* w_dn = (const float*)d_in[21]; const float* b_dn = (const float*)d_in[22];
    float* out = (float*)d_out;
    constexpr size_t MiB = 1u << 20;
    char* ws = (char*)d_ws;
    float* mod = (float*)(ws + 0);
    int* cnt = (int*)(ws + 128 * 1024); int* off = cnt + 64;
    int* topi = (int*)(ws + 1 * MiB); float* topg = (float*)(ws + 2 * MiB); int* list = (int*)(ws + 3 * MiB); int* pos = (int*)(ws + 4 * MiB);
    float* hc = (float*)(ws + 5 * MiB);
    float* kvc = (float*)(ws + 7 * MiB);
    float* R0 = (float*)(ws + 16 * MiB);
    float* proj = (float*)(ws + 80 * MiB);
    float* mixin = (float*)(ws + 240 * MiB);
    float* gln = (float*)(ws + 304 * MiB);
    float* ybuf = proj;
    float* x1 = (float*)(ws + 336 * MiB);
    float* h2 = (float*)(ws + 400 * MiB);
    float* act = (float*)(ws + 464 * MiB);
    if (ws_size < 720 * MiB) { fprintf(stderr, "workspace too small: %zu\n", ws_size); return; }
    float* hx = R0; float* mix = R0; float* ffn = R0;

    k_ada<<<dim3(24, 3), 256, 0, stream>>>(c, c_ctx, ada_w, ada_b, mod);
    k_lnmod<<<M / 4, 256, 0, stream>>>(x, mod + 0, mod + 1024, S, 6144, hx, M);
    k_lnmod<<<(NB * CTX) / 4, 256, 0, stream>>>(ctx, mod + 2 * 6144, mod + 2 * 6144 + 1024, CTX, 0, hc, NB * CTX);
    k_gemm<0><<<dim3(DIN / 64, M / 64, 1), 256, 0, stream>>>(hx, D, w_in, DIN, proj, DIN, M, D, nullptr, nullptr, nullptr, nullptr);
    k_gemm<0><<<dim3(1024 / 64, (NB * CTX) / 64, 1), 256, 0, stream>>>(hc, D, w_in + 512, DIN, kvc, 1024, NB * CTX, D, nullptr, nullptr, nullptr, nullptr);
    k_attn<<<M * NH / 4, 256, 0, stream>>>(proj, kvc, rpb, mixin);
    k_sgu_ln<<<M / 4, 256, 0, stream>>>(proj, sgu_ln_g, sgu_ln_b, gln);
    k_sgu_mix<<<M * 512 / 256, 256, 0, stream>>>(proj, gln, sgu_w, sgu_b, mixin);
    k_gemm<0><<<dim3(D / 64, M / 64, 1), 256, 0, stream>>>(mixin, D, w_out, D, mix, D, M, D, nullptr, nullptr, nullptr, nullptr);
    k_ln1route<<<M / 4, 256, 0, stream>>>(x, mix, mod, ln1_g, ln1_b, router_w, router_b, x1, h2, topi, topg);
    k_count<<<NE, 1024, 0, stream>>>(topi, cnt);
    k_group<<<NE, 1024, 0, stream>>>(topi, cnt, off, list, pos);
    k_gemm<1><<<dim3(DFF / 64, M / 64, NE), 256, 0, stream>>>(h2, D, w_gu, 2 * DFF, act, DFF, 0, D, b_gu, list, cnt, off);
    k_gemm<2><<<dim3(D / 64, M / 64, NE), 256, 0, stream>>>(act, DFF, w_dn, D, ybuf, D, 0, DFF, b_dn, list, cnt, off);
    k_combine<<<M * D / 256, 256, 0, stream>>>(ybuf, pos, topg, ffn);
    k_final<<<M / 4, 256, 0, stream>>>(x1, ffn, mod, ln2_g, ln2_b, out);
}
```

```cpp
#include <hip/hip_runtime.h>
#include <stdint.h>
#include <stdio.h>

#define GAS __attribute__((address_space(1)))
#define LAS __attribute__((address_space(3)))
typedef unsigned short bf16_t;
typedef short bf16x8 __attribute__((ext_vector_type(8)));
typedef float f32x4 __attribute__((ext_vector_type(4)));
typedef float f32x2 __attribute__((ext_vector_type(2)));
typedef unsigned u32x4 __attribute__((ext_vector_type(4)));
typedef unsigned u32x2 __attribute__((ext_vector_type(2)));

namespace mk {
constexpr int D = 1024, NB = 2, S = 8192, M = NB * S, GW = 64, ROWS = 128, CTX = 256, NH = 8, KH = 8, KW = 16;
constexpr int NE = 32, TOPK = 4, DFF = 1024, DIN = 2560, NPAIR = M * TOPK, MX = M + NB * CTX;
constexpr int LCAP = 16384, MAXT = 288, ACT_ROWS = MAXT * 256;
constexpr float EPS = 1e-5f;
constexpr float DN_ALPHA = 1.189207115002721f;
constexpr size_t MiB = 1u << 20;
constexpr size_t WS_CTL = 0, CTL_ZERO_BYTES = 1 * MiB;
constexpr size_t WS_MOD = 1 * MiB;
constexpr size_t WS_TOPG = 2 * MiB;
constexpr size_t WS_TOPI = 2 * MiB + 512 * 1024;
constexpr size_t WS_LIST = 3 * MiB;
constexpr size_t WS_SGUW = 5 * MiB;
constexpr size_t WS_WIN = 6 * MiB;
constexpr size_t WS_WOUT = 11 * MiB;
constexpr size_t WS_WGU = 16 * MiB;
constexpr size_t WS_WDN = 144 * MiB;
constexpr size_t WS_HXC = 208 * MiB;
constexpr size_t WS_PROJ = 241 * MiB;
constexpr size_t WS_MIXIN = 324 * MiB;
constexpr size_t WS_Y1 = 356 * MiB;
constexpr size_t WS_H2 = 420 * MiB;
constexpr size_t WS_ACT = 452 * MiB;
constexpr size_t WS_YBUF = 596 * MiB;
constexpr size_t WS_END = 724 * MiB;
constexpr int CW_BAR = 4096;
constexpr int CW_CNT = 8192;
constexpr int RING_BYTES = 131072;
constexpr int L_MISC = RING_BYTES;
constexpr int L_IDX = L_MISC + 1024;
constexpr int L_TILEE = L_IDX + 3072;
constexpr int L_TSTART = L_TILEE + 1280;
constexpr int L_ROUTE = L_TSTART + 512;
constexpr int L_RPB = L_ROUTE + 256 + 1024;
constexpr int L_WSCR = L_RPB + 2048;
constexpr int LDS_BYTES = 147456;
static_assert(L_WSCR + 8 * 512 <= LDS_BYTES, "LDS map");

__device__ __forceinline__ float wsum(float v) {
#pragma unroll
    for (int o = 32; o; o >>= 1) v += __shfl_xor(v, o);
    return v;
}
__device__ __forceinline__ float wmax(float v) {
#pragma unroll
    for (int o = 32; o; o >>= 1) v = fmaxf(v, __shfl_xor(v, o));
    return v;
}
__device__ __forceinline__ unsigned f2bf(float f) { unsigned u = __builtin_bit_cast(unsigned, f); return (u + 0x7fffu + ((u >> 16) & 1u)) >> 16; }
__device__ __forceinline__ unsigned pk2(float lo, float hi) { return f2bf(lo) | (f2bf(hi) << 16); }
__device__ __forceinline__ float bf2f(unsigned short b) { return __builtin_bit_cast(float, ((unsigned)b) << 16); }
__device__ __forceinline__ float bflo(unsigned w) { return __builtin_bit_cast(float, w << 16); }
__device__ __forceinline__ float bfhi(unsigned w) { return __builtin_bit_cast(float, w & 0xffff0000u); }
__device__ __forceinline__ unsigned cvt_pk_bf16(float lo, float hi) { unsigned r; asm volatile("v_cvt_pk_bf16_f32 %0, %1, %2" : "=v"(r) : "v"(lo), "v"(hi)); return r; }
__device__ __forceinline__ float gelu_fast(float x) {
    const float c1 = -2.302208198f;
    const float c3 = c1 * 0.044715f;
    const float x2 = x * x;
    const float t = x * (c1 + c3 * x2);
    return x * __builtin_amdgcn_rcpf(1.f + __builtin_amdgcn_exp2f(t));
}

#define XB_TMO      128
#define XB_XCNT(j)  (256  + 64 * (j))
#define XB_XSUB(j)  (1280 + 64 * (j))
#define XB_XGEN(j)  (2304 + 64 * (j))
#define XB_TOP      3328
#define XB_TOPGEN   3392
#define XCD_BAR_WORDS 3456
#define XB_SPIN_CAP (1u << 18)
__device__ __forceinline__ unsigned xb_ld(unsigned* p)              { return __hip_atomic_load(p, __ATOMIC_RELAXED, __HIP_MEMORY_SCOPE_AGENT); }
__device__ __forceinline__ unsigned xb_add(unsigned* p, unsigned v) { return __hip_atomic_fetch_add(p, v, __ATOMIC_RELAXED, __HIP_MEMORY_SCOPE_AGENT); }
__device__ __forceinline__ unsigned xb_xcc_id() { return (unsigned)__builtin_amdgcn_s_getreg((3 << 11) | 20) & 0xFu; }
#define XB_SPIN(cond, bar) do { unsigned _sp = 0; while (cond) { __builtin_amdgcn_s_sleep(1); \
    if ((++_sp & 255u) == 0u) { if (xb_ld(&(bar)[XB_TMO])) break; if (_sp > XB_SPIN_CAP) { atomicAdd(&(bar)[XB_TMO], 1u); break; } } } } while (0)
struct XcdBarrier { unsigned* bar; unsigned x; volatile LAS unsigned* st; };
__device__ __forceinline__ XcdBarrier xcd_barrier_post(unsigned* bar, volatile LAS unsigned* st) {
    XcdBarrier b; b.bar = bar; b.x = xb_xcc_id(); b.st = st;
    if (threadIdx.x == 0) (void)xb_add(&bar[XB_XCNT(b.x)], 1u);
    return b;
}
__device__ __forceinline__ void xcd_barrier_complete(unsigned* bar, unsigned x, unsigned& nloc, unsigned& nx) {
    const unsigned G = gridDim.x * gridDim.y * gridDim.z;
    unsigned sum, cnt, mine, sp = 0u;
    for (;;) {
        sum = 0u; cnt = 0u; mine = 0u;
#pragma unroll
        for (unsigned j = 0; j < 16; ++j) { const unsigned c = xb_ld(&bar[XB_XCNT(j)]); sum += c; cnt += (c > 0u) ? 1u : 0u; mine = (j == x) ? c : mine; }
        if (sum == G) break;
        __builtin_amdgcn_s_sleep(1);
        if ((++sp & 255u) == 0u) { if (xb_ld(&bar[XB_TMO])) break; if (sp > XB_SPIN_CAP) { atomicAdd(&bar[XB_TMO], 1u); break; } }
    }
    nloc = mine > 0u ? mine : 1u; nx = cnt > 0u ? cnt : 1u;
}
__device__ __forceinline__ void xcd_barrier(const XcdBarrier& b) {
    asm volatile("s_waitcnt vmcnt(0)" ::: "memory");
    __syncthreads();
    if (threadIdx.x == 0) {
        unsigned* bar = b.bar;
        __builtin_amdgcn_s_waitcnt(0);
        unsigned nloc = b.st[0], nx = b.st[1];
        if (nloc == 0u) { xcd_barrier_complete(bar, b.x, nloc, nx); b.st[0] = nloc; b.st[1] = nx; }
        const unsigned old = xb_add(&bar[XB_XSUB(b.x)], 1u);
        const unsigned gen = old / nloc;
        if (old + 1u == (gen + 1u) * nloc) {
            __builtin_amdgcn_fence(__ATOMIC_RELEASE, "agent");
            asm volatile("s_waitcnt vmcnt(0)" ::: "memory");
            const unsigned og = xb_add(&bar[XB_TOP], 1u);
            const unsigned tg = og / nx;
            if (og + 1u == (tg + 1u) * nx) xb_add(&bar[XB_TOPGEN], 1u);
            else XB_SPIN(xb_ld(&bar[XB_TOPGEN]) == tg, bar);
            __builtin_amdgcn_fence(__ATOMIC_ACQUIRE, "agent");
            xb_add(&bar[XB_XGEN(b.x)], 1u);
            asm volatile("s_waitcnt vmcnt(0)" ::: "memory");
        } else {
            XB_SPIN(xb_ld(&bar[XB_XGEN(b.x)]) == gen, bar);
            __builtin_amdgcn_fence(__ATOMIC_ACQUIRE, "agent");
            asm volatile("s_waitcnt vmcnt(0)" ::: "memory");
        }
    }
    __syncthreads();
}

struct Frame {
    LAS unsigned char* lds;
    volatile LAS unsigned* MISC;
    unsigned* ctl;
    int tid, lane, wave, vcu, G;
    const float *x, *c, *ctx, *c_ctx, *ada_w, *ada_b, *w_in, *rpb, *sgu_ln_g, *sgu_ln_b, *sgu_w, *sgu_b, *w_out, *ln1_g, *ln1_b, *ln2_g, *ln2_b, *router_w, *router_b, *w_gu, *b_gu, *w_dn, *b_dn;
    float* out;
    float* mod; float* topg; int* topi; int* list; bf16_t* sguw; bf16_t* Wt_in; bf16_t* Wt_out; bf16_t* Wt_gu; bf16_t* Wt_dn;
    bf16_t* hxc; bf16_t* proj; bf16_t* mixin; float* y1; bf16_t* h2; bf16_t* act; bf16_t* ybuf;
};
#define LDS_WAIT() asm volatile("s_waitcnt lgkmcnt(0)" ::: "memory")
#define VM_WAIT() asm volatile("s_waitcnt vmcnt(0)" ::: "memory")

namespace pg8 {
constexpr int BM = 256, BK = 64, HALF = 128, HTB = HALF * BK * 2, STAGE_BYTES = 8 * HTB, NXCD = 8, WGM = 8, KD = 1024, NKT = KD / BK;
__device__ __forceinline__ int lds_byte(int r, int c) { const int st = (r >> 4) * 2 + (c >> 5), rr = r & 15, cc = c & 31, ob = rr * 64 + cc * 2; return st * 1024 + (ob ^ (((ob >> 9) & 1) << 5)); }
__device__ __forceinline__ void stage_rc(int b, int& R, int& C) { const int st = b / 1024, sb = b % 1024, swz = sb ^ (((sb >> 9) & 1) << 5); R = (st >> 1) * 16 + swz / 64; C = (st & 1) * 32 + (swz % 64) / 2; }
__device__ __forceinline__ int perm32(int rho) { const int n = rho >> 4, i = rho & 15; return 8 * (i >> 2) + 4 * n + (i & 3); }
struct Unit { int pm, pn, e, nvalid, ti; };
__device__ __forceinline__ void static_tile(int L, int nM, int nN, int& pm, int& pn) {
    const int nwg = nM * nN; int wgid = L;
    { const int q = nwg / NXCD, r = nwg % NXCD, xcd = wgid % NXCD, off = wgid / NXCD; wgid = (xcd < r ? xcd * (q + 1) : r * (q + 1) + (xcd - r) * q) + off; }
    const int nig = WGM * nN, gid = wgid / nig, fm = gid * WGM, gsz = (nM - fm) < WGM ? (nM - fm) : WGM;
    pm = fm + ((wgid % nig) % gsz); pn = (wgid % nig) / gsz;
}

template <class P>
__device__ __forceinline__ void gemm_phase(LAS unsigned char* lds, const P& pol) {
    const int tid = threadIdx.x, wid = __builtin_amdgcn_readfirstlane(tid >> 6), lane = tid & 63, wr = wid >> 2, wc = wid & 3, fr = lane & 15, fq = lane >> 4;
    unsigned voffB[2]; int Ra[2], Ca[2];
#pragma unroll
    for (int i = 0; i < 2; ++i) { int R, C; stage_rc(tid * 16 + i * 8192, R, C); const int Rb = P::PERM ? ((R & ~31) + perm32(R & 31)) : R;
        voffB[i] = (unsigned)(Rb * KD + C) * 2u; Ra[i] = R; Ca[i] = C; }
    const size_t kstep = (size_t)(BK * 2);
    const size_t hstep = (size_t)HALF * KD * 2;
    const unsigned ldsw = (unsigned)wid * 1024u;
    const int aoff = lds_byte(wr * 64 + fr, fq * 8), boff = lds_byte(wc * 32 + fr, fq * 8);
#define PG8_SA(b, h) (((b) * 2 + (h)) * HTB)
#define PG8_SB(b, h) ((4 + (b) * 2 + (h)) * HTB)
#define PG8_STAGE(bufoff, gbase, voff) do { _Pragma("unroll") for (int _i = 0; _i < 2; ++_i) \
        __builtin_amdgcn_global_load_lds((const unsigned*)((const char*)(gbase) + (voff)[_i]), (LAS unsigned*)(lds + (bufoff) + ldsw + _i * 8192), 16, 0, 0); } while (0)
#define PG8_LDA(dst, b, h) do { _Pragma("unroll") for (int m = 0; m < 4; ++m) _Pragma("unroll") for (int k = 0; k < 2; ++k) dst[m][k] = *(const LAS bf16x8*)(lds + PG8_SA(b, h) + aoff + m * 2048 + k * 1024); } while (0)
#define PG8_LDB(dst, b, h) do { _Pragma("unroll") for (int n = 0; n < 2; ++n) _Pragma("unroll") for (int k = 0; k < 2; ++k) dst[n][k] = *(const LAS bf16x8*)(lds + PG8_SB(b, h) + boff + n * 2048 + k * 1024); } while (0)
#define PG8_MMA(ai, bj, At, Bt) do { __builtin_amdgcn_s_setprio(1); _Pragma("unroll") for (int m = 0; m < 4; ++m) _Pragma("unroll") for (int n = 0; n < 2; ++n) _Pragma("unroll") for (int k = 0; k < 2; ++k) \
        acc[ai][bj][m][n] = __builtin_amdgcn_mfma_f32_16x16x32_bf16(Bt[n][k], At[m][k], acc[ai][bj][m][n], 0, 0, 0); __builtin_amdgcn_s_setprio(0); } while (0)
#define PG8_WAIT_V(n) asm volatile("s_waitcnt vmcnt(" #n ")" ::: "memory")
#define PG8_WAIT_L(n) asm volatile("s_waitcnt lgkmcnt(" #n ")" ::: "memory")
#define PG8_BAR __builtin_amdgcn_s_barrier()
#define PG8_SCHED __builtin_amdgcn_sched_barrier(0)
    Unit cur, nxt; int ui = 0;
    if (!pol.next(0, cur)) return;
    f32x4 acc[2][2][4][2];
#pragma unroll
    for (int a = 0; a < 2; ++a)
#pragma unroll
        for (int b = 0; b < 2; ++b)
#pragma unroll
            for (int m = 0; m < 4; ++m)
#pragma unroll
                for (int n = 0; n < 2; ++n) acc[a][b][m][n] = (f32x4){0.f, 0.f, 0.f, 0.f};
    bf16x8 At[4][2], B0[2][2], B1[2][2];
    int slot = 0;
    if (P::META) { pol.meta_issue(cur, 0, lds, wid, lane); PG8_WAIT_V(0); asm volatile("" ::: "memory"); PG8_BAR; asm volatile("" ::: "memory"); }
    unsigned aC[2][2], aN[2][2];
    pol.a_off(cur, 0, lds, Ra, Ca, aC);
    const char* const Ab = (const char*)pol.A;
    const char* cB = pol.b_ptr(cur);
    PG8_STAGE(PG8_SB(0, 0), cB, voffB); PG8_STAGE(PG8_SB(0, 1), cB + hstep, voffB); PG8_STAGE(PG8_SA(0, 0), Ab, aC[0]); PG8_STAGE(PG8_SA(0, 1), Ab, aC[1]);
    if (wr == 1) PG8_BAR;
    PG8_WAIT_V(2); PG8_BAR;
    PG8_STAGE(PG8_SB(1, 0), cB + kstep, voffB); PG8_STAGE(PG8_SA(1, 0), Ab + kstep, aC[0]); PG8_STAGE(PG8_SB(1, 1), cB + hstep + kstep, voffB);
    PG8_WAIT_V(6); PG8_BAR;
    for (;;) {
        const bool has_next = pol.next(ui + 1, nxt);
        const int nslot = slot == 2 ? 0 : slot + 1;
        if (P::META) { if (has_next) pol.meta_issue(nxt, nslot, lds, wid, lane); }
        const char* nB = has_next ? pol.b_ptr(nxt) : cB;
        for (int t = 0; t < NKT; t += 2) {
            const bool last = (t == NKT - 2);
            if (last) { if (has_next) pol.a_off(nxt, nslot, lds, Ra, Ca, aN); else { aN[0][0] = aC[0][0]; aN[0][1] = aC[0][1]; aN[1][0] = aC[1][0]; aN[1][1] = aC[1][1]; } }
            const char* a1 = Ab + (size_t)(t + 1) * kstep;
            const char* a2 = last ? Ab : Ab + (size_t)(t + 2) * kstep; const char* b2 = last ? nB : cB + (size_t)(t + 2) * kstep;
            const char* a3 = a2 + kstep; const char* b3 = b2 + kstep;
            unsigned o2[2][2];
            o2[0][0] = last ? aN[0][0] : aC[0][0]; o2[0][1] = last ? aN[0][1] : aC[0][1]; o2[1][0] = last ? aN[1][0] : aC[1][0]; o2[1][1] = last ? aN[1][1] : aC[1][1];
            PG8_LDB(B0, 0, 0); PG8_LDB(B1, 0, 1); PG8_SCHED; PG8_LDA(At, 0, 0); PG8_STAGE(PG8_SA(1, 1), a1, aC[1]);
            PG8_WAIT_V(8); PG8_WAIT_L(0); PG8_BAR; PG8_MMA(0, 0, At, B0); PG8_MMA(0, 1, At, B1); PG8_BAR; PG8_SCHED;
            PG8_LDA(At, 0, 1); PG8_STAGE(PG8_SB(0, 0), b2, voffB); PG8_STAGE(PG8_SB(0, 1), b2 + hstep, voffB); PG8_STAGE(PG8_SA(0, 0), a2, o2[0]);
            PG8_WAIT_V(8); PG8_WAIT_L(0); PG8_BAR; PG8_MMA(1, 0, At, B0); PG8_MMA(1, 1, At, B1); PG8_BAR; PG8_SCHED;
            PG8_LDB(B0, 1, 0); PG8_LDB(B1, 1, 1); PG8_SCHED; PG8_LDA(At, 1, 0); PG8_STAGE(PG8_SA(0, 1), a2, o2[1]);
            PG8_WAIT_V(8); PG8_WAIT_L(0); PG8_BAR; PG8_MMA(0, 0, At, B0); PG8_MMA(0, 1, At, B1); PG8_BAR; PG8_SCHED;
            PG8_LDA(At, 1, 1); PG8_STAGE(PG8_SB(1, 0), b3, voffB); PG8_STAGE(PG8_SB(1, 1), b3 + hstep, voffB); PG8_STAGE(PG8_SA(1, 0), a3, o2[0]);
            PG8_WAIT_V(8); PG8_WAIT_L(0); PG8_BAR; PG8_MMA(1, 0, At, B0); PG8_MMA(1, 1, At, B1); PG8_BAR; PG8_SCHED;
        }
        if (wr == 0) PG8_BAR;
        pol.epi(acc, cur, slot, lds, wr, wc, fr, fq);
        if (!has_next) break;
#pragma unroll
        for (int a = 0; a < 2; ++a)
#pragma unroll
            for (int b = 0; b < 2; ++b)
#pragma unroll
                for (int m = 0; m < 4; ++m)
#pragma unroll
                    for (int n = 0; n < 2; ++n) acc[a][b][m][n] = (f32x4){0.f, 0.f, 0.f, 0.f};
        cur = nxt; cB = nB; ++ui; slot = nslot;
        aC[0][0] = aN[0][0]; aC[0][1] = aN[0][1]; aC[1][0] = aN[1][0]; aC[1][1] = aN[1][1];
        if (wr == 1) PG8_BAR;
    }
    PG8_WAIT_V(0);
    PG8_BAR;
#undef PG8_SA
#undef PG8_SB
#undef PG8_STAGE
#undef PG8_LDA
#undef PG8_LDB
#undef PG8_MMA
#undef PG8_WAIT_V
#undef PG8_WAIT_L
#undef PG8_BAR
#undef PG8_SCHED
}
}

typedef f32x4 AccT[2][2][4][2];

struct PolProj {
    static constexpr bool PERM = true, META = false;
    const bf16_t* A; const bf16_t* Bt; bf16_t* O; int G, c;
    __device__ __forceinline__ bool next(int i, pg8::Unit& u) const {
        const int L = i * G + c;
        if (L < 640) { pg8::static_tile(L, 64, 10, u.pm, u.pn); return true; }
        if (L < 648) { const int j = L - 640; u.pm = 64 + (j >> 2); u.pn = 2 + (j & 3); return true; }
        return false;
    }
    __device__ __forceinline__ const char* b_ptr(const pg8::Unit& u) const { return (const char*)Bt + (size_t)u.pn * 256 * 1024 * 2; }
    __device__ __forceinline__ void meta_issue(const pg8::Unit&, int, LAS unsigned char*, int, int) const {}
    __device__ __forceinline__ void a_off(const pg8::Unit& u, int, LAS unsigned char*, const int (&Ra)[2], const int (&Ca)[2], unsigned (&o)[2][2]) const {
#pragma unroll
        for (int h = 0; h < 2; ++h)
#pragma unroll
            for (int i = 0; i < 2; ++i) o[h][i] = (unsigned)((u.pm * 256 + 128 * h + Ra[i]) * 1024 + Ca[i]) * 2u;
    }
    __device__ __forceinline__ void epi(const AccT& acc, const pg8::Unit& u, int, LAS unsigned char*, int wr, int wc, int fr, int fq) const {
        const int row0 = u.pm * 256 + wr * 64 + fr, col0 = u.pn * 256 + wc * 32 + 8 * fq;
        const bool act = u.pn >= 6;
#pragma unroll
        for (int ai = 0; ai < 2; ++ai)
#pragma unroll
            for (int m = 0; m < 4; ++m) { bf16_t* rowp = O + (size_t)(row0 + ai * 128 + m * 16) * DIN + col0;
#pragma unroll
                for (int bj = 0; bj < 2; ++bj) { f32x4 v0 = acc[ai][bj][m][0], v1 = acc[ai][bj][m][1];
                    if (act) {
#pragma unroll
                        for (int j = 0; j < 4; ++j) { v0[j] = gelu_fast(v0[j]); v1[j] = gelu_fast(v1[j]); } }
                    u32x4 w; w.x = cvt_pk_bf16(v0[0], v0[1]); w.y = cvt_pk_bf16(v0[2], v0[3]); w.z = cvt_pk_bf16(v1[0], v1[1]); w.w = cvt_pk_bf16(v1[2], v1[3]);
                    *(u32x4*)(rowp + bj * 128) = w; } }
    }
};

struct PolOut {
    static constexpr bool PERM = false, META = false;
    const bf16_t* A; const bf16_t* Bt; const float* x; const float* mod; float* Y; int G, c;
    __device__ __forceinline__ bool next(int i, pg8::Unit& u) const { const int L = i * G + c; if (L >= 256) return false; pg8::static_tile(L, 64, 4, u.pm, u.pn); return true; }
    __device__ __forceinline__ const char* b_ptr(const pg8::Unit& u) const { return (const char*)Bt + (size_t)u.pn * 256 * 1024 * 2; }
    __device__ __forceinline__ void meta_issue(const pg8::Unit&, int, LAS unsigned char*, int, int) const {}
    __device__ __forceinline__ void a_off(const pg8::Unit& u, int, LAS unsigned char*, const int (&Ra)[2], const int (&Ca)[2], unsigned (&o)[2][2]) const {
#pragma unroll
        for (int h = 0; h < 2; ++h)
#pragma unroll
            for (int i = 0; i < 2; ++i) o[h][i] = (unsigned)((u.pm * 256 + 128 * h + Ra[i]) * 1024 + Ca[i]) * 2u;
    }
    __device__ __forceinline__ void epi(const AccT& acc, const pg8::Unit& u, int, LAS unsigned char*, int wr, int wc, int fr, int fq) const {
        const int row0 = u.pm * 256 + wr * 64 + fr, col0 = u.pn * 256 + wc * 32 + 4 * fq;
        const float* g1 = mod + (u.pm >= 32 ? 6144 : 0) + 2 * 1024;
        f32x4 gv[2][2];
#pragma unroll
        for (int bj = 0; bj < 2; ++bj)
#pragma unroll
            for (int n = 0; n < 2; ++n) gv[bj][n] = *(const f32x4*)(g1 + col0 + bj * 128 + n * 16);
#pragma unroll
        for (int ai = 0; ai < 2; ++ai)
#pragma unroll
            for (int m = 0; m < 4; ++m) { const size_t off = (size_t)(row0 + ai * 128 + m * 16) * D + col0;
#pragma unroll
                for (int bj = 0; bj < 2; ++bj)
#pragma unroll
                    for (int n = 0; n < 2; ++n) { const f32x4 xv = *(const f32x4*)(x + off + bj * 128 + n * 16);
                        *(f32x4*)(Y + off + bj * 128 + n * 16) = xv * DN_ALPHA + gv[bj][n] * acc[ai][bj][m][n]; }
                asm volatile("" ::: "memory"); }
    }
};

struct ExpTab { const LAS int* tile_e; const LAS int* tstart; const LAS int* cnt; int T; };
__device__ __forceinline__ int expert_tables(Frame& F) {
    LAS int* tile_e = (LAS int*)(F.lds + L_TILEE); LAS int* tstart = (LAS int*)(F.lds + L_TSTART); LAS int* cn = tstart + 64;
    if (F.tid < 32) cn[F.tid] = (int)__hip_atomic_load(F.ctl + CW_CNT + 32 * F.tid, __ATOMIC_RELAXED, __HIP_MEMORY_SCOPE_AGENT);
    __syncthreads();
    if (F.tid == 0) { int run = 0; for (int e = 0; e < NE; ++e) { tstart[e] = run; run += (cn[e] + 255) >> 8; } tstart[NE] = run; }
    __syncthreads();
    const int T = tstart[NE];
    if (F.tid < MAXT && F.tid < T) { int e = 0; while (e < NE - 1 && tstart[e + 1] <= F.tid) ++e; tile_e[F.tid] = e; }
    __syncthreads();
    return T < MAXT ? T : MAXT;
}
__device__ __forceinline__ int rfl(int v) { return __builtin_amdgcn_readfirstlane(v); }

struct PolGU {
    static constexpr bool PERM = true, META = true;
    const bf16_t* A; const bf16_t* Bt; const float* bias; const int* list; bf16_t* O; ExpTab tb; int G, c;
    __device__ __forceinline__ bool next(int i, pg8::Unit& u) const {
        const int L = i * G + c; if (L >= tb.T * 8) return false;
        u.ti = L >> 3; u.pn = L & 7; u.e = rfl(tb.tile_e[u.ti]); u.pm = u.ti - rfl(tb.tstart[u.e]);
        const int rem = rfl(tb.cnt[u.e]) - u.pm * 256; u.nvalid = rem < 256 ? rem : 256; return true;
    }
    __device__ __forceinline__ const char* b_ptr(const pg8::Unit& u) const { return (const char*)Bt + ((size_t)u.e * 2048 + (size_t)u.pn * 256) * 1024 * 2; }
    __device__ __forceinline__ void meta_issue(const pg8::Unit& u, int slot, LAS unsigned char* lds, int wid, int lane) const {
        if (wid < 4) __builtin_amdgcn_global_load_lds((const unsigned*)(list + (size_t)u.e * LCAP + u.pm * 256 + wid * 64 + lane), (LAS unsigned*)(lds + L_IDX + slot * 1024 + wid * 256), 4, 0, 0);
    }
    __device__ __forceinline__ void a_off(const pg8::Unit& u, int slot, LAS unsigned char* lds, const int (&Ra)[2], const int (&Ca)[2], unsigned (&o)[2][2]) const {
        const LAS int* idx = (const LAS int*)(lds + L_IDX + slot * 1024);
#pragma unroll
        for (int h = 0; h < 2; ++h)
#pragma unroll
            for (int i = 0; i < 2; ++i) { const int r = 128 * h + Ra[i]; int pr = idx[r]; pr = r < u.nvalid ? pr : 0; o[h][i] = (unsigned)((pr >> 2) * 1024 + Ca[i]) * 2u; }
    }
    __device__ __forceinline__ void epi(const AccT& acc, const pg8::Unit& u, int, LAS unsigned char*, int wr, int wc, int fr, int fq) const {
        const int row0 = u.ti * 256 + wr * 64 + fr, col0 = u.pn * 128 + wc * 32 + 8 * fq;
        const float* bg = bias + (size_t)u.e * 2048 + col0;
        const f32x4 g0 = *(const f32x4*)(bg), g1 = *(const f32x4*)(bg + 4), l0 = *(const f32x4*)(bg + 1024), l1 = *(const f32x4*)(bg + 1028);
#pragma unroll
        for (int ai = 0; ai < 2; ++ai)
#pragma unroll
            for (int m = 0; m < 4; ++m) {
                f32x4 a0 = acc[ai][0][m][0] + g0, a1 = acc[ai][0][m][1] + g1, b0 = acc[ai][1][m][0] + l0, b1 = acc[ai][1][m][1] + l1, r0, r1;
#pragma unroll
                for (int j = 0; j < 4; ++j) {
                    { const float g = fminf(a0[j], 7.f), l = fminf(fmaxf(b0[j], -7.f), 7.f); r0[j] = (l + 1.f) * g * __builtin_amdgcn_rcpf(1.f + __builtin_amdgcn_exp2f(-2.45546696f * g)); }
                    { const float g = fminf(a1[j], 7.f), l = fminf(fmaxf(b1[j], -7.f), 7.f); r1[j] = (l + 1.f) * g * __builtin_amdgcn_rcpf(1.f + __builtin_amdgcn_exp2f(-2.45546696f * g)); }
                }
                u32x4 w; w.x = cvt_pk_bf16(r0[0], r0[1]); w.y = cvt_pk_bf16(r0[2], r0[3]); w.z = cvt_pk_bf16(r1[0], r1[1]); w.w = cvt_pk_bf16(r1[2], r1[3]);
                *(u32x4*)(O + (size_t)(row0 + ai * 128 + m * 16) * DFF + col0) = w; }
    }
};

struct PolDN {
    static constexpr bool PERM = true, META = true;
    const bf16_t* A; const bf16_t* Bt; const float* bias; const int* list; const float* topg; bf16_t* O; ExpTab tb; int G, c;
    __device__ __forceinline__ bool next(int i, pg8::Unit& u) const {
        const int L = i * G + c; if (L >= tb.T * 4) return false;
        u.ti = L >> 2; u.pn = L & 3; u.e = rfl(tb.tile_e[u.ti]); u.pm = u.ti - rfl(tb.tstart[u.e]);
        const int rem = rfl(tb.cnt[u.e]) - u.pm * 256; u.nvalid = rem < 256 ? rem : 256; return true;
    }
    __device__ __forceinline__ const char* b_ptr(const pg8::Unit& u) const { return (const char*)Bt + ((size_t)u.e * 1024 + (size_t)u.pn * 256) * 1024 * 2; }
    __device__ __forceinline__ void meta_issue(const pg8::Unit& u, int slot, LAS unsigned char* lds, int wid, int lane) const {
        if (wid < 4) __builtin_amdgcn_global_load_lds((const unsigned*)(list + (size_t)u.e * LCAP + u.pm * 256 + wid * 64 + lane), (LAS unsigned*)(lds + L_IDX + slot * 1024 + wid * 256), 4, 0, 0);
    }
    __device__ __forceinline__ void a_off(const pg8::Unit& u, int, LAS unsigned char*, const int (&Ra)[2], const int (&Ca)[2], unsigned (&o)[2][2]) const {
#pragma unroll
        for (int h = 0; h < 2; ++h)
#pragma unroll
            for (int i = 0; i < 2; ++i) o[h][i] = (unsigned)((u.ti * 256 + 128 * h + Ra[i]) * 1024 + Ca[i]) * 2u;
    }
    __device__ __forceinline__ void epi(const AccT& acc, const pg8::Unit& u, int slot, LAS unsigned char* lds, int wr, int wc, int fr, int fq) const {
        const LAS int* idx = (const LAS int*)(lds + L_IDX + slot * 1024);
        const int col0 = u.pn * 256 + wc * 32 + 8 * fq;
        const float* bd = bias + (size_t)u.e * 1024 + col0;
        f32x4 bv[2][2];
#pragma unroll
        for (int bj = 0; bj < 2; ++bj)
#pragma unroll
            for (int n = 0; n < 2; ++n) bv[bj][n] = *(const f32x4*)(bd + bj * 128 + 4 * n);
#pragma unroll
        for (int ai = 0; ai < 2; ++ai)
#pragma unroll
            for (int m = 0; m < 4; ++m) { const int r = ai * 128 + wr * 64 + m * 16 + fr;
                if (r < u.nvalid) { const int pr = idx[r]; const float gt = topg[pr]; bf16_t* rowp = O + (size_t)pr * D + col0;
#pragma unroll
                    for (int bj = 0; bj < 2; ++bj) { const f32x4 v0 = (acc[ai][bj][m][0] + bv[bj][0]) * gt, v1 = (acc[ai][bj][m][1] + bv[bj][1]) * gt;
                        u32x4 w; w.x = cvt_pk_bf16(v0[0], v0[1]); w.y = cvt_pk_bf16(v0[2], v0[3]); w.z = cvt_pk_bf16(v1[0], v1[1]); w.w = cvt_pk_bf16(v1[2], v1[3]);
                        *(u32x4*)(rowp + bj * 128) = w; } } }
    }
};

__device__ __forceinline__ void p_ada(Frame& F) {
    LAS float* sl = (LAS float*)F.lds;
    LAS float* red = sl + 3072;
    for (int i = F.tid; i < 3072; i += 512) { const int w = i >> 10, k = i & 1023; const float v = w < 2 ? F.c[w * D + k] : F.c_ctx[k]; sl[i] = v / (1.f + __expf(-v)); }
    __syncthreads();
    for (int slab = blockIdx.x; slab < 256; slab += F.G) {
        const int j0 = slab * 24, cg = F.tid % 6, kr = F.tid / 6;
        float a[3][4] = {};
        if (F.tid < 480) {
            for (int k = kr; k < D; k += 80) {
                const f32x4 w4 = *(const f32x4*)(F.ada_w + (size_t)k * 6144 + j0 + 4 * cg);
                const float s0 = sl[k], s1 = sl[1024 + k], s2 = sl[2048 + k];
#pragma unroll
                for (int q = 0; q < 4; ++q) { a[0][q] += s0 * w4[q]; a[1][q] += s1 * w4[q]; a[2][q] += s2 * w4[q]; }
            }
#pragma unroll
            for (int w = 0; w < 3; ++w)
#pragma unroll
                for (int q = 0; q < 4; ++q) red[kr * 72 + cg * 12 + w * 4 + q] = a[w][q];
        }
        __syncthreads();
        if (F.tid < 72) {
            float s = 0.f;
            for (int r = 0; r < 80; ++r) s += red[r * 72 + F.tid];
            const int g = F.tid / 12, w = (F.tid % 12) >> 2, q = F.tid & 3, col = j0 + 4 * g + q;
            F.mod[w * 6144 + col] = s + F.ada_b[col];
        }
        __syncthreads();
    }
}

__device__ __forceinline__ void transpose_item(const float* W, int K, int N, bf16_t* WT, int item, bool gu_map, LAS float* scr, int lane) {
    const int nblk = N / 32, kb = item / nblk, nb = item % nblk, k0 = 64 * kb, n0 = 32 * nb;
#pragma unroll 8
    for (int i = 0; i < 32; ++i) { const int kk = 2 * i + (lane >> 5); scr[kk * 33 + (lane & 31)] = W[(size_t)(k0 + kk) * N + n0 + (lane & 31)]; }
    LDS_WAIT(); asm volatile("" ::: "memory");
    int d0 = n0;
    if (gu_map) { const int nn = n0 & 1023; d0 = (nn >> 7) * 256 + (nn & 127) + ((n0 >> 10) ? 128 : 0); }
    const int c = lane & 7;
#pragma unroll
    for (int j = 0; j < 4; ++j) { const int n = (lane >> 3) + 8 * j; const LAS float* s = scr + (8 * c) * 33 + n;
        u32x4 o; o.x = pk2(s[0 * 33], s[1 * 33]); o.y = pk2(s[2 * 33], s[3 * 33]); o.z = pk2(s[4 * 33], s[5 * 33]); o.w = pk2(s[6 * 33], s[7 * 33]);
        *(u32x4*)(WT + (size_t)(d0 + n) * K + k0 + 8 * c) = o; }
    LDS_WAIT(); asm volatile("" ::: "memory");
}
__device__ __forceinline__ void p_weights(Frame& F) {
    LAS float* scr = (LAS float*)(F.lds + F.wave * 16384);
    const int gw = F.vcu * 8 + F.wave, NGW = F.G * 8;
    constexpr int I_IN = 16 * 80, I_OUT = 16 * 32, I_GU = 16 * 64, I_DN = 16 * 32;
    constexpr int NITEMS = I_IN + I_OUT + NE * I_GU + NE * I_DN;
    for (int it = gw; it < NITEMS; it += NGW) {
        int r = it;
        if (r < I_IN) { transpose_item(F.w_in, D, DIN, F.Wt_in, r, false, scr, F.lane); continue; } r -= I_IN;
        if (r < I_OUT) { transpose_item(F.w_out, D, D, F.Wt_out, r, false, scr, F.lane); continue; } r -= I_OUT;
        if (r < NE * I_GU) { const int e = r / I_GU; transpose_item(F.w_gu + (size_t)e * D * 2048, D, 2048, F.Wt_gu + (size_t)e * 2048 * D, r % I_GU, true, scr, F.lane); continue; } r -= NE * I_GU;
        { const int e = r / I_DN; transpose_item(F.w_dn + (size_t)e * DFF * D, DFF, D, F.Wt_dn + (size_t)e * D * DFF, r % I_DN, false, scr, F.lane); }
    }
    for (int i = (blockIdx.x * 512 + F.tid) * 4; i < 4 * 128 * 128; i += F.G * 512 * 4) {
        const f32x4 v = *(const f32x4*)(F.sgu_w + i); u32x2 o; o.x = pk2(v[0], v[1]); o.y = pk2(v[2], v[3]); *(u32x2*)(F.sguw + i) = o; }
}
__device__ __forceinline__ void p_lnmod(Frame& F) {
    const int gw = F.vcu * 8 + F.wave, NGW = F.G * 8;
    for (int row = gw; row < MX; row += NGW) {
        const float* xr; const float* md;
        if (row < M) { xr = F.x + (size_t)row * D; md = F.mod + (row >> 13) * 6144; } else { xr = F.ctx + (size_t)(row - M) * D; md = F.mod + 2 * 6144; }
        const f32x4* xp = (const f32x4*)xr + F.lane;
        f32x4 v[4]; float s = 0.f;
#pragma unroll
        for (int j = 0; j < 4; ++j) { v[j] = xp[64 * j]; s += (v[j][0] + v[j][1]) + (v[j][2] + v[j][3]); }
        const float mean = wsum(s) * (1.f / D); float q = 0.f;
#pragma unroll
        for (int j = 0; j < 4; ++j) { v[j] = v[j] - mean; q += (v[j][0] * v[j][0] + v[j][1] * v[j][1]) + (v[j][2] * v[j][2] + v[j][3] * v[j][3]); }
        const float rstd = rsqrtf(wsum(q) * (1.f / D) + EPS);
        u32x2* op = (u32x2*)(F.hxc + (size_t)row * D) + F.lane;
#pragma unroll
        for (int j = 0; j < 4; ++j) { const f32x4 sh = *((const f32x4*)md + F.lane + 64 * j), sc = *((const f32x4*)(md + 1024) + F.lane + 64 * j);
            const f32x4 o = v[j] * rstd * (sc + 1.f) + sh; u32x2 w; w.x = pk2(o[0], o[1]); w.y = pk2(o[2], o[3]); op[64 * j] = w; }
    }
}

__device__ __forceinline__ void p_attn_simple(Frame& F) {
    LAS float* sq = (LAS float*)(F.lds + F.wave * 4096);
    LAS float* sp = sq + 64;
    const int gw = F.vcu * 8 + F.wave, NGW = F.G * 8;
    for (int gid = gw; gid < M * NH; gid += NGW) {
        const int h = gid & 7, tok = gid >> 3, b = tok >> 13, t = tok & (S - 1), r = t >> 6, c = t & 63;
        const int rs = min(max(r - KH / 2, 0), ROWS - KH), cs = min(max(c - KW / 2, 0), GW - KW);
        sq[F.lane] = bf2f(F.proj[(size_t)tok * DIN + h * 64 + F.lane]);
        LDS_WAIT(); asm volatile("" ::: "memory");
        float sc[6]; float mx = -1e30f;
#pragma unroll
        for (int i = 0; i < 6; ++i) {
            const int kk = F.lane + 64 * i;
            const bf16_t* kp; float bias = 0.f;
            if (kk < 128) { const int ki = kk >> 4, kj = kk & 15;
                kp = F.proj + (size_t)(b * S + (rs + ki) * GW + cs + kj) * DIN + 512 + h * 64;
                bias = F.rpb[(h * 15 + (rs + ki - r + 7)) * 31 + (cs + kj - c + 15)];
            } else kp = F.proj + (size_t)(M + b * CTX + (kk - 128)) * DIN + 512 + h * 64;
            float d = 0.f;
#pragma unroll
            for (int dd = 0; dd < 64; dd += 8) { const u32x4 kv = *(const u32x4*)(kp + dd);
                d += sq[dd] * bflo(kv.x) + sq[dd + 1] * bfhi(kv.x) + sq[dd + 2] * bflo(kv.y) + sq[dd + 3] * bfhi(kv.y) + sq[dd + 4] * bflo(kv.z) + sq[dd + 5] * bfhi(kv.z) + sq[dd + 6] * bflo(kv.w) + sq[dd + 7] * bfhi(kv.w); }
            sc[i] = d * 0.125f + bias; mx = fmaxf(mx, sc[i]);
        }
        mx = wmax(mx);
        float sum = 0.f;
#pragma unroll
        for (int i = 0; i < 6; ++i) { const float p = __expf(sc[i] - mx); sum += p; sp[F.lane + 64 * i] = p; }
        sum = wsum(sum);
        LDS_WAIT(); asm volatile("" ::: "memory");
        float acc = 0.f;
        for (int kk = 0; kk < 384; ++kk) {
            const bf16_t* vp;
            if (kk < 128) { const int ki = kk >> 4, kj = kk & 15; vp = F.proj + (size_t)(b * S + (rs + ki) * GW + cs + kj) * DIN + 1024 + h * 64; }
            else vp = F.proj + (size_t)(M + b * CTX + (kk - 128)) * DIN + 1024 + h * 64;
            acc += sp[kk] * bf2f(vp[F.lane]);
        }
        F.mixin[(size_t)tok * D + h * 64 + F.lane] = (bf16_t)f2bf(acc / sum);
        LDS_WAIT(); asm volatile("" ::: "memory");
    }
}
__device__ __forceinline__ void p_sgu_simple(Frame& F) {
    LAS bf16_t* G = (LAS bf16_t*)F.lds;
    for (int u = blockIdx.x; u < M / 128; u += F.G) {
        const int base = u * 128;
        for (int tl = F.wave; tl < 128; tl += 8) {
            const bf16_t* zr = F.proj + (size_t)(base + tl) * DIN + 2048 + F.lane * 8;
            const u32x4 zv = *(const u32x4*)zr;
            float v[8] = {bflo(zv.x), bfhi(zv.x), bflo(zv.y), bfhi(zv.y), bflo(zv.z), bfhi(zv.z), bflo(zv.w), bfhi(zv.w)};
            float s = 0.f;
#pragma unroll
            for (int i = 0; i < 8; ++i) s += v[i];
            const float mean = wsum(s) * (1.f / 512.f); float q = 0.f;
#pragma unroll
            for (int i = 0; i < 8; ++i) { v[i] -= mean; q += v[i] * v[i]; }
            const float rstd = rsqrtf(wsum(q) * (1.f / 512.f) + EPS);
#pragma unroll
            for (int i = 0; i < 8; ++i) { const int ch = F.lane * 8 + i; G[tl * 512 + ch] = (bf16_t)f2bf(v[i] * rstd * F.sgu_ln_g[ch] + F.sgu_ln_b[ch]); }
        }
        __syncthreads();
        const int ch = F.tid, grp = ch >> 7;
        for (int i = 0; i < 128; ++i) {
            const float* wrow = F.sgu_w + (size_t)(grp * 128 + i) * 128;
            float acc = 0.f;
            for (int j = 0; j < 128; ++j) acc += wrow[j] * bf2f(G[j * 512 + ch]);
            acc += F.sgu_b[grp * 128 + i];
            const float uu = bf2f(F.proj[(size_t)(base + i) * DIN + 1536 + ch]);
            F.mixin[(size_t)(base + i) * D + 512 + ch] = (bf16_t)f2bf(uu * acc);
        }
        __syncthreads();
    }
}

__device__ __forceinline__ void p_route(Frame& F) {
    LAS int* lcnt = (LAS int*)(F.lds + L_ROUTE); LAS int* gbase = lcnt + 32; LAS int* sel = lcnt + 64;
    for (int i = F.tid; i < 8192; i += 512) { const int c = i >> 3, q = i & 7; *(LAS f32x4*)(F.lds + c * 128 + ((q ^ ((c >> 1) & 7)) << 4)) = *(const f32x4*)(F.router_w + c * 32 + q * 4); }
    if (F.tid < 32) lcnt[F.tid] = 0;
    __syncthreads();
    for (int tb = blockIdx.x; tb < M / 64; tb += F.G) {
        for (int tl = F.wave; tl < 64; tl += 8) {
            const int tok = tb * 64 + tl, b = tok >> 13;
            const float* sh2 = F.mod + b * 6144 + 3 * 1024; const float* sc2 = F.mod + b * 6144 + 4 * 1024;
            float* yr = F.y1 + (size_t)tok * D;
            float v[16]; float s = 0.f;
#pragma unroll
            for (int i = 0; i < 16; ++i) { v[i] = yr[F.lane + 64 * i]; s += v[i]; }
            float mean = wsum(s) * (1.f / D), q = 0.f;
#pragma unroll
            for (int i = 0; i < 16; ++i) { v[i] -= mean; q += v[i] * v[i]; }
            float rstd = rsqrtf(wsum(q) * (1.f / D) + EPS);
            s = 0.f;
#pragma unroll
            for (int i = 0; i < 16; ++i) { const int col = F.lane + 64 * i; v[i] = v[i] * rstd * F.ln1_g[col] + F.ln1_b[col]; yr[col] = v[i]; s += v[i]; }
            mean = wsum(s) * (1.f / D); q = 0.f;
#pragma unroll
            for (int i = 0; i < 16; ++i) { v[i] -= mean; q += v[i] * v[i]; }
            rstd = rsqrtf(wsum(q) * (1.f / D) + EPS);
            float lg[NE];
#pragma unroll
            for (int e = 0; e < NE; ++e) lg[e] = 0.f;
#pragma unroll
            for (int i = 0; i < 16; ++i) {
                const int col = F.lane + 64 * i;
                v[i] = v[i] * rstd * (1.f + sc2[col]) + sh2[col];
                F.h2[(size_t)tok * D + col] = (bf16_t)f2bf(v[i]);
                const LAS unsigned char* wr = F.lds + col * 128; const int sw = (col >> 1) & 7;
#pragma unroll
                for (int qq = 0; qq < 8; ++qq) { const f32x4 w4 = *(const LAS f32x4*)(wr + ((qq ^ sw) << 4));
#pragma unroll
                    for (int j = 0; j < 4; ++j) lg[qq * 4 + j] += v[i] * w4[j]; }
            }
            float r16[16], r8[8], r4[4], r2[2], r1;
            { const bool hi = F.lane & 32;
#pragma unroll
              for (int e = 0; e < 16; ++e) { const float mine = hi ? lg[e + 16] : lg[e], send = hi ? lg[e] : lg[e + 16]; r16[e] = mine + __shfl_xor(send, 32); } }
            { const bool hi = F.lane & 16;
#pragma unroll
              for (int e = 0; e < 8; ++e) { const float mine = hi ? r16[e + 8] : r16[e], send = hi ? r16[e] : r16[e + 8]; r8[e] = mine + __shfl_xor(send, 16); } }
            { const bool hi = F.lane & 8;
#pragma unroll
              for (int e = 0; e < 4; ++e) { const float mine = hi ? r8[e + 4] : r8[e], send = hi ? r8[e] : r8[e + 4]; r4[e] = mine + __shfl_xor(send, 8); } }
            { const bool hi = F.lane & 4;
#pragma unroll
              for (int e = 0; e < 2; ++e) { const float mine = hi ? r4[e + 2] : r4[e], send = hi ? r4[e] : r4[e + 2]; r2[e] = mine + __shfl_xor(send, 4); } }
            { const bool hi = F.lane & 2; const float mine = hi ? r2[1] : r2[0], send = hi ? r2[0] : r2[1]; r1 = mine + __shfl_xor(send, 2); }
            r1 += __shfl_xor(r1, 1);
            const int e = F.lane >> 1;
            const float lgt = r1 + F.router_b[e];
            int rank = 0; float mx = -3.0e38f;
#pragma unroll
            for (int e2 = 0; e2 < NE; ++e2) { const float o = __builtin_bit_cast(float, __builtin_amdgcn_readlane(__builtin_bit_cast(int, lgt), 2 * e2));
                rank += (o > lgt || (o == lgt && e2 < e)) ? 1 : 0; mx = fmaxf(mx, o); }
            const bool selq = rank < TOPK && !(F.lane & 1);
            const float pe = selq ? __expf(lgt - mx) : 0.f;
            const float den = wsum(pe);
            if (selq) {
                const int lp = __hip_atomic_fetch_add(lcnt + e, 1, __ATOMIC_RELAXED, __HIP_MEMORY_SCOPE_WORKGROUP);
                sel[tl * 4 + rank] = e | (lp << 8);
                F.topg[tok * 4 + rank] = pe / den; F.topi[tok * 4 + rank] = e;
            }
        }
        __syncthreads();
        if (F.tid < 32) { const int n = lcnt[F.tid]; gbase[F.tid] = n ? (int)__hip_atomic_fetch_add(F.ctl + CW_CNT + 32 * F.tid, (unsigned)n, __ATOMIC_RELAXED, __HIP_MEMORY_SCOPE_AGENT) : 0; lcnt[F.tid] = 0; }
        __syncthreads();
        if (F.tid < 256) { const int sv = sel[F.tid], e = sv & 255, lp = sv >> 8; F.list[(size_t)e * LCAP + gbase[e] + lp] = (tb * 64 + (F.tid >> 2)) * 4 + (F.tid & 3); }
        __syncthreads();
    }
}

__device__ __forceinline__ void p_final(Frame& F) {
    const int gw = F.vcu * 8 + F.wave, NGW = F.G * 8;
    for (int tok = gw; tok < M; tok += NGW) {
        const float* g2 = F.mod + (tok >> 13) * 6144 + 5 * 1024;
        const f32x4* xp = (const f32x4*)(F.y1 + (size_t)tok * D) + F.lane;
        f32x4 v[4]; float s = 0.f;
#pragma unroll
        for (int j = 0; j < 4; ++j) {
            f32x4 f = (f32x4){0.f, 0.f, 0.f, 0.f};
#pragma unroll
            for (int k = 0; k < TOPK; ++k) { const u32x2 yv = *((const u32x2*)(F.ybuf + (size_t)(tok * 4 + k) * D) + F.lane + 64 * j);
                f[0] += bflo(yv.x); f[1] += bfhi(yv.x); f[2] += bflo(yv.y); f[3] += bfhi(yv.y); }
            const f32x4 gv = *((const f32x4*)g2 + F.lane + 64 * j);
            v[j] = xp[64 * j] * DN_ALPHA + gv * f; s += (v[j][0] + v[j][1]) + (v[j][2] + v[j][3]);
        }
        const float mean = wsum(s) * (1.f / D); float q = 0.f;
#pragma unroll
        for (int j = 0; j < 4; ++j) { v[j] = v[j] - mean; q += (v[j][0] * v[j][0] + v[j][1] * v[j][1]) + (v[j][2] * v[j][2] + v[j][3] * v[j][3]); }
        const float rstd = rsqrtf(wsum(q) * (1.f / D) + EPS);
        f32x4* op = (f32x4*)(F.out + (size_t)tok * D) + F.lane;
#pragma unroll
        for (int j = 0; j < 4; ++j) { const f32x4 gg = *((const f32x4*)F.ln2_g + F.lane + 64 * j), bb = *((const f32x4*)F.ln2_b + F.lane + 64 * j); op[64 * j] = v[j] * rstd * gg + bb; }
    }
}

struct Args { const float* in[23]; float* out; unsigned char* ws; int ph_lo, ph_hi; };
constexpr int N_PHASES = 9;
__global__ void __launch_bounds__(512, 2) mk_fwd(Args args) {
    extern __shared__ __attribute__((aligned(16))) unsigned char lds_raw[];
    Frame F;
    F.lds = (LAS unsigned char*)lds_raw;
    F.MISC = (volatile LAS unsigned*)(F.lds + L_MISC);
    F.tid = threadIdx.x; F.lane = F.tid & 63; F.wave = __builtin_amdgcn_readfirstlane(F.tid >> 6);
    F.G = gridDim.x; { const int bx = blockIdx.x; F.vcu = (F.G % 8 == 0) ? (bx % 8) * (F.G / 8) + bx / 8 : bx; }
    unsigned char* ws = args.ws;
    F.ctl = (unsigned*)(ws + WS_CTL);
    F.x = args.in[0]; F.c = args.in[1]; F.ctx = args.in[2]; F.c_ctx = args.in[3]; F.ada_w = args.in[4]; F.ada_b = args.in[5]; F.w_in = args.in[6]; F.rpb = args.in[7];
    F.sgu_ln_g = args.in[8]; F.sgu_ln_b = args.in[9]; F.sgu_w = args.in[10]; F.sgu_b = args.in[11]; F.w_out = args.in[12]; F.ln1_g = args.in[13]; F.ln1_b = args.in[14];
    F.ln2_g = args.in[15]; F.ln2_b = args.in[16]; F.router_w = args.in[17]; F.router_b = args.in[18]; F.w_gu = args.in[19]; F.b_gu = args.in[20]; F.w_dn = args.in[21]; F.b_dn = args.in[22];
    F.out = args.out;
    F.mod = (float*)(ws + WS_MOD); F.topg = (float*)(ws + WS_TOPG); F.topi = (int*)(ws + WS_TOPI); F.list = (int*)(ws + WS_LIST); F.sguw = (bf16_t*)(ws + WS_SGUW);
    F.Wt_in = (bf16_t*)(ws + WS_WIN); F.Wt_out = (bf16_t*)(ws + WS_WOUT); F.Wt_gu = (bf16_t*)(ws + WS_WGU); F.Wt_dn = (bf16_t*)(ws + WS_WDN);
    F.hxc = (bf16_t*)(ws + WS_HXC); F.proj = (bf16_t*)(ws + WS_PROJ); F.mixin = (bf16_t*)(ws + WS_MIXIN); F.y1 = (float*)(ws + WS_Y1); F.h2 = (bf16_t*)(ws + WS_H2);
    F.act = (bf16_t*)(ws + WS_ACT); F.ybuf = (bf16_t*)(ws + WS_YBUF);
    for (int u = F.tid; u < (LDS_BYTES - L_MISC) / 4; u += 512) ((LAS unsigned*)(F.lds + L_MISC))[u] = 0u;
    __syncthreads();
    const int lo = args.ph_lo, hi = args.ph_hi;
    const bool one = (hi - lo) > 1;
    XcdBarrier bar; bar.bar = (unsigned*)(F.ctl + CW_BAR); bar.x = 0; bar.st = nullptr;
    if (one) bar = xcd_barrier_post((unsigned*)(F.ctl + CW_BAR), F.MISC + 8);
#define IN(k) (lo <= (k) && (k) < hi)
#define SEAM(k) do { if (IN(k) && IN((k) + 1)) xcd_barrier(bar); } while (0)
    if (IN(0)) { p_ada(F); p_weights(F); SEAM(0); }
    if (IN(1)) { p_lnmod(F); SEAM(1); }
    if (IN(2)) { PolProj P{F.hxc, F.Wt_in, F.proj, F.G, (int)blockIdx.x}; pg8::gemm_phase<PolProj>(F.lds, P); SEAM(2); }
    if (IN(3)) { p_attn_simple(F); __syncthreads(); p_sgu_simple(F); SEAM(3); }
    if (IN(4)) { PolOut P{F.mixin, F.Wt_out, F.x, F.mod, F.y1, F.G, (int)blockIdx.x}; pg8::gemm_phase<PolOut>(F.lds, P); SEAM(4); }
    if (IN(5)) { p_route(F); SEAM(5); }
    if (IN(6)) { const int T = expert_tables(F); ExpTab tb{(const LAS int*)(F.lds + L_TILEE), (const LAS int*)(F.lds + L_TSTART), (const LAS int*)(F.lds + L_TSTART) + 64, T};
        PolGU P{F.h2, F.Wt_gu, F.b_gu, F.list, F.act, tb, F.G, (int)blockIdx.x}; pg8::gemm_phase<PolGU>(F.lds, P); SEAM(6); }
    if (IN(7)) { const int T = expert_tables(F); ExpTab tb{(const LAS int*)(F.lds + L_TILEE), (const LAS int*)(F.lds + L_TSTART), (const LAS int*)(F.lds + L_TSTART) + 64, T};
        PolDN P{F.act, F.Wt_dn, F.b_dn, F.list, F.topg, F.ybuf, tb, F.G, (int)blockIdx.x}; pg8::gemm_phase<PolDN>(F.lds, P); SEAM(7); }
    if (IN(8)) { p_final(F); }
#undef IN
#undef SEAM
}

static inline void launch_forward(void* const* d_in, void* d_out, void* d_ws, hipStream_t stream, int n_launches) {
    static int grid = 0;
    if (grid == 0) {
        int dev = 0, cus = 0;
        if (hipGetDevice(&dev) != hipSuccess || hipDeviceGetAttribute(&cus, hipDeviceAttributeMultiprocessorCount, dev) != hipSuccess) { fprintf(stderr, "kernel_launch: device query failed\n"); grid = -1; return; }
        if (hipFuncSetAttribute((const void*)mk_fwd, hipFuncAttributeMaxDynamicSharedMemorySize, LDS_BYTES) != hipSuccess) { fprintf(stderr, "kernel_launch: hipFuncSetAttribute failed\n"); grid = -1; return; }
        int per_cu = 0;
        if (hipOccupancyMaxActiveBlocksPerMultiprocessor(&per_cu, (const void*)mk_fwd, 512, LDS_BYTES) != hipSuccess || per_cu < 1) fprintf(stderr, "kernel_launch: occupancy query says %d\n", per_cu);
        (void)hipGetLastError();
        grid = cus;
    }
    if (grid < 0) return;
    (void)hipMemsetAsync((char*)d_ws + WS_CTL, 0, CTL_ZERO_BYTES, stream);
    Args a{};
    for (int i = 0; i < 23; ++i) a.in[i] = (const float*)d_in[i];
    a.out = (float*)d_out; a.ws = (unsigned char*)d_ws;
    if (n_launches == 1) { a.ph_lo = 0; a.ph_hi = N_PHASES; hipLaunchKernelGGL(mk_fwd, dim3(grid), dim3(512), LDS_BYTES, stream, a); }
    else for (int p = 0; p < N_PHASES; ++p) { a.ph_lo = p; a.ph_hi = p + 1; hipLaunchKernelGGL(mk_fwd, dim3(grid), dim3(512), LDS_BYTES, stream, a); }
}
}
extern "C" void kernel_launch(void* const* d_in, const int* in_sizes, int n_in, void* d_out, int out_size, void* d_ws, size_t ws_size, hipStream_t stream) {
    if (ws_size < mk::WS_END || n_in != 23) { fprintf(stderr, "kernel_launch: unexpected workspace / inputs (%zu, %d)\n", ws_size, n_in); return; }
    mk::launch_forward(d_in, d_out, d_ws, stream, 1);
}
```

```cpp
#include <hip/hip_runtime.h>
#include <stdint.h>
#include <stdio.h>

#define GAS __attribute__((address_space(1)))
#define LAS __attribute__((address_space(3)))
typedef unsigned short bf16_t;
typedef short bf16x8 __attribute__((ext_vector_type(8)));
typedef float f32x4 __attribute__((ext_vector_type(4)));
typedef float f32x2 __attribute__((ext_vector_type(2)));
typedef unsigned u32x4 __attribute__((ext_vector_type(4)));
typedef unsigned u32x2 __attribute__((ext_vector_type(2)));

namespace mk {
constexpr int D = 1024, NB = 2, S = 8192, M = NB * S, GW = 64, ROWS = 128, CTX = 256, NH = 8, KH = 8, KW = 16;
constexpr int NE = 32, TOPK = 4, DFF = 1024, DIN = 2560, NPAIR = M * TOPK, MX = M + NB * CTX;
constexpr int LCAP = 16384, MAXT = 288, ACT_ROWS = MAXT * 256;
constexpr float EPS = 1e-5f;
constexpr float DN_ALPHA = 1.189207115002721f;
constexpr size_t MiB = 1u << 20;
constexpr size_t WS_CTL = 0, CTL_ZERO_BYTES = 1 * MiB;
constexpr size_t WS_MOD = 1 * MiB;
constexpr size_t WS_TOPG = 2 * MiB;
constexpr size_t WS_TOPI = 2 * MiB + 512 * 1024;
constexpr size_t WS_LIST = 3 * MiB;
constexpr size_t WS_SGUW = 5 * MiB;
constexpr size_t WS_WIN = 6 * MiB;
constexpr size_t WS_WOUT = 11 * MiB;
constexpr size_t WS_WGU = 16 * MiB;
constexpr size_t WS_WDN = 144 * MiB;
constexpr size_t WS_HXC = 208 * MiB;
constexpr size_t WS_PROJ = 241 * MiB;
constexpr size_t WS_MIXIN = 324 * MiB;
constexpr size_t WS_Y1 = 356 * MiB;
constexpr size_t WS_H2 = 420 * MiB;
constexpr size_t WS_ACT = 452 * MiB;
constexpr size_t WS_YBUF = 596 * MiB;
constexpr size_t WS_END = 724 * MiB;
constexpr int CW_BAR = 4096;
constexpr int CW_CNT = 8192;
constexpr int RING_BYTES = 131072;
constexpr int L_MISC = RING_BYTES;
constexpr int L_IDX = L_MISC + 1024;
constexpr int L_TILEE = L_IDX + 3072;
constexpr int L_TSTART = L_TILEE + 1280;
constexpr int L_ROUTE = L_TSTART + 512;
constexpr int L_RPB = L_ROUTE + 256 + 1024;
constexpr int L_WSCR = L_RPB + 2048;
constexpr int LDS_BYTES = 147456;
static_assert(L_WSCR + 8 * 512 <= LDS_BYTES, "LDS map");

__device__ __forceinline__ float wsum(float v) {
#pragma unroll
    for (int o = 32; o; o >>= 1) v += __shfl_xor(v, o);
    return v;
}
__device__ __forceinline__ float wmax(float v) {
#pragma unroll
    for (int o = 32; o; o >>= 1) v = fmaxf(v, __shfl_xor(v, o));
    return v;
}
__device__ __forceinline__ unsigned f2bf(float f) { unsigned u = __builtin_bit_cast(unsigned, f); return (u + 0x7fffu + ((u >> 16) & 1u)) >> 16; }
__device__ __forceinline__ unsigned pk2(float lo, float hi) { return f2bf(lo) | (f2bf(hi) << 16); }
__device__ __forceinline__ float bf2f(unsigned short b) { return __builtin_bit_cast(float, ((unsigned)b) << 16); }
__device__ __forceinline__ float bflo(unsigned w) { return __builtin_bit_cast(float, w << 16); }
__device__ __forceinline__ float bfhi(unsigned w) { return __builtin_bit_cast(float, w & 0xffff0000u); }
__device__ __forceinline__ unsigned cvt_pk_bf16(float lo, float hi) { unsigned r; asm volatile("v_cvt_pk_bf16_f32 %0, %1, %2" : "=v"(r) : "v"(lo), "v"(hi)); return r; }
__device__ __forceinline__ float gelu_fast(float x) {
    const float c1 = -2.302208198f;
    const float c3 = c1 * 0.044715f;
    const float x2 = x * x;
    const float t = x * (c1 + c3 * x2);
    return x * __builtin_amdgcn_rcpf(1.f + __builtin_amdgcn_exp2f(t));
}

#define XB_TMO      128
#define XB_XCNT(j)  (256  + 64 * (j))
#define XB_XSUB(j)  (1280 + 64 * (j))
#define XB_XGEN(j)  (2304 + 64 * (j))
#define XB_TOP      3328
#define XB_TOPGEN   3392
#define XCD_BAR_WORDS 3456
#define XB_SPIN_CAP (1u << 18)
__device__ __forceinline__ unsigned xb_ld(unsigned* p)              { return __hip_atomic_load(p, __ATOMIC_RELAXED, __HIP_MEMORY_SCOPE_AGENT); }
__device__ __forceinline__ unsigned xb_add(unsigned* p, unsigned v) { return __hip_atomic_fetch_add(p, v, __ATOMIC_RELAXED, __HIP_MEMORY_SCOPE_AGENT); }
__device__ __forceinline__ unsigned xb_xcc_id() { return (unsigned)__builtin_amdgcn_s_getreg((3 << 11) | 20) & 0xFu; }
#define XB_SPIN(cond, bar) do { unsigned _sp = 0; while (cond) { __builtin_amdgcn_s_sleep(1); \
    if ((++_sp & 255u) == 0u) { if (xb_ld(&(bar)[XB_TMO])) break; if (_sp > XB_SPIN_CAP) { atomicAdd(&(bar)[XB_TMO], 1u); break; } } } } while (0)
struct XcdBarrier { unsigned* bar; unsigned x; volatile LAS unsigned* st; };
__device__ __forceinline__ XcdBarrier xcd_barrier_post(unsigned* bar, volatile LAS unsigned* st) {
    XcdBarrier b; b.bar = bar; b.x = xb_xcc_id(); b.st = st;
    if (threadIdx.x == 0) (void)xb_add(&bar[XB_XCNT(b.x)], 1u);
    return b;
}
__device__ __forceinline__ void xcd_barrier_complete(unsigned* bar, unsigned x, unsigned& nloc, unsigned& nx) {
    const unsigned G = gridDim.x * gridDim.y * gridDim.z;
    unsigned sum, cnt, mine, sp = 0u;
    for (;;) {
        sum = 0u; cnt = 0u; mine = 0u;
#pragma unroll
        for (unsigned j = 0; j < 16; ++j) { const unsigned c = xb_ld(&bar[XB_XCNT(j)]); sum += c; cnt += (c > 0u) ? 1u : 0u; mine = (j == x) ? c : mine; }
        if (sum == G) break;
        __builtin_amdgcn_s_sleep(1);
        if ((++sp & 255u) == 0u) { if (xb_ld(&bar[XB_TMO])) break; if (sp > XB_SPIN_CAP) { atomicAdd(&bar[XB_TMO], 1u); break; } }
    }
    nloc = mine > 0u ? mine : 1u; nx = cnt > 0u ? cnt : 1u;
}
__device__ __forceinline__ void xcd_barrier(const XcdBarrier& b) {
    asm volatile("s_waitcnt vmcnt(0)" ::: "memory");
    __syncthreads();
    if (threadIdx.x == 0) {
        unsigned* bar = b.bar;
        __builtin_amdgcn_s_waitcnt(0);
        unsigned nloc = b.st[0], nx = b.st[1];
        if (nloc == 0u) { xcd_barrier_complete(bar, b.x, nloc, nx); b.st[0] = nloc; b.st[1] = nx; }
        const unsigned old = xb_add(&bar[XB_XSUB(b.x)], 1u);
        const unsigned gen = old / nloc;
        if (old + 1u == (gen + 1u) * nloc) {
            __builtin_amdgcn_fence(__ATOMIC_RELEASE, "agent");
            asm volatile("s_waitcnt vmcnt(0)" ::: "memory");
            const unsigned og = xb_add(&bar[XB_TOP], 1u);
            const unsigned tg = og / nx;
            if (og + 1u == (tg + 1u) * nx) xb_add(&bar[XB_TOPGEN], 1u);
            else XB_SPIN(xb_ld(&bar[XB_TOPGEN]) == tg, bar);
            __builtin_amdgcn_fence(__ATOMIC_ACQUIRE, "agent");
            xb_add(&bar[XB_XGEN(b.x)], 1u);
            asm volatile("s_waitcnt vmcnt(0)" ::: "memory");
        } else {
            XB_SPIN(xb_ld(&bar[XB_XGEN(b.x)]) == gen, bar);
            __builtin_amdgcn_fence(__ATOMIC_ACQUIRE, "agent");
            asm volatile("s_waitcnt vmcnt(0)" ::: "memory");
        }
    }
    __syncthreads();
}

struct Frame {
    LAS unsigned char* lds;
    volatile LAS unsigned* MISC;
    unsigned* ctl;
    int tid, lane, wave, vcu, G;
    const float *x, *c, *ctx, *c_ctx, *ada_w, *ada_b, *w_in, *rpb, *sgu_ln_g, *sgu_ln_b, *sgu_w, *sgu_b, *w_out, *ln1_g, *ln1_b, *ln2_g, *ln2_b, *router_w, *router_b, *w_gu, *b_gu, *w_dn, *b_dn;
    float* out;
    float* mod; float* topg; int* topi; int* list; bf16_t* sguw; bf16_t* Wt_in; bf16_t* Wt_out; bf16_t* Wt_gu; bf16_t* Wt_dn;
    bf16_t* hxc; bf16_t* proj; bf16_t* mixin; float* y1; bf16_t* h2; bf16_t* act; bf16_t* ybuf;
};
#define LDS_WAIT() asm volatile("s_waitcnt lgkmcnt(0)" ::: "memory")
#define VM_WAIT() asm volatile("s_waitcnt vmcnt(0)" ::: "memory")

namespace pg8 {
constexpr int BM = 256, BK = 64, HALF = 128, HTB = HALF * BK * 2, STAGE_BYTES = 8 * HTB, NXCD = 8, WGM = 8, KD = 1024, NKT = KD / BK;
__device__ __forceinline__ int lds_byte(int r, int c) { const int st = (r >> 4) * 2 + (c >> 5), rr = r & 15, cc = c & 31, ob = rr * 64 + cc * 2; return st * 1024 + (ob ^ (((ob >> 9) & 1) << 5)); }
__device__ __forceinline__ void stage_rc(int b, int& R, int& C) { const int st = b / 1024, sb = b % 1024, swz = sb ^ (((sb >> 9) & 1) << 5); R = (st >> 1) * 16 + swz / 64; C = (st & 1) * 32 + (swz % 64) / 2; }
__device__ __forceinline__ int perm32(int rho) { const int n = rho >> 4, i = rho & 15; return 8 * (i >> 2) + 4 * n + (i & 3); }
struct Unit { int pm, pn, e, nvalid, ti; };
__device__ __forceinline__ void static_tile(int L, int nM, int nN, int& pm, int& pn) {
    const int nwg = nM * nN; int wgid = L;
    { const int q = nwg / NXCD, r = nwg % NXCD, xcd = wgid % NXCD, off = wgid / NXCD; wgid = (xcd < r ? xcd * (q + 1) : r * (q + 1) + (xcd - r) * q) + off; }
    const int nig = WGM * nN, gid = wgid / nig, fm = gid * WGM, gsz = (nM - fm) < WGM ? (nM - fm) : WGM;
    pm = fm + ((wgid % nig) % gsz); pn = (wgid % nig) / gsz;
}

template <class P>
__device__ __forceinline__ void gemm_phase(LAS unsigned char* lds, const P& pol) {
    const int tid = threadIdx.x, wid = __builtin_amdgcn_readfirstlane(tid >> 6), lane = tid & 63, wr = wid >> 2, wc = wid & 3, fr = lane & 15, fq = lane >> 4;
    unsigned voffB[2]; int Ra[2], Ca[2];
#pragma unroll
    for (int i = 0; i < 2; ++i) { int R, C; stage_rc(tid * 16 + i * 8192, R, C); const int Rb = P::PERM ? ((R & ~31) + perm32(R & 31)) : R;
        voffB[i] = (unsigned)(Rb * KD + C) * 2u; Ra[i] = R; Ca[i] = C; }
    const size_t kstep = (size_t)(BK * 2);
    const size_t hstep = (size_t)HALF * KD * 2;
    const unsigned ldsw = (unsigned)wid * 1024u;
    const int aoff = lds_byte(wr * 64 + fr, fq * 8), boff = lds_byte(wc * 32 + fr, fq * 8);
#define PG8_SA(b, h) (((b) * 2 + (h)) * HTB)
#define PG8_SB(b, h) ((4 + (b) * 2 + (h)) * HTB)
#define PG8_STAGE(bufoff, gbase, voff) do { _Pragma("unroll") for (int _i = 0; _i < 2; ++_i) \
        __builtin_amdgcn_global_load_lds((const unsigned*)((const char*)(gbase) + (voff)[_i]), (LAS unsigned*)(lds + (bufoff) + ldsw + _i * 8192), 16, 0, 0); } while (0)
#define PG8_LDA(dst, b, h) do { _Pragma("unroll") for (int m = 0; m < 4; ++m) _Pragma("unroll") for (int k = 0; k < 2; ++k) dst[m][k] = *(const LAS bf16x8*)(lds + PG8_SA(b, h) + aoff + m * 2048 + k * 1024); } while (0)
#define PG8_LDB(dst, b, h) do { _Pragma("unroll") for (int n = 0; n < 2; ++n) _Pragma("unroll") for (int k = 0; k < 2; ++k) dst[n][k] = *(const LAS bf16x8*)(lds + PG8_SB(b, h) + boff + n * 2048 + k * 1024); } while (0)
#define PG8_MMA(ai, bj, At, Bt) do { __builtin_amdgcn_s_setprio(1); _Pragma("unroll") for (int m = 0; m < 4; ++m) _Pragma("unroll") for (int n = 0; n < 2; ++n) _Pragma("unroll") for (int k = 0; k < 2; ++k) \
        acc[ai][bj][m][n] = __builtin_amdgcn_mfma_f32_16x16x32_bf16(Bt[n][k], At[m][k], acc[ai][bj][m][n], 0, 0, 0); __builtin_amdgcn_s_setprio(0); } while (0)
#define PG8_WAIT_V(n) asm volatile("s_waitcnt vmcnt(" #n ")" ::: "memory")
#define PG8_WAIT_L(n) asm volatile("s_waitcnt lgkmcnt(" #n ")" ::: "memory")
#define PG8_BAR __builtin_amdgcn_s_barrier()
#define PG8_SCHED __builtin_amdgcn_sched_barrier(0)
    Unit cur, nxt; int ui = 0;
    if (!pol.next(0, cur)) return;
    f32x4 acc[2][2][4][2];
#pragma unroll
    for (int a = 0; a < 2; ++a)
#pragma unroll
        for (int b = 0; b < 2; ++b)
#pragma unroll
            for (int m = 0; m < 4; ++m)
#pragma unroll
                for (int n = 0; n < 2; ++n) acc[a][b][m][n] = (f32x4){0.f, 0.f, 0.f, 0.f};
    bf16x8 At[4][2], B0[2][2], B1[2][2];
    int slot = 0;
    if (P::META) { pol.meta_issue(cur, 0, lds, wid, lane); PG8_WAIT_V(0); asm volatile("" ::: "memory"); PG8_BAR; asm volatile("" ::: "memory"); }
    unsigned aC[2][2], aN[2][2];
    pol.a_off(cur, 0, lds, Ra, Ca, aC);
    const char* const Ab = (const char*)pol.A;
    const char* cB = pol.b_ptr(cur);
    PG8_STAGE(PG8_SB(0, 0), cB, voffB); PG8_STAGE(PG8_SB(0, 1), cB + hstep, voffB); PG8_STAGE(PG8_SA(0, 0), Ab, aC[0]); PG8_STAGE(PG8_SA(0, 1), Ab, aC[1]);
    if (wr == 1) PG8_BAR;
    PG8_WAIT_V(2); PG8_BAR;
    PG8_STAGE(PG8_SB(1, 0), cB + kstep, voffB); PG8_STAGE(PG8_SA(1, 0), Ab + kstep, aC[0]); PG8_STAGE(PG8_SB(1, 1), cB + hstep + kstep, voffB);
    PG8_WAIT_V(6); PG8_BAR;
    for (;;) {
        const bool has_next = pol.next(ui + 1, nxt);
        const int nslot = slot == 2 ? 0 : slot + 1;
        if (P::META) { if (has_next) pol.meta_issue(nxt, nslot, lds, wid, lane); }
        const char* nB = has_next ? pol.b_ptr(nxt) : cB;
        for (int t = 0; t < NKT; t += 2) {
            const bool last = (t == NKT - 2);
            if (last) { if (has_next) pol.a_off(nxt, nslot, lds, Ra, Ca, aN); else { aN[0][0] = aC[0][0]; aN[0][1] = aC[0][1]; aN[1][0] = aC[1][0]; aN[1][1] = aC[1][1]; } }
            const char* a1 = Ab + (size_t)(t + 1) * kstep;
            const char* a2 = last ? Ab : Ab + (size_t)(t + 2) * kstep; const char* b2 = last ? nB : cB + (size_t)(t + 2) * kstep;
            const char* a3 = a2 + kstep; const char* b3 = b2 + kstep;
            unsigned o2[2][2];
            o2[0][0] = last ? aN[0][0] : aC[0][0]; o2[0][1] = last ? aN[0][1] : aC[0][1]; o2[1][0] = last ? aN[1][0] : aC[1][0]; o2[1][1] = last ? aN[1][1] : aC[1][1];
            PG8_LDB(B0, 0, 0); PG8_LDB(B1, 0, 1); PG8_SCHED; PG8_LDA(At, 0, 0); PG8_STAGE(PG8_SA(1, 1), a1, aC[1]);
            PG8_WAIT_V(8); PG8_WAIT_L(0); PG8_BAR; PG8_MMA(0, 0, At, B0); PG8_MMA(0, 1, At, B1); PG8_BAR; PG8_SCHED;
            PG8_LDA(At, 0, 1); PG8_STAGE(PG8_SB(0, 0), b2, voffB); PG8_STAGE(PG8_SB(0, 1), b2 + hstep, voffB); PG8_STAGE(PG8_SA(0, 0), a2, o2[0]);
            PG8_WAIT_V(8); PG8_WAIT_L(0); PG8_BAR; PG8_MMA(1, 0, At, B0); PG8_MMA(1, 1, At, B1); PG8_BAR; PG8_SCHED;
            PG8_LDB(B0, 1, 0); PG8_LDB(B1, 1, 1); PG8_SCHED; PG8_LDA(At, 1, 0); PG8_STAGE(PG8_SA(0, 1), a2, o2[1]);
            PG8_WAIT_V(8); PG8_WAIT_L(0); PG8_BAR; PG8_MMA(0, 0, At, B0); PG8_MMA(0, 1, At, B1); PG8_BAR; PG8_SCHED;
            PG8_LDA(At, 1, 1); PG8_STAGE(PG8_SB(1, 0), b3, voffB); PG8_STAGE(PG8_SB(1, 1), b3 + hstep, voffB); PG8_STAGE(PG8_SA(1, 0), a3, o2[0]);
            PG8_WAIT_V(8); PG8_WAIT_L(0); PG8_BAR; PG8_MMA(1, 0, At, B0); PG8_MMA(1, 1, At, B1); PG8_BAR; PG8_SCHED;
        }
        if (wr == 0) PG8_BAR;
        pol.epi(acc, cur, slot, lds, wr, wc, fr, fq);
        if (!has_next) break;
#pragma unroll
        for (int a = 0; a < 2; ++a)
#pragma unroll
            for (int b = 0; b < 2; ++b)
#pragma unroll
                for (int m = 0; m < 4; ++m)
#pragma unroll
                    for (int n = 0; n < 2; ++n) acc[a][b][m][n] = (f32x4){0.f, 0.f, 0.f, 0.f};
        cur = nxt; cB = nB; ++ui; slot = nslot;
        aC[0][0] = aN[0][0]; aC[0][1] = aN[0][1]; aC[1][0] = aN[1][0]; aC[1][1] = aN[1][1];
        if (wr == 1) PG8_BAR;
    }
    PG8_WAIT_V(0);
    PG8_BAR;
#undef PG8_SA
#undef PG8_SB
#undef PG8_STAGE
#undef PG8_LDA
#undef PG8_LDB
#undef PG8_MMA
#undef PG8_WAIT_V
#undef PG8_WAIT_L
#undef PG8_BAR
#undef PG8_SCHED
}
}

typedef f32x4 AccT[2][2][4][2];

struct PolProj {
    static constexpr bool PERM = true, META = false;
    const bf16_t* A; const bf16_t* Bt; bf16_t* O; int G, c;
    __device__ __forceinline__ bool next(int i, pg8::Unit& u) const {
        const int L = i * G + c;
        if (L < 640) { pg8::static_tile(L, 64, 10, u.pm, u.pn); return true; }
        if (L < 648) { const int j = L - 640; u.pm = 64 + (j >> 2); u.pn = 2 + (j & 3); return true; }
        return false;
    }
    __device__ __forceinline__ const char* b_ptr(const pg8::Unit& u) const { return (const char*)Bt + (size_t)u.pn * 256 * 1024 * 2; }
    __device__ __forceinline__ void meta_issue(const pg8::Unit&, int, LAS unsigned char*, int, int) const {}
    __device__ __forceinline__ void a_off(const pg8::Unit& u, int, LAS unsigned char*, const int (&Ra)[2], const int (&Ca)[2], unsigned (&o)[2][2]) const {
#pragma unroll
        for (int h = 0; h < 2; ++h)
#pragma unroll
            for (int i = 0; i < 2; ++i) o[h][i] = (unsigned)((u.pm * 256 + 128 * h + Ra[i]) * 1024 + Ca[i]) * 2u;
    }
    __device__ __forceinline__ void epi(const AccT& acc, const pg8::Unit& u, int, LAS unsigned char*, int wr, int wc, int fr, int fq) const {
        const int row0 = u.pm * 256 + wr * 64 + fr, col0 = u.pn * 256 + wc * 32 + 8 * fq;
        const bool act = u.pn >= 6;
#pragma unroll
        for (int ai = 0; ai < 2; ++ai)
#pragma unroll
            for (int m = 0; m < 4; ++m) { bf16_t* rowp = O + (size_t)(row0 + ai * 128 + m * 16) * DIN + col0;
#pragma unroll
                for (int bj = 0; bj < 2; ++bj) { f32x4 v0 = acc[ai][bj][m][0], v1 = acc[ai][bj][m][1];
                    if (act) {
#pragma unroll
                        for (int j = 0; j < 4; ++j) { v0[j] = gelu_fast(v0[j]); v1[j] = gelu_fast(v1[j]); } }
                    u32x4 w; w.x = cvt_pk_bf16(v0[0], v0[1]); w.y = cvt_pk_bf16(v0[2], v0[3]); w.z = cvt_pk_bf16(v1[0], v1[1]); w.w = cvt_pk_bf16(v1[2], v1[3]);
                    *(u32x4*)(rowp + bj * 128) = w; } }
    }
};

struct PolOut {
    static constexpr bool PERM = false, META = false;
    const bf16_t* A; const bf16_t* Bt; const float* x; const float* mod; float* Y; int G, c;
    __device__ __forceinline__ bool next(int i, pg8::Unit& u) const { const int L = i * G + c; if (L >= 256) return false; pg8::static_tile(L, 64, 4, u.pm, u.pn); return true; }
    __device__ __forceinline__ const char* b_ptr(const pg8::Unit& u) const { return (const char*)Bt + (size_t)u.pn * 256 * 1024 * 2; }
    __device__ __forceinline__ void meta_issue(const pg8::Unit&, int, LAS unsigned char*, int, int) const {}
    __device__ __forceinline__ void a_off(const pg8::Unit& u, int, LAS unsigned char*, const int (&Ra)[2], const int (&Ca)[2], unsigned (&o)[2][2]) const {
#pragma unroll
        for (int h = 0; h < 2; ++h)
#pragma unroll
            for (int i = 0; i < 2; ++i) o[h][i] = (unsigned)((u.pm * 256 + 128 * h + Ra[i]) * 1024 + Ca[i]) * 2u;
    }
    __device__ __forceinline__ void epi(const AccT& acc, const pg8::Unit& u, int, LAS unsigned char*, int wr, int wc, int fr, int fq) const {
        const int row0 = u.pm * 256 + wr * 64 + fr, col0 = u.pn * 256 + wc * 32 + 4 * fq;
        const float* g1 = mod + (u.pm >= 32 ? 6144 : 0) + 2 * 1024;
        f32x4 gv[2][2];
#pragma unroll
        for (int bj = 0; bj < 2; ++bj)
#pragma unroll
            for (int n = 0; n < 2; ++n) gv[bj][n] = *(const f32x4*)(g1 + col0 + bj * 128 + n * 16);
#pragma unroll
        for (int ai = 0; ai < 2; ++ai)
#pragma unroll
            for (int m = 0; m < 4; ++m) { const size_t off = (size_t)(row0 + ai * 128 + m * 16) * D + col0;
#pragma unroll
                for (int bj = 0; bj < 2; ++bj)
#pragma unroll
                    for (int n = 0; n < 2; ++n) { const f32x4 xv = *(const f32x4*)(x + off + bj * 128 + n * 16);
                        *(f32x4*)(Y + off + bj * 128 + n * 16) = xv * DN_ALPHA + gv[bj][n] * acc[ai][bj][m][n]; }
                asm volatile("" ::: "memory"); }
    }
};

struct ExpTab { const LAS int* tile_e; const LAS int* tstart; const LAS int* cnt; int T; };
__device__ __forceinline__ int expert_tables(Frame& F) {
    LAS int* tile_e = (LAS int*)(F.lds + L_TILEE); LAS int* tstart = (LAS int*)(F.lds + L_TSTART); LAS int* cn = tstart + 64;
    if (F.tid < 32) cn[F.tid] = (int)__hip_atomic_load(F.ctl + CW_CNT + 32 * F.tid, __ATOMIC_RELAXED, __HIP_MEMORY_SCOPE_AGENT);
    __syncthreads();
    if (F.tid == 0) { int run = 0; for (int e = 0; e < NE; ++e) { tstart[e] = run; run += (cn[e] + 255) >> 8; } tstart[NE] = run; }
    __syncthreads();
    const int T = tstart[NE];
    if (F.tid < MAXT && F.tid < T) { int e = 0; while (e < NE - 1 && tstart[e + 1] <= F.tid) ++e; tile_e[F.tid] = e; }
    __syncthreads();
    return T < MAXT ? T : MAXT;
}
__device__ __forceinline__ int rfl(int v) { return __builtin_amdgcn_readfirstlane(v); }

struct PolGU {
    static constexpr bool PERM = true, META = true;
    const bf16_t* A; const bf16_t* Bt; const float* bias; const int* list; bf16_t* O; ExpTab tb; int G, c;
    __device__ __forceinline__ bool next(int i, pg8::Unit& u) const {
        const int L = i * G + c; if (L >= tb.T * 8) return false;
        u.ti = L >> 3; u.pn = L & 7; u.e = rfl(tb.tile_e[u.ti]); u.pm = u.ti - rfl(tb.tstart[u.e]);
        const int rem = rfl(tb.cnt[u.e]) - u.pm * 256; u.nvalid = rem < 256 ? rem : 256; return true;
    }
    __device__ __forceinline__ const char* b_ptr(const pg8::Unit& u) const { return (const char*)Bt + ((size_t)u.e * 2048 + (size_t)u.pn * 256) * 1024 * 2; }
    __device__ __forceinline__ void meta_issue(const pg8::Unit& u, int slot, LAS unsigned char* lds, int wid, int lane) const {
        if (wid < 4) __builtin_amdgcn_global_load_lds((const unsigned*)(list + (size_t)u.e * LCAP + u.pm * 256 + wid * 64 + lane), (LAS unsigned*)(lds + L_IDX + slot * 1024 + wid * 256), 4, 0, 0);
    }
    __device__ __forceinline__ void a_off(const pg8::Unit& u, int slot, LAS unsigned char* lds, const int (&Ra)[2], const int (&Ca)[2], unsigned (&o)[2][2]) const {
        const LAS int* idx = (const LAS int*)(lds + L_IDX + slot * 1024);
#pragma unroll
        for (int h = 0; h < 2; ++h)
#pragma unroll
            for (int i = 0; i < 2; ++i) { const int r = 128 * h + Ra[i]; int pr = idx[r]; pr = r < u.nvalid ? pr : 0; o[h][i] = (unsigned)((pr >> 2) * 1024 + Ca[i]) * 2u; }
    }
    __device__ __forceinline__ void epi(const AccT& acc, const pg8::Unit& u, int, LAS unsigned char*, int wr, int wc, int fr, int fq) const {
        const int row0 = u.ti * 256 + wr * 64 + fr, col0 = u.pn * 128 + wc * 32 + 8 * fq;
        const float* bg = bias + (size_t)u.e * 2048 + col0;
        const f32x4 g0 = *(const f32x4*)(bg), g1 = *(const f32x4*)(bg + 4), l0 = *(const f32x4*)(bg + 1024), l1 = *(const f32x4*)(bg + 1028);
#pragma unroll
        for (int ai = 0; ai < 2; ++ai)
#pragma unroll
            for (int m = 0; m < 4; ++m) {
                f32x4 a0 = acc[ai][0][m][0] + g0, a1 = acc[ai][0][m][1] + g1, b0 = acc[ai][1][m][0] + l0, b1 = acc[ai][1][m][1] + l1, r0, r1;
#pragma unroll
                for (int j = 0; j < 4; ++j) {
                    { const float g = fminf(a0[j], 7.f), l = fminf(fmaxf(b0[j], -7.f), 7.f); r0[j] = (l + 1.f) * g * __builtin_amdgcn_rcpf(1.f + __builtin_amdgcn_exp2f(-2.45546696f * g)); }
                    { const float g = fminf(a1[j], 7.f), l = fminf(fmaxf(b1[j], -7.f), 7.f); r1[j] = (l + 1.f) * g * __builtin_amdgcn_rcpf(1.f + __builtin_amdgcn_exp2f(-2.45546696f * g)); }
                }
                u32x4 w; w.x = cvt_pk_bf16(r0[0], r0[1]); w.y = cvt_pk_bf16(r0[2], r0[3]); w.z = cvt_pk_bf16(r1[0], r1[1]); w.w = cvt_pk_bf16(r1[2], r1[3]);
                *(u32x4*)(O + (size_t)(row0 + ai * 128 + m * 16) * DFF + col0) = w; }
    }
};

struct PolDN {
    static constexpr bool PERM = true, META = true;
    const bf16_t* A; const bf16_t* Bt; const float* bias; const int* list; const float* topg; bf16_t* O; ExpTab tb; int G, c;
    __device__ __forceinline__ bool next(int i, pg8::Unit& u) const {
        const int L = i * G + c; if (L >= tb.T * 4) return false;
        u.ti = L >> 2; u.pn = L & 3; u.e = rfl(tb.tile_e[u.ti]); u.pm = u.ti - rfl(tb.tstart[u.e]);
        const int rem = rfl(tb.cnt[u.e]) - u.pm * 256; u.nvalid = rem < 256 ? rem : 256; return true;
    }
    __device__ __forceinline__ const char* b_ptr(const pg8::Unit& u) const { return (const char*)Bt + ((size_t)u.e * 1024 + (size_t)u.pn * 256) * 1024 * 2; }
    __device__ __forceinline__ void meta_issue(const pg8::Unit& u, int slot, LAS unsigned char* lds, int wid, int lane) const {
        if (wid < 4) __builtin_amdgcn_global_load_lds((const unsigned*)(list + (size_t)u.e * LCAP + u.pm * 256 + wid * 64 + lane), (LAS unsigned*)(lds + L_IDX + slot * 1024 + wid * 256), 4, 0, 0);
    }
    __device__ __forceinline__ void a_off(const pg8::Unit& u, int, LAS unsigned char*, const int (&Ra)[2], const int (&Ca)[2], unsigned (&o)[2][2]) const {
#pragma unroll
        for (int h = 0; h < 2; ++h)
#pragma unroll
            for (int i = 0; i < 2; ++i) o[h][i] = (unsigned)((u.ti * 256 + 128 * h + Ra[i]) * 1024 + Ca[i]) * 2u;
    }
    __device__ __forceinline__ void epi(const AccT& acc, const pg8::Unit& u, int slot, LAS unsigned char* lds, int wr, int wc, int fr, int fq) const {
        const LAS int* idx = (const LAS int*)(lds + L_IDX + slot * 1024);
        const int col0 = u.pn * 256 + wc * 32 + 8 * fq;
        const float* bd = bias + (size_t)u.e * 1024 + col0;
        f32x4 bv[2][2];
#pragma unroll
        for (int bj = 0; bj < 2; ++bj)
#pragma unroll
            for (int n = 0; n < 2; ++n) bv[bj][n] = *(const f32x4*)(bd + bj * 128 + 4 * n);
#pragma unroll
        for (int ai = 0; ai < 2; ++ai)
#pragma unroll
            for (int m = 0; m < 4; ++m) { const int r = ai * 128 + wr * 64 + m * 16 + fr;
                if (r < u.nvalid) { const int pr = idx[r]; const float gt = topg[pr]; bf16_t* rowp = O + (size_t)pr * D + col0;
#pragma unroll
                    for (int bj = 0; bj < 2; ++bj) { const f32x4 v0 = (acc[ai][bj][m][0] + bv[bj][0]) * gt, v1 = (acc[ai][bj][m][1] + bv[bj][1]) * gt;
                        u32x4 w; w.x = cvt_pk_bf16(v0[0], v0[1]); w.y = cvt_pk_bf16(v0[2], v0[3]); w.z = cvt_pk_bf16(v1[0], v1[1]); w.w = cvt_pk_bf16(v1[2], v1[3]);
                        *(u32x4*)(rowp + bj * 128) = w; } } }
    }
};

__device__ __forceinline__ void p_ada(Frame& F) {
    LAS float* sl = (LAS float*)F.lds;
    LAS float* red = sl + 3072;
    for (int i = F.tid; i < 3072; i += 512) { const int w = i >> 10, k = i & 1023; const float v = w < 2 ? F.c[w * D + k] : F.c_ctx[k]; sl[i] = v / (1.f + __expf(-v)); }
    __syncthreads();
    for (int slab = blockIdx.x; slab < 256; slab += F.G) {
        const int j0 = slab * 24, cg = F.tid % 6, kr = F.tid / 6;
        float a[3][4] = {};
        if (F.tid < 480) {
            for (int k = kr; k < D; k += 80) {
                const f32x4 w4 = *(const f32x4*)(F.ada_w + (size_t)k * 6144 + j0 + 4 * cg);
                const float s0 = sl[k], s1 = sl[1024 + k], s2 = sl[2048 + k];
#pragma unroll
                for (int q = 0; q < 4; ++q) { a[0][q] += s0 * w4[q]; a[1][q] += s1 * w4[q]; a[2][q] += s2 * w4[q]; }
            }
#pragma unroll
            for (int w = 0; w < 3; ++w)
#pragma unroll
                for (int q = 0; q < 4; ++q) red[kr * 72 + cg * 12 + w * 4 + q] = a[w][q];
        }
        __syncthreads();
        if (F.tid < 72) {
            float s = 0.f;
            for (int r = 0; r < 80; ++r) s += red[r * 72 + F.tid];
            const int g = F.tid / 12, w = (F.tid % 12) >> 2, q = F.tid & 3, col = j0 + 4 * g + q;
            F.mod[w * 6144 + col] = s + F.ada_b[col];
        }
        __syncthreads();
    }
}

__device__ __forceinline__ void transpose_item(const float* W, int K, int N, bf16_t* WT, int item, bool gu_map, LAS float* scr, int lane) {
    const int nblk = N / 32, kb = item / nblk, nb = item % nblk, k0 = 64 * kb, n0 = 32 * nb;
#pragma unroll 8
    for (int i = 0; i < 32; ++i) { const int kk = 2 * i + (lane >> 5); scr[kk * 33 + (lane & 31)] = W[(size_t)(k0 + kk) * N + n0 + (lane & 31)]; }
    LDS_WAIT(); asm volatile("" ::: "memory");
    int d0 = n0;
    if (gu_map) { const int nn = n0 & 1023; d0 = (nn >> 7) * 256 + (nn & 127) + ((n0 >> 10) ? 128 : 0); }
    const int c = lane & 7;
#pragma unroll
    for (int j = 0; j < 4; ++j) { const int n = (lane >> 3) + 8 * j; const LAS float* s = scr + (8 * c) * 33 + n;
        u32x4 o; o.x = pk2(s[0 * 33], s[1 * 33]); o.y = pk2(s[2 * 33], s[3 * 33]); o.z = pk2(s[4 * 33], s[5 * 33]); o.w = pk2(s[6 * 33], s[7 * 33]);
        *(u32x4*)(WT + (size_t)(d0 + n) * K + k0 + 8 * c) = o; }
    LDS_WAIT(); asm volatile("" ::: "memory");
}
__device__ __forceinline__ void p_weights(Frame& F) {
    LAS float* scr = (LAS float*)(F.lds + F.wave * 16384);
    const int gw = F.vcu * 8 + F.wave, NGW = F.G * 8;
    constexpr int I_IN = 16 * 80, I_OUT = 16 * 32, I_GU = 16 * 64, I_DN = 16 * 32;
    constexpr int NITEMS = I_IN + I_OUT + NE * I_GU + NE * I_DN;
    for (int it = gw; it < NITEMS; it += NGW) {
        int r = it;
        if (r < I_IN) { transpose_item(F.w_in, D, DIN, F.Wt_in, r, false, scr, F.lane); continue; } r -= I_IN;
        if (r < I_OUT) { transpose_item(F.w_out, D, D, F.Wt_out, r, false, scr, F.lane); continue; } r -= I_OUT;
        if (r < NE * I_GU) { const int e = r / I_GU; transpose_item(F.w_gu + (size_t)e * D * 2048, D, 2048, F.Wt_gu + (size_t)e * 2048 * D, r % I_GU, true, scr, F.lane); continue; } r -= NE * I_GU;
        { const int e = r / I_DN; transpose_item(F.w_dn + (size_t)e * DFF * D, DFF, D, F.Wt_dn + (size_t)e * D * DFF, r % I_DN, false, scr, F.lane); }
    }
    for (int i = (blockIdx.x * 512 + F.tid) * 4; i < 4 * 128 * 128; i += F.G * 512 * 4) {
        const f32x4 v = *(const f32x4*)(F.sgu_w + i); u32x2 o; o.x = pk2(v[0], v[1]); o.y = pk2(v[2], v[3]); *(u32x2*)(F.sguw + i) = o; }
}
__device__ __forceinline__ void p_lnmod(Frame& F) {
    const int gw = F.vcu * 8 + F.wave, NGW = F.G * 8;
    for (int row = gw; row < MX; row += NGW) {
        const float* xr; const float* md;
        if (row < M) { xr = F.x + (size_t)row * D; md = F.mod + (row >> 13) * 6144; } else { xr = F.ctx + (size_t)(row - M) * D; md = F.mod + 2 * 6144; }
        const f32x4* xp = (const f32x4*)xr + F.lane;
        f32x4 v[4]; float s = 0.f;
#pragma unroll
        for (int j = 0; j < 4; ++j) { v[j] = xp[64 * j]; s += (v[j][0] + v[j][1]) + (v[j][2] + v[j][3]); }
        const float mean = wsum(s) * (1.f / D); float q = 0.f;
#pragma unroll
        for (int j = 0; j < 4; ++j) { v[j] = v[j] - mean; q += (v[j][0] * v[j][0] + v[j][1] * v[j][1]) + (v[j][2] * v[j][2] + v[j][3] * v[j][3]); }
        const float rstd = rsqrtf(wsum(q) * (1.f / D) + EPS);
        u32x2* op = (u32x2*)(F.hxc + (size_t)row * D) + F.lane;
#pragma unroll
        for (int j = 0; j < 4; ++j) { const f32x4 sh = *((const f32x4*)md + F.lane + 64 * j), sc = *((const f32x4*)(md + 1024) + F.lane + 64 * j);
            const f32x4 o = v[j] * rstd * (sc + 1.f) + sh; u32x2 w; w.x = pk2(o[0], o[1]); w.y = pk2(o[2], o[3]); op[64 * j] = w; }
    }
}

__device__ __forceinline__ void p_attn_simple(Frame& F) {
    LAS float* sq = (LAS float*)(F.lds + F.wave * 4096);
    LAS float* sp = sq + 64;
    const int gw = F.vcu * 8 + F.wave, NGW = F.G * 8;
    for (int gid = gw; gid < M * NH; gid += NGW) {
        const int h = gid & 7, tok = gid >> 3, b = tok >> 13, t = tok & (S - 1), r = t >> 6, c = t & 63;
        const int rs = min(max(r - KH / 2, 0), ROWS - KH), cs = min(max(c - KW / 2, 0), GW - KW);
        sq[F.lane] = bf2f(F.proj[(size_t)tok * DIN + h * 64 + F.lane]);
        LDS_WAIT(); asm volatile("" ::: "memory");
        float sc[6]; float mx = -1e30f;
#pragma unroll
        for (int i = 0; i < 6; ++i) {
            const int kk = F.lane + 64 * i;
            const bf16_t* kp; float bias = 0.f;
            if (kk < 128) { const int ki = kk >> 4, kj = kk & 15;
                kp = F.proj + (size_t)(b * S + (rs + ki) * GW + cs + kj) * DIN + 512 + h * 64;
                bias = F.rpb[(h * 15 + (rs + ki - r + 7)) * 31 + (cs + kj - c + 15)];
            } else kp = F.proj + (size_t)(M + b * CTX + (kk - 128)) * DIN + 512 + h * 64;
            float d = 0.f;
#pragma unroll
            for (int dd = 0; dd < 64; dd += 8) { const u32x4 kv = *(const u32x4*)(kp + dd);
                d += sq[dd] * bflo(kv.x) + sq[dd + 1] * bfhi(kv.x) + sq[dd + 2] * bflo(kv.y) + sq[dd + 3] * bfhi(kv.y) + sq[dd + 4] * bflo(kv.z) + sq[dd + 5] * bfhi(kv.z) + sq[dd + 6] * bflo(kv.w) + sq[dd + 7] * bfhi(kv.w); }
            sc[i] = d * 0.125f + bias; mx = fmaxf(mx, sc[i]);
        }
        mx = wmax(mx);
        float sum = 0.f;
#pragma unroll
        for (int i = 0; i < 6; ++i) { const float p = __expf(sc[i] - mx); sum += p; sp[F.lane + 64 * i] = p; }
        sum = wsum(sum);
        LDS_WAIT(); asm volatile("" ::: "memory");
        float acc = 0.f;
        for (int kk = 0; kk < 384; ++kk) {
            const bf16_t* vp;
            if (kk < 128) { const int ki = kk >> 4, kj = kk & 15; vp = F.proj + (size_t)(b * S + (rs + ki) * GW + cs + kj) * DIN + 1024 + h * 64; }
            else vp = F.proj + (size_t)(M + b * CTX + (kk - 128)) * DIN + 1024 + h * 64;
            acc += sp[kk] * bf2f(vp[F.lane]);
        }
        F.mixin[(size_t)tok * D + h * 64 + F.lane] = (bf16_t)f2bf(acc / sum);
        LDS_WAIT(); asm volatile("" ::: "memory");
    }
}
__device__ __forceinline__ void p_sgu_simple(Frame& F) {
    LAS bf16_t* G = (LAS bf16_t*)F.lds;
    for (int u = blockIdx.x; u < M / 128; u += F.G) {
        const int base = u * 128;
        for (int tl = F.wave; tl < 128; tl += 8) {
            const bf16_t* zr = F.proj + (size_t)(base + tl) * DIN + 2048 + F.lane * 8;
            const u32x4 zv = *(const u32x4*)zr;
            float v[8] = {bflo(zv.x), bfhi(zv.x), bflo(zv.y), bfhi(zv.y), bflo(zv.z), bfhi(zv.z), bflo(zv.w), bfhi(zv.w)};
            float s = 0.f;
#pragma unroll
            for (int i = 0; i < 8; ++i) s += v[i];
            const float mean = wsum(s) * (1.f / 512.f); float q = 0.f;
#pragma unroll
            for (int i = 0; i < 8; ++i) { v[i] -= mean; q += v[i] * v[i]; }
            const float rstd = rsqrtf(wsum(q) * (1.f / 512.f) + EPS);
#pragma unroll
            for (int i = 0; i < 8; ++i) { const int ch = F.lane * 8 + i; G[tl * 512 + ch] = (bf16_t)f2bf(v[i] * rstd * F.sgu_ln_g[ch] + F.sgu_ln_b[ch]); }
        }
        __syncthreads();
        const int ch = F.tid, grp = ch >> 7;
        for (int i = 0; i < 128; ++i) {
            const float* wrow = F.sgu_w + (size_t)(grp * 128 + i) * 128;
            float acc = 0.f;
            for (int j = 0; j < 128; ++j) acc += wrow[j] * bf2f(G[j * 512 + ch]);
            acc += F.sgu_b[grp * 128 + i];
            const float uu = bf2f(F.proj[(size_t)(base + i) * DIN + 1536 + ch]);
            F.mixin[(size_t)(base + i) * D + 512 + ch] = (bf16_t)f2bf(uu * acc);
        }
        __syncthreads();
    }
}

namespace at {
typedef float f32x16 __attribute__((ext_vector_type(16)));
typedef short s16x4 __attribute__((ext_vector_type(4)));
typedef short v4i16_t __attribute__((ext_vector_type(4)));
constexpr int A_K = 0, A_V = 16384, A_STG = 32768, A_WSF = 65536, A_RPB = 67584;
constexpr float C2 = 0.125f * 1.4426950408889634f, L2E = 1.4426950408889634f;
__device__ __forceinline__ int crow(int r, int hi) { return (r & 3) + 8 * (r >> 2) + 4 * hi; }
__device__ __forceinline__ s16x4 vtr(const LAS unsigned char* p) { return __builtin_bit_cast(s16x4, __builtin_amdgcn_ds_read_tr16_b64_v4i16((LAS v4i16_t*)p)); }
__device__ __forceinline__ int rsf(int r) { return min(max(r - KH / 2, 0), ROWS - KH); }
#define AT_WAIT_BAR() asm volatile("s_waitcnt vmcnt(0) lgkmcnt(0)\n\ts_barrier" ::: "memory")

__device__ __forceinline__ void attn_unit(Frame& F, int b, int h, int rg) {
    const int lane = F.lane, r32 = lane & 31, hi = lane >> 5, w = F.wave;
    const int r0 = 4 * rg, r = r0 + (w >> 1), c = 32 * (w & 1) + r32;
    const int krlo = rsf(r0), nnb = rsf(r0 + 3) + 7 - krlo + 1, nst = nnb + 4;
    const int rsw = rsf(r), cs = min(max(c - KW / 2, 0), GW - KW);
    LAS float* tbl = (LAS float*)(F.lds + A_RPB);
    LAS float* wsf = (LAS float*)(F.lds + A_WSF) + w * 64;
    for (int i = F.tid; i < 480; i += 512) { const int dr = i >> 5, dc = i & 31; tbl[64 + i] = dc < 31 ? F.rpb[(h * 15 + dr) * 31 + dc] * L2E : 0.f; }
    const bf16_t* qp = F.proj + (size_t)(b * S + r * GW + c) * DIN + h * 64 + hi * 8;
    bf16x8 qr[4];
#pragma unroll
    for (int d0 = 0; d0 < 4; ++d0) qr[d0] = *(const bf16x8*)(qp + d0 * 16);
    const bf16_t* kbase = F.proj + 512 + h * 64 + w * 8;
    const bf16_t* vbase = F.proj + 1024 + h * 64 + (w >> 2) * 32 + (lane & 3) * 8;
#define AT_DMA(st) do { const int _t0 = (st) < nnb ? b * S + (krlo + (st)) * GW : M + b * CTX + ((st) - nnb) * 64; const int _bf = ((st) & 1) * 8192; \
        __builtin_amdgcn_global_load_lds((const unsigned*)(kbase + (size_t)(_t0 + lane) * DIN), (LAS unsigned*)(F.lds + A_K + _bf + w * 1024), 16, 0, 0); \
        __builtin_amdgcn_global_load_lds((const unsigned*)(vbase + (size_t)(_t0 + 16 * (w & 3) + (lane >> 2)) * DIN), (LAS unsigned*)(F.lds + A_V + _bf + w * 1024), 16, 0, 0); } while (0)
    float m = -1e30f, l = 0.f;
    f32x16 o[2];
#pragma unroll
    for (int i = 0; i < 16; ++i) { o[0][i] = 0.f; o[1][i] = 0.f; }
    AT_DMA(0);
    for (int st = 0; st < nst; ++st) {
        AT_WAIT_BAR();
        if (st + 1 < nst) AT_DMA(st + 1);
        const bool isnb = st < nnb; const int kr = krlo + st;
        const bool act = !isnb || (kr >= rsw && kr < rsw + KH);
        if (act) {
            const LAS unsigned char* kp0 = F.lds + A_K + (st & 1) * 8192 + hi * 1024 + r32 * 16;
            f32x16 p0, p1;
#pragma unroll
            for (int i = 0; i < 16; ++i) { p0[i] = 0.f; p1[i] = 0.f; }
#pragma unroll
            for (int d0 = 0; d0 < 4; ++d0) {
                const bf16x8 b0 = *(const LAS bf16x8*)(kp0 + d0 * 2048), b1 = *(const LAS bf16x8*)(kp0 + d0 * 2048 + 512);
                p0 = __builtin_amdgcn_mfma_f32_32x32x16_bf16(b0, qr[d0], p0, 0, 0, 0);
                p1 = __builtin_amdgcn_mfma_f32_32x32x16_bf16(b1, qr[d0], p1, 0, 0, 0);
            }
            if (isnb) {
                const LAS float* tb = tbl + 64 + (kr - r + 7) * 32 + 4 * hi - c + 15;
#pragma unroll
                for (int rr = 0; rr < 16; ++rr) { const int ko = (rr & 3) + 8 * (rr >> 2), kc = ko + 4 * hi;
                    const float t0 = p0[rr] * C2 + tb[ko], t1 = p1[rr] * C2 + tb[ko + 32];
                    p0[rr] = (unsigned)(kc - cs) < (unsigned)KW ? t0 : -INFINITY; p1[rr] = (unsigned)(kc + 32 - cs) < (unsigned)KW ? t1 : -INFINITY; }
            } else {
#pragma unroll
                for (int rr = 0; rr < 16; ++rr) { p0[rr] *= C2; p1[rr] *= C2; }
            }
            float tm = fmaxf(p0[0], p1[0]);
#pragma unroll
            for (int rr = 1; rr < 16; ++rr) tm = fmaxf(tm, fmaxf(p0[rr], p1[rr]));
            tm = fmaxf(tm, __shfl_xor(tm, 32));
            const float mn = fmaxf(m, tm), alpha = __builtin_amdgcn_exp2f(m - mn);
            float rsum = 0.f;
#pragma unroll
            for (int rr = 0; rr < 16; ++rr) { p0[rr] = __builtin_amdgcn_exp2f(p0[rr] - mn); p1[rr] = __builtin_amdgcn_exp2f(p1[rr] - mn); rsum += p0[rr] + p1[rr]; }
            l = l * alpha + rsum; m = mn;
            if (__any(alpha != 1.f)) {
                if (hi == 0) wsf[r32] = alpha;
                LDS_WAIT();
#pragma unroll
                for (int rr = 0; rr < 16; ++rr) { const float a = wsf[crow(rr, hi)]; o[0][rr] *= a; o[1][rr] *= a; }
                LDS_WAIT();
            }
            u32x4 pw[4];
#pragma unroll
            for (int q = 0; q < 4; ++q) { pw[0][q] = cvt_pk_bf16(p0[2 * q], p0[2 * q + 1]); pw[1][q] = cvt_pk_bf16(p0[8 + 2 * q], p0[9 + 2 * q]);
                                          pw[2][q] = cvt_pk_bf16(p1[2 * q], p1[2 * q + 1]); pw[3][q] = cvt_pk_bf16(p1[8 + 2 * q], p1[9 + 2 * q]); }
            const LAS unsigned char* vp = F.lds + A_V + (st & 1) * 8192 + ((lane >> 4) & 1) * 32 + (lane & 3) * 8 + (4 * hi + ((lane & 15) >> 2)) * 64;
#pragma unroll
            for (int d0 = 0; d0 < 2; ++d0)
#pragma unroll
                for (int ks = 0; ks < 4; ++ks) {
                    const s16x4 lo = vtr(vp + d0 * 4096 + ks * 1024), hh = vtr(vp + d0 * 4096 + ks * 1024 + 512);
                    const bf16x8 vf = (bf16x8){lo[0], lo[1], lo[2], lo[3], hh[0], hh[1], hh[2], hh[3]};
                    o[d0] = __builtin_amdgcn_mfma_f32_32x32x16_bf16(__builtin_bit_cast(bf16x8, pw[ks]), vf, o[d0], 0, 0, 0);
                }
        }
    }
#undef AT_DMA
    l += __shfl_xor(l, 32);
    if (hi == 0) wsf[32 + r32] = l;
    LDS_WAIT();
    LAS bf16_t* stg = (LAS bf16_t*)(F.lds + A_STG) + w * 2048;
#pragma unroll
    for (int rr = 0; rr < 16; ++rr) { const int orow = crow(rr, hi); const float rl = __builtin_amdgcn_rcpf(wsf[32 + orow]);
        stg[orow * 64 + r32] = (bf16_t)f2bf(o[0][rr] * rl); stg[orow * 64 + 32 + r32] = (bf16_t)f2bf(o[1][rr] * rl); }
    LDS_WAIT();
    bf16_t* ow = F.mixin + (size_t)(b * S + r * GW + 32 * (w & 1)) * D + h * 64;
#pragma unroll
    for (int i = 0; i < 4; ++i) { const int row = i * 8 + (lane >> 3), ch = lane & 7; const u32x4 v = *(const LAS u32x4*)(stg + row * 64 + ch * 8); *(u32x4*)(ow + (size_t)row * D + ch * 8) = v; }
    AT_WAIT_BAR();
}

constexpr int G_IMG = 0, G_STG = 65536, G_STAT = 98304;
__device__ __forceinline__ void sgu_unit(Frame& F, int chunk, int gh) {
    const int lane = F.lane, r32 = lane & 31, hi = lane >> 5, w = F.wave;
    const int base = chunk * 128;
    LAS f32x2* stat = (LAS f32x2*)(F.lds + G_STAT);
    for (int t = 0; t < 16; ++t) {
        const int tok = 16 * w + t;
        const u32x4 zv = *(const u32x4*)(F.proj + (size_t)(base + tok) * DIN + 2048 + lane * 8);
        float v[8] = {bflo(zv.x), bfhi(zv.x), bflo(zv.y), bfhi(zv.y), bflo(zv.z), bfhi(zv.z), bflo(zv.w), bfhi(zv.w)};
        float s = 0.f;
#pragma unroll
        for (int i = 0; i < 8; ++i) s += v[i];
        const float mean = wsum(s) * (1.f / 512.f); float q = 0.f;
#pragma unroll
        for (int i = 0; i < 8; ++i) { const float d = v[i] - mean; q += d * d; }
        const float rstd = rsqrtf(wsum(q) * (1.f / 512.f) + EPS);
        if (lane == 0) stat[tok] = (f32x2){mean, rstd};
    }
    AT_WAIT_BAR();
    {
        const int ch0 = 256 * gh + 32 * w + 8 * (lane & 3);
        const f32x4 g0 = *(const f32x4*)(F.sgu_ln_g + ch0), g1 = *(const f32x4*)(F.sgu_ln_g + ch0 + 4), b0 = *(const f32x4*)(F.sgu_ln_b + ch0), b1 = *(const f32x4*)(F.sgu_ln_b + ch0 + 4);
#pragma unroll
        for (int i = 0; i < 8; ++i) {
            const int tok = 16 * i + (lane >> 2);
            const u32x4 zv = *(const u32x4*)(F.proj + (size_t)(base + tok) * DIN + 2048 + ch0);
            const f32x2 st = stat[tok];
            u32x4 o;
            o.x = pk2((bflo(zv.x) - st[0]) * st[1] * g0[0] + b0[0], (bfhi(zv.x) - st[0]) * st[1] * g0[1] + b0[1]);
            o.y = pk2((bflo(zv.y) - st[0]) * st[1] * g0[2] + b0[2], (bfhi(zv.y) - st[0]) * st[1] * g0[3] + b0[3]);
            o.z = pk2((bflo(zv.z) - st[0]) * st[1] * g1[0] + b1[0], (bfhi(zv.z) - st[0]) * st[1] * g1[1] + b1[1]);
            o.w = pk2((bflo(zv.w) - st[0]) * st[1] * g1[2] + b1[2], (bfhi(zv.w) - st[0]) * st[1] * g1[3] + b1[3]);
            *(LAS u32x4*)(F.lds + G_IMG + w * 8192 + i * 1024 + lane * 16) = o;
        }
    }
    AT_WAIT_BAR();
    const int cb = w & 3, th = w >> 2, grp = 2 * gh + (cb >> 1);
    f32x16 acc[2][2];
#pragma unroll
    for (int a = 0; a < 2; ++a)
#pragma unroll
        for (int q = 0; q < 2; ++q)
#pragma unroll
            for (int i = 0; i < 16; ++i) acc[a][q][i] = 0.f;
    const bf16_t* wp = F.sguw + (size_t)(grp * 128 + 64 * th + r32) * 128 + 8 * hi;
    const LAS unsigned char* gp = F.lds + G_IMG + (2 * cb) * 8192 + ((lane >> 4) & 1) * 32 + (lane & 3) * 8 + (8 * hi + ((lane & 15) >> 2)) * 64;
#pragma unroll
    for (int ks = 0; ks < 8; ++ks) {
        const bf16x8 w0 = *(const bf16x8*)(wp + ks * 16), w1 = *(const bf16x8*)(wp + 32 * 128 + ks * 16);
#pragma unroll
        for (int c32 = 0; c32 < 2; ++c32) {
            const s16x4 lo = vtr(gp + c32 * 8192 + ks * 1024), hh = vtr(gp + c32 * 8192 + ks * 1024 + 256);
            const bf16x8 gf = (bf16x8){lo[0], lo[1], lo[2], lo[3], hh[0], hh[1], hh[2], hh[3]};
            acc[0][c32] = __builtin_amdgcn_mfma_f32_32x32x16_bf16(gf, w0, acc[0][c32], 0, 0, 0);
            acc[1][c32] = __builtin_amdgcn_mfma_f32_32x32x16_bf16(gf, w1, acc[1][c32], 0, 0, 0);
        }
    }
    LAS unsigned char* stg = F.lds + G_STG + w * 4096;
#pragma unroll
    for (int ib = 0; ib < 2; ++ib) {
        const int i0 = 64 * th + 32 * ib;
        const float bi = F.sgu_b[grp * 128 + i0 + r32];
#pragma unroll
        for (int c32 = 0; c32 < 2; ++c32)
#pragma unroll
            for (int a = 0; a < 4; ++a) { u32x2 o; o.x = pk2(acc[ib][c32][4 * a] + bi, acc[ib][c32][4 * a + 1] + bi); o.y = pk2(acc[ib][c32][4 * a + 2] + bi, acc[ib][c32][4 * a + 3] + bi);
                *(LAS u32x2*)(stg + r32 * 128 + (((4 * c32 + a) ^ (r32 & 7)) << 4) + hi * 8) = o; }
        LDS_WAIT();
#pragma unroll
        for (int it = 0; it < 4; ++it) {
            const int row = 8 * it + (lane >> 3), chn = lane & 7;
            const u32x4 v = *(const LAS u32x4*)(stg + row * 128 + ((chn ^ (row & 7)) << 4));
            const size_t tok = (size_t)(base + i0 + row);
            const u32x4 uv = *(const u32x4*)(F.proj + tok * DIN + 1536 + 256 * gh + 64 * cb + 8 * chn);
            u32x4 o;
            o.x = pk2(bflo(v.x) * bflo(uv.x), bfhi(v.x) * bfhi(uv.x)); o.y = pk2(bflo(v.y) * bflo(uv.y), bfhi(v.y) * bfhi(uv.y));
            o.z = pk2(bflo(v.z) * bflo(uv.z), bfhi(v.z) * bfhi(uv.z)); o.w = pk2(bflo(v.w) * bflo(uv.w), bfhi(v.w) * bfhi(uv.w));
            *(u32x4*)(F.mixin + tok * D + 512 + 256 * gh + 64 * cb + 8 * chn) = o;
        }
        LDS_WAIT();
    }
    AT_WAIT_BAR();
}
__device__ __forceinline__ void p_mixer(Frame& F) {
    for (int uid = F.vcu; uid < NB * NH * 32; uid += F.G) attn_unit(F, uid >> 8, (uid >> 5) & 7, uid & 31);
    for (int uid = F.vcu; uid < (M / 128) * 2; uid += F.G) sgu_unit(F, uid >> 1, uid & 1);
}
#undef AT_WAIT_BAR
}

__device__ __forceinline__ void p_route(Frame& F) {
    LAS int* lcnt = (LAS int*)(F.lds + L_ROUTE); LAS int* gbase = lcnt + 32; LAS int* sel = lcnt + 64;
    for (int i = F.tid; i < 8192; i += 512) { const int c = i >> 3, q = i & 7; *(LAS f32x4*)(F.lds + c * 128 + ((q ^ ((c >> 1) & 7)) << 4)) = *(const f32x4*)(F.router_w + c * 32 + q * 4); }
    if (F.tid < 32) lcnt[F.tid] = 0;
    __syncthreads();
    for (int tb = blockIdx.x; tb < M / 64; tb += F.G) {
        for (int tl = F.wave; tl < 64; tl += 8) {
            const int tok = tb * 64 + tl, b = tok >> 13;
            const float* sh2 = F.mod + b * 6144 + 3 * 1024; const float* sc2 = F.mod + b * 6144 + 4 * 1024;
            float* yr = F.y1 + (size_t)tok * D;
            float v[16]; float s = 0.f;
#pragma unroll
            for (int i = 0; i < 16; ++i) { v[i] = yr[F.lane + 64 * i]; s += v[i]; }
            float mean = wsum(s) * (1.f / D), q = 0.f;
#pragma unroll
            for (int i = 0; i < 16; ++i) { v[i] -= mean; q += v[i] * v[i]; }
            float rstd = rsqrtf(wsum(q) * (1.f / D) + EPS);
            s = 0.f;
#pragma unroll
            for (int i = 0; i < 16; ++i) { const int col = F.lane + 64 * i; v[i] = v[i] * rstd * F.ln1_g[col] + F.ln1_b[col]; yr[col] = v[i]; s += v[i]; }
            mean = wsum(s) * (1.f / D); q = 0.f;
#pragma unroll
            for (int i = 0; i < 16; ++i) { v[i] -= mean; q += v[i] * v[i]; }
            rstd = rsqrtf(wsum(q) * (1.f / D) + EPS);
            float lg[NE];
#pragma unroll
            for (int e = 0; e < NE; ++e) lg[e] = 0.f;
#pragma unroll
            for (int i = 0; i < 16; ++i) {
                const int col = F.lane + 64 * i;
                v[i] = v[i] * rstd * (1.f + sc2[col]) + sh2[col];
                F.h2[(size_t)tok * D + col] = (bf16_t)f2bf(v[i]);
                const LAS unsigned char* wr = F.lds + col * 128; const int sw = (col >> 1) & 7;
#pragma unroll
                for (int qq = 0; qq < 8; ++qq) { const f32x4 w4 = *(const LAS f32x4*)(wr + ((qq ^ sw) << 4));
#pragma unroll
                    for (int j = 0; j < 4; ++j) lg[qq * 4 + j] += v[i] * w4[j]; }
            }
            float r16[16], r8[8], r4[4], r2[2], r1;
            { const bool hi = F.lane & 32;
#pragma unroll
              for (int e = 0; e < 16; ++e) { const float mine = hi ? lg[e + 16] : lg[e], send = hi ? lg[e] : lg[e + 16]; r16[e] = mine + __shfl_xor(send, 32); } }
            { const bool hi = F.lane & 16;
#pragma unroll
              for (int e = 0; e < 8; ++e) { const float mine = hi ? r16[e + 8] : r16[e], send = hi ? r16[e] : r16[e + 8]; r8[e] = mine + __shfl_xor(send, 16); } }
            { const bool hi = F.lane & 8;
#pragma unroll
              for (int e = 0; e < 4; ++e) { const float mine = hi ? r8[e + 4] : r8[e], send = hi ? r8[e] : r8[e + 4]; r4[e] = mine + __shfl_xor(send, 8); } }
            { const bool hi = F.lane & 4;
#pragma unroll
              for (int e = 0; e < 2; ++e) { const float mine = hi ? r4[e + 2] : r4[e], send = hi ? r4[e] : r4[e + 2]; r2[e] = mine + __shfl_xor(send, 4); } }
            { const bool hi = F.lane & 2; const float mine = hi ? r2[1] : r2[0], send = hi ? r2[0] : r2[1]; r1 = mine + __shfl_xor(send, 2); }
            r1 += __shfl_xor(r1, 1);
            const int e = F.lane >> 1;
            const float lgt = r1 + F.router_b[e];
            int rank = 0; float mx = -3.0e38f;
#pragma unroll
            for (int e2 = 0; e2 < NE; ++e2) { const float o = __builtin_bit_cast(float, __builtin_amdgcn_readlane(__builtin_bit_cast(int, lgt), 2 * e2));
                rank += (o > lgt || (o == lgt && e2 < e)) ? 1 : 0; mx = fmaxf(mx, o); }
            const bool selq = rank < TOPK && !(F.lane & 1);
            const float pe = selq ? __expf(lgt - mx) : 0.f;
            const float den = wsum(pe);
            if (selq) {
                const int lp = __hip_atomic_fetch_add(lcnt + e, 1, __ATOMIC_RELAXED, __HIP_MEMORY_SCOPE_WORKGROUP);
                sel[tl * 4 + rank] = e | (lp << 8);
                F.topg[tok * 4 + rank] = pe / den; F.topi[tok * 4 + rank] = e;
            }
        }
        __syncthreads();
        if (F.tid < 32) { const int n = lcnt[F.tid]; gbase[F.tid] = n ? (int)__hip_atomic_fetch_add(F.ctl + CW_CNT + 32 * F.tid, (unsigned)n, __ATOMIC_RELAXED, __HIP_MEMORY_SCOPE_AGENT) : 0; lcnt[F.tid] = 0; }
        __syncthreads();
        if (F.tid < 256) { const int sv = sel[F.tid], e = sv & 255, lp = sv >> 8; F.list[(size_t)e * LCAP + gbase[e] + lp] = (tb * 64 + (F.tid >> 2)) * 4 + (F.tid & 3); }
        __syncthreads();
    }
}

__device__ __forceinline__ void p_final(Frame& F) {
    const int gw = F.vcu * 8 + F.wave, NGW = F.G * 8;
    for (int tok = gw; tok < M; tok += NGW) {
        const float* g2 = F.mod + (tok >> 13) * 6144 + 5 * 1024;
        const f32x4* xp = (const f32x4*)(F.y1 + (size_t)tok * D) + F.lane;
        f32x4 v[4]; float s = 0.f;
#pragma unroll
        for (int j = 0; j < 4; ++j) {
            f32x4 f = (f32x4){0.f, 0.f, 0.f, 0.f};
#pragma unroll
            for (int k = 0; k < TOPK; ++k) { const u32x2 yv = *((const u32x2*)(F.ybuf + (size_t)(tok * 4 + k) * D) + F.lane + 64 * j);
                f[0] += bflo(yv.x); f[1] += bfhi(yv.x); f[2] += bflo(yv.y); f[3] += bfhi(yv.y); }
            const f32x4 gv = *((const f32x4*)g2 + F.lane + 64 * j);
            v[j] = xp[64 * j] * DN_ALPHA + gv * f; s += (v[j][0] + v[j][1]) + (v[j][2] + v[j][3]);
        }
        const float mean = wsum(s) * (1.f / D); float q = 0.f;
#pragma unroll
        for (int j = 0; j < 4; ++j) { v[j] = v[j] - mean; q += (v[j][0] * v[j][0] + v[j][1] * v[j][1]) + (v[j][2] * v[j][2] + v[j][3] * v[j][3]); }
        const float rstd = rsqrtf(wsum(q) * (1.f / D) + EPS);
        f32x4* op = (f32x4*)(F.out + (size_t)tok * D) + F.lane;
#pragma unroll
        for (int j = 0; j < 4; ++j) { const f32x4 gg = *((const f32x4*)F.ln2_g + F.lane + 64 * j), bb = *((const f32x4*)F.ln2_b + F.lane + 64 * j); op[64 * j] = v[j] * rstd * gg + bb; }
    }
}

struct Args { const float* in[23]; float* out; unsigned char* ws; int ph_lo, ph_hi; };
constexpr int N_PHASES = 9;
__global__ void __launch_bounds__(512, 2) mk_fwd(Args args) {
    extern __shared__ __attribute__((aligned(16))) unsigned char lds_raw[];
    Frame F;
    F.lds = (LAS unsigned char*)lds_raw;
    F.MISC = (volatile LAS unsigned*)(F.lds + L_MISC);
    F.tid = threadIdx.x; F.lane = F.tid & 63; F.wave = __builtin_amdgcn_readfirstlane(F.tid >> 6);
    F.G = gridDim.x; { const int bx = blockIdx.x; F.vcu = (F.G % 8 == 0) ? (bx % 8) * (F.G / 8) + bx / 8 : bx; }
    unsigned char* ws = args.ws;
    F.ctl = (unsigned*)(ws + WS_CTL);
    F.x = args.in[0]; F.c = args.in[1]; F.ctx = args.in[2]; F.c_ctx = args.in[3]; F.ada_w = args.in[4]; F.ada_b = args.in[5]; F.w_in = args.in[6]; F.rpb = args.in[7];
    F.sgu_ln_g = args.in[8]; F.sgu_ln_b = args.in[9]; F.sgu_w = args.in[10]; F.sgu_b = args.in[11]; F.w_out = args.in[12]; F.ln1_g = args.in[13]; F.ln1_b = args.in[14];
    F.ln2_g = args.in[15]; F.ln2_b = args.in[16]; F.router_w = args.in[17]; F.router_b = args.in[18]; F.w_gu = args.in[19]; F.b_gu = args.in[20]; F.w_dn = args.in[21]; F.b_dn = args.in[22];
    F.out = args.out;
    F.mod = (float*)(ws + WS_MOD); F.topg = (float*)(ws + WS_TOPG); F.topi = (int*)(ws + WS_TOPI); F.list = (int*)(ws + WS_LIST); F.sguw = (bf16_t*)(ws + WS_SGUW);
    F.Wt_in = (bf16_t*)(ws + WS_WIN); F.Wt_out = (bf16_t*)(ws + WS_WOUT); F.Wt_gu = (bf16_t*)(ws + WS_WGU); F.Wt_dn = (bf16_t*)(ws + WS_WDN);
    F.hxc = (bf16_t*)(ws + WS_HXC); F.proj = (bf16_t*)(ws + WS_PROJ); F.mixin = (bf16_t*)(ws + WS_MIXIN); F.y1 = (float*)(ws + WS_Y1); F.h2 = (bf16_t*)(ws + WS_H2);
    F.act = (bf16_t*)(ws + WS_ACT); F.ybuf = (bf16_t*)(ws + WS_YBUF);
    for (int u = F.tid; u < (LDS_BYTES - L_MISC) / 4; u += 512) ((LAS unsigned*)(F.lds + L_MISC))[u] = 0u;
    __syncthreads();
    const int lo = args.ph_lo, hi = args.ph_hi;
    const bool one = (hi - lo) > 1;
    XcdBarrier bar; bar.bar = (unsigned*)(F.ctl + CW_BAR); bar.x = 0; bar.st = nullptr;
    if (one) bar = xcd_barrier_post((unsigned*)(F.ctl + CW_BAR), F.MISC + 8);
#define IN(k) (lo <= (k) && (k) < hi)
#define SEAM(k) do { if (IN(k) && IN((k) + 1)) xcd_barrier(bar); } while (0)
    if (IN(0)) { p_ada(F); p_weights(F); SEAM(0); }
    if (IN(1)) { p_lnmod(F); SEAM(1); }
    if (IN(2)) { PolProj P{F.hxc, F.Wt_in, F.proj, F.G, (int)blockIdx.x}; pg8::gemm_phase<PolProj>(F.lds, P); SEAM(2); }
    if (IN(3)) { at::p_mixer(F); SEAM(3); }
    if (IN(4)) { PolOut P{F.mixin, F.Wt_out, F.x, F.mod, F.y1, F.G, (int)blockIdx.x}; pg8::gemm_phase<PolOut>(F.lds, P); SEAM(4); }
    if (IN(5)) { p_route(F); SEAM(5); }
    if (IN(6)) { const int T = expert_tables(F); ExpTab tb{(const LAS int*)(F.lds + L_TILEE), (const LAS int*)(F.lds + L_TSTART), (const LAS int*)(F.lds + L_TSTART) + 64, T};
        PolGU P{F.h2, F.Wt_gu, F.b_gu, F.list, F.act, tb, F.G, (int)blockIdx.x}; pg8::gemm_phase<PolGU>(F.lds, P); SEAM(6); }
    if (IN(7)) { const int T = expert_tables(F); ExpTab tb{(const LAS int*)(F.lds + L_TILEE), (const LAS int*)(F.lds + L_TSTART), (const LAS int*)(F.lds + L_TSTART) + 64, T};
        PolDN P{F.act, F.Wt_dn, F.b_dn, F.list, F.topg, F.ybuf, tb, F.G, (int)blockIdx.x}; pg8::gemm_phase<PolDN>(F.lds, P); SEAM(7); }
    if (IN(8)) { p_final(F); }
#undef IN
#undef SEAM
}

static inline void launch_forward(void* const* d_in, void* d_out, void* d_ws, hipStream_t stream, int n_launches) {
    static int grid = 0;
    if (grid == 0) {
        int dev = 0, cus = 0;
        if (hipGetDevice(&dev) != hipSuccess || hipDeviceGetAttribute(&cus, hipDeviceAttributeMultiprocessorCount, dev) != hipSuccess) { fprintf(stderr, "kernel_launch: device query failed\n"); grid = -1; return; }
        if (hipFuncSetAttribute((const void*)mk_fwd, hipFuncAttributeMaxDynamicSharedMemorySize, LDS_BYTES) != hipSuccess) { fprintf(stderr, "kernel_launch: hipFuncSetAttribute failed\n"); grid = -1; return; }
        int per_cu = 0;
        if (hipOccupancyMaxActiveBlocksPerMultiprocessor(&per_cu, (const void*)mk_fwd, 512, LDS_BYTES) != hipSuccess || per_cu < 1) fprintf(stderr, "kernel_launch: occupancy query says %d\n", per_cu);
        (void)hipGetLastError();
        grid = cus;
    }
    if (grid < 0) return;
    (void)hipMemsetAsync((char*)d_ws + WS_CTL, 0, CTL_ZERO_BYTES, stream);
    Args a{};
    for (int i = 0; i < 23; ++i) a.in[i] = (const float*)d_in[i];
    a.out = (float*)d_out; a.ws = (unsigned char*)d_ws;
    if (n_launches == 1) { a.ph_lo = 0; a.ph_hi = N_PHASES; hipLaunchKernelGGL(mk_fwd, dim3(grid), dim3(512), LDS_BYTES, stream, a); }
    else for (int p = 0; p < N_PHASES; ++p) { a.ph_lo = p; a.ph_hi = p + 1; hipLaunchKernelGGL(mk_fwd, dim3(grid), dim3(512), LDS_BYTES, stream, a); }
}
}
extern "C" void kernel_launch(void* const* d_in, const int* in_sizes, int n_in, void* d_out, int out_size, void* d_ws, size_t ws_size, hipStream_t stream) {
    if (ws_size < mk::WS_END || n_in != 23) { fprintf(stderr, "kernel_launch: unexpected workspace / inputs (%zu, %d)\n", ws_size, n_in); return; }
    mk::launch_forward(d_in, d_out, d_ws, stream, 1);
}
```

```cpp
#include <hip/hip_runtime.h>
#include <stdint.h>
#include <stdio.h>

#define GAS __attribute__((address_space(1)))
#define LAS __attribute__((address_space(3)))
typedef unsigned short bf16_t;
typedef short bf16x8 __attribute__((ext_vector_type(8)));
typedef float f32x4 __attribute__((ext_vector_type(4)));
typedef float f32x2 __attribute__((ext_vector_type(2)));
typedef unsigned u32x4 __attribute__((ext_vector_type(4)));
typedef unsigned u32x2 __attribute__((ext_vector_type(2)));

namespace mk {
constexpr int D = 1024, NB = 2, S = 8192, M = NB * S, GW = 64, ROWS = 128, CTX = 256, NH = 8, KH = 8, KW = 16;
constexpr int NE = 32, TOPK = 4, DFF = 1024, DIN = 2560, NPAIR = M * TOPK, MX = M + NB * CTX;
constexpr int LCAP = 16384, MAXT = 288, ACT_ROWS = MAXT * 256;
constexpr float EPS = 1e-5f;
constexpr float DN_ALPHA = 1.189207115002721f;
constexpr size_t MiB = 1u << 20;
constexpr size_t WS_CTL = 0, CTL_ZERO_BYTES = 1 * MiB;
constexpr size_t WS_MOD = 1 * MiB;
constexpr size_t WS_TOPG = 2 * MiB;
constexpr size_t WS_TOPI = 2 * MiB + 512 * 1024;
constexpr size_t WS_LIST = 3 * MiB;
constexpr size_t WS_SGUW = 5 * MiB;
constexpr size_t WS_WIN = 6 * MiB;
constexpr size_t WS_WOUT = 11 * MiB;
constexpr size_t WS_WGU = 16 * MiB;
constexpr size_t WS_WDN = 144 * MiB;
constexpr size_t WS_HXC = 208 * MiB;
constexpr size_t WS_PROJ = 241 * MiB;
constexpr size_t WS_MIXIN = 324 * MiB;
constexpr size_t WS_Y1 = 356 * MiB;
constexpr size_t WS_H2 = 420 * MiB;
constexpr size_t WS_ACT = 452 * MiB;
constexpr size_t WS_YBUF = 596 * MiB;
constexpr size_t WS_END = 724 * MiB;
constexpr int CW_BAR = 4096;
constexpr int CW_CNT = 8192;
constexpr int RING_BYTES = 131072;
constexpr int L_MISC = RING_BYTES;
constexpr int L_IDX = L_MISC + 1024;
constexpr int L_TILEE = L_IDX + 3072;
constexpr int L_TSTART = L_TILEE + 1280;
constexpr int L_ROUTE = L_TSTART + 512;
constexpr int L_RPB = L_ROUTE + 256 + 1024;
constexpr int L_WSCR = L_RPB + 2048;
constexpr int LDS_BYTES = 155648;
static_assert(L_WSCR + 8 * 1024 <= LDS_BYTES, "LDS map");

__device__ __forceinline__ float wsum(float v) {
#pragma unroll
    for (int o = 32; o; o >>= 1) v += __shfl_xor(v, o);
    return v;
}
__device__ __forceinline__ float wmax(float v) {
#pragma unroll
    for (int o = 32; o; o >>= 1) v = fmaxf(v, __shfl_xor(v, o));
    return v;
}
__device__ __forceinline__ unsigned f2bf(float f) { unsigned u = __builtin_bit_cast(unsigned, f); return (u + 0x7fffu + ((u >> 16) & 1u)) >> 16; }
__device__ __forceinline__ unsigned pk2(float lo, float hi) { return f2bf(lo) | (f2bf(hi) << 16); }
__device__ __forceinline__ float bf2f(unsigned short b) { return __builtin_bit_cast(float, ((unsigned)b) << 16); }
__device__ __forceinline__ float bflo(unsigned w) { return __builtin_bit_cast(float, w << 16); }
__device__ __forceinline__ float bfhi(unsigned w) { return __builtin_bit_cast(float, w & 0xffff0000u); }
__device__ __forceinline__ unsigned cvt_pk_bf16(float lo, float hi) { unsigned r; asm volatile("v_cvt_pk_bf16_f32 %0, %1, %2" : "=v"(r) : "v"(lo), "v"(hi)); return r; }
__device__ __forceinline__ float gelu_fast(float x) {
    const float c1 = -2.302208198f;
    const float c3 = c1 * 0.044715f;
    const float x2 = x * x;
    const float t = x * (c1 + c3 * x2);
    return x * __builtin_amdgcn_rcpf(1.f + __builtin_amdgcn_exp2f(t));
}

#define XB_TMO      128
#define XB_XCNT(j)  (256  + 64 * (j))
#define XB_XSUB(j)  (1280 + 64 * (j))
#define XB_XGEN(j)  (2304 + 64 * (j))
#define XB_TOP      3328
#define XB_TOPGEN   3392
#define XCD_BAR_WORDS 3456
#define XB_SPIN_CAP (1u << 18)
__device__ __forceinline__ unsigned xb_ld(unsigned* p)              { return __hip_atomic_load(p, __ATOMIC_RELAXED, __HIP_MEMORY_SCOPE_AGENT); }
__device__ __forceinline__ unsigned xb_add(unsigned* p, unsigned v) { return __hip_atomic_fetch_add(p, v, __ATOMIC_RELAXED, __HIP_MEMORY_SCOPE_AGENT); }
__device__ __forceinline__ unsigned xb_xcc_id() { return (unsigned)__builtin_amdgcn_s_getreg((3 << 11) | 20) & 0xFu; }
#define XB_SPIN(cond, bar) do { unsigned _sp = 0; while (cond) { __builtin_amdgcn_s_sleep(1); \
    if ((++_sp & 255u) == 0u) { if (xb_ld(&(bar)[XB_TMO])) break; if (_sp > XB_SPIN_CAP) { atomicAdd(&(bar)[XB_TMO], 1u); break; } } } } while (0)
struct XcdBarrier { unsigned* bar; unsigned x; volatile LAS unsigned* st; };
__device__ __forceinline__ XcdBarrier xcd_barrier_post(unsigned* bar, volatile LAS unsigned* st) {
    XcdBarrier b; b.bar = bar; b.x = xb_xcc_id(); b.st = st;
    if (threadIdx.x == 0) (void)xb_add(&bar[XB_XCNT(b.x)], 1u);
    return b;
}
__device__ __forceinline__ void xcd_barrier_complete(unsigned* bar, unsigned x, unsigned& nloc, unsigned& nx) {
    const unsigned G = gridDim.x * gridDim.y * gridDim.z;
    unsigned sum, cnt, mine, sp = 0u;
    for (;;) {
        sum = 0u; cnt = 0u; mine = 0u;
#pragma unroll
        for (unsigned j = 0; j < 16; ++j) { const unsigned c = xb_ld(&bar[XB_XCNT(j)]); sum += c; cnt += (c > 0u) ? 1u : 0u; mine = (j == x) ? c : mine; }
        if (sum == G) break;
        __builtin_amdgcn_s_sleep(1);
        if ((++sp & 255u) == 0u) { if (xb_ld(&bar[XB_TMO])) break; if (sp > XB_SPIN_CAP) { atomicAdd(&bar[XB_TMO], 1u); break; } }
    }
    nloc = mine > 0u ? mine : 1u; nx = cnt > 0u ? cnt : 1u;
}
__device__ __forceinline__ void xcd_barrier(const XcdBarrier& b) {
    asm volatile("s_waitcnt vmcnt(0)" ::: "memory");
    __syncthreads();
    if (threadIdx.x == 0) {
        unsigned* bar = b.bar;
        __builtin_amdgcn_s_waitcnt(0);
        unsigned nloc = b.st[0], nx = b.st[1];
        if (nloc == 0u) { xcd_barrier_complete(bar, b.x, nloc, nx); b.st[0] = nloc; b.st[1] = nx; }
        const unsigned old = xb_add(&bar[XB_XSUB(b.x)], 1u);
        const unsigned gen = old / nloc;
        if (old + 1u == (gen + 1u) * nloc) {
            __builtin_amdgcn_fence(__ATOMIC_RELEASE, "agent");
            asm volatile("s_waitcnt vmcnt(0)" ::: "memory");
            const unsigned og = xb_add(&bar[XB_TOP], 1u);
            const unsigned tg = og / nx;
            if (og + 1u == (tg + 1u) * nx) xb_add(&bar[XB_TOPGEN], 1u);
            else XB_SPIN(xb_ld(&bar[XB_TOPGEN]) == tg, bar);
            __builtin_amdgcn_fence(__ATOMIC_ACQUIRE, "agent");
            xb_add(&bar[XB_XGEN(b.x)], 1u);
            asm volatile("s_waitcnt vmcnt(0)" ::: "memory");
        } else {
            XB_SPIN(xb_ld(&bar[XB_XGEN(b.x)]) == gen, bar);
            __builtin_amdgcn_fence(__ATOMIC_ACQUIRE, "agent");
            asm volatile("s_waitcnt vmcnt(0)" ::: "memory");
        }
    }
    __syncthreads();
}

struct Frame {
    LAS unsigned char* lds;
    volatile LAS unsigned* MISC;
    unsigned* ctl;
    int tid, lane, wave, vcu, G;
    const float *x, *c, *ctx, *c_ctx, *ada_w, *ada_b, *w_in, *rpb, *sgu_ln_g, *sgu_ln_b, *sgu_w, *sgu_b, *w_out, *ln1_g, *ln1_b, *ln2_g, *ln2_b, *router_w, *router_b, *w_gu, *b_gu, *w_dn, *b_dn;
    float* out;
    float* mod; float* topg; int* topi; int* list; bf16_t* sguw; bf16_t* Wt_in; bf16_t* Wt_out; unsigned char* Wt_gu; unsigned char* Wt_dn;
    bf16_t* hxc; bf16_t* proj; bf16_t* mixin; float* y1; unsigned char* h2; unsigned char* act; bf16_t* ybuf;
};
#define LDS_WAIT() asm volatile("s_waitcnt lgkmcnt(0)" ::: "memory")
#define VM_WAIT() asm volatile("s_waitcnt vmcnt(0)" ::: "memory")

namespace pg8 {
constexpr int BM = 256, BK = 64, HALF = 128, HTB = HALF * BK * 2, STAGE_BYTES = 8 * HTB, NXCD = 8, WGM = 8, KD = 1024, NKT = KD / BK;
__device__ __forceinline__ int lds_byte(int r, int c) { const int st = (r >> 4) * 2 + (c >> 5), rr = r & 15, cc = c & 31, ob = rr * 64 + cc * 2; return st * 1024 + (ob ^ (((ob >> 9) & 1) << 5)); }
__device__ __forceinline__ void stage_rc(int b, int& R, int& C) { const int st = b / 1024, sb = b % 1024, swz = sb ^ (((sb >> 9) & 1) << 5); R = (st >> 1) * 16 + swz / 64; C = (st & 1) * 32 + (swz % 64) / 2; }
__device__ __forceinline__ int perm32(int rho) { const int n = rho >> 4, i = rho & 15; return 8 * (i >> 2) + 4 * n + (i & 3); }
struct Unit { int pm, pn, e, nvalid, ti; };
__device__ __forceinline__ void static_tile(int L, int nM, int nN, int& pm, int& pn) {
    const int nwg = nM * nN; int wgid = L;
    { const int q = nwg / NXCD, r = nwg % NXCD, xcd = wgid % NXCD, off = wgid / NXCD; wgid = (xcd < r ? xcd * (q + 1) : r * (q + 1) + (xcd - r) * q) + off; }
    const int nig = WGM * nN, gid = wgid / nig, fm = gid * WGM, gsz = (nM - fm) < WGM ? (nM - fm) : WGM;
    pm = fm + ((wgid % nig) % gsz); pn = (wgid % nig) / gsz;
}

typedef int v8i __attribute__((ext_vector_type(8)));
template <bool FP8> struct Frags;
template <> struct Frags<false> { bf16x8 At[4][2], B0[2][2], B1[2][2]; };
template <> struct Frags<true> { v8i At[4], B0[2], B1[2]; };
template <class P>
__device__ __forceinline__ void gemm_phase(LAS unsigned char* lds, const P& pol) {
    const int tid = threadIdx.x, wid = __builtin_amdgcn_readfirstlane(tid >> 6), lane = tid & 63, wr = wid >> 2, wc = wid & 3, fr = lane & 15, fq = lane >> 4;
    constexpr int KDB = P::FP8 ? 1024 : 2048, NKT_ = KDB / 128;
    unsigned voffB[2];
#pragma unroll
    for (int i = 0; i < 2; ++i) { int R, C; stage_rc(tid * 16 + i * 8192, R, C); const int Rb = P::PERM ? ((R & ~31) + perm32(R & 31)) : R;
        voffB[i] = (unsigned)(Rb * KDB + C * 2); }
    const size_t kstep = (size_t)(BK * 2);
    const size_t hstep = (size_t)HALF * KDB;
    const unsigned ldsw = (unsigned)wid * 1024u;
    const int aoff = lds_byte(wr * 64 + fr, fq * 8), boff = lds_byte(wc * 32 + fr, fq * 8);
#define PG8_SA(b, h) (((b) * 2 + (h)) * HTB)
#define PG8_SB(b, h) ((4 + (b) * 2 + (h)) * HTB)
#define PG8_STAGE(bufoff, gbase, voff) do { _Pragma("unroll") for (int _i = 0; _i < 2; ++_i) \
        __builtin_amdgcn_global_load_lds((const unsigned*)((const char*)(gbase) + (voff)[_i]), (LAS unsigned*)(lds + (bufoff) + ldsw + _i * 8192), 16, 0, 0); } while (0)
#define PG8_RD8(p) __builtin_shufflevector(*(const LAS u32x4*)(p), *(const LAS u32x4*)((p) + 1024), 0, 1, 2, 3, 4, 5, 6, 7)
#define PG8_LDA(dst, b, h) do { if constexpr (P::FP8) { _Pragma("unroll") for (int m = 0; m < 4; ++m) fg.dst[m] = __builtin_bit_cast(v8i, PG8_RD8(lds + PG8_SA(b, h) + aoff + m * 2048)); } \
        else { _Pragma("unroll") for (int m = 0; m < 4; ++m) _Pragma("unroll") for (int k = 0; k < 2; ++k) fg.dst[m][k] = *(const LAS bf16x8*)(lds + PG8_SA(b, h) + aoff + m * 2048 + k * 1024); } } while (0)
#define PG8_LDB(dst, b, h) do { if constexpr (P::FP8) { _Pragma("unroll") for (int n = 0; n < 2; ++n) fg.dst[n] = __builtin_bit_cast(v8i, PG8_RD8(lds + PG8_SB(b, h) + boff + n * 2048)); } \
        else { _Pragma("unroll") for (int n = 0; n < 2; ++n) _Pragma("unroll") for (int k = 0; k < 2; ++k) fg.dst[n][k] = *(const LAS bf16x8*)(lds + PG8_SB(b, h) + boff + n * 2048 + k * 1024); } } while (0)
#define PG8_MMA(ai, bj, At, Bt) do { __builtin_amdgcn_s_setprio(1); \
        if constexpr (P::FP8) { _Pragma("unroll") for (int m = 0; m < 4; ++m) _Pragma("unroll") for (int n = 0; n < 2; ++n) \
            acc[ai][bj][m][n] = __builtin_amdgcn_mfma_scale_f32_16x16x128_f8f6f4(fg.Bt[n], fg.At[m], acc[ai][bj][m][n], 0, 0, 0, P::SCALE_W, 0, 0x7f7f7f7f); } \
        else { _Pragma("unroll") for (int m = 0; m < 4; ++m) _Pragma("unroll") for (int n = 0; n < 2; ++n) _Pragma("unroll") for (int k = 0; k < 2; ++k) \
            acc[ai][bj][m][n] = __builtin_amdgcn_mfma_f32_16x16x32_bf16(fg.Bt[n][k], fg.At[m][k], acc[ai][bj][m][n], 0, 0, 0); } \
        __builtin_amdgcn_s_setprio(0); } while (0)
#define PG8_WAIT_V(n) asm volatile("s_waitcnt vmcnt(" #n ")" ::: "memory")
#define PG8_WAIT_L(n) asm volatile("s_waitcnt lgkmcnt(" #n ")" ::: "memory")
#define PG8_BAR __builtin_amdgcn_s_barrier()
#define PG8_SCHED __builtin_amdgcn_sched_barrier(0)
    Unit cur, nxt; int ui = 0;
    if (!pol.next(0, cur)) return;
    f32x4 acc[2][2][4][2];
#pragma unroll
    for (int a = 0; a < 2; ++a)
#pragma unroll
        for (int b = 0; b < 2; ++b)
#pragma unroll
            for (int m = 0; m < 4; ++m)
#pragma unroll
                for (int n = 0; n < 2; ++n) acc[a][b][m][n] = (f32x4){0.f, 0.f, 0.f, 0.f};
    Frags<P::FP8> fg;
    int slot = 0;
    if (P::META) { pol.meta_issue(cur, 0, lds, wid, lane); PG8_WAIT_V(0); asm volatile("" ::: "memory"); PG8_BAR; asm volatile("" ::: "memory"); }
    unsigned aC[2][2];
    pol.a_off(cur, 0, lds, aC);
    const char* const Ab = (const char*)pol.A;
    const char* cB = pol.b_ptr(cur);
    PG8_STAGE(PG8_SB(0, 0), cB, voffB); PG8_STAGE(PG8_SB(0, 1), cB + hstep, voffB); PG8_STAGE(PG8_SA(0, 0), Ab, aC[0]); PG8_STAGE(PG8_SA(0, 1), Ab, aC[1]);
    if (wr == 1) PG8_BAR;
    PG8_WAIT_V(2); PG8_BAR;
    PG8_STAGE(PG8_SB(1, 0), cB + kstep, voffB); PG8_STAGE(PG8_SA(1, 0), Ab + kstep, aC[0]); PG8_STAGE(PG8_SB(1, 1), cB + hstep + kstep, voffB);
    PG8_WAIT_V(6); PG8_BAR;
    for (;;) {
        const bool has_next = pol.next(ui + 1, nxt);
        const int nslot = slot == 2 ? 0 : slot + 1;
        if (P::META) { if (has_next) pol.meta_issue(nxt, nslot, lds, wid, lane); }
        const char* nB = has_next ? pol.b_ptr(nxt) : cB;
#pragma unroll 1
        for (int t = 0; t < NKT_; t += 2) {
            const bool last = (t == NKT_ - 2);
            const char* a1 = Ab + (size_t)(t + 1) * kstep;
            const char* a2 = last ? Ab : Ab + (size_t)(t + 2) * kstep; const char* b2 = last ? nB : cB + (size_t)(t + 2) * kstep;
            const char* a3 = a2 + kstep; const char* b3 = b2 + kstep;
            PG8_LDB(B0, 0, 0); PG8_LDB(B1, 0, 1); PG8_SCHED; PG8_LDA(At, 0, 0); PG8_STAGE(PG8_SA(1, 1), a1, aC[1]);
            if (last && has_next) pol.a_off(nxt, nslot, lds, aC);
            PG8_WAIT_V(8); PG8_WAIT_L(0); PG8_BAR; PG8_MMA(0, 0, At, B0); PG8_MMA(0, 1, At, B1); PG8_BAR; PG8_SCHED;
            PG8_LDA(At, 0, 1); PG8_STAGE(PG8_SB(0, 0), b2, voffB); PG8_STAGE(PG8_SB(0, 1), b2 + hstep, voffB); PG8_STAGE(PG8_SA(0, 0), a2, aC[0]);
            PG8_WAIT_V(8); PG8_WAIT_L(0); PG8_BAR; PG8_MMA(1, 0, At, B0); PG8_MMA(1, 1, At, B1); PG8_BAR; PG8_SCHED;
            PG8_LDB(B0, 1, 0); PG8_LDB(B1, 1, 1); PG8_SCHED; PG8_LDA(At, 1, 0); PG8_STAGE(PG8_SA(0, 1), a2, aC[1]);
            PG8_WAIT_V(8); PG8_WAIT_L(0); PG8_BAR; PG8_MMA(0, 0, At, B0); PG8_MMA(0, 1, At, B1); PG8_BAR; PG8_SCHED;
            PG8_LDA(At, 1, 1); PG8_STAGE(PG8_SB(1, 0), b3, voffB); PG8_STAGE(PG8_SB(1, 1), b3 + hstep, voffB); PG8_STAGE(PG8_SA(1, 0), a3, aC[0]);
            PG8_WAIT_V(8); PG8_WAIT_L(0); PG8_BAR; PG8_MMA(1, 0, At, B0); PG8_MMA(1, 1, At, B1); PG8_BAR; PG8_SCHED;
        }
        if (wr == 0) PG8_BAR;
        pol.epi(acc, cur, slot, lds, wr, wc, fr, fq);
        if (!has_next) break;
#pragma unroll
        for (int a = 0; a < 2; ++a)
#pragma unroll
            for (int b = 0; b < 2; ++b)
#pragma unroll
                for (int m = 0; m < 4; ++m)
#pragma unroll
                    for (int n = 0; n < 2; ++n) acc[a][b][m][n] = (f32x4){0.f, 0.f, 0.f, 0.f};
        cur = nxt; cB = nB; ++ui; slot = nslot;
        if (wr == 1) PG8_BAR;
    }
    PG8_WAIT_V(0);
    PG8_BAR;
#undef PG8_SA
#undef PG8_SB
#undef PG8_STAGE
#undef PG8_LDA
#undef PG8_LDB
#undef PG8_MMA
#undef PG8_RD8
#undef PG8_WAIT_V
#undef PG8_WAIT_L
#undef PG8_BAR
#undef PG8_SCHED
}
}

typedef f32x4 AccT[2][2][4][2];

struct PolProj {
    static constexpr bool PERM = true, META = false, FP8 = false; static constexpr int SCALE_W = 0x7f7f7f7f;
    const bf16_t* A; const bf16_t* Bt; bf16_t* O; int G, c;
    __device__ __forceinline__ bool next(int i, pg8::Unit& u) const {
        const int L = i * G + c;
        if (L < 640) { pg8::static_tile(L, 64, 10, u.pm, u.pn); return true; }
        if (L < 648) { const int j = L - 640; u.pm = 64 + (j >> 2); u.pn = 2 + (j & 3); return true; }
        return false;
    }
    __device__ __forceinline__ const char* b_ptr(const pg8::Unit& u) const { return (const char*)Bt + (size_t)u.pn * 256 * 1024 * 2; }
    __device__ __forceinline__ void meta_issue(const pg8::Unit&, int, LAS unsigned char*, int, int) const {}
    __device__ __forceinline__ void a_off(const pg8::Unit& u, int, LAS unsigned char*, unsigned (&o)[2][2]) const {
        int Ra[2], Ca[2]; pg8::stage_rc((int)threadIdx.x * 16, Ra[0], Ca[0]); pg8::stage_rc((int)threadIdx.x * 16 + 8192, Ra[1], Ca[1]);
#pragma unroll
        for (int h = 0; h < 2; ++h)
#pragma unroll
            for (int i = 0; i < 2; ++i) o[h][i] = (unsigned)((u.pm * 256 + 128 * h + Ra[i]) * 1024 + Ca[i]) * 2u;
    }
    __device__ __forceinline__ void epi(const AccT& acc, const pg8::Unit& u, int, LAS unsigned char*, int wr, int wc, int fr, int fq) const {
        const int row0 = u.pm * 256 + wr * 64 + fr, col0 = u.pn * 256 + wc * 32 + 8 * fq;
        const bool act = u.pn >= 6;
#pragma unroll
        for (int ai = 0; ai < 2; ++ai)
#pragma unroll
            for (int m = 0; m < 4; ++m) { bf16_t* rowp = O + (size_t)(row0 + ai * 128 + m * 16) * DIN + col0;
#pragma unroll
                for (int bj = 0; bj < 2; ++bj) { f32x4 v0 = acc[ai][bj][m][0], v1 = acc[ai][bj][m][1];
                    if (act) {
#pragma unroll
                        for (int j = 0; j < 4; ++j) { v0[j] = gelu_fast(v0[j]); v1[j] = gelu_fast(v1[j]); } }
                    u32x4 w; w.x = cvt_pk_bf16(v0[0], v0[1]); w.y = cvt_pk_bf16(v0[2], v0[3]); w.z = cvt_pk_bf16(v1[0], v1[1]); w.w = cvt_pk_bf16(v1[2], v1[3]);
                    *(u32x4*)(rowp + bj * 128) = w; } }
    }
};

struct PolOut {
    static constexpr bool PERM = false, META = false, FP8 = false; static constexpr int SCALE_W = 0x7f7f7f7f;
    const bf16_t* A; const bf16_t* Bt; const float* x; const float* mod; float* Y; int G, c;
    __device__ __forceinline__ bool next(int i, pg8::Unit& u) const { const int L = i * G + c; if (L >= 256) return false; pg8::static_tile(L, 64, 4, u.pm, u.pn); return true; }
    __device__ __forceinline__ const char* b_ptr(const pg8::Unit& u) const { return (const char*)Bt + (size_t)u.pn * 256 * 1024 * 2; }
    __device__ __forceinline__ void meta_issue(const pg8::Unit&, int, LAS unsigned char*, int, int) const {}
    __device__ __forceinline__ void a_off(const pg8::Unit& u, int, LAS unsigned char*, unsigned (&o)[2][2]) const {
        int Ra[2], Ca[2]; pg8::stage_rc((int)threadIdx.x * 16, Ra[0], Ca[0]); pg8::stage_rc((int)threadIdx.x * 16 + 8192, Ra[1], Ca[1]);
#pragma unroll
        for (int h = 0; h < 2; ++h)
#pragma unroll
            for (int i = 0; i < 2; ++i) o[h][i] = (unsigned)((u.pm * 256 + 128 * h + Ra[i]) * 1024 + Ca[i]) * 2u;
    }
    __device__ __forceinline__ void epi(const AccT& acc, const pg8::Unit& u, int, LAS unsigned char*, int wr, int wc, int fr, int fq) const {
        const int row0 = u.pm * 256 + wr * 64 + fr, col0 = u.pn * 256 + wc * 32 + 4 * fq;
        const float* g1 = mod + (u.pm >= 32 ? 6144 : 0) + 2 * 1024;
        f32x4 gv[2][2];
#pragma unroll
        for (int bj = 0; bj < 2; ++bj)
#pragma unroll
            for (int n = 0; n < 2; ++n) gv[bj][n] = *(const f32x4*)(g1 + col0 + bj * 128 + n * 16);
#pragma unroll
        for (int ai = 0; ai < 2; ++ai)
#pragma unroll
            for (int m = 0; m < 4; ++m) { const size_t off = (size_t)(row0 + ai * 128 + m * 16) * D + col0;
#pragma unroll
                for (int bj = 0; bj < 2; ++bj)
#pragma unroll
                    for (int n = 0; n < 2; ++n) { const f32x4 xv = *(const f32x4*)(x + off + bj * 128 + n * 16);
                        *(f32x4*)(Y + off + bj * 128 + n * 16) = xv * DN_ALPHA + gv[bj][n] * acc[ai][bj][m][n]; }
                asm volatile("" ::: "memory"); }
    }
};

struct ExpTab { const LAS int* tile_e; const LAS int* tstart; const LAS int* cnt; int T; };
__device__ __forceinline__ int expert_tables(Frame& F) {
    LAS int* tile_e = (LAS int*)(F.lds + L_TILEE); LAS int* tstart = (LAS int*)(F.lds + L_TSTART); LAS int* cn = tstart + 64;
    if (F.tid < 32) cn[F.tid] = (int)__hip_atomic_load(F.ctl + CW_CNT + 32 * F.tid, __ATOMIC_RELAXED, __HIP_MEMORY_SCOPE_AGENT);
    __syncthreads();
    if (F.tid == 0) { int run = 0; for (int e = 0; e < NE; ++e) { tstart[e] = run; run += (cn[e] + 255) >> 8; } tstart[NE] = run; }
    __syncthreads();
    const int T = tstart[NE];
    if (F.tid < MAXT && F.tid < T) { int e = 0; while (e < NE - 1 && tstart[e + 1] <= F.tid) ++e; tile_e[F.tid] = e; }
    __syncthreads();
    return T < MAXT ? T : MAXT;
}
__device__ __forceinline__ int rfl(int v) { return __builtin_amdgcn_readfirstlane(v); }

struct PolGU {
    static constexpr bool PERM = true, META = true, FP8 = true; static constexpr int SCALE_W = 0x79797979;
    const unsigned char* A; const unsigned char* Bt; const float* bias; const int* list; unsigned char* O; ExpTab tb; int G, c;
    __device__ __forceinline__ bool next(int i, pg8::Unit& u) const {
        const int L = i * G + c; if (L >= tb.T * 8) return false;
        u.ti = L >> 3; u.pn = L & 7; u.e = rfl(tb.tile_e[u.ti]); u.pm = u.ti - rfl(tb.tstart[u.e]);
        const int rem = rfl(tb.cnt[u.e]) - u.pm * 256; u.nvalid = rem < 256 ? rem : 256; return true;
    }
    __device__ __forceinline__ const char* b_ptr(const pg8::Unit& u) const { return (const char*)Bt + ((size_t)u.e * 2048 + (size_t)u.pn * 256) * 1024; }
    __device__ __forceinline__ void meta_issue(const pg8::Unit& u, int slot, LAS unsigned char* lds, int wid, int lane) const {
        if (wid < 4) __builtin_amdgcn_global_load_lds((const unsigned*)(list + (size_t)u.e * LCAP + u.pm * 256 + wid * 64 + lane), (LAS unsigned*)(lds + L_IDX + slot * 1024 + wid * 256), 4, 0, 0);
    }
    __device__ __forceinline__ void a_off(const pg8::Unit& u, int slot, LAS unsigned char* lds, unsigned (&o)[2][2]) const {
        int Ra[2], Ca[2]; pg8::stage_rc((int)threadIdx.x * 16, Ra[0], Ca[0]); pg8::stage_rc((int)threadIdx.x * 16 + 8192, Ra[1], Ca[1]);
        const LAS int* idx = (const LAS int*)(lds + L_IDX + slot * 1024);
#pragma unroll
        for (int h = 0; h < 2; ++h)
#pragma unroll
            for (int i = 0; i < 2; ++i) { const int r = 128 * h + Ra[i]; int pr = idx[r]; pr = r < u.nvalid ? pr : 0; o[h][i] = (unsigned)((pr >> 2) * 1024 + Ca[i] * 2); }
    }
    __device__ __forceinline__ void epi(const AccT& acc, const pg8::Unit& u, int, LAS unsigned char*, int wr, int wc, int fr, int fq) const {
        const int row0 = u.ti * 256 + wr * 64 + fr, col0 = u.pn * 128 + wc * 32 + 8 * fq;
        const float* bg = bias + (size_t)u.e * 2048 + col0;
        const f32x4 g0 = *(const f32x4*)(bg), g1 = *(const f32x4*)(bg + 4), l0 = *(const f32x4*)(bg + 1024), l1 = *(const f32x4*)(bg + 1028);
#pragma unroll
        for (int ai = 0; ai < 2; ++ai)
#pragma unroll
            for (int m = 0; m < 4; ++m) {
                f32x4 a0 = acc[ai][0][m][0] + g0, a1 = acc[ai][0][m][1] + g1, b0 = acc[ai][1][m][0] + l0, b1 = acc[ai][1][m][1] + l1, r0, r1;
#pragma unroll
                for (int j = 0; j < 4; ++j) {
                    { const float g = fminf(a0[j], 7.f), l = fminf(fmaxf(b0[j], -7.f), 7.f); r0[j] = (l + 1.f) * g * __builtin_amdgcn_rcpf(1.f + __builtin_amdgcn_exp2f(-2.45546696f * g)); }
                    { const float g = fminf(a1[j], 7.f), l = fminf(fmaxf(b1[j], -7.f), 7.f); r1[j] = (l + 1.f) * g * __builtin_amdgcn_rcpf(1.f + __builtin_amdgcn_exp2f(-2.45546696f * g)); }
                }
                u32x2 w; w.x = (unsigned)__builtin_amdgcn_cvt_pk_fp8_f32(r0[2], r0[3], __builtin_amdgcn_cvt_pk_fp8_f32(r0[0], r0[1], 0, false), true);
                w.y = (unsigned)__builtin_amdgcn_cvt_pk_fp8_f32(r1[2], r1[3], __builtin_amdgcn_cvt_pk_fp8_f32(r1[0], r1[1], 0, false), true);
                *(u32x2*)(O + (size_t)(row0 + ai * 128 + m * 16) * DFF + col0) = w; }
    }
};

struct PolDN {
    static constexpr bool PERM = true, META = true, FP8 = true; static constexpr int SCALE_W = 0x79797979;
    const unsigned char* A; const unsigned char* Bt; const float* bias; const int* list; const float* topg; bf16_t* O; ExpTab tb; int G, c;
    __device__ __forceinline__ bool next(int i, pg8::Unit& u) const {
        const int L = i * G + c; if (L >= tb.T * 4) return false;
        u.ti = L >> 2; u.pn = L & 3; u.e = rfl(tb.tile_e[u.ti]); u.pm = u.ti - rfl(tb.tstart[u.e]);
        const int rem = rfl(tb.cnt[u.e]) - u.pm * 256; u.nvalid = rem < 256 ? rem : 256; return true;
    }
    __device__ __forceinline__ const char* b_ptr(const pg8::Unit& u) const { return (const char*)Bt + ((size_t)u.e * 1024 + (size_t)u.pn * 256) * 1024; }
    __device__ __forceinline__ void meta_issue(const pg8::Unit& u, int slot, LAS unsigned char* lds, int wid, int lane) const {
        if (wid < 4) __builtin_amdgcn_global_load_lds((const unsigned*)(list + (size_t)u.e * LCAP + u.pm * 256 + wid * 64 + lane), (LAS unsigned*)(lds + L_IDX + slot * 1024 + wid * 256), 4, 0, 0);
    }
    __device__ __forceinline__ void a_off(const pg8::Unit& u, int, LAS unsigned char*, unsigned (&o)[2][2]) const {
        int Ra[2], Ca[2]; pg8::stage_rc((int)threadIdx.x * 16, Ra[0], Ca[0]); pg8::stage_rc((int)threadIdx.x * 16 + 8192, Ra[1], Ca[1]);
#pragma unroll
        for (int h = 0; h < 2; ++h)
#pragma unroll
            for (int i = 0; i < 2; ++i) o[h][i] = (unsigned)((u.ti * 256 + 128 * h + Ra[i]) * 1024 + Ca[i] * 2);
    }
    __device__ __forceinline__ void epi(const AccT& acc, const pg8::Unit& u, int slot, LAS unsigned char* lds, int wr, int wc, int fr, int fq) const {
        const LAS int* idx = (const LAS int*)(lds + L_IDX + slot * 1024);
        const int col0 = u.pn * 256 + wc * 32 + 8 * fq;
        const float* bd = bias + (size_t)u.e * 1024 + col0;
        f32x4 bv[2][2];
#pragma unroll
        for (int bj = 0; bj < 2; ++bj)
#pragma unroll
            for (int n = 0; n < 2; ++n) bv[bj][n] = *(const f32x4*)(bd + bj * 128 + 4 * n);
#pragma unroll
        for (int ai = 0; ai < 2; ++ai)
#pragma unroll
            for (int m = 0; m < 4; ++m) { const int r = ai * 128 + wr * 64 + m * 16 + fr;
                if (r < u.nvalid) { const int pr = idx[r]; const float gt = topg[pr]; bf16_t* rowp = O + (size_t)pr * D + col0;
#pragma unroll
                    for (int bj = 0; bj < 2; ++bj) { const f32x4 v0 = (acc[ai][bj][m][0] + bv[bj][0]) * gt, v1 = (acc[ai][bj][m][1] + bv[bj][1]) * gt;
                        u32x4 w; w.x = cvt_pk_bf16(v0[0], v0[1]); w.y = cvt_pk_bf16(v0[2], v0[3]); w.z = cvt_pk_bf16(v1[0], v1[1]); w.w = cvt_pk_bf16(v1[2], v1[3]);
                        *(u32x4*)(rowp + bj * 128) = w; } } }
    }
};

__device__ __forceinline__ void p_ada(Frame& F) {
    LAS float* sl = (LAS float*)F.lds;
    LAS float* red = sl + 3072;
    for (int i = F.tid; i < 3072; i += 512) { const int w = i >> 10, k = i & 1023; const float v = w < 2 ? F.c[w * D + k] : F.c_ctx[k]; sl[i] = v / (1.f + __expf(-v)); }
    __syncthreads();
    for (int slab = blockIdx.x; slab < 256; slab += F.G) {
        const int j0 = slab * 24, cg = F.tid % 6, kr = F.tid / 6;
        float a[3][4] = {};
        if (F.tid < 480) {
            for (int k = kr; k < D; k += 80) {
                const f32x4 w4 = *(const f32x4*)(F.ada_w + (size_t)k * 6144 + j0 + 4 * cg);
                const float s0 = sl[k], s1 = sl[1024 + k], s2 = sl[2048 + k];
#pragma unroll
                for (int q = 0; q < 4; ++q) { a[0][q] += s0 * w4[q]; a[1][q] += s1 * w4[q]; a[2][q] += s2 * w4[q]; }
            }
#pragma unroll
            for (int w = 0; w < 3; ++w)
#pragma unroll
                for (int q = 0; q < 4; ++q) red[kr * 72 + cg * 12 + w * 4 + q] = a[w][q];
        }
        __syncthreads();
        if (F.tid < 72) {
            float s = 0.f;
            for (int r = 0; r < 80; ++r) s += red[r * 72 + F.tid];
            const int g = F.tid / 12, w = (F.tid % 12) >> 2, q = F.tid & 3, col = j0 + 4 * g + q;
            F.mod[w * 6144 + col] = s + F.ada_b[col];
        }
        __syncthreads();
    }
}

__device__ __forceinline__ void transpose_item(const float* W, int K, int N, bf16_t* WT, int item, bool gu_map, LAS float* scr, int lane) {
    const int nblk = N / 32, kb = item / nblk, nb = item % nblk, k0 = 64 * kb, n0 = 32 * nb;
#pragma unroll 8
    for (int i = 0; i < 32; ++i) { const int kk = 2 * i + (lane >> 5); scr[kk * 33 + (lane & 31)] = W[(size_t)(k0 + kk) * N + n0 + (lane & 31)]; }
    LDS_WAIT(); asm volatile("" ::: "memory");
    int d0 = n0;
    if (gu_map) { const int nn = n0 & 1023; d0 = (nn >> 7) * 256 + (nn & 127) + ((n0 >> 10) ? 128 : 0); }
    const int c = lane & 7;
#pragma unroll
    for (int j = 0; j < 4; ++j) { const int n = (lane >> 3) + 8 * j; const LAS float* s = scr + (8 * c) * 33 + n;
        u32x4 o; o.x = pk2(s[0 * 33], s[1 * 33]); o.y = pk2(s[2 * 33], s[3 * 33]); o.z = pk2(s[4 * 33], s[5 * 33]); o.w = pk2(s[6 * 33], s[7 * 33]);
        *(u32x4*)(WT + (size_t)(d0 + n) * K + k0 + 8 * c) = o; }
    LDS_WAIT(); asm volatile("" ::: "memory");
}
__device__ __forceinline__ unsigned pk4_fp8(float a, float b, float c, float d) { return (unsigned)__builtin_amdgcn_cvt_pk_fp8_f32(c, d, __builtin_amdgcn_cvt_pk_fp8_f32(a, b, 0, false), true); }
__device__ __forceinline__ void transpose_item8(const float* W, int K, int N, unsigned char* WT, int item, bool gu_map, LAS float* scr, int lane) {
    const int nblk = N / 32, kb = item / nblk, nb = item % nblk, k0 = 64 * kb, n0 = 32 * nb;
#pragma unroll 8
    for (int i = 0; i < 32; ++i) { const int kk = 2 * i + (lane >> 5); scr[kk * 33 + (lane & 31)] = W[(size_t)(k0 + kk) * N + n0 + (lane & 31)]; }
    LDS_WAIT(); asm volatile("" ::: "memory");
    int d0 = n0;
    if (gu_map) { const int nn = n0 & 1023; d0 = (nn >> 7) * 256 + (nn & 127) + ((n0 >> 10) ? 128 : 0); }
    const int c = lane & 7;
#pragma unroll
    for (int j = 0; j < 4; ++j) { const int n = (lane >> 3) + 8 * j; const LAS float* s = scr + (8 * c) * 33 + n;
        u32x2 o; o.x = pk4_fp8(s[0 * 33] * 64.f, s[1 * 33] * 64.f, s[2 * 33] * 64.f, s[3 * 33] * 64.f); o.y = pk4_fp8(s[4 * 33] * 64.f, s[5 * 33] * 64.f, s[6 * 33] * 64.f, s[7 * 33] * 64.f);
        *(u32x2*)(WT + (size_t)(d0 + n) * K + k0 + 8 * c) = o; }
    LDS_WAIT(); asm volatile("" ::: "memory");
}
__device__ __forceinline__ void p_weights(Frame& F) {
    LAS float* scr = (LAS float*)(F.lds + F.wave * 16384);
    const int gw = F.vcu * 8 + F.wave, NGW = F.G * 8;
    constexpr int I_IN = 16 * 80, I_OUT = 16 * 32, I_GU = 16 * 64, I_DN = 16 * 32;
    constexpr int NITEMS = I_IN + I_OUT + NE * I_GU + NE * I_DN;
    for (int it = gw; it < NITEMS; it += NGW) {
        int r = it;
        if (r < I_IN) { transpose_item(F.w_in, D, DIN, F.Wt_in, r, false, scr, F.lane); continue; } r -= I_IN;
        if (r < I_OUT) { transpose_item(F.w_out, D, D, F.Wt_out, r, false, scr, F.lane); continue; } r -= I_OUT;
        if (r < NE * I_GU) { const int e = r / I_GU; transpose_item8(F.w_gu + (size_t)e * D * 2048, D, 2048, F.Wt_gu + (size_t)e * 2048 * D, r % I_GU, true, scr, F.lane); continue; } r -= NE * I_GU;
        { const int e = r / I_DN; transpose_item8(F.w_dn + (size_t)e * DFF * D, DFF, D, F.Wt_dn + (size_t)e * D * DFF, r % I_DN, false, scr, F.lane); }
    }
    for (int i = (blockIdx.x * 512 + F.tid) * 4; i < 4 * 128 * 128; i += F.G * 512 * 4) {
        const f32x4 v = *(const f32x4*)(F.sgu_w + i); u32x2 o; o.x = pk2(v[0], v[1]); o.y = pk2(v[2], v[3]); *(u32x2*)(F.sguw + i) = o; }
}
__device__ __forceinline__ void p_lnmod(Frame& F) {
    const int gw = F.vcu * 8 + F.wave, NGW = F.G * 8;
    for (int row = gw; row < MX; row += NGW) {
        const float* xr; const float* md;
        if (row < M) { xr = F.x + (size_t)row * D; md = F.mod + (row >> 13) * 6144; } else { xr = F.ctx + (size_t)(row - M) * D; md = F.mod + 2 * 6144; }
        const f32x4* xp = (const f32x4*)xr + F.lane;
        f32x4 v[4]; float s = 0.f;
#pragma unroll
        for (int j = 0; j < 4; ++j) { v[j] = xp[64 * j]; s += (v[j][0] + v[j][1]) + (v[j][2] + v[j][3]); }
        const float mean = wsum(s) * (1.f / D); float q = 0.f;
#pragma unroll
        for (int j = 0; j < 4; ++j) { v[j] = v[j] - mean; q += (v[j][0] * v[j][0] + v[j][1] * v[j][1]) + (v[j][2] * v[j][2] + v[j][3] * v[j][3]); }
        const float rstd = rsqrtf(wsum(q) * (1.f / D) + EPS);
        u32x2* op = (u32x2*)(F.hxc + (size_t)row * D) + F.lane;
#pragma unroll
        for (int j = 0; j < 4; ++j) { const f32x4 sh = *((const f32x4*)md + F.lane + 64 * j), sc = *((const f32x4*)(md + 1024) + F.lane + 64 * j);
            const f32x4 o = v[j] * rstd * (sc + 1.f) + sh; u32x2 w; w.x = pk2(o[0], o[1]); w.y = pk2(o[2], o[3]); op[64 * j] = w; }
    }
}

__device__ __forceinline__ void p_attn_simple(Frame& F) {
    LAS float* sq = (LAS float*)(F.lds + F.wave * 4096);
    LAS float* sp = sq + 64;
    const int gw = F.vcu * 8 + F.wave, NGW = F.G * 8;
    for (int gid = gw; gid < M * NH; gid += NGW) {
        const int h = gid & 7, tok = gid >> 3, b = tok >> 13, t = tok & (S - 1), r = t >> 6, c = t & 63;
        const int rs = min(max(r - KH / 2, 0), ROWS - KH), cs = min(max(c - KW / 2, 0), GW - KW);
        sq[F.lane] = bf2f(F.proj[(size_t)tok * DIN + h * 64 + F.lane]);
        LDS_WAIT(); asm volatile("" ::: "memory");
        float sc[6]; float mx = -1e30f;
#pragma unroll
        for (int i = 0; i < 6; ++i) {
            const int kk = F.lane + 64 * i;
            const bf16_t* kp; float bias = 0.f;
            if (kk < 128) { const int ki = kk >> 4, kj = kk & 15;
                kp = F.proj + (size_t)(b * S + (rs + ki) * GW + cs + kj) * DIN + 512 + h * 64;
                bias = F.rpb[(h * 15 + (rs + ki - r + 7)) * 31 + (cs + kj - c + 15)];
            } else kp = F.proj + (size_t)(M + b * CTX + (kk - 128)) * DIN + 512 + h * 64;
            float d = 0.f;
#pragma unroll
            for (int dd = 0; dd < 64; dd += 8) { const u32x4 kv = *(const u32x4*)(kp + dd);
                d += sq[dd] * bflo(kv.x) + sq[dd + 1] * bfhi(kv.x) + sq[dd + 2] * bflo(kv.y) + sq[dd + 3] * bfhi(kv.y) + sq[dd + 4] * bflo(kv.z) + sq[dd + 5] * bfhi(kv.z) + sq[dd + 6] * bflo(kv.w) + sq[dd + 7] * bfhi(kv.w); }
            sc[i] = d * 0.125f + bias; mx = fmaxf(mx, sc[i]);
        }
        mx = wmax(mx);
        float sum = 0.f;
#pragma unroll
        for (int i = 0; i < 6; ++i) { const float p = __expf(sc[i] - mx); sum += p; sp[F.lane + 64 * i] = p; }
        sum = wsum(sum);
        LDS_WAIT(); asm volatile("" ::: "memory");
        float acc = 0.f;
        for (int kk = 0; kk < 384; ++kk) {
            const bf16_t* vp;
            if (kk < 128) { const int ki = kk >> 4, kj = kk & 15; vp = F.proj + (size_t)(b * S + (rs + ki) * GW + cs + kj) * DIN + 1024 + h * 64; }
            else vp = F.proj + (size_t)(M + b * CTX + (kk - 128)) * DIN + 1024 + h * 64;
            acc += sp[kk] * bf2f(vp[F.lane]);
        }
        F.mixin[(size_t)tok * D + h * 64 + F.lane] = (bf16_t)f2bf(acc / sum);
        LDS_WAIT(); asm volatile("" ::: "memory");
    }
}
__device__ __forceinline__ void p_sgu_simple(Frame& F) {
    LAS bf16_t* G = (LAS bf16_t*)F.lds;
    for (int u = blockIdx.x; u < M / 128; u += F.G) {
        const int base = u * 128;
        for (int tl = F.wave; tl < 128; tl += 8) {
            const bf16_t* zr = F.proj + (size_t)(base + tl) * DIN + 2048 + F.lane * 8;
            const u32x4 zv = *(const u32x4*)zr;
            float v[8] = {bflo(zv.x), bfhi(zv.x), bflo(zv.y), bfhi(zv.y), bflo(zv.z), bfhi(zv.z), bflo(zv.w), bfhi(zv.w)};
            float s = 0.f;
#pragma unroll
            for (int i = 0; i < 8; ++i) s += v[i];
            const float mean = wsum(s) * (1.f / 512.f); float q = 0.f;
#pragma unroll
            for (int i = 0; i < 8; ++i) { v[i] -= mean; q += v[i] * v[i]; }
            const float rstd = rsqrtf(wsum(q) * (1.f / 512.f) + EPS);
#pragma unroll
            for (int i = 0; i < 8; ++i) { const int ch = F.lane * 8 + i; G[tl * 512 + ch] = (bf16_t)f2bf(v[i] * rstd * F.sgu_ln_g[ch] + F.sgu_ln_b[ch]); }
        }
        __syncthreads();
        const int ch = F.tid, grp = ch >> 7;
        for (int i = 0; i < 128; ++i) {
            const float* wrow = F.sgu_w + (size_t)(grp * 128 + i) * 128;
            float acc = 0.f;
            for (int j = 0; j < 128; ++j) acc += wrow[j] * bf2f(G[j * 512 + ch]);
            acc += F.sgu_b[grp * 128 + i];
            const float uu = bf2f(F.proj[(size_t)(base + i) * DIN + 1536 + ch]);
            F.mixin[(size_t)(base + i) * D + 512 + ch] = (bf16_t)f2bf(uu * acc);
        }
        __syncthreads();
    }
}

namespace at {
typedef float f32x16 __attribute__((ext_vector_type(16)));
typedef short s16x4 __attribute__((ext_vector_type(4)));
typedef short v4i16_t __attribute__((ext_vector_type(4)));
constexpr int A_K = 0, A_V = 16384, A_STG = 32768, A_WSF = 65536, A_RPB = 67584;
constexpr float C2 = 0.125f * 1.4426950408889634f, L2E = 1.4426950408889634f;
__device__ __forceinline__ int crow(int r, int hi) { return (r & 3) + 8 * (r >> 2) + 4 * hi; }
__device__ __forceinline__ s16x4 vtr(const LAS unsigned char* p) { return __builtin_bit_cast(s16x4, __builtin_amdgcn_ds_read_tr16_b64_v4i16((LAS v4i16_t*)p)); }
__device__ __forceinline__ int rsf(int r) { return min(max(r - KH / 2, 0), ROWS - KH); }
#define AT_WAIT_BAR() asm volatile("s_waitcnt vmcnt(0) lgkmcnt(0)\n\ts_barrier" ::: "memory")

__device__ __forceinline__ void attn_unit(Frame& F, int b, int h, int rg) {
    const int lane = F.lane, r32 = lane & 31, hi = lane >> 5, w = F.wave;
    const int r0 = 4 * rg, r = r0 + (w >> 1), c = 32 * (w & 1) + r32;
    const int krlo = rsf(r0), nnb = rsf(r0 + 3) + 7 - krlo + 1, nst = nnb + 4;
    const int rsw = rsf(r), cs = min(max(c - KW / 2, 0), GW - KW);
    LAS float* tbl = (LAS float*)(F.lds + A_RPB);
    LAS float* wsf = (LAS float*)(F.lds + A_WSF) + w * 64;
    for (int i = F.tid; i < 480; i += 512) { const int dr = i >> 5, dc = i & 31; tbl[64 + i] = dc < 31 ? F.rpb[(h * 15 + dr) * 31 + dc] * L2E : 0.f; }
    const bf16_t* qp = F.proj + (size_t)(b * S + r * GW + c) * DIN + h * 64 + hi * 8;
    bf16x8 qr[4];
#pragma unroll
    for (int d0 = 0; d0 < 4; ++d0) qr[d0] = *(const bf16x8*)(qp + d0 * 16);
    const bf16_t* kbase = F.proj + 512 + h * 64 + w * 8;
    const bf16_t* vbase = F.proj + 1024 + h * 64 + (w >> 2) * 32 + (lane & 3) * 8;
#define AT_DMA(st) do { const int _t0 = (st) < nnb ? b * S + (krlo + (st)) * GW : M + b * CTX + ((st) - nnb) * 64; const int _bf = ((st) & 1) * 8192; \
        __builtin_amdgcn_global_load_lds((const unsigned*)(kbase + (size_t)(_t0 + lane) * DIN), (LAS unsigned*)(F.lds + A_K + _bf + w * 1024), 16, 0, 0); \
        __builtin_amdgcn_global_load_lds((const unsigned*)(vbase + (size_t)(_t0 + 16 * (w & 3) + (lane >> 2)) * DIN), (LAS unsigned*)(F.lds + A_V + _bf + w * 1024), 16, 0, 0); } while (0)
    float m = -1e30f, l = 0.f;
    f32x16 o[2];
#pragma unroll
    for (int i = 0; i < 16; ++i) { o[0][i] = 0.f; o[1][i] = 0.f; }
    AT_DMA(0);
    for (int st = 0; st < nst; ++st) {
        AT_WAIT_BAR();
        if (st + 1 < nst) AT_DMA(st + 1);
        const bool isnb = st < nnb; const int kr = krlo + st;
        const bool act = !isnb || (kr >= rsw && kr < rsw + KH);
        if (act) {
            const LAS unsigned char* kp0 = F.lds + A_K + (st & 1) * 8192 + hi * 1024 + r32 * 16;
            f32x16 p0, p1;
#pragma unroll
            for (int i = 0; i < 16; ++i) { p0[i] = 0.f; p1[i] = 0.f; }
#pragma unroll
            for (int d0 = 0; d0 < 4; ++d0) {
                const bf16x8 b0 = *(const LAS bf16x8*)(kp0 + d0 * 2048), b1 = *(const LAS bf16x8*)(kp0 + d0 * 2048 + 512);
                p0 = __builtin_amdgcn_mfma_f32_32x32x16_bf16(b0, qr[d0], p0, 0, 0, 0);
                p1 = __builtin_amdgcn_mfma_f32_32x32x16_bf16(b1, qr[d0], p1, 0, 0, 0);
            }
            if (isnb) {
                const LAS float* tb = tbl + 64 + (kr - r + 7) * 32 + 4 * hi - c + 15;
#pragma unroll
                for (int rr = 0; rr < 16; ++rr) { const int ko = (rr & 3) + 8 * (rr >> 2), kc = ko + 4 * hi;
                    const float t0 = p0[rr] * C2 + tb[ko], t1 = p1[rr] * C2 + tb[ko + 32];
                    p0[rr] = (unsigned)(kc - cs) < (unsigned)KW ? t0 : -INFINITY; p1[rr] = (unsigned)(kc + 32 - cs) < (unsigned)KW ? t1 : -INFINITY; }
            } else {
#pragma unroll
                for (int rr = 0; rr < 16; ++rr) { p0[rr] *= C2; p1[rr] *= C2; }
            }
            float tm = fmaxf(p0[0], p1[0]);
#pragma unroll
            for (int rr = 1; rr < 16; ++rr) tm = fmaxf(tm, fmaxf(p0[rr], p1[rr]));
            tm = fmaxf(tm, __shfl_xor(tm, 32));
            const float mn = fmaxf(m, tm), alpha = __builtin_amdgcn_exp2f(m - mn);
            float rsum = 0.f;
#pragma unroll
            for (int rr = 0; rr < 16; ++rr) { p0[rr] = __builtin_amdgcn_exp2f(p0[rr] - mn); p1[rr] = __builtin_amdgcn_exp2f(p1[rr] - mn); rsum += p0[rr] + p1[rr]; }
            l = l * alpha + rsum; m = mn;
            if (__any(alpha != 1.f)) {
                if (hi == 0) wsf[r32] = alpha;
                LDS_WAIT();
#pragma unroll
                for (int rr = 0; rr < 16; ++rr) { const float a = wsf[crow(rr, hi)]; o[0][rr] *= a; o[1][rr] *= a; }
                LDS_WAIT();
            }
            u32x4 pw[4];
#pragma unroll
            for (int q = 0; q < 4; ++q) { pw[0][q] = cvt_pk_bf16(p0[2 * q], p0[2 * q + 1]); pw[1][q] = cvt_pk_bf16(p0[8 + 2 * q], p0[9 + 2 * q]);
                                          pw[2][q] = cvt_pk_bf16(p1[2 * q], p1[2 * q + 1]); pw[3][q] = cvt_pk_bf16(p1[8 + 2 * q], p1[9 + 2 * q]); }
            const LAS unsigned char* vp = F.lds + A_V + (st & 1) * 8192 + ((lane >> 4) & 1) * 32 + (lane & 3) * 8 + (4 * hi + ((lane & 15) >> 2)) * 64;
#pragma unroll
            for (int d0 = 0; d0 < 2; ++d0)
#pragma unroll
                for (int ks = 0; ks < 4; ++ks) {
                    const s16x4 lo = vtr(vp + d0 * 4096 + ks * 1024), hh = vtr(vp + d0 * 4096 + ks * 1024 + 512);
                    const bf16x8 vf = (bf16x8){lo[0], lo[1], lo[2], lo[3], hh[0], hh[1], hh[2], hh[3]};
                    o[d0] = __builtin_amdgcn_mfma_f32_32x32x16_bf16(__builtin_bit_cast(bf16x8, pw[ks]), vf, o[d0], 0, 0, 0);
                }
        }
    }
#undef AT_DMA
    l += __shfl_xor(l, 32);
    if (hi == 0) wsf[32 + r32] = l;
    LDS_WAIT();
    LAS bf16_t* stg = (LAS bf16_t*)(F.lds + A_STG) + w * 2048;
#pragma unroll
    for (int rr = 0; rr < 16; ++rr) { const int orow = crow(rr, hi); const float rl = __builtin_amdgcn_rcpf(wsf[32 + orow]);
        stg[orow * 64 + r32] = (bf16_t)f2bf(o[0][rr] * rl); stg[orow * 64 + 32 + r32] = (bf16_t)f2bf(o[1][rr] * rl); }
    LDS_WAIT();
    bf16_t* ow = F.mixin + (size_t)(b * S + r * GW + 32 * (w & 1)) * D + h * 64;
#pragma unroll
    for (int i = 0; i < 4; ++i) { const int row = i * 8 + (lane >> 3), ch = lane & 7; const u32x4 v = *(const LAS u32x4*)(stg + row * 64 + ch * 8); *(u32x4*)(ow + (size_t)row * D + ch * 8) = v; }
    AT_WAIT_BAR();
}

constexpr int G_IMG = 0, G_STG = 65536, G_STAT = 98304;
__device__ __forceinline__ void sgu_unit(Frame& F, int chunk, int gh) {
    const int lane = F.lane, r32 = lane & 31, hi = lane >> 5, w = F.wave;
    const int base = chunk * 128;
    LAS f32x2* stat = (LAS f32x2*)(F.lds + G_STAT);
    for (int t = 0; t < 16; ++t) {
        const int tok = 16 * w + t;
        const u32x4 zv = *(const u32x4*)(F.proj + (size_t)(base + tok) * DIN + 2048 + lane * 8);
        float v[8] = {bflo(zv.x), bfhi(zv.x), bflo(zv.y), bfhi(zv.y), bflo(zv.z), bfhi(zv.z), bflo(zv.w), bfhi(zv.w)};
        float s = 0.f;
#pragma unroll
        for (int i = 0; i < 8; ++i) s += v[i];
        const float mean = wsum(s) * (1.f / 512.f); float q = 0.f;
#pragma unroll
        for (int i = 0; i < 8; ++i) { const float d = v[i] - mean; q += d * d; }
        const float rstd = rsqrtf(wsum(q) * (1.f / 512.f) + EPS);
        if (lane == 0) stat[tok] = (f32x2){mean, rstd};
    }
    AT_WAIT_BAR();
    {
        const int ch0 = 256 * gh + 32 * w + 8 * (lane & 3);
        const f32x4 g0 = *(const f32x4*)(F.sgu_ln_g + ch0), g1 = *(const f32x4*)(F.sgu_ln_g + ch0 + 4), b0 = *(const f32x4*)(F.sgu_ln_b + ch0), b1 = *(const f32x4*)(F.sgu_ln_b + ch0 + 4);
#pragma unroll
        for (int i = 0; i < 8; ++i) {
            const int tok = 16 * i + (lane >> 2);
            const u32x4 zv = *(const u32x4*)(F.proj + (size_t)(base + tok) * DIN + 2048 + ch0);
            const f32x2 st = stat[tok];
            u32x4 o;
            o.x = pk2((bflo(zv.x) - st[0]) * st[1] * g0[0] + b0[0], (bfhi(zv.x) - st[0]) * st[1] * g0[1] + b0[1]);
            o.y = pk2((bflo(zv.y) - st[0]) * st[1] * g0[2] + b0[2], (bfhi(zv.y) - st[0]) * st[1] * g0[3] + b0[3]);
            o.z = pk2((bflo(zv.z) - st[0]) * st[1] * g1[0] + b1[0], (bfhi(zv.z) - st[0]) * st[1] * g1[1] + b1[1]);
            o.w = pk2((bflo(zv.w) - st[0]) * st[1] * g1[2] + b1[2], (bfhi(zv.w) - st[0]) * st[1] * g1[3] + b1[3]);
            *(LAS u32x4*)(F.lds + G_IMG + w * 8192 + i * 1024 + lane * 16) = o;
        }
    }
    AT_WAIT_BAR();
    const int cb = w & 3, th = w >> 2, grp = 2 * gh + (cb >> 1);
    f32x16 acc[2][2];
#pragma unroll
    for (int a = 0; a < 2; ++a)
#pragma unroll
        for (int q = 0; q < 2; ++q)
#pragma unroll
            for (int i = 0; i < 16; ++i) acc[a][q][i] = 0.f;
    const bf16_t* wp = F.sguw + (size_t)(grp * 128 + 64 * th + r32) * 128 + 8 * hi;
    const LAS unsigned char* gp = F.lds + G_IMG + (2 * cb) * 8192 + ((lane >> 4) & 1) * 32 + (lane & 3) * 8 + (8 * hi + ((lane & 15) >> 2)) * 64;
#pragma unroll
    for (int ks = 0; ks < 8; ++ks) {
        const bf16x8 w0 = *(const bf16x8*)(wp + ks * 16), w1 = *(const bf16x8*)(wp + 32 * 128 + ks * 16);
#pragma unroll
        for (int c32 = 0; c32 < 2; ++c32) {
            const s16x4 lo = vtr(gp + c32 * 8192 + ks * 1024), hh = vtr(gp + c32 * 8192 + ks * 1024 + 256);
            const bf16x8 gf = (bf16x8){lo[0], lo[1], lo[2], lo[3], hh[0], hh[1], hh[2], hh[3]};
            acc[0][c32] = __builtin_amdgcn_mfma_f32_32x32x16_bf16(gf, w0, acc[0][c32], 0, 0, 0);
            acc[1][c32] = __builtin_amdgcn_mfma_f32_32x32x16_bf16(gf, w1, acc[1][c32], 0, 0, 0);
        }
    }
    LAS unsigned char* stg = F.lds + G_STG + w * 4096;
#pragma unroll
    for (int ib = 0; ib < 2; ++ib) {
        const int i0 = 64 * th + 32 * ib;
        const float bi = F.sgu_b[grp * 128 + i0 + r32];
#pragma unroll
        for (int c32 = 0; c32 < 2; ++c32)
#pragma unroll
            for (int a = 0; a < 4; ++a) { u32x2 o; o.x = pk2(acc[ib][c32][4 * a] + bi, acc[ib][c32][4 * a + 1] + bi); o.y = pk2(acc[ib][c32][4 * a + 2] + bi, acc[ib][c32][4 * a + 3] + bi);
                *(LAS u32x2*)(stg + r32 * 128 + (((4 * c32 + a) ^ (r32 & 7)) << 4) + hi * 8) = o; }
        LDS_WAIT();
#pragma unroll
        for (int it = 0; it < 4; ++it) {
            const int row = 8 * it + (lane >> 3), chn = lane & 7;
            const u32x4 v = *(const LAS u32x4*)(stg + row * 128 + ((chn ^ (row & 7)) << 4));
            const size_t tok = (size_t)(base + i0 + row);
            const u32x4 uv = *(const u32x4*)(F.proj + tok * DIN + 1536 + 256 * gh + 64 * cb + 8 * chn);
            u32x4 o;
            o.x = pk2(bflo(v.x) * bflo(uv.x), bfhi(v.x) * bfhi(uv.x)); o.y = pk2(bflo(v.y) * bflo(uv.y), bfhi(v.y) * bfhi(uv.y));
            o.z = pk2(bflo(v.z) * bflo(uv.z), bfhi(v.z) * bfhi(uv.z)); o.w = pk2(bflo(v.w) * bflo(uv.w), bfhi(v.w) * bfhi(uv.w));
            *(u32x4*)(F.mixin + tok * D + 512 + 256 * gh + 64 * cb + 8 * chn) = o;
        }
        LDS_WAIT();
    }
    AT_WAIT_BAR();
}
__device__ __forceinline__ void p_mixer(Frame& F) {
    for (int uid = F.vcu; uid < NB * NH * 32; uid += F.G) attn_unit(F, uid >> 8, (uid >> 5) & 7, uid & 31);
    for (int uid = F.vcu; uid < (M / 128) * 2; uid += F.G) sgu_unit(F, uid >> 1, uid & 1);
}
#undef AT_WAIT_BAR
}

__device__ __forceinline__ void p_route(Frame& F) {
    LAS int* lcnt = (LAS int*)(F.lds + L_ROUTE); LAS int* gbase = lcnt + 32; LAS int* sel = lcnt + 64;
    for (int i = F.tid; i < 8192; i += 512) { const int c = i >> 3, q = i & 7; *(LAS f32x4*)(F.lds + c * 128 + ((q ^ ((c >> 1) & 7)) << 4)) = *(const f32x4*)(F.router_w + c * 32 + q * 4); }
    if (F.tid < 32) lcnt[F.tid] = 0;
    __syncthreads();
    for (int tb = blockIdx.x; tb < M / 64; tb += F.G) {
        for (int tl = F.wave; tl < 64; tl += 8) {
            const int tok = tb * 64 + tl, b = tok >> 13;
            const float* sh2 = F.mod + b * 6144 + 3 * 1024; const float* sc2 = F.mod + b * 6144 + 4 * 1024;
            float* yr = F.y1 + (size_t)tok * D;
            float v[16]; float s = 0.f;
#pragma unroll
            for (int i = 0; i < 16; ++i) { v[i] = yr[F.lane + 64 * i]; s += v[i]; }
            float mean = wsum(s) * (1.f / D), q = 0.f;
#pragma unroll
            for (int i = 0; i < 16; ++i) { v[i] -= mean; q += v[i] * v[i]; }
            float rstd = rsqrtf(wsum(q) * (1.f / D) + EPS);
            s = 0.f;
#pragma unroll
            for (int i = 0; i < 16; ++i) { const int col = F.lane + 64 * i; v[i] = v[i] * rstd * F.ln1_g[col] + F.ln1_b[col]; yr[col] = v[i]; s += v[i]; }
            mean = wsum(s) * (1.f / D); q = 0.f;
#pragma unroll
            for (int i = 0; i < 16; ++i) { v[i] -= mean; q += v[i] * v[i]; }
            rstd = rsqrtf(wsum(q) * (1.f / D) + EPS);
            float lg[NE];
            LAS unsigned char* hrow = F.lds + L_WSCR + F.wave * 1024;
#pragma unroll
            for (int e = 0; e < NE; ++e) lg[e] = 0.f;
#pragma unroll
            for (int i = 0; i < 16; ++i) {
                const int col = F.lane + 64 * i;
                v[i] = v[i] * rstd * (1.f + sc2[col]) + sh2[col];
                hrow[col] = (unsigned char)__builtin_amdgcn_cvt_pk_fp8_f32(v[i], v[i], 0, false);
                const LAS unsigned char* wr = F.lds + col * 128; const int sw = (col >> 1) & 7;
#pragma unroll
                for (int qq = 0; qq < 8; ++qq) { const f32x4 w4 = *(const LAS f32x4*)(wr + ((qq ^ sw) << 4));
#pragma unroll
                    for (int j = 0; j < 4; ++j) lg[qq * 4 + j] += v[i] * w4[j]; }
            }
            LDS_WAIT();
            *(u32x4*)(F.h2 + (size_t)tok * D + F.lane * 16) = *(const LAS u32x4*)(hrow + F.lane * 16);
            float r16[16], r8[8], r4[4], r2[2], r1;
            { const bool hi = F.lane & 32;
#pragma unroll
              for (int e = 0; e < 16; ++e) { const float mine = hi ? lg[e + 16] : lg[e], send = hi ? lg[e] : lg[e + 16]; r16[e] = mine + __shfl_xor(send, 32); } }
            { const bool hi = F.lane & 16;
#pragma unroll
              for (int e = 0; e < 8; ++e) { const float mine = hi ? r16[e + 8] : r16[e], send = hi ? r16[e] : r16[e + 8]; r8[e] = mine + __shfl_xor(send, 16); } }
            { const bool hi = F.lane & 8;
#pragma unroll
              for (int e = 0; e < 4; ++e) { const float mine = hi ? r8[e + 4] : r8[e], send = hi ? r8[e] : r8[e + 4]; r4[e] = mine + __shfl_xor(send, 8); } }
            { const bool hi = F.lane & 4;
#pragma unroll
              for (int e = 0; e < 2; ++e) { const float mine = hi ? r4[e + 2] : r4[e], send = hi ? r4[e] : r4[e + 2]; r2[e] = mine + __shfl_xor(send, 4); } }
            { const bool hi = F.lane & 2; const float mine = hi ? r2[1] : r2[0], send = hi ? r2[0] : r2[1]; r1 = mine + __shfl_xor(send, 2); }
            r1 += __shfl_xor(r1, 1);
            const int e = F.lane >> 1;
            const float lgt = r1 + F.router_b[e];
            int rank = 0; float mx = -3.0e38f;
#pragma unroll
            for (int e2 = 0; e2 < NE; ++e2) { const float o = __builtin_bit_cast(float, __builtin_amdgcn_readlane(__builtin_bit_cast(int, lgt), 2 * e2));
                rank += (o > lgt || (o == lgt && e2 < e)) ? 1 : 0; mx = fmaxf(mx, o); }
            const bool selq = rank < TOPK && !(F.lane & 1);
            const float pe = selq ? __expf(lgt - mx) : 0.f;
            const float den = wsum(pe);
            if (selq) {
                const int lp = __hip_atomic_fetch_add(lcnt + e, 1, __ATOMIC_RELAXED, __HIP_MEMORY_SCOPE_WORKGROUP);
                sel[tl * 4 + rank] = e | (lp << 8);
                F.topg[tok * 4 + rank] = pe / den; F.topi[tok * 4 + rank] = e;
            }
        }
        __syncthreads();
        if (F.tid < 32) { const int n = lcnt[F.tid]; gbase[F.tid] = n ? (int)__hip_atomic_fetch_add(F.ctl + CW_CNT + 32 * F.tid, (unsigned)n, __ATOMIC_RELAXED, __HIP_MEMORY_SCOPE_AGENT) : 0; lcnt[F.tid] = 0; }
        __syncthreads();
        if (F.tid < 256) { const int sv = sel[F.tid], e = sv & 255, lp = sv >> 8; F.list[(size_t)e * LCAP + gbase[e] + lp] = (tb * 64 + (F.tid >> 2)) * 4 + (F.tid & 3); }
        __syncthreads();
    }
}

__device__ __forceinline__ void p_final(Frame& F) {
    const int gw = F.vcu * 8 + F.wave, NGW = F.G * 8;
    for (int tok = gw; tok < M; tok += NGW) {
        const float* g2 = F.mod + (tok >> 13) * 6144 + 5 * 1024;
        const f32x4* xp = (const f32x4*)(F.y1 + (size_t)tok * D) + F.lane;
        f32x4 v[4]; float s = 0.f;
#pragma unroll
        for (int j = 0; j < 4; ++j) {
            f32x4 f = (f32x4){0.f, 0.f, 0.f, 0.f};
#pragma unroll
            for (int k = 0; k < TOPK; ++k) { const u32x2 yv = *((const u32x2*)(F.ybuf + (size_t)(tok * 4 + k) * D) + F.lane + 64 * j);
                f[0] += bflo(yv.x); f[1] += bfhi(yv.x); f[2] += bflo(yv.y); f[3] += bfhi(yv.y); }
            const f32x4 gv = *((const f32x4*)g2 + F.lane + 64 * j);
            v[j] = xp[64 * j] * DN_ALPHA + gv * f; s += (v[j][0] + v[j][1]) + (v[j][2] + v[j][3]);
        }
        const float mean = wsum(s) * (1.f / D); float q = 0.f;
#pragma unroll
        for (int j = 0; j < 4; ++j) { v[j] = v[j] - mean; q += (v[j][0] * v[j][0] + v[j][1] * v[j][1]) + (v[j][2] * v[j][2] + v[j][3] * v[j][3]); }
        const float rstd = rsqrtf(wsum(q) * (1.f / D) + EPS);
        f32x4* op = (f32x4*)(F.out + (size_t)tok * D) + F.lane;
#pragma unroll
        for (int j = 0; j < 4; ++j) { const f32x4 gg = *((const f32x4*)F.ln2_g + F.lane + 64 * j), bb = *((const f32x4*)F.ln2_b + F.lane + 64 * j); op[64 * j] = v[j] * rstd * gg + bb; }
    }
}

struct Args { const float* in[23]; float* out; unsigned char* ws; int ph_lo, ph_hi; };
constexpr int N_PHASES = 9;
__global__ void __launch_bounds__(512, 2) mk_fwd(Args args) {
    extern __shared__ __attribute__((aligned(16))) unsigned char lds_raw[];
    Frame F;
    F.lds = (LAS unsigned char*)lds_raw;
    F.MISC = (volatile LAS unsigned*)(F.lds + L_MISC);
    F.tid = threadIdx.x; F.lane = F.tid & 63; F.wave = __builtin_amdgcn_readfirstlane(F.tid >> 6);
    F.G = gridDim.x; { const int bx = blockIdx.x; F.vcu = (F.G % 8 == 0) ? (bx % 8) * (F.G / 8) + bx / 8 : bx; }
    unsigned char* ws = args.ws;
    F.ctl = (unsigned*)(ws + WS_CTL);
    F.x = args.in[0]; F.c = args.in[1]; F.ctx = args.in[2]; F.c_ctx = args.in[3]; F.ada_w = args.in[4]; F.ada_b = args.in[5]; F.w_in = args.in[6]; F.rpb = args.in[7];
    F.sgu_ln_g = args.in[8]; F.sgu_ln_b = args.in[9]; F.sgu_w = args.in[10]; F.sgu_b = args.in[11]; F.w_out = args.in[12]; F.ln1_g = args.in[13]; F.ln1_b = args.in[14];
    F.ln2_g = args.in[15]; F.ln2_b = args.in[16]; F.router_w = args.in[17]; F.router_b = args.in[18]; F.w_gu = args.in[19]; F.b_gu = args.in[20]; F.w_dn = args.in[21]; F.b_dn = args.in[22];
    F.out = args.out;
    F.mod = (float*)(ws + WS_MOD); F.topg = (float*)(ws + WS_TOPG); F.topi = (int*)(ws + WS_TOPI); F.list = (int*)(ws + WS_LIST); F.sguw = (bf16_t*)(ws + WS_SGUW);
    F.Wt_in = (bf16_t*)(ws + WS_WIN); F.Wt_out = (bf16_t*)(ws + WS_WOUT); F.Wt_gu = ws + WS_WGU; F.Wt_dn = ws + WS_WDN;
    F.hxc = (bf16_t*)(ws + WS_HXC); F.proj = (bf16_t*)(ws + WS_PROJ); F.mixin = (bf16_t*)(ws + WS_MIXIN); F.y1 = (float*)(ws + WS_Y1); F.h2 = ws + WS_H2;
    F.act = ws + WS_ACT; F.ybuf = (bf16_t*)(ws + WS_YBUF);
    for (int u = F.tid; u < (LDS_BYTES - L_MISC) / 4; u += 512) ((LAS unsigned*)(F.lds + L_MISC))[u] = 0u;
    __syncthreads();
    const int lo = args.ph_lo, hi = args.ph_hi;
    const bool one = (hi - lo) > 1;
    XcdBarrier bar; bar.bar = (unsigned*)(F.ctl + CW_BAR); bar.x = 0; bar.st = nullptr;
    if (one) bar = xcd_barrier_post((unsigned*)(F.ctl + CW_BAR), F.MISC + 8);
#define IN(k) (lo <= (k) && (k) < hi)
#define SEAM(k) do { if (IN(k) && IN((k) + 1)) xcd_barrier(bar); } while (0)
#ifndef PROBE_REPS
#define PROBE_REPS {1, 1, 1, 1, 1, 1, 1, 1, 1}
#endif
    constexpr int REPS[N_PHASES] = PROBE_REPS;
#define REPEAT(k) _Pragma("unroll") for (int rep_ = 0; rep_ < REPS[k]; ++rep_)
#define RSEAM(k) do { if (rep_ + 1 < REPS[k]) xcd_barrier(bar); else SEAM(k); } while (0)
    if (IN(0)) REPEAT(0) { p_ada(F); p_weights(F); RSEAM(0); }
    if (IN(1)) REPEAT(1) { p_lnmod(F); RSEAM(1); }
    if (IN(2)) REPEAT(2) { PolProj P{F.hxc, F.Wt_in, F.proj, F.G, (int)blockIdx.x}; pg8::gemm_phase<PolProj>(F.lds, P); RSEAM(2); }
    if (IN(3)) REPEAT(3) { at::p_mixer(F); RSEAM(3); }
    if (IN(4)) REPEAT(4) { PolOut P{F.mixin, F.Wt_out, F.x, F.mod, F.y1, F.G, (int)blockIdx.x}; pg8::gemm_phase<PolOut>(F.lds, P); RSEAM(4); }
    if (IN(5)) { p_route(F); SEAM(5); }
    if (IN(6)) REPEAT(6) { const int T = expert_tables(F); ExpTab tb{(const LAS int*)(F.lds + L_TILEE), (const LAS int*)(F.lds + L_TSTART), (const LAS int*)(F.lds + L_TSTART) + 64, T};
        PolGU P{F.h2, F.Wt_gu, F.b_gu, F.list, F.act, tb, F.G, (int)blockIdx.x}; pg8::gemm_phase<PolGU>(F.lds, P); RSEAM(6); }
    if (IN(7)) REPEAT(7) { const int T = expert_tables(F); ExpTab tb{(const LAS int*)(F.lds + L_TILEE), (const LAS int*)(F.lds + L_TSTART), (const LAS int*)(F.lds + L_TSTART) + 64, T};
        PolDN P{F.act, F.Wt_dn, F.b_dn, F.list, F.topg, F.ybuf, tb, F.G, (int)blockIdx.x}; pg8::gemm_phase<PolDN>(F.lds, P); RSEAM(7); }
    if (IN(8)) REPEAT(8) { p_final(F); if (rep_ + 1 < REPS[8]) xcd_barrier(bar); }
#undef IN
#undef SEAM
#undef REPEAT
#undef RSEAM
}

static inline void launch_forward(void* const* d_in, void* d_out, void* d_ws, hipStream_t stream, int n_launches) {
    static int grid = 0;
    if (grid == 0) {
        int dev = 0, cus = 0;
        if (hipGetDevice(&dev) != hipSuccess || hipDeviceGetAttribute(&cus, hipDeviceAttributeMultiprocessorCount, dev) != hipSuccess) { fprintf(stderr, "kernel_launch: device query failed\n"); grid = -1; return; }
        if (hipFuncSetAttribute((const void*)mk_fwd, hipFuncAttributeMaxDynamicSharedMemorySize, LDS_BYTES) != hipSuccess) { fprintf(stderr, "kernel_launch: hipFuncSetAttribute failed\n"); grid = -1; return; }
        int per_cu = 0;
        if (hipOccupancyMaxActiveBlocksPerMultiprocessor(&per_cu, (const void*)mk_fwd, 512, LDS_BYTES) != hipSuccess || per_cu < 1) fprintf(stderr, "kernel_launch: occupancy query says %d\n", per_cu);
        (void)hipGetLastError();
        grid = cus;
    }
    if (grid < 0) return;
    (void)hipMemsetAsync((char*)d_ws + WS_CTL, 0, CTL_ZERO_BYTES, stream);
    Args a{};
    for (int i = 0; i < 23; ++i) a.in[i] = (const float*)d_in[i];
    a.out = (float*)d_out; a.ws = (unsigned char*)d_ws;
    if (n_launches == 1) { a.ph_lo = 0; a.ph_hi = N_PHASES; hipLaunchKernelGGL(mk_fwd, dim3(grid), dim3(512), LDS_BYTES, stream, a); }
    else for (int p = 0; p < N_PHASES; ++p) { a.ph_lo = p; a.ph_hi = p + 1; hipLaunchKernelGGL(mk_fwd, dim3(grid), dim3(512), LDS_BYTES, stream, a); }
#ifdef PROBE_EXTRA
    { const int extra[] = PROBE_EXTRA; for (int p : extra) { a.ph_lo = p; a.ph_hi = p + 1; hipLaunchKernelGGL(mk_fwd, dim3(grid), dim3(512), LDS_BYTES, stream, a); } }
#endif
}
}
extern "C" void kernel_launch(void* const* d_in, const int* in_sizes, int n_in, void* d_out, int out_size, void* d_ws, size_t ws_size, hipStream_t stream) {
    if (ws_size < mk::WS_END || n_in != 23) { fprintf(stderr, "kernel_launch: unexpected workspace / inputs (%zu, %d)\n", ws_size, n_in); return; }
    mk::launch_forward(d_in, d_out, d_ws, stream, 1);
}
```

```cpp
#include <hip/hip_runtime.h>
#include <stdint.h>
#include <stdio.h>

#define GAS __attribute__((address_space(1)))
#define LAS __attribute__((address_space(3)))
typedef unsigned short bf16_t;
typedef short bf16x8 __attribute__((ext_vector_type(8)));
typedef float f32x4 __attribute__((ext_vector_type(4)));
typedef float f32x2 __attribute__((ext_vector_type(2)));
typedef unsigned u32x4 __attribute__((ext_vector_type(4)));
typedef unsigned u32x2 __attribute__((ext_vector_type(2)));

namespace mk {
constexpr int D = 1024, NB = 2, S = 8192, M = NB * S, GW = 64, ROWS = 128, CTX = 256, NH = 8, KH = 8, KW = 16;
constexpr int NE = 32, TOPK = 4, DFF = 1024, DIN = 2560, NPAIR = M * TOPK, MX = M + NB * CTX;
constexpr int LCAP = 16384, MAXT = 288, ACT_ROWS = MAXT * 256;
constexpr float EPS = 1e-5f;
constexpr float DN_ALPHA = 1.189207115002721f;
constexpr size_t MiB = 1u << 20;
constexpr size_t WS_CTL = 0, CTL_ZERO_BYTES = 1 * MiB;
constexpr size_t WS_MOD = 1 * MiB;
constexpr size_t WS_TOPG = 2 * MiB;
constexpr size_t WS_TOPI = 2 * MiB + 512 * 1024;
constexpr size_t WS_LIST = 3 * MiB;
constexpr size_t WS_SGUW = 5 * MiB;
constexpr size_t WS_WIN = 6 * MiB;
constexpr size_t WS_WOUT = 11 * MiB;
constexpr size_t WS_WGU = 16 * MiB;
constexpr size_t WS_WDN = 144 * MiB;
constexpr size_t WS_HXC = 208 * MiB;
constexpr size_t WS_PROJ = 241 * MiB;
constexpr size_t WS_MIXIN = 324 * MiB;
constexpr size_t WS_Y1 = 356 * MiB;
constexpr size_t WS_H2 = 420 * MiB;
constexpr size_t WS_ACT = 452 * MiB;
constexpr size_t WS_YBUF = 596 * MiB;
constexpr size_t WS_END = 724 * MiB;
constexpr int CW_BAR = 4096;
constexpr int CW_CNT = 8192;
constexpr int RING_BYTES = 131072;
constexpr int L_MISC = RING_BYTES;
constexpr int L_IDX = L_MISC + 1024;
constexpr int L_TILEE = L_IDX + 3072;
constexpr int L_TSTART = L_TILEE + 1280;
constexpr int L_ROUTE = L_TSTART + 512;
constexpr int L_RPB = L_ROUTE + 256 + 1024;
constexpr int L_WSCR = L_RPB + 2048;
constexpr int LDS_BYTES = 155648;
static_assert(L_WSCR + 8 * 1024 <= LDS_BYTES, "LDS map");

__device__ __forceinline__ float wsum(float v) {
#pragma unroll
    for (int o = 32; o; o >>= 1) v += __shfl_xor(v, o);
    return v;
}
__device__ __forceinline__ float wmax(float v) {
#pragma unroll
    for (int o = 32; o; o >>= 1) v = fmaxf(v, __shfl_xor(v, o));
    return v;
}
__device__ __forceinline__ unsigned f2bf(float f) { unsigned u = __builtin_bit_cast(unsigned, f); return (u + 0x7fffu + ((u >> 16) & 1u)) >> 16; }
__device__ __forceinline__ unsigned pk2(float lo, float hi) { return f2bf(lo) | (f2bf(hi) << 16); }
__device__ __forceinline__ float bf2f(unsigned short b) { return __builtin_bit_cast(float, ((unsigned)b) << 16); }
__device__ __forceinline__ float bflo(unsigned w) { return __builtin_bit_cast(float, w << 16); }
__device__ __forceinline__ float bfhi(unsigned w) { return __builtin_bit_cast(float, w & 0xffff0000u); }
__device__ __forceinline__ unsigned cvt_pk_bf16(float lo, float hi) { unsigned r; asm volatile("v_cvt_pk_bf16_f32 %0, %1, %2" : "=v"(r) : "v"(lo), "v"(hi)); return r; }
__device__ __forceinline__ float gelu_fast(float x) {
    const float c1 = -2.302208198f;
    const float c3 = c1 * 0.044715f;
    const float x2 = x * x;
    const float t = x * (c1 + c3 * x2);
    return x * __builtin_amdgcn_rcpf(1.f + __builtin_amdgcn_exp2f(t));
}

#define XB_TMO      128
#define XB_XCNT(j)  (256  + 64 * (j))
#define XB_XSUB(j)  (1280 + 64 * (j))
#define XB_XGEN(j)  (2304 + 64 * (j))
#define XB_TOP      3328
#define XB_TOPGEN   3392
#define XCD_BAR_WORDS 3456
#define XB_SPIN_CAP (1u << 18)
__device__ __forceinline__ unsigned xb_ld(unsigned* p)              { return __hip_atomic_load(p, __ATOMIC_RELAXED, __HIP_MEMORY_SCOPE_AGENT); }
__device__ __forceinline__ unsigned xb_add(unsigned* p, unsigned v) { return __hip_atomic_fetch_add(p, v, __ATOMIC_RELAXED, __HIP_MEMORY_SCOPE_AGENT); }
__device__ __forceinline__ unsigned xb_xcc_id() { return (unsigned)__builtin_amdgcn_s_getreg((3 << 11) | 20) & 0xFu; }
#define XB_SPIN(cond, bar) do { unsigned _sp = 0; while (cond) { __builtin_amdgcn_s_sleep(1); \
    if ((++_sp & 255u) == 0u) { if (xb_ld(&(bar)[XB_TMO])) break; if (_sp > XB_SPIN_CAP) { atomicAdd(&(bar)[XB_TMO], 1u); break; } } } } while (0)
struct XcdBarrier { unsigned* bar; unsigned x; volatile LAS unsigned* st; };
__device__ __forceinline__ XcdBarrier xcd_barrier_post(unsigned* bar, volatile LAS unsigned* st) {
    XcdBarrier b; b.bar = bar; b.x = xb_xcc_id(); b.st = st;
    if (threadIdx.x == 0) (void)xb_add(&bar[XB_XCNT(b.x)], 1u);
    return b;
}
__device__ __forceinline__ void xcd_barrier_complete(unsigned* bar, unsigned x, unsigned& nloc, unsigned& nx) {
    const unsigned G = gridDim.x * gridDim.y * gridDim.z;
    unsigned sum, cnt, mine, sp = 0u;
    for (;;) {
        sum = 0u; cnt = 0u; mine = 0u;
#pragma unroll
        for (unsigned j = 0; j < 16; ++j) { const unsigned c = xb_ld(&bar[XB_XCNT(j)]); sum += c; cnt += (c > 0u) ? 1u : 0u; mine = (j == x) ? c : mine; }
        if (sum == G) break;
        __builtin_amdgcn_s_sleep(1);
        if ((++sp & 255u) == 0u) { if (xb_ld(&bar[XB_TMO])) break; if (sp > XB_SPIN_CAP) { atomicAdd(&bar[XB_TMO], 1u); break; } }
    }
    nloc = mine > 0u ? mine : 1u; nx = cnt > 0u ? cnt : 1u;
}
__device__ __forceinline__ void xcd_barrier(const XcdBarrier& b) {
    asm volatile("s_waitcnt vmcnt(0)" ::: "memory");
    __syncthreads();
    if (threadIdx.x == 0) {
        unsigned* bar = b.bar;
        __builtin_amdgcn_s_waitcnt(0);
        unsigned nloc = b.st[0], nx = b.st[1];
        if (nloc == 0u) { xcd_barrier_complete(bar, b.x, nloc, nx); b.st[0] = nloc; b.st[1] = nx; }
        const unsigned old = xb_add(&bar[XB_XSUB(b.x)], 1u);
        const unsigned gen = old / nloc;
        if (old + 1u == (gen + 1u) * nloc) {
            __builtin_amdgcn_fence(__ATOMIC_RELEASE, "agent");
            asm volatile("s_waitcnt vmcnt(0)" ::: "memory");
            const unsigned og = xb_add(&bar[XB_TOP], 1u);
            const unsigned tg = og / nx;
            if (og + 1u == (tg + 1u) * nx) xb_add(&bar[XB_TOPGEN], 1u);
            else XB_SPIN(xb_ld(&bar[XB_TOPGEN]) == tg, bar);
            __builtin_amdgcn_fence(__ATOMIC_ACQUIRE, "agent");
            xb_add(&bar[XB_XGEN(b.x)], 1u);
            asm volatile("s_waitcnt vmcnt(0)" ::: "memory");
        } else {
            XB_SPIN(xb_ld(&bar[XB_XGEN(b.x)]) == gen, bar);
            __builtin_amdgcn_fence(__ATOMIC_ACQUIRE, "agent");
            asm volatile("s_waitcnt vmcnt(0)" ::: "memory");
        }
    }
    __syncthreads();
}

struct Frame {
    LAS unsigned char* lds;
    volatile LAS unsigned* MISC;
    unsigned* ctl;
    int tid, lane, wave, vcu, G;
    const float *x, *c, *ctx, *c_ctx, *ada_w, *ada_b, *w_in, *rpb, *sgu_ln_g, *sgu_ln_b, *sgu_w, *sgu_b, *w_out, *ln1_g, *ln1_b, *ln2_g, *ln2_b, *router_w, *router_b, *w_gu, *b_gu, *w_dn, *b_dn;
    float* out;
    float* mod; float* topg; int* topi; int* list; bf16_t* sguw; bf16_t* Wt_in; bf16_t* Wt_out; unsigned char* Wt_gu; unsigned char* Wt_dn;
    bf16_t* hxc; bf16_t* proj; bf16_t* mixin; float* y1; unsigned char* h2; unsigned char* act; bf16_t* ybuf;
};
#define LDS_WAIT() asm volatile("s_waitcnt lgkmcnt(0)" ::: "memory")
#define VM_WAIT() asm volatile("s_waitcnt vmcnt(0)" ::: "memory")

namespace pg8 {
constexpr int BM = 256, BK = 64, HALF = 128, HTB = HALF * BK * 2, STAGE_BYTES = 8 * HTB, NXCD = 8, WGM = 8, KD = 1024, NKT = KD / BK;
__device__ __forceinline__ int lds_byte(int r, int c) { const int st = (r >> 4) * 2 + (c >> 5), rr = r & 15, cc = c & 31, ob = rr * 64 + cc * 2; return st * 1024 + (ob ^ (((ob >> 9) & 1) << 5)); }
__device__ __forceinline__ void stage_rc(int b, int& R, int& C) { const int st = b / 1024, sb = b % 1024, swz = sb ^ (((sb >> 9) & 1) << 5); R = (st >> 1) * 16 + swz / 64; C = (st & 1) * 32 + (swz % 64) / 2; }
__device__ __forceinline__ int perm32(int rho) { const int n = rho >> 4, i = rho & 15; return 8 * (i >> 2) + 4 * n + (i & 3); }
struct Unit { int pm, pn, e, nvalid, ti; };
__device__ __forceinline__ void static_tile(int L, int nM, int nN, int& pm, int& pn) {
    const int nwg = nM * nN; int wgid = L;
    { const int q = nwg / NXCD, r = nwg % NXCD, xcd = wgid % NXCD, off = wgid / NXCD; wgid = (xcd < r ? xcd * (q + 1) : r * (q + 1) + (xcd - r) * q) + off; }
    const int nig = WGM * nN, gid = wgid / nig, fm = gid * WGM, gsz = (nM - fm) < WGM ? (nM - fm) : WGM;
    pm = fm + ((wgid % nig) % gsz); pn = (wgid % nig) / gsz;
}

typedef int v8i __attribute__((ext_vector_type(8)));
template <bool FP8> struct Frags;
template <> struct Frags<false> { bf16x8 At[4][2], B0[2][2], B1[2][2]; };
template <> struct Frags<true> { v8i At[4], B0[2], B1[2]; };
template <class P>
__device__ __forceinline__ void gemm_phase(LAS unsigned char* lds, const P& pol) {
    const int tid = threadIdx.x, wid = __builtin_amdgcn_readfirstlane(tid >> 6), lane = tid & 63, wr = wid >> 2, wc = wid & 3, fr = lane & 15, fq = lane >> 4;
    constexpr int KDB = P::FP8 ? 1024 : 2048, NKT_ = KDB / 128;
    unsigned voffB[2];
#pragma unroll
    for (int i = 0; i < 2; ++i) { int R, C; stage_rc(tid * 16 + i * 8192, R, C); const int Rb = P::PERM ? ((R & ~31) + perm32(R & 31)) : R;
        voffB[i] = (unsigned)(Rb * KDB + C * 2); }
    const size_t kstep = (size_t)(BK * 2);
    const size_t hstep = (size_t)HALF * KDB;
    const unsigned ldsw = (unsigned)wid * 1024u;
    const int aoff = lds_byte(wr * 64 + fr, fq * 8), boff = lds_byte(wc * 32 + fr, fq * 8);
#define PG8_SA(b, h) (((b) * 2 + (h)) * HTB)
#define PG8_SB(b, h) ((4 + (b) * 2 + (h)) * HTB)
#define PG8_STAGE(bufoff, gbase, voff) do { _Pragma("unroll") for (int _i = 0; _i < 2; ++_i) \
        __builtin_amdgcn_global_load_lds((const unsigned*)((const char*)(gbase) + (voff)[_i]), (LAS unsigned*)(lds + (bufoff) + ldsw + _i * 8192), 16, 0, 0); } while (0)
#define PG8_RD8(p) __builtin_shufflevector(*(const LAS u32x4*)(p), *(const LAS u32x4*)((p) + 1024), 0, 1, 2, 3, 4, 5, 6, 7)
#define PG8_LDA(dst, b, h) do { if constexpr (P::FP8) { _Pragma("unroll") for (int m = 0; m < 4; ++m) fg.dst[m] = __builtin_bit_cast(v8i, PG8_RD8(lds + PG8_SA(b, h) + aoff + m * 2048)); } \
        else { _Pragma("unroll") for (int m = 0; m < 4; ++m) _Pragma("unroll") for (int k = 0; k < 2; ++k) fg.dst[m][k] = *(const LAS bf16x8*)(lds + PG8_SA(b, h) + aoff + m * 2048 + k * 1024); } } while (0)
#define PG8_LDB(dst, b, h) do { if constexpr (P::FP8) { _Pragma("unroll") for (int n = 0; n < 2; ++n) fg.dst[n] = __builtin_bit_cast(v8i, PG8_RD8(lds + PG8_SB(b, h) + boff + n * 2048)); } \
        else { _Pragma("unroll") for (int n = 0; n < 2; ++n) _Pragma("unroll") for (int k = 0; k < 2; ++k) fg.dst[n][k] = *(const LAS bf16x8*)(lds + PG8_SB(b, h) + boff + n * 2048 + k * 1024); } } while (0)
#define PG8_MMA(ai, bj, At, Bt) do { __builtin_amdgcn_s_setprio(1); \
        if constexpr (P::FP8) { _Pragma("unroll") for (int m = 0; m < 4; ++m) _Pragma("unroll") for (int n = 0; n < 2; ++n) \
            acc[ai][bj][m][n] = __builtin_amdgcn_mfma_scale_f32_16x16x128_f8f6f4(fg.Bt[n], fg.At[m], acc[ai][bj][m][n], 0, 0, 0, 0, 0, 0); } \
        else { _Pragma("unroll") for (int m = 0; m < 4; ++m) _Pragma("unroll") for (int n = 0; n < 2; ++n) _Pragma("unroll") for (int k = 0; k < 2; ++k) \
            acc[ai][bj][m][n] = __builtin_amdgcn_mfma_f32_16x16x32_bf16(fg.Bt[n][k], fg.At[m][k], acc[ai][bj][m][n], 0, 0, 0); } \
        __builtin_amdgcn_s_setprio(0); } while (0)
#define PG8_WAIT_V(n) asm volatile("s_waitcnt vmcnt(" #n ")" ::: "memory")
#define PG8_WAIT_L(n) asm volatile("s_waitcnt lgkmcnt(" #n ")" ::: "memory")
#define PG8_BAR __builtin_amdgcn_s_barrier()
#define PG8_SCHED __builtin_amdgcn_sched_barrier(0)
    Unit cur, nxt; int ui = 0;
    if (!pol.next(0, cur)) return;
    f32x4 acc[2][2][4][2];
#pragma unroll
    for (int a = 0; a < 2; ++a)
#pragma unroll
        for (int b = 0; b < 2; ++b)
#pragma unroll
            for (int m = 0; m < 4; ++m)
#pragma unroll
                for (int n = 0; n < 2; ++n) acc[a][b][m][n] = (f32x4){0.f, 0.f, 0.f, 0.f};
    Frags<P::FP8> fg;
    int slot = 0;
    if (P::META) { pol.meta_issue(cur, 0, lds, wid, lane); PG8_WAIT_V(0); asm volatile("" ::: "memory"); PG8_BAR; asm volatile("" ::: "memory"); }
    unsigned aC[2][2];
    pol.a_off(cur, 0, lds, aC);
    const char* const Ab = (const char*)pol.A;
    const char* cB = pol.b_ptr(cur);
    PG8_STAGE(PG8_SB(0, 0), cB, voffB); PG8_STAGE(PG8_SB(0, 1), cB + hstep, voffB); PG8_STAGE(PG8_SA(0, 0), Ab, aC[0]); PG8_STAGE(PG8_SA(0, 1), Ab, aC[1]);
    if (wr == 1) PG8_BAR;
    PG8_WAIT_V(2); PG8_BAR;
    PG8_STAGE(PG8_SB(1, 0), cB + kstep, voffB); PG8_STAGE(PG8_SA(1, 0), Ab + kstep, aC[0]); PG8_STAGE(PG8_SB(1, 1), cB + hstep + kstep, voffB);
    PG8_WAIT_V(6); PG8_BAR;
    for (;;) {
        const bool has_next = pol.next(ui + 1, nxt);
        const int nslot = slot == 2 ? 0 : slot + 1;
        if (P::META) { if (has_next) pol.meta_issue(nxt, nslot, lds, wid, lane); }
        const char* nB = has_next ? pol.b_ptr(nxt) : cB;
#pragma unroll 1
        for (int t = 0; t < NKT_; t += 2) {
            const bool last = (t == NKT_ - 2);
            const char* a1 = Ab + (size_t)(t + 1) * kstep;
            const char* a2 = last ? Ab : Ab + (size_t)(t + 2) * kstep; const char* b2 = last ? nB : cB + (size_t)(t + 2) * kstep;
            const char* a3 = a2 + kstep; const char* b3 = b2 + kstep;
            PG8_LDB(B0, 0, 0); PG8_LDB(B1, 0, 1); PG8_SCHED; PG8_LDA(At, 0, 0); PG8_STAGE(PG8_SA(1, 1), a1, aC[1]);
            if (last && has_next) pol.a_off(nxt, nslot, lds, aC);
            PG8_WAIT_V(8); PG8_WAIT_L(0); PG8_BAR; PG8_MMA(0, 0, At, B0); PG8_MMA(0, 1, At, B1); PG8_BAR; PG8_SCHED;
            PG8_LDA(At, 0, 1); PG8_STAGE(PG8_SB(0, 0), b2, voffB); PG8_STAGE(PG8_SB(0, 1), b2 + hstep, voffB); PG8_STAGE(PG8_SA(0, 0), a2, aC[0]);
            PG8_WAIT_V(8); PG8_WAIT_L(0); PG8_BAR; PG8_MMA(1, 0, At, B0); PG8_MMA(1, 1, At, B1); PG8_BAR; PG8_SCHED;
            PG8_LDB(B0, 1, 0); PG8_LDB(B1, 1, 1); PG8_SCHED; PG8_LDA(At, 1, 0); PG8_STAGE(PG8_SA(0, 1), a2, aC[1]);
            PG8_WAIT_V(8); PG8_WAIT_L(0); PG8_BAR; PG8_MMA(0, 0, At, B0); PG8_MMA(0, 1, At, B1); PG8_BAR; PG8_SCHED;
            PG8_LDA(At, 1, 1); PG8_STAGE(PG8_SB(1, 0), b3, voffB); PG8_STAGE(PG8_SB(1, 1), b3 + hstep, voffB); PG8_STAGE(PG8_SA(1, 0), a3, aC[0]);
            PG8_WAIT_V(8); PG8_WAIT_L(0); PG8_BAR; PG8_MMA(1, 0, At, B0); PG8_MMA(1, 1, At, B1); PG8_BAR; PG8_SCHED;
        }
        if (wr == 0) PG8_BAR;
        pol.epi(acc, cur, slot, lds, wr, wc, fr, fq);
#ifdef PROBE_EPI2
        if (P::META) { asm volatile("" ::: "memory");
#pragma unroll
            for (int a = 0; a < 2; ++a)
#pragma unroll
                for (int b = 0; b < 2; ++b)
#pragma unroll
                    for (int m = 0; m < 4; ++m)
#pragma unroll
                        for (int n = 0; n < 2; ++n) asm volatile("" : "+v"(acc[a][b][m][n]));
            pol.epi(acc, cur, slot, lds, wr, wc, fr, fq); }
#endif
        if (!has_next) break;
#pragma unroll
        for (int a = 0; a < 2; ++a)
#pragma unroll
            for (int b = 0; b < 2; ++b)
#pragma unroll
                for (int m = 0; m < 4; ++m)
#pragma unroll
                    for (int n = 0; n < 2; ++n) acc[a][b][m][n] = (f32x4){0.f, 0.f, 0.f, 0.f};
        cur = nxt; cB = nB; ++ui; slot = nslot;
        if (wr == 1) PG8_BAR;
    }
    PG8_WAIT_V(0);
    PG8_BAR;
#undef PG8_SA
#undef PG8_SB
#undef PG8_STAGE
#undef PG8_LDA
#undef PG8_LDB
#undef PG8_MMA
#undef PG8_RD8
#undef PG8_WAIT_V
#undef PG8_WAIT_L
#undef PG8_BAR
#undef PG8_SCHED
}
}

typedef f32x4 AccT[2][2][4][2];

struct PolProj {
    static constexpr bool PERM = true, META = false, FP8 = false; static constexpr int SCALE_W = 0x7f7f7f7f;
    const bf16_t* A; const bf16_t* Bt; bf16_t* O; int G, c;
    __device__ __forceinline__ bool next(int i, pg8::Unit& u) const {
        const int L = i * G + c;
        if (L < 640) { pg8::static_tile(L, 64, 10, u.pm, u.pn); return true; }
        if (L < 648) { const int j = L - 640; u.pm = 64 + (j >> 2); u.pn = 2 + (j & 3); return true; }
        return false;
    }
    __device__ __forceinline__ const char* b_ptr(const pg8::Unit& u) const { return (const char*)Bt + (size_t)u.pn * 256 * 1024 * 2; }
    __device__ __forceinline__ void meta_issue(const pg8::Unit&, int, LAS unsigned char*, int, int) const {}
    __device__ __forceinline__ void a_off(const pg8::Unit& u, int, LAS unsigned char*, unsigned (&o)[2][2]) const {
        int Ra[2], Ca[2]; pg8::stage_rc((int)threadIdx.x * 16, Ra[0], Ca[0]); pg8::stage_rc((int)threadIdx.x * 16 + 8192, Ra[1], Ca[1]);
#pragma unroll
        for (int h = 0; h < 2; ++h)
#pragma unroll
            for (int i = 0; i < 2; ++i) o[h][i] = (unsigned)((u.pm * 256 + 128 * h + Ra[i]) * 1024 + Ca[i]) * 2u;
    }
    __device__ __forceinline__ void epi(const AccT& acc, const pg8::Unit& u, int, LAS unsigned char*, int wr, int wc, int fr, int fq) const {
        const int row0 = u.pm * 256 + wr * 64 + fr, col0 = u.pn * 256 + wc * 32 + 8 * fq;
        const bool act = u.pn >= 6;
#pragma unroll
        for (int ai = 0; ai < 2; ++ai)
#pragma unroll
            for (int m = 0; m < 4; ++m) { bf16_t* rowp = O + (size_t)(row0 + ai * 128 + m * 16) * DIN + col0;
#pragma unroll
                for (int bj = 0; bj < 2; ++bj) { f32x4 v0 = acc[ai][bj][m][0], v1 = acc[ai][bj][m][1];
                    if (act) {
#pragma unroll
                        for (int j = 0; j < 4; ++j) { v0[j] = gelu_fast(v0[j]); v1[j] = gelu_fast(v1[j]); } }
                    u32x4 w; w.x = cvt_pk_bf16(v0[0], v0[1]); w.y = cvt_pk_bf16(v0[2], v0[3]); w.z = cvt_pk_bf16(v1[0], v1[1]); w.w = cvt_pk_bf16(v1[2], v1[3]);
                    *(u32x4*)(rowp + bj * 128) = w; } }
    }
};

struct PolOut {
    static constexpr bool PERM = false, META = false, FP8 = false; static constexpr int SCALE_W = 0x7f7f7f7f;
    const bf16_t* A; const bf16_t* Bt; const float* x; const float* mod; float* Y; int G, c;
    __device__ __forceinline__ bool next(int i, pg8::Unit& u) const { const int L = i * G + c; if (L >= 256) return false; pg8::static_tile(L, 64, 4, u.pm, u.pn); return true; }
    __device__ __forceinline__ const char* b_ptr(const pg8::Unit& u) const { return (const char*)Bt + (size_t)u.pn * 256 * 1024 * 2; }
    __device__ __forceinline__ void meta_issue(const pg8::Unit&, int, LAS unsigned char*, int, int) const {}
    __device__ __forceinline__ void a_off(const pg8::Unit& u, int, LAS unsigned char*, unsigned (&o)[2][2]) const {
        int Ra[2], Ca[2]; pg8::stage_rc((int)threadIdx.x * 16, Ra[0], Ca[0]); pg8::stage_rc((int)threadIdx.x * 16 + 8192, Ra[1], Ca[1]);
#pragma unroll
        for (int h = 0; h < 2; ++h)
#pragma unroll
            for (int i = 0; i < 2; ++i) o[h][i] = (unsigned)((u.pm * 256 + 128 * h + Ra[i]) * 1024 + Ca[i]) * 2u;
    }
    __device__ __forceinline__ void epi(const AccT& acc, const pg8::Unit& u, int, LAS unsigned char*, int wr, int wc, int fr, int fq) const {
        const int row0 = u.pm * 256 + wr * 64 + fr, col0 = u.pn * 256 + wc * 32 + 4 * fq;
        const float* g1 = mod + (u.pm >= 32 ? 6144 : 0) + 2 * 1024;
        f32x4 gv[2][2];
#pragma unroll
        for (int bj = 0; bj < 2; ++bj)
#pragma unroll
            for (int n = 0; n < 2; ++n) gv[bj][n] = *(const f32x4*)(g1 + col0 + bj * 128 + n * 16);
#pragma unroll
        for (int ai = 0; ai < 2; ++ai)
#pragma unroll
            for (int m = 0; m < 4; ++m) { const size_t off = (size_t)(row0 + ai * 128 + m * 16) * D + col0;
#pragma unroll
                for (int bj = 0; bj < 2; ++bj)
#pragma unroll
                    for (int n = 0; n < 2; ++n) { const f32x4 xv = *(const f32x4*)(x + off + bj * 128 + n * 16);
                        *(f32x4*)(Y + off + bj * 128 + n * 16) = xv * DN_ALPHA + gv[bj][n] * acc[ai][bj][m][n]; }
                asm volatile("" ::: "memory"); }
    }
};

struct ExpTab { const LAS int* tile_e; const LAS int* tstart; const LAS int* cnt; int T; };
__device__ __forceinline__ int expert_tables(Frame& F) {
    LAS int* tile_e = (LAS int*)(F.lds + L_TILEE); LAS int* tstart = (LAS int*)(F.lds + L_TSTART); LAS int* cn = tstart + 64;
    if (F.tid < 32) cn[F.tid] = (int)__hip_atomic_load(F.ctl + CW_CNT + 32 * F.tid, __ATOMIC_RELAXED, __HIP_MEMORY_SCOPE_AGENT);
    __syncthreads();
    if (F.tid == 0) { int run = 0; for (int e = 0; e < NE; ++e) { tstart[e] = run; run += (cn[e] + 255) >> 8; } tstart[NE] = run; }
    __syncthreads();
    const int T = tstart[NE];
    if (F.tid < MAXT && F.tid < T) { int e = 0; while (e < NE - 1 && tstart[e + 1] <= F.tid) ++e; tile_e[F.tid] = e; }
    __syncthreads();
    return T < MAXT ? T : MAXT;
}
__device__ __forceinline__ int rfl(int v) { return __builtin_amdgcn_readfirstlane(v); }

struct PolGU {
    static constexpr bool PERM = true, META = true, FP8 = true; static constexpr int SCALE_W = 0; static constexpr float WSC = 1.f / 64.f;
    const unsigned char* A; const unsigned char* Bt; const float* bias; const int* list; unsigned char* O; ExpTab tb; int G, c;
    __device__ __forceinline__ bool next(int i, pg8::Unit& u) const {
        const int L = i * G + c; if (L >= tb.T * 8) return false;
        u.ti = L >> 3; u.pn = L & 7; u.e = rfl(tb.tile_e[u.ti]); u.pm = u.ti - rfl(tb.tstart[u.e]);
        const int rem = rfl(tb.cnt[u.e]) - u.pm * 256; u.nvalid = rem < 256 ? rem : 256; return true;
    }
    __device__ __forceinline__ const char* b_ptr(const pg8::Unit& u) const { return (const char*)Bt + ((size_t)u.e * 2048 + (size_t)u.pn * 256) * 1024; }
    __device__ __forceinline__ void meta_issue(const pg8::Unit& u, int slot, LAS unsigned char* lds, int wid, int lane) const {
        if (wid < 4) __builtin_amdgcn_global_load_lds((const unsigned*)(list + (size_t)u.e * LCAP + u.pm * 256 + wid * 64 + lane), (LAS unsigned*)(lds + L_IDX + slot * 1024 + wid * 256), 4, 0, 0);
    }
    __device__ __forceinline__ void a_off(const pg8::Unit& u, int slot, LAS unsigned char* lds, unsigned (&o)[2][2]) const {
        int Ra[2], Ca[2]; pg8::stage_rc((int)threadIdx.x * 16, Ra[0], Ca[0]); pg8::stage_rc((int)threadIdx.x * 16 + 8192, Ra[1], Ca[1]);
        const LAS int* idx = (const LAS int*)(lds + L_IDX + slot * 1024);
#pragma unroll
        for (int h = 0; h < 2; ++h)
#pragma unroll
            for (int i = 0; i < 2; ++i) { const int r = 128 * h + Ra[i]; int pr = idx[r]; pr = r < u.nvalid ? pr : 0; o[h][i] = (unsigned)((pr >> 2) * 1024 + Ca[i] * 2); }
    }
    __device__ __forceinline__ void epi(const AccT& acc, const pg8::Unit& u, int, LAS unsigned char*, int wr, int wc, int fr, int fq) const {
        const int row0 = u.ti * 256 + wr * 64 + fr, col0 = u.pn * 128 + wc * 32 + 8 * fq;
        const float* bg = bias + (size_t)u.e * 2048 + col0;
        const f32x4 g0 = *(const f32x4*)(bg), g1 = *(const f32x4*)(bg + 4), l0 = *(const f32x4*)(bg + 1024), l1 = *(const f32x4*)(bg + 1028);
#pragma unroll
        for (int ai = 0; ai < 2; ++ai)
#pragma unroll
            for (int m = 0; m < 4; ++m) {
                f32x4 a0 = acc[ai][0][m][0] * WSC + g0, a1 = acc[ai][0][m][1] * WSC + g1, b0 = acc[ai][1][m][0] * WSC + l0, b1 = acc[ai][1][m][1] * WSC + l1, r0, r1;
#pragma unroll
                for (int j = 0; j < 4; ++j) {
                    { const float g = fminf(a0[j], 7.f), l = fminf(fmaxf(b0[j], -7.f), 7.f); r0[j] = (l + 1.f) * g * __builtin_amdgcn_rcpf(1.f + __builtin_amdgcn_exp2f(-2.45546696f * g)); }
                    { const float g = fminf(a1[j], 7.f), l = fminf(fmaxf(b1[j], -7.f), 7.f); r1[j] = (l + 1.f) * g * __builtin_amdgcn_rcpf(1.f + __builtin_amdgcn_exp2f(-2.45546696f * g)); }
                }
                u32x2 w; w.x = (unsigned)__builtin_amdgcn_cvt_pk_fp8_f32(r0[2], r0[3], __builtin_amdgcn_cvt_pk_fp8_f32(r0[0], r0[1], 0, false), true);
                w.y = (unsigned)__builtin_amdgcn_cvt_pk_fp8_f32(r1[2], r1[3], __builtin_amdgcn_cvt_pk_fp8_f32(r1[0], r1[1], 0, false), true);
                *(u32x2*)(O + (size_t)(row0 + ai * 128 + m * 16) * DFF + col0) = w; }
    }
};

struct PolDN {
    static constexpr bool PERM = true, META = true, FP8 = true; static constexpr int SCALE_W = 0; static constexpr float WSC = 1.f / 64.f;
    const unsigned char* A; const unsigned char* Bt; const float* bias; const int* list; const float* topg; bf16_t* O; ExpTab tb; int G, c;
    __device__ __forceinline__ bool next(int i, pg8::Unit& u) const {
        const int L = i * G + c; if (L >= tb.T * 4) return false;
        u.ti = L >> 2; u.pn = L & 3; u.e = rfl(tb.tile_e[u.ti]); u.pm = u.ti - rfl(tb.tstart[u.e]);
        const int rem = rfl(tb.cnt[u.e]) - u.pm * 256; u.nvalid = rem < 256 ? rem : 256; return true;
    }
    __device__ __forceinline__ const char* b_ptr(const pg8::Unit& u) const { return (const char*)Bt + ((size_t)u.e * 1024 + (size_t)u.pn * 256) * 1024; }
    __device__ __forceinline__ void meta_issue(const pg8::Unit& u, int slot, LAS unsigned char* lds, int wid, int lane) const {
        if (wid < 4) __builtin_amdgcn_global_load_lds((const unsigned*)(list + (size_t)u.e * LCAP + u.pm * 256 + wid * 64 + lane), (LAS unsigned*)(lds + L_IDX + slot * 1024 + wid * 256), 4, 0, 0);
    }
    __device__ __forceinline__ void a_off(const pg8::Unit& u, int, LAS unsigned char*, unsigned (&o)[2][2]) const {
        int Ra[2], Ca[2]; pg8::stage_rc((int)threadIdx.x * 16, Ra[0], Ca[0]); pg8::stage_rc((int)threadIdx.x * 16 + 8192, Ra[1], Ca[1]);
#pragma unroll
        for (int h = 0; h < 2; ++h)
#pragma unroll
            for (int i = 0; i < 2; ++i) o[h][i] = (unsigned)((u.ti * 256 + 128 * h + Ra[i]) * 1024 + Ca[i] * 2);
    }
    __device__ __forceinline__ void epi(const AccT& acc, const pg8::Unit& u, int slot, LAS unsigned char* lds, int wr, int wc, int fr, int fq) const {
        const LAS int* idx = (const LAS int*)(lds + L_IDX + slot * 1024);
        const int col0 = u.pn * 256 + wc * 32 + 8 * fq;
        const float* bd = bias + (size_t)u.e * 1024 + col0;
        f32x4 bv[2][2];
#pragma unroll
        for (int bj = 0; bj < 2; ++bj)
#pragma unroll
            for (int n = 0; n < 2; ++n) bv[bj][n] = *(const f32x4*)(bd + bj * 128 + 4 * n);
#pragma unroll
        for (int ai = 0; ai < 2; ++ai)
#pragma unroll
            for (int m = 0; m < 4; ++m) { const int r = ai * 128 + wr * 64 + m * 16 + fr;
                if (r < u.nvalid) { const int pr = idx[r]; const float gt = topg[pr]; bf16_t* rowp = O + (size_t)pr * D + col0;
#pragma unroll
                    for (int bj = 0; bj < 2; ++bj) { const f32x4 v0 = (acc[ai][bj][m][0] * WSC + bv[bj][0]) * gt, v1 = (acc[ai][bj][m][1] * WSC + bv[bj][1]) * gt;
                        u32x4 w; w.x = cvt_pk_bf16(v0[0], v0[1]); w.y = cvt_pk_bf16(v0[2], v0[3]); w.z = cvt_pk_bf16(v1[0], v1[1]); w.w = cvt_pk_bf16(v1[2], v1[3]);
                        *(u32x4*)(rowp + bj * 128) = w; } } }
    }
};

__device__ __forceinline__ void p_ada(Frame& F) {
    LAS float* sl = (LAS float*)F.lds;
    LAS float* red = sl + 3072;
    for (int i = F.tid; i < 3072; i += 512) { const int w = i >> 10, k = i & 1023; const float v = w < 2 ? F.c[w * D + k] : F.c_ctx[k]; sl[i] = v / (1.f + __expf(-v)); }
    __syncthreads();
    for (int slab = blockIdx.x; slab < 256; slab += F.G) {
        const int j0 = slab * 24, cg = F.tid % 6, kr = F.tid / 6;
        float a[3][4] = {};
        if (F.tid < 480) {
            for (int k = kr; k < D; k += 80) {
                const f32x4 w4 = *(const f32x4*)(F.ada_w + (size_t)k * 6144 + j0 + 4 * cg);
                const float s0 = sl[k], s1 = sl[1024 + k], s2 = sl[2048 + k];
#pragma unroll
                for (int q = 0; q < 4; ++q) { a[0][q] += s0 * w4[q]; a[1][q] += s1 * w4[q]; a[2][q] += s2 * w4[q]; }
            }
#pragma unroll
            for (int w = 0; w < 3; ++w)
#pragma unroll
                for (int q = 0; q < 4; ++q) red[kr * 72 + cg * 12 + w * 4 + q] = a[w][q];
        }
        __syncthreads();
        if (F.tid < 72) {
            float s = 0.f;
            for (int r = 0; r < 80; ++r) s += red[r * 72 + F.tid];
            const int g = F.tid / 12, w = (F.tid % 12) >> 2, q = F.tid & 3, col = j0 + 4 * g + q;
            F.mod[w * 6144 + col] = s + F.ada_b[col];
        }
        __syncthreads();
    }
}

__device__ __forceinline__ void transpose_item(const float* W, int K, int N, bf16_t* WT, int item, bool gu_map, LAS float* scr, int lane) {
    const int nblk = N / 32, kb = item / nblk, nb = item % nblk, k0 = 64 * kb, n0 = 32 * nb;
#pragma unroll 8
    for (int i = 0; i < 32; ++i) { const int kk = 2 * i + (lane >> 5); scr[kk * 33 + (lane & 31)] = W[(size_t)(k0 + kk) * N + n0 + (lane & 31)]; }
    LDS_WAIT(); asm volatile("" ::: "memory");
    int d0 = n0;
    if (gu_map) { const int nn = n0 & 1023; d0 = (nn >> 7) * 256 + (nn & 127) + ((n0 >> 10) ? 128 : 0); }
    const int c = lane & 7;
#pragma unroll
    for (int j = 0; j < 4; ++j) { const int n = (lane >> 3) + 8 * j; const LAS float* s = scr + (8 * c) * 33 + n;
        u32x4 o; o.x = pk2(s[0 * 33], s[1 * 33]); o.y = pk2(s[2 * 33], s[3 * 33]); o.z = pk2(s[4 * 33], s[5 * 33]); o.w = pk2(s[6 * 33], s[7 * 33]);
        *(u32x4*)(WT + (size_t)(d0 + n) * K + k0 + 8 * c) = o; }
    LDS_WAIT(); asm volatile("" ::: "memory");
}
__device__ __forceinline__ unsigned pk4_fp8(float a, float b, float c, float d) { return (unsigned)__builtin_amdgcn_cvt_pk_fp8_f32(c, d, __builtin_amdgcn_cvt_pk_fp8_f32(a, b, 0, false), true); }
__device__ __forceinline__ void transpose_item8(const float* W, int K, int N, unsigned char* WT, int item, bool gu_map, LAS float* scr, int lane) {
    const int nblk = N / 32, kb = item / nblk, nb = item % nblk, k0 = 64 * kb, n0 = 32 * nb;
#pragma unroll 8
    for (int i = 0; i < 32; ++i) { const int kk = 2 * i + (lane >> 5); scr[kk * 33 + (lane & 31)] = W[(size_t)(k0 + kk) * N + n0 + (lane & 31)]; }
    LDS_WAIT(); asm volatile("" ::: "memory");
    int d0 = n0;
    if (gu_map) { const int nn = n0 & 1023; d0 = (nn >> 7) * 256 + (nn & 127) + ((n0 >> 10) ? 128 : 0); }
    const int c = lane & 7;
#pragma unroll
    for (int j = 0; j < 4; ++j) { const int n = (lane >> 3) + 8 * j; const LAS float* s = scr + (8 * c) * 33 + n;
        u32x2 o; o.x = pk4_fp8(s[0 * 33] * 64.f, s[1 * 33] * 64.f, s[2 * 33] * 64.f, s[3 * 33] * 64.f); o.y = pk4_fp8(s[4 * 33] * 64.f, s[5 * 33] * 64.f, s[6 * 33] * 64.f, s[7 * 33] * 64.f);
        *(u32x2*)(WT + (size_t)(d0 + n) * K + k0 + 8 * c) = o; }
    LDS_WAIT(); asm volatile("" ::: "memory");
}
__device__ __forceinline__ void p_weights(Frame& F) {
    LAS float* scr = (LAS float*)(F.lds + F.wave * 16384);
    const int gw = F.vcu * 8 + F.wave, NGW = F.G * 8;
    constexpr int I_IN = 16 * 80, I_OUT = 16 * 32, I_GU = 16 * 64, I_DN = 16 * 32;
    constexpr int NITEMS = I_IN + I_OUT + NE * I_GU + NE * I_DN;
    for (int it = gw; it < NITEMS; it += NGW) {
        int r = it;
        if (r < I_IN) { transpose_item(F.w_in, D, DIN, F.Wt_in, r, false, scr, F.lane); continue; } r -= I_IN;
        if (r < I_OUT) { transpose_item(F.w_out, D, D, F.Wt_out, r, false, scr, F.lane); continue; } r -= I_OUT;
        if (r < NE * I_GU) { const int e = r / I_GU; transpose_item8(F.w_gu + (size_t)e * D * 2048, D, 2048, F.Wt_gu + (size_t)e * 2048 * D, r % I_GU, true, scr, F.lane); continue; } r -= NE * I_GU;
        { const int e = r / I_DN; transpose_item8(F.w_dn + (size_t)e * DFF * D, DFF, D, F.Wt_dn + (size_t)e * D * DFF, r % I_DN, false, scr, F.lane); }
    }
    for (int i = (blockIdx.x * 512 + F.tid) * 4; i < 4 * 128 * 128; i += F.G * 512 * 4) {
        const f32x4 v = *(const f32x4*)(F.sgu_w + i); u32x2 o; o.x = pk2(v[0], v[1]); o.y = pk2(v[2], v[3]); *(u32x2*)(F.sguw + i) = o; }
}
__device__ __forceinline__ void p_lnmod(Frame& F) {
    const int gw = F.vcu * 8 + F.wave, NGW = F.G * 8;
    for (int row = gw; row < MX; row += NGW) {
        const float* xr; const float* md;
        if (row < M) { xr = F.x + (size_t)row * D; md = F.mod + (row >> 13) * 6144; } else { xr = F.ctx + (size_t)(row - M) * D; md = F.mod + 2 * 6144; }
        const f32x4* xp = (const f32x4*)xr + F.lane;
        f32x4 v[4]; float s = 0.f;
#pragma unroll
        for (int j = 0; j < 4; ++j) { v[j] = xp[64 * j]; s += (v[j][0] + v[j][1]) + (v[j][2] + v[j][3]); }
        const float mean = wsum(s) * (1.f / D); float q = 0.f;
#pragma unroll
        for (int j = 0; j < 4; ++j) { v[j] = v[j] - mean; q += (v[j][0] * v[j][0] + v[j][1] * v[j][1]) + (v[j][2] * v[j][2] + v[j][3] * v[j][3]); }
        const float rstd = rsqrtf(wsum(q) * (1.f / D) + EPS);
        u32x2* op = (u32x2*)(F.hxc + (size_t)row * D) + F.lane;
#pragma unroll
        for (int j = 0; j < 4; ++j) { const f32x4 sh = *((const f32x4*)md + F.lane + 64 * j), sc = *((const f32x4*)(md + 1024) + F.lane + 64 * j);
            const f32x4 o = v[j] * rstd * (sc + 1.f) + sh; u32x2 w; w.x = pk2(o[0], o[1]); w.y = pk2(o[2], o[3]); op[64 * j] = w; }
    }
}

__device__ __forceinline__ void p_attn_simple(Frame& F) {
    LAS float* sq = (LAS float*)(F.lds + F.wave * 4096);
    LAS float* sp = sq + 64;
    const int gw = F.vcu * 8 + F.wave, NGW = F.G * 8;
    for (int gid = gw; gid < M * NH; gid += NGW) {
        const int h = gid & 7, tok = gid >> 3, b = tok >> 13, t = tok & (S - 1), r = t >> 6, c = t & 63;
        const int rs = min(max(r - KH / 2, 0), ROWS - KH), cs = min(max(c - KW / 2, 0), GW - KW);
        sq[F.lane] = bf2f(F.proj[(size_t)tok * DIN + h * 64 + F.lane]);
        LDS_WAIT(); asm volatile("" ::: "memory");
        float sc[6]; float mx = -1e30f;
#pragma unroll
        for (int i = 0; i < 6; ++i) {
            const int kk = F.lane + 64 * i;
            const bf16_t* kp; float bias = 0.f;
            if (kk < 128) { const int ki = kk >> 4, kj = kk & 15;
                kp = F.proj + (size_t)(b * S + (rs + ki) * GW + cs + kj) * DIN + 512 + h * 64;
                bias = F.rpb[(h * 15 + (rs + ki - r + 7)) * 31 + (cs + kj - c + 15)];
            } else kp = F.proj + (size_t)(M + b * CTX + (kk - 128)) * DIN + 512 + h * 64;
            float d = 0.f;
#pragma unroll
            for (int dd = 0; dd < 64; dd += 8) { const u32x4 kv = *(const u32x4*)(kp + dd);
                d += sq[dd] * bflo(kv.x) + sq[dd + 1] * bfhi(kv.x) + sq[dd + 2] * bflo(kv.y) + sq[dd + 3] * bfhi(kv.y) + sq[dd + 4] * bflo(kv.z) + sq[dd + 5] * bfhi(kv.z) + sq[dd + 6] * bflo(kv.w) + sq[dd + 7] * bfhi(kv.w); }
            sc[i] = d * 0.125f + bias; mx = fmaxf(mx, sc[i]);
        }
        mx = wmax(mx);
        float sum = 0.f;
#pragma unroll
        for (int i = 0; i < 6; ++i) { const float p = __expf(sc[i] - mx); sum += p; sp[F.lane + 64 * i] = p; }
        sum = wsum(sum);
        LDS_WAIT(); asm volatile("" ::: "memory");
        float acc = 0.f;
        for (int kk = 0; kk < 384; ++kk) {
            const bf16_t* vp;
            if (kk < 128) { const int ki = kk >> 4, kj = kk & 15; vp = F.proj + (size_t)(b * S + (rs + ki) * GW + cs + kj) * DIN + 1024 + h * 64; }
            else vp = F.proj + (size_t)(M + b * CTX + (kk - 128)) * DIN + 1024 + h * 64;
            acc += sp[kk] * bf2f(vp[F.lane]);
        }
        F.mixin[(size_t)tok * D + h * 64 + F.lane] = (bf16_t)f2bf(acc / sum);
        LDS_WAIT(); asm volatile("" ::: "memory");
    }
}
__device__ __forceinline__ void p_sgu_simple(Frame& F) {
    LAS bf16_t* G = (LAS bf16_t*)F.lds;
    for (int u = blockIdx.x; u < M / 128; u += F.G) {
        const int base = u * 128;
        for (int tl = F.wave; tl < 128; tl += 8) {
            const bf16_t* zr = F.proj + (size_t)(base + tl) * DIN + 2048 + F.lane * 8;
            const u32x4 zv = *(const u32x4*)zr;
            float v[8] = {bflo(zv.x), bfhi(zv.x), bflo(zv.y), bfhi(zv.y), bflo(zv.z), bfhi(zv.z), bflo(zv.w), bfhi(zv.w)};
            float s = 0.f;
#pragma unroll
            for (int i = 0; i < 8; ++i) s += v[i];
            const float mean = wsum(s) * (1.f / 512.f); float q = 0.f;
#pragma unroll
            for (int i = 0; i < 8; ++i) { v[i] -= mean; q += v[i] * v[i]; }
            const float rstd = rsqrtf(wsum(q) * (1.f / 512.f) + EPS);
#pragma unroll
            for (int i = 0; i < 8; ++i) { const int ch = F.lane * 8 + i; G[tl * 512 + ch] = (bf16_t)f2bf(v[i] * rstd * F.sgu_ln_g[ch] + F.sgu_ln_b[ch]); }
        }
        __syncthreads();
        const int ch = F.tid, grp = ch >> 7;
        for (int i = 0; i < 128; ++i) {
            const float* wrow = F.sgu_w + (size_t)(grp * 128 + i) * 128;
            float acc = 0.f;
            for (int j = 0; j < 128; ++j) acc += wrow[j] * bf2f(G[j * 512 + ch]);
            acc += F.sgu_b[grp * 128 + i];
            const float uu = bf2f(F.proj[(size_t)(base + i) * DIN + 1536 + ch]);
            F.mixin[(size_t)(base + i) * D + 512 + ch] = (bf16_t)f2bf(uu * acc);
        }
        __syncthreads();
    }
}

namespace at {
typedef float f32x16 __attribute__((ext_vector_type(16)));
typedef short s16x4 __attribute__((ext_vector_type(4)));
typedef short v4i16_t __attribute__((ext_vector_type(4)));
constexpr int A_K = 0, A_V = 16384, A_STG = 32768, A_WSF = 65536, A_RPB = 67584;
constexpr float C2 = 0.125f * 1.4426950408889634f, L2E = 1.4426950408889634f;
__device__ __forceinline__ int crow(int r, int hi) { return (r & 3) + 8 * (r >> 2) + 4 * hi; }
__device__ __forceinline__ s16x4 vtr(const LAS unsigned char* p) { return __builtin_bit_cast(s16x4, __builtin_amdgcn_ds_read_tr16_b64_v4i16((LAS v4i16_t*)p)); }
__device__ __forceinline__ int rsf(int r) { return min(max(r - KH / 2, 0), ROWS - KH); }
#define AT_WAIT_BAR() asm volatile("s_waitcnt vmcnt(0) lgkmcnt(0)\n\ts_barrier" ::: "memory")

__device__ __forceinline__ void attn_unit(Frame& F, int b, int h, int rg) {
    const int lane = F.lane, r32 = lane & 31, hi = lane >> 5, w = F.wave;
    const int r0 = 4 * rg, r = r0 + (w >> 1), c = 32 * (w & 1) + r32;
    const int krlo = rsf(r0), nnb = rsf(r0 + 3) + 7 - krlo + 1, nst = nnb + 4;
    const int rsw = rsf(r), cs = min(max(c - KW / 2, 0), GW - KW);
    LAS float* tbl = (LAS float*)(F.lds + A_RPB);
    LAS float* wsf = (LAS float*)(F.lds + A_WSF) + w * 64;
    for (int i = F.tid; i < 480; i += 512) { const int dr = i >> 5, dc = i & 31; tbl[64 + i] = dc < 31 ? F.rpb[(h * 15 + dr) * 31 + dc] * L2E : 0.f; }
    const bf16_t* qp = F.proj + (size_t)(b * S + r * GW + c) * DIN + h * 64 + hi * 8;
    bf16x8 qr[4];
#pragma unroll
    for (int d0 = 0; d0 < 4; ++d0) qr[d0] = *(const bf16x8*)(qp + d0 * 16);
    const bf16_t* kbase = F.proj + 512 + h * 64 + w * 8;
    const bf16_t* vbase = F.proj + 1024 + h * 64 + (w >> 2) * 32 + (lane & 3) * 8;
#define AT_DMA(st) do { const int _t0 = (st) < nnb ? b * S + (krlo + (st)) * GW : M + b * CTX + ((st) - nnb) * 64; const int _bf = ((st) & 1) * 8192; \
        __builtin_amdgcn_global_load_lds((const unsigned*)(kbase + (size_t)(_t0 + lane) * DIN), (LAS unsigned*)(F.lds + A_K + _bf + w * 1024), 16, 0, 0); \
        __builtin_amdgcn_global_load_lds((const unsigned*)(vbase + (size_t)(_t0 + 16 * (w & 3) + (lane >> 2)) * DIN), (LAS unsigned*)(F.lds + A_V + _bf + w * 1024), 16, 0, 0); } while (0)
    float m = -1e30f, l = 0.f;
    f32x16 o[2];
#pragma unroll
    for (int i = 0; i < 16; ++i) { o[0][i] = 0.f; o[1][i] = 0.f; }
    AT_DMA(0);
    for (int st = 0; st < nst; ++st) {
        AT_WAIT_BAR();
        if (st + 1 < nst) AT_DMA(st + 1);
        const bool isnb = st < nnb; const int kr = krlo + st;
        const bool act = !isnb || (kr >= rsw && kr < rsw + KH);
        if (act) {
            const LAS unsigned char* kp0 = F.lds + A_K + (st & 1) * 8192 + hi * 1024 + r32 * 16;
            f32x16 p0, p1;
#pragma unroll
            for (int i = 0; i < 16; ++i) { p0[i] = 0.f; p1[i] = 0.f; }
#pragma unroll
            for (int d0 = 0; d0 < 4; ++d0) {
                const bf16x8 b0 = *(const LAS bf16x8*)(kp0 + d0 * 2048), b1 = *(const LAS bf16x8*)(kp0 + d0 * 2048 + 512);
                p0 = __builtin_amdgcn_mfma_f32_32x32x16_bf16(b0, qr[d0], p0, 0, 0, 0);
                p1 = __builtin_amdgcn_mfma_f32_32x32x16_bf16(b1, qr[d0], p1, 0, 0, 0);
            }
            if (isnb) {
                const LAS float* tb = tbl + 64 + (kr - r + 7) * 32 + 4 * hi - c + 15;
#pragma unroll
                for (int rr = 0; rr < 16; ++rr) { const int ko = (rr & 3) + 8 * (rr >> 2), kc = ko + 4 * hi;
                    const float t0 = p0[rr] * C2 + tb[ko], t1 = p1[rr] * C2 + tb[ko + 32];
                    p0[rr] = (unsigned)(kc - cs) < (unsigned)KW ? t0 : -INFINITY; p1[rr] = (unsigned)(kc + 32 - cs) < (unsigned)KW ? t1 : -INFINITY; }
            } else {
#pragma unroll
                for (int rr = 0; rr < 16; ++rr) { p0[rr] *= C2; p1[rr] *= C2; }
            }
            float tm = fmaxf(p0[0], p1[0]);
#pragma unroll
            for (int rr = 1; rr < 16; ++rr) tm = fmaxf(tm, fmaxf(p0[rr], p1[rr]));
            tm = fmaxf(tm, __shfl_xor(tm, 32));
            const float mn = fmaxf(m, tm), alpha = __builtin_amdgcn_exp2f(m - mn);
            float rsum = 0.f;
#pragma unroll
            for (int rr = 0; rr < 16; ++rr) { p0[rr] = __builtin_amdgcn_exp2f(p0[rr] - mn); p1[rr] = __builtin_amdgcn_exp2f(p1[rr] - mn); rsum += p0[rr] + p1[rr]; }
            l = l * alpha + rsum; m = mn;
            if (__any(alpha != 1.f)) {
                if (hi == 0) wsf[r32] = alpha;
                LDS_WAIT();
#pragma unroll
                for (int rr = 0; rr < 16; ++rr) { const float a = wsf[crow(rr, hi)]; o[0][rr] *= a; o[1][rr] *= a; }
                LDS_WAIT();
            }
            u32x4 pw[4];
#pragma unroll
            for (int q = 0; q < 4; ++q) { pw[0][q] = cvt_pk_bf16(p0[2 * q], p0[2 * q + 1]); pw[1][q] = cvt_pk_bf16(p0[8 + 2 * q], p0[9 + 2 * q]);
                                          pw[2][q] = cvt_pk_bf16(p1[2 * q], p1[2 * q + 1]); pw[3][q] = cvt_pk_bf16(p1[8 + 2 * q], p1[9 + 2 * q]); }
            const LAS unsigned char* vp = F.lds + A_V + (st & 1) * 8192 + ((lane >> 4) & 1) * 32 + (lane & 3) * 8 + (4 * hi + ((lane & 15) >> 2)) * 64;
#pragma unroll
            for (int d0 = 0; d0 < 2; ++d0)
#pragma unroll
                for (int ks = 0; ks < 4; ++ks) {
                    const s16x4 lo = vtr(vp + d0 * 4096 + ks * 1024), hh = vtr(vp + d0 * 4096 + ks * 1024 + 512);
                    const bf16x8 vf = (bf16x8){lo[0], lo[1], lo[2], lo[3], hh[0], hh[1], hh[2], hh[3]};
                    o[d0] = __builtin_amdgcn_mfma_f32_32x32x16_bf16(__builtin_bit_cast(bf16x8, pw[ks]), vf, o[d0], 0, 0, 0);
                }
        }
    }
#undef AT_DMA
    l += __shfl_xor(l, 32);
    if (hi == 0) wsf[32 + r32] = l;
    LDS_WAIT();
    LAS bf16_t* stg = (LAS bf16_t*)(F.lds + A_STG) + w * 2048;
#pragma unroll
    for (int rr = 0; rr < 16; ++rr) { const int orow = crow(rr, hi); const float rl = __builtin_amdgcn_rcpf(wsf[32 + orow]);
        stg[orow * 64 + r32] = (bf16_t)f2bf(o[0][rr] * rl); stg[orow * 64 + 32 + r32] = (bf16_t)f2bf(o[1][rr] * rl); }
    LDS_WAIT();
    bf16_t* ow = F.mixin + (size_t)(b * S + r * GW + 32 * (w & 1)) * D + h * 64;
#pragma unroll
    for (int i = 0; i < 4; ++i) { const int row = i * 8 + (lane >> 3), ch = lane & 7; const u32x4 v = *(const LAS u32x4*)(stg + row * 64 + ch * 8); *(u32x4*)(ow + (size_t)row * D + ch * 8) = v; }
    AT_WAIT_BAR();
}

constexpr int G_IMG = 0, G_STG = 65536, G_STAT = 98304;
__device__ __forceinline__ void sgu_unit(Frame& F, int chunk, int gh) {
    const int lane = F.lane, r32 = lane & 31, hi = lane >> 5, w = F.wave;
    const int base = chunk * 128;
    LAS f32x2* stat = (LAS f32x2*)(F.lds + G_STAT);
    for (int t = 0; t < 16; ++t) {
        const int tok = 16 * w + t;
        const u32x4 zv = *(const u32x4*)(F.proj + (size_t)(base + tok) * DIN + 2048 + lane * 8);
        float v[8] = {bflo(zv.x), bfhi(zv.x), bflo(zv.y), bfhi(zv.y), bflo(zv.z), bfhi(zv.z), bflo(zv.w), bfhi(zv.w)};
        float s = 0.f;
#pragma unroll
        for (int i = 0; i < 8; ++i) s += v[i];
        const float mean = wsum(s) * (1.f / 512.f); float q = 0.f;
#pragma unroll
        for (int i = 0; i < 8; ++i) { const float d = v[i] - mean; q += d * d; }
        const float rstd = rsqrtf(wsum(q) * (1.f / 512.f) + EPS);
        if (lane == 0) stat[tok] = (f32x2){mean, rstd};
    }
    AT_WAIT_BAR();
    {
        const int ch0 = 256 * gh + 32 * w + 8 * (lane & 3);
        const f32x4 g0 = *(const f32x4*)(F.sgu_ln_g + ch0), g1 = *(const f32x4*)(F.sgu_ln_g + ch0 + 4), b0 = *(const f32x4*)(F.sgu_ln_b + ch0), b1 = *(const f32x4*)(F.sgu_ln_b + ch0 + 4);
#pragma unroll
        for (int i = 0; i < 8; ++i) {
            const int tok = 16 * i + (lane >> 2);
            const u32x4 zv = *(const u32x4*)(F.proj + (size_t)(base + tok) * DIN + 2048 + ch0);
            const f32x2 st = stat[tok];
            u32x4 o;
            o.x = pk2((bflo(zv.x) - st[0]) * st[1] * g0[0] + b0[0], (bfhi(zv.x) - st[0]) * st[1] * g0[1] + b0[1]);
            o.y = pk2((bflo(zv.y) - st[0]) * st[1] * g0[2] + b0[2], (bfhi(zv.y) - st[0]) * st[1] * g0[3] + b0[3]);
            o.z = pk2((bflo(zv.z) - st[0]) * st[1] * g1[0] + b1[0], (bfhi(zv.z) - st[0]) * st[1] * g1[1] + b1[1]);
            o.w = pk2((bflo(zv.w) - st[0]) * st[1] * g1[2] + b1[2], (bfhi(zv.w) - st[0]) * st[1] * g1[3] + b1[3]);
            *(LAS u32x4*)(F.lds + G_IMG + w * 8192 + i * 1024 + lane * 16) = o;
        }
    }
    AT_WAIT_BAR();
    const int cb = w & 3, th = w >> 2, grp = 2 * gh + (cb >> 1);
    f32x16 acc[2][2];
#pragma unroll
    for (int a = 0; a < 2; ++a)
#pragma unroll
        for (int q = 0; q < 2; ++q)
#pragma unroll
            for (int i = 0; i < 16; ++i) acc[a][q][i] = 0.f;
    const bf16_t* wp = F.sguw + (size_t)(grp * 128 + 64 * th + r32) * 128 + 8 * hi;
    const LAS unsigned char* gp = F.lds + G_IMG + (2 * cb) * 8192 + ((lane >> 4) & 1) * 32 + (lane & 3) * 8 + (8 * hi + ((lane & 15) >> 2)) * 64;
#pragma unroll
    for (int ks = 0; ks < 8; ++ks) {
        const bf16x8 w0 = *(const bf16x8*)(wp + ks * 16), w1 = *(const bf16x8*)(wp + 32 * 128 + ks * 16);
#pragma unroll
        for (int c32 = 0; c32 < 2; ++c32) {
            const s16x4 lo = vtr(gp + c32 * 8192 + ks * 1024), hh = vtr(gp + c32 * 8192 + ks * 1024 + 256);
            const bf16x8 gf = (bf16x8){lo[0], lo[1], lo[2], lo[3], hh[0], hh[1], hh[2], hh[3]};
            acc[0][c32] = __builtin_amdgcn_mfma_f32_32x32x16_bf16(gf, w0, acc[0][c32], 0, 0, 0);
            acc[1][c32] = __builtin_amdgcn_mfma_f32_32x32x16_bf16(gf, w1, acc[1][c32], 0, 0, 0);
        }
    }
    LAS unsigned char* stg = F.lds + G_STG + w * 4096;
#pragma unroll
    for (int ib = 0; ib < 2; ++ib) {
        const int i0 = 64 * th + 32 * ib;
        const float bi = F.sgu_b[grp * 128 + i0 + r32];
#pragma unroll
        for (int c32 = 0; c32 < 2; ++c32)
#pragma unroll
            for (int a = 0; a < 4; ++a) { u32x2 o; o.x = pk2(acc[ib][c32][4 * a] + bi, acc[ib][c32][4 * a + 1] + bi); o.y = pk2(acc[ib][c32][4 * a + 2] + bi, acc[ib][c32][4 * a + 3] + bi);
                *(LAS u32x2*)(stg + r32 * 128 + (((4 * c32 + a) ^ (r32 & 7)) << 4) + hi * 8) = o; }
        LDS_WAIT();
#pragma unroll
        for (int it = 0; it < 4; ++it) {
            const int row = 8 * it + (lane >> 3), chn = lane & 7;
            const u32x4 v = *(const LAS u32x4*)(stg + row * 128 + ((chn ^ (row & 7)) << 4));
            const size_t tok = (size_t)(base + i0 + row);
            const u32x4 uv = *(const u32x4*)(F.proj + tok * DIN + 1536 + 256 * gh + 64 * cb + 8 * chn);
            u32x4 o;
            o.x = pk2(bflo(v.x) * bflo(uv.x), bfhi(v.x) * bfhi(uv.x)); o.y = pk2(bflo(v.y) * bflo(uv.y), bfhi(v.y) * bfhi(uv.y));
            o.z = pk2(bflo(v.z) * bflo(uv.z), bfhi(v.z) * bfhi(uv.z)); o.w = pk2(bflo(v.w) * bflo(uv.w), bfhi(v.w) * bfhi(uv.w));
            *(u32x4*)(F.mixin + tok * D + 512 + 256 * gh + 64 * cb + 8 * chn) = o;
        }
        LDS_WAIT();
    }
    AT_WAIT_BAR();
}
__device__ __forceinline__ void p_mixer(Frame& F) {
    for (int uid = F.vcu; uid < NB * NH * 32; uid += F.G) attn_unit(F, uid >> 8, (uid >> 5) & 7, uid & 31);
    for (int uid = F.vcu; uid < (M / 128) * 2; uid += F.G) sgu_unit(F, uid >> 1, uid & 1);
}
#undef AT_WAIT_BAR
}

__device__ __forceinline__ void p_route(Frame& F) {
    LAS int* lcnt = (LAS int*)(F.lds + L_ROUTE); LAS int* gbase = lcnt + 32; LAS int* sel = lcnt + 64;
    for (int i = F.tid; i < 8192; i += 512) { const int c = i >> 3, q = i & 7; *(LAS f32x4*)(F.lds + c * 128 + ((q ^ ((c >> 1) & 7)) << 4)) = *(const f32x4*)(F.router_w + c * 32 + q * 4); }
    if (F.tid < 32) lcnt[F.tid] = 0;
    __syncthreads();
    for (int tb = blockIdx.x; tb < M / 64; tb += F.G) {
        for (int tl = F.wave; tl < 64; tl += 8) {
            const int tok = tb * 64 + tl, b = tok >> 13;
            const float* sh2 = F.mod + b * 6144 + 3 * 1024; const float* sc2 = F.mod + b * 6144 + 4 * 1024;
            float* yr = F.y1 + (size_t)tok * D;
            float v[16]; float s = 0.f;
#pragma unroll
            for (int i = 0; i < 16; ++i) { v[i] = yr[F.lane + 64 * i]; s += v[i]; }
            float mean = wsum(s) * (1.f / D), q = 0.f;
#pragma unroll
            for (int i = 0; i < 16; ++i) { v[i] -= mean; q += v[i] * v[i]; }
            float rstd = rsqrtf(wsum(q) * (1.f / D) + EPS);
            s = 0.f;
#pragma unroll
            for (int i = 0; i < 16; ++i) { const int col = F.lane + 64 * i; v[i] = v[i] * rstd * F.ln1_g[col] + F.ln1_b[col]; yr[col] = v[i]; s += v[i]; }
            mean = wsum(s) * (1.f / D); q = 0.f;
#pragma unroll
            for (int i = 0; i < 16; ++i) { v[i] -= mean; q += v[i] * v[i]; }
            rstd = rsqrtf(wsum(q) * (1.f / D) + EPS);
            float lg[NE];
            LAS unsigned char* hrow = F.lds + L_WSCR + F.wave * 1024;
#pragma unroll
            for (int e = 0; e < NE; ++e) lg[e] = 0.f;
#pragma unroll
            for (int i = 0; i < 16; ++i) {
                const int col = F.lane + 64 * i;
                v[i] = v[i] * rstd * (1.f + sc2[col]) + sh2[col];
                hrow[col] = (unsigned char)__builtin_amdgcn_cvt_pk_fp8_f32(v[i], v[i], 0, false);
                const LAS unsigned char* wr = F.lds + col * 128; const int sw = (col >> 1) & 7;
#pragma unroll
                for (int qq = 0; qq < 8; ++qq) { const f32x4 w4 = *(const LAS f32x4*)(wr + ((qq ^ sw) << 4));
#pragma unroll
                    for (int j = 0; j < 4; ++j) lg[qq * 4 + j] += v[i] * w4[j]; }
            }
            LDS_WAIT();
            *(u32x4*)(F.h2 + (size_t)tok * D + F.lane * 16) = *(const LAS u32x4*)(hrow + F.lane * 16);
            float r16[16], r8[8], r4[4], r2[2], r1;
            { const bool hi = F.lane & 32;
#pragma unroll
              for (int e = 0; e < 16; ++e) { const float mine = hi ? lg[e + 16] : lg[e], send = hi ? lg[e] : lg[e + 16]; r16[e] = mine + __shfl_xor(send, 32); } }
            { const bool hi = F.lane & 16;
#pragma unroll
              for (int e = 0; e < 8; ++e) { const float mine = hi ? r16[e + 8] : r16[e], send = hi ? r16[e] : r16[e + 8]; r8[e] = mine + __shfl_xor(send, 16); } }
            { const bool hi = F.lane & 8;
#pragma unroll
              for (int e = 0; e < 4; ++e) { const float mine = hi ? r8[e + 4] : r8[e], send = hi ? r8[e] : r8[e + 4]; r4[e] = mine + __shfl_xor(send, 8); } }
            { const bool hi = F.lane & 4;
#pragma unroll
              for (int e = 0; e < 2; ++e) { const float mine = hi ? r4[e + 2] : r4[e], send = hi ? r4[e] : r4[e + 2]; r2[e] = mine + __shfl_xor(send, 4); } }
            { const bool hi = F.lane & 2; const float mine = hi ? r2[1] : r2[0], send = hi ? r2[0] : r2[1]; r1 = mine + __shfl_xor(send, 2); }
            r1 += __shfl_xor(r1, 1);
            const int e = F.lane >> 1;
            const float lgt = r1 + F.router_b[e];
            int rank = 0; float mx = -3.0e38f;
#pragma unroll
            for (int e2 = 0; e2 < NE; ++e2) { const float o = __builtin_bit_cast(float, __builtin_amdgcn_readlane(__builtin_bit_cast(int, lgt), 2 * e2));
                rank += (o > lgt || (o == lgt && e2 < e)) ? 1 : 0; mx = fmaxf(mx, o); }
            const bool selq = rank < TOPK && !(F.lane & 1);
            const float pe = selq ? __expf(lgt - mx) : 0.f;
            const float den = wsum(pe);
            if (selq) {
                const int lp = __hip_atomic_fetch_add(lcnt + e, 1, __ATOMIC_RELAXED, __HIP_MEMORY_SCOPE_WORKGROUP);
                sel[tl * 4 + rank] = e | (lp << 8);
                F.topg[tok * 4 + rank] = pe / den; F.topi[tok * 4 + rank] = e;
            }
        }
        __syncthreads();
        if (F.tid < 32) { const int n = lcnt[F.tid]; gbase[F.tid] = n ? (int)__hip_atomic_fetch_add(F.ctl + CW_CNT + 32 * F.tid, (unsigned)n, __ATOMIC_RELAXED, __HIP_MEMORY_SCOPE_AGENT) : 0; lcnt[F.tid] = 0; }
        __syncthreads();
        if (F.tid < 256) { const int sv = sel[F.tid], e = sv & 255, lp = sv >> 8; F.list[(size_t)e * LCAP + gbase[e] + lp] = (tb * 64 + (F.tid >> 2)) * 4 + (F.tid & 3); }
        __syncthreads();
    }
}

__device__ __forceinline__ void p_final(Frame& F) {
    const int gw = F.vcu * 8 + F.wave, NGW = F.G * 8;
    for (int tok = gw; tok < M; tok += NGW) {
        const float* g2 = F.mod + (tok >> 13) * 6144 + 5 * 1024;
        const f32x4* xp = (const f32x4*)(F.y1 + (size_t)tok * D) + F.lane;
        f32x4 v[4]; float s = 0.f;
#pragma unroll
        for (int j = 0; j < 4; ++j) {
            f32x4 f = (f32x4){0.f, 0.f, 0.f, 0.f};
#pragma unroll
            for (int k = 0; k < TOPK; ++k) { const u32x2 yv = *((const u32x2*)(F.ybuf + (size_t)(tok * 4 + k) * D) + F.lane + 64 * j);
                f[0] += bflo(yv.x); f[1] += bfhi(yv.x); f[2] += bflo(yv.y); f[3] += bfhi(yv.y); }
            const f32x4 gv = *((const f32x4*)g2 + F.lane + 64 * j);
            v[j] = xp[64 * j] * DN_ALPHA + gv * f; s += (v[j][0] + v[j][1]) + (v[j][2] + v[j][3]);
        }
        const float mean = wsum(s) * (1.f / D); float q = 0.f;
#pragma unroll
        for (int j = 0; j < 4; ++j) { v[j] = v[j] - mean; q += (v[j][0] * v[j][0] + v[j][1] * v[j][1]) + (v[j][2] * v[j][2] + v[j][3] * v[j][3]); }
        const float rstd = rsqrtf(wsum(q) * (1.f / D) + EPS);
        f32x4* op = (f32x4*)(F.out + (size_t)tok * D) + F.lane;
#pragma unroll
        for (int j = 0; j < 4; ++j) { const f32x4 gg = *((const f32x4*)F.ln2_g + F.lane + 64 * j), bb = *((const f32x4*)F.ln2_b + F.lane + 64 * j); op[64 * j] = v[j] * rstd * gg + bb; }
    }
}

struct Args { const float* in[23]; float* out; unsigned char* ws; int ph_lo, ph_hi; };
constexpr int N_PHASES = 9;
__global__ void __launch_bounds__(512, 2) mk_fwd(Args args) {
    extern __shared__ __attribute__((aligned(16))) unsigned char lds_raw[];
    Frame F;
    F.lds = (LAS unsigned char*)lds_raw;
    F.MISC = (volatile LAS unsigned*)(F.lds + L_MISC);
    F.tid = threadIdx.x; F.lane = F.tid & 63; F.wave = __builtin_amdgcn_readfirstlane(F.tid >> 6);
    F.G = gridDim.x; { const int bx = blockIdx.x; F.vcu = (F.G % 8 == 0) ? (bx % 8) * (F.G / 8) + bx / 8 : bx; }
    unsigned char* ws = args.ws;
    F.ctl = (unsigned*)(ws + WS_CTL);
    F.x = args.in[0]; F.c = args.in[1]; F.ctx = args.in[2]; F.c_ctx = args.in[3]; F.ada_w = args.in[4]; F.ada_b = args.in[5]; F.w_in = args.in[6]; F.rpb = args.in[7];
    F.sgu_ln_g = args.in[8]; F.sgu_ln_b = args.in[9]; F.sgu_w = args.in[10]; F.sgu_b = args.in[11]; F.w_out = args.in[12]; F.ln1_g = args.in[13]; F.ln1_b = args.in[14];
    F.ln2_g = args.in[15]; F.ln2_b = args.in[16]; F.router_w = args.in[17]; F.router_b = args.in[18]; F.w_gu = args.in[19]; F.b_gu = args.in[20]; F.w_dn = args.in[21]; F.b_dn = args.in[22];
    F.out = args.out;
    F.mod = (float*)(ws + WS_MOD); F.topg = (float*)(ws + WS_TOPG); F.topi = (int*)(ws + WS_TOPI); F.list = (int*)(ws + WS_LIST); F.sguw = (bf16_t*)(ws + WS_SGUW);
    F.Wt_in = (bf16_t*)(ws + WS_WIN); F.Wt_out = (bf16_t*)(ws + WS_WOUT); F.Wt_gu = ws + WS_WGU; F.Wt_dn = ws + WS_WDN;
    F.hxc = (bf16_t*)(ws + WS_HXC); F.proj = (bf16_t*)(ws + WS_PROJ); F.mixin = (bf16_t*)(ws + WS_MIXIN); F.y1 = (float*)(ws + WS_Y1); F.h2 = ws + WS_H2;
    F.act = ws + WS_ACT; F.ybuf = (bf16_t*)(ws + WS_YBUF);
    for (int u = F.tid; u < (LDS_BYTES - L_MISC) / 4; u += 512) ((LAS unsigned*)(F.lds + L_MISC))[u] = 0u;
    __syncthreads();
    const int lo = args.ph_lo, hi = args.ph_hi;
    const bool one = (hi - lo) > 1;
    XcdBarrier bar; bar.bar = (unsigned*)(F.ctl + CW_BAR); bar.x = 0; bar.st = nullptr;
    if (one) bar = xcd_barrier_post((unsigned*)(F.ctl + CW_BAR), F.MISC + 8);
#define IN(k) (lo <= (k) && (k) < hi)
#define SEAM(k) do { if (IN(k) && IN((k) + 1)) xcd_barrier(bar); } while (0)
#ifndef PROBE_REPS
#define PROBE_REPS {1, 1, 1, 1, 1, 1, 1, 1, 1}
#endif
    constexpr int REPS[N_PHASES] = PROBE_REPS;
#define REPEAT(k) _Pragma("unroll") for (int rep_ = 0; rep_ < REPS[k]; ++rep_)
#define RSEAM(k) do { if (rep_ + 1 < REPS[k]) xcd_barrier(bar); else SEAM(k); } while (0)
    if (IN(0)) REPEAT(0) { p_ada(F); p_weights(F); RSEAM(0); }
    if (IN(1)) REPEAT(1) { p_lnmod(F); RSEAM(1); }
    if (IN(2)) REPEAT(2) { PolProj P{F.hxc, F.Wt_in, F.proj, F.G, (int)blockIdx.x}; pg8::gemm_phase<PolProj>(F.lds, P); RSEAM(2); }
    if (IN(3)) REPEAT(3) { at::p_mixer(F); RSEAM(3); }
    if (IN(4)) REPEAT(4) { PolOut P{F.mixin, F.Wt_out, F.x, F.mod, F.y1, F.G, (int)blockIdx.x}; pg8::gemm_phase<PolOut>(F.lds, P); RSEAM(4); }
    if (IN(5)) { p_route(F); SEAM(5); }
    if (IN(6)) REPEAT(6) { const int T = expert_tables(F); ExpTab tb{(const LAS int*)(F.lds + L_TILEE), (const LAS int*)(F.lds + L_TSTART), (const LAS int*)(F.lds + L_TSTART) + 64, T};
        PolGU P{F.h2, F.Wt_gu, F.b_gu, F.list, F.act, tb, F.G, (int)blockIdx.x}; pg8::gemm_phase<PolGU>(F.lds, P); RSEAM(6); }
    if (IN(7)) REPEAT(7) { const int T = expert_tables(F); ExpTab tb{(const LAS int*)(F.lds + L_TILEE), (const LAS int*)(F.lds + L_TSTART), (const LAS int*)(F.lds + L_TSTART) + 64, T};
        PolDN P{F.act, F.Wt_dn, F.b_dn, F.list, F.topg, F.ybuf, tb, F.G, (int)blockIdx.x}; pg8::gemm_phase<PolDN>(F.lds, P); RSEAM(7); }
    if (IN(8)) REPEAT(8) { p_final(F); if (rep_ + 1 < REPS[8]) xcd_barrier(bar); }
#undef IN
#undef SEAM
#undef REPEAT
#undef RSEAM
}

static inline void launch_forward(void* const* d_in, void* d_out, void* d_ws, hipStream_t stream, int n_launches) {
    static int grid = 0;
    if (grid == 0) {
        int dev = 0, cus = 0;
        if (hipGetDevice(&dev) != hipSuccess || hipDeviceGetAttribute(&cus, hipDeviceAttributeMultiprocessorCount, dev) != hipSuccess) { fprintf(stderr, "kernel_launch: device query failed\n"); grid = -1; return; }
        if (hipFuncSetAttribute((const void*)mk_fwd, hipFuncAttributeMaxDynamicSharedMemorySize, LDS_BYTES) != hipSuccess) { fprintf(stderr, "kernel_launch: hipFuncSetAttribute failed\n"); grid = -1; return; }
        int per_cu = 0;
        if (hipOccupancyMaxActiveBlocksPerMultiprocessor(&per_cu, (const void*)mk_fwd, 512, LDS_BYTES) != hipSuccess || per_cu < 1) fprintf(stderr, "kernel_launch: occupancy query says %d\n", per_cu);
        (void)hipGetLastError();
        grid = cus;
    }
    if (grid < 0) return;
    (void)hipMemsetAsync((char*)d_ws + WS_CTL, 0, CTL_ZERO_BYTES, stream);
    Args a{};
    for (int i = 0; i < 23; ++i) a.in[i] = (const float*)d_in[i];
    a.out = (float*)d_out; a.ws = (unsigned char*)d_ws;
    if (n_launches == 1) { a.ph_lo = 0; a.ph_hi = N_PHASES; hipLaunchKernelGGL(mk_fwd, dim3(grid), dim3(512), LDS_BYTES, stream, a); }
    else for (int p = 0; p < N_PHASES; ++p) { a.ph_lo = p; a.ph_hi = p + 1; hipLaunchKernelGGL(mk_fwd, dim3(grid), dim3(512), LDS_BYTES, stream, a); }
#ifdef PROBE_EXTRA
    { const int extra[] = PROBE_EXTRA; for (int p : extra) { a.ph_lo = p; a.ph_hi = p + 1; hipLaunchKernelGGL(mk_fwd, dim3(grid), dim3(512), LDS_BYTES, stream, a); } }
#endif
}
}
extern "C" void kernel_launch(void* const* d_in, const int* in_sizes, int n_in, void* d_out, int out_size, void* d_ws, size_t ws_size, hipStream_t stream) {
    if (ws_size < mk::WS_END || n_in != 23) { fprintf(stderr, "kernel_launch: unexpected workspace / inputs (%zu, %d)\n", ws_size, n_in); return; }
    mk::launch_forward(d_in, d_out, d_ws, stream, 1);
}
```

```cpp
#include <hip/hip_runtime.h>
#include <stdint.h>
#include <stdio.h>

#define GAS __attribute__((address_space(1)))
#define LAS __attribute__((address_space(3)))
typedef unsigned short bf16_t;
typedef short bf16x8 __attribute__((ext_vector_type(8)));
typedef float f32x4 __attribute__((ext_vector_type(4)));
typedef float f32x2 __attribute__((ext_vector_type(2)));
typedef unsigned u32x4 __attribute__((ext_vector_type(4)));
typedef unsigned u32x2 __attribute__((ext_vector_type(2)));

namespace mk {
constexpr int D = 1024, NB = 2, S = 8192, M = NB * S, GW = 64, ROWS = 128, CTX = 256, NH = 8, KH = 8, KW = 16;
constexpr int NE = 32, TOPK = 4, DFF = 1024, DIN = 2560, NPAIR = M * TOPK, MX = M + NB * CTX;
constexpr int LCAP = 16384, MAXT = 288, ACT_ROWS = MAXT * 256;
constexpr float EPS = 1e-5f;
constexpr float DN_ALPHA = 1.189207115002721f;
constexpr size_t MiB = 1u << 20;
constexpr size_t WS_CTL = 0, CTL_ZERO_BYTES = 1 * MiB;
constexpr size_t WS_MOD = 1 * MiB;
constexpr size_t WS_TOPG = 2 * MiB;
constexpr size_t WS_TOPI = 2 * MiB + 512 * 1024;
constexpr size_t WS_LIST = 3 * MiB;
constexpr size_t WS_SGUW = 5 * MiB;
constexpr size_t WS_WIN = 6 * MiB;
constexpr size_t WS_WOUT = 11 * MiB;
constexpr size_t WS_WGU = 16 * MiB;
constexpr size_t WS_WDN = 144 * MiB;
constexpr size_t WS_HXC = 208 * MiB;
constexpr size_t WS_PROJ = 241 * MiB;
constexpr size_t WS_MIXIN = 324 * MiB;
constexpr size_t WS_Y1 = 356 * MiB;
constexpr size_t WS_H2 = 420 * MiB;
constexpr size_t WS_ACT = 452 * MiB;
constexpr size_t WS_YBUF = 596 * MiB;
constexpr size_t WS_X1 = 724 * MiB;
constexpr size_t WS_END = 788 * MiB;
constexpr size_t WS_ALT = 788 * MiB;
constexpr int CW_CNT_ALT = 12288;
constexpr int CW_BAR = 4096;
constexpr int CW_CNT = 8192;
constexpr int RING_BYTES = 131072;
constexpr int L_MISC = RING_BYTES;
constexpr int L_IDX = L_MISC + 1024;
constexpr int L_TILEE = L_IDX + 3072;
constexpr int L_TSTART = L_TILEE + 1280;
constexpr int L_ROUTE = L_TSTART + 512;
constexpr int L_RPB = L_ROUTE + 256 + 1024;
constexpr int L_WSCR = L_RPB + 2048;
constexpr int LDS_BYTES = 155648;
static_assert(L_WSCR + 8 * 1024 <= LDS_BYTES, "LDS map");

__device__ __forceinline__ float wsum(float v) {
#pragma unroll
    for (int o = 32; o; o >>= 1) v += __shfl_xor(v, o);
    return v;
}
__device__ __forceinline__ float wmax(float v) {
#pragma unroll
    for (int o = 32; o; o >>= 1) v = fmaxf(v, __shfl_xor(v, o));
    return v;
}
__device__ __forceinline__ unsigned f2bf(float f) { unsigned u = __builtin_bit_cast(unsigned, f); return (u + 0x7fffu + ((u >> 16) & 1u)) >> 16; }
__device__ __forceinline__ unsigned pk2(float lo, float hi) { return f2bf(lo) | (f2bf(hi) << 16); }
__device__ __forceinline__ float bf2f(unsigned short b) { return __builtin_bit_cast(float, ((unsigned)b) << 16); }
__device__ __forceinline__ float bflo(unsigned w) { return __builtin_bit_cast(float, w << 16); }
__device__ __forceinline__ float bfhi(unsigned w) { return __builtin_bit_cast(float, w & 0xffff0000u); }
__device__ __forceinline__ unsigned cvt_pk_bf16(float lo, float hi) { unsigned r; asm volatile("v_cvt_pk_bf16_f32 %0, %1, %2" : "=v"(r) : "v"(lo), "v"(hi)); return r; }
__device__ __forceinline__ float gelu_fast(float x) {
    const float c1 = -2.302208198f;
    const float c3 = c1 * 0.044715f;
    const float x2 = x * x;
    const float t = x * (c1 + c3 * x2);
    return x * __builtin_amdgcn_rcpf(1.f + __builtin_amdgcn_exp2f(t));
}

#define XB_TMO      128
#define XB_XCNT(j)  (256  + 64 * (j))
#define XB_XSUB(j)  (1280 + 64 * (j))
#define XB_XGEN(j)  (2304 + 64 * (j))
#define XB_TOP      3328
#define XB_TOPGEN   3392
#define XCD_BAR_WORDS 3456
#define XB_SPIN_CAP (1u << 18)
__device__ __forceinline__ unsigned xb_ld(unsigned* p)              { return __hip_atomic_load(p, __ATOMIC_RELAXED, __HIP_MEMORY_SCOPE_AGENT); }
__device__ __forceinline__ unsigned xb_add(unsigned* p, unsigned v) { return __hip_atomic_fetch_add(p, v, __ATOMIC_RELAXED, __HIP_MEMORY_SCOPE_AGENT); }
__device__ __forceinline__ unsigned xb_xcc_id() { return (unsigned)__builtin_amdgcn_s_getreg((3 << 11) | 20) & 0xFu; }
#define XB_SPIN(cond, bar) do { unsigned _sp = 0; while (cond) { __builtin_amdgcn_s_sleep(1); \
    if ((++_sp & 255u) == 0u) { if (xb_ld(&(bar)[XB_TMO])) break; if (_sp > XB_SPIN_CAP) { atomicAdd(&(bar)[XB_TMO], 1u); break; } } } } while (0)
struct XcdBarrier { unsigned* bar; unsigned x; volatile LAS unsigned* st; };
__device__ __forceinline__ XcdBarrier xcd_barrier_post(unsigned* bar, volatile LAS unsigned* st) {
    XcdBarrier b; b.bar = bar; b.x = xb_xcc_id(); b.st = st;
    if (threadIdx.x == 0) (void)xb_add(&bar[XB_XCNT(b.x)], 1u);
    return b;
}
__device__ __forceinline__ void xcd_barrier_complete(unsigned* bar, unsigned x, unsigned& nloc, unsigned& nx) {
    const unsigned G = gridDim.x * gridDim.y * gridDim.z;
    unsigned sum, cnt, mine, sp = 0u;
    for (;;) {
        sum = 0u; cnt = 0u; mine = 0u;
#pragma unroll
        for (unsigned j = 0; j < 16; ++j) { const unsigned c = xb_ld(&bar[XB_XCNT(j)]); sum += c; cnt += (c > 0u) ? 1u : 0u; mine = (j == x) ? c : mine; }
        if (sum == G) break;
        __builtin_amdgcn_s_sleep(1);
        if ((++sp & 255u) == 0u) { if (xb_ld(&bar[XB_TMO])) break; if (sp > XB_SPIN_CAP) { atomicAdd(&bar[XB_TMO], 1u); break; } }
    }
    nloc = mine > 0u ? mine : 1u; nx = cnt > 0u ? cnt : 1u;
}
__device__ __forceinline__ void xcd_barrier(const XcdBarrier& b) {
    asm volatile("s_waitcnt vmcnt(0)" ::: "memory");
    __syncthreads();
    if (threadIdx.x == 0) {
        unsigned* bar = b.bar;
        __builtin_amdgcn_s_waitcnt(0);
        unsigned nloc = b.st[0], nx = b.st[1];
        if (nloc == 0u) { xcd_barrier_complete(bar, b.x, nloc, nx); b.st[0] = nloc; b.st[1] = nx; }
        const unsigned old = xb_add(&bar[XB_XSUB(b.x)], 1u);
        const unsigned gen = old / nloc;
        if (old + 1u == (gen + 1u) * nloc) {
            __builtin_amdgcn_fence(__ATOMIC_RELEASE, "agent");
            asm volatile("s_waitcnt vmcnt(0)" ::: "memory");
            const unsigned og = xb_add(&bar[XB_TOP], 1u);
            const unsigned tg = og / nx;
            if (og + 1u == (tg + 1u) * nx) xb_add(&bar[XB_TOPGEN], 1u);
            else XB_SPIN(xb_ld(&bar[XB_TOPGEN]) == tg, bar);
            __builtin_amdgcn_fence(__ATOMIC_ACQUIRE, "agent");
            xb_add(&bar[XB_XGEN(b.x)], 1u);
            asm volatile("s_waitcnt vmcnt(0)" ::: "memory");
        } else {
            XB_SPIN(xb_ld(&bar[XB_XGEN(b.x)]) == gen, bar);
            __builtin_amdgcn_fence(__ATOMIC_ACQUIRE, "agent");
            asm volatile("s_waitcnt vmcnt(0)" ::: "memory");
        }
    }
    __syncthreads();
}

struct Frame {
    LAS unsigned char* lds;
    volatile LAS unsigned* MISC;
    unsigned* ctl;
    int tid, lane, wave, vcu, G;
    const float *x, *c, *ctx, *c_ctx, *ada_w, *ada_b, *w_in, *rpb, *sgu_ln_g, *sgu_ln_b, *sgu_w, *sgu_b, *w_out, *ln1_g, *ln1_b, *ln2_g, *ln2_b, *router_w, *router_b, *w_gu, *b_gu, *w_dn, *b_dn;
    float* out;
    float* mod; float* topg; int* topi; int* list; bf16_t* sguw; bf16_t* Wt_in; bf16_t* Wt_out; unsigned char* Wt_gu; unsigned char* Wt_dn;
    bf16_t* hxc; bf16_t* proj; bf16_t* mixin; float* y1; float* x1; unsigned* cntw; unsigned char* h2; unsigned char* act; bf16_t* ybuf;
};
#define LDS_WAIT() asm volatile("s_waitcnt lgkmcnt(0)" ::: "memory")
#define VM_WAIT() asm volatile("s_waitcnt vmcnt(0)" ::: "memory")

namespace pg8 {
constexpr int BM = 256, BK = 64, HALF = 128, HTB = HALF * BK * 2, STAGE_BYTES = 8 * HTB, NXCD = 8, WGM = 8, KD = 1024, NKT = KD / BK;
__device__ __forceinline__ int lds_byte(int r, int c) { const int st = (r >> 4) * 2 + (c >> 5), rr = r & 15, cc = c & 31, ob = rr * 64 + cc * 2; return st * 1024 + (ob ^ (((ob >> 9) & 1) << 5)); }
__device__ __forceinline__ void stage_rc(int b, int& R, int& C) { const int st = b / 1024, sb = b % 1024, swz = sb ^ (((sb >> 9) & 1) << 5); R = (st >> 1) * 16 + swz / 64; C = (st & 1) * 32 + (swz % 64) / 2; }
__device__ __forceinline__ int perm32(int rho) { const int n = rho >> 4, i = rho & 15; return 8 * (i >> 2) + 4 * n + (i & 3); }
struct Unit { int pm, pn, e, nvalid, ti; };
__device__ __forceinline__ void static_tile(int L, int nM, int nN, int& pm, int& pn) {
    const int nwg = nM * nN; int wgid = L;
    { const int q = nwg / NXCD, r = nwg % NXCD, xcd = wgid % NXCD, off = wgid / NXCD; wgid = (xcd < r ? xcd * (q + 1) : r * (q + 1) + (xcd - r) * q) + off; }
    const int nig = WGM * nN, gid = wgid / nig, fm = gid * WGM, gsz = (nM - fm) < WGM ? (nM - fm) : WGM;
    pm = fm + ((wgid % nig) % gsz); pn = (wgid % nig) / gsz;
}

typedef int v8i __attribute__((ext_vector_type(8)));
template <bool FP8> struct Frags;
template <> struct Frags<false> { bf16x8 At[4][2], B0[2][2], B1[2][2]; };
template <> struct Frags<true> { v8i At[4], B0[2], B1[2]; };
template <class P>
__device__ __forceinline__ void gemm_phase(LAS unsigned char* lds, const P& pol) {
    const int tid = threadIdx.x, wid = __builtin_amdgcn_readfirstlane(tid >> 6), lane = tid & 63, wr = wid >> 2, wc = wid & 3, fr = lane & 15, fq = lane >> 4;
    constexpr int KDB = P::FP8 ? 1024 : 2048, NKT_ = KDB / 128;
    unsigned voffB[2];
#pragma unroll
    for (int i = 0; i < 2; ++i) { int R, C; stage_rc(tid * 16 + i * 8192, R, C); const int Rb = P::PERM ? ((R & ~31) + perm32(R & 31)) : R;
        voffB[i] = (unsigned)(Rb * KDB + C * 2); }
    const size_t kstep = (size_t)(BK * 2);
    const size_t hstep = (size_t)HALF * KDB;
    const unsigned ldsw = (unsigned)wid * 1024u;
    const int aoff = lds_byte(wr * 64 + fr, fq * 8), boff = lds_byte(wc * 32 + fr, fq * 8);
#define PG8_SA(b, h) (((b) * 2 + (h)) * HTB)
#define PG8_SB(b, h) ((4 + (b) * 2 + (h)) * HTB)
#define PG8_STAGE(bufoff, gbase, voff) do { _Pragma("unroll") for (int _i = 0; _i < 2; ++_i) \
        __builtin_amdgcn_global_load_lds((const unsigned*)((const char*)(gbase) + (voff)[_i]), (LAS unsigned*)(lds + (bufoff) + ldsw + _i * 8192), 16, 0, 0); } while (0)
#define PG8_RD8(p) __builtin_shufflevector(*(const LAS u32x4*)(p), *(const LAS u32x4*)((p) + 1024), 0, 1, 2, 3, 4, 5, 6, 7)
#define PG8_LDA(dst, b, h) do { if constexpr (P::FP8) { _Pragma("unroll") for (int m = 0; m < 4; ++m) fg.dst[m] = __builtin_bit_cast(v8i, PG8_RD8(lds + PG8_SA(b, h) + aoff + m * 2048)); } \
        else { _Pragma("unroll") for (int m = 0; m < 4; ++m) _Pragma("unroll") for (int k = 0; k < 2; ++k) fg.dst[m][k] = *(const LAS bf16x8*)(lds + PG8_SA(b, h) + aoff + m * 2048 + k * 1024); } } while (0)
#define PG8_LDB(dst, b, h) do { if constexpr (P::FP8) { _Pragma("unroll") for (int n = 0; n < 2; ++n) fg.dst[n] = __builtin_bit_cast(v8i, PG8_RD8(lds + PG8_SB(b, h) + boff + n * 2048)); } \
        else { _Pragma("unroll") for (int n = 0; n < 2; ++n) _Pragma("unroll") for (int k = 0; k < 2; ++k) fg.dst[n][k] = *(const LAS bf16x8*)(lds + PG8_SB(b, h) + boff + n * 2048 + k * 1024); } } while (0)
#define PG8_MMA(ai, bj, At, Bt) do { __builtin_amdgcn_s_setprio(1); \
        if constexpr (P::FP8) { _Pragma("unroll") for (int m = 0; m < 4; ++m) _Pragma("unroll") for (int n = 0; n < 2; ++n) \
            acc[ai][bj][m][n] = __builtin_amdgcn_mfma_scale_f32_16x16x128_f8f6f4(fg.Bt[n], fg.At[m], acc[ai][bj][m][n], 0, 0, 0, 0, 0, 0); } \
        else { _Pragma("unroll") for (int m = 0; m < 4; ++m) _Pragma("unroll") for (int n = 0; n < 2; ++n) _Pragma("unroll") for (int k = 0; k < 2; ++k) \
            acc[ai][bj][m][n] = __builtin_amdgcn_mfma_f32_16x16x32_bf16(fg.Bt[n][k], fg.At[m][k], acc[ai][bj][m][n], 0, 0, 0); } \
        __builtin_amdgcn_s_setprio(0); } while (0)
#define PG8_WAIT_V(n) asm volatile("s_waitcnt vmcnt(" #n ")" ::: "memory")
#define PG8_WAIT_L(n) asm volatile("s_waitcnt lgkmcnt(" #n ")" ::: "memory")
#define PG8_BAR __builtin_amdgcn_s_barrier()
#define PG8_SCHED __builtin_amdgcn_sched_barrier(0)
    Unit cur, nxt; int ui = 0;
    if (!pol.next(0, cur)) return;
    f32x4 acc[2][2][4][2];
#pragma unroll
    for (int a = 0; a < 2; ++a)
#pragma unroll
        for (int b = 0; b < 2; ++b)
#pragma unroll
            for (int m = 0; m < 4; ++m)
#pragma unroll
                for (int n = 0; n < 2; ++n) acc[a][b][m][n] = (f32x4){0.f, 0.f, 0.f, 0.f};
    Frags<P::FP8> fg;
    int slot = 0;
    if (P::META) { pol.meta_issue(cur, 0, lds, wid, lane); PG8_WAIT_V(0); asm volatile("" ::: "memory"); PG8_BAR; asm volatile("" ::: "memory"); }
    unsigned aC[2][2];
    pol.a_off(cur, 0, lds, aC);
    const char* const Ab = (const char*)pol.A;
    const char* cB = pol.b_ptr(cur);
    PG8_STAGE(PG8_SB(0, 0), cB, voffB); PG8_STAGE(PG8_SB(0, 1), cB + hstep, voffB); PG8_STAGE(PG8_SA(0, 0), Ab, aC[0]); PG8_STAGE(PG8_SA(0, 1), Ab, aC[1]);
    if (wr == 1) PG8_BAR;
    PG8_WAIT_V(2); PG8_BAR;
    PG8_STAGE(PG8_SB(1, 0), cB + kstep, voffB); PG8_STAGE(PG8_SA(1, 0), Ab + kstep, aC[0]); PG8_STAGE(PG8_SB(1, 1), cB + hstep + kstep, voffB);
    PG8_WAIT_V(6); PG8_BAR;
    for (;;) {
        const bool has_next = pol.next(ui + 1, nxt);
        const int nslot = slot == 2 ? 0 : slot + 1;
        if (P::META) { if (has_next) pol.meta_issue(nxt, nslot, lds, wid, lane); }
        const char* nB = has_next ? pol.b_ptr(nxt) : cB;
#pragma unroll 1
        for (int t = 0; t < NKT_; t += 2) {
            const bool last = (t == NKT_ - 2);
            const char* a1 = Ab + (size_t)(t + 1) * kstep;
            const char* a2 = last ? Ab : Ab + (size_t)(t + 2) * kstep; const char* b2 = last ? nB : cB + (size_t)(t + 2) * kstep;
            const char* a3 = a2 + kstep; const char* b3 = b2 + kstep;
            PG8_LDB(B0, 0, 0); PG8_LDB(B1, 0, 1); PG8_SCHED; PG8_LDA(At, 0, 0); PG8_STAGE(PG8_SA(1, 1), a1, aC[1]);
            if (last && has_next) pol.a_off(nxt, nslot, lds, aC);
            PG8_WAIT_V(8); PG8_WAIT_L(0); PG8_BAR; PG8_MMA(0, 0, At, B0); PG8_MMA(0, 1, At, B1); PG8_BAR; PG8_SCHED;
            PG8_LDA(At, 0, 1); PG8_STAGE(PG8_SB(0, 0), b2, voffB); PG8_STAGE(PG8_SB(0, 1), b2 + hstep, voffB); PG8_STAGE(PG8_SA(0, 0), a2, aC[0]);
            PG8_WAIT_V(8); PG8_WAIT_L(0); PG8_BAR; PG8_MMA(1, 0, At, B0); PG8_MMA(1, 1, At, B1); PG8_BAR; PG8_SCHED;
            PG8_LDB(B0, 1, 0); PG8_LDB(B1, 1, 1); PG8_SCHED; PG8_LDA(At, 1, 0); PG8_STAGE(PG8_SA(0, 1), a2, aC[1]);
            PG8_WAIT_V(8); PG8_WAIT_L(0); PG8_BAR; PG8_MMA(0, 0, At, B0); PG8_MMA(0, 1, At, B1); PG8_BAR; PG8_SCHED;
            PG8_LDA(At, 1, 1); PG8_STAGE(PG8_SB(1, 0), b3, voffB); PG8_STAGE(PG8_SB(1, 1), b3 + hstep, voffB); PG8_STAGE(PG8_SA(1, 0), a3, aC[0]);
            PG8_WAIT_V(8); PG8_WAIT_L(0); PG8_BAR; PG8_MMA(1, 0, At, B0); PG8_MMA(1, 1, At, B1); PG8_BAR; PG8_SCHED;
        }
        if (wr == 0) PG8_BAR;
        pol.epi(acc, cur, slot, lds, wr, wc, fr, fq);
#ifdef PROBE_EPI2
        if (P::META) { asm volatile("" ::: "memory");
#pragma unroll
            for (int a = 0; a < 2; ++a)
#pragma unroll
                for (int b = 0; b < 2; ++b)
#pragma unroll
                    for (int m = 0; m < 4; ++m)
#pragma unroll
                        for (int n = 0; n < 2; ++n) asm volatile("" : "+v"(acc[a][b][m][n]));
            pol.epi(acc, cur, slot, lds, wr, wc, fr, fq); }
#endif
        if (!has_next) break;
#pragma unroll
        for (int a = 0; a < 2; ++a)
#pragma unroll
            for (int b = 0; b < 2; ++b)
#pragma unroll
                for (int m = 0; m < 4; ++m)
#pragma unroll
                    for (int n = 0; n < 2; ++n) acc[a][b][m][n] = (f32x4){0.f, 0.f, 0.f, 0.f};
        cur = nxt; cB = nB; ++ui; slot = nslot;
        if (wr == 1) PG8_BAR;
    }
    PG8_WAIT_V(0);
    PG8_BAR;
#undef PG8_SA
#undef PG8_SB
#undef PG8_STAGE
#undef PG8_LDA
#undef PG8_LDB
#undef PG8_MMA
#undef PG8_RD8
#undef PG8_WAIT_V
#undef PG8_WAIT_L
#undef PG8_BAR
#undef PG8_SCHED
}
}

typedef f32x4 AccT[2][2][4][2];

struct PolProj {
    static constexpr bool PERM = true, META = false, FP8 = false; static constexpr int SCALE_W = 0x7f7f7f7f;
    const bf16_t* A; const bf16_t* Bt; bf16_t* O; int G, c;
    __device__ __forceinline__ bool next(int i, pg8::Unit& u) const {
        const int L = i * G + c;
        if (L < 640) { pg8::static_tile(L, 64, 10, u.pm, u.pn); return true; }
        if (L < 648) { const int j = L - 640; u.pm = 64 + (j >> 2); u.pn = 2 + (j & 3); return true; }
        return false;
    }
    __device__ __forceinline__ const char* b_ptr(const pg8::Unit& u) const { return (const char*)Bt + (size_t)u.pn * 256 * 1024 * 2; }
    __device__ __forceinline__ void meta_issue(const pg8::Unit&, int, LAS unsigned char*, int, int) const {}
    __device__ __forceinline__ void a_off(const pg8::Unit& u, int, LAS unsigned char*, unsigned (&o)[2][2]) const {
        int Ra[2], Ca[2]; pg8::stage_rc((int)threadIdx.x * 16, Ra[0], Ca[0]); pg8::stage_rc((int)threadIdx.x * 16 + 8192, Ra[1], Ca[1]);
#pragma unroll
        for (int h = 0; h < 2; ++h)
#pragma unroll
            for (int i = 0; i < 2; ++i) o[h][i] = (unsigned)((u.pm * 256 + 128 * h + Ra[i]) * 1024 + Ca[i]) * 2u;
    }
    __device__ __forceinline__ void epi(const AccT& acc, const pg8::Unit& u, int, LAS unsigned char*, int wr, int wc, int fr, int fq) const {
        const int row0 = u.pm * 256 + wr * 64 + fr, col0 = u.pn * 256 + wc * 32 + 8 * fq;
        const bool act = u.pn >= 6;
#pragma unroll
        for (int ai = 0; ai < 2; ++ai)
#pragma unroll
            for (int m = 0; m < 4; ++m) { bf16_t* rowp = O + (size_t)(row0 + ai * 128 + m * 16) * DIN + col0;
#pragma unroll
                for (int bj = 0; bj < 2; ++bj) { f32x4 v0 = acc[ai][bj][m][0], v1 = acc[ai][bj][m][1];
                    if (act) {
#pragma unroll
                        for (int j = 0; j < 4; ++j) { v0[j] = gelu_fast(v0[j]); v1[j] = gelu_fast(v1[j]); } }
                    u32x4 w; w.x = cvt_pk_bf16(v0[0], v0[1]); w.y = cvt_pk_bf16(v0[2], v0[3]); w.z = cvt_pk_bf16(v1[0], v1[1]); w.w = cvt_pk_bf16(v1[2], v1[3]);
                    *(u32x4*)(rowp + bj * 128) = w; } }
    }
};

struct PolOut {
    static constexpr bool PERM = false, META = false, FP8 = false; static constexpr int SCALE_W = 0x7f7f7f7f;
    const bf16_t* A; const bf16_t* Bt; const float* x; const float* mod; float* Y; int G, c;
    __device__ __forceinline__ bool next(int i, pg8::Unit& u) const { const int L = i * G + c; if (L >= 256) return false; pg8::static_tile(L, 64, 4, u.pm, u.pn); return true; }
    __device__ __forceinline__ const char* b_ptr(const pg8::Unit& u) const { return (const char*)Bt + (size_t)u.pn * 256 * 1024 * 2; }
    __device__ __forceinline__ void meta_issue(const pg8::Unit&, int, LAS unsigned char*, int, int) const {}
    __device__ __forceinline__ void a_off(const pg8::Unit& u, int, LAS unsigned char*, unsigned (&o)[2][2]) const {
        int Ra[2], Ca[2]; pg8::stage_rc((int)threadIdx.x * 16, Ra[0], Ca[0]); pg8::stage_rc((int)threadIdx.x * 16 + 8192, Ra[1], Ca[1]);
#pragma unroll
        for (int h = 0; h < 2; ++h)
#pragma unroll
            for (int i = 0; i < 2; ++i) o[h][i] = (unsigned)((u.pm * 256 + 128 * h + Ra[i]) * 1024 + Ca[i]) * 2u;
    }
    __device__ __forceinline__ void epi(const AccT& acc, const pg8::Unit& u, int, LAS unsigned char*, int wr, int wc, int fr, int fq) const {
        const int row0 = u.pm * 256 + wr * 64 + fr, col0 = u.pn * 256 + wc * 32 + 4 * fq;
        const float* g1 = mod + (u.pm >= 32 ? 6144 : 0) + 2 * 1024;
        f32x4 gv[2][2];
#pragma unroll
        for (int bj = 0; bj < 2; ++bj)
#pragma unroll
            for (int n = 0; n < 2; ++n) gv[bj][n] = *(const f32x4*)(g1 + col0 + bj * 128 + n * 16);
#pragma unroll
        for (int ai = 0; ai < 2; ++ai)
#pragma unroll
            for (int m = 0; m < 4; ++m) { const size_t off = (size_t)(row0 + ai * 128 + m * 16) * D + col0;
#pragma unroll
                for (int bj = 0; bj < 2; ++bj)
#pragma unroll
                    for (int n = 0; n < 2; ++n) { const f32x4 xv = *(const f32x4*)(x + off + bj * 128 + n * 16);
                        *(f32x4*)(Y + off + bj * 128 + n * 16) = xv * DN_ALPHA + gv[bj][n] * acc[ai][bj][m][n]; }
                asm volatile("" ::: "memory"); }
    }
};

struct ExpTab { const LAS int* tile_e; const LAS int* tstart; const LAS int* cnt; int T; };
__device__ __forceinline__ int expert_tables(Frame& F) {
    LAS int* tile_e = (LAS int*)(F.lds + L_TILEE); LAS int* tstart = (LAS int*)(F.lds + L_TSTART); LAS int* cn = tstart + 64;
    if (F.tid < 32) cn[F.tid] = (int)__hip_atomic_load(F.ctl + CW_CNT + 32 * F.tid, __ATOMIC_RELAXED, __HIP_MEMORY_SCOPE_AGENT);
    __syncthreads();
    if (F.tid == 0) { int run = 0; for (int e = 0; e < NE; ++e) { tstart[e] = run; run += (cn[e] + 255) >> 8; } tstart[NE] = run; }
    __syncthreads();
    const int T = tstart[NE];
    if (F.tid < MAXT && F.tid < T) { int e = 0; while (e < NE - 1 && tstart[e + 1] <= F.tid) ++e; tile_e[F.tid] = e; }
    __syncthreads();
    return T < MAXT ? T : MAXT;
}
__device__ __forceinline__ int rfl(int v) { return __builtin_amdgcn_readfirstlane(v); }

struct PolGU {
    static constexpr bool PERM = true, META = true, FP8 = true; static constexpr int SCALE_W = 0; static constexpr float WSC = 1.f / 64.f;
    const unsigned char* A; const unsigned char* Bt; const float* bias; const int* list; unsigned char* O; ExpTab tb; int G, c;
    __device__ __forceinline__ bool next(int i, pg8::Unit& u) const {
        const int L = i * G + c; if (L >= tb.T * 8) return false;
        u.ti = L >> 3; u.pn = L & 7; u.e = rfl(tb.tile_e[u.ti]); u.pm = u.ti - rfl(tb.tstart[u.e]);
        const int rem = rfl(tb.cnt[u.e]) - u.pm * 256; u.nvalid = rem < 256 ? rem : 256; return true;
    }
    __device__ __forceinline__ const char* b_ptr(const pg8::Unit& u) const { return (const char*)Bt + ((size_t)u.e * 2048 + (size_t)u.pn * 256) * 1024; }
    __device__ __forceinline__ void meta_issue(const pg8::Unit& u, int slot, LAS unsigned char* lds, int wid, int lane) const {
        if (wid < 4) __builtin_amdgcn_global_load_lds((const unsigned*)(list + (size_t)u.e * LCAP + u.pm * 256 + wid * 64 + lane), (LAS unsigned*)(lds + L_IDX + slot * 1024 + wid * 256), 4, 0, 0);
    }
    __device__ __forceinline__ void a_off(const pg8::Unit& u, int slot, LAS unsigned char* lds, unsigned (&o)[2][2]) const {
        int Ra[2], Ca[2]; pg8::stage_rc((int)threadIdx.x * 16, Ra[0], Ca[0]); pg8::stage_rc((int)threadIdx.x * 16 + 8192, Ra[1], Ca[1]);
        const LAS int* idx = (const LAS int*)(lds + L_IDX + slot * 1024);
#pragma unroll
        for (int h = 0; h < 2; ++h)
#pragma unroll
            for (int i = 0; i < 2; ++i) { const int r = 128 * h + Ra[i]; int pr = idx[r]; pr = r < u.nvalid ? pr : 0; o[h][i] = (unsigned)((pr >> 2) * 1024 + Ca[i] * 2); }
    }
    __device__ __forceinline__ void epi(const AccT& acc, const pg8::Unit& u, int, LAS unsigned char*, int wr, int wc, int fr, int fq) const {
        const int row0 = u.ti * 256 + wr * 64 + fr, col0 = u.pn * 128 + wc * 32 + 8 * fq;
        const float* bg = bias + (size_t)u.e * 2048 + col0;
        const f32x4 g0 = *(const f32x4*)(bg), g1 = *(const f32x4*)(bg + 4), l0 = *(const f32x4*)(bg + 1024), l1 = *(const f32x4*)(bg + 1028);
#pragma unroll
        for (int ai = 0; ai < 2; ++ai)
#pragma unroll
            for (int m = 0; m < 4; ++m) {
                f32x4 a0 = acc[ai][0][m][0] * WSC + g0, a1 = acc[ai][0][m][1] * WSC + g1, b0 = acc[ai][1][m][0] * WSC + l0, b1 = acc[ai][1][m][1] * WSC + l1, r0, r1;
#pragma unroll
                for (int j = 0; j < 4; ++j) {
                    { const float g = fminf(a0[j], 7.f), l = fminf(fmaxf(b0[j], -7.f), 7.f); r0[j] = (l + 1.f) * g * __builtin_amdgcn_rcpf(1.f + __builtin_amdgcn_exp2f(-2.45546696f * g)); }
                    { const float g = fminf(a1[j], 7.f), l = fminf(fmaxf(b1[j], -7.f), 7.f); r1[j] = (l + 1.f) * g * __builtin_amdgcn_rcpf(1.f + __builtin_amdgcn_exp2f(-2.45546696f * g)); }
                }
                u32x2 w; w.x = (unsigned)__builtin_amdgcn_cvt_pk_fp8_f32(r0[2], r0[3], __builtin_amdgcn_cvt_pk_fp8_f32(r0[0], r0[1], 0, false), true);
                w.y = (unsigned)__builtin_amdgcn_cvt_pk_fp8_f32(r1[2], r1[3], __builtin_amdgcn_cvt_pk_fp8_f32(r1[0], r1[1], 0, false), true);
                *(u32x2*)(O + (size_t)(row0 + ai * 128 + m * 16) * DFF + col0) = w; }
    }
};

struct PolDN {
    static constexpr bool PERM = true, META = true, FP8 = true; static constexpr int SCALE_W = 0; static constexpr float WSC = 1.f / 64.f;
    const unsigned char* A; const unsigned char* Bt; const float* bias; const int* list; const float* topg; bf16_t* O; ExpTab tb; int G, c;
    __device__ __forceinline__ bool next(int i, pg8::Unit& u) const {
        const int L = i * G + c; if (L >= tb.T * 4) return false;
        u.ti = L >> 2; u.pn = L & 3; u.e = rfl(tb.tile_e[u.ti]); u.pm = u.ti - rfl(tb.tstart[u.e]);
        const int rem = rfl(tb.cnt[u.e]) - u.pm * 256; u.nvalid = rem < 256 ? rem : 256; return true;
    }
    __device__ __forceinline__ const char* b_ptr(const pg8::Unit& u) const { return (const char*)Bt + ((size_t)u.e * 1024 + (size_t)u.pn * 256) * 1024; }
    __device__ __forceinline__ void meta_issue(const pg8::Unit& u, int slot, LAS unsigned char* lds, int wid, int lane) const {
        if (wid < 4) __builtin_amdgcn_global_load_lds((const unsigned*)(list + (size_t)u.e * LCAP + u.pm * 256 + wid * 64 + lane), (LAS unsigned*)(lds + L_IDX + slot * 1024 + wid * 256), 4, 0, 0);
    }
    __device__ __forceinline__ void a_off(const pg8::Unit& u, int, LAS unsigned char*, unsigned (&o)[2][2]) const {
        int Ra[2], Ca[2]; pg8::stage_rc((int)threadIdx.x * 16, Ra[0], Ca[0]); pg8::stage_rc((int)threadIdx.x * 16 + 8192, Ra[1], Ca[1]);
#pragma unroll
        for (int h = 0; h < 2; ++h)
#pragma unroll
            for (int i = 0; i < 2; ++i) o[h][i] = (unsigned)((u.ti * 256 + 128 * h + Ra[i]) * 1024 + Ca[i] * 2);
    }
    __device__ __forceinline__ void epi(const AccT& acc, const pg8::Unit& u, int slot, LAS unsigned char* lds, int wr, int wc, int fr, int fq) const {
        const LAS int* idx = (const LAS int*)(lds + L_IDX + slot * 1024);
        const int col0 = u.pn * 256 + wc * 32 + 8 * fq;
        const float* bd = bias + (size_t)u.e * 1024 + col0;
        f32x4 bv[2][2];
#pragma unroll
        for (int bj = 0; bj < 2; ++bj)
#pragma unroll
            for (int n = 0; n < 2; ++n) bv[bj][n] = *(const f32x4*)(bd + bj * 128 + 4 * n);
#pragma unroll
        for (int ai = 0; ai < 2; ++ai)
#pragma unroll
            for (int m = 0; m < 4; ++m) { const int r = ai * 128 + wr * 64 + m * 16 + fr;
                if (r < u.nvalid) { const int pr = idx[r]; const float gt = topg[pr]; bf16_t* rowp = O + (size_t)pr * D + col0;
#pragma unroll
                    for (int bj = 0; bj < 2; ++bj) { const f32x4 v0 = (acc[ai][bj][m][0] * WSC + bv[bj][0]) * gt, v1 = (acc[ai][bj][m][1] * WSC + bv[bj][1]) * gt;
                        u32x4 w; w.x = cvt_pk_bf16(v0[0], v0[1]); w.y = cvt_pk_bf16(v0[2], v0[3]); w.z = cvt_pk_bf16(v1[0], v1[1]); w.w = cvt_pk_bf16(v1[2], v1[3]);
                        *(u32x4*)(rowp + bj * 128) = w; } } }
    }
};

__device__ __forceinline__ void p_ada(Frame& F) {
    LAS float* sl = (LAS float*)F.lds;
    LAS float* red = sl + 3072;
    for (int i = F.tid; i < 3072; i += 512) { const int w = i >> 10, k = i & 1023; const float v = w < 2 ? F.c[w * D + k] : F.c_ctx[k]; sl[i] = v / (1.f + __expf(-v)); }
    __syncthreads();
    for (int slab = blockIdx.x; slab < 256; slab += F.G) {
        const int j0 = slab * 24, cg = F.tid % 6, kr = F.tid / 6;
        float a[3][4] = {};
        if (F.tid < 480) {
            for (int k = kr; k < D; k += 80) {
                const f32x4 w4 = *(const f32x4*)(F.ada_w + (size_t)k * 6144 + j0 + 4 * cg);
                const float s0 = sl[k], s1 = sl[1024 + k], s2 = sl[2048 + k];
#pragma unroll
                for (int q = 0; q < 4; ++q) { a[0][q] += s0 * w4[q]; a[1][q] += s1 * w4[q]; a[2][q] += s2 * w4[q]; }
            }
#pragma unroll
            for (int w = 0; w < 3; ++w)
#pragma unroll
                for (int q = 0; q < 4; ++q) red[kr * 72 + cg * 12 + w * 4 + q] = a[w][q];
        }
        __syncthreads();
        if (F.tid < 72) {
            float s = 0.f;
            for (int r = 0; r < 80; ++r) s += red[r * 72 + F.tid];
            const int g = F.tid / 12, w = (F.tid % 12) >> 2, q = F.tid & 3, col = j0 + 4 * g + q;
            F.mod[w * 6144 + col] = s + F.ada_b[col];
        }
        __syncthreads();
    }
}

__device__ __forceinline__ void transpose_item(const float* W, int K, int N, bf16_t* WT, int item, bool gu_map, LAS float* scr, int lane) {
    const int nblk = N / 32, kb = item / nblk, nb = item % nblk, k0 = 64 * kb, n0 = 32 * nb;
#pragma unroll 8
    for (int i = 0; i < 32; ++i) { const int kk = 2 * i + (lane >> 5); scr[kk * 33 + (lane & 31)] = W[(size_t)(k0 + kk) * N + n0 + (lane & 31)]; }
    LDS_WAIT(); asm volatile("" ::: "memory");
    int d0 = n0;
    if (gu_map) { const int nn = n0 & 1023; d0 = (nn >> 7) * 256 + (nn & 127) + ((n0 >> 10) ? 128 : 0); }
    const int c = lane & 7;
#pragma unroll
    for (int j = 0; j < 4; ++j) { const int n = (lane >> 3) + 8 * j; const LAS float* s = scr + (8 * c) * 33 + n;
        u32x4 o; o.x = pk2(s[0 * 33], s[1 * 33]); o.y = pk2(s[2 * 33], s[3 * 33]); o.z = pk2(s[4 * 33], s[5 * 33]); o.w = pk2(s[6 * 33], s[7 * 33]);
        *(u32x4*)(WT + (size_t)(d0 + n) * K + k0 + 8 * c) = o; }
    LDS_WAIT(); asm volatile("" ::: "memory");
}
__device__ __forceinline__ unsigned pk4_fp8(float a, float b, float c, float d) { return (unsigned)__builtin_amdgcn_cvt_pk_fp8_f32(c, d, __builtin_amdgcn_cvt_pk_fp8_f32(a, b, 0, false), true); }
__device__ __forceinline__ void transpose_item8(const float* W, int K, int N, unsigned char* WT, int item, bool gu_map, LAS float* scr, int lane) {
    const int nblk = N / 32, kb = item / nblk, nb = item % nblk, k0 = 64 * kb, n0 = 32 * nb;
#pragma unroll 8
    for (int i = 0; i < 32; ++i) { const int kk = 2 * i + (lane >> 5); scr[kk * 33 + (lane & 31)] = W[(size_t)(k0 + kk) * N + n0 + (lane & 31)]; }
    LDS_WAIT(); asm volatile("" ::: "memory");
    int d0 = n0;
    if (gu_map) { const int nn = n0 & 1023; d0 = (nn >> 7) * 256 + (nn & 127) + ((n0 >> 10) ? 128 : 0); }
    const int c = lane & 7;
#pragma unroll
    for (int j = 0; j < 4; ++j) { const int n = (lane >> 3) + 8 * j; const LAS float* s = scr + (8 * c) * 33 + n;
        u32x2 o; o.x = pk4_fp8(s[0 * 33] * 64.f, s[1 * 33] * 64.f, s[2 * 33] * 64.f, s[3 * 33] * 64.f); o.y = pk4_fp8(s[4 * 33] * 64.f, s[5 * 33] * 64.f, s[6 * 33] * 64.f, s[7 * 33] * 64.f);
        *(u32x2*)(WT + (size_t)(d0 + n) * K + k0 + 8 * c) = o; }
    LDS_WAIT(); asm volatile("" ::: "memory");
}
__device__ __forceinline__ void p_weights(Frame& F) {
    LAS float* scr = (LAS float*)(F.lds + F.wave * 16384);
    const int gw = F.vcu * 8 + F.wave, NGW = F.G * 8;
    constexpr int I_IN = 16 * 80, I_OUT = 16 * 32, I_GU = 16 * 64, I_DN = 16 * 32;
    constexpr int NITEMS = I_IN + I_OUT + NE * I_GU + NE * I_DN;
    for (int it = gw; it < NITEMS; it += NGW) {
        int r = it;
        if (r < I_IN) { transpose_item(F.w_in, D, DIN, F.Wt_in, r, false, scr, F.lane); continue; } r -= I_IN;
        if (r < I_OUT) { transpose_item(F.w_out, D, D, F.Wt_out, r, false, scr, F.lane); continue; } r -= I_OUT;
        if (r < NE * I_GU) { const int e = r / I_GU; transpose_item8(F.w_gu + (size_t)e * D * 2048, D, 2048, F.Wt_gu + (size_t)e * 2048 * D, r % I_GU, true, scr, F.lane); continue; } r -= NE * I_GU;
        { const int e = r / I_DN; transpose_item8(F.w_dn + (size_t)e * DFF * D, DFF, D, F.Wt_dn + (size_t)e * D * DFF, r % I_DN, false, scr, F.lane); }
    }
    for (int i = (blockIdx.x * 512 + F.tid) * 4; i < 4 * 128 * 128; i += F.G * 512 * 4) {
        const f32x4 v = *(const f32x4*)(F.sgu_w + i); u32x2 o; o.x = pk2(v[0], v[1]); o.y = pk2(v[2], v[3]); *(u32x2*)(F.sguw + i) = o; }
}
__device__ __forceinline__ void p_lnmod(Frame& F) {
    const int gw = F.vcu * 8 + F.wave, NGW = F.G * 8;
    for (int row = gw; row < MX; row += NGW) {
        const float* xr; const float* md;
        if (row < M) { xr = F.x + (size_t)row * D; md = F.mod + (row >> 13) * 6144; } else { xr = F.ctx + (size_t)(row - M) * D; md = F.mod + 2 * 6144; }
        const f32x4* xp = (const f32x4*)xr + F.lane;
        f32x4 v[4]; float s = 0.f;
#pragma unroll
        for (int j = 0; j < 4; ++j) { v[j] = xp[64 * j]; s += (v[j][0] + v[j][1]) + (v[j][2] + v[j][3]); }
        const float mean = wsum(s) * (1.f / D); float q = 0.f;
#pragma unroll
        for (int j = 0; j < 4; ++j) { v[j] = v[j] - mean; q += (v[j][0] * v[j][0] + v[j][1] * v[j][1]) + (v[j][2] * v[j][2] + v[j][3] * v[j][3]); }
        const float rstd = rsqrtf(wsum(q) * (1.f / D) + EPS);
        u32x2* op = (u32x2*)(F.hxc + (size_t)row * D) + F.lane;
#pragma unroll
        for (int j = 0; j < 4; ++j) { const f32x4 sh = *((const f32x4*)md + F.lane + 64 * j), sc = *((const f32x4*)(md + 1024) + F.lane + 64 * j);
            const f32x4 o = v[j] * rstd * (sc + 1.f) + sh; u32x2 w; w.x = pk2(o[0], o[1]); w.y = pk2(o[2], o[3]); op[64 * j] = w; }
    }
}

__device__ __forceinline__ void p_attn_simple(Frame& F) {
    LAS float* sq = (LAS float*)(F.lds + F.wave * 4096);
    LAS float* sp = sq + 64;
    const int gw = F.vcu * 8 + F.wave, NGW = F.G * 8;
    for (int gid = gw; gid < M * NH; gid += NGW) {
        const int h = gid & 7, tok = gid >> 3, b = tok >> 13, t = tok & (S - 1), r = t >> 6, c = t & 63;
        const int rs = min(max(r - KH / 2, 0), ROWS - KH), cs = min(max(c - KW / 2, 0), GW - KW);
        sq[F.lane] = bf2f(F.proj[(size_t)tok * DIN + h * 64 + F.lane]);
        LDS_WAIT(); asm volatile("" ::: "memory");
        float sc[6]; float mx = -1e30f;
#pragma unroll
        for (int i = 0; i < 6; ++i) {
            const int kk = F.lane + 64 * i;
            const bf16_t* kp; float bias = 0.f;
            if (kk < 128) { const int ki = kk >> 4, kj = kk & 15;
                kp = F.proj + (size_t)(b * S + (rs + ki) * GW + cs + kj) * DIN + 512 + h * 64;
                bias = F.rpb[(h * 15 + (rs + ki - r + 7)) * 31 + (cs + kj - c + 15)];
            } else kp = F.proj + (size_t)(M + b * CTX + (kk - 128)) * DIN + 512 + h * 64;
            float d = 0.f;
#pragma unroll
            for (int dd = 0; dd < 64; dd += 8) { const u32x4 kv = *(const u32x4*)(kp + dd);
                d += sq[dd] * bflo(kv.x) + sq[dd + 1] * bfhi(kv.x) + sq[dd + 2] * bflo(kv.y) + sq[dd + 3] * bfhi(kv.y) + sq[dd + 4] * bflo(kv.z) + sq[dd + 5] * bfhi(kv.z) + sq[dd + 6] * bflo(kv.w) + sq[dd + 7] * bfhi(kv.w); }
            sc[i] = d * 0.125f + bias; mx = fmaxf(mx, sc[i]);
        }
        mx = wmax(mx);
        float sum = 0.f;
#pragma unroll
        for (int i = 0; i < 6; ++i) { const float p = __expf(sc[i] - mx); sum += p; sp[F.lane + 64 * i] = p; }
        sum = wsum(sum);
        LDS_WAIT(); asm volatile("" ::: "memory");
        float acc = 0.f;
        for (int kk = 0; kk < 384; ++kk) {
            const bf16_t* vp;
            if (kk < 128) { const int ki = kk >> 4, kj = kk & 15; vp = F.proj + (size_t)(b * S + (rs + ki) * GW + cs + kj) * DIN + 1024 + h * 64; }
            else vp = F.proj + (size_t)(M + b * CTX + (kk - 128)) * DIN + 1024 + h * 64;
            acc += sp[kk] * bf2f(vp[F.lane]);
        }
        F.mixin[(size_t)tok * D + h * 64 + F.lane] = (bf16_t)f2bf(acc / sum);
        LDS_WAIT(); asm volatile("" ::: "memory");
    }
}
__device__ __forceinline__ void p_sgu_simple(Frame& F) {
    LAS bf16_t* G = (LAS bf16_t*)F.lds;
    for (int u = blockIdx.x; u < M / 128; u += F.G) {
        const int base = u * 128;
        for (int tl = F.wave; tl < 128; tl += 8) {
            const bf16_t* zr = F.proj + (size_t)(base + tl) * DIN + 2048 + F.lane * 8;
            const u32x4 zv = *(const u32x4*)zr;
            float v[8] = {bflo(zv.x), bfhi(zv.x), bflo(zv.y), bfhi(zv.y), bflo(zv.z), bfhi(zv.z), bflo(zv.w), bfhi(zv.w)};
            float s = 0.f;
#pragma unroll
            for (int i = 0; i < 8; ++i) s += v[i];
            const float mean = wsum(s) * (1.f / 512.f); float q = 0.f;
#pragma unroll
            for (int i = 0; i < 8; ++i) { v[i] -= mean; q += v[i] * v[i]; }
            const float rstd = rsqrtf(wsum(q) * (1.f / 512.f) + EPS);
#pragma unroll
            for (int i = 0; i < 8; ++i) { const int ch = F.lane * 8 + i; G[tl * 512 + ch] = (bf16_t)f2bf(v[i] * rstd * F.sgu_ln_g[ch] + F.sgu_ln_b[ch]); }
        }
        __syncthreads();
        const int ch = F.tid, grp = ch >> 7;
        for (int i = 0; i < 128; ++i) {
            const float* wrow = F.sgu_w + (size_t)(grp * 128 + i) * 128;
            float acc = 0.f;
            for (int j = 0; j < 128; ++j) acc += wrow[j] * bf2f(G[j * 512 + ch]);
            acc += F.sgu_b[grp * 128 + i];
            const float uu = bf2f(F.proj[(size_t)(base + i) * DIN + 1536 + ch]);
            F.mixin[(size_t)(base + i) * D + 512 + ch] = (bf16_t)f2bf(uu * acc);
        }
        __syncthreads();
    }
}

namespace at {
typedef float f32x16 __attribute__((ext_vector_type(16)));
typedef short s16x4 __attribute__((ext_vector_type(4)));
typedef short v4i16_t __attribute__((ext_vector_type(4)));
constexpr int A_K = 0, A_V = 16384, A_STG = 32768, A_WSF = 65536, A_RPB = 67584;
constexpr float C2 = 0.125f * 1.4426950408889634f, L2E = 1.4426950408889634f;
__device__ __forceinline__ int crow(int r, int hi) { return (r & 3) + 8 * (r >> 2) + 4 * hi; }
__device__ __forceinline__ s16x4 vtr(const LAS unsigned char* p) { return __builtin_bit_cast(s16x4, __builtin_amdgcn_ds_read_tr16_b64_v4i16((LAS v4i16_t*)p)); }
__device__ __forceinline__ int rsf(int r) { return min(max(r - KH / 2, 0), ROWS - KH); }
#define AT_WAIT_BAR() asm volatile("s_waitcnt vmcnt(0) lgkmcnt(0)\n\ts_barrier" ::: "memory")

__device__ __forceinline__ void attn_unit(Frame& F, int b, int h, int rg) {
    const int lane = F.lane, r32 = lane & 31, hi = lane >> 5, w = F.wave;
    const int r0 = 4 * rg, r = r0 + (w >> 1), c = 32 * (w & 1) + r32;
    const int krlo = rsf(r0), nnb = rsf(r0 + 3) + 7 - krlo + 1, nst = nnb + 4;
    const int rsw = rsf(r), cs = min(max(c - KW / 2, 0), GW - KW);
    LAS float* tbl = (LAS float*)(F.lds + A_RPB);
    LAS float* wsf = (LAS float*)(F.lds + A_WSF) + w * 64;
    for (int i = F.tid; i < 480; i += 512) { const int dr = i >> 5, dc = i & 31; tbl[64 + i] = dc < 31 ? F.rpb[(h * 15 + dr) * 31 + dc] * L2E : 0.f; }
    const bf16_t* qp = F.proj + (size_t)(b * S + r * GW + c) * DIN + h * 64 + hi * 8;
    bf16x8 qr[4];
#pragma unroll
    for (int d0 = 0; d0 < 4; ++d0) qr[d0] = *(const bf16x8*)(qp + d0 * 16);
    const bf16_t* kbase = F.proj + 512 + h * 64 + w * 8;
    const bf16_t* vbase = F.proj + 1024 + h * 64 + (w >> 2) * 32 + (lane & 3) * 8;
#define AT_DMA(st) do { const int _t0 = (st) < nnb ? b * S + (krlo + (st)) * GW : M + b * CTX + ((st) - nnb) * 64; const int _bf = ((st) & 1) * 8192; \
        __builtin_amdgcn_global_load_lds((const unsigned*)(kbase + (size_t)(_t0 + lane) * DIN), (LAS unsigned*)(F.lds + A_K + _bf + w * 1024), 16, 0, 0); \
        __builtin_amdgcn_global_load_lds((const unsigned*)(vbase + (size_t)(_t0 + 16 * (w & 3) + (lane >> 2)) * DIN), (LAS unsigned*)(F.lds + A_V + _bf + w * 1024), 16, 0, 0); } while (0)
    float m = -1e30f, l = 0.f;
    f32x16 o[2];
#pragma unroll
    for (int i = 0; i < 16; ++i) { o[0][i] = 0.f; o[1][i] = 0.f; }
    AT_DMA(0);
    for (int st = 0; st < nst; ++st) {
        AT_WAIT_BAR();
        if (st + 1 < nst) AT_DMA(st + 1);
        const bool isnb = st < nnb; const int kr = krlo + st;
        const bool act = !isnb || (kr >= rsw && kr < rsw + KH);
        if (act) {
            const LAS unsigned char* kp0 = F.lds + A_K + (st & 1) * 8192 + hi * 1024 + r32 * 16;
            f32x16 p0, p1;
#pragma unroll
            for (int i = 0; i < 16; ++i) { p0[i] = 0.f; p1[i] = 0.f; }
#pragma unroll
            for (int d0 = 0; d0 < 4; ++d0) {
                const bf16x8 b0 = *(const LAS bf16x8*)(kp0 + d0 * 2048), b1 = *(const LAS bf16x8*)(kp0 + d0 * 2048 + 512);
                p0 = __builtin_amdgcn_mfma_f32_32x32x16_bf16(b0, qr[d0], p0, 0, 0, 0);
                p1 = __builtin_amdgcn_mfma_f32_32x32x16_bf16(b1, qr[d0], p1, 0, 0, 0);
            }
            if (isnb) {
                const LAS float* tb = tbl + 64 + (kr - r + 7) * 32 + 4 * hi - c + 15;
#pragma unroll
                for (int rr = 0; rr < 16; ++rr) { const int ko = (rr & 3) + 8 * (rr >> 2), kc = ko + 4 * hi;
                    const float t0 = p0[rr] * C2 + tb[ko], t1 = p1[rr] * C2 + tb[ko + 32];
                    p0[rr] = (unsigned)(kc - cs) < (unsigned)KW ? t0 : -INFINITY; p1[rr] = (unsigned)(kc + 32 - cs) < (unsigned)KW ? t1 : -INFINITY; }
            } else {
#pragma unroll
                for (int rr = 0; rr < 16; ++rr) { p0[rr] *= C2; p1[rr] *= C2; }
            }
            float tm = fmaxf(p0[0], p1[0]);
#pragma unroll
            for (int rr = 1; rr < 16; ++rr) tm = fmaxf(tm, fmaxf(p0[rr], p1[rr]));
            tm = fmaxf(tm, __shfl_xor(tm, 32));
            const float mn = fmaxf(m, tm), alpha = __builtin_amdgcn_exp2f(m - mn);
            float rsum = 0.f;
#pragma unroll
            for (int rr = 0; rr < 16; ++rr) { p0[rr] = __builtin_amdgcn_exp2f(p0[rr] - mn); p1[rr] = __builtin_amdgcn_exp2f(p1[rr] - mn); rsum += p0[rr] + p1[rr]; }
            l = l * alpha + rsum; m = mn;
            if (__any(alpha != 1.f)) {
                if (hi == 0) wsf[r32] = alpha;
                LDS_WAIT();
#pragma unroll
                for (int rr = 0; rr < 16; ++rr) { const float a = wsf[crow(rr, hi)]; o[0][rr] *= a; o[1][rr] *= a; }
                LDS_WAIT();
            }
            u32x4 pw[4];
#pragma unroll
            for (int q = 0; q < 4; ++q) { pw[0][q] = cvt_pk_bf16(p0[2 * q], p0[2 * q + 1]); pw[1][q] = cvt_pk_bf16(p0[8 + 2 * q], p0[9 + 2 * q]);
                                          pw[2][q] = cvt_pk_bf16(p1[2 * q], p1[2 * q + 1]); pw[3][q] = cvt_pk_bf16(p1[8 + 2 * q], p1[9 + 2 * q]); }
            const LAS unsigned char* vp = F.lds + A_V + (st & 1) * 8192 + ((lane >> 4) & 1) * 32 + (lane & 3) * 8 + (4 * hi + ((lane & 15) >> 2)) * 64;
#pragma unroll
            for (int d0 = 0; d0 < 2; ++d0)
#pragma unroll
                for (int ks = 0; ks < 4; ++ks) {
                    const s16x4 lo = vtr(vp + d0 * 4096 + ks * 1024), hh = vtr(vp + d0 * 4096 + ks * 1024 + 512);
                    const bf16x8 vf = (bf16x8){lo[0], lo[1], lo[2], lo[3], hh[0], hh[1], hh[2], hh[3]};
                    o[d0] = __builtin_amdgcn_mfma_f32_32x32x16_bf16(__builtin_bit_cast(bf16x8, pw[ks]), vf, o[d0], 0, 0, 0);
                }
        }
    }
#undef AT_DMA
    l += __shfl_xor(l, 32);
    if (hi == 0) wsf[32 + r32] = l;
    LDS_WAIT();
    LAS bf16_t* stg = (LAS bf16_t*)(F.lds + A_STG) + w * 2048;
#pragma unroll
    for (int rr = 0; rr < 16; ++rr) { const int orow = crow(rr, hi); const float rl = __builtin_amdgcn_rcpf(wsf[32 + orow]);
        stg[orow * 64 + r32] = (bf16_t)f2bf(o[0][rr] * rl); stg[orow * 64 + 32 + r32] = (bf16_t)f2bf(o[1][rr] * rl); }
    LDS_WAIT();
    bf16_t* ow = F.mixin + (size_t)(b * S + r * GW + 32 * (w & 1)) * D + h * 64;
#pragma unroll
    for (int i = 0; i < 4; ++i) { const int row = i * 8 + (lane >> 3), ch = lane & 7; const u32x4 v = *(const LAS u32x4*)(stg + row * 64 + ch * 8); *(u32x4*)(ow + (size_t)row * D + ch * 8) = v; }
    AT_WAIT_BAR();
}

constexpr int G_IMG = 0, G_STG = 65536, G_STAT = 98304;
__device__ __forceinline__ void sgu_unit(Frame& F, int chunk, int gh) {
    const int lane = F.lane, r32 = lane & 31, hi = lane >> 5, w = F.wave;
    const int base = chunk * 128;
    LAS f32x2* stat = (LAS f32x2*)(F.lds + G_STAT);
    for (int t = 0; t < 16; ++t) {
        const int tok = 16 * w + t;
        const u32x4 zv = *(const u32x4*)(F.proj + (size_t)(base + tok) * DIN + 2048 + lane * 8);
        float v[8] = {bflo(zv.x), bfhi(zv.x), bflo(zv.y), bfhi(zv.y), bflo(zv.z), bfhi(zv.z), bflo(zv.w), bfhi(zv.w)};
        float s = 0.f;
#pragma unroll
        for (int i = 0; i < 8; ++i) s += v[i];
        const float mean = wsum(s) * (1.f / 512.f); float q = 0.f;
#pragma unroll
        for (int i = 0; i < 8; ++i) { const float d = v[i] - mean; q += d * d; }
        const float rstd = rsqrtf(wsum(q) * (1.f / 512.f) + EPS);
        if (lane == 0) stat[tok] = (f32x2){mean, rstd};
    }
    AT_WAIT_BAR();
    {
        const int ch0 = 256 * gh + 32 * w + 8 * (lane & 3);
        const f32x4 g0 = *(const f32x4*)(F.sgu_ln_g + ch0), g1 = *(const f32x4*)(F.sgu_ln_g + ch0 + 4), b0 = *(const f32x4*)(F.sgu_ln_b + ch0), b1 = *(const f32x4*)(F.sgu_ln_b + ch0 + 4);
#pragma unroll
        for (int i = 0; i < 8; ++i) {
            const int tok = 16 * i + (lane >> 2);
            const u32x4 zv = *(const u32x4*)(F.proj + (size_t)(base + tok) * DIN + 2048 + ch0);
            const f32x2 st = stat[tok];
            u32x4 o;
            o.x = pk2((bflo(zv.x) - st[0]) * st[1] * g0[0] + b0[0], (bfhi(zv.x) - st[0]) * st[1] * g0[1] + b0[1]);
            o.y = pk2((bflo(zv.y) - st[0]) * st[1] * g0[2] + b0[2], (bfhi(zv.y) - st[0]) * st[1] * g0[3] + b0[3]);
            o.z = pk2((bflo(zv.z) - st[0]) * st[1] * g1[0] + b1[0], (bfhi(zv.z) - st[0]) * st[1] * g1[1] + b1[1]);
            o.w = pk2((bflo(zv.w) - st[0]) * st[1] * g1[2] + b1[2], (bfhi(zv.w) - st[0]) * st[1] * g1[3] + b1[3]);
            *(LAS u32x4*)(F.lds + G_IMG + w * 8192 + i * 1024 + lane * 16) = o;
        }
    }
    AT_WAIT_BAR();
    const int cb = w & 3, th = w >> 2, grp = 2 * gh + (cb >> 1);
    f32x16 acc[2][2];
#pragma unroll
    for (int a = 0; a < 2; ++a)
#pragma unroll
        for (int q = 0; q < 2; ++q)
#pragma unroll
            for (int i = 0; i < 16; ++i) acc[a][q][i] = 0.f;
    const bf16_t* wp = F.sguw + (size_t)(grp * 128 + 64 * th + r32) * 128 + 8 * hi;
    const LAS unsigned char* gp = F.lds + G_IMG + (2 * cb) * 8192 + ((lane >> 4) & 1) * 32 + (lane & 3) * 8 + (8 * hi + ((lane & 15) >> 2)) * 64;
#pragma unroll
    for (int ks = 0; ks < 8; ++ks) {
        const bf16x8 w0 = *(const bf16x8*)(wp + ks * 16), w1 = *(const bf16x8*)(wp + 32 * 128 + ks * 16);
#pragma unroll
        for (int c32 = 0; c32 < 2; ++c32) {
            const s16x4 lo = vtr(gp + c32 * 8192 + ks * 1024), hh = vtr(gp + c32 * 8192 + ks * 1024 + 256);
            const bf16x8 gf = (bf16x8){lo[0], lo[1], lo[2], lo[3], hh[0], hh[1], hh[2], hh[3]};
            acc[0][c32] = __builtin_amdgcn_mfma_f32_32x32x16_bf16(gf, w0, acc[0][c32], 0, 0, 0);
            acc[1][c32] = __builtin_amdgcn_mfma_f32_32x32x16_bf16(gf, w1, acc[1][c32], 0, 0, 0);
        }
    }
    LAS unsigned char* stg = F.lds + G_STG + w * 4096;
#pragma unroll
    for (int ib = 0; ib < 2; ++ib) {
        const int i0 = 64 * th + 32 * ib;
        const float bi = F.sgu_b[grp * 128 + i0 + r32];
#pragma unroll
        for (int c32 = 0; c32 < 2; ++c32)
#pragma unroll
            for (int a = 0; a < 4; ++a) { u32x2 o; o.x = pk2(acc[ib][c32][4 * a] + bi, acc[ib][c32][4 * a + 1] + bi); o.y = pk2(acc[ib][c32][4 * a + 2] + bi, acc[ib][c32][4 * a + 3] + bi);
                *(LAS u32x2*)(stg + r32 * 128 + (((4 * c32 + a) ^ (r32 & 7)) << 4) + hi * 8) = o; }
        LDS_WAIT();
#pragma unroll
        for (int it = 0; it < 4; ++it) {
            const int row = 8 * it + (lane >> 3), chn = lane & 7;
            const u32x4 v = *(const LAS u32x4*)(stg + row * 128 + ((chn ^ (row & 7)) << 4));
            const size_t tok = (size_t)(base + i0 + row);
            const u32x4 uv = *(const u32x4*)(F.proj + tok * DIN + 1536 + 256 * gh + 64 * cb + 8 * chn);
            u32x4 o;
            o.x = pk2(bflo(v.x) * bflo(uv.x), bfhi(v.x) * bfhi(uv.x)); o.y = pk2(bflo(v.y) * bflo(uv.y), bfhi(v.y) * bfhi(uv.y));
            o.z = pk2(bflo(v.z) * bflo(uv.z), bfhi(v.z) * bfhi(uv.z)); o.w = pk2(bflo(v.w) * bflo(uv.w), bfhi(v.w) * bfhi(uv.w));
            *(u32x4*)(F.mixin + tok * D + 512 + 256 * gh + 64 * cb + 8 * chn) = o;
        }
        LDS_WAIT();
    }
    AT_WAIT_BAR();
}
__device__ __forceinline__ void p_mixer(Frame& F) {
    for (int uid = F.vcu; uid < NB * NH * 32; uid += F.G) attn_unit(F, uid >> 8, (uid >> 5) & 7, uid & 31);
    for (int uid = F.vcu; uid < (M / 128) * 2; uid += F.G) sgu_unit(F, uid >> 1, uid & 1);
}
#undef AT_WAIT_BAR
}

__device__ __forceinline__ void p_route(Frame& F) {
    LAS int* lcnt = (LAS int*)(F.lds + L_ROUTE); LAS int* gbase = lcnt + 32; LAS int* sel = lcnt + 64;
    for (int i = F.tid; i < 8192; i += 512) { const int c = i >> 3, q = i & 7; *(LAS f32x4*)(F.lds + c * 128 + ((q ^ ((c >> 1) & 7)) << 4)) = *(const f32x4*)(F.router_w + c * 32 + q * 4); }
    if (F.tid < 32) lcnt[F.tid] = 0;
    __syncthreads();
    const int lane = F.lane;
    const LAS unsigned char* wbase = F.lds + lane * 128;
    const int sw = (lane >> 1) & 7;
    LAS unsigned char* hrow = F.lds + L_WSCR + F.wave * 1024;
    for (int tb = blockIdx.x; tb < M / 64; tb += F.G) {
        const int b = (tb * 64) >> 13;
        float pg[16], pb[16], ps[16], ph[16];
#pragma unroll
        for (int i = 0; i < 16; ++i) { const int col = lane + 64 * i; pg[i] = F.ln1_g[col]; pb[i] = F.ln1_b[col]; ps[i] = 1.f + F.mod[b * 6144 + 4 * 1024 + col]; ph[i] = F.mod[b * 6144 + 3 * 1024 + col]; }
        float vn[16];
        { const float* yr = F.y1 + (size_t)(tb * 64 + F.wave) * D;
#pragma unroll
          for (int i = 0; i < 16; ++i) vn[i] = yr[lane + 64 * i]; }
        for (int tl = F.wave; tl < 64; tl += 8) {
            const int tok = tb * 64 + tl;
            float v[16]; float s = 0.f;
#pragma unroll
            for (int i = 0; i < 16; ++i) { v[i] = vn[i]; s += v[i]; }
            if (tl + 8 < 64) { const float* yr = F.y1 + (size_t)(tok + 8) * D;
#pragma unroll
                for (int i = 0; i < 16; ++i) vn[i] = yr[lane + 64 * i]; }
            float mean = wsum(s) * (1.f / D), q = 0.f;
#pragma unroll
            for (int i = 0; i < 16; ++i) { v[i] -= mean; q += v[i] * v[i]; }
            float rstd = rsqrtf(wsum(q) * (1.f / D) + EPS);
            s = 0.f;
#pragma unroll
            for (int i = 0; i < 16; ++i) { v[i] = v[i] * rstd * pg[i] + pb[i]; F.x1[(size_t)tok * D + lane + 64 * i] = v[i]; s += v[i]; }
            mean = wsum(s) * (1.f / D); q = 0.f;
#pragma unroll
            for (int i = 0; i < 16; ++i) { v[i] -= mean; q += v[i] * v[i]; }
            rstd = rsqrtf(wsum(q) * (1.f / D) + EPS);
#pragma unroll
            for (int i = 0; i < 16; ++i) { v[i] = v[i] * rstd * ps[i] + ph[i]; hrow[lane + 64 * i] = (unsigned char)__builtin_amdgcn_cvt_pk_fp8_f32(v[i], v[i], 0, false); }
            float lg[NE];
#pragma unroll
            for (int e = 0; e < NE; ++e) lg[e] = 0.f;
#pragma unroll
            for (int i = 0; i < 16; ++i) {
                f32x4 w4[8];
#pragma unroll
                for (int qq = 0; qq < 8; ++qq) w4[qq] = *(const LAS f32x4*)(wbase + i * 8192 + ((qq ^ sw) << 4));
                __builtin_amdgcn_sched_barrier(0);
#pragma unroll
                for (int qq = 0; qq < 8; ++qq)
#pragma unroll
                    for (int jj = 0; jj < 4; ++jj) lg[qq * 4 + jj] += v[i] * w4[qq][jj];
                __builtin_amdgcn_sched_barrier(0);
            }
            LDS_WAIT();
            *(u32x4*)(F.h2 + (size_t)tok * D + lane * 16) = *(const LAS u32x4*)(hrow + lane * 16);
            float r16[16], r8[8], r4[4], r2[2], r1;
            { const bool hi = lane & 32;
#pragma unroll
              for (int e = 0; e < 16; ++e) { const float mine = hi ? lg[e + 16] : lg[e], send = hi ? lg[e] : lg[e + 16]; r16[e] = mine + __shfl_xor(send, 32); } }
            { const bool hi = lane & 16;
#pragma unroll
              for (int e = 0; e < 8; ++e) { const float mine = hi ? r16[e + 8] : r16[e], send = hi ? r16[e] : r16[e + 8]; r8[e] = mine + __shfl_xor(send, 16); } }
            { const bool hi = lane & 8;
#pragma unroll
              for (int e = 0; e < 4; ++e) { const float mine = hi ? r8[e + 4] : r8[e], send = hi ? r8[e] : r8[e + 4]; r4[e] = mine + __shfl_xor(send, 8); } }
            { const bool hi = lane & 4;
#pragma unroll
              for (int e = 0; e < 2; ++e) { const float mine = hi ? r4[e + 2] : r4[e], send = hi ? r4[e] : r4[e + 2]; r2[e] = mine + __shfl_xor(send, 4); } }
            { const bool hi = lane & 2; const float mine = hi ? r2[1] : r2[0], send = hi ? r2[0] : r2[1]; r1 = mine + __shfl_xor(send, 2); }
            r1 += __shfl_xor(r1, 1);
            const int e = lane >> 1;
            const float lgt = r1 + F.router_b[e];
            int rank = 0; float mx = -3.0e38f;
#pragma unroll
            for (int e2 = 0; e2 < NE; ++e2) { const float o = __builtin_bit_cast(float, __builtin_amdgcn_readlane(__builtin_bit_cast(int, lgt), 2 * e2));
                rank += (o > lgt || (o == lgt && e2 < e)) ? 1 : 0; mx = fmaxf(mx, o); }
            const bool selq = rank < TOPK && !(lane & 1);
            const float pe = selq ? __expf(lgt - mx) : 0.f;
            const float den = wsum(pe);
            if (selq) {
                const int lp = __hip_atomic_fetch_add(lcnt + e, 1, __ATOMIC_RELAXED, __HIP_MEMORY_SCOPE_WORKGROUP);
                sel[tl * 4 + rank] = e | (lp << 8);
                F.topg[tok * 4 + rank] = pe / den; F.topi[tok * 4 + rank] = e;
            }
        }
        __syncthreads();
        if (F.tid < 32) { const int n = lcnt[F.tid]; gbase[F.tid] = n ? (int)__hip_atomic_fetch_add(F.cntw + 32 * F.tid, (unsigned)n, __ATOMIC_RELAXED, __HIP_MEMORY_SCOPE_AGENT) : 0; lcnt[F.tid] = 0; }
        __syncthreads();
        if (F.tid < 256) { const int sv = sel[F.tid], e = sv & 255, lp = sv >> 8; F.list[(size_t)e * LCAP + gbase[e] + lp] = (tb * 64 + (F.tid >> 2)) * 4 + (F.tid & 3); }
        __syncthreads();
    }
}

__device__ __forceinline__ void p_final(Frame& F) {
    const int gw = F.vcu * 8 + F.wave, NGW = F.G * 8;
    for (int tok = gw; tok < M; tok += NGW) {
        const float* g2 = F.mod + (tok >> 13) * 6144 + 5 * 1024;
        const f32x4* xp = (const f32x4*)(F.x1 + (size_t)tok * D) + F.lane;
        f32x4 v[4]; float s = 0.f;
#pragma unroll
        for (int j = 0; j < 4; ++j) {
            f32x4 f = (f32x4){0.f, 0.f, 0.f, 0.f};
#pragma unroll
            for (int k = 0; k < TOPK; ++k) { const u32x2 yv = *((const u32x2*)(F.ybuf + (size_t)(tok * 4 + k) * D) + F.lane + 64 * j);
                f[0] += bflo(yv.x); f[1] += bfhi(yv.x); f[2] += bflo(yv.y); f[3] += bfhi(yv.y); }
            const f32x4 gv = *((const f32x4*)g2 + F.lane + 64 * j);
            v[j] = xp[64 * j] * DN_ALPHA + gv * f; s += (v[j][0] + v[j][1]) + (v[j][2] + v[j][3]);
        }
        const float mean = wsum(s) * (1.f / D); float q = 0.f;
#pragma unroll
        for (int j = 0; j < 4; ++j) { v[j] = v[j] - mean; q += (v[j][0] * v[j][0] + v[j][1] * v[j][1]) + (v[j][2] * v[j][2] + v[j][3] * v[j][3]); }
        const float rstd = rsqrtf(wsum(q) * (1.f / D) + EPS);
        f32x4* op = (f32x4*)(F.out + (size_t)tok * D) + F.lane;
#pragma unroll
        for (int j = 0; j < 4; ++j) { const f32x4 gg = *((const f32x4*)F.ln2_g + F.lane + 64 * j), bb = *((const f32x4*)F.ln2_b + F.lane + 64 * j); op[64 * j] = v[j] * rstd * gg + bb; }
    }
}

struct Args { const float* in[23]; float* out; unsigned char* ws; int ph_lo, ph_hi, alt, pad; };
constexpr int N_PHASES = 9;
__global__ void __launch_bounds__(512, 2) mk_fwd(Args args) {
    extern __shared__ __attribute__((aligned(16))) unsigned char lds_raw[];
    Frame F;
    F.lds = (LAS unsigned char*)lds_raw;
    F.MISC = (volatile LAS unsigned*)(F.lds + L_MISC);
    F.tid = threadIdx.x; F.lane = F.tid & 63; F.wave = __builtin_amdgcn_readfirstlane(F.tid >> 6);
    F.G = gridDim.x; { const int bx = blockIdx.x; F.vcu = (F.G % 8 == 0) ? (bx % 8) * (F.G / 8) + bx / 8 : bx; }
    unsigned char* ws = args.ws;
    F.ctl = (unsigned*)(ws + WS_CTL);
    F.x = args.in[0]; F.c = args.in[1]; F.ctx = args.in[2]; F.c_ctx = args.in[3]; F.ada_w = args.in[4]; F.ada_b = args.in[5]; F.w_in = args.in[6]; F.rpb = args.in[7];
    F.sgu_ln_g = args.in[8]; F.sgu_ln_b = args.in[9]; F.sgu_w = args.in[10]; F.sgu_b = args.in[11]; F.w_out = args.in[12]; F.ln1_g = args.in[13]; F.ln1_b = args.in[14];
    F.ln2_g = args.in[15]; F.ln2_b = args.in[16]; F.router_w = args.in[17]; F.router_b = args.in[18]; F.w_gu = args.in[19]; F.b_gu = args.in[20]; F.w_dn = args.in[21]; F.b_dn = args.in[22];
    F.out = args.out;
    F.mod = (float*)(ws + WS_MOD); F.topg = (float*)(ws + WS_TOPG); F.topi = (int*)(ws + WS_TOPI); F.list = (int*)(ws + WS_LIST); F.sguw = (bf16_t*)(ws + WS_SGUW);
    F.Wt_in = (bf16_t*)(ws + WS_WIN); F.Wt_out = (bf16_t*)(ws + WS_WOUT); F.Wt_gu = ws + WS_WGU; F.Wt_dn = ws + WS_WDN;
    F.hxc = (bf16_t*)(ws + WS_HXC); F.proj = (bf16_t*)(ws + WS_PROJ); F.mixin = (bf16_t*)(ws + WS_MIXIN); F.y1 = (float*)(ws + WS_Y1); F.x1 = (float*)(ws + WS_X1); F.cntw = F.ctl + CW_CNT; F.h2 = ws + WS_H2;
    F.act = ws + WS_ACT; F.ybuf = (bf16_t*)(ws + WS_YBUF);
    for (int u = F.tid; u < (LDS_BYTES - L_MISC) / 4; u += 512) ((LAS unsigned*)(F.lds + L_MISC))[u] = 0u;
    __syncthreads();
    if (args.alt) { F.x1 = (float*)(ws + WS_ALT); F.h2 = ws + WS_ALT + 64 * MiB; F.list = (int*)(ws + WS_ALT + 80 * MiB); F.topg = (float*)(ws + WS_ALT + 82 * MiB); F.topi = (int*)(ws + WS_ALT + 82 * MiB + 512 * 1024); F.cntw = F.ctl + CW_CNT_ALT; }
    const int lo = args.ph_lo, hi = args.ph_hi;
    const bool one = (hi - lo) > 1;
    XcdBarrier bar; bar.bar = (unsigned*)(F.ctl + CW_BAR); bar.x = 0; bar.st = nullptr;
    if (one) bar = xcd_barrier_post((unsigned*)(F.ctl + CW_BAR), F.MISC + 8);
#define IN(k) (lo <= (k) && (k) < hi)
#define SEAM(k) do { if (IN(k) && IN((k) + 1)) xcd_barrier(bar); } while (0)
#ifndef PROBE_REPS
#define PROBE_REPS {1, 1, 1, 1, 1, 1, 1, 1, 1}
#endif
    constexpr int REPS[N_PHASES] = PROBE_REPS;
#define REPEAT(k) _Pragma("unroll") for (int rep_ = 0; rep_ < REPS[k]; ++rep_)
#define RSEAM(k) do { if (rep_ + 1 < REPS[k]) xcd_barrier(bar); else SEAM(k); } while (0)
    if (IN(0)) REPEAT(0) { p_ada(F); p_weights(F); RSEAM(0); }
    if (IN(1)) REPEAT(1) { p_lnmod(F); RSEAM(1); }
    if (IN(2)) REPEAT(2) { PolProj P{F.hxc, F.Wt_in, F.proj, F.G, (int)blockIdx.x}; pg8::gemm_phase<PolProj>(F.lds, P); RSEAM(2); }
    if (IN(3)) REPEAT(3) { at::p_mixer(F); RSEAM(3); }
    if (IN(4)) REPEAT(4) { PolOut P{F.mixin, F.Wt_out, F.x, F.mod, F.y1, F.G, (int)blockIdx.x}; pg8::gemm_phase<PolOut>(F.lds, P); RSEAM(4); }
    if (IN(5)) { p_route(F); SEAM(5); }
    if (IN(6)) REPEAT(6) { const int T = expert_tables(F); ExpTab tb{(const LAS int*)(F.lds + L_TILEE), (const LAS int*)(F.lds + L_TSTART), (const LAS int*)(F.lds + L_TSTART) + 64, T};
        PolGU P{F.h2, F.Wt_gu, F.b_gu, F.list, F.act, tb, F.G, (int)blockIdx.x}; pg8::gemm_phase<PolGU>(F.lds, P); RSEAM(6); }
    if (IN(7)) REPEAT(7) { const int T = expert_tables(F); ExpTab tb{(const LAS int*)(F.lds + L_TILEE), (const LAS int*)(F.lds + L_TSTART), (const LAS int*)(F.lds + L_TSTART) + 64, T};
        PolDN P{F.act, F.Wt_dn, F.b_dn, F.list, F.topg, F.ybuf, tb, F.G, (int)blockIdx.x}; pg8::gemm_phase<PolDN>(F.lds, P); RSEAM(7); }
    if (IN(8)) REPEAT(8) { p_final(F); if (rep_ + 1 < REPS[8]) xcd_barrier(bar); }
#undef IN
#undef SEAM
#undef REPEAT
#undef RSEAM
}

static inline void launch_forward(void* const* d_in, void* d_out, void* d_ws, hipStream_t stream, int n_launches) {
    static int grid = 0;
    if (grid == 0) {
        int dev = 0, cus = 0;
        if (hipGetDevice(&dev) != hipSuccess || hipDeviceGetAttribute(&cus, hipDeviceAttributeMultiprocessorCount, dev) != hipSuccess) { fprintf(stderr, "kernel_launch: device query failed\n"); grid = -1; return; }
        if (hipFuncSetAttribute((const void*)mk_fwd, hipFuncAttributeMaxDynamicSharedMemorySize, LDS_BYTES) != hipSuccess) { fprintf(stderr, "kernel_launch: hipFuncSetAttribute failed\n"); grid = -1; return; }
        int per_cu = 0;
        if (hipOccupancyMaxActiveBlocksPerMultiprocessor(&per_cu, (const void*)mk_fwd, 512, LDS_BYTES) != hipSuccess || per_cu < 1) fprintf(stderr, "kernel_launch: occupancy query says %d\n", per_cu);
        (void)hipGetLastError();
        grid = cus;
    }
    if (grid < 0) return;
    (void)hipMemsetAsync((char*)d_ws + WS_CTL, 0, CTL_ZERO_BYTES, stream);
    Args a{};
    for (int i = 0; i < 23; ++i) a.in[i] = (const float*)d_in[i];
    a.out = (float*)d_out; a.ws = (unsigned char*)d_ws;
    if (n_launches == 1) { a.ph_lo = 0; a.ph_hi = N_PHASES; hipLaunchKernelGGL(mk_fwd, dim3(grid), dim3(512), LDS_BYTES, stream, a); }
    else for (int p = 0; p < N_PHASES; ++p) { a.ph_lo = p; a.ph_hi = p + 1; hipLaunchKernelGGL(mk_fwd, dim3(grid), dim3(512), LDS_BYTES, stream, a); }
#ifdef PROBE_EXTRA
    { const int extra[] = PROBE_EXTRA; for (int p : extra) { a.ph_lo = p; a.ph_hi = p + 1; a.alt = (p == 5); hipLaunchKernelGGL(mk_fwd, dim3(grid), dim3(512), LDS_BYTES, stream, a); } }
#endif
}
}
extern "C" void kernel_launch(void* const* d_in, const int* in_sizes, int n_in, void* d_out, int out_size, void* d_ws, size_t ws_size, hipStream_t stream) {
    if (ws_size < mk::WS_END || n_in != 23) { fprintf(stderr, "kernel_launch: unexpected workspace / inputs (%zu, %d)\n", ws_size, n_in); return; }
    mk::launch_forward(d_in, d_out, d_ws, stream, 1);
}
```

```cpp
#include <hip/hip_runtime.h>
#include <stdint.h>
#include <stdio.h>

#define GAS __attribute__((address_space(1)))
#define LAS __attribute__((address_space(3)))
typedef unsigned short bf16_t;
typedef short bf16x8 __attribute__((ext_vector_type(8)));
typedef float f32x4 __attribute__((ext_vector_type(4)));
typedef float f32x2 __attribute__((ext_vector_type(2)));
typedef unsigned u32x4 __attribute__((ext_vector_type(4)));
typedef unsigned u32x2 __attribute__((ext_vector_type(2)));

namespace mk {
constexpr int D = 1024, NB = 2, S = 8192, M = NB * S, GW = 64, ROWS = 128, CTX = 256, NH = 8, KH = 8, KW = 16;
constexpr int NE = 32, TOPK = 4, DFF = 1024, DIN = 2560, NPAIR = M * TOPK, MX = M + NB * CTX;
constexpr int LCAP = 16384, MAXT = 288, ACT_ROWS = MAXT * 256;
constexpr float EPS = 1e-5f;
constexpr float DN_ALPHA = 1.189207115002721f;
constexpr size_t MiB = 1u << 20;
constexpr size_t WS_CTL = 0, CTL_ZERO_BYTES = 1 * MiB;
constexpr size_t WS_MOD = 1 * MiB;
constexpr size_t WS_TOPG = 2 * MiB;
constexpr size_t WS_TOPI = 2 * MiB + 512 * 1024;
constexpr size_t WS_STAT = 5 * MiB + 512 * 1024;
constexpr size_t WS_LIST = 3 * MiB;
constexpr size_t WS_SGUW = 5 * MiB;
constexpr size_t WS_LISTG = 14 * MiB;
constexpr size_t WS_WIN = 6 * MiB;
constexpr size_t WS_WOUT = 11 * MiB;
constexpr size_t WS_WGU = 16 * MiB;
constexpr size_t WS_WDN = 144 * MiB;
constexpr size_t WS_HXC = 208 * MiB;
constexpr size_t WS_PROJ = 241 * MiB;
constexpr size_t WS_MIXIN = 324 * MiB;
constexpr size_t WS_Y1 = 356 * MiB;
constexpr size_t WS_H2 = 420 * MiB;
constexpr size_t WS_ACT = 452 * MiB;
constexpr size_t WS_YBUF = 596 * MiB;
constexpr size_t WS_X1 = 724 * MiB;
constexpr size_t WS_END = 788 * MiB;
constexpr size_t WS_ALT = 788 * MiB;
constexpr int CW_CNT_ALT = 12288;
constexpr int CW_BAR = 4096;
constexpr int CW_CNT = 8192;
constexpr int RING_BYTES = 131072;
constexpr int L_MISC = RING_BYTES;
constexpr int L_IDX = L_MISC + 1024;
constexpr int L_TILEE = L_IDX + 6144;
constexpr int L_TSTART = L_TILEE + 1280;
constexpr int L_ROUTE = L_TSTART + 512;
constexpr int L_RPB = L_ROUTE + 256 + 1024;
constexpr int L_WSCR = L_RPB + 2048;
constexpr int LDS_BYTES = 155648;
static_assert(L_WSCR + 8 * 1024 <= LDS_BYTES, "LDS map");

template <int CTRL> __device__ __forceinline__ float dppf(float v) { return __builtin_bit_cast(float, __builtin_amdgcn_update_dpp(0, __builtin_bit_cast(int, v), CTRL, 0xF, 0xF, true)); }
__device__ __forceinline__ float rlane(float v, int l) { return __builtin_bit_cast(float, __builtin_amdgcn_readlane(__builtin_bit_cast(int, v), l)); }
__device__ __forceinline__ float wsum(float v) {
    v += dppf<0xB1>(v); v += dppf<0x4E>(v); v += dppf<0x141>(v); v += dppf<0x140>(v);
    return (rlane(v, 0) + rlane(v, 16)) + (rlane(v, 32) + rlane(v, 48));
}
__device__ __forceinline__ float wmax(float v) {
    v = fmaxf(v, dppf<0xB1>(v)); v = fmaxf(v, dppf<0x4E>(v)); v = fmaxf(v, dppf<0x141>(v)); v = fmaxf(v, dppf<0x140>(v));
    return fmaxf(fmaxf(rlane(v, 0), rlane(v, 16)), fmaxf(rlane(v, 32), rlane(v, 48)));
}
__device__ __forceinline__ unsigned f2bf(float f) { unsigned u = __builtin_bit_cast(unsigned, f); return (u + 0x7fffu + ((u >> 16) & 1u)) >> 16; }
__device__ __forceinline__ unsigned pk2(float lo, float hi) { return f2bf(lo) | (f2bf(hi) << 16); }
__device__ __forceinline__ float bf2f(unsigned short b) { return __builtin_bit_cast(float, ((unsigned)b) << 16); }
__device__ __forceinline__ float bflo(unsigned w) { return __builtin_bit_cast(float, w << 16); }
__device__ __forceinline__ float bfhi(unsigned w) { return __builtin_bit_cast(float, w & 0xffff0000u); }
__device__ __forceinline__ unsigned cvt_pk_bf16(float lo, float hi) { unsigned r; asm volatile("v_cvt_pk_bf16_f32 %0, %1, %2" : "=v"(r) : "v"(lo), "v"(hi)); return r; }
__device__ __forceinline__ float gelu_fast(float x) {
    const float c1 = -2.302208198f;
    const float c3 = c1 * 0.044715f;
    const float x2 = x * x;
    const float t = x * (c1 + c3 * x2);
    return x * __builtin_amdgcn_rcpf(1.f + __builtin_amdgcn_exp2f(t));
}

#define XB_TMO      128
#define XB_XCNT(j)  (256  + 64 * (j))
#define XB_XSUB(j)  (1280 + 64 * (j))
#define XB_XGEN(j)  (2304 + 64 * (j))
#define XB_TOP      3328
#define XB_TOPGEN   3392
#define XCD_BAR_WORDS 3456
#define XB_SPIN_CAP (1u << 18)
__device__ __forceinline__ unsigned xb_ld(unsigned* p)              { return __hip_atomic_load(p, __ATOMIC_RELAXED, __HIP_MEMORY_SCOPE_AGENT); }
__device__ __forceinline__ unsigned xb_add(unsigned* p, unsigned v) { return __hip_atomic_fetch_add(p, v, __ATOMIC_RELAXED, __HIP_MEMORY_SCOPE_AGENT); }
__device__ __forceinline__ unsigned xb_xcc_id() { return (unsigned)__builtin_amdgcn_s_getreg((3 << 11) | 20) & 0xFu; }
#define XB_SPIN(cond, bar) do { unsigned _sp = 0; while (cond) { __builtin_amdgcn_s_sleep(1); \
    if ((++_sp & 255u) == 0u) { if (xb_ld(&(bar)[XB_TMO])) break; if (_sp > XB_SPIN_CAP) { atomicAdd(&(bar)[XB_TMO], 1u); break; } } } } while (0)
struct XcdBarrier { unsigned* bar; unsigned x; volatile LAS unsigned* st; };
__device__ __forceinline__ XcdBarrier xcd_barrier_post(unsigned* bar, volatile LAS unsigned* st) {
    XcdBarrier b; b.bar = bar; b.x = xb_xcc_id(); b.st = st;
    if (threadIdx.x == 0) (void)xb_add(&bar[XB_XCNT(b.x)], 1u);
    return b;
}
__device__ __forceinline__ void xcd_barrier_complete(unsigned* bar, unsigned x, unsigned& nloc, unsigned& nx) {
    const unsigned G = gridDim.x * gridDim.y * gridDim.z;
    unsigned sum, cnt, mine, sp = 0u;
    for (;;) {
        sum = 0u; cnt = 0u; mine = 0u;
#pragma unroll
        for (unsigned j = 0; j < 16; ++j) { const unsigned c = xb_ld(&bar[XB_XCNT(j)]); sum += c; cnt += (c > 0u) ? 1u : 0u; mine = (j == x) ? c : mine; }
        if (sum == G) break;
        __builtin_amdgcn_s_sleep(1);
        if ((++sp & 255u) == 0u) { if (xb_ld(&bar[XB_TMO])) break; if (sp > XB_SPIN_CAP) { atomicAdd(&bar[XB_TMO], 1u); break; } }
    }
    nloc = mine > 0u ? mine : 1u; nx = cnt > 0u ? cnt : 1u;
}
__device__ __forceinline__ void xcd_barrier(const XcdBarrier& b) {
    asm volatile("s_waitcnt vmcnt(0)" ::: "memory");
    __syncthreads();
    if (threadIdx.x == 0) {
        unsigned* bar = b.bar;
        __builtin_amdgcn_s_waitcnt(0);
        unsigned nloc = b.st[0], nx = b.st[1];
        if (nloc == 0u) { xcd_barrier_complete(bar, b.x, nloc, nx); b.st[0] = nloc; b.st[1] = nx; }
        const unsigned old = xb_add(&bar[XB_XSUB(b.x)], 1u);
        const unsigned gen = old / nloc;
        if (old + 1u == (gen + 1u) * nloc) {
            __builtin_amdgcn_fence(__ATOMIC_RELEASE, "agent");
            asm volatile("s_waitcnt vmcnt(0)" ::: "memory");
            const unsigned og = xb_add(&bar[XB_TOP], 1u);
            const unsigned tg = og / nx;
            if (og + 1u == (tg + 1u) * nx) xb_add(&bar[XB_TOPGEN], 1u);
            else XB_SPIN(xb_ld(&bar[XB_TOPGEN]) == tg, bar);
            __builtin_amdgcn_fence(__ATOMIC_ACQUIRE, "agent");
            xb_add(&bar[XB_XGEN(b.x)], 1u);
            asm volatile("s_waitcnt vmcnt(0)" ::: "memory");
        } else {
            XB_SPIN(xb_ld(&bar[XB_XGEN(b.x)]) == gen, bar);
            __builtin_amdgcn_fence(__ATOMIC_ACQUIRE, "agent");
            asm volatile("s_waitcnt vmcnt(0)" ::: "memory");
        }
    }
    __syncthreads();
}

struct Frame {
    LAS unsigned char* lds;
    volatile LAS unsigned* MISC;
    unsigned* ctl;
    int tid, lane, wave, vcu, G;
    const float *x, *c, *ctx, *c_ctx, *ada_w, *ada_b, *w_in, *rpb, *sgu_ln_g, *sgu_ln_b, *sgu_w, *sgu_b, *w_out, *ln1_g, *ln1_b, *ln2_g, *ln2_b, *router_w, *router_b, *w_gu, *b_gu, *w_dn, *b_dn;
    float* out;
    float* mod; float* topg; int* topi; int* list; float* listg; bf16_t* sguw; bf16_t* Wt_in; bf16_t* Wt_out; unsigned char* Wt_gu; unsigned char* Wt_dn;
    bf16_t* hxc; bf16_t* proj; bf16_t* mixin; float* y1; float* x1; f32x2* stat; unsigned* cntw; unsigned char* h2; unsigned char* act; bf16_t* ybuf;
};
#define LDS_WAIT() asm volatile("s_waitcnt lgkmcnt(0)" ::: "memory")
#define VM_WAIT() asm volatile("s_waitcnt vmcnt(0)" ::: "memory")

namespace pg8 {
constexpr int BM = 256, BK = 64, HALF = 128, HTB = HALF * BK * 2, STAGE_BYTES = 8 * HTB, NXCD = 8, WGM = 8, KD = 1024, NKT = KD / BK;
__device__ __forceinline__ int lds_byte(int r, int c) { const int st = (r >> 4) * 2 + (c >> 5), rr = r & 15, cc = c & 31, ob = rr * 64 + cc * 2; return st * 1024 + (ob ^ (((ob >> 9) & 1) << 5)); }
__device__ __forceinline__ void stage_rc(int b, int& R, int& C) { const int st = b / 1024, sb = b % 1024, swz = sb ^ (((sb >> 9) & 1) << 5); R = (st >> 1) * 16 + swz / 64; C = (st & 1) * 32 + (swz % 64) / 2; }
__device__ __forceinline__ int perm32(int rho) { const int n = rho >> 4, i = rho & 15; return 8 * (i >> 2) + 4 * n + (i & 3); }
struct Unit { int pm, pn, e, nvalid, ti; };
__device__ __forceinline__ void static_tile(int L, int nM, int nN, int& pm, int& pn) {
    const int nwg = nM * nN; int wgid = L;
    { const int q = nwg / NXCD, r = nwg % NXCD, xcd = wgid % NXCD, off = wgid / NXCD; wgid = (xcd < r ? xcd * (q + 1) : r * (q + 1) + (xcd - r) * q) + off; }
    const int nig = WGM * nN, gid = wgid / nig, fm = gid * WGM, gsz = (nM - fm) < WGM ? (nM - fm) : WGM;
    pm = fm + ((wgid % nig) % gsz); pn = (wgid % nig) / gsz;
}

typedef int v8i __attribute__((ext_vector_type(8)));
template <bool FP8> struct Frags;
template <> struct Frags<false> { bf16x8 At[4][2], B0[2][2], B1[2][2]; };
template <> struct Frags<true> { v8i At[4], B0[2], B1[2]; };
template <class P>
__device__ __forceinline__ void gemm_phase(LAS unsigned char* lds, const P& pol) {
    const int tid = threadIdx.x, wid = __builtin_amdgcn_readfirstlane(tid >> 6), lane = tid & 63, wr = wid >> 2, wc = wid & 3, fr = lane & 15, fq = lane >> 4;
    constexpr int KDB = P::FP8 ? 1024 : 2048, NKT_ = KDB / 128;
    unsigned voffB[2];
#pragma unroll
    for (int i = 0; i < 2; ++i) { int R, C; stage_rc(tid * 16 + i * 8192, R, C); const int Rb = P::PERM ? ((R & ~31) + perm32(R & 31)) : R;
        voffB[i] = (unsigned)(Rb * KDB + C * 2); }
    const size_t kstep = (size_t)(BK * 2);
    const size_t hstep = (size_t)HALF * KDB;
    const unsigned ldsw = (unsigned)wid * 1024u;
    const int aoff = lds_byte(wr * 64 + fr, fq * 8), boff = lds_byte(wc * 32 + fr, fq * 8);
#define PG8_SA(b, h) (((b) * 2 + (h)) * HTB)
#define PG8_SB(b, h) ((4 + (b) * 2 + (h)) * HTB)
#define PG8_STAGE(bufoff, gbase, voff) do { _Pragma("unroll") for (int _i = 0; _i < 2; ++_i) \
        __builtin_amdgcn_global_load_lds((const unsigned*)((const char*)(gbase) + (voff)[_i]), (LAS unsigned*)(lds + (bufoff) + ldsw + _i * 8192), 16, 0, 0); } while (0)
#define PG8_RD8(p) __builtin_shufflevector(*(const LAS u32x4*)(p), *(const LAS u32x4*)((p) + 1024), 0, 1, 2, 3, 4, 5, 6, 7)
#define PG8_LDA(dst, b, h) do { if constexpr (P::FP8) { _Pragma("unroll") for (int m = 0; m < 4; ++m) fg.dst[m] = __builtin_bit_cast(v8i, PG8_RD8(lds + PG8_SA(b, h) + aoff + m * 2048)); } \
        else { _Pragma("unroll") for (int m = 0; m < 4; ++m) _Pragma("unroll") for (int k = 0; k < 2; ++k) fg.dst[m][k] = *(const LAS bf16x8*)(lds + PG8_SA(b, h) + aoff + m * 2048 + k * 1024); } } while (0)
#define PG8_LDB(dst, b, h) do { if constexpr (P::FP8) { _Pragma("unroll") for (int n = 0; n < 2; ++n) fg.dst[n] = __builtin_bit_cast(v8i, PG8_RD8(lds + PG8_SB(b, h) + boff + n * 2048)); } \
        else { _Pragma("unroll") for (int n = 0; n < 2; ++n) _Pragma("unroll") for (int k = 0; k < 2; ++k) fg.dst[n][k] = *(const LAS bf16x8*)(lds + PG8_SB(b, h) + boff + n * 2048 + k * 1024); } } while (0)
#define PG8_MMA(ai, bj, At, Bt) do { __builtin_amdgcn_s_setprio(1); \
        if constexpr (P::FP8) { _Pragma("unroll") for (int m = 0; m < 4; ++m) _Pragma("unroll") for (int n = 0; n < 2; ++n) \
            acc[ai][bj][m][n] = __builtin_amdgcn_mfma_scale_f32_16x16x128_f8f6f4(fg.Bt[n], fg.At[m], acc[ai][bj][m][n], 0, 0, 0, 0, 0, 0); } \
        else { _Pragma("unroll") for (int m = 0; m < 4; ++m) _Pragma("unroll") for (int n = 0; n < 2; ++n) _Pragma("unroll") for (int k = 0; k < 2; ++k) \
            acc[ai][bj][m][n] = __builtin_amdgcn_mfma_f32_16x16x32_bf16(fg.Bt[n][k], fg.At[m][k], acc[ai][bj][m][n], 0, 0, 0); } \
        __builtin_amdgcn_s_setprio(0); } while (0)
#define PG8_WAIT_V(n) asm volatile("s_waitcnt vmcnt(" #n ")" ::: "memory")
#define PG8_WAIT_L(n) asm volatile("s_waitcnt lgkmcnt(" #n ")" ::: "memory")
#define PG8_BAR __builtin_amdgcn_s_barrier()
#define PG8_SCHED __builtin_amdgcn_sched_barrier(0)
    Unit cur, nxt; int ui = 0;
    if (!pol.next(0, cur)) return;
    f32x4 acc[2][2][4][2];
#pragma unroll
    for (int a = 0; a < 2; ++a)
#pragma unroll
        for (int b = 0; b < 2; ++b)
#pragma unroll
            for (int m = 0; m < 4; ++m)
#pragma unroll
                for (int n = 0; n < 2; ++n) acc[a][b][m][n] = (f32x4){0.f, 0.f, 0.f, 0.f};
    Frags<P::FP8> fg;
    int slot = 0;
    if (P::META) { pol.meta_issue(cur, 0, lds, wid, lane); PG8_WAIT_V(0); asm volatile("" ::: "memory"); PG8_BAR; asm volatile("" ::: "memory"); }
    unsigned aC[2][2];
    pol.a_off(cur, 0, lds, aC);
    const char* const Ab = (const char*)pol.A;
    const char* cB = pol.b_ptr(cur);
    PG8_STAGE(PG8_SB(0, 0), cB, voffB); PG8_STAGE(PG8_SB(0, 1), cB + hstep, voffB); PG8_STAGE(PG8_SA(0, 0), Ab, aC[0]); PG8_STAGE(PG8_SA(0, 1), Ab, aC[1]);
    if (wr == 1) PG8_BAR;
    PG8_WAIT_V(2); PG8_BAR;
    PG8_STAGE(PG8_SB(1, 0), cB + kstep, voffB); PG8_STAGE(PG8_SA(1, 0), Ab + kstep, aC[0]); PG8_STAGE(PG8_SB(1, 1), cB + hstep + kstep, voffB);
    PG8_WAIT_V(6); PG8_BAR;
    for (;;) {
        const bool has_next = pol.next(ui + 1, nxt);
        const int nslot = slot == 2 ? 0 : slot + 1;
        if (P::META) { if (has_next) pol.meta_issue(nxt, nslot, lds, wid, lane); }
        const char* nB = has_next ? pol.b_ptr(nxt) : cB;
#pragma unroll 1
        for (int t = 0; t < NKT_; t += 2) {
            const bool last = (t == NKT_ - 2);
            const char* a1 = Ab + (size_t)(t + 1) * kstep;
            const char* a2 = last ? Ab : Ab + (size_t)(t + 2) * kstep; const char* b2 = last ? nB : cB + (size_t)(t + 2) * kstep;
            const char* a3 = a2 + kstep; const char* b3 = b2 + kstep;
            PG8_LDB(B0, 0, 0); PG8_LDB(B1, 0, 1); PG8_SCHED; PG8_LDA(At, 0, 0); PG8_STAGE(PG8_SA(1, 1), a1, aC[1]);
            if (last && has_next) pol.a_off(nxt, nslot, lds, aC);
            PG8_WAIT_V(8); PG8_WAIT_L(0); PG8_BAR; PG8_MMA(0, 0, At, B0); PG8_MMA(0, 1, At, B1); PG8_BAR; PG8_SCHED;
            PG8_LDA(At, 0, 1); PG8_STAGE(PG8_SB(0, 0), b2, voffB); PG8_STAGE(PG8_SB(0, 1), b2 + hstep, voffB); PG8_STAGE(PG8_SA(0, 0), a2, aC[0]);
            PG8_WAIT_V(8); PG8_WAIT_L(0); PG8_BAR; PG8_MMA(1, 0, At, B0); PG8_MMA(1, 1, At, B1); PG8_BAR; PG8_SCHED;
            PG8_LDB(B0, 1, 0); PG8_LDB(B1, 1, 1); PG8_SCHED; PG8_LDA(At, 1, 0); PG8_STAGE(PG8_SA(0, 1), a2, aC[1]);
            PG8_WAIT_V(8); PG8_WAIT_L(0); PG8_BAR; PG8_MMA(0, 0, At, B0); PG8_MMA(0, 1, At, B1); PG8_BAR; PG8_SCHED;
            PG8_LDA(At, 1, 1); PG8_STAGE(PG8_SB(1, 0), b3, voffB); PG8_STAGE(PG8_SB(1, 1), b3 + hstep, voffB); PG8_STAGE(PG8_SA(1, 0), a3, aC[0]);
            PG8_WAIT_V(8); PG8_WAIT_L(0); PG8_BAR; PG8_MMA(1, 0, At, B0); PG8_MMA(1, 1, At, B1); PG8_BAR; PG8_SCHED;
        }
        if (wr == 0) PG8_BAR;
#ifdef PROBE_KLOOP2
        const bool do_epi = !P::FP8 || (ui & 1);
        if (do_epi) {
            if (P::FP8) {
#pragma unroll
                for (int a = 0; a < 2; ++a)
#pragma unroll
                    for (int b = 0; b < 2; ++b)
#pragma unroll
                        for (int m = 0; m < 4; ++m)
#pragma unroll
                            for (int n = 0; n < 2; ++n) acc[a][b][m][n] *= 0.5f; }
            pol.epi(acc, cur, slot, lds, wr, wc, fr, fq); }
#else
        constexpr bool do_epi = true;
        pol.epi(acc, cur, slot, lds, wr, wc, fr, fq);
#endif
#ifdef PROBE_EPI2
        if (P::META) { asm volatile("" ::: "memory");
#pragma unroll
            for (int a = 0; a < 2; ++a)
#pragma unroll
                for (int b = 0; b < 2; ++b)
#pragma unroll
                    for (int m = 0; m < 4; ++m)
#pragma unroll
                        for (int n = 0; n < 2; ++n) asm volatile("" : "+v"(acc[a][b][m][n]));
            pol.epi(acc, cur, slot, lds, wr, wc, fr, fq); }
#endif
        if (!has_next) break;
        if (do_epi) {
#pragma unroll
        for (int a = 0; a < 2; ++a)
#pragma unroll
            for (int b = 0; b < 2; ++b)
#pragma unroll
                for (int m = 0; m < 4; ++m)
#pragma unroll
                    for (int n = 0; n < 2; ++n) acc[a][b][m][n] = (f32x4){0.f, 0.f, 0.f, 0.f};
        }
        cur = nxt; cB = nB; ++ui; slot = nslot;
        if (wr == 1) PG8_BAR;
    }
    PG8_WAIT_V(0);
    PG8_BAR;
#undef PG8_SA
#undef PG8_SB
#undef PG8_STAGE
#undef PG8_LDA
#undef PG8_LDB
#undef PG8_MMA
#undef PG8_RD8
#undef PG8_WAIT_V
#undef PG8_WAIT_L
#undef PG8_BAR
#undef PG8_SCHED
}
}

typedef f32x4 AccT[2][2][4][2];

struct PolProj {
    static constexpr bool PERM = true, META = false, FP8 = false; static constexpr int SCALE_W = 0x7f7f7f7f;
    const bf16_t* A; const bf16_t* Bt; bf16_t* O; int G, c;
    __device__ __forceinline__ bool next(int i, pg8::Unit& u) const {
        const int L = i * G + c;
        if (L < 640) { pg8::static_tile(L, 64, 10, u.pm, u.pn); return true; }
        if (L < 648) { const int j = L - 640; u.pm = 64 + (j >> 2); u.pn = 2 + (j & 3); return true; }
        return false;
    }
    __device__ __forceinline__ const char* b_ptr(const pg8::Unit& u) const { return (const char*)Bt + (size_t)u.pn * 256 * 1024 * 2; }
    __device__ __forceinline__ void meta_issue(const pg8::Unit&, int, LAS unsigned char*, int, int) const {}
    __device__ __forceinline__ void a_off(const pg8::Unit& u, int, LAS unsigned char*, unsigned (&o)[2][2]) const {
        int Ra[2], Ca[2]; pg8::stage_rc((int)threadIdx.x * 16, Ra[0], Ca[0]); pg8::stage_rc((int)threadIdx.x * 16 + 8192, Ra[1], Ca[1]);
#pragma unroll
        for (int h = 0; h < 2; ++h)
#pragma unroll
            for (int i = 0; i < 2; ++i) o[h][i] = (unsigned)((u.pm * 256 + 128 * h + Ra[i]) * 1024 + Ca[i]) * 2u;
    }
    __device__ __forceinline__ void epi(const AccT& acc, const pg8::Unit& u, int, LAS unsigned char*, int wr, int wc, int fr, int fq) const {
        const int row0 = u.pm * 256 + wr * 64 + fr, col0 = u.pn * 256 + wc * 32 + 8 * fq;
        const bool act = u.pn >= 6;
#pragma unroll
        for (int ai = 0; ai < 2; ++ai)
#pragma unroll
            for (int m = 0; m < 4; ++m) { bf16_t* rowp = O + (size_t)(row0 + ai * 128 + m * 16) * DIN + col0;
#pragma unroll
                for (int bj = 0; bj < 2; ++bj) { f32x4 v0 = acc[ai][bj][m][0], v1 = acc[ai][bj][m][1];
                    if (act) {
#pragma unroll
                        for (int j = 0; j < 4; ++j) { v0[j] = gelu_fast(v0[j]); v1[j] = gelu_fast(v1[j]); } }
                    u32x4 w; w.x = cvt_pk_bf16(v0[0], v0[1]); w.y = cvt_pk_bf16(v0[2], v0[3]); w.z = cvt_pk_bf16(v1[0], v1[1]); w.w = cvt_pk_bf16(v1[2], v1[3]);
                    *(u32x4*)(rowp + bj * 128) = w; } }
    }
};

struct PolOut {
    static constexpr bool PERM = false, META = false, FP8 = false; static constexpr int SCALE_W = 0x7f7f7f7f;
    const bf16_t* A; const bf16_t* Bt; const float* x; const float* mod; float* Y; int G, c;
    __device__ __forceinline__ bool next(int i, pg8::Unit& u) const { const int L = i * G + c; if (L >= 256) return false; pg8::static_tile(L, 64, 4, u.pm, u.pn); return true; }
    __device__ __forceinline__ const char* b_ptr(const pg8::Unit& u) const { return (const char*)Bt + (size_t)u.pn * 256 * 1024 * 2; }
    __device__ __forceinline__ void meta_issue(const pg8::Unit&, int, LAS unsigned char*, int, int) const {}
    __device__ __forceinline__ void a_off(const pg8::Unit& u, int, LAS unsigned char*, unsigned (&o)[2][2]) const {
        int Ra[2], Ca[2]; pg8::stage_rc((int)threadIdx.x * 16, Ra[0], Ca[0]); pg8::stage_rc((int)threadIdx.x * 16 + 8192, Ra[1], Ca[1]);
#pragma unroll
        for (int h = 0; h < 2; ++h)
#pragma unroll
            for (int i = 0; i < 2; ++i) o[h][i] = (unsigned)((u.pm * 256 + 128 * h + Ra[i]) * 1024 + Ca[i]) * 2u;
    }
    __device__ __forceinline__ void epi(const AccT& acc, const pg8::Unit& u, int, LAS unsigned char*, int wr, int wc, int fr, int fq) const {
        const int row0 = u.pm * 256 + wr * 64 + fr, col0 = u.pn * 256 + wc * 32 + 4 * fq;
        const float* g1 = mod + (u.pm >= 32 ? 6144 : 0) + 2 * 1024;
        f32x4 gv[2][2];
#pragma unroll
        for (int bj = 0; bj < 2; ++bj)
#pragma unroll
            for (int n = 0; n < 2; ++n) gv[bj][n] = *(const f32x4*)(g1 + col0 + bj * 128 + n * 16);
#pragma unroll
        for (int ai = 0; ai < 2; ++ai)
#pragma unroll
            for (int m = 0; m < 4; ++m) { const size_t off = (size_t)(row0 + ai * 128 + m * 16) * D + col0;
#pragma unroll
                for (int bj = 0; bj < 2; ++bj)
#pragma unroll
                    for (int n = 0; n < 2; ++n) { const f32x4 xv = *(const f32x4*)(x + off + bj * 128 + n * 16);
                        *(f32x4*)(Y + off + bj * 128 + n * 16) = xv * DN_ALPHA + gv[bj][n] * acc[ai][bj][m][n]; }
                asm volatile("" ::: "memory"); }
    }
};

struct ExpTab { const LAS int* tile_e; const LAS int* tstart; const LAS int* cnt; int T; };
__device__ __forceinline__ int expert_tables(Frame& F) {
    LAS int* tile_e = (LAS int*)(F.lds + L_TILEE); LAS int* tstart = (LAS int*)(F.lds + L_TSTART); LAS int* cn = tstart + 64;
    if (F.tid < 32) cn[F.tid] = (int)__hip_atomic_load(F.ctl + CW_CNT + 32 * F.tid, __ATOMIC_RELAXED, __HIP_MEMORY_SCOPE_AGENT);
    __syncthreads();
    if (F.tid == 0) { int run = 0; for (int e = 0; e < NE; ++e) { tstart[e] = run; run += (cn[e] + 255) >> 8; } tstart[NE] = run; }
    __syncthreads();
    const int T = tstart[NE];
    if (F.tid < MAXT && F.tid < T) { int e = 0; while (e < NE - 1 && tstart[e + 1] <= F.tid) ++e; tile_e[F.tid] = e; }
    __syncthreads();
    return T < MAXT ? T : MAXT;
}
__device__ __forceinline__ int rfl(int v) { return __builtin_amdgcn_readfirstlane(v); }

struct PolGU {
    static constexpr bool PERM = true, META = true, FP8 = true; static constexpr int SCALE_W = 0; static constexpr float WSC = 1.f / 64.f;
    const unsigned char* A; const unsigned char* Bt; const float* bias; const int* list; unsigned char* O; ExpTab tb; int G, c;
    __device__ __forceinline__ bool next(int i, pg8::Unit& u) const {
#ifdef PROBE_KLOOP2
        const int L = (i >> 1) * G + c; if (L >= tb.T * 8) return false;
#else
        const int L = i * G + c; if (L >= tb.T * 8) return false;
#endif
        u.ti = L >> 3; u.pn = L & 7; u.e = rfl(tb.tile_e[u.ti]); u.pm = u.ti - rfl(tb.tstart[u.e]);
        const int rem = rfl(tb.cnt[u.e]) - u.pm * 256; u.nvalid = rem < 256 ? rem : 256; return true;
    }
    __device__ __forceinline__ const char* b_ptr(const pg8::Unit& u) const { return (const char*)Bt + ((size_t)u.e * 2048 + (size_t)u.pn * 256) * 1024; }
    __device__ __forceinline__ void meta_issue(const pg8::Unit& u, int slot, LAS unsigned char* lds, int wid, int lane) const {
        if (wid < 4) __builtin_amdgcn_global_load_lds((const unsigned*)(list + (size_t)u.e * LCAP + u.pm * 256 + wid * 64 + lane), (LAS unsigned*)(lds + L_IDX + slot * 2048 + wid * 256), 4, 0, 0);
    }
    __device__ __forceinline__ void a_off(const pg8::Unit& u, int slot, LAS unsigned char* lds, unsigned (&o)[2][2]) const {
        int Ra[2], Ca[2]; pg8::stage_rc((int)threadIdx.x * 16, Ra[0], Ca[0]); pg8::stage_rc((int)threadIdx.x * 16 + 8192, Ra[1], Ca[1]);
        const LAS int* idx = (const LAS int*)(lds + L_IDX + slot * 2048);
#pragma unroll
        for (int h = 0; h < 2; ++h)
#pragma unroll
            for (int i = 0; i < 2; ++i) { const int r = 128 * h + Ra[i]; int pr = idx[r]; pr = r < u.nvalid ? pr : 0; o[h][i] = (unsigned)((pr >> 2) * 1024 + Ca[i] * 2); }
    }
    __device__ __forceinline__ void epi(const AccT& acc, const pg8::Unit& u, int, LAS unsigned char*, int wr, int wc, int fr, int fq) const {
        const int row0 = u.ti * 256 + wr * 64 + fr, col0 = u.pn * 128 + wc * 32 + 8 * fq;
        const float* bg = bias + (size_t)u.e * 2048 + col0;
        const f32x4 g0 = *(const f32x4*)(bg), g1 = *(const f32x4*)(bg + 4), l0 = *(const f32x4*)(bg + 1024) + 1.f, l1 = *(const f32x4*)(bg + 1028) + 1.f;
#pragma unroll
        for (int ai = 0; ai < 2; ++ai)
#pragma unroll
            for (int m = 0; m < 4; ++m) {
                f32x4 r0, r1;
#pragma unroll
                for (int hp = 0; hp < 2; ++hp) {
                    const f32x2 ga0 = (f32x2){acc[ai][0][m][0][2 * hp], acc[ai][0][m][0][2 * hp + 1]} * WSC + (f32x2){g0[2 * hp], g0[2 * hp + 1]};
                    const f32x2 ga1 = (f32x2){acc[ai][0][m][1][2 * hp], acc[ai][0][m][1][2 * hp + 1]} * WSC + (f32x2){g1[2 * hp], g1[2 * hp + 1]};
                    const f32x2 lb0 = (f32x2){acc[ai][1][m][0][2 * hp], acc[ai][1][m][0][2 * hp + 1]} * WSC + (f32x2){l0[2 * hp], l0[2 * hp + 1]};
                    const f32x2 lb1 = (f32x2){acc[ai][1][m][1][2 * hp], acc[ai][1][m][1][2 * hp + 1]} * WSC + (f32x2){l1[2 * hp], l1[2 * hp + 1]};
                    f32x2 gg0, gg1, ll0, ll1, e0, e1;
                    gg0[0] = fminf(ga0[0], 7.f); gg0[1] = fminf(ga0[1], 7.f); gg1[0] = fminf(ga1[0], 7.f); gg1[1] = fminf(ga1[1], 7.f);
                    ll0[0] = __builtin_amdgcn_fmed3f(lb0[0], -6.f, 8.f); ll0[1] = __builtin_amdgcn_fmed3f(lb0[1], -6.f, 8.f); ll1[0] = __builtin_amdgcn_fmed3f(lb1[0], -6.f, 8.f); ll1[1] = __builtin_amdgcn_fmed3f(lb1[1], -6.f, 8.f);
                    const f32x2 x0 = gg0 * -2.45546696f, x1 = gg1 * -2.45546696f;
                    e0[0] = __builtin_amdgcn_exp2f(x0[0]); e0[1] = __builtin_amdgcn_exp2f(x0[1]); e1[0] = __builtin_amdgcn_exp2f(x1[0]); e1[1] = __builtin_amdgcn_exp2f(x1[1]);
                    const f32x2 d0 = e0 + 1.f, d1 = e1 + 1.f;
                    f32x2 q0, q1; q0[0] = __builtin_amdgcn_rcpf(d0[0]); q0[1] = __builtin_amdgcn_rcpf(d0[1]); q1[0] = __builtin_amdgcn_rcpf(d1[0]); q1[1] = __builtin_amdgcn_rcpf(d1[1]);
                    const f32x2 o0 = (ll0 * gg0) * q0, o1 = (ll1 * gg1) * q1;
                    r0[2 * hp] = o0[0]; r0[2 * hp + 1] = o0[1]; r1[2 * hp] = o1[0]; r1[2 * hp + 1] = o1[1];
                }
                u32x2 w; w.x = (unsigned)__builtin_amdgcn_cvt_pk_fp8_f32(r0[2], r0[3], __builtin_amdgcn_cvt_pk_fp8_f32(r0[0], r0[1], 0, false), true);
                w.y = (unsigned)__builtin_amdgcn_cvt_pk_fp8_f32(r1[2], r1[3], __builtin_amdgcn_cvt_pk_fp8_f32(r1[0], r1[1], 0, false), true);
                *(u32x2*)(O + (size_t)(row0 + ai * 128 + m * 16) * DFF + col0) = w; }
    }
};

struct PolDN {
    static constexpr bool PERM = true, META = true, FP8 = true; static constexpr int SCALE_W = 0; static constexpr float WSC = 1.f / 64.f;
    const unsigned char* A; const unsigned char* Bt; const float* bias; const int* list; const float* listg; bf16_t* O; ExpTab tb; int G, c;
    __device__ __forceinline__ bool next(int i, pg8::Unit& u) const {
#ifdef PROBE_KLOOP2
        const int L = (i >> 1) * G + c; if (L >= tb.T * 4) return false;
#else
        const int L = i * G + c; if (L >= tb.T * 4) return false;
#endif
        u.ti = L >> 2; u.pn = L & 3; u.e = rfl(tb.tile_e[u.ti]); u.pm = u.ti - rfl(tb.tstart[u.e]);
        const int rem = rfl(tb.cnt[u.e]) - u.pm * 256; u.nvalid = rem < 256 ? rem : 256; return true;
    }
    __device__ __forceinline__ const char* b_ptr(const pg8::Unit& u) const { return (const char*)Bt + ((size_t)u.e * 1024 + (size_t)u.pn * 256) * 1024; }
    __device__ __forceinline__ void meta_issue(const pg8::Unit& u, int slot, LAS unsigned char* lds, int wid, int lane) const {
        if (wid < 4) __builtin_amdgcn_global_load_lds((const unsigned*)(list + (size_t)u.e * LCAP + u.pm * 256 + wid * 64 + lane), (LAS unsigned*)(lds + L_IDX + slot * 2048 + wid * 256), 4, 0, 0);
        else __builtin_amdgcn_global_load_lds((const unsigned*)(listg + (size_t)u.e * LCAP + u.pm * 256 + (wid - 4) * 64 + lane), (LAS unsigned*)(lds + L_IDX + slot * 2048 + 1024 + (wid - 4) * 256), 4, 0, 0);
    }
    __device__ __forceinline__ void a_off(const pg8::Unit& u, int, LAS unsigned char*, unsigned (&o)[2][2]) const {
        int Ra[2], Ca[2]; pg8::stage_rc((int)threadIdx.x * 16, Ra[0], Ca[0]); pg8::stage_rc((int)threadIdx.x * 16 + 8192, Ra[1], Ca[1]);
#pragma unroll
        for (int h = 0; h < 2; ++h)
#pragma unroll
            for (int i = 0; i < 2; ++i) o[h][i] = (unsigned)((u.ti * 256 + 128 * h + Ra[i]) * 1024 + Ca[i] * 2);
    }
    __device__ __forceinline__ void epi(const AccT& acc, const pg8::Unit& u, int slot, LAS unsigned char* lds, int wr, int wc, int fr, int fq) const {
        const LAS int* idx = (const LAS int*)(lds + L_IDX + slot * 2048);
        const int col0 = u.pn * 256 + wc * 32 + 8 * fq;
        const float* bd = bias + (size_t)u.e * 1024 + col0;
        f32x4 bv[2][2];
#pragma unroll
        for (int bj = 0; bj < 2; ++bj)
#pragma unroll
            for (int n = 0; n < 2; ++n) bv[bj][n] = *(const f32x4*)(bd + bj * 128 + 4 * n);
#pragma unroll
        for (int ai = 0; ai < 2; ++ai)
#pragma unroll
            for (int m = 0; m < 4; ++m) { const int r = ai * 128 + wr * 64 + m * 16 + fr;
                if (r < u.nvalid) { const int pr = idx[r]; const float gt = ((const LAS float*)idx)[256 + r]; bf16_t* rowp = O + (size_t)pr * D + col0;
#pragma unroll
                    for (int bj = 0; bj < 2; ++bj) { const f32x4 v0 = (acc[ai][bj][m][0] * WSC + bv[bj][0]) * gt, v1 = (acc[ai][bj][m][1] * WSC + bv[bj][1]) * gt;
                        u32x4 w; w.x = cvt_pk_bf16(v0[0], v0[1]); w.y = cvt_pk_bf16(v0[2], v0[3]); w.z = cvt_pk_bf16(v1[0], v1[1]); w.w = cvt_pk_bf16(v1[2], v1[3]);
                        *(u32x4*)(rowp + bj * 128) = w; } } }
    }
};

__device__ __forceinline__ void p_ada(Frame& F) {
    LAS float* sl = (LAS float*)F.lds;
    LAS float* red = sl + 3072;
    for (int i = F.tid; i < 3072; i += 512) { const int w = i >> 10, k = i & 1023; const float v = w < 2 ? F.c[w * D + k] : F.c_ctx[k]; sl[i] = v / (1.f + __expf(-v)); }
    __syncthreads();
    for (int slab = blockIdx.x; slab < 256; slab += F.G) {
        const int j0 = slab * 24, cg = F.tid % 6, kr = F.tid / 6;
        float a[3][4] = {};
        if (F.tid < 480) {
            for (int k = kr; k < D; k += 80) {
                const f32x4 w4 = *(const f32x4*)(F.ada_w + (size_t)k * 6144 + j0 + 4 * cg);
                const float s0 = sl[k], s1 = sl[1024 + k], s2 = sl[2048 + k];
#pragma unroll
                for (int q = 0; q < 4; ++q) { a[0][q] += s0 * w4[q]; a[1][q] += s1 * w4[q]; a[2][q] += s2 * w4[q]; }
            }
#pragma unroll
            for (int w = 0; w < 3; ++w)
#pragma unroll
                for (int q = 0; q < 4; ++q) red[kr * 72 + cg * 12 + w * 4 + q] = a[w][q];
        }
        __syncthreads();
        if (F.tid < 72) {
            float s = 0.f;
            for (int r = 0; r < 80; ++r) s += red[r * 72 + F.tid];
            const int g = F.tid / 12, w = (F.tid % 12) >> 2, q = F.tid & 3, col = j0 + 4 * g + q;
            F.mod[w * 6144 + col] = s + F.ada_b[col];
        }
        __syncthreads();
    }
}

__device__ __forceinline__ void transpose_item(const float* W, int K, int N, bf16_t* WT, int item, bool gu_map, LAS float* scr, int lane) {
    const int nblk = N / 32, kb = item / nblk, nb = item % nblk, k0 = 64 * kb, n0 = 32 * nb;
#pragma unroll 8
    for (int i = 0; i < 32; ++i) { const int kk = 2 * i + (lane >> 5); scr[kk * 33 + (lane & 31)] = W[(size_t)(k0 + kk) * N + n0 + (lane & 31)]; }
    LDS_WAIT(); asm volatile("" ::: "memory");
    int d0 = n0;
    if (gu_map) { const int nn = n0 & 1023; d0 = (nn >> 7) * 256 + (nn & 127) + ((n0 >> 10) ? 128 : 0); }
    const int c = lane & 7;
#pragma unroll
    for (int j = 0; j < 4; ++j) { const int n = (lane >> 3) + 8 * j; const LAS float* s = scr + (8 * c) * 33 + n;
        u32x4 o; o.x = pk2(s[0 * 33], s[1 * 33]); o.y = pk2(s[2 * 33], s[3 * 33]); o.z = pk2(s[4 * 33], s[5 * 33]); o.w = pk2(s[6 * 33], s[7 * 33]);
        *(u32x4*)(WT + (size_t)(d0 + n) * K + k0 + 8 * c) = o; }
    LDS_WAIT(); asm volatile("" ::: "memory");
}
__device__ __forceinline__ unsigned pk4_fp8(float a, float b, float c, float d) { return (unsigned)__builtin_amdgcn_cvt_pk_fp8_f32(c, d, __builtin_amdgcn_cvt_pk_fp8_f32(a, b, 0, false), true); }
__device__ __forceinline__ void transpose_item8(const float* W, int K, int N, unsigned char* WT, int item, bool gu_map, LAS float* scr, int lane) {
    const int nblk = N / 32, kb = item / nblk, nb = item % nblk, k0 = 64 * kb, n0 = 32 * nb;
#pragma unroll 8
    for (int i = 0; i < 32; ++i) { const int kk = 2 * i + (lane >> 5); scr[kk * 33 + (lane & 31)] = W[(size_t)(k0 + kk) * N + n0 + (lane & 31)]; }
    LDS_WAIT(); asm volatile("" ::: "memory");
    int d0 = n0;
    if (gu_map) { const int nn = n0 & 1023; d0 = (nn >> 7) * 256 + (nn & 127) + ((n0 >> 10) ? 128 : 0); }
    const int c = lane & 7;
#pragma unroll
    for (int j = 0; j < 4; ++j) { const int n = (lane >> 3) + 8 * j; const LAS float* s = scr + (8 * c) * 33 + n;
        u32x2 o; o.x = pk4_fp8(s[0 * 33] * 64.f, s[1 * 33] * 64.f, s[2 * 33] * 64.f, s[3 * 33] * 64.f); o.y = pk4_fp8(s[4 * 33] * 64.f, s[5 * 33] * 64.f, s[6 * 33] * 64.f, s[7 * 33] * 64.f);
        *(u32x2*)(WT + (size_t)(d0 + n) * K + k0 + 8 * c) = o; }
    LDS_WAIT(); asm volatile("" ::: "memory");
}
__device__ __forceinline__ void p_weights(Frame& F, int it_lo, int n_items, int gw, int NGW, bool with_sgu) {
    LAS float* scr = (LAS float*)(F.lds + F.wave * 16384);
    constexpr int I_IN = 16 * 80, I_OUT = 16 * 32, I_GU = 16 * 64, I_DN = 16 * 32;
    constexpr int NITEMS = I_IN + I_OUT + NE * I_GU + NE * I_DN;
    for (int it0 = gw; it0 < n_items; it0 += NGW) {
        const int it = it_lo + it0; int r = it;
        if (r < I_IN) { transpose_item(F.w_in, D, DIN, F.Wt_in, r, false, scr, F.lane); continue; } r -= I_IN;
        if (r < I_OUT) { transpose_item(F.w_out, D, D, F.Wt_out, r, false, scr, F.lane); continue; } r -= I_OUT;
        if (r < NE * I_GU) { const int e = r / I_GU; transpose_item8(F.w_gu + (size_t)e * D * 2048, D, 2048, F.Wt_gu + (size_t)e * 2048 * D, r % I_GU, true, scr, F.lane); continue; } r -= NE * I_GU;
        { const int e = r / I_DN; transpose_item8(F.w_dn + (size_t)e * DFF * D, DFF, D, F.Wt_dn + (size_t)e * D * DFF, r % I_DN, false, scr, F.lane); }
    }
    if (with_sgu) for (int i = (blockIdx.x * 512 + F.tid) * 4; i < 4 * 128 * 128; i += F.G * 512 * 4) {
        const f32x4 v = *(const f32x4*)(F.sgu_w + i); u32x2 o; o.x = pk2(v[0], v[1]); o.y = pk2(v[2], v[3]); *(u32x2*)(F.sguw + i) = o; }
}
__device__ __forceinline__ void p_lnmod(Frame& F) {
    const int gw = F.vcu * 8 + F.wave, NGW = F.G * 8;
    for (int row = gw; row < MX; row += NGW) {
        const float* xr; const float* md;
        if (row < M) { xr = F.x + (size_t)row * D; md = F.mod + (row >> 13) * 6144; } else { xr = F.ctx + (size_t)(row - M) * D; md = F.mod + 2 * 6144; }
        const f32x4* xp = (const f32x4*)xr + F.lane;
        f32x4 v[4]; float s = 0.f;
#pragma unroll
        for (int j = 0; j < 4; ++j) { v[j] = xp[64 * j]; s += (v[j][0] + v[j][1]) + (v[j][2] + v[j][3]); }
        const float mean = wsum(s) * (1.f / D); float q = 0.f;
#pragma unroll
        for (int j = 0; j < 4; ++j) { v[j] = v[j] - mean; q += (v[j][0] * v[j][0] + v[j][1] * v[j][1]) + (v[j][2] * v[j][2] + v[j][3] * v[j][3]); }
        const float rstd = rsqrtf(wsum(q) * (1.f / D) + EPS);
        u32x2* op = (u32x2*)(F.hxc + (size_t)row * D) + F.lane;
#pragma unroll
        for (int j = 0; j < 4; ++j) { const f32x4 sh = *((const f32x4*)md + F.lane + 64 * j), sc = *((const f32x4*)(md + 1024) + F.lane + 64 * j);
            const f32x4 o = v[j] * rstd * (sc + 1.f) + sh; u32x2 w; w.x = pk2(o[0], o[1]); w.y = pk2(o[2], o[3]); op[64 * j] = w; }
    }
}

__device__ __forceinline__ void p_attn_simple(Frame& F) {
    LAS float* sq = (LAS float*)(F.lds + F.wave * 4096);
    LAS float* sp = sq + 64;
    const int gw = F.vcu * 8 + F.wave, NGW = F.G * 8;
    for (int gid = gw; gid < M * NH; gid += NGW) {
        const int h = gid & 7, tok = gid >> 3, b = tok >> 13, t = tok & (S - 1), r = t >> 6, c = t & 63;
        const int rs = min(max(r - KH / 2, 0), ROWS - KH), cs = min(max(c - KW / 2, 0), GW - KW);
        sq[F.lane] = bf2f(F.proj[(size_t)tok * DIN + h * 64 + F.lane]);
        LDS_WAIT(); asm volatile("" ::: "memory");
        float sc[6]; float mx = -1e30f;
#pragma unroll
        for (int i = 0; i < 6; ++i) {
            const int kk = F.lane + 64 * i;
            const bf16_t* kp; float bias = 0.f;
            if (kk < 128) { const int ki = kk >> 4, kj = kk & 15;
                kp = F.proj + (size_t)(b * S + (rs + ki) * GW + cs + kj) * DIN + 512 + h * 64;
                bias = F.rpb[(h * 15 + (rs + ki - r + 7)) * 31 + (cs + kj - c + 15)];
            } else kp = F.proj + (size_t)(M + b * CTX + (kk - 128)) * DIN + 512 + h * 64;
            float d = 0.f;
#pragma unroll
            for (int dd = 0; dd < 64; dd += 8) { const u32x4 kv = *(const u32x4*)(kp + dd);
                d += sq[dd] * bflo(kv.x) + sq[dd + 1] * bfhi(kv.x) + sq[dd + 2] * bflo(kv.y) + sq[dd + 3] * bfhi(kv.y) + sq[dd + 4] * bflo(kv.z) + sq[dd + 5] * bfhi(kv.z) + sq[dd + 6] * bflo(kv.w) + sq[dd + 7] * bfhi(kv.w); }
            sc[i] = d * 0.125f + bias; mx = fmaxf(mx, sc[i]);
        }
        mx = wmax(mx);
        float sum = 0.f;
#pragma unroll
        for (int i = 0; i < 6; ++i) { const float p = __expf(sc[i] - mx); sum += p; sp[F.lane + 64 * i] = p; }
        sum = wsum(sum);
        LDS_WAIT(); asm volatile("" ::: "memory");
        float acc = 0.f;
        for (int kk = 0; kk < 384; ++kk) {
            const bf16_t* vp;
            if (kk < 128) { const int ki = kk >> 4, kj = kk & 15; vp = F.proj + (size_t)(b * S + (rs + ki) * GW + cs + kj) * DIN + 1024 + h * 64; }
            else vp = F.proj + (size_t)(M + b * CTX + (kk - 128)) * DIN + 1024 + h * 64;
            acc += sp[kk] * bf2f(vp[F.lane]);
        }
        F.mixin[(size_t)tok * D + h * 64 + F.lane] = (bf16_t)f2bf(acc / sum);
        LDS_WAIT(); asm volatile("" ::: "memory");
    }
}
__device__ __forceinline__ void p_sgu_simple(Frame& F) {
    LAS bf16_t* G = (LAS bf16_t*)F.lds;
    for (int u = blockIdx.x; u < M / 128; u += F.G) {
        const int base = u * 128;
        for (int tl = F.wave; tl < 128; tl += 8) {
            const bf16_t* zr = F.proj + (size_t)(base + tl) * DIN + 2048 + F.lane * 8;
            const u32x4 zv = *(const u32x4*)zr;
            float v[8] = {bflo(zv.x), bfhi(zv.x), bflo(zv.y), bfhi(zv.y), bflo(zv.z), bfhi(zv.z), bflo(zv.w), bfhi(zv.w)};
            float s = 0.f;
#pragma unroll
            for (int i = 0; i < 8; ++i) s += v[i];
            const float mean = wsum(s) * (1.f / 512.f); float q = 0.f;
#pragma unroll
            for (int i = 0; i < 8; ++i) { v[i] -= mean; q += v[i] * v[i]; }
            const float rstd = rsqrtf(wsum(q) * (1.f / 512.f) + EPS);
#pragma unroll
            for (int i = 0; i < 8; ++i) { const int ch = F.lane * 8 + i; G[tl * 512 + ch] = (bf16_t)f2bf(v[i] * rstd * F.sgu_ln_g[ch] + F.sgu_ln_b[ch]); }
        }
        __syncthreads();
        const int ch = F.tid, grp = ch >> 7;
        for (int i = 0; i < 128; ++i) {
            const float* wrow = F.sgu_w + (size_t)(grp * 128 + i) * 128;
            float acc = 0.f;
            for (int j = 0; j < 128; ++j) acc += wrow[j] * bf2f(G[j * 512 + ch]);
            acc += F.sgu_b[grp * 128 + i];
            const float uu = bf2f(F.proj[(size_t)(base + i) * DIN + 1536 + ch]);
            F.mixin[(size_t)(base + i) * D + 512 + ch] = (bf16_t)f2bf(uu * acc);
        }
        __syncthreads();
    }
}

namespace at {
typedef float f32x16 __attribute__((ext_vector_type(16)));
typedef short s16x4 __attribute__((ext_vector_type(4)));
typedef short v4i16_t __attribute__((ext_vector_type(4)));
constexpr int A_K = 0, A_V = 32768, A_STG = 65536, A_WSF = 98304, A_RPB = 100352;
constexpr float C2 = 0.125f * 1.4426950408889634f, L2E = 1.4426950408889634f;
__device__ __forceinline__ int crow(int r, int hi) { return (r & 3) + 8 * (r >> 2) + 4 * hi; }
__device__ __forceinline__ s16x4 vtr(const LAS unsigned char* p) { return __builtin_bit_cast(s16x4, __builtin_amdgcn_ds_read_tr16_b64_v4i16((LAS v4i16_t*)p)); }
__device__ __forceinline__ int rsf(int r) { return min(max(r - KH / 2, 0), ROWS - KH); }
#define AT_WAIT_BAR() asm volatile("s_waitcnt vmcnt(0) lgkmcnt(0)\n\ts_barrier" ::: "memory")
__device__ __forceinline__ void glds16(const void* gsrc, unsigned lds_dst) { unsigned keep;
    asm volatile("s_mov_b32 %0, m0\n\ts_mov_b32 m0, %2\n\ts_nop 0\n\tglobal_load_lds_dwordx4 %1, off\n\ts_mov_b32 m0, %0" : "=&s"(keep) : "v"(gsrc), "s"(lds_dst) : "memory"); }

template <int MODE> __device__ __forceinline__ constexpr bool act0(int rr) { return MODE != 2 || rr >= 12; }
template <int MODE> __device__ __forceinline__ constexpr bool act1(int rr) { return MODE != 1 || rr < 4; }
template <int MODE>
__device__ __forceinline__ void tile_compute(const LAS unsigned char* kp0, const LAS unsigned char* vp, const LAS float* tb, const bf16x8 (&qr)[4], f32x16 (&o)[2], float& m, float& l,
                                             LAS float* wsf, int r32, int hi, int cs) {
    f32x16 p0, p1;
#pragma unroll
    for (int i = 0; i < 16; ++i) { p0[i] = 0.f; p1[i] = 0.f; }
#pragma unroll
    for (int d0 = 0; d0 < 4; ++d0) {
        const bf16x8 b0 = *(const LAS bf16x8*)(kp0 + d0 * 2048), b1 = *(const LAS bf16x8*)(kp0 + d0 * 2048 + 512);
        p0 = __builtin_amdgcn_mfma_f32_32x32x16_bf16(b0, qr[d0], p0, 0, 0, 0);
        p1 = __builtin_amdgcn_mfma_f32_32x32x16_bf16(b1, qr[d0], p1, 0, 0, 0);
    }
    float tm = -INFINITY;
#pragma unroll
    for (int rr = 0; rr < 16; ++rr) { const int ko = (rr & 3) + 8 * (rr >> 2), kc = ko + 4 * hi;
        if (MODE == 0) { p0[rr] *= C2; p1[rr] *= C2; tm = fmaxf(tm, fmaxf(p0[rr], p1[rr])); }
        else {
            if (act0<MODE>(rr)) { const float t0 = p0[rr] * C2 + tb[ko]; p0[rr] = (unsigned)(kc - cs) < (unsigned)KW ? t0 : -INFINITY; tm = fmaxf(tm, p0[rr]); }
            if (act1<MODE>(rr)) { const float t1 = p1[rr] * C2 + tb[ko + 32]; p1[rr] = (unsigned)(kc + 32 - cs) < (unsigned)KW ? t1 : -INFINITY; tm = fmaxf(tm, p1[rr]); }
        } }
    { float a = tm, bq = tm; asm volatile("s_nop 1\n\tv_permlane32_swap_b32 %0, %1" : "+v"(a), "+v"(bq)); tm = fmaxf(a, bq); }
    const float mn = fmaxf(m, tm), alpha = __builtin_amdgcn_exp2f(m - mn);
    float rsum = 0.f;
#pragma unroll
    for (int rr = 0; rr < 16; ++rr) {
        if (act0<MODE>(rr)) { p0[rr] = __builtin_amdgcn_exp2f(p0[rr] - mn); rsum += p0[rr]; } else p0[rr] = 0.f;
        if (act1<MODE>(rr)) { p1[rr] = __builtin_amdgcn_exp2f(p1[rr] - mn); rsum += p1[rr]; } else p1[rr] = 0.f; }
    l = l * alpha + rsum; m = mn;
    if (__any(alpha != 1.f)) {
        if (hi == 0) wsf[r32] = alpha;
        LDS_WAIT();
#pragma unroll
        for (int rr = 0; rr < 16; ++rr) { const float a = wsf[crow(rr, hi)]; o[0][rr] *= a; o[1][rr] *= a; }
        LDS_WAIT();
    }
    u32x4 pw[4];
#pragma unroll
    for (int q = 0; q < 4; ++q) { pw[0][q] = cvt_pk_bf16(p0[2 * q], p0[2 * q + 1]); pw[1][q] = cvt_pk_bf16(p0[8 + 2 * q], p0[9 + 2 * q]);
                                  pw[2][q] = cvt_pk_bf16(p1[2 * q], p1[2 * q + 1]); pw[3][q] = cvt_pk_bf16(p1[8 + 2 * q], p1[9 + 2 * q]); }
#pragma unroll
    for (int d0 = 0; d0 < 2; ++d0)
#pragma unroll
        for (int ks = 0; ks < 4; ++ks) {
            if ((MODE == 1 && ks == 3) || (MODE == 2 && ks == 0)) continue;
            const s16x4 lo = vtr(vp + d0 * 4096 + ks * 1024), hh = vtr(vp + d0 * 4096 + ks * 1024 + 512);
            const bf16x8 vf = (bf16x8){lo[0], lo[1], lo[2], lo[3], hh[0], hh[1], hh[2], hh[3]};
            o[d0] = __builtin_amdgcn_mfma_f32_32x32x16_bf16(__builtin_bit_cast(bf16x8, pw[ks]), vf, o[d0], 0, 0, 0);
        }
}

__device__ __forceinline__ void attn_unit(Frame& F, int b, int h, int rg) {
    const int lane = F.lane, r32 = lane & 31, hi = lane >> 5, w = F.wave;
    const int r0 = 4 * rg, r = r0 + (w >> 1), c = 32 * (w & 1) + r32;
    const int krlo = rsf(r0), nnb = rsf(r0 + 3) + 7 - krlo + 1, nst = nnb + 4;
    const int rsw = rsf(r), cs = min(max(c - KW / 2, 0), GW - KW);
    LAS float* tbl = (LAS float*)(F.lds + A_RPB);
    LAS float* wsf = (LAS float*)(F.lds + A_WSF) + w * 64;
    for (int i = F.tid; i < 480; i += 512) { const int dr = i >> 5, dc = i & 31; tbl[64 + i] = dc < 31 ? F.rpb[(h * 15 + dr) * 31 + dc] * L2E : 0.f; }
    const bf16_t* qp = F.proj + (size_t)(b * S + r * GW + c) * DIN + h * 64 + hi * 8;
    bf16x8 qr[4];
#pragma unroll
    for (int d0 = 0; d0 < 4; ++d0) qr[d0] = *(const bf16x8*)(qp + d0 * 16);
    const bf16_t* kbase = F.proj + 512 + h * 64 + w * 8;
    const bf16_t* vbase = F.proj + 1024 + h * 64 + (w >> 2) * 32 + (lane & 3) * 8;
#define AT_DMA(st) do { const int _t0 = (st) < nnb ? b * S + (krlo + (st)) * GW : M + b * CTX + ((st) - nnb) * 64; const int _bf = ((st) & 3) * 8192; \
        __builtin_amdgcn_global_load_lds((const unsigned*)(kbase + (size_t)(_t0 + lane) * DIN), (LAS unsigned*)(F.lds + A_K + _bf + w * 1024), 16, 0, 0); \
        __builtin_amdgcn_global_load_lds((const unsigned*)(vbase + (size_t)(_t0 + 16 * (w & 3) + (lane >> 2)) * DIN), (LAS unsigned*)(F.lds + A_V + _bf + w * 1024), 16, 0, 0); } while (0)
    const unsigned lds0 = (unsigned)(size_t)F.lds;
    float m = -1e30f, l = 0.f;
    f32x16 o[2];
#pragma unroll
    for (int i = 0; i < 16; ++i) { o[0][i] = 0.f; o[1][i] = 0.f; }
    AT_DMA(0); AT_DMA(1); AT_DMA(2);
    for (int st = 0; st < nst; ++st) {
        if (st + 2 < nst) asm volatile("s_waitcnt vmcnt(4) lgkmcnt(0)\n\ts_barrier" ::: "memory");
        else if (st + 1 < nst) asm volatile("s_waitcnt vmcnt(2) lgkmcnt(0)\n\ts_barrier" ::: "memory");
        else AT_WAIT_BAR();
        if (st + 3 < nst) AT_DMA(st + 3);
        const bool isnb = st < nnb; const int kr = krlo + st;
        const bool act = !isnb || (kr >= rsw && kr < rsw + KH);
        if (act) {
            const LAS unsigned char* kp0 = F.lds + A_K + (st & 3) * 8192 + hi * 1024 + r32 * 16;
            const LAS unsigned char* vp = F.lds + A_V + (st & 3) * 8192 + ((lane >> 4) & 1) * 32 + (lane & 3) * 8 + (4 * hi + ((lane & 15) >> 2)) * 64;
            const LAS float* tb = tbl + 64 + (kr - r + 7) * 32 + 4 * hi - c + 15;
            if (!isnb) tile_compute<0>(kp0, vp, tb, qr, o, m, l, wsf, r32, hi, cs);
            else if ((w & 1) == 0) tile_compute<1>(kp0, vp, tb, qr, o, m, l, wsf, r32, hi, cs);
            else tile_compute<2>(kp0, vp, tb, qr, o, m, l, wsf, r32, hi, cs);
        }
    }
#undef AT_DMA
    l += __shfl_xor(l, 32);
    if (hi == 0) wsf[32 + r32] = l;
    LDS_WAIT();
    LAS bf16_t* stg = (LAS bf16_t*)(F.lds + A_STG) + w * 2048;
#pragma unroll
    for (int rr = 0; rr < 16; ++rr) { const int orow = crow(rr, hi); const float rl = __builtin_amdgcn_rcpf(wsf[32 + orow]);
        stg[orow * 64 + r32] = (bf16_t)f2bf(o[0][rr] * rl); stg[orow * 64 + 32 + r32] = (bf16_t)f2bf(o[1][rr] * rl); }
    LDS_WAIT();
    bf16_t* ow = F.mixin + (size_t)(b * S + r * GW + 32 * (w & 1)) * D + h * 64;
#pragma unroll
    for (int i = 0; i < 4; ++i) { const int row = i * 8 + (lane >> 3), ch = lane & 7; const u32x4 v = *(const LAS u32x4*)(stg + row * 64 + ch * 8); *(u32x4*)(ow + (size_t)row * D + ch * 8) = v; }
    AT_WAIT_BAR();
}

constexpr int G_IMG = 0, G_STG = 65536, G_STAT = 98304;
__device__ __forceinline__ void sgu_unit(Frame& F, int chunk, int gh) {
    const int lane = F.lane, r32 = lane & 31, hi = lane >> 5, w = F.wave;
    const int base = chunk * 128;
    LAS f32x2* stat = (LAS f32x2*)(F.lds + G_STAT);
    u32x4 zrow[16];
#pragma unroll
    for (int t = 0; t < 16; ++t) zrow[t] = *(const u32x4*)(F.proj + (size_t)(base + 16 * w + t) * DIN + 2048 + lane * 8);
    const int cb = w & 3, th = w >> 2, grp = 2 * gh + (cb >> 1);
    const bf16_t* wp = F.sguw + (size_t)(grp * 128 + 64 * th + r32) * 128 + 8 * hi;
    bf16x8 wf0[8], wf1[8];
#pragma unroll
    for (int ks = 0; ks < 8; ++ks) { wf0[ks] = *(const bf16x8*)(wp + ks * 16); wf1[ks] = *(const bf16x8*)(wp + 32 * 128 + ks * 16); }
#pragma unroll
    for (int t = 0; t < 16; ++t) {
        const int tok = 16 * w + t;
        const u32x4 zv = zrow[t];
        float v[8] = {bflo(zv.x), bfhi(zv.x), bflo(zv.y), bfhi(zv.y), bflo(zv.z), bfhi(zv.z), bflo(zv.w), bfhi(zv.w)};
        float s = 0.f;
#pragma unroll
        for (int i = 0; i < 8; ++i) s += v[i];
        const float mean = wsum(s) * (1.f / 512.f); float q = 0.f;
#pragma unroll
        for (int i = 0; i < 8; ++i) { const float d = v[i] - mean; q += d * d; }
        const float rstd = rsqrtf(wsum(q) * (1.f / 512.f) + EPS);
        if (lane == 0) stat[tok] = (f32x2){mean, rstd};
    }
    AT_WAIT_BAR();
    {
        const int ch0 = 256 * gh + 32 * w + 8 * (lane & 3);
        const f32x4 g0 = *(const f32x4*)(F.sgu_ln_g + ch0), g1 = *(const f32x4*)(F.sgu_ln_g + ch0 + 4), b0 = *(const f32x4*)(F.sgu_ln_b + ch0), b1 = *(const f32x4*)(F.sgu_ln_b + ch0 + 4);
#pragma unroll
        for (int i = 0; i < 8; ++i) {
            const int tok = 16 * i + (lane >> 2);
            const u32x4 zv = *(const u32x4*)(F.proj + (size_t)(base + tok) * DIN + 2048 + ch0);
            const f32x2 st = stat[tok];
            u32x4 o;
            o.x = pk2((bflo(zv.x) - st[0]) * st[1] * g0[0] + b0[0], (bfhi(zv.x) - st[0]) * st[1] * g0[1] + b0[1]);
            o.y = pk2((bflo(zv.y) - st[0]) * st[1] * g0[2] + b0[2], (bfhi(zv.y) - st[0]) * st[1] * g0[3] + b0[3]);
            o.z = pk2((bflo(zv.z) - st[0]) * st[1] * g1[0] + b1[0], (bfhi(zv.z) - st[0]) * st[1] * g1[1] + b1[1]);
            o.w = pk2((bflo(zv.w) - st[0]) * st[1] * g1[2] + b1[2], (bfhi(zv.w) - st[0]) * st[1] * g1[3] + b1[3]);
            *(LAS u32x4*)(F.lds + G_IMG + w * 8192 + i * 1024 + lane * 16) = o;
        }
    }
    AT_WAIT_BAR();
    f32x16 acc[2][2];
#pragma unroll
    for (int a = 0; a < 2; ++a)
#pragma unroll
        for (int q = 0; q < 2; ++q)
#pragma unroll
            for (int i = 0; i < 16; ++i) acc[a][q][i] = 0.f;
    const LAS unsigned char* gp = F.lds + G_IMG + (2 * cb) * 8192 + ((lane >> 4) & 1) * 32 + (lane & 3) * 8 + (8 * hi + ((lane & 15) >> 2)) * 64;
#pragma unroll
    for (int ks = 0; ks < 8; ++ks) {
        const bf16x8 w0 = wf0[ks], w1 = wf1[ks];
#pragma unroll
        for (int c32 = 0; c32 < 2; ++c32) {
            const s16x4 lo = vtr(gp + c32 * 8192 + ks * 1024), hh = vtr(gp + c32 * 8192 + ks * 1024 + 256);
            const bf16x8 gf = (bf16x8){lo[0], lo[1], lo[2], lo[3], hh[0], hh[1], hh[2], hh[3]};
            acc[0][c32] = __builtin_amdgcn_mfma_f32_32x32x16_bf16(gf, w0, acc[0][c32], 0, 0, 0);
            acc[1][c32] = __builtin_amdgcn_mfma_f32_32x32x16_bf16(gf, w1, acc[1][c32], 0, 0, 0);
        }
    }
    LAS unsigned char* stg = F.lds + G_STG + w * 4096;
#pragma unroll
    for (int ib = 0; ib < 2; ++ib) {
        const int i0 = 64 * th + 32 * ib;
        const float bi = F.sgu_b[grp * 128 + i0 + r32];
#pragma unroll
        for (int c32 = 0; c32 < 2; ++c32)
#pragma unroll
            for (int a = 0; a < 4; ++a) { u32x2 o; o.x = pk2(acc[ib][c32][4 * a] + bi, acc[ib][c32][4 * a + 1] + bi); o.y = pk2(acc[ib][c32][4 * a + 2] + bi, acc[ib][c32][4 * a + 3] + bi);
                *(LAS u32x2*)(stg + r32 * 128 + (((4 * c32 + a) ^ (r32 & 7)) << 4) + hi * 8) = o; }
        LDS_WAIT();
#pragma unroll
        for (int it = 0; it < 4; ++it) {
            const int row = 8 * it + (lane >> 3), chn = lane & 7;
            const u32x4 v = *(const LAS u32x4*)(stg + row * 128 + ((chn ^ (row & 7)) << 4));
            const size_t tok = (size_t)(base + i0 + row);
            const u32x4 uv = *(const u32x4*)(F.proj + tok * DIN + 1536 + 256 * gh + 64 * cb + 8 * chn);
            u32x4 o;
            o.x = pk2(bflo(v.x) * bflo(uv.x), bfhi(v.x) * bfhi(uv.x)); o.y = pk2(bflo(v.y) * bflo(uv.y), bfhi(v.y) * bfhi(uv.y));
            o.z = pk2(bflo(v.z) * bflo(uv.z), bfhi(v.z) * bfhi(uv.z)); o.w = pk2(bflo(v.w) * bflo(uv.w), bfhi(v.w) * bfhi(uv.w));
            *(u32x4*)(F.mixin + tok * D + 512 + 256 * gh + 64 * cb + 8 * chn) = o;
        }
        LDS_WAIT();
    }
    AT_WAIT_BAR();
}
__device__ __forceinline__ void p_mixer(Frame& F) {
#ifndef PROBE_MIX_A
#define PROBE_MIX_A 1
#endif
#ifndef PROBE_MIX_S
#define PROBE_MIX_S 1
#endif
#pragma unroll 1
    for (int rep = 0; rep < PROBE_MIX_A; ++rep)
    for (int uid = F.vcu; uid < NB * NH * 32; uid += F.G) attn_unit(F, uid >> 8, (uid >> 5) & 7, uid & 31);
#pragma unroll 1
    for (int rep = 0; rep < PROBE_MIX_S; ++rep)
    for (int uid = F.vcu; uid < (M / 128) * 2; uid += F.G) sgu_unit(F, uid >> 1, uid & 1);
}
#undef AT_WAIT_BAR
}

__device__ __forceinline__ void p_route(Frame& F) {
    LAS int* lcnt = (LAS int*)(F.lds + L_ROUTE); LAS int* gbase = lcnt + 32; LAS int* sel = lcnt + 64; LAS float* selg = (LAS float*)(F.lds + L_RPB);
    for (int i = F.tid; i < 8192; i += 512) { const int c = i >> 3, q = i & 7; *(LAS f32x4*)(F.lds + c * 128 + ((q ^ ((c >> 1) & 7)) << 4)) = *(const f32x4*)(F.router_w + c * 32 + q * 4); }
    if (F.tid < 32) lcnt[F.tid] = 0;
    __syncthreads();
    const int lane = F.lane;
    const LAS unsigned char* wbase = F.lds + lane * 128;
    const int sw = (lane >> 1) & 7;
    LAS unsigned char* hrow = F.lds + L_WSCR + F.wave * 1024;
    for (int tb = blockIdx.x; tb < M / 64; tb += F.G) {
        const int b = (tb * 64) >> 13;
        float pg[16], pb[16], ps[16], ph[16];
#pragma unroll
        for (int i = 0; i < 16; ++i) { const int col = lane + 64 * i; pg[i] = F.ln1_g[col]; pb[i] = F.ln1_b[col]; ps[i] = 1.f + F.mod[b * 6144 + 4 * 1024 + col]; ph[i] = F.mod[b * 6144 + 3 * 1024 + col]; }
        float vn[16];
        { const float* yr = F.y1 + (size_t)(tb * 64 + F.wave) * D;
#pragma unroll
          for (int i = 0; i < 16; ++i) vn[i] = yr[lane + 64 * i]; }
        for (int tl = F.wave; tl < 64; tl += 8) {
            const int tok = tb * 64 + tl;
            float v[16]; float s = 0.f;
#pragma unroll
            for (int i = 0; i < 16; ++i) { v[i] = vn[i]; s += v[i]; }
            if (tl + 8 < 64) { const float* yr = F.y1 + (size_t)(tok + 8) * D;
#pragma unroll
                for (int i = 0; i < 16; ++i) vn[i] = yr[lane + 64 * i]; }
            float mean = wsum(s) * (1.f / D), q = 0.f;
#pragma unroll
            for (int i = 0; i < 16; ++i) { v[i] -= mean; q += v[i] * v[i]; }
            float rstd = rsqrtf(wsum(q) * (1.f / D) + EPS);
            s = 0.f;
#pragma unroll
            for (int i = 0; i < 16; ++i) { v[i] = v[i] * rstd * pg[i] + pb[i]; s += v[i]; }
            if (lane == 0) F.stat[tok] = (f32x2){mean, rstd};
#ifdef MK_WRITE_X1
#pragma unroll
            for (int i = 0; i < 16; ++i) F.x1[(size_t)tok * D + lane + 64 * i] = v[i];
#endif
            mean = wsum(s) * (1.f / D); q = 0.f;
#pragma unroll
            for (int i = 0; i < 16; ++i) { v[i] -= mean; q += v[i] * v[i]; }
            rstd = rsqrtf(wsum(q) * (1.f / D) + EPS);
#pragma unroll
            for (int i = 0; i < 16; ++i) { v[i] = v[i] * rstd * ps[i] + ph[i]; hrow[lane + 64 * i] = (unsigned char)__builtin_amdgcn_cvt_pk_fp8_f32(v[i], v[i], 0, false); }
            f32x2 lg2[NE / 2];
#pragma unroll
            for (int e = 0; e < NE / 2; ++e) lg2[e] = (f32x2){0.f, 0.f};
            f32x4 wa[8];
#define RT_RD(dst, i) do { _Pragma("unroll") for (int qq = 0; qq < 8; ++qq) dst[qq] = *(const LAS f32x4*)(wbase + (i) * 8192 + ((qq ^ sw) << 4)); } while (0)
#define RT_FMA(src, i) do { const f32x2 hv = (f32x2){v[i], v[i]}; _Pragma("unroll") for (int qq = 0; qq < 8; ++qq) { \
                lg2[2 * qq] = __builtin_elementwise_fma(hv, (f32x2){src[qq][0], src[qq][1]}, lg2[2 * qq]); lg2[2 * qq + 1] = __builtin_elementwise_fma(hv, (f32x2){src[qq][2], src[qq][3]}, lg2[2 * qq + 1]); } } while (0)
#pragma unroll
            for (int i = 0; i < 16; ++i) {
                RT_RD(wa, i); __builtin_amdgcn_sched_barrier(0);
                RT_FMA(wa, i); __builtin_amdgcn_sched_barrier(0);
            }
#undef RT_RD
#undef RT_FMA
            float lg[NE];
#pragma unroll
            for (int e = 0; e < NE / 2; ++e) { lg[2 * e] = lg2[e][0]; lg[2 * e + 1] = lg2[e][1]; }
            LDS_WAIT();
            *(u32x4*)(F.h2 + (size_t)tok * D + lane * 16) = *(const LAS u32x4*)(hrow + lane * 16);
            float r16[16], r8[8];
#pragma unroll
            for (int e = 0; e < 16; ++e) { float a = lg[e], bq = lg[e + 16]; asm volatile("s_nop 1\n\tv_permlane32_swap_b32 %0, %1" : "+v"(a), "+v"(bq)); r16[e] = a + bq; }
#pragma unroll
            for (int e = 0; e < 8; ++e) { float a = r16[e], bq = r16[e + 8]; asm volatile("s_nop 1\n\tv_permlane16_swap_b32 %0, %1" : "+v"(a), "+v"(bq)); r8[e] = a + bq; }
            float r1 = 0.f;
#pragma unroll
            for (int e = 0; e < 8; ++e) { float t = r8[e]; t += dppf<0xB1>(t); t += dppf<0x4E>(t); t += dppf<0x141>(t); t += dppf<0x140>(t); r1 = ((lane & 7) == e) ? t : r1; }
            const int e = ((lane >> 5) << 4) | (((lane >> 4) & 1) << 3) | (lane & 7);
            const float lgt = r1 + F.router_b[e];
            int rank = 0; float mx = -3.0e38f;
#pragma unroll
            for (int e2 = 0; e2 < NE; ++e2) { const float o = rlane(lgt, ((e2 >> 4) << 5) | (((e2 >> 3) & 1) << 4) | (e2 & 7));
                rank += (o > lgt || (o == lgt && e2 < e)) ? 1 : 0; mx = fmaxf(mx, o); }
            const bool selq = rank < TOPK && !(lane & 8);
            const float pe = selq ? __expf(lgt - mx) : 0.f;
            const float den = wsum(pe);
            if (selq) {
                const int lp = __hip_atomic_fetch_add(lcnt + e, 1, __ATOMIC_RELAXED, __HIP_MEMORY_SCOPE_WORKGROUP);
                sel[tl * 4 + rank] = e | (lp << 8); selg[tl * 4 + rank] = pe / den;
                F.topg[tok * 4 + rank] = pe / den; F.topi[tok * 4 + rank] = e;
            }
        }
        __syncthreads();
        if (F.tid < 32) { const int n = lcnt[F.tid]; gbase[F.tid] = n ? (int)__hip_atomic_fetch_add(F.cntw + 32 * F.tid, (unsigned)n, __ATOMIC_RELAXED, __HIP_MEMORY_SCOPE_AGENT) : 0; lcnt[F.tid] = 0; }
        __syncthreads();
        if (F.tid < 256) { const int sv = sel[F.tid], e = sv & 255, lp = sv >> 8; F.list[(size_t)e * LCAP + gbase[e] + lp] = (tb * 64 + (F.tid >> 2)) * 4 + (F.tid & 3); F.listg[(size_t)e * LCAP + gbase[e] + lp] = selg[F.tid]; }
        __syncthreads();
    }
}

__device__ __forceinline__ void p_final(Frame& F) {
    const int gw = F.vcu * 8 + F.wave, NGW = F.G * 8;
    for (int tok = gw; tok < M; tok += NGW) {
        const float* g2 = F.mod + (tok >> 13) * 6144 + 5 * 1024;
        const f32x4* xp = (const f32x4*)(F.y1 + (size_t)tok * D) + F.lane;
        const f32x2 st = F.stat[tok];
        f32x4 v[4]; float s = 0.f;
#pragma unroll
        for (int j = 0; j < 4; ++j) {
            f32x4 f = (f32x4){0.f, 0.f, 0.f, 0.f};
#pragma unroll
            for (int k = 0; k < TOPK; ++k) { const u32x2 yv = *((const u32x2*)(F.ybuf + (size_t)(tok * 4 + k) * D) + F.lane + 64 * j);
                f[0] += bflo(yv.x); f[1] += bfhi(yv.x); f[2] += bflo(yv.y); f[3] += bfhi(yv.y); }
            const f32x4 gv = *((const f32x4*)g2 + F.lane + 64 * j);
            const f32x4 l1g = *((const f32x4*)F.ln1_g + F.lane + 64 * j), l1b = *((const f32x4*)F.ln1_b + F.lane + 64 * j);
            const f32x4 x1v = (xp[64 * j] - st[0]) * st[1] * l1g + l1b;
            v[j] = x1v * DN_ALPHA + gv * f; s += (v[j][0] + v[j][1]) + (v[j][2] + v[j][3]);
        }
        const float mean = wsum(s) * (1.f / D); float q = 0.f;
#pragma unroll
        for (int j = 0; j < 4; ++j) { v[j] = v[j] - mean; q += (v[j][0] * v[j][0] + v[j][1] * v[j][1]) + (v[j][2] * v[j][2] + v[j][3] * v[j][3]); }
        const float rstd = rsqrtf(wsum(q) * (1.f / D) + EPS);
        f32x4* op = (f32x4*)(F.out + (size_t)tok * D) + F.lane;
#pragma unroll
        for (int j = 0; j < 4; ++j) { const f32x4 gg = *((const f32x4*)F.ln2_g + F.lane + 64 * j), bb = *((const f32x4*)F.ln2_b + F.lane + 64 * j); op[64 * j] = v[j] * rstd * gg + bb; }
    }
}

struct Args { const float* in[23]; float* out; unsigned char* ws; int ph_lo, ph_hi, alt, pad; };
constexpr int N_PHASES = 9;
__global__ void __launch_bounds__(512, 2) mk_fwd(Args args) {
    extern __shared__ __attribute__((aligned(16))) unsigned char lds_raw[];
    Frame F;
    F.lds = (LAS unsigned char*)lds_raw;
    F.MISC = (volatile LAS unsigned*)(F.lds + L_MISC);
    F.tid = threadIdx.x; F.lane = F.tid & 63; F.wave = __builtin_amdgcn_readfirstlane(F.tid >> 6);
    F.G = gridDim.x; { const int bx = blockIdx.x; F.vcu = (F.G % 8 == 0) ? (bx % 8) * (F.G / 8) + bx / 8 : bx; }
    unsigned char* ws = args.ws;
    F.ctl = (unsigned*)(ws + WS_CTL);
    F.x = args.in[0]; F.c = args.in[1]; F.ctx = args.in[2]; F.c_ctx = args.in[3]; F.ada_w = args.in[4]; F.ada_b = args.in[5]; F.w_in = args.in[6]; F.rpb = args.in[7];
    F.sgu_ln_g = args.in[8]; F.sgu_ln_b = args.in[9]; F.sgu_w = args.in[10]; F.sgu_b = args.in[11]; F.w_out = args.in[12]; F.ln1_g = args.in[13]; F.ln1_b = args.in[14];
    F.ln2_g = args.in[15]; F.ln2_b = args.in[16]; F.router_w = args.in[17]; F.router_b = args.in[18]; F.w_gu = args.in[19]; F.b_gu = args.in[20]; F.w_dn = args.in[21]; F.b_dn = args.in[22];
    F.out = args.out;
    F.mod = (float*)(ws + WS_MOD); F.topg = (float*)(ws + WS_TOPG); F.topi = (int*)(ws + WS_TOPI); F.list = (int*)(ws + WS_LIST); F.listg = (float*)(ws + WS_LISTG); F.sguw = (bf16_t*)(ws + WS_SGUW);
    F.Wt_in = (bf16_t*)(ws + WS_WIN); F.Wt_out = (bf16_t*)(ws + WS_WOUT); F.Wt_gu = ws + WS_WGU; F.Wt_dn = ws + WS_WDN;
    F.hxc = (bf16_t*)(ws + WS_HXC); F.proj = (bf16_t*)(ws + WS_PROJ); F.mixin = (bf16_t*)(ws + WS_MIXIN); F.y1 = (float*)(ws + WS_Y1); F.x1 = (float*)(ws + WS_X1); F.stat = (f32x2*)(ws + WS_STAT); F.cntw = F.ctl + CW_CNT; F.h2 = ws + WS_H2;
    F.act = ws + WS_ACT; F.ybuf = (bf16_t*)(ws + WS_YBUF);
    for (int u = F.tid; u < (LDS_BYTES - L_MISC) / 4; u += 512) ((LAS unsigned*)(F.lds + L_MISC))[u] = 0u;
    __syncthreads();
    if (args.alt) { F.x1 = (float*)(ws + WS_ALT); F.h2 = ws + WS_ALT + 64 * MiB; F.list = (int*)(ws + WS_ALT + 80 * MiB); F.listg = (float*)(ws + WS_ALT + 84 * MiB); F.topg = (float*)(ws + WS_ALT + 82 * MiB); F.topi = (int*)(ws + WS_ALT + 82 * MiB + 512 * 1024); F.cntw = F.ctl + CW_CNT_ALT; F.stat = (f32x2*)(ws + WS_ALT + 83 * MiB); }
    const int lo = args.ph_lo, hi = args.ph_hi;
    const bool one = (hi - lo) > 1;
    XcdBarrier bar; bar.bar = (unsigned*)(F.ctl + CW_BAR); bar.x = 0; bar.st = nullptr;
    if (one) bar = xcd_barrier_post((unsigned*)(F.ctl + CW_BAR), F.MISC + 8);
#define IN(k) (lo <= (k) && (k) < hi)
#define SEAM(k) do { if (IN(k) && IN((k) + 1)) xcd_barrier(bar); } while (0)
#ifndef PROBE_REPS
#define PROBE_REPS {1, 1, 1, 1, 1, 1, 1, 1, 1}
#endif
    constexpr int REPS[N_PHASES] = PROBE_REPS;
#define REPEAT(k) _Pragma("unroll") for (int rep_ = 0; rep_ < REPS[k]; ++rep_)
#define RSEAM(k) do { if (rep_ + 1 < REPS[k]) xcd_barrier(bar); else SEAM(k); } while (0)
    constexpr int W_ITEMS = 16 * 80 + 16 * 32 + NE * 16 * 64 + NE * 16 * 32, W_TAIL = 7680;
    const bool tail_wg = (F.G == 256 && (int)blockIdx.x >= 136);
    if (IN(0)) REPEAT(0) { p_ada(F); p_weights(F, 0, (F.G == 256) ? W_ITEMS - W_TAIL : W_ITEMS, F.vcu * 8 + F.wave, F.G * 8, true); RSEAM(0); }
    if (IN(1)) REPEAT(1) { p_lnmod(F); RSEAM(1); }
    if (IN(2)) REPEAT(2) { PolProj P{F.hxc, F.Wt_in, F.proj, F.G, (int)blockIdx.x}; pg8::gemm_phase<PolProj>(F.lds, P);
        if (tail_wg) p_weights(F, W_ITEMS - W_TAIL, W_TAIL, ((int)blockIdx.x - 136) * 8 + F.wave, 120 * 8, false); RSEAM(2); }
    if (IN(3)) REPEAT(3) { at::p_mixer(F); RSEAM(3); }
    if (IN(4)) REPEAT(4) { PolOut P{F.mixin, F.Wt_out, F.x, F.mod, F.y1, F.G, (int)blockIdx.x}; pg8::gemm_phase<PolOut>(F.lds, P); RSEAM(4); }
    if (IN(5)) { p_route(F); SEAM(5); }
    if (IN(6)) REPEAT(6) { const int T = expert_tables(F); ExpTab tb{(const LAS int*)(F.lds + L_TILEE), (const LAS int*)(F.lds + L_TSTART), (const LAS int*)(F.lds + L_TSTART) + 64, T};
        PolGU P{F.h2, F.Wt_gu, F.b_gu, F.list, F.act, tb, F.G, (int)blockIdx.x}; pg8::gemm_phase<PolGU>(F.lds, P); RSEAM(6); }
    if (IN(7)) REPEAT(7) { const int T = expert_tables(F); ExpTab tb{(const LAS int*)(F.lds + L_TILEE), (const LAS int*)(F.lds + L_TSTART), (const LAS int*)(F.lds + L_TSTART) + 64, T};
        PolDN P{F.act, F.Wt_dn, F.b_dn, F.list, F.listg, F.ybuf, tb, F.G, (int)blockIdx.x}; pg8::gemm_phase<PolDN>(F.lds, P); RSEAM(7); }
    if (IN(8)) REPEAT(8) { p_final(F); if (rep_ + 1 < REPS[8]) xcd_barrier(bar); }
#undef IN
#undef SEAM
#undef REPEAT
#undef RSEAM
}

static inline void launch_forward(void* const* d_in, void* d_out, void* d_ws, hipStream_t stream, int n_launches) {
    static int grid = 0;
    if (grid == 0) {
        int dev = 0, cus = 0;
        if (hipGetDevice(&dev) != hipSuccess || hipDeviceGetAttribute(&cus, hipDeviceAttributeMultiprocessorCount, dev) != hipSuccess) { fprintf(stderr, "kernel_launch: device query failed\n"); grid = -1; return; }
        if (hipFuncSetAttribute((const void*)mk_fwd, hipFuncAttributeMaxDynamicSharedMemorySize, LDS_BYTES) != hipSuccess) { fprintf(stderr, "kernel_launch: hipFuncSetAttribute failed\n"); grid = -1; return; }
        int per_cu = 0;
        if (hipOccupancyMaxActiveBlocksPerMultiprocessor(&per_cu, (const void*)mk_fwd, 512, LDS_BYTES) != hipSuccess || per_cu < 1) fprintf(stderr, "kernel_launch: occupancy query says %d\n", per_cu);
        (void)hipGetLastError();
        grid = cus;
    }
    if (grid < 0) return;
    (void)hipMemsetAsync((char*)d_ws + WS_CTL, 0, CTL_ZERO_BYTES, stream);
    Args a{};
    for (int i = 0; i < 23; ++i) a.in[i] = (const float*)d_in[i];
    a.out = (float*)d_out; a.ws = (unsigned char*)d_ws;
    if (n_launches == 1) { a.ph_lo = 0; a.ph_hi = N_PHASES; hipLaunchKernelGGL(mk_fwd, dim3(grid), dim3(512), LDS_BYTES, stream, a); }
    else for (int p = 0; p < N_PHASES; ++p) { a.ph_lo = p; a.ph_hi = p + 1; hipLaunchKernelGGL(mk_fwd, dim3(grid), dim3(512), LDS_BYTES, stream, a); }
#ifdef PROBE_EXTRA
    { const int extra[] = PROBE_EXTRA; for (int p : extra) { a.ph_lo = p; a.ph_hi = p + 1; a.alt = (p == 5); hipLaunchKernelGGL(mk_fwd, dim3(grid), dim3(512), LDS_BYTES, stream, a); } }
#endif
}
}
extern "C" void kernel_launch(void* const* d_in, const int* in_sizes, int n_in, void* d_out, int out_size, void* d_ws, size_t ws_size, hipStream_t stream) {
    if (ws_size < mk::WS_END || n_in != 23) { fprintf(stderr, "kernel_launch: unexpected workspace / inputs (%zu, %d)\n", ws_size, n_in); return; }
    mk::launch_forward(d_in, d_out, d_ws, stream, 1);
}
```

```cpp
#include <hip/hip_runtime.h>
#include <stdint.h>
#include <stdio.h>

#define GAS __attribute__((address_space(1)))
#define LAS __attribute__((address_space(3)))
typedef unsigned short bf16_t;
typedef short bf16x8 __attribute__((ext_vector_type(8)));
typedef float f32x4 __attribute__((ext_vector_type(4)));
typedef float f32x2 __attribute__((ext_vector_type(2)));
typedef unsigned u32x4 __attribute__((ext_vector_type(4)));
typedef unsigned u32x2 __attribute__((ext_vector_type(2)));

namespace mk {
constexpr int D = 1024, NB = 2, S = 8192, M = NB * S, GW = 64, ROWS = 128, CTX = 256, NH = 8, KH = 8, KW = 16;
constexpr int NE = 32, TOPK = 4, DFF = 1024, DIN = 2560, NPAIR = M * TOPK, MX = M + NB * CTX;
constexpr int LCAP = 16384, MAXT = 288, ACT_ROWS = MAXT * 256;
constexpr float EPS = 1e-5f;
constexpr float DN_ALPHA = 1.189207115002721f;
constexpr size_t MiB = 1u << 20;
constexpr size_t WS_CTL = 0, CTL_ZERO_BYTES = 1 * MiB;
constexpr size_t WS_MOD = 1 * MiB;
constexpr size_t WS_TOPG = 2 * MiB;
constexpr size_t WS_TOPI = 2 * MiB + 512 * 1024;
constexpr size_t WS_STAT = 5 * MiB + 512 * 1024;
constexpr size_t WS_LIST = 3 * MiB;
constexpr size_t WS_SGUW = 5 * MiB;
constexpr size_t WS_LISTG = 14 * MiB;
constexpr size_t WS_WIN = 6 * MiB;
constexpr size_t WS_WOUT = 11 * MiB;
constexpr size_t WS_WGU = 16 * MiB;
constexpr size_t WS_WDN = 144 * MiB;
constexpr size_t WS_HXC = 208 * MiB;
constexpr size_t WS_PROJ = 241 * MiB;
constexpr size_t WS_MIXIN = 324 * MiB;
constexpr size_t WS_Y1 = 356 * MiB;
constexpr size_t WS_H2 = 420 * MiB;
constexpr size_t WS_ACT = 452 * MiB;
constexpr size_t WS_YBUF = 596 * MiB;
constexpr size_t WS_X1 = 724 * MiB;
constexpr size_t WS_END = 788 * MiB;
constexpr size_t WS_ALT = 788 * MiB;
constexpr int CW_CNT_ALT = 12288;
constexpr int CW_BAR = 4096;
constexpr int CW_CNT = 8192;
constexpr int RING_BYTES = 131072;
constexpr int L_MISC = RING_BYTES;
constexpr int L_IDX = L_MISC + 1024;
constexpr int L_TILEE = L_IDX + 6144;
constexpr int L_TSTART = L_TILEE + 1280;
constexpr int L_ROUTE = L_TSTART + 512;
constexpr int L_RPB = L_ROUTE + 256 + 1024;
constexpr int L_WSCR = L_RPB + 2048;
constexpr int LDS_BYTES = 163840;
static_assert(L_WSCR + 8 * 2048 <= LDS_BYTES, "LDS map");

template <int CTRL> __device__ __forceinline__ float dppf(float v) { return __builtin_bit_cast(float, __builtin_amdgcn_update_dpp(0, __builtin_bit_cast(int, v), CTRL, 0xF, 0xF, true)); }
__device__ __forceinline__ float rlane(float v, int l) { return __builtin_bit_cast(float, __builtin_amdgcn_readlane(__builtin_bit_cast(int, v), l)); }
__device__ __forceinline__ float wsum(float v) {
    v += dppf<0xB1>(v); v += dppf<0x4E>(v); v += dppf<0x141>(v); v += dppf<0x140>(v);
    return (rlane(v, 0) + rlane(v, 16)) + (rlane(v, 32) + rlane(v, 48));
}
__device__ __forceinline__ float wmax(float v) {
    v = fmaxf(v, dppf<0xB1>(v)); v = fmaxf(v, dppf<0x4E>(v)); v = fmaxf(v, dppf<0x141>(v)); v = fmaxf(v, dppf<0x140>(v));
    return fmaxf(fmaxf(rlane(v, 0), rlane(v, 16)), fmaxf(rlane(v, 32), rlane(v, 48)));
}
__device__ __forceinline__ unsigned f2bf(float f) { unsigned u = __builtin_bit_cast(unsigned, f); return (u + 0x7fffu + ((u >> 16) & 1u)) >> 16; }
__device__ __forceinline__ unsigned pk2(float lo, float hi) { return f2bf(lo) | (f2bf(hi) << 16); }
__device__ __forceinline__ float bf2f(unsigned short b) { return __builtin_bit_cast(float, ((unsigned)b) << 16); }
__device__ __forceinline__ float bflo(unsigned w) { return __builtin_bit_cast(float, w << 16); }
__device__ __forceinline__ float bfhi(unsigned w) { return __builtin_bit_cast(float, w & 0xffff0000u); }
__device__ __forceinline__ unsigned cvt_pk_bf16(float lo, float hi) { unsigned r; asm volatile("v_cvt_pk_bf16_f32 %0, %1, %2" : "=v"(r) : "v"(lo), "v"(hi)); return r; }
__device__ __forceinline__ float gelu_fast(float x) {
    const float c1 = -2.302208198f;
    const float c3 = c1 * 0.044715f;
    const float x2 = x * x;
    const float t = x * (c1 + c3 * x2);
    return x * __builtin_amdgcn_rcpf(1.f + __builtin_amdgcn_exp2f(t));
}

#define XB_TMO      128
#define XB_XCNT(j)  (256  + 64 * (j))
#define XB_XSUB(j)  (1280 + 64 * (j))
#define XB_XGEN(j)  (2304 + 64 * (j))
#define XB_TOP      3328
#define XB_TOPGEN   3392
#define XCD_BAR_WORDS 3456
#define XB_SPIN_CAP (1u << 18)
__device__ __forceinline__ unsigned xb_ld(unsigned* p)              { return __hip_atomic_load(p, __ATOMIC_RELAXED, __HIP_MEMORY_SCOPE_AGENT); }
__device__ __forceinline__ unsigned xb_add(unsigned* p, unsigned v) { return __hip_atomic_fetch_add(p, v, __ATOMIC_RELAXED, __HIP_MEMORY_SCOPE_AGENT); }
__device__ __forceinline__ unsigned xb_xcc_id() { return (unsigned)__builtin_amdgcn_s_getreg((3 << 11) | 20) & 0xFu; }
#define XB_SPIN(cond, bar) do { unsigned _sp = 0; while (cond) { __builtin_amdgcn_s_sleep(1); \
    if ((++_sp & 255u) == 0u) { if (xb_ld(&(bar)[XB_TMO])) break; if (_sp > XB_SPIN_CAP) { atomicAdd(&(bar)[XB_TMO], 1u); break; } } } } while (0)
struct XcdBarrier { unsigned* bar; unsigned x; volatile LAS unsigned* st; };
__device__ __forceinline__ XcdBarrier xcd_barrier_post(unsigned* bar, volatile LAS unsigned* st) {
    XcdBarrier b; b.bar = bar; b.x = xb_xcc_id(); b.st = st;
    if (threadIdx.x == 0) (void)xb_add(&bar[XB_XCNT(b.x)], 1u);
    return b;
}
__device__ __forceinline__ void xcd_barrier_complete(unsigned* bar, unsigned x, unsigned& nloc, unsigned& nx) {
    const unsigned G = gridDim.x * gridDim.y * gridDim.z;
    unsigned sum, cnt, mine, sp = 0u;
    for (;;) {
        sum = 0u; cnt = 0u; mine = 0u;
#pragma unroll
        for (unsigned j = 0; j < 16; ++j) { const unsigned c = xb_ld(&bar[XB_XCNT(j)]); sum += c; cnt += (c > 0u) ? 1u : 0u; mine = (j == x) ? c : mine; }
        if (sum == G) break;
        __builtin_amdgcn_s_sleep(1);
        if ((++sp & 255u) == 0u) { if (xb_ld(&bar[XB_TMO])) break; if (sp > XB_SPIN_CAP) { atomicAdd(&bar[XB_TMO], 1u); break; } }
    }
    nloc = mine > 0u ? mine : 1u; nx = cnt > 0u ? cnt : 1u;
}
__device__ __forceinline__ void xcd_barrier(const XcdBarrier& b) {
    asm volatile("s_waitcnt vmcnt(0)" ::: "memory");
    __syncthreads();
    if (threadIdx.x == 0) {
        unsigned* bar = b.bar;
        __builtin_amdgcn_s_waitcnt(0);
        unsigned nloc = b.st[0], nx = b.st[1];
        if (nloc == 0u) { xcd_barrier_complete(bar, b.x, nloc, nx); b.st[0] = nloc; b.st[1] = nx; }
        const unsigned old = xb_add(&bar[XB_XSUB(b.x)], 1u);
        const unsigned gen = old / nloc;
        if (old + 1u == (gen + 1u) * nloc) {
            __builtin_amdgcn_fence(__ATOMIC_RELEASE, "agent");
            asm volatile("s_waitcnt vmcnt(0)" ::: "memory");
            const unsigned og = xb_add(&bar[XB_TOP], 1u);
            const unsigned tg = og / nx;
            if (og + 1u == (tg + 1u) * nx) xb_add(&bar[XB_TOPGEN], 1u);
            else XB_SPIN(xb_ld(&bar[XB_TOPGEN]) == tg, bar);
            __builtin_amdgcn_fence(__ATOMIC_ACQUIRE, "agent");
            xb_add(&bar[XB_XGEN(b.x)], 1u);
            asm volatile("s_waitcnt vmcnt(0)" ::: "memory");
        } else {
            XB_SPIN(xb_ld(&bar[XB_XGEN(b.x)]) == gen, bar);
            __builtin_amdgcn_fence(__ATOMIC_ACQUIRE, "agent");
            asm volatile("s_waitcnt vmcnt(0)" ::: "memory");
        }
    }
    __syncthreads();
}

struct Frame {
    LAS unsigned char* lds;
    volatile LAS unsigned* MISC;
    unsigned* ctl;
    int tid, lane, wave, vcu, G;
    const float *x, *c, *ctx, *c_ctx, *ada_w, *ada_b, *w_in, *rpb, *sgu_ln_g, *sgu_ln_b, *sgu_w, *sgu_b, *w_out, *ln1_g, *ln1_b, *ln2_g, *ln2_b, *router_w, *router_b, *w_gu, *b_gu, *w_dn, *b_dn;
    float* out;
    float* mod; float* topg; int* topi; int* list; float* listg; bf16_t* sguw; bf16_t* Wt_in; bf16_t* Wt_out; unsigned char* Wt_gu; unsigned char* Wt_dn;
    bf16_t* hxc; bf16_t* proj; bf16_t* mixin; bf16_t* y1; float* x1; f32x2* stat; unsigned* cntw; unsigned char* h2; unsigned char* act; bf16_t* ybuf;
};
#define LDS_WAIT() asm volatile("s_waitcnt lgkmcnt(0)" ::: "memory")
#define VM_WAIT() asm volatile("s_waitcnt vmcnt(0)" ::: "memory")

namespace pg8 {
constexpr int BM = 256, BK = 64, HALF = 128, HTB = HALF * BK * 2, STAGE_BYTES = 8 * HTB, NXCD = 8, WGM = 8, KD = 1024, NKT = KD / BK;
__device__ __forceinline__ int lds_byte(int r, int c) { const int st = (r >> 4) * 2 + (c >> 5), rr = r & 15, cc = c & 31, ob = rr * 64 + cc * 2; return st * 1024 + (ob ^ (((ob >> 9) & 1) << 5)); }
__device__ __forceinline__ void stage_rc(int b, int& R, int& C) { const int st = b / 1024, sb = b % 1024, swz = sb ^ (((sb >> 9) & 1) << 5); R = (st >> 1) * 16 + swz / 64; C = (st & 1) * 32 + (swz % 64) / 2; }
__device__ __forceinline__ int perm32(int rho) { const int n = rho >> 4, i = rho & 15; return 8 * (i >> 2) + 4 * n + (i & 3); }
struct Unit { int pm, pn, e, nvalid, ti; };
__device__ __forceinline__ void static_tile(int L, int nM, int nN, int& pm, int& pn) {
    const int nwg = nM * nN; int wgid = L;
    { const int q = nwg / NXCD, r = nwg % NXCD, xcd = wgid % NXCD, off = wgid / NXCD; wgid = (xcd < r ? xcd * (q + 1) : r * (q + 1) + (xcd - r) * q) + off; }
    const int nig = WGM * nN, gid = wgid / nig, fm = gid * WGM, gsz = (nM - fm) < WGM ? (nM - fm) : WGM;
    pm = fm + ((wgid % nig) % gsz); pn = (wgid % nig) / gsz;
}

typedef int v8i __attribute__((ext_vector_type(8)));
template <bool FP8> struct Frags;
template <> struct Frags<false> { bf16x8 At[4][2], B0[2][2], B1[2][2]; };
template <> struct Frags<true> { v8i At[4], B0[2], B1[2]; };
template <class P>
__device__ __forceinline__ void gemm_phase(LAS unsigned char* lds, const P& pol) {
    const int tid = threadIdx.x, wid = __builtin_amdgcn_readfirstlane(tid >> 6), lane = tid & 63, wr = wid >> 2, wc = wid & 3, fr = lane & 15, fq = lane >> 4;
    constexpr int KDB = P::FP8 ? 1024 : 2048, NKT_ = KDB / 128;
    unsigned voffB[2];
#pragma unroll
    for (int i = 0; i < 2; ++i) { int R, C; stage_rc(tid * 16 + i * 8192, R, C); const int Rb = P::PERM ? ((R & ~31) + perm32(R & 31)) : R;
        voffB[i] = (unsigned)(Rb * KDB + C * 2); }
    const size_t kstep = (size_t)(BK * 2);
    const size_t hstep = (size_t)HALF * KDB;
    const unsigned ldsw = (unsigned)wid * 1024u;
    const int aoff = lds_byte(wr * 64 + fr, fq * 8), boff = lds_byte(wc * 32 + fr, fq * 8);
#define PG8_SA(b, h) (((b) * 2 + (h)) * HTB)
#define PG8_SB(b, h) ((4 + (b) * 2 + (h)) * HTB)
#define PG8_STAGE(bufoff, gbase, voff) do { _Pragma("unroll") for (int _i = 0; _i < 2; ++_i) \
        __builtin_amdgcn_global_load_lds((const unsigned*)((const char*)(gbase) + (voff)[_i]), (LAS unsigned*)(lds + (bufoff) + ldsw + _i * 8192), 16, 0, 0); } while (0)
#define PG8_RD8(p) __builtin_shufflevector(*(const LAS u32x4*)(p), *(const LAS u32x4*)((p) + 1024), 0, 1, 2, 3, 4, 5, 6, 7)
#define PG8_LDA(dst, b, h) do { if constexpr (P::FP8) { _Pragma("unroll") for (int m = 0; m < 4; ++m) fg.dst[m] = __builtin_bit_cast(v8i, PG8_RD8(lds + PG8_SA(b, h) + aoff + m * 2048)); } \
        else { _Pragma("unroll") for (int m = 0; m < 4; ++m) _Pragma("unroll") for (int k = 0; k < 2; ++k) fg.dst[m][k] = *(const LAS bf16x8*)(lds + PG8_SA(b, h) + aoff + m * 2048 + k * 1024); } } while (0)
#define PG8_LDB(dst, b, h) do { if constexpr (P::FP8) { _Pragma("unroll") for (int n = 0; n < 2; ++n) fg.dst[n] = __builtin_bit_cast(v8i, PG8_RD8(lds + PG8_SB(b, h) + boff + n * 2048)); } \
        else { _Pragma("unroll") for (int n = 0; n < 2; ++n) _Pragma("unroll") for (int k = 0; k < 2; ++k) fg.dst[n][k] = *(const LAS bf16x8*)(lds + PG8_SB(b, h) + boff + n * 2048 + k * 1024); } } while (0)
#define PG8_MMA(ai, bj, At, Bt) do { __builtin_amdgcn_s_setprio(1); \
        if constexpr (P::FP8) { _Pragma("unroll") for (int m = 0; m < 4; ++m) _Pragma("unroll") for (int n = 0; n < 2; ++n) \
            acc[ai][bj][m][n] = __builtin_amdgcn_mfma_scale_f32_16x16x128_f8f6f4(fg.Bt[n], fg.At[m], acc[ai][bj][m][n], 0, 0, 0, 0, 0, 0); } \
        else { _Pragma("unroll") for (int m = 0; m < 4; ++m) _Pragma("unroll") for (int n = 0; n < 2; ++n) _Pragma("unroll") for (int k = 0; k < 2; ++k) \
            acc[ai][bj][m][n] = __builtin_amdgcn_mfma_f32_16x16x32_bf16(fg.Bt[n][k], fg.At[m][k], acc[ai][bj][m][n], 0, 0, 0); } \
        __builtin_amdgcn_s_setprio(0); } while (0)
#define PG8_WAIT_V(n) asm volatile("s_waitcnt vmcnt(" #n ")" ::: "memory")
#define PG8_WAIT_L(n) asm volatile("s_waitcnt lgkmcnt(" #n ")" ::: "memory")
#define PG8_BAR __builtin_amdgcn_s_barrier()
#define PG8_SCHED __builtin_amdgcn_sched_barrier(0)
    Unit cur, nxt; int ui = 0;
    if (!pol.next(0, cur)) return;
    f32x4 acc[2][2][4][2];
#pragma unroll
    for (int a = 0; a < 2; ++a)
#pragma unroll
        for (int b = 0; b < 2; ++b)
#pragma unroll
            for (int m = 0; m < 4; ++m)
#pragma unroll
                for (int n = 0; n < 2; ++n) acc[a][b][m][n] = (f32x4){0.f, 0.f, 0.f, 0.f};
    Frags<P::FP8> fg;
    int slot = 0;
    if (P::META) { pol.meta_issue(cur, 0, lds, wid, lane); PG8_WAIT_V(0); asm volatile("" ::: "memory"); PG8_BAR; asm volatile("" ::: "memory"); }
    unsigned aC[2][2];
    pol.a_off(cur, 0, lds, aC);
    const char* const Ab = (const char*)pol.A;
    const char* cB = pol.b_ptr(cur);
    PG8_STAGE(PG8_SB(0, 0), cB, voffB); PG8_STAGE(PG8_SB(0, 1), cB + hstep, voffB); PG8_STAGE(PG8_SA(0, 0), Ab, aC[0]); PG8_STAGE(PG8_SA(0, 1), Ab, aC[1]);
    if (wr == 1) PG8_BAR;
    PG8_WAIT_V(2); PG8_BAR;
    PG8_STAGE(PG8_SB(1, 0), cB + kstep, voffB); PG8_STAGE(PG8_SA(1, 0), Ab + kstep, aC[0]); PG8_STAGE(PG8_SB(1, 1), cB + hstep + kstep, voffB);
    PG8_WAIT_V(6); PG8_BAR;
    for (;;) {
        const bool has_next = pol.next(ui + 1, nxt);
        const int nslot = slot == 2 ? 0 : slot + 1;
        if (P::META) { if (has_next) pol.meta_issue(nxt, nslot, lds, wid, lane); }
        const char* nB = has_next ? pol.b_ptr(nxt) : cB;
#pragma unroll 1
        for (int t = 0; t < NKT_; t += 2) {
            const bool last = (t == NKT_ - 2);
            const char* a1 = Ab + (size_t)(t + 1) * kstep;
            const char* a2 = last ? Ab : Ab + (size_t)(t + 2) * kstep; const char* b2 = last ? nB : cB + (size_t)(t + 2) * kstep;
            const char* a3 = a2 + kstep; const char* b3 = b2 + kstep;
            PG8_LDB(B0, 0, 0); PG8_LDB(B1, 0, 1); PG8_SCHED; PG8_LDA(At, 0, 0); PG8_STAGE(PG8_SA(1, 1), a1, aC[1]);
            if (last && has_next) pol.a_off(nxt, nslot, lds, aC);
            PG8_WAIT_V(8); PG8_WAIT_L(0); PG8_BAR; PG8_MMA(0, 0, At, B0); PG8_MMA(0, 1, At, B1); PG8_BAR; PG8_SCHED;
            PG8_LDA(At, 0, 1); PG8_STAGE(PG8_SB(0, 0), b2, voffB); PG8_STAGE(PG8_SB(0, 1), b2 + hstep, voffB); PG8_STAGE(PG8_SA(0, 0), a2, aC[0]);
            PG8_WAIT_V(8); PG8_WAIT_L(0); PG8_BAR; PG8_MMA(1, 0, At, B0); PG8_MMA(1, 1, At, B1); PG8_BAR; PG8_SCHED;
            PG8_LDB(B0, 1, 0); PG8_LDB(B1, 1, 1); PG8_SCHED; PG8_LDA(At, 1, 0); PG8_STAGE(PG8_SA(0, 1), a2, aC[1]);
            PG8_WAIT_V(8); PG8_WAIT_L(0); PG8_BAR; PG8_MMA(0, 0, At, B0); PG8_MMA(0, 1, At, B1); PG8_BAR; PG8_SCHED;
            PG8_LDA(At, 1, 1); PG8_STAGE(PG8_SB(1, 0), b3, voffB); PG8_STAGE(PG8_SB(1, 1), b3 + hstep, voffB); PG8_STAGE(PG8_SA(1, 0), a3, aC[0]);
            PG8_WAIT_V(8); PG8_WAIT_L(0); PG8_BAR; PG8_MMA(1, 0, At, B0); PG8_MMA(1, 1, At, B1); PG8_BAR; PG8_SCHED;
        }
        if (wr == 0) PG8_BAR;
#ifdef PROBE_KLOOP2
        const bool do_epi = !(P::FP8 && P::KIND == PROBE_KLOOP2) || (ui & 1);
        if (do_epi) {
            if (P::FP8 && P::KIND == PROBE_KLOOP2) {
#pragma unroll
                for (int a = 0; a < 2; ++a)
#pragma unroll
                    for (int b = 0; b < 2; ++b)
#pragma unroll
                        for (int m = 0; m < 4; ++m)
#pragma unroll
                            for (int n = 0; n < 2; ++n) acc[a][b][m][n] *= 0.5f; }
            pol.epi(acc, cur, slot, lds, wr, wc, fr, fq); }
#else
        constexpr bool do_epi = true;
        pol.epi(acc, cur, slot, lds, wr, wc, fr, fq);
#endif
#ifdef PROBE_EPI2
        if (P::KIND == PROBE_EPI2) { asm volatile("" ::: "memory");
#pragma unroll
            for (int a = 0; a < 2; ++a)
#pragma unroll
                for (int b = 0; b < 2; ++b)
#pragma unroll
                    for (int m = 0; m < 4; ++m)
#pragma unroll
                        for (int n = 0; n < 2; ++n) asm volatile("" : "+v"(acc[a][b][m][n]));
            pol.epi(acc, cur, slot, lds, wr, wc, fr, fq); }
#endif
        if (!has_next) break;
        if (do_epi) {
#pragma unroll
        for (int a = 0; a < 2; ++a)
#pragma unroll
            for (int b = 0; b < 2; ++b)
#pragma unroll
                for (int m = 0; m < 4; ++m)
#pragma unroll
                    for (int n = 0; n < 2; ++n) acc[a][b][m][n] = (f32x4){0.f, 0.f, 0.f, 0.f};
        }
        cur = nxt; cB = nB; ++ui; slot = nslot;
        if (wr == 1) PG8_BAR;
    }
    PG8_WAIT_V(0);
    PG8_BAR;
#undef PG8_SA
#undef PG8_SB
#undef PG8_STAGE
#undef PG8_LDA
#undef PG8_LDB
#undef PG8_MMA
#undef PG8_RD8
#undef PG8_WAIT_V
#undef PG8_WAIT_L
#undef PG8_BAR
#undef PG8_SCHED
}
}

typedef f32x4 AccT[2][2][4][2];

struct PolProj {
    static constexpr int KIND = 0; static constexpr bool PERM = true, META = false, FP8 = false; static constexpr int SCALE_W = 0x7f7f7f7f;
    const bf16_t* A; const bf16_t* Bt; bf16_t* O; int G, c;
    __device__ __forceinline__ bool next(int i, pg8::Unit& u) const {
        const int L = i * G + c;
        if (L < 640) { pg8::static_tile(L, 64, 10, u.pm, u.pn); return true; }
        if (L < 648) { const int j = L - 640; u.pm = 64 + (j >> 2); u.pn = 2 + (j & 3); return true; }
        return false;
    }
    __device__ __forceinline__ const char* b_ptr(const pg8::Unit& u) const { return (const char*)Bt + (size_t)u.pn * 256 * 1024 * 2; }
    __device__ __forceinline__ void meta_issue(const pg8::Unit&, int, LAS unsigned char*, int, int) const {}
    __device__ __forceinline__ void a_off(const pg8::Unit& u, int, LAS unsigned char*, unsigned (&o)[2][2]) const {
        int Ra[2], Ca[2]; pg8::stage_rc((int)threadIdx.x * 16, Ra[0], Ca[0]); pg8::stage_rc((int)threadIdx.x * 16 + 8192, Ra[1], Ca[1]);
#pragma unroll
        for (int h = 0; h < 2; ++h)
#pragma unroll
            for (int i = 0; i < 2; ++i) o[h][i] = (unsigned)((u.pm * 256 + 128 * h + Ra[i]) * 1024 + Ca[i]) * 2u;
    }
    __device__ __forceinline__ void epi(const AccT& acc, const pg8::Unit& u, int, LAS unsigned char*, int wr, int wc, int fr, int fq) const {
        const int row0 = u.pm * 256 + wr * 64 + fr, col0 = u.pn * 256 + wc * 32 + 8 * fq;
        const bool act = u.pn >= 6;
#pragma unroll
        for (int ai = 0; ai < 2; ++ai)
#pragma unroll
            for (int m = 0; m < 4; ++m) { bf16_t* rowp = O + (size_t)(row0 + ai * 128 + m * 16) * DIN + col0;
#pragma unroll
                for (int bj = 0; bj < 2; ++bj) { f32x4 v0 = acc[ai][bj][m][0], v1 = acc[ai][bj][m][1];
                    if (act) {
#pragma unroll
                        for (int j = 0; j < 4; ++j) { v0[j] = gelu_fast(v0[j]); v1[j] = gelu_fast(v1[j]); } }
                    u32x4 w; w.x = cvt_pk_bf16(v0[0], v0[1]); w.y = cvt_pk_bf16(v0[2], v0[3]); w.z = cvt_pk_bf16(v1[0], v1[1]); w.w = cvt_pk_bf16(v1[2], v1[3]);
                    *(u32x4*)(rowp + bj * 128) = w; } }
    }
};

struct PolOut {
    static constexpr int KIND = 0; static constexpr bool PERM = true, META = false, FP8 = false; static constexpr int SCALE_W = 0x7f7f7f7f;
    const bf16_t* A; const bf16_t* Bt; const float* x; const float* mod; bf16_t* Y; int G, c;
    __device__ __forceinline__ bool next(int i, pg8::Unit& u) const { const int L = i * G + c; if (L >= 256) return false; pg8::static_tile(L, 64, 4, u.pm, u.pn); return true; }
    __device__ __forceinline__ const char* b_ptr(const pg8::Unit& u) const { return (const char*)Bt + (size_t)u.pn * 256 * 1024 * 2; }
    __device__ __forceinline__ void meta_issue(const pg8::Unit&, int, LAS unsigned char*, int, int) const {}
    __device__ __forceinline__ void a_off(const pg8::Unit& u, int, LAS unsigned char*, unsigned (&o)[2][2]) const {
        int Ra[2], Ca[2]; pg8::stage_rc((int)threadIdx.x * 16, Ra[0], Ca[0]); pg8::stage_rc((int)threadIdx.x * 16 + 8192, Ra[1], Ca[1]);
#pragma unroll
        for (int h = 0; h < 2; ++h)
#pragma unroll
            for (int i = 0; i < 2; ++i) o[h][i] = (unsigned)((u.pm * 256 + 128 * h + Ra[i]) * 1024 + Ca[i]) * 2u;
    }
    __device__ __forceinline__ void epi(const AccT& acc, const pg8::Unit& u, int, LAS unsigned char*, int wr, int wc, int fr, int fq) const {
        const int row0 = u.pm * 256 + wr * 64 + fr, col0 = u.pn * 256 + wc * 32 + 8 * fq;
        const float* g1 = mod + (u.pm >= 32 ? 6144 : 0) + 2 * 1024;
        f32x4 gv[2][2];
#pragma unroll
        for (int bj = 0; bj < 2; ++bj)
#pragma unroll
            for (int n = 0; n < 2; ++n) gv[bj][n] = *(const f32x4*)(g1 + col0 + bj * 128 + 4 * n);
#pragma unroll
        for (int ai = 0; ai < 2; ++ai)
#pragma unroll
            for (int m = 0; m < 4; ++m) { const size_t off = (size_t)(row0 + ai * 128 + m * 16) * D + col0;
#pragma unroll
                for (int bj = 0; bj < 2; ++bj) { const f32x4 x0 = *(const f32x4*)(x + off + bj * 128), x1v = *(const f32x4*)(x + off + bj * 128 + 4);
                    const f32x4 v0 = x0 * DN_ALPHA + gv[bj][0] * acc[ai][bj][m][0], v1 = x1v * DN_ALPHA + gv[bj][1] * acc[ai][bj][m][1];
                    u32x4 w; w.x = cvt_pk_bf16(v0[0], v0[1]); w.y = cvt_pk_bf16(v0[2], v0[3]); w.z = cvt_pk_bf16(v1[0], v1[1]); w.w = cvt_pk_bf16(v1[2], v1[3]);
                    *(u32x4*)(Y + off + bj * 128) = w; }
                asm volatile("" ::: "memory"); }
    }
};

struct ExpTab { const LAS int* tile_e; const LAS int* tstart; const LAS int* cnt; int T; };
__device__ __forceinline__ int expert_tables(Frame& F) {
    LAS int* tile_e = (LAS int*)(F.lds + L_TILEE); LAS int* tstart = (LAS int*)(F.lds + L_TSTART); LAS int* cn = tstart + 64;
    if (F.tid < 32) cn[F.tid] = (int)__hip_atomic_load(F.ctl + CW_CNT + 32 * F.tid, __ATOMIC_RELAXED, __HIP_MEMORY_SCOPE_AGENT);
    __syncthreads();
    if (F.tid == 0) { int run = 0; for (int e = 0; e < NE; ++e) { tstart[e] = run; run += (cn[e] + 255) >> 8; } tstart[NE] = run; }
    __syncthreads();
    const int T = tstart[NE];
    if (F.tid < MAXT && F.tid < T) { int e = 0; while (e < NE - 1 && tstart[e + 1] <= F.tid) ++e; tile_e[F.tid] = e; }
    __syncthreads();
    return T < MAXT ? T : MAXT;
}
__device__ __forceinline__ int rfl(int v) { return __builtin_amdgcn_readfirstlane(v); }

struct PolGU {
    static constexpr int KIND = 1; static constexpr bool PERM = true, META = true, FP8 = true; static constexpr int SCALE_W = 0; static constexpr float WSC = 1.f / 64.f;
    const unsigned char* A; const unsigned char* Bt; const float* bias; const int* list; unsigned char* O; ExpTab tb; int G, c;
    __device__ __forceinline__ bool next(int i, pg8::Unit& u) const {
#if defined(PROBE_KLOOP2) && PROBE_KLOOP2 == 1
        const int L = (i >> 1) * G + c; if (L >= tb.T * 8) return false;
#else
        const int L = i * G + c; if (L >= tb.T * 8) return false;
#endif
        u.ti = L >> 3; u.pn = L & 7; u.e = rfl(tb.tile_e[u.ti]); u.pm = u.ti - rfl(tb.tstart[u.e]);
        const int rem = rfl(tb.cnt[u.e]) - u.pm * 256; u.nvalid = rem < 256 ? rem : 256; return true;
    }
    __device__ __forceinline__ const char* b_ptr(const pg8::Unit& u) const { return (const char*)Bt + ((size_t)u.e * 2048 + (size_t)u.pn * 256) * 1024; }
    __device__ __forceinline__ void meta_issue(const pg8::Unit& u, int slot, LAS unsigned char* lds, int wid, int lane) const {
        if (wid < 4) __builtin_amdgcn_global_load_lds((const unsigned*)(list + (size_t)u.e * LCAP + u.pm * 256 + wid * 64 + lane), (LAS unsigned*)(lds + L_IDX + slot * 2048 + wid * 256), 4, 0, 0);
    }
    __device__ __forceinline__ void a_off(const pg8::Unit& u, int slot, LAS unsigned char* lds, unsigned (&o)[2][2]) const {
        int Ra[2], Ca[2]; pg8::stage_rc((int)threadIdx.x * 16, Ra[0], Ca[0]); pg8::stage_rc((int)threadIdx.x * 16 + 8192, Ra[1], Ca[1]);
        const LAS int* idx = (const LAS int*)(lds + L_IDX + slot * 2048);
#pragma unroll
        for (int h = 0; h < 2; ++h)
#pragma unroll
            for (int i = 0; i < 2; ++i) { const int r = 128 * h + Ra[i]; int pr = idx[r]; pr = r < u.nvalid ? pr : 0; o[h][i] = (unsigned)((pr >> 2) * 1024 + Ca[i] * 2); }
    }
    __device__ __forceinline__ void epi(const AccT& acc, const pg8::Unit& u, int, LAS unsigned char*, int wr, int wc, int fr, int fq) const {
        const int row0 = u.ti * 256 + wr * 64 + fr, col0 = u.pn * 128 + wc * 32 + 8 * fq;
        const float* bg = bias + (size_t)u.e * 2048 + col0;
        const f32x4 g0 = *(const f32x4*)(bg), g1 = *(const f32x4*)(bg + 4), l0 = *(const f32x4*)(bg + 1024) + 1.f, l1 = *(const f32x4*)(bg + 1028) + 1.f;
#pragma unroll
        for (int ai = 0; ai < 2; ++ai)
#pragma unroll
            for (int m = 0; m < 4; ++m) {
                f32x4 r0, r1;
#pragma unroll
                for (int hp = 0; hp < 2; ++hp) {
                    const f32x2 ga0 = (f32x2){acc[ai][0][m][0][2 * hp], acc[ai][0][m][0][2 * hp + 1]} * WSC + (f32x2){g0[2 * hp], g0[2 * hp + 1]};
                    const f32x2 ga1 = (f32x2){acc[ai][0][m][1][2 * hp], acc[ai][0][m][1][2 * hp + 1]} * WSC + (f32x2){g1[2 * hp], g1[2 * hp + 1]};
                    const f32x2 lb0 = (f32x2){acc[ai][1][m][0][2 * hp], acc[ai][1][m][0][2 * hp + 1]} * WSC + (f32x2){l0[2 * hp], l0[2 * hp + 1]};
                    const f32x2 lb1 = (f32x2){acc[ai][1][m][1][2 * hp], acc[ai][1][m][1][2 * hp + 1]} * WSC + (f32x2){l1[2 * hp], l1[2 * hp + 1]};
                    f32x2 gg0, gg1, ll0, ll1, e0, e1;
                    gg0[0] = fminf(ga0[0], 7.f); gg0[1] = fminf(ga0[1], 7.f); gg1[0] = fminf(ga1[0], 7.f); gg1[1] = fminf(ga1[1], 7.f);
                    ll0[0] = __builtin_amdgcn_fmed3f(lb0[0], -6.f, 8.f); ll0[1] = __builtin_amdgcn_fmed3f(lb0[1], -6.f, 8.f); ll1[0] = __builtin_amdgcn_fmed3f(lb1[0], -6.f, 8.f); ll1[1] = __builtin_amdgcn_fmed3f(lb1[1], -6.f, 8.f);
                    const f32x2 x0 = gg0 * -2.45546696f, x1 = gg1 * -2.45546696f;
                    e0[0] = __builtin_amdgcn_exp2f(x0[0]); e0[1] = __builtin_amdgcn_exp2f(x0[1]); e1[0] = __builtin_amdgcn_exp2f(x1[0]); e1[1] = __builtin_amdgcn_exp2f(x1[1]);
                    const f32x2 d0 = e0 + 1.f, d1 = e1 + 1.f;
                    f32x2 q0, q1; q0[0] = __builtin_amdgcn_rcpf(d0[0]); q0[1] = __builtin_amdgcn_rcpf(d0[1]); q1[0] = __builtin_amdgcn_rcpf(d1[0]); q1[1] = __builtin_amdgcn_rcpf(d1[1]);
                    const f32x2 o0 = (ll0 * gg0) * q0, o1 = (ll1 * gg1) * q1;
                    r0[2 * hp] = o0[0]; r0[2 * hp + 1] = o0[1]; r1[2 * hp] = o1[0]; r1[2 * hp + 1] = o1[1];
                }
                u32x2 w; w.x = (unsigned)__builtin_amdgcn_cvt_pk_fp8_f32(r0[2], r0[3], __builtin_amdgcn_cvt_pk_fp8_f32(r0[0], r0[1], 0, false), true);
                w.y = (unsigned)__builtin_amdgcn_cvt_pk_fp8_f32(r1[2], r1[3], __builtin_amdgcn_cvt_pk_fp8_f32(r1[0], r1[1], 0, false), true);
                *(u32x2*)(O + (size_t)(row0 + ai * 128 + m * 16) * DFF + col0) = w; }
    }
};

struct PolDN {
    static constexpr int KIND = 2; static constexpr bool PERM = true, META = true, FP8 = true; static constexpr int SCALE_W = 0; static constexpr float WSC = 1.f / 64.f;
    const unsigned char* A; const unsigned char* Bt; const float* bias; const int* list; const float* listg; bf16_t* O; ExpTab tb; int G, c;
    __device__ __forceinline__ bool next(int i, pg8::Unit& u) const {
#if defined(PROBE_KLOOP2) && PROBE_KLOOP2 == 2
        const int L = (i >> 1) * G + c; if (L >= tb.T * 4) return false;
#else
        const int L = i * G + c; if (L >= tb.T * 4) return false;
#endif
        u.ti = L >> 2; u.pn = L & 3; u.e = rfl(tb.tile_e[u.ti]); u.pm = u.ti - rfl(tb.tstart[u.e]);
        const int rem = rfl(tb.cnt[u.e]) - u.pm * 256; u.nvalid = rem < 256 ? rem : 256; return true;
    }
    __device__ __forceinline__ const char* b_ptr(const pg8::Unit& u) const { return (const char*)Bt + ((size_t)u.e * 1024 + (size_t)u.pn * 256) * 1024; }
    __device__ __forceinline__ void meta_issue(const pg8::Unit& u, int slot, LAS unsigned char* lds, int wid, int lane) const {
        if (wid < 4) __builtin_amdgcn_global_load_lds((const unsigned*)(list + (size_t)u.e * LCAP + u.pm * 256 + wid * 64 + lane), (LAS unsigned*)(lds + L_IDX + slot * 2048 + wid * 256), 4, 0, 0);
        else __builtin_amdgcn_global_load_lds((const unsigned*)(listg + (size_t)u.e * LCAP + u.pm * 256 + (wid - 4) * 64 + lane), (LAS unsigned*)(lds + L_IDX + slot * 2048 + 1024 + (wid - 4) * 256), 4, 0, 0);
    }
    __device__ __forceinline__ void a_off(const pg8::Unit& u, int, LAS unsigned char*, unsigned (&o)[2][2]) const {
        int Ra[2], Ca[2]; pg8::stage_rc((int)threadIdx.x * 16, Ra[0], Ca[0]); pg8::stage_rc((int)threadIdx.x * 16 + 8192, Ra[1], Ca[1]);
#pragma unroll
        for (int h = 0; h < 2; ++h)
#pragma unroll
            for (int i = 0; i < 2; ++i) o[h][i] = (unsigned)((u.ti * 256 + 128 * h + Ra[i]) * 1024 + Ca[i] * 2);
    }
    __device__ __forceinline__ void epi(const AccT& acc, const pg8::Unit& u, int slot, LAS unsigned char* lds, int wr, int wc, int fr, int fq) const {
        const LAS int* idx = (const LAS int*)(lds + L_IDX + slot * 2048);
        const int col0 = u.pn * 256 + wc * 32 + 8 * fq;
        const float* bd = bias + (size_t)u.e * 1024 + col0;
        f32x4 bv[2][2];
#pragma unroll
        for (int bj = 0; bj < 2; ++bj)
#pragma unroll
            for (int n = 0; n < 2; ++n) bv[bj][n] = *(const f32x4*)(bd + bj * 128 + 4 * n);
#pragma unroll
        for (int ai = 0; ai < 2; ++ai)
#pragma unroll
            for (int m = 0; m < 4; ++m) { const int r = ai * 128 + wr * 64 + m * 16 + fr;
                if (r < u.nvalid) { const int pr = idx[r]; const float gt = ((const LAS float*)idx)[256 + r]; bf16_t* rowp = O + (size_t)pr * D + col0;
#pragma unroll
                    for (int bj = 0; bj < 2; ++bj) { const f32x4 v0 = (acc[ai][bj][m][0] * WSC + bv[bj][0]) * gt, v1 = (acc[ai][bj][m][1] * WSC + bv[bj][1]) * gt;
                        u32x4 w; w.x = cvt_pk_bf16(v0[0], v0[1]); w.y = cvt_pk_bf16(v0[2], v0[3]); w.z = cvt_pk_bf16(v1[0], v1[1]); w.w = cvt_pk_bf16(v1[2], v1[3]);
                        __builtin_nontemporal_store(w, (u32x4*)(rowp + bj * 128)); } } }
    }
};

__device__ __forceinline__ void p_ada(Frame& F) {
    LAS float* sl = (LAS float*)F.lds;
    LAS float* red = sl + 3072;
    for (int i = F.tid; i < 3072; i += 512) { const int w = i >> 10, k = i & 1023; const float v = w < 2 ? F.c[w * D + k] : F.c_ctx[k]; sl[i] = v / (1.f + __expf(-v)); }
    __syncthreads();
    for (int slab = blockIdx.x; slab < 256; slab += F.G) {
        const int j0 = slab * 24, cg = F.tid % 6, kr = F.tid / 6;
        float a[3][4] = {};
        if (F.tid < 480) {
            for (int k = kr; k < D; k += 80) {
                const f32x4 w4 = *(const f32x4*)(F.ada_w + (size_t)k * 6144 + j0 + 4 * cg);
                const float s0 = sl[k], s1 = sl[1024 + k], s2 = sl[2048 + k];
#pragma unroll
                for (int q = 0; q < 4; ++q) { a[0][q] += s0 * w4[q]; a[1][q] += s1 * w4[q]; a[2][q] += s2 * w4[q]; }
            }
#pragma unroll
            for (int w = 0; w < 3; ++w)
#pragma unroll
                for (int q = 0; q < 4; ++q) red[kr * 72 + cg * 12 + w * 4 + q] = a[w][q];
        }
        __syncthreads();
        if (F.tid < 72) {
            float s = 0.f;
            for (int r = 0; r < 80; ++r) s += red[r * 72 + F.tid];
            const int g = F.tid / 12, w = (F.tid % 12) >> 2, q = F.tid & 3, col = j0 + 4 * g + q;
            F.mod[w * 6144 + col] = s + F.ada_b[col];
        }
        __syncthreads();
    }
}

__device__ __forceinline__ void transpose_item(const float* W, int K, int N, bf16_t* WT, int item, bool gu_map, LAS float* scr, int lane) {
    const int nblk = N / 32, kb = item / nblk, nb = item % nblk, k0 = 64 * kb, n0 = 32 * nb;
#pragma unroll 8
    for (int i = 0; i < 32; ++i) { const int kk = 2 * i + (lane >> 5); scr[kk * 33 + (lane & 31)] = W[(size_t)(k0 + kk) * N + n0 + (lane & 31)]; }
    LDS_WAIT(); asm volatile("" ::: "memory");
    int d0 = n0;
    if (gu_map) { const int nn = n0 & 1023; d0 = (nn >> 7) * 256 + (nn & 127) + ((n0 >> 10) ? 128 : 0); }
    const int c = lane & 7;
#pragma unroll
    for (int j = 0; j < 4; ++j) { const int n = (lane >> 3) + 8 * j; const LAS float* s = scr + (8 * c) * 33 + n;
        u32x4 o; o.x = pk2(s[0 * 33], s[1 * 33]); o.y = pk2(s[2 * 33], s[3 * 33]); o.z = pk2(s[4 * 33], s[5 * 33]); o.w = pk2(s[6 * 33], s[7 * 33]);
        *(u32x4*)(WT + (size_t)(d0 + n) * K + k0 + 8 * c) = o; }
    LDS_WAIT(); asm volatile("" ::: "memory");
}
__device__ __forceinline__ unsigned pk4_fp8(float a, float b, float c, float d) { return (unsigned)__builtin_amdgcn_cvt_pk_fp8_f32(c, d, __builtin_amdgcn_cvt_pk_fp8_f32(a, b, 0, false), true); }
__device__ __forceinline__ void transpose_item8(const float* W, int K, int N, unsigned char* WT, int item, bool gu_map, LAS float* scr, int lane) {
    const int nblk = N / 32, kb = item / nblk, nb = item % nblk, k0 = 64 * kb, n0 = 32 * nb;
#pragma unroll 8
    for (int i = 0; i < 32; ++i) { const int kk = 2 * i + (lane >> 5); scr[kk * 33 + (lane & 31)] = W[(size_t)(k0 + kk) * N + n0 + (lane & 31)]; }
    LDS_WAIT(); asm volatile("" ::: "memory");
    int d0 = n0;
    if (gu_map) { const int nn = n0 & 1023; d0 = (nn >> 7) * 256 + (nn & 127) + ((n0 >> 10) ? 128 : 0); }
    const int c = lane & 7;
#pragma unroll
    for (int j = 0; j < 4; ++j) { const int n = (lane >> 3) + 8 * j; const LAS float* s = scr + (8 * c) * 33 + n;
        u32x2 o; o.x = pk4_fp8(s[0 * 33] * 64.f, s[1 * 33] * 64.f, s[2 * 33] * 64.f, s[3 * 33] * 64.f); o.y = pk4_fp8(s[4 * 33] * 64.f, s[5 * 33] * 64.f, s[6 * 33] * 64.f, s[7 * 33] * 64.f);
        *(u32x2*)(WT + (size_t)(d0 + n) * K + k0 + 8 * c) = o; }
    LDS_WAIT(); asm volatile("" ::: "memory");
}
__device__ __forceinline__ void p_weights(Frame& F, int it_lo, int n_items, int gw, int NGW, bool with_sgu) {
    LAS float* scr = (LAS float*)(F.lds + F.wave * 16384);
    constexpr int I_IN = 16 * 80, I_OUT = 16 * 32, I_GU = 16 * 64, I_DN = 16 * 32;
    constexpr int NITEMS = I_IN + I_OUT + NE * I_GU + NE * I_DN;
    for (int it0 = gw; it0 < n_items; it0 += NGW) {
        const int it = it_lo + it0; int r = it;
        if (r < I_IN) { transpose_item(F.w_in, D, DIN, F.Wt_in, r, false, scr, F.lane); continue; } r -= I_IN;
        if (r < I_OUT) { transpose_item(F.w_out, D, D, F.Wt_out, r, false, scr, F.lane); continue; } r -= I_OUT;
        if (r < NE * I_GU) { const int e = r / I_GU; transpose_item8(F.w_gu + (size_t)e * D * 2048, D, 2048, F.Wt_gu + (size_t)e * 2048 * D, r % I_GU, true, scr, F.lane); continue; } r -= NE * I_GU;
        { const int e = r / I_DN; transpose_item8(F.w_dn + (size_t)e * DFF * D, DFF, D, F.Wt_dn + (size_t)e * D * DFF, r % I_DN, false, scr, F.lane); }
    }
    if (with_sgu) for (int i = (blockIdx.x * 512 + F.tid) * 4; i < 4 * 128 * 128; i += F.G * 512 * 4) {
        const f32x4 v = *(const f32x4*)(F.sgu_w + i); u32x2 o; o.x = pk2(v[0], v[1]); o.y = pk2(v[2], v[3]); *(u32x2*)(F.sguw + i) = o; }
}
__device__ __forceinline__ void p_lnmod(Frame& F) {
    const int gw = F.vcu * 8 + F.wave, NGW = F.G * 8;
    for (int row = gw; row < MX; row += NGW) {
        const float* xr; const float* md;
        if (row < M) { xr = F.x + (size_t)row * D; md = F.mod + (row >> 13) * 6144; } else { xr = F.ctx + (size_t)(row - M) * D; md = F.mod + 2 * 6144; }
        const f32x4* xp = (const f32x4*)xr + F.lane;
        f32x4 v[4]; float s = 0.f;
#pragma unroll
        for (int j = 0; j < 4; ++j) { v[j] = xp[64 * j]; s += (v[j][0] + v[j][1]) + (v[j][2] + v[j][3]); }
        const float mean = wsum(s) * (1.f / D); float q = 0.f;
#pragma unroll
        for (int j = 0; j < 4; ++j) { v[j] = v[j] - mean; q += (v[j][0] * v[j][0] + v[j][1] * v[j][1]) + (v[j][2] * v[j][2] + v[j][3] * v[j][3]); }
        const float rstd = rsqrtf(wsum(q) * (1.f / D) + EPS);
        u32x2* op = (u32x2*)(F.hxc + (size_t)row * D) + F.lane;
#pragma unroll
        for (int j = 0; j < 4; ++j) { const f32x4 sh = *((const f32x4*)md + F.lane + 64 * j), sc = *((const f32x4*)(md + 1024) + F.lane + 64 * j);
            const f32x4 o = v[j] * rstd * (sc + 1.f) + sh; u32x2 w; w.x = pk2(o[0], o[1]); w.y = pk2(o[2], o[3]); op[64 * j] = w; }
    }
}

__device__ __forceinline__ void p_attn_simple(Frame& F) {
    LAS float* sq = (LAS float*)(F.lds + F.wave * 4096);
    LAS float* sp = sq + 64;
    const int gw = F.vcu * 8 + F.wave, NGW = F.G * 8;
    for (int gid = gw; gid < M * NH; gid += NGW) {
        const int h = gid & 7, tok = gid >> 3, b = tok >> 13, t = tok & (S - 1), r = t >> 6, c = t & 63;
        const int rs = min(max(r - KH / 2, 0), ROWS - KH), cs = min(max(c - KW / 2, 0), GW - KW);
        sq[F.lane] = bf2f(F.proj[(size_t)tok * DIN + h * 64 + F.lane]);
        LDS_WAIT(); asm volatile("" ::: "memory");
        float sc[6]; float mx = -1e30f;
#pragma unroll
        for (int i = 0; i < 6; ++i) {
            const int kk = F.lane + 64 * i;
            const bf16_t* kp; float bias = 0.f;
            if (kk < 128) { const int ki = kk >> 4, kj = kk & 15;
                kp = F.proj + (size_t)(b * S + (rs + ki) * GW + cs + kj) * DIN + 512 + h * 64;
                bias = F.rpb[(h * 15 + (rs + ki - r + 7)) * 31 + (cs + kj - c + 15)];
            } else kp = F.proj + (size_t)(M + b * CTX + (kk - 128)) * DIN + 512 + h * 64;
            float d = 0.f;
#pragma unroll
            for (int dd = 0; dd < 64; dd += 8) { const u32x4 kv = *(const u32x4*)(kp + dd);
                d += sq[dd] * bflo(kv.x) + sq[dd + 1] * bfhi(kv.x) + sq[dd + 2] * bflo(kv.y) + sq[dd + 3] * bfhi(kv.y) + sq[dd + 4] * bflo(kv.z) + sq[dd + 5] * bfhi(kv.z) + sq[dd + 6] * bflo(kv.w) + sq[dd + 7] * bfhi(kv.w); }
            sc[i] = d * 0.125f + bias; mx = fmaxf(mx, sc[i]);
        }
        mx = wmax(mx);
        float sum = 0.f;
#pragma unroll
        for (int i = 0; i < 6; ++i) { const float p = __expf(sc[i] - mx); sum += p; sp[F.lane + 64 * i] = p; }
        sum = wsum(sum);
        LDS_WAIT(); asm volatile("" ::: "memory");
        float acc = 0.f;
        for (int kk = 0; kk < 384; ++kk) {
            const bf16_t* vp;
            if (kk < 128) { const int ki = kk >> 4, kj = kk & 15; vp = F.proj + (size_t)(b * S + (rs + ki) * GW + cs + kj) * DIN + 1024 + h * 64; }
            else vp = F.proj + (size_t)(M + b * CTX + (kk - 128)) * DIN + 1024 + h * 64;
            acc += sp[kk] * bf2f(vp[F.lane]);
        }
        F.mixin[(size_t)tok * D + h * 64 + F.lane] = (bf16_t)f2bf(acc / sum);
        LDS_WAIT(); asm volatile("" ::: "memory");
    }
}
__device__ __forceinline__ void p_sgu_simple(Frame& F) {
    LAS bf16_t* G = (LAS bf16_t*)F.lds;
    for (int u = blockIdx.x; u < M / 128; u += F.G) {
        const int base = u * 128;
        for (int tl = F.wave; tl < 128; tl += 8) {
            const bf16_t* zr = F.proj + (size_t)(base + tl) * DIN + 2048 + F.lane * 8;
            const u32x4 zv = *(const u32x4*)zr;
            float v[8] = {bflo(zv.x), bfhi(zv.x), bflo(zv.y), bfhi(zv.y), bflo(zv.z), bfhi(zv.z), bflo(zv.w), bfhi(zv.w)};
            float s = 0.f;
#pragma unroll
            for (int i = 0; i < 8; ++i) s += v[i];
            const float mean = wsum(s) * (1.f / 512.f); float q = 0.f;
#pragma unroll
            for (int i = 0; i < 8; ++i) { v[i] -= mean; q += v[i] * v[i]; }
            const float rstd = rsqrtf(wsum(q) * (1.f / 512.f) + EPS);
#pragma unroll
            for (int i = 0; i < 8; ++i) { const int ch = F.lane * 8 + i; G[tl * 512 + ch] = (bf16_t)f2bf(v[i] * rstd * F.sgu_ln_g[ch] + F.sgu_ln_b[ch]); }
        }
        __syncthreads();
        const int ch = F.tid, grp = ch >> 7;
        for (int i = 0; i < 128; ++i) {
            const float* wrow = F.sgu_w + (size_t)(grp * 128 + i) * 128;
            float acc = 0.f;
            for (int j = 0; j < 128; ++j) acc += wrow[j] * bf2f(G[j * 512 + ch]);
            acc += F.sgu_b[grp * 128 + i];
            const float uu = bf2f(F.proj[(size_t)(base + i) * DIN + 1536 + ch]);
            F.mixin[(size_t)(base + i) * D + 512 + ch] = (bf16_t)f2bf(uu * acc);
        }
        __syncthreads();
    }
}

namespace at {
typedef float f32x16 __attribute__((ext_vector_type(16)));
typedef short s16x4 __attribute__((ext_vector_type(4)));
typedef short v4i16_t __attribute__((ext_vector_type(4)));
constexpr int A_K = 0, A_V = 32768, A_STG = 65536, A_WSF = 98304, A_RPB = 100352;
constexpr float C2 = 0.125f * 1.4426950408889634f, L2E = 1.4426950408889634f;
__device__ __forceinline__ int crow(int r, int hi) { return (r & 3) + 8 * (r >> 2) + 4 * hi; }
__device__ __forceinline__ s16x4 vtr(const LAS unsigned char* p) { return __builtin_bit_cast(s16x4, __builtin_amdgcn_ds_read_tr16_b64_v4i16((LAS v4i16_t*)p)); }
__device__ __forceinline__ int rsf(int r) { return min(max(r - KH / 2, 0), ROWS - KH); }
#define AT_WAIT_BAR() asm volatile("s_waitcnt vmcnt(0) lgkmcnt(0)\n\ts_barrier" ::: "memory")
__device__ __forceinline__ void glds16(const void* gsrc, unsigned lds_dst) { unsigned keep;
    asm volatile("s_mov_b32 %0, m0\n\ts_mov_b32 m0, %2\n\ts_nop 0\n\tglobal_load_lds_dwordx4 %1, off\n\ts_mov_b32 m0, %0" : "=&s"(keep) : "v"(gsrc), "s"(lds_dst) : "memory"); }

template <int MODE> __device__ __forceinline__ constexpr bool act0(int rr) { return MODE != 2 || rr >= 12; }
template <int MODE> __device__ __forceinline__ constexpr bool act1(int rr) { return MODE != 1 || rr < 4; }
template <int MODE>
__device__ __forceinline__ void tile_compute(const LAS unsigned char* kp0, const LAS unsigned char* vp, const LAS float* tb, const bf16x8 (&qr)[4], f32x16 (&o)[2], float& m, float& l,
                                             LAS float* wsf, int r32, int hi, int cs) {
    f32x16 p0, p1;
#pragma unroll
    for (int i = 0; i < 16; ++i) { p0[i] = 0.f; p1[i] = 0.f; }
#pragma unroll
    for (int d0 = 0; d0 < 4; ++d0) {
        const bf16x8 b0 = *(const LAS bf16x8*)(kp0 + d0 * 2048), b1 = *(const LAS bf16x8*)(kp0 + d0 * 2048 + 512);
        p0 = __builtin_amdgcn_mfma_f32_32x32x16_bf16(b0, qr[d0], p0, 0, 0, 0);
        p1 = __builtin_amdgcn_mfma_f32_32x32x16_bf16(b1, qr[d0], p1, 0, 0, 0);
    }
    float tm = -INFINITY;
#pragma unroll
    for (int rr = 0; rr < 16; ++rr) { const int ko = (rr & 3) + 8 * (rr >> 2), kc = ko + 4 * hi;
        if (MODE == 0) { p0[rr] *= C2; p1[rr] *= C2; tm = fmaxf(tm, fmaxf(p0[rr], p1[rr])); }
        else {
            if (act0<MODE>(rr)) { const float t0 = p0[rr] * C2 + tb[ko]; p0[rr] = (unsigned)(kc - cs) < (unsigned)KW ? t0 : -INFINITY; tm = fmaxf(tm, p0[rr]); }
            if (act1<MODE>(rr)) { const float t1 = p1[rr] * C2 + tb[ko + 32]; p1[rr] = (unsigned)(kc + 32 - cs) < (unsigned)KW ? t1 : -INFINITY; tm = fmaxf(tm, p1[rr]); }
        } }
    { float a = tm, bq = tm; asm volatile("s_nop 1\n\tv_permlane32_swap_b32 %0, %1" : "+v"(a), "+v"(bq)); tm = fmaxf(a, bq); }
    const float mn = fmaxf(m, tm), alpha = __builtin_amdgcn_exp2f(m - mn);
    float rsum = 0.f;
#pragma unroll
    for (int rr = 0; rr < 16; ++rr) {
        if (act0<MODE>(rr)) { p0[rr] = __builtin_amdgcn_exp2f(p0[rr] - mn); rsum += p0[rr]; } else p0[rr] = 0.f;
        if (act1<MODE>(rr)) { p1[rr] = __builtin_amdgcn_exp2f(p1[rr] - mn); rsum += p1[rr]; } else p1[rr] = 0.f; }
    l = l * alpha + rsum; m = mn;
    if (__any(alpha != 1.f)) {
        if (hi == 0) wsf[r32] = alpha;
        LDS_WAIT();
#pragma unroll
        for (int rr = 0; rr < 16; ++rr) { const float a = wsf[crow(rr, hi)]; o[0][rr] *= a; o[1][rr] *= a; }
        LDS_WAIT();
    }
    u32x4 pw[4];
#pragma unroll
    for (int q = 0; q < 4; ++q) { pw[0][q] = cvt_pk_bf16(p0[2 * q], p0[2 * q + 1]); pw[1][q] = cvt_pk_bf16(p0[8 + 2 * q], p0[9 + 2 * q]);
                                  pw[2][q] = cvt_pk_bf16(p1[2 * q], p1[2 * q + 1]); pw[3][q] = cvt_pk_bf16(p1[8 + 2 * q], p1[9 + 2 * q]); }
#pragma unroll
    for (int d0 = 0; d0 < 2; ++d0)
#pragma unroll
        for (int ks = 0; ks < 4; ++ks) {
            if ((MODE == 1 && ks == 3) || (MODE == 2 && ks == 0)) continue;
            const s16x4 lo = vtr(vp + d0 * 4096 + ks * 1024), hh = vtr(vp + d0 * 4096 + ks * 1024 + 512);
            const bf16x8 vf = (bf16x8){lo[0], lo[1], lo[2], lo[3], hh[0], hh[1], hh[2], hh[3]};
            o[d0] = __builtin_amdgcn_mfma_f32_32x32x16_bf16(__builtin_bit_cast(bf16x8, pw[ks]), vf, o[d0], 0, 0, 0);
        }
}

__device__ __forceinline__ void attn_unit(Frame& F, int b, int h, int rg) {
    const int lane = F.lane, r32 = lane & 31, hi = lane >> 5, w = F.wave;
    const int r0 = 4 * rg, r = r0 + (w >> 1), c = 32 * (w & 1) + r32;
    const int krlo = rsf(r0), nnb = rsf(r0 + 3) + 7 - krlo + 1, nst = nnb + 4;
    const int rsw = rsf(r), cs = min(max(c - KW / 2, 0), GW - KW);
    LAS float* tbl = (LAS float*)(F.lds + A_RPB);
    LAS float* wsf = (LAS float*)(F.lds + A_WSF) + w * 64;
    for (int i = F.tid; i < 480; i += 512) { const int dr = i >> 5, dc = i & 31; tbl[64 + i] = dc < 31 ? F.rpb[(h * 15 + dr) * 31 + dc] * L2E : 0.f; }
    const bf16_t* qp = F.proj + (size_t)(b * S + r * GW + c) * DIN + h * 64 + hi * 8;
    bf16x8 qr[4];
#pragma unroll
    for (int d0 = 0; d0 < 4; ++d0) qr[d0] = *(const bf16x8*)(qp + d0 * 16);
    const bf16_t* kbase = F.proj + 512 + h * 64 + w * 8;
    const bf16_t* vbase = F.proj + 1024 + h * 64 + (w >> 2) * 32 + (lane & 3) * 8;
#define AT_DMA(st) do { const int _t0 = (st) < nnb ? b * S + (krlo + (st)) * GW : M + b * CTX + ((st) - nnb) * 64; const int _bf = ((st) & 3) * 8192; \
        __builtin_amdgcn_global_load_lds((const unsigned*)(kbase + (size_t)(_t0 + lane) * DIN), (LAS unsigned*)(F.lds + A_K + _bf + w * 1024), 16, 0, 0); \
        __builtin_amdgcn_global_load_lds((const unsigned*)(vbase + (size_t)(_t0 + 16 * (w & 3) + (lane >> 2)) * DIN), (LAS unsigned*)(F.lds + A_V + _bf + w * 1024), 16, 0, 0); } while (0)
    const unsigned lds0 = (unsigned)(size_t)F.lds;
    float m = -1e30f, l = 0.f;
    f32x16 o[2];
#pragma unroll
    for (int i = 0; i < 16; ++i) { o[0][i] = 0.f; o[1][i] = 0.f; }
    AT_DMA(0); AT_DMA(1); AT_DMA(2);
    for (int st = 0; st < nst; ++st) {
        if (st + 2 < nst) asm volatile("s_waitcnt vmcnt(4) lgkmcnt(0)\n\ts_barrier" ::: "memory");
        else if (st + 1 < nst) asm volatile("s_waitcnt vmcnt(2) lgkmcnt(0)\n\ts_barrier" ::: "memory");
        else AT_WAIT_BAR();
        if (st + 3 < nst) AT_DMA(st + 3);
        const bool isnb = st < nnb; const int kr = krlo + st;
        const bool act = !isnb || (kr >= rsw && kr < rsw + KH);
        if (act) {
            const LAS unsigned char* kp0 = F.lds + A_K + (st & 3) * 8192 + hi * 1024 + r32 * 16;
            const LAS unsigned char* vp = F.lds + A_V + (st & 3) * 8192 + ((lane >> 4) & 1) * 32 + (lane & 3) * 8 + (4 * hi + ((lane & 15) >> 2)) * 64;
            const LAS float* tb = tbl + 64 + (kr - r + 7) * 32 + 4 * hi - c + 15;
            if (!isnb) tile_compute<0>(kp0, vp, tb, qr, o, m, l, wsf, r32, hi, cs);
            else if ((w & 1) == 0) tile_compute<1>(kp0, vp, tb, qr, o, m, l, wsf, r32, hi, cs);
            else tile_compute<2>(kp0, vp, tb, qr, o, m, l, wsf, r32, hi, cs);
        }
    }
#undef AT_DMA
    l += __shfl_xor(l, 32);
    if (hi == 0) wsf[32 + r32] = l;
    LDS_WAIT();
    LAS bf16_t* stg = (LAS bf16_t*)(F.lds + A_STG) + w * 2048;
#pragma unroll
    for (int rr = 0; rr < 16; ++rr) { const int orow = crow(rr, hi); const float rl = __builtin_amdgcn_rcpf(wsf[32 + orow]);
        stg[orow * 64 + r32] = (bf16_t)f2bf(o[0][rr] * rl); stg[orow * 64 + 32 + r32] = (bf16_t)f2bf(o[1][rr] * rl); }
    LDS_WAIT();
    bf16_t* ow = F.mixin + (size_t)(b * S + r * GW + 32 * (w & 1)) * D + h * 64;
#pragma unroll
    for (int i = 0; i < 4; ++i) { const int row = i * 8 + (lane >> 3), ch = lane & 7; const u32x4 v = *(const LAS u32x4*)(stg + row * 64 + ch * 8); *(u32x4*)(ow + (size_t)row * D + ch * 8) = v; }
    AT_WAIT_BAR();
}

constexpr int G_IMG = 0, G_STG = 65536, G_STAT = 98304;
__device__ __forceinline__ void sgu_unit(Frame& F, int chunk, int gh) {
    const int lane = F.lane, r32 = lane & 31, hi = lane >> 5, w = F.wave;
    const int base = chunk * 128;
    LAS f32x2* stat = (LAS f32x2*)(F.lds + G_STAT);
    u32x4 zrow[16];
#pragma unroll
    for (int t = 0; t < 16; ++t) zrow[t] = *(const u32x4*)(F.proj + (size_t)(base + 16 * w + t) * DIN + 2048 + lane * 8);
    const int cb = w & 3, th = w >> 2, grp = 2 * gh + (cb >> 1);
    const bf16_t* wp = F.sguw + (size_t)(grp * 128 + 64 * th + r32) * 128 + 8 * hi;
    bf16x8 wf0[8], wf1[8];
#pragma unroll
    for (int ks = 0; ks < 8; ++ks) { wf0[ks] = *(const bf16x8*)(wp + ks * 16); wf1[ks] = *(const bf16x8*)(wp + 32 * 128 + ks * 16); }
#pragma unroll
    for (int t = 0; t < 16; ++t) {
        const int tok = 16 * w + t;
        const u32x4 zv = zrow[t];
        float v[8] = {bflo(zv.x), bfhi(zv.x), bflo(zv.y), bfhi(zv.y), bflo(zv.z), bfhi(zv.z), bflo(zv.w), bfhi(zv.w)};
        float s = 0.f;
#pragma unroll
        for (int i = 0; i < 8; ++i) s += v[i];
        const float mean = wsum(s) * (1.f / 512.f); float q = 0.f;
#pragma unroll
        for (int i = 0; i < 8; ++i) { const float d = v[i] - mean; q += d * d; }
        const float rstd = rsqrtf(wsum(q) * (1.f / 512.f) + EPS);
        if (lane == 0) stat[tok] = (f32x2){mean, rstd};
    }
    AT_WAIT_BAR();
    {
        const int ch0 = 256 * gh + 32 * w + 8 * (lane & 3);
        const f32x4 g0 = *(const f32x4*)(F.sgu_ln_g + ch0), g1 = *(const f32x4*)(F.sgu_ln_g + ch0 + 4), b0 = *(const f32x4*)(F.sgu_ln_b + ch0), b1 = *(const f32x4*)(F.sgu_ln_b + ch0 + 4);
#pragma unroll
        for (int i = 0; i < 8; ++i) {
            const int tok = 16 * i + (lane >> 2);
            const u32x4 zv = *(const u32x4*)(F.proj + (size_t)(base + tok) * DIN + 2048 + ch0);
            const f32x2 st = stat[tok];
            u32x4 o;
            o.x = pk2((bflo(zv.x) - st[0]) * st[1] * g0[0] + b0[0], (bfhi(zv.x) - st[0]) * st[1] * g0[1] + b0[1]);
            o.y = pk2((bflo(zv.y) - st[0]) * st[1] * g0[2] + b0[2], (bfhi(zv.y) - st[0]) * st[1] * g0[3] + b0[3]);
            o.z = pk2((bflo(zv.z) - st[0]) * st[1] * g1[0] + b1[0], (bfhi(zv.z) - st[0]) * st[1] * g1[1] + b1[1]);
            o.w = pk2((bflo(zv.w) - st[0]) * st[1] * g1[2] + b1[2], (bfhi(zv.w) - st[0]) * st[1] * g1[3] + b1[3]);
            *(LAS u32x4*)(F.lds + G_IMG + w * 8192 + i * 1024 + lane * 16) = o;
        }
    }
    AT_WAIT_BAR();
    f32x16 acc[2][2];
#pragma unroll
    for (int a = 0; a < 2; ++a)
#pragma unroll
        for (int q = 0; q < 2; ++q)
#pragma unroll
            for (int i = 0; i < 16; ++i) acc[a][q][i] = 0.f;
    const LAS unsigned char* gp = F.lds + G_IMG + (2 * cb) * 8192 + ((lane >> 4) & 1) * 32 + (lane & 3) * 8 + (8 * hi + ((lane & 15) >> 2)) * 64;
#pragma unroll
    for (int ks = 0; ks < 8; ++ks) {
        const bf16x8 w0 = wf0[ks], w1 = wf1[ks];
#pragma unroll
        for (int c32 = 0; c32 < 2; ++c32) {
            const s16x4 lo = vtr(gp + c32 * 8192 + ks * 1024), hh = vtr(gp + c32 * 8192 + ks * 1024 + 256);
            const bf16x8 gf = (bf16x8){lo[0], lo[1], lo[2], lo[3], hh[0], hh[1], hh[2], hh[3]};
            acc[0][c32] = __builtin_amdgcn_mfma_f32_32x32x16_bf16(gf, w0, acc[0][c32], 0, 0, 0);
            acc[1][c32] = __builtin_amdgcn_mfma_f32_32x32x16_bf16(gf, w1, acc[1][c32], 0, 0, 0);
        }
    }
    LAS unsigned char* stg = F.lds + G_STG + w * 4096;
#pragma unroll
    for (int ib = 0; ib < 2; ++ib) {
        const int i0 = 64 * th + 32 * ib;
        const float bi = F.sgu_b[grp * 128 + i0 + r32];
#pragma unroll
        for (int c32 = 0; c32 < 2; ++c32)
#pragma unroll
            for (int a = 0; a < 4; ++a) { u32x2 o; o.x = pk2(acc[ib][c32][4 * a] + bi, acc[ib][c32][4 * a + 1] + bi); o.y = pk2(acc[ib][c32][4 * a + 2] + bi, acc[ib][c32][4 * a + 3] + bi);
                *(LAS u32x2*)(stg + r32 * 128 + (((4 * c32 + a) ^ (r32 & 7)) << 4) + hi * 8) = o; }
        LDS_WAIT();
#pragma unroll
        for (int it = 0; it < 4; ++it) {
            const int row = 8 * it + (lane >> 3), chn = lane & 7;
            const u32x4 v = *(const LAS u32x4*)(stg + row * 128 + ((chn ^ (row & 7)) << 4));
            const size_t tok = (size_t)(base + i0 + row);
            const u32x4 uv = *(const u32x4*)(F.proj + tok * DIN + 1536 + 256 * gh + 64 * cb + 8 * chn);
            u32x4 o;
            o.x = pk2(bflo(v.x) * bflo(uv.x), bfhi(v.x) * bfhi(uv.x)); o.y = pk2(bflo(v.y) * bflo(uv.y), bfhi(v.y) * bfhi(uv.y));
            o.z = pk2(bflo(v.z) * bflo(uv.z), bfhi(v.z) * bfhi(uv.z)); o.w = pk2(bflo(v.w) * bflo(uv.w), bfhi(v.w) * bfhi(uv.w));
            *(u32x4*)(F.mixin + tok * D + 512 + 256 * gh + 64 * cb + 8 * chn) = o;
        }
        LDS_WAIT();
    }
    AT_WAIT_BAR();
}
__device__ __forceinline__ void p_mixer(Frame& F) {
#ifndef PROBE_MIX_A
#define PROBE_MIX_A 1
#endif
#ifndef PROBE_MIX_S
#define PROBE_MIX_S 1
#endif
#pragma unroll 1
    for (int rep = 0; rep < PROBE_MIX_A; ++rep)
    for (int uid = F.vcu; uid < NB * NH * 32; uid += F.G) attn_unit(F, uid >> 8, (uid >> 5) & 7, uid & 31);
#pragma unroll 1
    for (int rep = 0; rep < PROBE_MIX_S; ++rep)
    for (int uid = F.vcu; uid < (M / 128) * 2; uid += F.G) sgu_unit(F, uid >> 1, uid & 1);
}
#undef AT_WAIT_BAR
}

__device__ __forceinline__ void route_select(Frame& F, float lgt, int e, int lane, int tl, int tok, LAS int* lcnt, LAS int* sel, LAS float* selg) {
    int rank = 0; float mx = -3.0e38f;
#pragma unroll
    for (int e2 = 0; e2 < NE; ++e2) { const float o = rlane(lgt, ((e2 >> 4) << 5) | (((e2 >> 3) & 1) << 4) | (e2 & 7));
        rank += (o > lgt || (o == lgt && e2 < e)) ? 1 : 0; mx = fmaxf(mx, o); }
    const bool selq = rank < TOPK && !(lane & 8);
    const float pe = selq ? __expf(lgt - mx) : 0.f;
    const float den = wsum(pe);
    if (selq) {
        const int lp = __hip_atomic_fetch_add(lcnt + e, 1, __ATOMIC_RELAXED, __HIP_MEMORY_SCOPE_WORKGROUP);
        sel[tl * 4 + rank] = e | (lp << 8); selg[tl * 4 + rank] = pe / den;
        F.topg[tok * 4 + rank] = pe / den; F.topi[tok * 4 + rank] = e;
    }
}
__device__ __forceinline__ float route_reduce(const f32x2 (&lg2)[NE / 2], int lane) {
    float r16[16], r8[8];
#pragma unroll
    for (int e = 0; e < 16; ++e) { float a = lg2[e >> 1][e & 1], bq = lg2[(e + 16) >> 1][e & 1]; asm volatile("s_nop 1\n\tv_permlane32_swap_b32 %0, %1" : "+v"(a), "+v"(bq)); r16[e] = a + bq; }
#pragma unroll
    for (int e = 0; e < 8; ++e) { float a = r16[e], bq = r16[e + 8]; asm volatile("s_nop 1\n\tv_permlane16_swap_b32 %0, %1" : "+v"(a), "+v"(bq)); r8[e] = a + bq; }
    float r1 = 0.f;
#pragma unroll
    for (int e = 0; e < 8; ++e) { float t = r8[e]; t += dppf<0xB1>(t); t += dppf<0x4E>(t); t += dppf<0x141>(t); t += dppf<0x140>(t); r1 = ((lane & 7) == e) ? t : r1; }
    return r1;
}
__device__ __forceinline__ void p_route(Frame& F) {
    LAS int* lcnt = (LAS int*)(F.lds + L_ROUTE); LAS int* gbase = lcnt + 32; LAS int* sel = lcnt + 64; LAS float* selg = (LAS float*)(F.lds + L_RPB);
    for (int i = F.tid; i < 8192; i += 512) { const int c = i >> 3, q = i & 7; *(LAS f32x4*)(F.lds + c * 128 + ((q ^ ((c >> 1) & 7)) << 4)) = *(const f32x4*)(F.router_w + c * 32 + q * 4); }
    if (F.tid < 32) lcnt[F.tid] = 0;
    __syncthreads();
    const int lane = F.lane;
    const LAS unsigned char* wbase = F.lds + lane * 128;
    const int sw = (lane >> 1) & 7;
    LAS unsigned char* hrowA = F.lds + L_WSCR + F.wave * 2048; LAS unsigned char* hrowB = hrowA + 1024;
    const int e = ((lane >> 5) << 4) | (((lane >> 4) & 1) << 3) | (lane & 7);
    const float rbias = F.router_b[e];
    for (int tb = blockIdx.x; tb < M / 64; tb += F.G) {
        const int b = (tb * 64) >> 13;
        float ps[16], ph[16];
#pragma unroll
        for (int i = 0; i < 16; ++i) { const int col = lane + 64 * i; ps[i] = 1.f + F.mod[b * 6144 + 4 * 1024 + col]; ph[i] = F.mod[b * 6144 + 3 * 1024 + col]; }
#pragma unroll 1
        for (int k = 0; k < 4; ++k) {
            const int tlA = F.wave + 8 * k, tlB = tlA + 32, tokA = tb * 64 + tlA, tokB = tb * 64 + tlB;
            float vA[16], vB[16]; float sA = 0.f, sB = 0.f;
            float pg[16], pb[16];
#pragma unroll
            for (int i = 0; i < 16; ++i) { pg[i] = F.ln1_g[lane + 64 * i]; pb[i] = F.ln1_b[lane + 64 * i]; }
            { const bf16_t* ya = F.y1 + (size_t)tokA * D; const bf16_t* yb = F.y1 + (size_t)tokB * D;
#pragma unroll
              for (int i = 0; i < 16; ++i) { vA[i] = bf2f(ya[lane + 64 * i]); vB[i] = bf2f(yb[lane + 64 * i]); }
#pragma unroll
              for (int i = 0; i < 16; ++i) { sA += vA[i]; sB += vB[i]; } }
            float meanA = wsum(sA) * (1.f / D), meanB = wsum(sB) * (1.f / D), qA = 0.f, qB = 0.f;
#pragma unroll
            for (int i = 0; i < 16; ++i) { vA[i] -= meanA; qA += vA[i] * vA[i]; vB[i] -= meanB; qB += vB[i] * vB[i]; }
            float rstdA = rsqrtf(wsum(qA) * (1.f / D) + EPS), rstdB = rsqrtf(wsum(qB) * (1.f / D) + EPS);
            if (lane == 0) { F.stat[tokA] = (f32x2){meanA, rstdA}; F.stat[tokB] = (f32x2){meanB, rstdB}; }
            sA = 0.f; sB = 0.f;
#pragma unroll
            for (int i = 0; i < 16; ++i) { vA[i] = vA[i] * rstdA * pg[i] + pb[i]; sA += vA[i]; vB[i] = vB[i] * rstdB * pg[i] + pb[i]; sB += vB[i]; }
#ifdef MK_WRITE_X1
#pragma unroll
            for (int i = 0; i < 16; ++i) { F.x1[(size_t)tokA * D + lane + 64 * i] = vA[i]; F.x1[(size_t)tokB * D + lane + 64 * i] = vB[i]; }
#endif
            meanA = wsum(sA) * (1.f / D); meanB = wsum(sB) * (1.f / D); qA = 0.f; qB = 0.f;
#pragma unroll
            for (int i = 0; i < 16; ++i) { vA[i] -= meanA; qA += vA[i] * vA[i]; vB[i] -= meanB; qB += vB[i] * vB[i]; }
            rstdA = rsqrtf(wsum(qA) * (1.f / D) + EPS); rstdB = rsqrtf(wsum(qB) * (1.f / D) + EPS);
#pragma unroll
            for (int i = 0; i < 16; ++i) { vA[i] = vA[i] * rstdA * ps[i] + ph[i]; vB[i] = vB[i] * rstdB * ps[i] + ph[i];
                hrowA[lane + 64 * i] = (unsigned char)__builtin_amdgcn_cvt_pk_fp8_f32(vA[i], vA[i], 0, false); hrowB[lane + 64 * i] = (unsigned char)__builtin_amdgcn_cvt_pk_fp8_f32(vB[i], vB[i], 0, false); }
            f32x2 lgA[NE / 2], lgB[NE / 2];
#pragma unroll
            for (int q = 0; q < NE / 2; ++q) { lgA[q] = (f32x2){0.f, 0.f}; lgB[q] = (f32x2){0.f, 0.f}; }
#pragma unroll
            for (int i = 0; i < 16; ++i) {
                f32x4 wa[8];
#pragma unroll
                for (int qq = 0; qq < 8; ++qq) wa[qq] = *(const LAS f32x4*)(wbase + i * 8192 + ((qq ^ sw) << 4));
                __builtin_amdgcn_sched_barrier(0);
                const f32x2 ha = (f32x2){vA[i], vA[i]}, hb = (f32x2){vB[i], vB[i]};
#pragma unroll
                for (int qq = 0; qq < 8; ++qq) { const f32x2 w0 = (f32x2){wa[qq][0], wa[qq][1]}, w1 = (f32x2){wa[qq][2], wa[qq][3]};
                    lgA[2 * qq] = __builtin_elementwise_fma(ha, w0, lgA[2 * qq]); lgA[2 * qq + 1] = __builtin_elementwise_fma(ha, w1, lgA[2 * qq + 1]);
                    lgB[2 * qq] = __builtin_elementwise_fma(hb, w0, lgB[2 * qq]); lgB[2 * qq + 1] = __builtin_elementwise_fma(hb, w1, lgB[2 * qq + 1]); }
                __builtin_amdgcn_sched_barrier(0);
            }
            LDS_WAIT();
            *(u32x4*)(F.h2 + (size_t)tokA * D + lane * 16) = *(const LAS u32x4*)(hrowA + lane * 16);
            *(u32x4*)(F.h2 + (size_t)tokB * D + lane * 16) = *(const LAS u32x4*)(hrowB + lane * 16);
            const float lgtA = route_reduce(lgA, lane) + rbias, lgtB = route_reduce(lgB, lane) + rbias;
            route_select(F, lgtA, e, lane, tlA, tokA, lcnt, sel, selg);
            route_select(F, lgtB, e, lane, tlB, tokB, lcnt, sel, selg);
        }
        __syncthreads();
        if (F.tid < 32) { const int n = lcnt[F.tid]; gbase[F.tid] = n ? (int)__hip_atomic_fetch_add(F.cntw + 32 * F.tid, (unsigned)n, __ATOMIC_RELAXED, __HIP_MEMORY_SCOPE_AGENT) : 0; lcnt[F.tid] = 0; }
        __syncthreads();
        if (F.tid < 256) { const int sv = sel[F.tid], ee = sv & 255, lp = sv >> 8; F.list[(size_t)ee * LCAP + gbase[ee] + lp] = (tb * 64 + (F.tid >> 2)) * 4 + (F.tid & 3); F.listg[(size_t)ee * LCAP + gbase[ee] + lp] = selg[F.tid]; }
        __syncthreads();
    }
}

__device__ __forceinline__ void p_final(Frame& F) {
    const int gw = F.vcu * 8 + F.wave, NGW = F.G * 8;
    for (int tok = gw; tok < M; tok += NGW) {
        const float* g2 = F.mod + (tok >> 13) * 6144 + 5 * 1024;
        const u32x2* xp = (const u32x2*)(F.y1 + (size_t)tok * D) + F.lane;
        const f32x2 st = F.stat[tok];
        f32x4 v[4]; float s = 0.f;
#pragma unroll
        for (int j = 0; j < 4; ++j) {
            f32x4 f = (f32x4){0.f, 0.f, 0.f, 0.f};
#pragma unroll
            for (int k = 0; k < TOPK; ++k) { const u32x2 yv = *((const u32x2*)(F.ybuf + (size_t)(tok * 4 + k) * D) + F.lane + 64 * j);
                f[0] += bflo(yv.x); f[1] += bfhi(yv.x); f[2] += bflo(yv.y); f[3] += bfhi(yv.y); }
            const f32x4 gv = *((const f32x4*)g2 + F.lane + 64 * j);
            const f32x4 l1g = *((const f32x4*)F.ln1_g + F.lane + 64 * j), l1b = *((const f32x4*)F.ln1_b + F.lane + 64 * j);
            const u32x2 yw = xp[64 * j]; const f32x4 yv = (f32x4){bflo(yw.x), bfhi(yw.x), bflo(yw.y), bfhi(yw.y)};
            const f32x4 x1v = (yv - st[0]) * st[1] * l1g + l1b;
            v[j] = x1v * DN_ALPHA + gv * f; s += (v[j][0] + v[j][1]) + (v[j][2] + v[j][3]);
        }
        const float mean = wsum(s) * (1.f / D); float q = 0.f;
#pragma unroll
        for (int j = 0; j < 4; ++j) { v[j] = v[j] - mean; q += (v[j][0] * v[j][0] + v[j][1] * v[j][1]) + (v[j][2] * v[j][2] + v[j][3] * v[j][3]); }
        const float rstd = rsqrtf(wsum(q) * (1.f / D) + EPS);
        f32x4* op = (f32x4*)(F.out + (size_t)tok * D) + F.lane;
#pragma unroll
        for (int j = 0; j < 4; ++j) { const f32x4 gg = *((const f32x4*)F.ln2_g + F.lane + 64 * j), bb = *((const f32x4*)F.ln2_b + F.lane + 64 * j); op[64 * j] = v[j] * rstd * gg + bb; }
    }
}

struct Args { const float* in[23]; float* out; unsigned char* ws; int ph_lo, ph_hi, alt, pad; };
constexpr int N_PHASES = 9;
__global__ void __launch_bounds__(512, 2) mk_fwd(Args args) {
    extern __shared__ __attribute__((aligned(16))) unsigned char lds_raw[];
    Frame F;
    F.lds = (LAS unsigned char*)lds_raw;
    F.MISC = (volatile LAS unsigned*)(F.lds + L_MISC);
    F.tid = threadIdx.x; F.lane = F.tid & 63; F.wave = __builtin_amdgcn_readfirstlane(F.tid >> 6);
    F.G = gridDim.x; { const int bx = blockIdx.x; F.vcu = (F.G % 8 == 0) ? (bx % 8) * (F.G / 8) + bx / 8 : bx; }
    unsigned char* ws = args.ws;
    F.ctl = (unsigned*)(ws + WS_CTL);
    F.x = args.in[0]; F.c = args.in[1]; F.ctx = args.in[2]; F.c_ctx = args.in[3]; F.ada_w = args.in[4]; F.ada_b = args.in[5]; F.w_in = args.in[6]; F.rpb = args.in[7];
    F.sgu_ln_g = args.in[8]; F.sgu_ln_b = args.in[9]; F.sgu_w = args.in[10]; F.sgu_b = args.in[11]; F.w_out = args.in[12]; F.ln1_g = args.in[13]; F.ln1_b = args.in[14];
    F.ln2_g = args.in[15]; F.ln2_b = args.in[16]; F.router_w = args.in[17]; F.router_b = args.in[18]; F.w_gu = args.in[19]; F.b_gu = args.in[20]; F.w_dn = args.in[21]; F.b_dn = args.in[22];
    F.out = args.out;
    F.mod = (float*)(ws + WS_MOD); F.topg = (float*)(ws + WS_TOPG); F.topi = (int*)(ws + WS_TOPI); F.list = (int*)(ws + WS_LIST); F.listg = (float*)(ws + WS_LISTG); F.sguw = (bf16_t*)(ws + WS_SGUW);
    F.Wt_in = (bf16_t*)(ws + WS_WIN); F.Wt_out = (bf16_t*)(ws + WS_WOUT); F.Wt_gu = ws + WS_WGU; F.Wt_dn = ws + WS_WDN;
    F.hxc = (bf16_t*)(ws + WS_HXC); F.proj = (bf16_t*)(ws + WS_PROJ); F.mixin = (bf16_t*)(ws + WS_MIXIN); F.y1 = (bf16_t*)(ws + WS_Y1); F.x1 = (float*)(ws + WS_X1); F.stat = (f32x2*)(ws + WS_STAT); F.cntw = F.ctl + CW_CNT; F.h2 = ws + WS_H2;
    F.act = ws + WS_ACT; F.ybuf = (bf16_t*)(ws + WS_YBUF);
    for (int u = F.tid; u < (LDS_BYTES - L_MISC) / 4; u += 512) ((LAS unsigned*)(F.lds + L_MISC))[u] = 0u;
    __syncthreads();
    if (args.alt) { F.x1 = (float*)(ws + WS_ALT); F.h2 = ws + WS_ALT + 64 * MiB; F.list = (int*)(ws + WS_ALT + 80 * MiB); F.listg = (float*)(ws + WS_ALT + 84 * MiB); F.topg = (float*)(ws + WS_ALT + 82 * MiB); F.topi = (int*)(ws + WS_ALT + 82 * MiB + 512 * 1024); F.cntw = F.ctl + CW_CNT_ALT; F.stat = (f32x2*)(ws + WS_ALT + 83 * MiB); }
    const int lo = args.ph_lo, hi = args.ph_hi;
    const bool one = (hi - lo) > 1;
    XcdBarrier bar; bar.bar = (unsigned*)(F.ctl + CW_BAR); bar.x = 0; bar.st = nullptr;
    if (one) bar = xcd_barrier_post((unsigned*)(F.ctl + CW_BAR), F.MISC + 8);
#define IN(k) (lo <= (k) && (k) < hi)
#define SEAM(k) do { if (IN(k) && IN((k) + 1)) xcd_barrier(bar); } while (0)
#ifndef PROBE_REPS
#define PROBE_REPS {1, 1, 1, 1, 1, 1, 1, 1, 1}
#endif
    constexpr int REPS[N_PHASES] = PROBE_REPS;
#define REPEAT(k) _Pragma("unroll") for (int rep_ = 0; rep_ < REPS[k]; ++rep_)
#define RSEAM(k) do { if (rep_ + 1 < REPS[k]) xcd_barrier(bar); else SEAM(k); } while (0)
    constexpr int W_ITEMS = 16 * 80 + 16 * 32 + NE * 16 * 64 + NE * 16 * 32, W_TAIL = 7680;
    const bool tail_wg = (F.G == 256 && (int)blockIdx.x >= 136);
    if (IN(0)) REPEAT(0) { p_ada(F); p_weights(F, 0, (F.G == 256) ? W_ITEMS - W_TAIL : W_ITEMS, F.vcu * 8 + F.wave, F.G * 8, true); RSEAM(0); }
    if (IN(1)) REPEAT(1) { p_lnmod(F); RSEAM(1); }
    if (IN(2)) REPEAT(2) { PolProj P{F.hxc, F.Wt_in, F.proj, F.G, (int)blockIdx.x}; pg8::gemm_phase<PolProj>(F.lds, P);
        if (tail_wg) p_weights(F, W_ITEMS - W_TAIL, W_TAIL, ((int)blockIdx.x - 136) * 8 + F.wave, 120 * 8, false); RSEAM(2); }
    if (IN(3)) REPEAT(3) { at::p_mixer(F); RSEAM(3); }
    if (IN(4)) REPEAT(4) { PolOut P{F.mixin, F.Wt_out, F.x, F.mod, F.y1, F.G, (int)blockIdx.x}; pg8::gemm_phase<PolOut>(F.lds, P); RSEAM(4); }
    if (IN(5)) { p_route(F); SEAM(5); }
    if (IN(6)) REPEAT(6) { const int T = expert_tables(F); ExpTab tb{(const LAS int*)(F.lds + L_TILEE), (const LAS int*)(F.lds + L_TSTART), (const LAS int*)(F.lds + L_TSTART) + 64, T};
        PolGU P{F.h2, F.Wt_gu, F.b_gu, F.list, F.act, tb, F.G, (int)blockIdx.x}; pg8::gemm_phase<PolGU>(F.lds, P); RSEAM(6); }
    if (IN(7)) REPEAT(7) { const int T = expert_tables(F); ExpTab tb{(const LAS int*)(F.lds + L_TILEE), (const LAS int*)(F.lds + L_TSTART), (const LAS int*)(F.lds + L_TSTART) + 64, T};
        PolDN P{F.act, F.Wt_dn, F.b_dn, F.list, F.listg, F.ybuf, tb, F.G, (int)blockIdx.x}; pg8::gemm_phase<PolDN>(F.lds, P); RSEAM(7); }
    if (IN(8)) REPEAT(8) { p_final(F); if (rep_ + 1 < REPS[8]) xcd_barrier(bar); }
#undef IN
#undef SEAM
#undef REPEAT
#undef RSEAM
}

static inline void launch_forward(void* const* d_in, void* d_out, void* d_ws, hipStream_t stream, int n_launches) {
    static int grid = 0;
    if (grid == 0) {
        int dev = 0, cus = 0;
        if (hipGetDevice(&dev) != hipSuccess || hipDeviceGetAttribute(&cus, hipDeviceAttributeMultiprocessorCount, dev) != hipSuccess) { fprintf(stderr, "kernel_launch: device query failed\n"); grid = -1; return; }
        if (hipFuncSetAttribute((const void*)mk_fwd, hipFuncAttributeMaxDynamicSharedMemorySize, LDS_BYTES) != hipSuccess) { fprintf(stderr, "kernel_launch: hipFuncSetAttribute failed\n"); grid = -1; return; }
        int per_cu = 0;
        if (hipOccupancyMaxActiveBlocksPerMultiprocessor(&per_cu, (const void*)mk_fwd, 512, LDS_BYTES) != hipSuccess || per_cu < 1) fprintf(stderr, "kernel_launch: occupancy query says %d\n", per_cu);
        (void)hipGetLastError();
        grid = cus;
    }
    if (grid < 0) return;
    (void)hipMemsetAsync((char*)d_ws + WS_CTL, 0, CTL_ZERO_BYTES, stream);
    Args a{};
    for (int i = 0; i < 23; ++i) a.in[i] = (const float*)d_in[i];
    a.out = (float*)d_out; a.ws = (unsigned char*)d_ws;
    if (n_launches == 1) { a.ph_lo = 0; a.ph_hi = N_PHASES; hipLaunchKernelGGL(mk_fwd, dim3(grid), dim3(512), LDS_BYTES, stream, a); }
    else for (int p = 0; p < N_PHASES; ++p) { a.ph_lo = p; a.ph_hi = p + 1; hipLaunchKernelGGL(mk_fwd, dim3(grid), dim3(512), LDS_BYTES, stream, a); }
#ifdef PROBE_EXTRA
    { const int extra[] = PROBE_EXTRA; for (int p : extra) { a.ph_lo = p; a.ph_hi = p + 1; a.alt = (p == 5); hipLaunchKernelGGL(mk_fwd, dim3(grid), dim3(512), LDS_BYTES, stream, a); } }
#endif
}
}
extern "C" void kernel_launch(void* const* d_in, const int* in_sizes, int n_in, void* d_out, int out_size, void* d_ws, size_t ws_size, hipStream_t stream) {
    if (ws_size < mk::WS_END || n_in != 23) { fprintf(stderr, "kernel_launch: unexpected workspace / inputs (%zu, %d)\n", ws_size, n_in); return; }
    mk::launch_forward(d_in, d_out, d_ws, stream, 1);
}
```

```cpp
#include <hip/hip_runtime.h>
#include <stdint.h>
#include <stdio.h>

#define GAS __attribute__((address_space(1)))
#define LAS __attribute__((address_space(3)))
typedef unsigned short bf16_t;
typedef short bf16x8 __attribute__((ext_vector_type(8)));
typedef float f32x4 __attribute__((ext_vector_type(4)));
typedef float f32x2 __attribute__((ext_vector_type(2)));
typedef unsigned u32x4 __attribute__((ext_vector_type(4)));
typedef unsigned u32x2 __attribute__((ext_vector_type(2)));

namespace mk {
constexpr int D = 1024, NB = 2, S = 8192, M = NB * S, GW = 64, ROWS = 128, CTX = 256, NH = 8, KH = 8, KW = 16;
constexpr int NE = 32, TOPK = 4, DFF = 1024, DIN = 2560, NPAIR = M * TOPK, MX = M + NB * CTX;
constexpr int LCAP = 16384, MAXT = 288, ACT_ROWS = MAXT * 256;
constexpr float EPS = 1e-5f;
constexpr float DN_ALPHA = 1.189207115002721f;
constexpr size_t MiB = 1u << 20;
constexpr size_t WS_CTL = 0, CTL_ZERO_BYTES = 1 * MiB;
constexpr size_t WS_MOD = 1 * MiB;
constexpr size_t WS_TOPG = 2 * MiB;
constexpr size_t WS_TOPI = 2 * MiB + 512 * 1024;
constexpr size_t WS_STAT = 5 * MiB + 512 * 1024;
constexpr size_t WS_LIST = 3 * MiB;
constexpr size_t WS_SGUW = 5 * MiB;
constexpr size_t WS_LISTG = 14 * MiB;
constexpr size_t WS_WIN = 6 * MiB;
constexpr size_t WS_WOUT = 11 * MiB;
constexpr size_t WS_WGU = 16 * MiB;
constexpr size_t WS_WDN = 144 * MiB;
constexpr size_t WS_HXC = 208 * MiB;
constexpr size_t WS_PROJ = 241 * MiB;
constexpr size_t WS_MIXIN = 324 * MiB;
constexpr size_t WS_Y1 = 356 * MiB;
constexpr size_t WS_H2 = 420 * MiB;
constexpr size_t WS_ACT = 452 * MiB;
constexpr size_t WS_YBUF = 596 * MiB;
constexpr size_t WS_X1 = 724 * MiB;
constexpr size_t WS_END = 788 * MiB;
constexpr size_t WS_ALT = 788 * MiB;
constexpr int CW_CNT_ALT = 12288;
constexpr int CW_BAR = 4096;
constexpr int CW_CNT = 8192;
constexpr int RING_BYTES = 131072;
constexpr int L_MISC = RING_BYTES;
constexpr int L_IDX = L_MISC + 1024;
constexpr int L_TILEE = L_IDX + 6144;
constexpr int L_TSTART = L_TILEE + 1280;
constexpr int L_ROUTE = L_TSTART + 512;
constexpr int L_RPB = L_ROUTE + 256 + 1024;
constexpr int L_WSCR = L_RPB + 2048;
constexpr int LDS_BYTES = 163840;
static_assert(L_WSCR + 8 * 2048 <= LDS_BYTES, "LDS map");

template <int CTRL> __device__ __forceinline__ float dppf(float v) { return __builtin_bit_cast(float, __builtin_amdgcn_update_dpp(0, __builtin_bit_cast(int, v), CTRL, 0xF, 0xF, true)); }
__device__ __forceinline__ float rlane(float v, int l) { return __builtin_bit_cast(float, __builtin_amdgcn_readlane(__builtin_bit_cast(int, v), l)); }
__device__ __forceinline__ float wsum(float v) {
    v += dppf<0xB1>(v); v += dppf<0x4E>(v); v += dppf<0x141>(v); v += dppf<0x140>(v);
    return (rlane(v, 0) + rlane(v, 16)) + (rlane(v, 32) + rlane(v, 48));
}
__device__ __forceinline__ float wmax(float v) {
    v = fmaxf(v, dppf<0xB1>(v)); v = fmaxf(v, dppf<0x4E>(v)); v = fmaxf(v, dppf<0x141>(v)); v = fmaxf(v, dppf<0x140>(v));
    return fmaxf(fmaxf(rlane(v, 0), rlane(v, 16)), fmaxf(rlane(v, 32), rlane(v, 48)));
}
__device__ __forceinline__ unsigned f2bf(float f) { unsigned u = __builtin_bit_cast(unsigned, f); return (u + 0x7fffu + ((u >> 16) & 1u)) >> 16; }
__device__ __forceinline__ unsigned pk2(float lo, float hi) { return f2bf(lo) | (f2bf(hi) << 16); }
__device__ __forceinline__ float bf2f(unsigned short b) { return __builtin_bit_cast(float, ((unsigned)b) << 16); }
__device__ __forceinline__ float bflo(unsigned w) { return __builtin_bit_cast(float, w << 16); }
__device__ __forceinline__ float bfhi(unsigned w) { return __builtin_bit_cast(float, w & 0xffff0000u); }
__device__ __forceinline__ unsigned cvt_pk_bf16(float lo, float hi) { unsigned r; asm volatile("v_cvt_pk_bf16_f32 %0, %1, %2" : "=v"(r) : "v"(lo), "v"(hi)); return r; }
__device__ __forceinline__ float gelu_fast(float x) {
    const float c1 = -2.302208198f;
    const float c3 = c1 * 0.044715f;
    const float x2 = x * x;
    const float t = x * (c1 + c3 * x2);
    return x * __builtin_amdgcn_rcpf(1.f + __builtin_amdgcn_exp2f(t));
}

#define XB_TMO      128
#define XB_XCNT(j)  (256  + 64 * (j))
#define XB_XSUB(j)  (1280 + 64 * (j))
#define XB_XGEN(j)  (2304 + 64 * (j))
#define XB_TOP      3328
#define XB_TOPGEN   3392
#define XCD_BAR_WORDS 3456
#define XB_SPIN_CAP (1u << 18)
__device__ __forceinline__ unsigned xb_ld(unsigned* p)              { return __hip_atomic_load(p, __ATOMIC_RELAXED, __HIP_MEMORY_SCOPE_AGENT); }
__device__ __forceinline__ unsigned xb_add(unsigned* p, unsigned v) { return __hip_atomic_fetch_add(p, v, __ATOMIC_RELAXED, __HIP_MEMORY_SCOPE_AGENT); }
__device__ __forceinline__ unsigned xb_xcc_id() { return (unsigned)__builtin_amdgcn_s_getreg((3 << 11) | 20) & 0xFu; }
#define XB_SPIN(cond, bar) do { unsigned _sp = 0; while (cond) { __builtin_amdgcn_s_sleep(1); \
    if ((++_sp & 255u) == 0u) { if (xb_ld(&(bar)[XB_TMO])) break; if (_sp > XB_SPIN_CAP) { atomicAdd(&(bar)[XB_TMO], 1u); break; } } } } while (0)
struct XcdBarrier { unsigned* bar; unsigned x; volatile LAS unsigned* st; };
__device__ __forceinline__ XcdBarrier xcd_barrier_post(unsigned* bar, volatile LAS unsigned* st) {
    XcdBarrier b; b.bar = bar; b.x = xb_xcc_id(); b.st = st;
    if (threadIdx.x == 0) (void)xb_add(&bar[XB_XCNT(b.x)], 1u);
    return b;
}
__device__ __forceinline__ void xcd_barrier_complete(unsigned* bar, unsigned x, unsigned& nloc, unsigned& nx) {
    const unsigned G = gridDim.x * gridDim.y * gridDim.z;
    unsigned sum, cnt, mine, sp = 0u;
    for (;;) {
        sum = 0u; cnt = 0u; mine = 0u;
#pragma unroll
        for (unsigned j = 0; j < 16; ++j) { const unsigned c = xb_ld(&bar[XB_XCNT(j)]); sum += c; cnt += (c > 0u) ? 1u : 0u; mine = (j == x) ? c : mine; }
        if (sum == G) break;
        __builtin_amdgcn_s_sleep(1);
        if ((++sp & 255u) == 0u) { if (xb_ld(&bar[XB_TMO])) break; if (sp > XB_SPIN_CAP) { atomicAdd(&bar[XB_TMO], 1u); break; } }
    }
    nloc = mine > 0u ? mine : 1u; nx = cnt > 0u ? cnt : 1u;
}
__device__ __forceinline__ void xcd_barrier(const XcdBarrier& b) {
    asm volatile("s_waitcnt vmcnt(0)" ::: "memory");
    __syncthreads();
    if (threadIdx.x == 0) {
        unsigned* bar = b.bar;
        __builtin_amdgcn_s_waitcnt(0);
        unsigned nloc = b.st[0], nx = b.st[1];
        if (nloc == 0u) { xcd_barrier_complete(bar, b.x, nloc, nx); b.st[0] = nloc; b.st[1] = nx; }
        const unsigned old = xb_add(&bar[XB_XSUB(b.x)], 1u);
        const unsigned gen = old / nloc;
        if (old + 1u == (gen + 1u) * nloc) {
            __builtin_amdgcn_fence(__ATOMIC_RELEASE, "agent");
            asm volatile("s_waitcnt vmcnt(0)" ::: "memory");
            const unsigned og = xb_add(&bar[XB_TOP], 1u);
            const unsigned tg = og / nx;
            if (og + 1u == (tg + 1u) * nx) xb_add(&bar[XB_TOPGEN], 1u);
            else XB_SPIN(xb_ld(&bar[XB_TOPGEN]) == tg, bar);
            __builtin_amdgcn_fence(__ATOMIC_ACQUIRE, "agent");
            xb_add(&bar[XB_XGEN(b.x)], 1u);
            asm volatile("s_waitcnt vmcnt(0)" ::: "memory");
        } else {
            XB_SPIN(xb_ld(&bar[XB_XGEN(b.x)]) == gen, bar);
            __builtin_amdgcn_fence(__ATOMIC_ACQUIRE, "agent");
            asm volatile("s_waitcnt vmcnt(0)" ::: "memory");
        }
    }
    __syncthreads();
}

struct Frame {
    LAS unsigned char* lds;
    volatile LAS unsigned* MISC;
    unsigned* ctl;
    int tid, lane, wave, vcu, G;
    const float *x, *c, *ctx, *c_ctx, *ada_w, *ada_b, *w_in, *rpb, *sgu_ln_g, *sgu_ln_b, *sgu_w, *sgu_b, *w_out, *ln1_g, *ln1_b, *ln2_g, *ln2_b, *router_w, *router_b, *w_gu, *b_gu, *w_dn, *b_dn;
    float* out;
    float* mod; float* topg; int* topi; int* list; float* listg; bf16_t* sguw; bf16_t* Wt_in; bf16_t* Wt_out; unsigned char* Wt_gu; unsigned char* Wt_dn;
    bf16_t* hxc; bf16_t* proj; bf16_t* mixin; bf16_t* y1; float* x1; f32x2* stat; unsigned* cntw; unsigned char* h2; unsigned char* act; bf16_t* ybuf;
};
#define LDS_WAIT() asm volatile("s_waitcnt lgkmcnt(0)" ::: "memory")
#define VM_WAIT() asm volatile("s_waitcnt vmcnt(0)" ::: "memory")

namespace pg8 {
constexpr int BM = 256, BK = 64, HALF = 128, HTB = HALF * BK * 2, STAGE_BYTES = 8 * HTB, NXCD = 8, WGM = 8, KD = 1024, NKT = KD / BK;
__device__ __forceinline__ int lds_byte(int r, int c) { const int st = (r >> 4) * 2 + (c >> 5), rr = r & 15, cc = c & 31, ob = rr * 64 + cc * 2; return st * 1024 + (ob ^ (((ob >> 9) & 1) << 5)); }
__device__ __forceinline__ void stage_rc(int b, int& R, int& C) { const int st = b / 1024, sb = b % 1024, swz = sb ^ (((sb >> 9) & 1) << 5); R = (st >> 1) * 16 + swz / 64; C = (st & 1) * 32 + (swz % 64) / 2; }
__device__ __forceinline__ int perm32(int rho) { const int n = rho >> 4, i = rho & 15; return 8 * (i >> 2) + 4 * n + (i & 3); }
struct Unit { int pm, pn, e, nvalid, ti; };
__device__ __forceinline__ void static_tile(int L, int nM, int nN, int& pm, int& pn) {
    const int nwg = nM * nN; int wgid = L;
    { const int q = nwg / NXCD, r = nwg % NXCD, xcd = wgid % NXCD, off = wgid / NXCD; wgid = (xcd < r ? xcd * (q + 1) : r * (q + 1) + (xcd - r) * q) + off; }
    const int nig = WGM * nN, gid = wgid / nig, fm = gid * WGM, gsz = (nM - fm) < WGM ? (nM - fm) : WGM;
    pm = fm + ((wgid % nig) % gsz); pn = (wgid % nig) / gsz;
}

typedef int v8i __attribute__((ext_vector_type(8)));
template <bool FP8> struct Frags;
template <> struct Frags<false> { bf16x8 At[4][2], B0[2][2], B1[2][2]; };
template <> struct Frags<true> { v8i At[4], B0[2], B1[2]; };
template <class P>
__device__ __forceinline__ void gemm_phase(LAS unsigned char* lds, const P& pol) {
    const int tid = threadIdx.x, wid = __builtin_amdgcn_readfirstlane(tid >> 6), lane = tid & 63, wr = wid >> 2, wc = wid & 3, fr = lane & 15, fq = lane >> 4;
    constexpr int KDB = P::FP8 ? 1024 : 2048, NKT_ = KDB / 128;
    unsigned voffB[2];
#pragma unroll
    for (int i = 0; i < 2; ++i) { int R, C; stage_rc(tid * 16 + i * 8192, R, C); const int Rb = P::PERM ? ((R & ~31) + perm32(R & 31)) : R;
        voffB[i] = (unsigned)(Rb * KDB + C * 2); }
    const size_t kstep = (size_t)(BK * 2);
    const size_t hstep = (size_t)HALF * KDB;
    const unsigned ldsw = (unsigned)wid * 1024u;
    const int aoff = lds_byte(wr * 64 + fr, fq * 8), boff = lds_byte(wc * 32 + fr, fq * 8);
#define PG8_SA(b, h) (((b) * 2 + (h)) * HTB)
#define PG8_SB(b, h) ((4 + (b) * 2 + (h)) * HTB)
#define PG8_STAGE(bufoff, gbase, voff) do { _Pragma("unroll") for (int _i = 0; _i < 2; ++_i) \
        __builtin_amdgcn_global_load_lds((const unsigned*)((const char*)(gbase) + (voff)[_i]), (LAS unsigned*)(lds + (bufoff) + ldsw + _i * 8192), 16, 0, 0); } while (0)
#define PG8_RD8(p) __builtin_shufflevector(*(const LAS u32x4*)(p), *(const LAS u32x4*)((p) + 1024), 0, 1, 2, 3, 4, 5, 6, 7)
#define PG8_LDA(dst, b, h) do { if constexpr (P::FP8) { _Pragma("unroll") for (int m = 0; m < 4; ++m) fg.dst[m] = __builtin_bit_cast(v8i, PG8_RD8(lds + PG8_SA(b, h) + aoff + m * 2048)); } \
        else { _Pragma("unroll") for (int m = 0; m < 4; ++m) _Pragma("unroll") for (int k = 0; k < 2; ++k) fg.dst[m][k] = *(const LAS bf16x8*)(lds + PG8_SA(b, h) + aoff + m * 2048 + k * 1024); } } while (0)
#define PG8_LDB(dst, b, h) do { if constexpr (P::FP8) { _Pragma("unroll") for (int n = 0; n < 2; ++n) fg.dst[n] = __builtin_bit_cast(v8i, PG8_RD8(lds + PG8_SB(b, h) + boff + n * 2048)); } \
        else { _Pragma("unroll") for (int n = 0; n < 2; ++n) _Pragma("unroll") for (int k = 0; k < 2; ++k) fg.dst[n][k] = *(const LAS bf16x8*)(lds + PG8_SB(b, h) + boff + n * 2048 + k * 1024); } } while (0)
#define PG8_MMA(ai, bj, At, Bt) do { __builtin_amdgcn_s_setprio(1); \
        if constexpr (P::FP8) { _Pragma("unroll") for (int m = 0; m < 4; ++m) _Pragma("unroll") for (int n = 0; n < 2; ++n) \
            acc[ai][bj][m][n] = __builtin_amdgcn_mfma_scale_f32_16x16x128_f8f6f4(fg.Bt[n], fg.At[m], acc[ai][bj][m][n], 0, 0, 0, 0, 0, 0); } \
        else { _Pragma("unroll") for (int m = 0; m < 4; ++m) _Pragma("unroll") for (int n = 0; n < 2; ++n) _Pragma("unroll") for (int k = 0; k < 2; ++k) \
            acc[ai][bj][m][n] = __builtin_amdgcn_mfma_f32_16x16x32_bf16(fg.Bt[n][k], fg.At[m][k], acc[ai][bj][m][n], 0, 0, 0); } \
        __builtin_amdgcn_s_setprio(0); } while (0)
#define PG8_WAIT_V(n) asm volatile("s_waitcnt vmcnt(" #n ")" ::: "memory")
#define PG8_WAIT_L(n) asm volatile("s_waitcnt lgkmcnt(" #n ")" ::: "memory")
#define PG8_BAR __builtin_amdgcn_s_barrier()
#define PG8_SCHED __builtin_amdgcn_sched_barrier(0)
    Unit cur, nxt; int ui = 0;
    if (!pol.next(0, cur)) return;
    f32x4 acc[2][2][4][2];
#pragma unroll
    for (int a = 0; a < 2; ++a)
#pragma unroll
        for (int b = 0; b < 2; ++b)
#pragma unroll
            for (int m = 0; m < 4; ++m)
#pragma unroll
                for (int n = 0; n < 2; ++n) acc[a][b][m][n] = (f32x4){0.f, 0.f, 0.f, 0.f};
    Frags<P::FP8> fg;
    int slot = 0;
    if (P::META) { pol.meta_issue(cur, 0, lds, wid, lane); PG8_WAIT_V(0); asm volatile("" ::: "memory"); PG8_BAR; asm volatile("" ::: "memory"); }
    unsigned aC[2][2];
    pol.a_off(cur, 0, lds, aC);
    const char* const Ab = (const char*)pol.A;
    const char* cB = pol.b_ptr(cur);
    PG8_STAGE(PG8_SB(0, 0), cB, voffB); PG8_STAGE(PG8_SB(0, 1), cB + hstep, voffB); PG8_STAGE(PG8_SA(0, 0), Ab, aC[0]); PG8_STAGE(PG8_SA(0, 1), Ab, aC[1]);
    if (wr == 1) PG8_BAR;
    PG8_WAIT_V(2); PG8_BAR;
    PG8_STAGE(PG8_SB(1, 0), cB + kstep, voffB); PG8_STAGE(PG8_SA(1, 0), Ab + kstep, aC[0]); PG8_STAGE(PG8_SB(1, 1), cB + hstep + kstep, voffB);
    PG8_WAIT_V(6); PG8_BAR;
    for (;;) {
        const bool has_next = pol.next(ui + 1, nxt);
        const int nslot = slot == 2 ? 0 : slot + 1;
        if (P::META) { if (has_next) pol.meta_issue(nxt, nslot, lds, wid, lane); }
        const char* nB = has_next ? pol.b_ptr(nxt) : cB;
#pragma unroll 1
        for (int t = 0; t < NKT_; t += 2) {
            const bool last = (t == NKT_ - 2);
            const char* a1 = Ab + (size_t)(t + 1) * kstep;
            const char* a2 = last ? Ab : Ab + (size_t)(t + 2) * kstep; const char* b2 = last ? nB : cB + (size_t)(t + 2) * kstep;
            const char* a3 = a2 + kstep; const char* b3 = b2 + kstep;
            PG8_LDB(B0, 0, 0); PG8_LDB(B1, 0, 1); PG8_SCHED; PG8_LDA(At, 0, 0); PG8_STAGE(PG8_SA(1, 1), a1, aC[1]);
            if (last && has_next) pol.a_off(nxt, nslot, lds, aC);
            PG8_WAIT_V(8); PG8_WAIT_L(0); PG8_BAR; PG8_MMA(0, 0, At, B0); PG8_MMA(0, 1, At, B1); PG8_BAR; PG8_SCHED;
            PG8_LDA(At, 0, 1); PG8_STAGE(PG8_SB(0, 0), b2, voffB); PG8_STAGE(PG8_SB(0, 1), b2 + hstep, voffB); PG8_STAGE(PG8_SA(0, 0), a2, aC[0]);
            PG8_WAIT_V(8); PG8_WAIT_L(0); PG8_BAR; PG8_MMA(1, 0, At, B0); PG8_MMA(1, 1, At, B1); PG8_BAR; PG8_SCHED;
            PG8_LDB(B0, 1, 0); PG8_LDB(B1, 1, 1); PG8_SCHED; PG8_LDA(At, 1, 0); PG8_STAGE(PG8_SA(0, 1), a2, aC[1]);
            PG8_WAIT_V(8); PG8_WAIT_L(0); PG8_BAR; PG8_MMA(0, 0, At, B0); PG8_MMA(0, 1, At, B1); PG8_BAR; PG8_SCHED;
            PG8_LDA(At, 1, 1); PG8_STAGE(PG8_SB(1, 0), b3, voffB); PG8_STAGE(PG8_SB(1, 1), b3 + hstep, voffB); PG8_STAGE(PG8_SA(1, 0), a3, aC[0]);
            PG8_WAIT_V(8); PG8_WAIT_L(0); PG8_BAR; PG8_MMA(1, 0, At, B0); PG8_MMA(1, 1, At, B1); PG8_BAR; PG8_SCHED;
        }
        if (wr == 0) PG8_BAR;
#ifdef PROBE_KLOOP2
        const bool do_epi = !(P::FP8 && P::KIND == PROBE_KLOOP2) || (ui & 1);
        if (do_epi) {
            if (P::FP8 && P::KIND == PROBE_KLOOP2) {
#pragma unroll
                for (int a = 0; a < 2; ++a)
#pragma unroll
                    for (int b = 0; b < 2; ++b)
#pragma unroll
                        for (int m = 0; m < 4; ++m)
#pragma unroll
                            for (int n = 0; n < 2; ++n) acc[a][b][m][n] *= 0.5f; }
            pol.epi(acc, cur, slot, lds, wr, wc, fr, fq); }
#else
        constexpr bool do_epi = true;
        pol.epi(acc, cur, slot, lds, wr, wc, fr, fq);
#endif
#ifdef PROBE_EPI2
        if (P::KIND == PROBE_EPI2) { asm volatile("" ::: "memory");
#pragma unroll
            for (int a = 0; a < 2; ++a)
#pragma unroll
                for (int b = 0; b < 2; ++b)
#pragma unroll
                    for (int m = 0; m < 4; ++m)
#pragma unroll
                        for (int n = 0; n < 2; ++n) asm volatile("" : "+v"(acc[a][b][m][n]));
            pol.epi(acc, cur, slot, lds, wr, wc, fr, fq); }
#endif
        if (!has_next) break;
        if (do_epi) {
#pragma unroll
        for (int a = 0; a < 2; ++a)
#pragma unroll
            for (int b = 0; b < 2; ++b)
#pragma unroll
                for (int m = 0; m < 4; ++m)
#pragma unroll
                    for (int n = 0; n < 2; ++n) acc[a][b][m][n] = (f32x4){0.f, 0.f, 0.f, 0.f};
        }
        cur = nxt; cB = nB; ++ui; slot = nslot;
        if (wr == 1) PG8_BAR;
    }
    PG8_WAIT_V(0);
    PG8_BAR;
#undef PG8_SA
#undef PG8_SB
#undef PG8_STAGE
#undef PG8_LDA
#undef PG8_LDB
#undef PG8_MMA
#undef PG8_RD8
#undef PG8_WAIT_V
#undef PG8_WAIT_L
#undef PG8_BAR
#undef PG8_SCHED
}
}

typedef f32x4 AccT[2][2][4][2];

struct PolProj {
    static constexpr int KIND = 0; static constexpr bool PERM = true, META = false, FP8 = false; static constexpr int SCALE_W = 0x7f7f7f7f;
    const bf16_t* A; const bf16_t* Bt; bf16_t* O; int G, c;
    __device__ __forceinline__ bool next(int i, pg8::Unit& u) const {
        const int L = i * G + c;
        if (L < 640) { pg8::static_tile(L, 64, 10, u.pm, u.pn); return true; }
        if (L < 648) { const int j = L - 640; u.pm = 64 + (j >> 2); u.pn = 2 + (j & 3); return true; }
        return false;
    }
    __device__ __forceinline__ const char* b_ptr(const pg8::Unit& u) const { return (const char*)Bt + (size_t)u.pn * 256 * 1024 * 2; }
    __device__ __forceinline__ void meta_issue(const pg8::Unit&, int, LAS unsigned char*, int, int) const {}
    __device__ __forceinline__ void a_off(const pg8::Unit& u, int, LAS unsigned char*, unsigned (&o)[2][2]) const {
        int Ra[2], Ca[2]; pg8::stage_rc((int)threadIdx.x * 16, Ra[0], Ca[0]); pg8::stage_rc((int)threadIdx.x * 16 + 8192, Ra[1], Ca[1]);
#pragma unroll
        for (int h = 0; h < 2; ++h)
#pragma unroll
            for (int i = 0; i < 2; ++i) o[h][i] = (unsigned)((u.pm * 256 + 128 * h + Ra[i]) * 1024 + Ca[i]) * 2u;
    }
    __device__ __forceinline__ void epi(const AccT& acc, const pg8::Unit& u, int, LAS unsigned char*, int wr, int wc, int fr, int fq) const {
        const int row0 = u.pm * 256 + wr * 64 + fr, col0 = u.pn * 256 + wc * 32 + 8 * fq;
        const bool act = u.pn >= 6;
#pragma unroll
        for (int ai = 0; ai < 2; ++ai)
#pragma unroll
            for (int m = 0; m < 4; ++m) { bf16_t* rowp = O + (size_t)(row0 + ai * 128 + m * 16) * DIN + col0;
#pragma unroll
                for (int bj = 0; bj < 2; ++bj) { f32x4 v0 = acc[ai][bj][m][0], v1 = acc[ai][bj][m][1];
                    if (act) {
#pragma unroll
                        for (int j = 0; j < 4; ++j) { v0[j] = gelu_fast(v0[j]); v1[j] = gelu_fast(v1[j]); } }
                    u32x4 w; w.x = cvt_pk_bf16(v0[0], v0[1]); w.y = cvt_pk_bf16(v0[2], v0[3]); w.z = cvt_pk_bf16(v1[0], v1[1]); w.w = cvt_pk_bf16(v1[2], v1[3]);
                    *(u32x4*)(rowp + bj * 128) = w; } }
    }
};

struct PolOut {
    static constexpr int KIND = 0; static constexpr bool PERM = true, META = false, FP8 = false; static constexpr int SCALE_W = 0x7f7f7f7f;
    const bf16_t* A; const bf16_t* Bt; const float* x; const float* mod; bf16_t* Y; int G, c;
    __device__ __forceinline__ bool next(int i, pg8::Unit& u) const { const int L = i * G + c; if (L >= 256) return false; pg8::static_tile(L, 64, 4, u.pm, u.pn); return true; }
    __device__ __forceinline__ const char* b_ptr(const pg8::Unit& u) const { return (const char*)Bt + (size_t)u.pn * 256 * 1024 * 2; }
    __device__ __forceinline__ void meta_issue(const pg8::Unit&, int, LAS unsigned char*, int, int) const {}
    __device__ __forceinline__ void a_off(const pg8::Unit& u, int, LAS unsigned char*, unsigned (&o)[2][2]) const {
        int Ra[2], Ca[2]; pg8::stage_rc((int)threadIdx.x * 16, Ra[0], Ca[0]); pg8::stage_rc((int)threadIdx.x * 16 + 8192, Ra[1], Ca[1]);
#pragma unroll
        for (int h = 0; h < 2; ++h)
#pragma unroll
            for (int i = 0; i < 2; ++i) o[h][i] = (unsigned)((u.pm * 256 + 128 * h + Ra[i]) * 1024 + Ca[i]) * 2u;
    }
    __device__ __forceinline__ void epi(const AccT& acc, const pg8::Unit& u, int, LAS unsigned char*, int wr, int wc, int fr, int fq) const {
        const int row0 = u.pm * 256 + wr * 64 + fr, col0 = u.pn * 256 + wc * 32 + 8 * fq;
        const float* g1 = mod + (u.pm >= 32 ? 6144 : 0) + 2 * 1024;
        f32x4 gv[2][2];
#pragma unroll
        for (int bj = 0; bj < 2; ++bj)
#pragma unroll
            for (int n = 0; n < 2; ++n) gv[bj][n] = *(const f32x4*)(g1 + col0 + bj * 128 + 4 * n);
#pragma unroll
        for (int ai = 0; ai < 2; ++ai)
#pragma unroll
            for (int m = 0; m < 4; ++m) { const size_t off = (size_t)(row0 + ai * 128 + m * 16) * D + col0;
#pragma unroll
                for (int bj = 0; bj < 2; ++bj) { const f32x4 x0 = __builtin_nontemporal_load((const f32x4*)(x + off + bj * 128)), x1v = __builtin_nontemporal_load((const f32x4*)(x + off + bj * 128 + 4));
                    const f32x4 v0 = x0 * DN_ALPHA + gv[bj][0] * acc[ai][bj][m][0], v1 = x1v * DN_ALPHA + gv[bj][1] * acc[ai][bj][m][1];
                    u32x4 w; w.x = cvt_pk_bf16(v0[0], v0[1]); w.y = cvt_pk_bf16(v0[2], v0[3]); w.z = cvt_pk_bf16(v1[0], v1[1]); w.w = cvt_pk_bf16(v1[2], v1[3]);
                    *(u32x4*)(Y + off + bj * 128) = w; }
                asm volatile("" ::: "memory"); }
    }
};

struct ExpTab { const LAS int* tile_e; const LAS int* tstart; const LAS int* cnt; int T; };
__device__ __forceinline__ int expert_tables(Frame& F) {
    LAS int* tile_e = (LAS int*)(F.lds + L_TILEE); LAS int* tstart = (LAS int*)(F.lds + L_TSTART); LAS int* cn = tstart + 64;
    if (F.tid < 32) cn[F.tid] = (int)__hip_atomic_load(F.ctl + CW_CNT + 32 * F.tid, __ATOMIC_RELAXED, __HIP_MEMORY_SCOPE_AGENT);
    __syncthreads();
    if (F.tid == 0) { int run = 0; for (int e = 0; e < NE; ++e) { tstart[e] = run; run += (cn[e] + 255) >> 8; } tstart[NE] = run; }
    __syncthreads();
    const int T = tstart[NE];
    if (F.tid < MAXT && F.tid < T) { int e = 0; while (e < NE - 1 && tstart[e + 1] <= F.tid) ++e; tile_e[F.tid] = e; }
    __syncthreads();
    return T < MAXT ? T : MAXT;
}
__device__ __forceinline__ int rfl(int v) { return __builtin_amdgcn_readfirstlane(v); }

struct PolGU {
    static constexpr int KIND = 1; static constexpr bool PERM = true, META = true, FP8 = true; static constexpr int SCALE_W = 0; static constexpr float WSC = 1.f / 64.f;
    const unsigned char* A; const unsigned char* Bt; const float* bias; const int* list; unsigned char* O; ExpTab tb; int G, c;
    __device__ __forceinline__ bool next(int i, pg8::Unit& u) const {
#if defined(PROBE_KLOOP2) && PROBE_KLOOP2 == 1
        const int L = (i >> 1) * G + c; if (L >= tb.T * 8) return false;
#else
        const int L = i * G + c; if (L >= tb.T * 8) return false;
#endif
        u.ti = L >> 3; u.pn = L & 7; u.e = rfl(tb.tile_e[u.ti]); u.pm = u.ti - rfl(tb.tstart[u.e]);
        const int rem = rfl(tb.cnt[u.e]) - u.pm * 256; u.nvalid = rem < 256 ? rem : 256; return true;
    }
    __device__ __forceinline__ const char* b_ptr(const pg8::Unit& u) const { return (const char*)Bt + ((size_t)u.e * 2048 + (size_t)u.pn * 256) * 1024; }
    __device__ __forceinline__ void meta_issue(const pg8::Unit& u, int slot, LAS unsigned char* lds, int wid, int lane) const {
        if (wid < 4) __builtin_amdgcn_global_load_lds((const unsigned*)(list + (size_t)u.e * LCAP + u.pm * 256 + wid * 64 + lane), (LAS unsigned*)(lds + L_IDX + slot * 2048 + wid * 256), 4, 0, 0);
    }
    __device__ __forceinline__ void a_off(const pg8::Unit& u, int slot, LAS unsigned char* lds, unsigned (&o)[2][2]) const {
        int Ra[2], Ca[2]; pg8::stage_rc((int)threadIdx.x * 16, Ra[0], Ca[0]); pg8::stage_rc((int)threadIdx.x * 16 + 8192, Ra[1], Ca[1]);
        const LAS int* idx = (const LAS int*)(lds + L_IDX + slot * 2048);
#pragma unroll
        for (int h = 0; h < 2; ++h)
#pragma unroll
            for (int i = 0; i < 2; ++i) { const int r = 128 * h + Ra[i]; int pr = idx[r]; pr = r < u.nvalid ? pr : 0; o[h][i] = (unsigned)((pr >> 2) * 1024 + Ca[i] * 2); }
    }
    __device__ __forceinline__ void epi(const AccT& acc, const pg8::Unit& u, int, LAS unsigned char*, int wr, int wc, int fr, int fq) const {
        const int row0 = u.ti * 256 + wr * 64 + fr, col0 = u.pn * 128 + wc * 32 + 8 * fq;
        const float* bg = bias + (size_t)u.e * 2048 + col0;
        const f32x4 g0 = *(const f32x4*)(bg), g1 = *(const f32x4*)(bg + 4), l0 = *(const f32x4*)(bg + 1024) + 1.f, l1 = *(const f32x4*)(bg + 1028) + 1.f;
#pragma unroll
        for (int ai = 0; ai < 2; ++ai)
#pragma unroll
            for (int m = 0; m < 4; ++m) {
                f32x4 r0, r1;
#pragma unroll
                for (int hp = 0; hp < 2; ++hp) {
                    const f32x2 ga0 = (f32x2){acc[ai][0][m][0][2 * hp], acc[ai][0][m][0][2 * hp + 1]} * WSC + (f32x2){g0[2 * hp], g0[2 * hp + 1]};
                    const f32x2 ga1 = (f32x2){acc[ai][0][m][1][2 * hp], acc[ai][0][m][1][2 * hp + 1]} * WSC + (f32x2){g1[2 * hp], g1[2 * hp + 1]};
                    const f32x2 lb0 = (f32x2){acc[ai][1][m][0][2 * hp], acc[ai][1][m][0][2 * hp + 1]} * WSC + (f32x2){l0[2 * hp], l0[2 * hp + 1]};
                    const f32x2 lb1 = (f32x2){acc[ai][1][m][1][2 * hp], acc[ai][1][m][1][2 * hp + 1]} * WSC + (f32x2){l1[2 * hp], l1[2 * hp + 1]};
                    f32x2 gg0, gg1, ll0, ll1, e0, e1;
                    gg0[0] = fminf(ga0[0], 7.f); gg0[1] = fminf(ga0[1], 7.f); gg1[0] = fminf(ga1[0], 7.f); gg1[1] = fminf(ga1[1], 7.f);
                    ll0[0] = __builtin_amdgcn_fmed3f(lb0[0], -6.f, 8.f); ll0[1] = __builtin_amdgcn_fmed3f(lb0[1], -6.f, 8.f); ll1[0] = __builtin_amdgcn_fmed3f(lb1[0], -6.f, 8.f); ll1[1] = __builtin_amdgcn_fmed3f(lb1[1], -6.f, 8.f);
                    const f32x2 x0 = gg0 * -2.45546696f, x1 = gg1 * -2.45546696f;
                    e0[0] = __builtin_amdgcn_exp2f(x0[0]); e0[1] = __builtin_amdgcn_exp2f(x0[1]); e1[0] = __builtin_amdgcn_exp2f(x1[0]); e1[1] = __builtin_amdgcn_exp2f(x1[1]);
                    const f32x2 d0 = e0 + 1.f, d1 = e1 + 1.f;
                    f32x2 q0, q1; q0[0] = __builtin_amdgcn_rcpf(d0[0]); q0[1] = __builtin_amdgcn_rcpf(d0[1]); q1[0] = __builtin_amdgcn_rcpf(d1[0]); q1[1] = __builtin_amdgcn_rcpf(d1[1]);
                    const f32x2 o0 = (ll0 * gg0) * q0, o1 = (ll1 * gg1) * q1;
                    r0[2 * hp] = o0[0]; r0[2 * hp + 1] = o0[1]; r1[2 * hp] = o1[0]; r1[2 * hp + 1] = o1[1];
                }
                u32x2 w; w.x = (unsigned)__builtin_amdgcn_cvt_pk_fp8_f32(r0[2], r0[3], __builtin_amdgcn_cvt_pk_fp8_f32(r0[0], r0[1], 0, false), true);
                w.y = (unsigned)__builtin_amdgcn_cvt_pk_fp8_f32(r1[2], r1[3], __builtin_amdgcn_cvt_pk_fp8_f32(r1[0], r1[1], 0, false), true);
                *(u32x2*)(O + (size_t)(row0 + ai * 128 + m * 16) * DFF + col0) = w; }
    }
};

struct PolDN {
    static constexpr int KIND = 2; static constexpr bool PERM = true, META = true, FP8 = true; static constexpr int SCALE_W = 0; static constexpr float WSC = 1.f / 64.f;
    const unsigned char* A; const unsigned char* Bt; const float* bias; const int* list; const float* listg; bf16_t* O; ExpTab tb; int G, c;
    __device__ __forceinline__ bool next(int i, pg8::Unit& u) const {
#if defined(PROBE_KLOOP2) && PROBE_KLOOP2 == 2
        const int L = (i >> 1) * G + c; if (L >= tb.T * 4) return false;
#else
        const int L = i * G + c; if (L >= tb.T * 4) return false;
#endif
        u.ti = L >> 2; u.pn = L & 3; u.e = rfl(tb.tile_e[u.ti]); u.pm = u.ti - rfl(tb.tstart[u.e]);
        const int rem = rfl(tb.cnt[u.e]) - u.pm * 256; u.nvalid = rem < 256 ? rem : 256; return true;
    }
    __device__ __forceinline__ const char* b_ptr(const pg8::Unit& u) const { return (const char*)Bt + ((size_t)u.e * 1024 + (size_t)u.pn * 256) * 1024; }
    __device__ __forceinline__ void meta_issue(const pg8::Unit& u, int slot, LAS unsigned char* lds, int wid, int lane) const {
        if (wid < 4) __builtin_amdgcn_global_load_lds((const unsigned*)(list + (size_t)u.e * LCAP + u.pm * 256 + wid * 64 + lane), (LAS unsigned*)(lds + L_IDX + slot * 2048 + wid * 256), 4, 0, 0);
        else __builtin_amdgcn_global_load_lds((const unsigned*)(listg + (size_t)u.e * LCAP + u.pm * 256 + (wid - 4) * 64 + lane), (LAS unsigned*)(lds + L_IDX + slot * 2048 + 1024 + (wid - 4) * 256), 4, 0, 0);
    }
    __device__ __forceinline__ void a_off(const pg8::Unit& u, int, LAS unsigned char*, unsigned (&o)[2][2]) const {
        int Ra[2], Ca[2]; pg8::stage_rc((int)threadIdx.x * 16, Ra[0], Ca[0]); pg8::stage_rc((int)threadIdx.x * 16 + 8192, Ra[1], Ca[1]);
#pragma unroll
        for (int h = 0; h < 2; ++h)
#pragma unroll
            for (int i = 0; i < 2; ++i) o[h][i] = (unsigned)((u.ti * 256 + 128 * h + Ra[i]) * 1024 + Ca[i] * 2);
    }
    __device__ __forceinline__ void epi(const AccT& acc, const pg8::Unit& u, int slot, LAS unsigned char* lds, int wr, int wc, int fr, int fq) const {
        const LAS int* idx = (const LAS int*)(lds + L_IDX + slot * 2048);
        const int col0 = u.pn * 256 + wc * 32 + 8 * fq;
        const float* bd = bias + (size_t)u.e * 1024 + col0;
        f32x4 bv[2][2];
#pragma unroll
        for (int bj = 0; bj < 2; ++bj)
#pragma unroll
            for (int n = 0; n < 2; ++n) bv[bj][n] = *(const f32x4*)(bd + bj * 128 + 4 * n);
#pragma unroll
        for (int ai = 0; ai < 2; ++ai)
#pragma unroll
            for (int m = 0; m < 4; ++m) { const int r = ai * 128 + wr * 64 + m * 16 + fr;
                if (r < u.nvalid) { const int pr = idx[r]; const float gt = ((const LAS float*)idx)[256 + r]; bf16_t* rowp = O + (size_t)pr * D + col0;
#pragma unroll
                    for (int bj = 0; bj < 2; ++bj) { const f32x4 v0 = (acc[ai][bj][m][0] * WSC + bv[bj][0]) * gt, v1 = (acc[ai][bj][m][1] * WSC + bv[bj][1]) * gt;
                        u32x4 w; w.x = cvt_pk_bf16(v0[0], v0[1]); w.y = cvt_pk_bf16(v0[2], v0[3]); w.z = cvt_pk_bf16(v1[0], v1[1]); w.w = cvt_pk_bf16(v1[2], v1[3]);
                        __builtin_nontemporal_store(w, (u32x4*)(rowp + bj * 128)); } } }
    }
};

__device__ __forceinline__ void p_ada(Frame& F) {
    LAS float* sl = (LAS float*)F.lds;
    LAS float* red = sl + 3072;
    for (int i = F.tid; i < 3072; i += 512) { const int w = i >> 10, k = i & 1023; const float v = w < 2 ? F.c[w * D + k] : F.c_ctx[k]; sl[i] = v / (1.f + __expf(-v)); }
    __syncthreads();
    for (int slab = blockIdx.x; slab < 256; slab += F.G) {
        const int j0 = slab * 24, cg = F.tid % 6, kr = F.tid / 6;
        float a[3][4] = {};
        if (F.tid < 480) {
            for (int k = kr; k < D; k += 80) {
                const f32x4 w4 = __builtin_nontemporal_load((const f32x4*)(F.ada_w + (size_t)k * 6144 + j0 + 4 * cg));
                const float s0 = sl[k], s1 = sl[1024 + k], s2 = sl[2048 + k];
#pragma unroll
                for (int q = 0; q < 4; ++q) { a[0][q] += s0 * w4[q]; a[1][q] += s1 * w4[q]; a[2][q] += s2 * w4[q]; }
            }
#pragma unroll
            for (int w = 0; w < 3; ++w)
#pragma unroll
                for (int q = 0; q < 4; ++q) red[kr * 72 + cg * 12 + w * 4 + q] = a[w][q];
        }
        __syncthreads();
        if (F.tid < 72) {
            float s = 0.f;
            for (int r = 0; r < 80; ++r) s += red[r * 72 + F.tid];
            const int g = F.tid / 12, w = (F.tid % 12) >> 2, q = F.tid & 3, col = j0 + 4 * g + q;
            F.mod[w * 6144 + col] = s + F.ada_b[col];
        }
        __syncthreads();
    }
}

__device__ __forceinline__ void transpose_item(const float* W, int K, int N, bf16_t* WT, int item, bool gu_map, LAS float* scr, int lane) {
    const int nblk = N / 32, kb = item / nblk, nb = item % nblk, k0 = 64 * kb, n0 = 32 * nb;
#pragma unroll 8
    for (int i = 0; i < 32; ++i) { const int kk = 2 * i + (lane >> 5); scr[kk * 33 + (lane & 31)] = __builtin_nontemporal_load(W + (size_t)(k0 + kk) * N + n0 + (lane & 31)); }
    LDS_WAIT(); asm volatile("" ::: "memory");
    int d0 = n0;
    if (gu_map) { const int nn = n0 & 1023; d0 = (nn >> 7) * 256 + (nn & 127) + ((n0 >> 10) ? 128 : 0); }
    const int c = lane & 7;
#pragma unroll
    for (int j = 0; j < 4; ++j) { const int n = (lane >> 3) + 8 * j; const LAS float* s = scr + (8 * c) * 33 + n;
        u32x4 o; o.x = pk2(s[0 * 33], s[1 * 33]); o.y = pk2(s[2 * 33], s[3 * 33]); o.z = pk2(s[4 * 33], s[5 * 33]); o.w = pk2(s[6 * 33], s[7 * 33]);
        *(u32x4*)(WT + (size_t)(d0 + n) * K + k0 + 8 * c) = o; }
    LDS_WAIT(); asm volatile("" ::: "memory");
}
__device__ __forceinline__ unsigned pk4_fp8(float a, float b, float c, float d) { return (unsigned)__builtin_amdgcn_cvt_pk_fp8_f32(c, d, __builtin_amdgcn_cvt_pk_fp8_f32(a, b, 0, false), true); }
__device__ __forceinline__ void transpose_item8(const float* W, int K, int N, unsigned char* WT, int item, bool gu_map, LAS float* scr, int lane) {
    const int nblk = N / 32, kb = item / nblk, nb = item % nblk, k0 = 64 * kb, n0 = 32 * nb;
#pragma unroll 8
    for (int i = 0; i < 32; ++i) { const int kk = 2 * i + (lane >> 5); scr[kk * 33 + (lane & 31)] = __builtin_nontemporal_load(W + (size_t)(k0 + kk) * N + n0 + (lane & 31)); }
    LDS_WAIT(); asm volatile("" ::: "memory");
    int d0 = n0;
    if (gu_map) { const int nn = n0 & 1023; d0 = (nn >> 7) * 256 + (nn & 127) + ((n0 >> 10) ? 128 : 0); }
    const int c = lane & 7;
#pragma unroll
    for (int j = 0; j < 4; ++j) { const int n = (lane >> 3) + 8 * j; const LAS float* s = scr + (8 * c) * 33 + n;
        u32x2 o; o.x = pk4_fp8(s[0 * 33] * 64.f, s[1 * 33] * 64.f, s[2 * 33] * 64.f, s[3 * 33] * 64.f); o.y = pk4_fp8(s[4 * 33] * 64.f, s[5 * 33] * 64.f, s[6 * 33] * 64.f, s[7 * 33] * 64.f);
        __builtin_nontemporal_store(o, (u32x2*)(WT + (size_t)(d0 + n) * K + k0 + 8 * c)); }
    LDS_WAIT(); asm volatile("" ::: "memory");
}
__device__ __forceinline__ void p_weights(Frame& F, int it_lo, int n_items, int gw, int NGW, bool with_sgu) {
    LAS float* scr = (LAS float*)(F.lds + F.wave * 16384);
    constexpr int I_IN = 16 * 80, I_OUT = 16 * 32, I_GU = 16 * 64, I_DN = 16 * 32;
    constexpr int NITEMS = I_IN + I_OUT + NE * I_GU + NE * I_DN;
    for (int it0 = gw; it0 < n_items; it0 += NGW) {
        const int it = it_lo + it0; int r = it;
        if (r < I_IN) { transpose_item(F.w_in, D, DIN, F.Wt_in, r, false, scr, F.lane); continue; } r -= I_IN;
        if (r < I_OUT) { transpose_item(F.w_out, D, D, F.Wt_out, r, false, scr, F.lane); continue; } r -= I_OUT;
        if (r < NE * I_GU) { const int e = r / I_GU; transpose_item8(F.w_gu + (size_t)e * D * 2048, D, 2048, F.Wt_gu + (size_t)e * 2048 * D, r % I_GU, true, scr, F.lane); continue; } r -= NE * I_GU;
        { const int e = r / I_DN; transpose_item8(F.w_dn + (size_t)e * DFF * D, DFF, D, F.Wt_dn + (size_t)e * D * DFF, r % I_DN, false, scr, F.lane); }
    }
    if (with_sgu) for (int i = (blockIdx.x * 512 + F.tid) * 4; i < 4 * 128 * 128; i += F.G * 512 * 4) {
        const f32x4 v = *(const f32x4*)(F.sgu_w + i); u32x2 o; o.x = pk2(v[0], v[1]); o.y = pk2(v[2], v[3]); *(u32x2*)(F.sguw + i) = o; }
}
__device__ __forceinline__ void p_lnmod(Frame& F) {
    const int gw = F.vcu * 8 + F.wave, NGW = F.G * 8;
    for (int row = gw; row < MX; row += NGW) {
        const float* xr; const float* md;
        if (row < M) { xr = F.x + (size_t)row * D; md = F.mod + (row >> 13) * 6144; } else { xr = F.ctx + (size_t)(row - M) * D; md = F.mod + 2 * 6144; }
        const f32x4* xp = (const f32x4*)xr + F.lane;
        f32x4 v[4]; float s = 0.f;
#pragma unroll
        for (int j = 0; j < 4; ++j) { v[j] = __builtin_nontemporal_load(xp + 64 * j); s += (v[j][0] + v[j][1]) + (v[j][2] + v[j][3]); }
        const float mean = wsum(s) * (1.f / D); float q = 0.f;
#pragma unroll
        for (int j = 0; j < 4; ++j) { v[j] = v[j] - mean; q += (v[j][0] * v[j][0] + v[j][1] * v[j][1]) + (v[j][2] * v[j][2] + v[j][3] * v[j][3]); }
        const float rstd = rsqrtf(wsum(q) * (1.f / D) + EPS);
        u32x2* op = (u32x2*)(F.hxc + (size_t)row * D) + F.lane;
#pragma unroll
        for (int j = 0; j < 4; ++j) { const f32x4 sh = *((const f32x4*)md + F.lane + 64 * j), sc = *((const f32x4*)(md + 1024) + F.lane + 64 * j);
            const f32x4 o = v[j] * rstd * (sc + 1.f) + sh; u32x2 w; w.x = pk2(o[0], o[1]); w.y = pk2(o[2], o[3]); op[64 * j] = w; }
    }
}

__device__ __forceinline__ void p_attn_simple(Frame& F) {
    LAS float* sq = (LAS float*)(F.lds + F.wave * 4096);
    LAS float* sp = sq + 64;
    const int gw = F.vcu * 8 + F.wave, NGW = F.G * 8;
    for (int gid = gw; gid < M * NH; gid += NGW) {
        const int h = gid & 7, tok = gid >> 3, b = tok >> 13, t = tok & (S - 1), r = t >> 6, c = t & 63;
        const int rs = min(max(r - KH / 2, 0), ROWS - KH), cs = min(max(c - KW / 2, 0), GW - KW);
        sq[F.lane] = bf2f(F.proj[(size_t)tok * DIN + h * 64 + F.lane]);
        LDS_WAIT(); asm volatile("" ::: "memory");
        float sc[6]; float mx = -1e30f;
#pragma unroll
        for (int i = 0; i < 6; ++i) {
            const int kk = F.lane + 64 * i;
            const bf16_t* kp; float bias = 0.f;
            if (kk < 128) { const int ki = kk >> 4, kj = kk & 15;
                kp = F.proj + (size_t)(b * S + (rs + ki) * GW + cs + kj) * DIN + 512 + h * 64;
                bias = F.rpb[(h * 15 + (rs + ki - r + 7)) * 31 + (cs + kj - c + 15)];
            } else kp = F.proj + (size_t)(M + b * CTX + (kk - 128)) * DIN + 512 + h * 64;
            float d = 0.f;
#pragma unroll
            for (int dd = 0; dd < 64; dd += 8) { const u32x4 kv = *(const u32x4*)(kp + dd);
                d += sq[dd] * bflo(kv.x) + sq[dd + 1] * bfhi(kv.x) + sq[dd + 2] * bflo(kv.y) + sq[dd + 3] * bfhi(kv.y) + sq[dd + 4] * bflo(kv.z) + sq[dd + 5] * bfhi(kv.z) + sq[dd + 6] * bflo(kv.w) + sq[dd + 7] * bfhi(kv.w); }
            sc[i] = d * 0.125f + bias; mx = fmaxf(mx, sc[i]);
        }
        mx = wmax(mx);
        float sum = 0.f;
#pragma unroll
        for (int i = 0; i < 6; ++i) { const float p = __expf(sc[i] - mx); sum += p; sp[F.lane + 64 * i] = p; }
        sum = wsum(sum);
        LDS_WAIT(); asm volatile("" ::: "memory");
        float acc = 0.f;
        for (int kk = 0; kk < 384; ++kk) {
            const bf16_t* vp;
            if (kk < 128) { const int ki = kk >> 4, kj = kk & 15; vp = F.proj + (size_t)(b * S + (rs + ki) * GW + cs + kj) * DIN + 1024 + h * 64; }
            else vp = F.proj + (size_t)(M + b * CTX + (kk - 128)) * DIN + 1024 + h * 64;
            acc += sp[kk] * bf2f(vp[F.lane]);
        }
        F.mixin[(size_t)tok * D + h * 64 + F.lane] = (bf16_t)f2bf(acc / sum);
        LDS_WAIT(); asm volatile("" ::: "memory");
    }
}
__device__ __forceinline__ void p_sgu_simple(Frame& F) {
    LAS bf16_t* G = (LAS bf16_t*)F.lds;
    for (int u = blockIdx.x; u < M / 128; u += F.G) {
        const int base = u * 128;
        for (int tl = F.wave; tl < 128; tl += 8) {
            const bf16_t* zr = F.proj + (size_t)(base + tl) * DIN + 2048 + F.lane * 8;
            const u32x4 zv = *(const u32x4*)zr;
            float v[8] = {bflo(zv.x), bfhi(zv.x), bflo(zv.y), bfhi(zv.y), bflo(zv.z), bfhi(zv.z), bflo(zv.w), bfhi(zv.w)};
            float s = 0.f;
#pragma unroll
            for (int i = 0; i < 8; ++i) s += v[i];
            const float mean = wsum(s) * (1.f / 512.f); float q = 0.f;
#pragma unroll
            for (int i = 0; i < 8; ++i) { v[i] -= mean; q += v[i] * v[i]; }
            const float rstd = rsqrtf(wsum(q) * (1.f / 512.f) + EPS);
#pragma unroll
            for (int i = 0; i < 8; ++i) { const int ch = F.lane * 8 + i; G[tl * 512 + ch] = (bf16_t)f2bf(v[i] * rstd * F.sgu_ln_g[ch] + F.sgu_ln_b[ch]); }
        }
        __syncthreads();
        const int ch = F.tid, grp = ch >> 7;
        for (int i = 0; i < 128; ++i) {
            const float* wrow = F.sgu_w + (size_t)(grp * 128 + i) * 128;
            float acc = 0.f;
            for (int j = 0; j < 128; ++j) acc += wrow[j] * bf2f(G[j * 512 + ch]);
            acc += F.sgu_b[grp * 128 + i];
            const float uu = bf2f(F.proj[(size_t)(base + i) * DIN + 1536 + ch]);
            F.mixin[(size_t)(base + i) * D + 512 + ch] = (bf16_t)f2bf(uu * acc);
        }
        __syncthreads();
    }
}

namespace at {
typedef float f32x16 __attribute__((ext_vector_type(16)));
typedef short s16x4 __attribute__((ext_vector_type(4)));
typedef short v4i16_t __attribute__((ext_vector_type(4)));
constexpr int A_K = 0, A_V = 32768, A_STG = 65536, A_WSF = 98304, A_RPB = 100352;
constexpr float C2 = 0.125f * 1.4426950408889634f, L2E = 1.4426950408889634f;
__device__ __forceinline__ int crow(int r, int hi) { return (r & 3) + 8 * (r >> 2) + 4 * hi; }
__device__ __forceinline__ s16x4 vtr(const LAS unsigned char* p) { return __builtin_bit_cast(s16x4, __builtin_amdgcn_ds_read_tr16_b64_v4i16((LAS v4i16_t*)p)); }
__device__ __forceinline__ int rsf(int r) { return min(max(r - KH / 2, 0), ROWS - KH); }
#define AT_WAIT_BAR() asm volatile("s_waitcnt vmcnt(0) lgkmcnt(0)\n\ts_barrier" ::: "memory")
__device__ __forceinline__ void glds16(const void* gsrc, unsigned lds_dst) { unsigned keep;
    asm volatile("s_mov_b32 %0, m0\n\ts_mov_b32 m0, %2\n\ts_nop 0\n\tglobal_load_lds_dwordx4 %1, off\n\ts_mov_b32 m0, %0" : "=&s"(keep) : "v"(gsrc), "s"(lds_dst) : "memory"); }

template <int MODE> __device__ __forceinline__ constexpr bool act0(int rr) { return MODE != 2 || rr >= 12; }
template <int MODE> __device__ __forceinline__ constexpr bool act1(int rr) { return MODE != 1 || rr < 4; }
template <int MODE>
__device__ __forceinline__ void tile_compute(const LAS unsigned char* kp0, const LAS unsigned char* vp, const LAS float* tb, const bf16x8 (&qr)[4], f32x16 (&o)[2], float& m, float& l,
                                             LAS float* wsf, int r32, int hi, int cs) {
    f32x16 p0, p1;
#pragma unroll
    for (int i = 0; i < 16; ++i) { p0[i] = 0.f; p1[i] = 0.f; }
#pragma unroll
    for (int d0 = 0; d0 < 4; ++d0) {
        const bf16x8 b0 = *(const LAS bf16x8*)(kp0 + d0 * 2048), b1 = *(const LAS bf16x8*)(kp0 + d0 * 2048 + 512);
        p0 = __builtin_amdgcn_mfma_f32_32x32x16_bf16(b0, qr[d0], p0, 0, 0, 0);
        p1 = __builtin_amdgcn_mfma_f32_32x32x16_bf16(b1, qr[d0], p1, 0, 0, 0);
    }
    float tm = -INFINITY;
#pragma unroll
    for (int rr = 0; rr < 16; ++rr) { const int ko = (rr & 3) + 8 * (rr >> 2), kc = ko + 4 * hi;
        if (MODE == 0) { p0[rr] *= C2; p1[rr] *= C2; tm = fmaxf(tm, fmaxf(p0[rr], p1[rr])); }
        else {
            if (act0<MODE>(rr)) { const float t0 = p0[rr] * C2 + tb[ko]; p0[rr] = (unsigned)(kc - cs) < (unsigned)KW ? t0 : -INFINITY; tm = fmaxf(tm, p0[rr]); }
            if (act1<MODE>(rr)) { const float t1 = p1[rr] * C2 + tb[ko + 32]; p1[rr] = (unsigned)(kc + 32 - cs) < (unsigned)KW ? t1 : -INFINITY; tm = fmaxf(tm, p1[rr]); }
        } }
    { float a = tm, bq = tm; asm volatile("s_nop 1\n\tv_permlane32_swap_b32 %0, %1" : "+v"(a), "+v"(bq)); tm = fmaxf(a, bq); }
    const float mn = fmaxf(m, tm), alpha = __builtin_amdgcn_exp2f(m - mn);
    float rsum = 0.f;
#pragma unroll
    for (int rr = 0; rr < 16; ++rr) {
        if (act0<MODE>(rr)) { p0[rr] = __builtin_amdgcn_exp2f(p0[rr] - mn); rsum += p0[rr]; } else p0[rr] = 0.f;
        if (act1<MODE>(rr)) { p1[rr] = __builtin_amdgcn_exp2f(p1[rr] - mn); rsum += p1[rr]; } else p1[rr] = 0.f; }
    l = l * alpha + rsum; m = mn;
    if (__any(alpha != 1.f)) {
        if (hi == 0) wsf[r32] = alpha;
        LDS_WAIT();
#pragma unroll
        for (int rr = 0; rr < 16; ++rr) { const float a = wsf[crow(rr, hi)]; o[0][rr] *= a; o[1][rr] *= a; }
        LDS_WAIT();
    }
    u32x4 pw[4];
#pragma unroll
    for (int q = 0; q < 4; ++q) { pw[0][q] = cvt_pk_bf16(p0[2 * q], p0[2 * q + 1]); pw[1][q] = cvt_pk_bf16(p0[8 + 2 * q], p0[9 + 2 * q]);
                                  pw[2][q] = cvt_pk_bf16(p1[2 * q], p1[2 * q + 1]); pw[3][q] = cvt_pk_bf16(p1[8 + 2 * q], p1[9 + 2 * q]); }
#pragma unroll
    for (int d0 = 0; d0 < 2; ++d0)
#pragma unroll
        for (int ks = 0; ks < 4; ++ks) {
            if ((MODE == 1 && ks == 3) || (MODE == 2 && ks == 0)) continue;
            const s16x4 lo = vtr(vp + d0 * 4096 + ks * 1024), hh = vtr(vp + d0 * 4096 + ks * 1024 + 512);
            const bf16x8 vf = (bf16x8){lo[0], lo[1], lo[2], lo[3], hh[0], hh[1], hh[2], hh[3]};
            o[d0] = __builtin_amdgcn_mfma_f32_32x32x16_bf16(__builtin_bit_cast(bf16x8, pw[ks]), vf, o[d0], 0, 0, 0);
        }
}

__device__ __forceinline__ void attn_unit(Frame& F, int b, int h, int rg) {
    const int lane = F.lane, r32 = lane & 31, hi = lane >> 5, w = F.wave;
    const int r0 = 4 * rg, r = r0 + (w >> 1), c = 32 * (w & 1) + r32;
    const int krlo = rsf(r0), nnb = rsf(r0 + 3) + 7 - krlo + 1, nst = nnb + 4;
    const int rsw = rsf(r), cs = min(max(c - KW / 2, 0), GW - KW);
    LAS float* tbl = (LAS float*)(F.lds + A_RPB);
    LAS float* wsf = (LAS float*)(F.lds + A_WSF) + w * 64;
    for (int i = F.tid; i < 480; i += 512) { const int dr = i >> 5, dc = i & 31; tbl[64 + i] = dc < 31 ? F.rpb[(h * 15 + dr) * 31 + dc] * L2E : 0.f; }
    const bf16_t* qp = F.proj + (size_t)(b * S + r * GW + c) * DIN + h * 64 + hi * 8;
    bf16x8 qr[4];
#pragma unroll
    for (int d0 = 0; d0 < 4; ++d0) qr[d0] = *(const bf16x8*)(qp + d0 * 16);
    const bf16_t* kbase = F.proj + 512 + h * 64 + w * 8;
    const bf16_t* vbase = F.proj + 1024 + h * 64 + (w >> 2) * 32 + (lane & 3) * 8;
#define AT_DMA(st) do { const int _t0 = (st) < nnb ? b * S + (krlo + (st)) * GW : M + b * CTX + ((st) - nnb) * 64; const int _bf = ((st) & 3) * 8192; \
        __builtin_amdgcn_global_load_lds((const unsigned*)(kbase + (size_t)(_t0 + lane) * DIN), (LAS unsigned*)(F.lds + A_K + _bf + w * 1024), 16, 0, 0); \
        __builtin_amdgcn_global_load_lds((const unsigned*)(vbase + (size_t)(_t0 + 16 * (w & 3) + (lane >> 2)) * DIN), (LAS unsigned*)(F.lds + A_V + _bf + w * 1024), 16, 0, 0); } while (0)
    const unsigned lds0 = (unsigned)(size_t)F.lds;
    float m = -1e30f, l = 0.f;
    f32x16 o[2];
#pragma unroll
    for (int i = 0; i < 16; ++i) { o[0][i] = 0.f; o[1][i] = 0.f; }
    AT_DMA(0); AT_DMA(1); AT_DMA(2);
    for (int st = 0; st < nst; ++st) {
        if (st + 2 < nst) asm volatile("s_waitcnt vmcnt(4) lgkmcnt(0)\n\ts_barrier" ::: "memory");
        else if (st + 1 < nst) asm volatile("s_waitcnt vmcnt(2) lgkmcnt(0)\n\ts_barrier" ::: "memory");
        else AT_WAIT_BAR();
        if (st + 3 < nst) AT_DMA(st + 3);
        const bool isnb = st < nnb; const int kr = krlo + st;
        const bool act = !isnb || (kr >= rsw && kr < rsw + KH);
        if (act) {
            const LAS unsigned char* kp0 = F.lds + A_K + (st & 3) * 8192 + hi * 1024 + r32 * 16;
            const LAS unsigned char* vp = F.lds + A_V + (st & 3) * 8192 + ((lane >> 4) & 1) * 32 + (lane & 3) * 8 + (4 * hi + ((lane & 15) >> 2)) * 64;
            const LAS float* tb = tbl + 64 + (kr - r + 7) * 32 + 4 * hi - c + 15;
            if (!isnb) tile_compute<0>(kp0, vp, tb, qr, o, m, l, wsf, r32, hi, cs);
            else if ((w & 1) == 0) tile_compute<1>(kp0, vp, tb, qr, o, m, l, wsf, r32, hi, cs);
            else tile_compute<2>(kp0, vp, tb, qr, o, m, l, wsf, r32, hi, cs);
        }
    }
#undef AT_DMA
    l += __shfl_xor(l, 32);
    if (hi == 0) wsf[32 + r32] = l;
    LDS_WAIT();
    LAS bf16_t* stg = (LAS bf16_t*)(F.lds + A_STG) + w * 2048;
#pragma unroll
    for (int rr = 0; rr < 16; ++rr) { const int orow = crow(rr, hi); const float rl = __builtin_amdgcn_rcpf(wsf[32 + orow]);
        stg[orow * 64 + r32] = (bf16_t)f2bf(o[0][rr] * rl); stg[orow * 64 + 32 + r32] = (bf16_t)f2bf(o[1][rr] * rl); }
    LDS_WAIT();
    bf16_t* ow = F.mixin + (size_t)(b * S + r * GW + 32 * (w & 1)) * D + h * 64;
#pragma unroll
    for (int i = 0; i < 4; ++i) { const int row = i * 8 + (lane >> 3), ch = lane & 7; const u32x4 v = *(const LAS u32x4*)(stg + row * 64 + ch * 8); *(u32x4*)(ow + (size_t)row * D + ch * 8) = v; }
    AT_WAIT_BAR();
}

constexpr int G_IMG = 0, G_STG = 65536, G_STAT = 98304;
__device__ __forceinline__ void sgu_unit(Frame& F, int chunk, int gh) {
    const int lane = F.lane, r32 = lane & 31, hi = lane >> 5, w = F.wave;
    const int base = chunk * 128;
    LAS f32x2* stat = (LAS f32x2*)(F.lds + G_STAT);
    u32x4 zrow[16];
#pragma unroll
    for (int t = 0; t < 16; ++t) zrow[t] = *(const u32x4*)(F.proj + (size_t)(base + 16 * w + t) * DIN + 2048 + lane * 8);
    const int cb = w & 3, th = w >> 2, grp = 2 * gh + (cb >> 1);
    const bf16_t* wp = F.sguw + (size_t)(grp * 128 + 64 * th + r32) * 128 + 8 * hi;
    bf16x8 wf0[8], wf1[8];
#pragma unroll
    for (int ks = 0; ks < 8; ++ks) { wf0[ks] = *(const bf16x8*)(wp + ks * 16); wf1[ks] = *(const bf16x8*)(wp + 32 * 128 + ks * 16); }
#pragma unroll
    for (int t = 0; t < 16; ++t) {
        const int tok = 16 * w + t;
        const u32x4 zv = zrow[t];
        float v[8] = {bflo(zv.x), bfhi(zv.x), bflo(zv.y), bfhi(zv.y), bflo(zv.z), bfhi(zv.z), bflo(zv.w), bfhi(zv.w)};
        float s = 0.f;
#pragma unroll
        for (int i = 0; i < 8; ++i) s += v[i];
        const float mean = wsum(s) * (1.f / 512.f); float q = 0.f;
#pragma unroll
        for (int i = 0; i < 8; ++i) { const float d = v[i] - mean; q += d * d; }
        const float rstd = rsqrtf(wsum(q) * (1.f / 512.f) + EPS);
        if (lane == 0) stat[tok] = (f32x2){mean, rstd};
    }
    AT_WAIT_BAR();
    {
        const int ch0 = 256 * gh + 32 * w + 8 * (lane & 3);
        const f32x4 g0 = *(const f32x4*)(F.sgu_ln_g + ch0), g1 = *(const f32x4*)(F.sgu_ln_g + ch0 + 4), b0 = *(const f32x4*)(F.sgu_ln_b + ch0), b1 = *(const f32x4*)(F.sgu_ln_b + ch0 + 4);
#pragma unroll
        for (int i = 0; i < 8; ++i) {
            const int tok = 16 * i + (lane >> 2);
            const u32x4 zv = *(const u32x4*)(F.proj + (size_t)(base + tok) * DIN + 2048 + ch0);
            const f32x2 st = stat[tok];
            u32x4 o;
            o.x = pk2((bflo(zv.x) - st[0]) * st[1] * g0[0] + b0[0], (bfhi(zv.x) - st[0]) * st[1] * g0[1] + b0[1]);
            o.y = pk2((bflo(zv.y) - st[0]) * st[1] * g0[2] + b0[2], (bfhi(zv.y) - st[0]) * st[1] * g0[3] + b0[3]);
            o.z = pk2((bflo(zv.z) - st[0]) * st[1] * g1[0] + b1[0], (bfhi(zv.z) - st[0]) * st[1] * g1[1] + b1[1]);
            o.w = pk2((bflo(zv.w) - st[0]) * st[1] * g1[2] + b1[2], (bfhi(zv.w) - st[0]) * st[1] * g1[3] + b1[3]);
            *(LAS u32x4*)(F.lds + G_IMG + w * 8192 + i * 1024 + lane * 16) = o;
        }
    }
    AT_WAIT_BAR();
    f32x16 acc[2][2];
#pragma unroll
    for (int a = 0; a < 2; ++a)
#pragma unroll
        for (int q = 0; q < 2; ++q)
#pragma unroll
            for (int i = 0; i < 16; ++i) acc[a][q][i] = 0.f;
    const LAS unsigned char* gp = F.lds + G_IMG + (2 * cb) * 8192 + ((lane >> 4) & 1) * 32 + (lane & 3) * 8 + (8 * hi + ((lane & 15) >> 2)) * 64;
#pragma unroll
    for (int ks = 0; ks < 8; ++ks) {
        const bf16x8 w0 = wf0[ks], w1 = wf1[ks];
#pragma unroll
        for (int c32 = 0; c32 < 2; ++c32) {
            const s16x4 lo = vtr(gp + c32 * 8192 + ks * 1024), hh = vtr(gp + c32 * 8192 + ks * 1024 + 256);
            const bf16x8 gf = (bf16x8){lo[0], lo[1], lo[2], lo[3], hh[0], hh[1], hh[2], hh[3]};
            acc[0][c32] = __builtin_amdgcn_mfma_f32_32x32x16_bf16(gf, w0, acc[0][c32], 0, 0, 0);
            acc[1][c32] = __builtin_amdgcn_mfma_f32_32x32x16_bf16(gf, w1, acc[1][c32], 0, 0, 0);
        }
    }
    LAS unsigned char* stg = F.lds + G_STG + w * 4096;
#pragma unroll
    for (int ib = 0; ib < 2; ++ib) {
        const int i0 = 64 * th + 32 * ib;
        const float bi = F.sgu_b[grp * 128 + i0 + r32];
#pragma unroll
        for (int c32 = 0; c32 < 2; ++c32)
#pragma unroll
            for (int a = 0; a < 4; ++a) { u32x2 o; o.x = pk2(acc[ib][c32][4 * a] + bi, acc[ib][c32][4 * a + 1] + bi); o.y = pk2(acc[ib][c32][4 * a + 2] + bi, acc[ib][c32][4 * a + 3] + bi);
                *(LAS u32x2*)(stg + r32 * 128 + (((4 * c32 + a) ^ (r32 & 7)) << 4) + hi * 8) = o; }
        LDS_WAIT();
#pragma unroll
        for (int it = 0; it < 4; ++it) {
            const int row = 8 * it + (lane >> 3), chn = lane & 7;
            const u32x4 v = *(const LAS u32x4*)(stg + row * 128 + ((chn ^ (row & 7)) << 4));
            const size_t tok = (size_t)(base + i0 + row);
            const u32x4 uv = *(const u32x4*)(F.proj + tok * DIN + 1536 + 256 * gh + 64 * cb + 8 * chn);
            u32x4 o;
            o.x = pk2(bflo(v.x) * bflo(uv.x), bfhi(v.x) * bfhi(uv.x)); o.y = pk2(bflo(v.y) * bflo(uv.y), bfhi(v.y) * bfhi(uv.y));
            o.z = pk2(bflo(v.z) * bflo(uv.z), bfhi(v.z) * bfhi(uv.z)); o.w = pk2(bflo(v.w) * bflo(uv.w), bfhi(v.w) * bfhi(uv.w));
            *(u32x4*)(F.mixin + tok * D + 512 + 256 * gh + 64 * cb + 8 * chn) = o;
        }
        LDS_WAIT();
    }
    AT_WAIT_BAR();
}
__device__ __forceinline__ void p_mixer(Frame& F) {
#ifndef PROBE_MIX_A
#define PROBE_MIX_A 1
#endif
#ifndef PROBE_MIX_S
#define PROBE_MIX_S 1
#endif
#pragma unroll 1
    for (int rep = 0; rep < PROBE_MIX_A; ++rep)
    for (int uid = F.vcu; uid < NB * NH * 32; uid += F.G) attn_unit(F, uid >> 8, (uid >> 5) & 7, uid & 31);
#pragma unroll 1
    for (int rep = 0; rep < PROBE_MIX_S; ++rep)
    for (int uid = F.vcu; uid < (M / 128) * 2; uid += F.G) sgu_unit(F, uid >> 1, uid & 1);
}
#undef AT_WAIT_BAR
}

__device__ __forceinline__ void route_select(Frame& F, float lgt, int e, int lane, int tl, int tok, LAS int* lcnt, LAS int* sel, LAS float* selg) {
    int rank = 0; float mx = -3.0e38f;
#pragma unroll
    for (int e2 = 0; e2 < NE; ++e2) { const float o = rlane(lgt, ((e2 >> 4) << 5) | (((e2 >> 3) & 1) << 4) | (e2 & 7));
        rank += (o > lgt || (o == lgt && e2 < e)) ? 1 : 0; mx = fmaxf(mx, o); }
    const bool selq = rank < TOPK && !(lane & 8);
    const float pe = selq ? __expf(lgt - mx) : 0.f;
    const float den = wsum(pe);
    if (selq) {
        const int lp = __hip_atomic_fetch_add(lcnt + e, 1, __ATOMIC_RELAXED, __HIP_MEMORY_SCOPE_WORKGROUP);
        sel[tl * 4 + rank] = e | (lp << 8); selg[tl * 4 + rank] = pe / den;
        F.topg[tok * 4 + rank] = pe / den; F.topi[tok * 4 + rank] = e;
    }
}
__device__ __forceinline__ float route_reduce(const f32x2 (&lg2)[NE / 2], int lane) {
    float r16[16], r8[8];
#pragma unroll
    for (int e = 0; e < 16; ++e) { float a = lg2[e >> 1][e & 1], bq = lg2[(e + 16) >> 1][e & 1]; asm volatile("s_nop 1\n\tv_permlane32_swap_b32 %0, %1" : "+v"(a), "+v"(bq)); r16[e] = a + bq; }
#pragma unroll
    for (int e = 0; e < 8; ++e) { float a = r16[e], bq = r16[e + 8]; asm volatile("s_nop 1\n\tv_permlane16_swap_b32 %0, %1" : "+v"(a), "+v"(bq)); r8[e] = a + bq; }
    float r1 = 0.f;
#pragma unroll
    for (int e = 0; e < 8; ++e) { float t = r8[e]; t += dppf<0xB1>(t); t += dppf<0x4E>(t); t += dppf<0x141>(t); t += dppf<0x140>(t); r1 = ((lane & 7) == e) ? t : r1; }
    return r1;
}
__device__ __forceinline__ void p_route(Frame& F) {
    LAS int* lcnt = (LAS int*)(F.lds + L_ROUTE); LAS int* gbase = lcnt + 32; LAS int* sel = lcnt + 64; LAS float* selg = (LAS float*)(F.lds + L_RPB);
    for (int i = F.tid; i < 8192; i += 512) { const int c = i >> 3, q = i & 7; *(LAS f32x4*)(F.lds + c * 128 + ((q ^ ((c >> 1) & 7)) << 4)) = *(const f32x4*)(F.router_w + c * 32 + q * 4); }
    if (F.tid < 32) lcnt[F.tid] = 0;
    __syncthreads();
    const int lane = F.lane;
    const LAS unsigned char* wbase = F.lds + lane * 128;
    const int sw = (lane >> 1) & 7;
    LAS unsigned char* hrowA = F.lds + L_WSCR + F.wave * 2048; LAS unsigned char* hrowB = hrowA + 1024;
    const int e = ((lane >> 5) << 4) | (((lane >> 4) & 1) << 3) | (lane & 7);
    const float rbias = F.router_b[e];
    for (int tb = blockIdx.x; tb < M / 64; tb += F.G) {
        const int b = (tb * 64) >> 13;
        float ps[16], ph[16];
#pragma unroll
        for (int i = 0; i < 16; ++i) { const int col = lane + 64 * i; ps[i] = 1.f + F.mod[b * 6144 + 4 * 1024 + col]; ph[i] = F.mod[b * 6144 + 3 * 1024 + col]; }
#pragma unroll 1
        for (int k = 0; k < 4; ++k) {
            const int tlA = F.wave + 8 * k, tlB = tlA + 32, tokA = tb * 64 + tlA, tokB = tb * 64 + tlB;
            float vA[16], vB[16]; float sA = 0.f, sB = 0.f;
            float pg[16], pb[16];
#pragma unroll
            for (int i = 0; i < 16; ++i) { pg[i] = F.ln1_g[lane + 64 * i]; pb[i] = F.ln1_b[lane + 64 * i]; }
            { const bf16_t* ya = F.y1 + (size_t)tokA * D; const bf16_t* yb = F.y1 + (size_t)tokB * D;
#pragma unroll
              for (int i = 0; i < 16; ++i) { vA[i] = bf2f(ya[lane + 64 * i]); vB[i] = bf2f(yb[lane + 64 * i]); }
#pragma unroll
              for (int i = 0; i < 16; ++i) { sA += vA[i]; sB += vB[i]; } }
            float meanA = wsum(sA) * (1.f / D), meanB = wsum(sB) * (1.f / D), qA = 0.f, qB = 0.f;
#pragma unroll
            for (int i = 0; i < 16; ++i) { vA[i] -= meanA; qA += vA[i] * vA[i]; vB[i] -= meanB; qB += vB[i] * vB[i]; }
            float rstdA = rsqrtf(wsum(qA) * (1.f / D) + EPS), rstdB = rsqrtf(wsum(qB) * (1.f / D) + EPS);
            if (lane == 0) { F.stat[tokA] = (f32x2){meanA, rstdA}; F.stat[tokB] = (f32x2){meanB, rstdB}; }
            sA = 0.f; sB = 0.f;
#pragma unroll
            for (int i = 0; i < 16; ++i) { vA[i] = vA[i] * rstdA * pg[i] + pb[i]; sA += vA[i]; vB[i] = vB[i] * rstdB * pg[i] + pb[i]; sB += vB[i]; }
#ifdef MK_WRITE_X1
#pragma unroll
            for (int i = 0; i < 16; ++i) { F.x1[(size_t)tokA * D + lane + 64 * i] = vA[i]; F.x1[(size_t)tokB * D + lane + 64 * i] = vB[i]; }
#endif
            meanA = wsum(sA) * (1.f / D); meanB = wsum(sB) * (1.f / D); qA = 0.f; qB = 0.f;
#pragma unroll
            for (int i = 0; i < 16; ++i) { vA[i] -= meanA; qA += vA[i] * vA[i]; vB[i] -= meanB; qB += vB[i] * vB[i]; }
            rstdA = rsqrtf(wsum(qA) * (1.f / D) + EPS); rstdB = rsqrtf(wsum(qB) * (1.f / D) + EPS);
#pragma unroll
            for (int i = 0; i < 16; ++i) { vA[i] = vA[i] * rstdA * ps[i] + ph[i]; vB[i] = vB[i] * rstdB * ps[i] + ph[i];
                hrowA[lane + 64 * i] = (unsigned char)__builtin_amdgcn_cvt_pk_fp8_f32(vA[i], vA[i], 0, false); hrowB[lane + 64 * i] = (unsigned char)__builtin_amdgcn_cvt_pk_fp8_f32(vB[i], vB[i], 0, false); }
            f32x2 lgA[NE / 2], lgB[NE / 2];
#pragma unroll
            for (int q = 0; q < NE / 2; ++q) { lgA[q] = (f32x2){0.f, 0.f}; lgB[q] = (f32x2){0.f, 0.f}; }
#pragma unroll
            for (int i = 0; i < 16; ++i) {
                f32x4 wa[8];
#pragma unroll
                for (int qq = 0; qq < 8; ++qq) wa[qq] = *(const LAS f32x4*)(wbase + i * 8192 + ((qq ^ sw) << 4));
                __builtin_amdgcn_sched_barrier(0);
                const f32x2 ha = (f32x2){vA[i], vA[i]}, hb = (f32x2){vB[i], vB[i]};
#pragma unroll
                for (int qq = 0; qq < 8; ++qq) { const f32x2 w0 = (f32x2){wa[qq][0], wa[qq][1]}, w1 = (f32x2){wa[qq][2], wa[qq][3]};
                    lgA[2 * qq] = __builtin_elementwise_fma(ha, w0, lgA[2 * qq]); lgA[2 * qq + 1] = __builtin_elementwise_fma(ha, w1, lgA[2 * qq + 1]);
                    lgB[2 * qq] = __builtin_elementwise_fma(hb, w0, lgB[2 * qq]); lgB[2 * qq + 1] = __builtin_elementwise_fma(hb, w1, lgB[2 * qq + 1]); }
                __builtin_amdgcn_sched_barrier(0);
            }
            LDS_WAIT();
            *(u32x4*)(F.h2 + (size_t)tokA * D + lane * 16) = *(const LAS u32x4*)(hrowA + lane * 16);
            *(u32x4*)(F.h2 + (size_t)tokB * D + lane * 16) = *(const LAS u32x4*)(hrowB + lane * 16);
            const float lgtA = route_reduce(lgA, lane) + rbias, lgtB = route_reduce(lgB, lane) + rbias;
            route_select(F, lgtA, e, lane, tlA, tokA, lcnt, sel, selg);
            route_select(F, lgtB, e, lane, tlB, tokB, lcnt, sel, selg);
        }
        __syncthreads();
        if (F.tid < 32) { const int n = lcnt[F.tid]; gbase[F.tid] = n ? (int)__hip_atomic_fetch_add(F.cntw + 32 * F.tid, (unsigned)n, __ATOMIC_RELAXED, __HIP_MEMORY_SCOPE_AGENT) : 0; lcnt[F.tid] = 0; }
        __syncthreads();
        if (F.tid < 256) { const int sv = sel[F.tid], ee = sv & 255, lp = sv >> 8; F.list[(size_t)ee * LCAP + gbase[ee] + lp] = (tb * 64 + (F.tid >> 2)) * 4 + (F.tid & 3); F.listg[(size_t)ee * LCAP + gbase[ee] + lp] = selg[F.tid]; }
        __syncthreads();
    }
}

__device__ __forceinline__ void p_final(Frame& F) {
    const int gw = F.vcu * 8 + F.wave, NGW = F.G * 8;
    for (int tok = gw; tok < M; tok += NGW) {
        const float* g2 = F.mod + (tok >> 13) * 6144 + 5 * 1024;
        const u32x2* xp = (const u32x2*)(F.y1 + (size_t)tok * D) + F.lane;
        const f32x2 st = F.stat[tok];
        f32x4 v[4]; float s = 0.f;
#pragma unroll
        for (int j = 0; j < 4; ++j) {
            f32x4 f = (f32x4){0.f, 0.f, 0.f, 0.f};
#pragma unroll
            for (int k = 0; k < TOPK; ++k) { const u32x2 yv = __builtin_nontemporal_load((const u32x2*)(F.ybuf + (size_t)(tok * 4 + k) * D) + F.lane + 64 * j);
                f[0] += bflo(yv.x); f[1] += bfhi(yv.x); f[2] += bflo(yv.y); f[3] += bfhi(yv.y); }
            const f32x4 gv = *((const f32x4*)g2 + F.lane + 64 * j);
            const f32x4 l1g = *((const f32x4*)F.ln1_g + F.lane + 64 * j), l1b = *((const f32x4*)F.ln1_b + F.lane + 64 * j);
            const u32x2 yw = __builtin_nontemporal_load(xp + 64 * j); const f32x4 yv = (f32x4){bflo(yw.x), bfhi(yw.x), bflo(yw.y), bfhi(yw.y)};
            const f32x4 x1v = (yv - st[0]) * st[1] * l1g + l1b;
            v[j] = x1v * DN_ALPHA + gv * f; s += (v[j][0] + v[j][1]) + (v[j][2] + v[j][3]);
        }
        const float mean = wsum(s) * (1.f / D); float q = 0.f;
#pragma unroll
        for (int j = 0; j < 4; ++j) { v[j] = v[j] - mean; q += (v[j][0] * v[j][0] + v[j][1] * v[j][1]) + (v[j][2] * v[j][2] + v[j][3] * v[j][3]); }
        const float rstd = rsqrtf(wsum(q) * (1.f / D) + EPS);
        f32x4* op = (f32x4*)(F.out + (size_t)tok * D) + F.lane;
#pragma unroll
        for (int j = 0; j < 4; ++j) { const f32x4 gg = *((const f32x4*)F.ln2_g + F.lane + 64 * j), bb = *((const f32x4*)F.ln2_b + F.lane + 64 * j); op[64 * j] = v[j] * rstd * gg + bb; }
    }
}

struct Args { const float* in[23]; float* out; unsigned char* ws; int ph_lo, ph_hi, alt, pad; };
constexpr int N_PHASES = 9;
__global__ void __launch_bounds__(512, 2) mk_fwd(Args args) {
    extern __shared__ __attribute__((aligned(16))) unsigned char lds_raw[];
    Frame F;
    F.lds = (LAS unsigned char*)lds_raw;
    F.MISC = (volatile LAS unsigned*)(F.lds + L_MISC);
    F.tid = threadIdx.x; F.lane = F.tid & 63; F.wave = __builtin_amdgcn_readfirstlane(F.tid >> 6);
    F.G = gridDim.x; { const int bx = blockIdx.x; F.vcu = (F.G % 8 == 0) ? (bx % 8) * (F.G / 8) + bx / 8 : bx; }
    unsigned char* ws = args.ws;
    F.ctl = (unsigned*)(ws + WS_CTL);
    F.x = args.in[0]; F.c = args.in[1]; F.ctx = args.in[2]; F.c_ctx = args.in[3]; F.ada_w = args.in[4]; F.ada_b = args.in[5]; F.w_in = args.in[6]; F.rpb = args.in[7];
    F.sgu_ln_g = args.in[8]; F.sgu_ln_b = args.in[9]; F.sgu_w = args.in[10]; F.sgu_b = args.in[11]; F.w_out = args.in[12]; F.ln1_g = args.in[13]; F.ln1_b = args.in[14];
    F.ln2_g = args.in[15]; F.ln2_b = args.in[16]; F.router_w = args.in[17]; F.router_b = args.in[18]; F.w_gu = args.in[19]; F.b_gu = args.in[20]; F.w_dn = args.in[21]; F.b_dn = args.in[22];
    F.out = args.out;
    F.mod = (float*)(ws + WS_MOD); F.topg = (float*)(ws + WS_TOPG); F.topi = (int*)(ws + WS_TOPI); F.list = (int*)(ws + WS_LIST); F.listg = (float*)(ws + WS_LISTG); F.sguw = (bf16_t*)(ws + WS_SGUW);
    F.Wt_in = (bf16_t*)(ws + WS_WIN); F.Wt_out = (bf16_t*)(ws + WS_WOUT); F.Wt_gu = ws + WS_WGU; F.Wt_dn = ws + WS_WDN;
    F.hxc = (bf16_t*)(ws + WS_HXC); F.proj = (bf16_t*)(ws + WS_PROJ); F.mixin = (bf16_t*)(ws + WS_MIXIN); F.y1 = (bf16_t*)(ws + WS_Y1); F.x1 = (float*)(ws + WS_X1); F.stat = (f32x2*)(ws + WS_STAT); F.cntw = F.ctl + CW_CNT; F.h2 = ws + WS_H2;
    F.act = ws + WS_ACT; F.ybuf = (bf16_t*)(ws + WS_YBUF);
    for (int u = F.tid; u < (LDS_BYTES - L_MISC) / 4; u += 512) ((LAS unsigned*)(F.lds + L_MISC))[u] = 0u;
    __syncthreads();
    if (args.alt) { F.x1 = (float*)(ws + WS_ALT); F.h2 = ws + WS_ALT + 64 * MiB; F.list = (int*)(ws + WS_ALT + 80 * MiB); F.listg = (float*)(ws + WS_ALT + 84 * MiB); F.topg = (float*)(ws + WS_ALT + 82 * MiB); F.topi = (int*)(ws + WS_ALT + 82 * MiB + 512 * 1024); F.cntw = F.ctl + CW_CNT_ALT; F.stat = (f32x2*)(ws + WS_ALT + 83 * MiB); }
    const int lo = args.ph_lo, hi = args.ph_hi;
    const bool one = (hi - lo) > 1;
    XcdBarrier bar; bar.bar = (unsigned*)(F.ctl + CW_BAR); bar.x = 0; bar.st = nullptr;
    if (one) bar = xcd_barrier_post((unsigned*)(F.ctl + CW_BAR), F.MISC + 8);
#define IN(k) (lo <= (k) && (k) < hi)
#define SEAM(k) do { if (IN(k) && IN((k) + 1)) xcd_barrier(bar); } while (0)
#ifndef PROBE_REPS
#define PROBE_REPS {1, 1, 1, 1, 1, 1, 1, 1, 1}
#endif
    constexpr int REPS[N_PHASES] = PROBE_REPS;
#define REPEAT(k) _Pragma("unroll") for (int rep_ = 0; rep_ < REPS[k]; ++rep_)
#define RSEAM(k) do { if (rep_ + 1 < REPS[k]) xcd_barrier(bar); else SEAM(k); } while (0)
    constexpr int W_ITEMS = 16 * 80 + 16 * 32 + NE * 16 * 64 + NE * 16 * 32, W_TAIL = 7680;
    const bool tail_wg = (F.G == 256 && (int)blockIdx.x >= 136);
    if (IN(0)) REPEAT(0) { p_ada(F); p_weights(F, 0, (F.G == 256) ? W_ITEMS - W_TAIL : W_ITEMS, F.vcu * 8 + F.wave, F.G * 8, true); RSEAM(0); }
    if (IN(1)) REPEAT(1) { p_lnmod(F); RSEAM(1); }
    if (IN(2)) REPEAT(2) { PolProj P{F.hxc, F.Wt_in, F.proj, F.G, (int)blockIdx.x}; pg8::gemm_phase<PolProj>(F.lds, P);
        if (tail_wg) p_weights(F, W_ITEMS - W_TAIL, W_TAIL, ((int)blockIdx.x - 136) * 8 + F.wave, 120 * 8, false); RSEAM(2); }
    if (IN(3)) REPEAT(3) { at::p_mixer(F); RSEAM(3); }
    if (IN(4)) REPEAT(4) { PolOut P{F.mixin, F.Wt_out, F.x, F.mod, F.y1, F.G, (int)blockIdx.x}; pg8::gemm_phase<PolOut>(F.lds, P); RSEAM(4); }
    if (IN(5)) { p_route(F); SEAM(5); }
    if (IN(6)) REPEAT(6) { const int T = expert_tables(F); ExpTab tb{(const LAS int*)(F.lds + L_TILEE), (const LAS int*)(F.lds + L_TSTART), (const LAS int*)(F.lds + L_TSTART) + 64, T};
        PolGU P{F.h2, F.Wt_gu, F.b_gu, F.list, F.act, tb, F.G, (int)blockIdx.x}; pg8::gemm_phase<PolGU>(F.lds, P); RSEAM(6); }
    if (IN(7)) REPEAT(7) { const int T = expert_tables(F); ExpTab tb{(const LAS int*)(F.lds + L_TILEE), (const LAS int*)(F.lds + L_TSTART), (const LAS int*)(F.lds + L_TSTART) + 64, T};
        PolDN P{F.act, F.Wt_dn, F.b_dn, F.list, F.listg, F.ybuf, tb, F.G, (int)blockIdx.x}; pg8::gemm_phase<PolDN>(F.lds, P); RSEAM(7); }
    if (IN(8)) REPEAT(8) { p_final(F); if (rep_ + 1 < REPS[8]) xcd_barrier(bar); }
#undef IN
#undef SEAM
#undef REPEAT
#undef RSEAM
}

static inline void launch_forward(void* const* d_in, void* d_out, void* d_ws, hipStream_t stream, int n_launches) {
    static int grid = 0;
    if (grid == 0) {
        int dev = 0, cus = 0;
        if (hipGetDevice(&dev) != hipSuccess || hipDeviceGetAttribute(&cus, hipDeviceAttributeMultiprocessorCount, dev) != hipSuccess) { fprintf(stderr, "kernel_launch: device query failed\n"); grid = -1; return; }
        if (hipFuncSetAttribute((const void*)mk_fwd, hipFuncAttributeMaxDynamicSharedMemorySize, LDS_BYTES) != hipSuccess) { fprintf(stderr, "kernel_launch: hipFuncSetAttribute failed\n"); grid = -1; return; }
        int per_cu = 0;
        if (hipOccupancyMaxActiveBlocksPerMultiprocessor(&per_cu, (const void*)mk_fwd, 512, LDS_BYTES) != hipSuccess || per_cu < 1) fprintf(stderr, "kernel_launch: occupancy query says %d\n", per_cu);
        (void)hipGetLastError();
        grid = cus;
    }
    if (grid < 0) return;
    (void)hipMemsetAsync((char*)d_ws + WS_CTL, 0, CTL_ZERO_BYTES, stream);
    Args a{};
    for (int i = 0; i < 23; ++i) a.in[i] = (const float*)d_in[i];
    a.out = (float*)d_out; a.ws = (unsigned char*)d_ws;
    if (n_launches == 1) { a.ph_lo = 0; a.ph_hi = N_PHASES; hipLaunchKernelGGL(mk_fwd, dim3(grid), dim3(512), LDS_BYTES, stream, a); }
    else for (int p = 0; p < N_PHASES; ++p) { a.ph_lo = p; a.ph_hi = p + 1; hipLaunchKernelGGL(mk_fwd, dim3(grid), dim3(512), LDS_BYTES, stream, a); }
#ifdef PROBE_EXTRA
    { const int extra[] = PROBE_EXTRA; for (int p : extra) { a.ph_lo = p; a.ph_hi = p + 1; a.alt = (p == 5); hipLaunchKernelGGL(mk_fwd, dim3(grid), dim3(512), LDS_BYTES, stream, a); } }
#endif
}
}
extern "C" void kernel_launch(void* const* d_in, const int* in_sizes, int n_in, void* d_out, int out_size, void* d_ws, size_t ws_size, hipStream_t stream) {
    if (ws_size < mk::WS_END || n_in != 23) { fprintf(stderr, "kernel_launch: unexpected workspace / inputs (%zu, %d)\n", ws_size, n_in); return; }
    mk::launch_forward(d_in, d_out, d_ws, stream, 1);
}
```

```cpp
#include <hip/hip_runtime.h>
#include <stdint.h>
#include <stdio.h>

#define GAS __attribute__((address_space(1)))
#define LAS __attribute__((address_space(3)))
typedef unsigned short bf16_t;
typedef short bf16x8 __attribute__((ext_vector_type(8)));
typedef float f32x4 __attribute__((ext_vector_type(4)));
typedef float f32x2 __attribute__((ext_vector_type(2)));
typedef unsigned u32x4 __attribute__((ext_vector_type(4)));
typedef unsigned u32x2 __attribute__((ext_vector_type(2)));

namespace mk {
constexpr int D = 1024, NB = 2, S = 8192, M = NB * S, GW = 64, ROWS = 128, CTX = 256, NH = 8, KH = 8, KW = 16;
constexpr int NE = 32, TOPK = 4, DFF = 1024, DIN = 2560, NPAIR = M * TOPK, MX = M + NB * CTX;
constexpr int LCAP = 16384, MAXT = 288, ACT_ROWS = MAXT * 256;
constexpr float EPS = 1e-5f;
constexpr float DN_ALPHA = 1.189207115002721f;
constexpr size_t MiB = 1u << 20;
constexpr size_t WS_CTL = 0, CTL_ZERO_BYTES = 1 * MiB;
constexpr size_t WS_MOD = 1 * MiB;
constexpr size_t WS_TOPG = 2 * MiB;
constexpr size_t WS_TOPI = 2 * MiB + 512 * 1024;
constexpr size_t WS_STAT = 5 * MiB + 512 * 1024;
constexpr size_t WS_LIST = 3 * MiB;
constexpr size_t WS_SGUW = 5 * MiB;
constexpr size_t WS_LISTG = 14 * MiB;
constexpr size_t WS_WIN = 6 * MiB;
constexpr size_t WS_WOUT = 11 * MiB;
constexpr size_t WS_WGU = 16 * MiB;
constexpr size_t WS_WDN = 144 * MiB;
constexpr size_t WS_HXC = 208 * MiB;
constexpr size_t WS_PROJ = 241 * MiB;
constexpr size_t WS_MIXIN = 324 * MiB;
constexpr size_t WS_Y1 = 356 * MiB;
constexpr size_t WS_H2 = 420 * MiB;
constexpr size_t WS_ACT = 452 * MiB;
constexpr size_t WS_YBUF = 596 * MiB;
constexpr size_t WS_X1 = 724 * MiB;
constexpr size_t WS_END = 788 * MiB;
constexpr size_t WS_ALT = 788 * MiB;
constexpr int CW_CNT_ALT = 12288;
constexpr int CW_BAR = 4096;
constexpr int CW_CNT = 8192;
constexpr int RING_BYTES = 131072;
constexpr int L_MISC = RING_BYTES;
constexpr int L_IDX = L_MISC + 1024;
constexpr int L_TILEE = L_IDX + 6144;
constexpr int L_TSTART = L_TILEE + 1280;
constexpr int L_ROUTE = L_TSTART + 512;
constexpr int L_RPB = L_ROUTE + 256 + 1024;
constexpr int L_WSCR = L_RPB + 2048;
constexpr int LDS_BYTES = 163840;
static_assert(L_WSCR + 8 * 2048 <= LDS_BYTES, "LDS map");

template <int CTRL> __device__ __forceinline__ float dppf(float v) { return __builtin_bit_cast(float, __builtin_amdgcn_update_dpp(0, __builtin_bit_cast(int, v), CTRL, 0xF, 0xF, true)); }
__device__ __forceinline__ float rlane(float v, int l) { return __builtin_bit_cast(float, __builtin_amdgcn_readlane(__builtin_bit_cast(int, v), l)); }
__device__ __forceinline__ float wsum(float v) {
    v += dppf<0xB1>(v); v += dppf<0x4E>(v); v += dppf<0x141>(v); v += dppf<0x140>(v);
    return (rlane(v, 0) + rlane(v, 16)) + (rlane(v, 32) + rlane(v, 48));
}
__device__ __forceinline__ float wmax(float v) {
    v = fmaxf(v, dppf<0xB1>(v)); v = fmaxf(v, dppf<0x4E>(v)); v = fmaxf(v, dppf<0x141>(v)); v = fmaxf(v, dppf<0x140>(v));
    return fmaxf(fmaxf(rlane(v, 0), rlane(v, 16)), fmaxf(rlane(v, 32), rlane(v, 48)));
}
__device__ __forceinline__ unsigned f2bf(float f) { unsigned u = __builtin_bit_cast(unsigned, f); return (u + 0x7fffu + ((u >> 16) & 1u)) >> 16; }
__device__ __forceinline__ unsigned pk2(float lo, float hi) { return f2bf(lo) | (f2bf(hi) << 16); }
__device__ __forceinline__ float bf2f(unsigned short b) { return __builtin_bit_cast(float, ((unsigned)b) << 16); }
__device__ __forceinline__ float bflo(unsigned w) { return __builtin_bit_cast(float, w << 16); }
__device__ __forceinline__ float bfhi(unsigned w) { return __builtin_bit_cast(float, w & 0xffff0000u); }
__device__ __forceinline__ void store16_sc1(void* p, u32x4 v) { asm volatile("global_store_dwordx4 %0, %1, off sc1\n\ts_nop 1" :: "v"(p), "v"(v) : "memory"); }
__device__ __forceinline__ unsigned cvt_pk_bf16(float lo, float hi) { unsigned r; asm volatile("v_cvt_pk_bf16_f32 %0, %1, %2" : "=v"(r) : "v"(lo), "v"(hi)); return r; }
__device__ __forceinline__ float gelu_fast(float x) {
    const float c1 = -2.302208198f;
    const float c3 = c1 * 0.044715f;
    const float x2 = x * x;
    const float t = x * (c1 + c3 * x2);
    return x * __builtin_amdgcn_rcpf(1.f + __builtin_amdgcn_exp2f(t));
}

#define XB_TMO      128
#define XB_XCNT(j)  (256  + 64 * (j))
#define XB_XSUB(j)  (1280 + 64 * (j))
#define XB_XGEN(j)  (2304 + 64 * (j))
#define XB_TOP      3328
#define XB_TOPGEN   3392
#define XCD_BAR_WORDS 3456
#define XB_SPIN_CAP (1u << 18)
__device__ __forceinline__ unsigned xb_ld(unsigned* p)              { return __hip_atomic_load(p, __ATOMIC_RELAXED, __HIP_MEMORY_SCOPE_AGENT); }
__device__ __forceinline__ unsigned xb_add(unsigned* p, unsigned v) { return __hip_atomic_fetch_add(p, v, __ATOMIC_RELAXED, __HIP_MEMORY_SCOPE_AGENT); }
__device__ __forceinline__ unsigned xb_xcc_id() { return (unsigned)__builtin_amdgcn_s_getreg((3 << 11) | 20) & 0xFu; }
#define XB_SPIN(cond, bar) do { unsigned _sp = 0; while (cond) { __builtin_amdgcn_s_sleep(1); \
    if ((++_sp & 255u) == 0u) { if (xb_ld(&(bar)[XB_TMO])) break; if (_sp > XB_SPIN_CAP) { atomicAdd(&(bar)[XB_TMO], 1u); break; } } } } while (0)
struct XcdBarrier { unsigned* bar; unsigned x; volatile LAS unsigned* st; };
__device__ __forceinline__ XcdBarrier xcd_barrier_post(unsigned* bar, volatile LAS unsigned* st) {
    XcdBarrier b; b.bar = bar; b.x = xb_xcc_id(); b.st = st;
    if (threadIdx.x == 0) (void)xb_add(&bar[XB_XCNT(b.x)], 1u);
    return b;
}
__device__ __forceinline__ void xcd_barrier_complete(unsigned* bar, unsigned x, unsigned& nloc, unsigned& nx) {
    const unsigned G = gridDim.x * gridDim.y * gridDim.z;
    unsigned sum, cnt, mine, sp = 0u;
    for (;;) {
        sum = 0u; cnt = 0u; mine = 0u;
#pragma unroll
        for (unsigned j = 0; j < 16; ++j) { const unsigned c = xb_ld(&bar[XB_XCNT(j)]); sum += c; cnt += (c > 0u) ? 1u : 0u; mine = (j == x) ? c : mine; }
        if (sum == G) break;
        __builtin_amdgcn_s_sleep(1);
        if ((++sp & 255u) == 0u) { if (xb_ld(&bar[XB_TMO])) break; if (sp > XB_SPIN_CAP) { atomicAdd(&bar[XB_TMO], 1u); break; } }
    }
    nloc = mine > 0u ? mine : 1u; nx = cnt > 0u ? cnt : 1u;
}
__device__ __forceinline__ void xcd_barrier(const XcdBarrier& b) {
    asm volatile("s_waitcnt vmcnt(0)" ::: "memory");
    __syncthreads();
    if (threadIdx.x == 0) {
        unsigned* bar = b.bar;
        __builtin_amdgcn_s_waitcnt(0);
        unsigned nloc = b.st[0], nx = b.st[1];
        if (nloc == 0u) { xcd_barrier_complete(bar, b.x, nloc, nx); b.st[0] = nloc; b.st[1] = nx; }
        const unsigned old = xb_add(&bar[XB_XSUB(b.x)], 1u);
        const unsigned gen = old / nloc;
        if (old + 1u == (gen + 1u) * nloc) {
            __builtin_amdgcn_fence(__ATOMIC_RELEASE, "agent");
            asm volatile("s_waitcnt vmcnt(0)" ::: "memory");
            const unsigned og = xb_add(&bar[XB_TOP], 1u);
            const unsigned tg = og / nx;
            if (og + 1u == (tg + 1u) * nx) xb_add(&bar[XB_TOPGEN], 1u);
            else XB_SPIN(xb_ld(&bar[XB_TOPGEN]) == tg, bar);
            __builtin_amdgcn_fence(__ATOMIC_ACQUIRE, "agent");
            xb_add(&bar[XB_XGEN(b.x)], 1u);
            asm volatile("s_waitcnt vmcnt(0)" ::: "memory");
        } else {
            XB_SPIN(xb_ld(&bar[XB_XGEN(b.x)]) == gen, bar);
            __builtin_amdgcn_fence(__ATOMIC_ACQUIRE, "agent");
            asm volatile("s_waitcnt vmcnt(0)" ::: "memory");
        }
    }
    __syncthreads();
}

struct Frame {
    LAS unsigned char* lds;
    volatile LAS unsigned* MISC;
    unsigned* ctl;
    int tid, lane, wave, vcu, G;
    const float *x, *c, *ctx, *c_ctx, *ada_w, *ada_b, *w_in, *rpb, *sgu_ln_g, *sgu_ln_b, *sgu_w, *sgu_b, *w_out, *ln1_g, *ln1_b, *ln2_g, *ln2_b, *router_w, *router_b, *w_gu, *b_gu, *w_dn, *b_dn;
    float* out;
    float* mod; float* topg; int* topi; int* list; float* listg; bf16_t* sguw; bf16_t* Wt_in; bf16_t* Wt_out; unsigned char* Wt_gu; unsigned char* Wt_dn;
    bf16_t* hxc; bf16_t* proj; bf16_t* mixin; bf16_t* y1; float* x1; f32x2* stat; unsigned* cntw; unsigned char* h2; unsigned char* act; bf16_t* ybuf;
};
#define LDS_WAIT() asm volatile("s_waitcnt lgkmcnt(0)" ::: "memory")
#define VM_WAIT() asm volatile("s_waitcnt vmcnt(0)" ::: "memory")

namespace pg8 {
constexpr int BM = 256, BK = 64, HALF = 128, HTB = HALF * BK * 2, STAGE_BYTES = 8 * HTB, NXCD = 8, WGM = 8, KD = 1024, NKT = KD / BK;
__device__ __forceinline__ int lds_byte(int r, int c) { const int st = (r >> 4) * 2 + (c >> 5), rr = r & 15, cc = c & 31, ob = rr * 64 + cc * 2; return st * 1024 + (ob ^ (((ob >> 9) & 1) << 5)); }
__device__ __forceinline__ void stage_rc(int b, int& R, int& C) { const int st = b / 1024, sb = b % 1024, swz = sb ^ (((sb >> 9) & 1) << 5); R = (st >> 1) * 16 + swz / 64; C = (st & 1) * 32 + (swz % 64) / 2; }
__device__ __forceinline__ int perm32(int rho) { const int n = rho >> 4, i = rho & 15; return 8 * (i >> 2) + 4 * n + (i & 3); }
struct Unit { int pm, pn, e, nvalid, ti; };
__device__ __forceinline__ void static_tile(int L, int nM, int nN, int& pm, int& pn) {
    const int nwg = nM * nN; int wgid = L;
    { const int q = nwg / NXCD, r = nwg % NXCD, xcd = wgid % NXCD, off = wgid / NXCD; wgid = (xcd < r ? xcd * (q + 1) : r * (q + 1) + (xcd - r) * q) + off; }
    const int nig = WGM * nN, gid = wgid / nig, fm = gid * WGM, gsz = (nM - fm) < WGM ? (nM - fm) : WGM;
    pm = fm + ((wgid % nig) % gsz); pn = (wgid % nig) / gsz;
}

typedef int v8i __attribute__((ext_vector_type(8)));
template <bool FP8> struct Frags;
template <> struct Frags<false> { bf16x8 At[4][2], B0[2][2], B1[2][2]; };
template <> struct Frags<true> { v8i At[4], B0[2], B1[2]; };
template <class P>
__device__ __forceinline__ void gemm_phase(LAS unsigned char* lds, const P& pol) {
    const int tid = threadIdx.x, wid = __builtin_amdgcn_readfirstlane(tid >> 6), lane = tid & 63, wr = wid >> 2, wc = wid & 3, fr = lane & 15, fq = lane >> 4;
    constexpr int KDB = P::FP8 ? 1024 : 2048, NKT_ = KDB / 128;
    unsigned voffB[2];
#pragma unroll
    for (int i = 0; i < 2; ++i) { int R, C; stage_rc(tid * 16 + i * 8192, R, C); const int Rb = P::PERM ? ((R & ~31) + perm32(R & 31)) : R;
        voffB[i] = (unsigned)(Rb * KDB + C * 2); }
    const size_t kstep = (size_t)(BK * 2);
    const size_t hstep = (size_t)HALF * KDB;
    const unsigned ldsw = (unsigned)wid * 1024u;
    const int aoff = lds_byte(wr * 64 + fr, fq * 8), boff = lds_byte(wc * 32 + fr, fq * 8);
#define PG8_SA(b, h) (((b) * 2 + (h)) * HTB)
#define PG8_SB(b, h) ((4 + (b) * 2 + (h)) * HTB)
#define PG8_STAGE(bufoff, gbase, voff) do { _Pragma("unroll") for (int _i = 0; _i < 2; ++_i) \
        __builtin_amdgcn_global_load_lds((const unsigned*)((const char*)(gbase) + (voff)[_i]), (LAS unsigned*)(lds + (bufoff) + ldsw + _i * 8192), 16, 0, 0); } while (0)
#define PG8_RD8(p) __builtin_shufflevector(*(const LAS u32x4*)(p), *(const LAS u32x4*)((p) + 1024), 0, 1, 2, 3, 4, 5, 6, 7)
#define PG8_LDA(dst, b, h) do { if constexpr (P::FP8) { _Pragma("unroll") for (int m = 0; m < 4; ++m) fg.dst[m] = __builtin_bit_cast(v8i, PG8_RD8(lds + PG8_SA(b, h) + aoff + m * 2048)); } \
        else { _Pragma("unroll") for (int m = 0; m < 4; ++m) _Pragma("unroll") for (int k = 0; k < 2; ++k) fg.dst[m][k] = *(const LAS bf16x8*)(lds + PG8_SA(b, h) + aoff + m * 2048 + k * 1024); } } while (0)
#define PG8_LDB(dst, b, h) do { if constexpr (P::FP8) { _Pragma("unroll") for (int n = 0; n < 2; ++n) fg.dst[n] = __builtin_bit_cast(v8i, PG8_RD8(lds + PG8_SB(b, h) + boff + n * 2048)); } \
        else { _Pragma("unroll") for (int n = 0; n < 2; ++n) _Pragma("unroll") for (int k = 0; k < 2; ++k) fg.dst[n][k] = *(const LAS bf16x8*)(lds + PG8_SB(b, h) + boff + n * 2048 + k * 1024); } } while (0)
#define PG8_MMA(ai, bj, At, Bt) do { __builtin_amdgcn_s_setprio(1); \
        if constexpr (P::FP8) { _Pragma("unroll") for (int m = 0; m < 4; ++m) _Pragma("unroll") for (int n = 0; n < 2; ++n) \
            acc[ai][bj][m][n] = __builtin_amdgcn_mfma_scale_f32_16x16x128_f8f6f4(fg.Bt[n], fg.At[m], acc[ai][bj][m][n], 0, 0, 0, 0, 0, 0); } \
        else { _Pragma("unroll") for (int m = 0; m < 4; ++m) _Pragma("unroll") for (int n = 0; n < 2; ++n) _Pragma("unroll") for (int k = 0; k < 2; ++k) \
            acc[ai][bj][m][n] = __builtin_amdgcn_mfma_f32_16x16x32_bf16(fg.Bt[n][k], fg.At[m][k], acc[ai][bj][m][n], 0, 0, 0); } \
        __builtin_amdgcn_s_setprio(0); } while (0)
#define PG8_WAIT_V(n) asm volatile("s_waitcnt vmcnt(" #n ")" ::: "memory")
#define PG8_WAIT_L(n) asm volatile("s_waitcnt lgkmcnt(" #n ")" ::: "memory")
#define PG8_BAR __builtin_amdgcn_s_barrier()
#define PG8_SCHED __builtin_amdgcn_sched_barrier(0)
    Unit cur, nxt; int ui = 0;
    if (!pol.next(0, cur)) return;
    f32x4 acc[2][2][4][2];
#pragma unroll
    for (int a = 0; a < 2; ++a)
#pragma unroll
        for (int b = 0; b < 2; ++b)
#pragma unroll
            for (int m = 0; m < 4; ++m)
#pragma unroll
                for (int n = 0; n < 2; ++n) acc[a][b][m][n] = (f32x4){0.f, 0.f, 0.f, 0.f};
    Frags<P::FP8> fg;
    int slot = 0;
    if (P::META) { pol.meta_issue(cur, 0, lds, wid, lane); PG8_WAIT_V(0); asm volatile("" ::: "memory"); PG8_BAR; asm volatile("" ::: "memory"); }
    unsigned aC[2][2];
    pol.a_off(cur, 0, lds, aC);
    const char* const Ab = (const char*)pol.A;
    const char* cB = pol.b_ptr(cur);
    PG8_STAGE(PG8_SB(0, 0), cB, voffB); PG8_STAGE(PG8_SB(0, 1), cB + hstep, voffB); PG8_STAGE(PG8_SA(0, 0), Ab, aC[0]); PG8_STAGE(PG8_SA(0, 1), Ab, aC[1]);
    if (wr == 1) PG8_BAR;
    PG8_WAIT_V(2); PG8_BAR;
    PG8_STAGE(PG8_SB(1, 0), cB + kstep, voffB); PG8_STAGE(PG8_SA(1, 0), Ab + kstep, aC[0]); PG8_STAGE(PG8_SB(1, 1), cB + hstep + kstep, voffB);
    PG8_WAIT_V(6); PG8_BAR;
    for (;;) {
        const bool has_next = pol.next(ui + 1, nxt);
        const int nslot = slot == 2 ? 0 : slot + 1;
        if (P::META) { if (has_next) pol.meta_issue(nxt, nslot, lds, wid, lane); }
        const char* nB = has_next ? pol.b_ptr(nxt) : cB;
#pragma unroll 1
        for (int t = 0; t < NKT_; t += 2) {
            const bool last = (t == NKT_ - 2);
            const char* a1 = Ab + (size_t)(t + 1) * kstep;
            const char* a2 = last ? Ab : Ab + (size_t)(t + 2) * kstep; const char* b2 = last ? nB : cB + (size_t)(t + 2) * kstep;
            const char* a3 = a2 + kstep; const char* b3 = b2 + kstep;
            PG8_LDB(B0, 0, 0); PG8_LDB(B1, 0, 1); PG8_SCHED; PG8_LDA(At, 0, 0); PG8_STAGE(PG8_SA(1, 1), a1, aC[1]);
            if (last && has_next) pol.a_off(nxt, nslot, lds, aC);
            PG8_WAIT_V(8); PG8_WAIT_L(0); PG8_BAR; PG8_MMA(0, 0, At, B0); PG8_MMA(0, 1, At, B1); PG8_BAR; PG8_SCHED;
            PG8_LDA(At, 0, 1); PG8_STAGE(PG8_SB(0, 0), b2, voffB); PG8_STAGE(PG8_SB(0, 1), b2 + hstep, voffB); PG8_STAGE(PG8_SA(0, 0), a2, aC[0]);
            PG8_WAIT_V(8); PG8_WAIT_L(0); PG8_BAR; PG8_MMA(1, 0, At, B0); PG8_MMA(1, 1, At, B1); PG8_BAR; PG8_SCHED;
            PG8_LDB(B0, 1, 0); PG8_LDB(B1, 1, 1); PG8_SCHED; PG8_LDA(At, 1, 0); PG8_STAGE(PG8_SA(0, 1), a2, aC[1]);
            PG8_WAIT_V(8); PG8_WAIT_L(0); PG8_BAR; PG8_MMA(0, 0, At, B0); PG8_MMA(0, 1, At, B1); PG8_BAR; PG8_SCHED;
            PG8_LDA(At, 1, 1); PG8_STAGE(PG8_SB(1, 0), b3, voffB); PG8_STAGE(PG8_SB(1, 1), b3 + hstep, voffB); PG8_STAGE(PG8_SA(1, 0), a3, aC[0]);
            PG8_WAIT_V(8); PG8_WAIT_L(0); PG8_BAR; PG8_MMA(1, 0, At, B0); PG8_MMA(1, 1, At, B1); PG8_BAR; PG8_SCHED;
        }
        if (wr == 0) PG8_BAR;
#ifdef PROBE_KLOOP2
        const bool do_epi = !(P::FP8 && P::KIND == PROBE_KLOOP2) || (ui & 1);
        if (do_epi) {
            if (P::FP8 && P::KIND == PROBE_KLOOP2) {
#pragma unroll
                for (int a = 0; a < 2; ++a)
#pragma unroll
                    for (int b = 0; b < 2; ++b)
#pragma unroll
                        for (int m = 0; m < 4; ++m)
#pragma unroll
                            for (int n = 0; n < 2; ++n) acc[a][b][m][n] *= 0.5f; }
            pol.epi(acc, cur, slot, lds, wr, wc, fr, fq); }
#else
        constexpr bool do_epi = true;
        pol.epi(acc, cur, slot, lds, wr, wc, fr, fq);
#endif
#ifdef PROBE_EPI2
        if (P::KIND == PROBE_EPI2) { asm volatile("" ::: "memory");
#pragma unroll
            for (int a = 0; a < 2; ++a)
#pragma unroll
                for (int b = 0; b < 2; ++b)
#pragma unroll
                    for (int m = 0; m < 4; ++m)
#pragma unroll
                        for (int n = 0; n < 2; ++n) asm volatile("" : "+v"(acc[a][b][m][n]));
            pol.epi(acc, cur, slot, lds, wr, wc, fr, fq); }
#endif
        if (!has_next) break;
        if (do_epi) {
#pragma unroll
        for (int a = 0; a < 2; ++a)
#pragma unroll
            for (int b = 0; b < 2; ++b)
#pragma unroll
                for (int m = 0; m < 4; ++m)
#pragma unroll
                    for (int n = 0; n < 2; ++n) acc[a][b][m][n] = (f32x4){0.f, 0.f, 0.f, 0.f};
        }
        cur = nxt; cB = nB; ++ui; slot = nslot;
        if (wr == 1) PG8_BAR;
    }
    PG8_WAIT_V(0);
    PG8_BAR;
#undef PG8_SA
#undef PG8_SB
#undef PG8_STAGE
#undef PG8_LDA
#undef PG8_LDB
#undef PG8_MMA
#undef PG8_RD8
#undef PG8_WAIT_V
#undef PG8_WAIT_L
#undef PG8_BAR
#undef PG8_SCHED
}
}

typedef f32x4 AccT[2][2][4][2];

struct PolProj {
    static constexpr int KIND = 0; static constexpr bool PERM = true, META = false, FP8 = false; static constexpr int SCALE_W = 0x7f7f7f7f;
    const bf16_t* A; const bf16_t* Bt; bf16_t* O; int G, c;
    __device__ __forceinline__ bool next(int i, pg8::Unit& u) const {
        const int L = i * G + c;
        if (L < 640) { pg8::static_tile(L, 64, 10, u.pm, u.pn); return true; }
        if (L < 648) { const int j = L - 640; u.pm = 64 + (j >> 2); u.pn = 2 + (j & 3); return true; }
        return false;
    }
    __device__ __forceinline__ const char* b_ptr(const pg8::Unit& u) const { return (const char*)Bt + (size_t)u.pn * 256 * 1024 * 2; }
    __device__ __forceinline__ void meta_issue(const pg8::Unit&, int, LAS unsigned char*, int, int) const {}
    __device__ __forceinline__ void a_off(const pg8::Unit& u, int, LAS unsigned char*, unsigned (&o)[2][2]) const {
        int Ra[2], Ca[2]; pg8::stage_rc((int)threadIdx.x * 16, Ra[0], Ca[0]); pg8::stage_rc((int)threadIdx.x * 16 + 8192, Ra[1], Ca[1]);
#pragma unroll
        for (int h = 0; h < 2; ++h)
#pragma unroll
            for (int i = 0; i < 2; ++i) o[h][i] = (unsigned)((u.pm * 256 + 128 * h + Ra[i]) * 1024 + Ca[i]) * 2u;
    }
    __device__ __forceinline__ void epi(const AccT& acc, const pg8::Unit& u, int, LAS unsigned char*, int wr, int wc, int fr, int fq) const {
        const int row0 = u.pm * 256 + wr * 64 + fr, col0 = u.pn * 256 + wc * 32 + 8 * fq;
        const bool act = u.pn >= 6;
#pragma unroll
        for (int ai = 0; ai < 2; ++ai)
#pragma unroll
            for (int m = 0; m < 4; ++m) { bf16_t* rowp = O + (size_t)(row0 + ai * 128 + m * 16) * DIN + col0;
#pragma unroll
                for (int bj = 0; bj < 2; ++bj) { f32x4 v0 = acc[ai][bj][m][0], v1 = acc[ai][bj][m][1];
                    if (act) {
#pragma unroll
                        for (int j = 0; j < 4; ++j) { v0[j] = gelu_fast(v0[j]); v1[j] = gelu_fast(v1[j]); } }
                    u32x4 w; w.x = cvt_pk_bf16(v0[0], v0[1]); w.y = cvt_pk_bf16(v0[2], v0[3]); w.z = cvt_pk_bf16(v1[0], v1[1]); w.w = cvt_pk_bf16(v1[2], v1[3]);
                    store16_sc1(rowp + bj * 128, w); } }
    }
};

struct PolOut {
    static constexpr int KIND = 0; static constexpr bool PERM = true, META = false, FP8 = false; static constexpr int SCALE_W = 0x7f7f7f7f;
    const bf16_t* A; const bf16_t* Bt; const float* x; const float* mod; bf16_t* Y; int G, c;
    __device__ __forceinline__ bool next(int i, pg8::Unit& u) const { const int L = i * G + c; if (L >= 256) return false; pg8::static_tile(L, 64, 4, u.pm, u.pn); return true; }
    __device__ __forceinline__ const char* b_ptr(const pg8::Unit& u) const { return (const char*)Bt + (size_t)u.pn * 256 * 1024 * 2; }
    __device__ __forceinline__ void meta_issue(const pg8::Unit&, int, LAS unsigned char*, int, int) const {}
    __device__ __forceinline__ void a_off(const pg8::Unit& u, int, LAS unsigned char*, unsigned (&o)[2][2]) const {
        int Ra[2], Ca[2]; pg8::stage_rc((int)threadIdx.x * 16, Ra[0], Ca[0]); pg8::stage_rc((int)threadIdx.x * 16 + 8192, Ra[1], Ca[1]);
#pragma unroll
        for (int h = 0; h < 2; ++h)
#pragma unroll
            for (int i = 0; i < 2; ++i) o[h][i] = (unsigned)((u.pm * 256 + 128 * h + Ra[i]) * 1024 + Ca[i]) * 2u;
    }
    __device__ __forceinline__ void epi(const AccT& acc, const pg8::Unit& u, int, LAS unsigned char*, int wr, int wc, int fr, int fq) const {
        const int row0 = u.pm * 256 + wr * 64 + fr, col0 = u.pn * 256 + wc * 32 + 8 * fq;
        const float* g1 = mod + (u.pm >= 32 ? 6144 : 0) + 2 * 1024;
        f32x4 gv[2][2];
#pragma unroll
        for (int bj = 0; bj < 2; ++bj)
#pragma unroll
            for (int n = 0; n < 2; ++n) gv[bj][n] = *(const f32x4*)(g1 + col0 + bj * 128 + 4 * n);
#pragma unroll
        for (int ai = 0; ai < 2; ++ai)
#pragma unroll
            for (int m = 0; m < 4; ++m) { const size_t off = (size_t)(row0 + ai * 128 + m * 16) * D + col0;
#pragma unroll
                for (int bj = 0; bj < 2; ++bj) { const f32x4 x0 = __builtin_nontemporal_load((const f32x4*)(x + off + bj * 128)), x1v = __builtin_nontemporal_load((const f32x4*)(x + off + bj * 128 + 4));
                    const f32x4 v0 = x0 * DN_ALPHA + gv[bj][0] * acc[ai][bj][m][0], v1 = x1v * DN_ALPHA + gv[bj][1] * acc[ai][bj][m][1];
                    u32x4 w; w.x = cvt_pk_bf16(v0[0], v0[1]); w.y = cvt_pk_bf16(v0[2], v0[3]); w.z = cvt_pk_bf16(v1[0], v1[1]); w.w = cvt_pk_bf16(v1[2], v1[3]);
                    *(u32x4*)(Y + off + bj * 128) = w; }
                asm volatile("" ::: "memory"); }
    }
};

struct ExpTab { const LAS int* tile_e; const LAS int* tstart; const LAS int* cnt; int T; };
__device__ __forceinline__ int expert_tables(Frame& F) {
    LAS int* tile_e = (LAS int*)(F.lds + L_TILEE); LAS int* tstart = (LAS int*)(F.lds + L_TSTART); LAS int* cn = tstart + 64;
    if (F.tid < 32) cn[F.tid] = (int)__hip_atomic_load(F.ctl + CW_CNT + 32 * F.tid, __ATOMIC_RELAXED, __HIP_MEMORY_SCOPE_AGENT);
    __syncthreads();
    if (F.tid == 0) { int run = 0; for (int e = 0; e < NE; ++e) { tstart[e] = run; run += (cn[e] + 255) >> 8; } tstart[NE] = run; }
    __syncthreads();
    const int T = tstart[NE];
    if (F.tid < MAXT && F.tid < T) { int e = 0; while (e < NE - 1 && tstart[e + 1] <= F.tid) ++e; tile_e[F.tid] = e; }
    __syncthreads();
    return T < MAXT ? T : MAXT;
}
__device__ __forceinline__ int rfl(int v) { return __builtin_amdgcn_readfirstlane(v); }

struct PolGU {
    static constexpr int KIND = 1; static constexpr bool PERM = true, META = true, FP8 = true; static constexpr int SCALE_W = 0; static constexpr float WSC = 1.f / 64.f;
    const unsigned char* A; const unsigned char* Bt; const float* bias; const int* list; unsigned char* O; ExpTab tb; int G, c;
    __device__ __forceinline__ bool next(int i, pg8::Unit& u) const {
#if defined(PROBE_KLOOP2) && PROBE_KLOOP2 == 1
        const int L = (i >> 1) * G + c; if (L >= tb.T * 8) return false;
#else
        const int L = i * G + c; if (L >= tb.T * 8) return false;
#endif
        u.ti = L >> 3; u.pn = L & 7; u.e = rfl(tb.tile_e[u.ti]); u.pm = u.ti - rfl(tb.tstart[u.e]);
        const int rem = rfl(tb.cnt[u.e]) - u.pm * 256; u.nvalid = rem < 256 ? rem : 256; return true;
    }
    __device__ __forceinline__ const char* b_ptr(const pg8::Unit& u) const { return (const char*)Bt + ((size_t)u.e * 2048 + (size_t)u.pn * 256) * 1024; }
    __device__ __forceinline__ void meta_issue(const pg8::Unit& u, int slot, LAS unsigned char* lds, int wid, int lane) const {
        if (wid < 4) __builtin_amdgcn_global_load_lds((const unsigned*)(list + (size_t)u.e * LCAP + u.pm * 256 + wid * 64 + lane), (LAS unsigned*)(lds + L_IDX + slot * 2048 + wid * 256), 4, 0, 0);
    }
    __device__ __forceinline__ void a_off(const pg8::Unit& u, int slot, LAS unsigned char* lds, unsigned (&o)[2][2]) const {
        int Ra[2], Ca[2]; pg8::stage_rc((int)threadIdx.x * 16, Ra[0], Ca[0]); pg8::stage_rc((int)threadIdx.x * 16 + 8192, Ra[1], Ca[1]);
        const LAS int* idx = (const LAS int*)(lds + L_IDX + slot * 2048);
#pragma unroll
        for (int h = 0; h < 2; ++h)
#pragma unroll
            for (int i = 0; i < 2; ++i) { const int r = 128 * h + Ra[i]; int pr = idx[r]; pr = r < u.nvalid ? pr : 0; o[h][i] = (unsigned)((pr >> 2) * 1024 + Ca[i] * 2); }
    }
    __device__ __forceinline__ void epi(const AccT& acc, const pg8::Unit& u, int, LAS unsigned char*, int wr, int wc, int fr, int fq) const {
        const int row0 = u.ti * 256 + wr * 64 + fr, col0 = u.pn * 128 + wc * 32 + 8 * fq;
        const float* bg = bias + (size_t)u.e * 2048 + col0;
        const f32x4 g0 = *(const f32x4*)(bg), g1 = *(const f32x4*)(bg + 4), l0 = *(const f32x4*)(bg + 1024) + 1.f, l1 = *(const f32x4*)(bg + 1028) + 1.f;
#pragma unroll
        for (int ai = 0; ai < 2; ++ai)
#pragma unroll
            for (int m = 0; m < 4; ++m) {
                f32x4 r0, r1;
#pragma unroll
                for (int hp = 0; hp < 2; ++hp) {
                    const f32x2 ga0 = (f32x2){acc[ai][0][m][0][2 * hp], acc[ai][0][m][0][2 * hp + 1]} * WSC + (f32x2){g0[2 * hp], g0[2 * hp + 1]};
                    const f32x2 ga1 = (f32x2){acc[ai][0][m][1][2 * hp], acc[ai][0][m][1][2 * hp + 1]} * WSC + (f32x2){g1[2 * hp], g1[2 * hp + 1]};
                    const f32x2 lb0 = (f32x2){acc[ai][1][m][0][2 * hp], acc[ai][1][m][0][2 * hp + 1]} * WSC + (f32x2){l0[2 * hp], l0[2 * hp + 1]};
                    const f32x2 lb1 = (f32x2){acc[ai][1][m][1][2 * hp], acc[ai][1][m][1][2 * hp + 1]} * WSC + (f32x2){l1[2 * hp], l1[2 * hp + 1]};
                    f32x2 gg0, gg1, ll0, ll1, e0, e1;
                    gg0[0] = fminf(ga0[0], 7.f); gg0[1] = fminf(ga0[1], 7.f); gg1[0] = fminf(ga1[0], 7.f); gg1[1] = fminf(ga1[1], 7.f);
                    ll0[0] = __builtin_amdgcn_fmed3f(lb0[0], -6.f, 8.f); ll0[1] = __builtin_amdgcn_fmed3f(lb0[1], -6.f, 8.f); ll1[0] = __builtin_amdgcn_fmed3f(lb1[0], -6.f, 8.f); ll1[1] = __builtin_amdgcn_fmed3f(lb1[1], -6.f, 8.f);
                    const f32x2 x0 = gg0 * -2.45546696f, x1 = gg1 * -2.45546696f;
                    e0[0] = __builtin_amdgcn_exp2f(x0[0]); e0[1] = __builtin_amdgcn_exp2f(x0[1]); e1[0] = __builtin_amdgcn_exp2f(x1[0]); e1[1] = __builtin_amdgcn_exp2f(x1[1]);
                    const f32x2 d0 = e0 + 1.f, d1 = e1 + 1.f;
                    f32x2 q0, q1; q0[0] = __builtin_amdgcn_rcpf(d0[0]); q0[1] = __builtin_amdgcn_rcpf(d0[1]); q1[0] = __builtin_amdgcn_rcpf(d1[0]); q1[1] = __builtin_amdgcn_rcpf(d1[1]);
                    const f32x2 o0 = (ll0 * gg0) * q0, o1 = (ll1 * gg1) * q1;
                    r0[2 * hp] = o0[0]; r0[2 * hp + 1] = o0[1]; r1[2 * hp] = o1[0]; r1[2 * hp + 1] = o1[1];
                }
                u32x2 w; w.x = (unsigned)__builtin_amdgcn_cvt_pk_fp8_f32(r0[2], r0[3], __builtin_amdgcn_cvt_pk_fp8_f32(r0[0], r0[1], 0, false), true);
                w.y = (unsigned)__builtin_amdgcn_cvt_pk_fp8_f32(r1[2], r1[3], __builtin_amdgcn_cvt_pk_fp8_f32(r1[0], r1[1], 0, false), true);
                *(u32x2*)(O + (size_t)(row0 + ai * 128 + m * 16) * DFF + col0) = w; }
    }
};

struct PolDN {
    static constexpr int KIND = 2; static constexpr bool PERM = true, META = true, FP8 = true; static constexpr int SCALE_W = 0; static constexpr float WSC = 1.f / 64.f;
    const unsigned char* A; const unsigned char* Bt; const float* bias; const int* list; const float* listg; bf16_t* O; ExpTab tb; int G, c;
    __device__ __forceinline__ bool next(int i, pg8::Unit& u) const {
#if defined(PROBE_KLOOP2) && PROBE_KLOOP2 == 2
        const int L = (i >> 1) * G + c; if (L >= tb.T * 4) return false;
#else
        const int L = i * G + c; if (L >= tb.T * 4) return false;
#endif
        u.ti = L >> 2; u.pn = L & 3; u.e = rfl(tb.tile_e[u.ti]); u.pm = u.ti - rfl(tb.tstart[u.e]);
        const int rem = rfl(tb.cnt[u.e]) - u.pm * 256; u.nvalid = rem < 256 ? rem : 256; return true;
    }
    __device__ __forceinline__ const char* b_ptr(const pg8::Unit& u) const { return (const char*)Bt + ((size_t)u.e * 1024 + (size_t)u.pn * 256) * 1024; }
    __device__ __forceinline__ void meta_issue(const pg8::Unit& u, int slot, LAS unsigned char* lds, int wid, int lane) const {
        if (wid < 4) __builtin_amdgcn_global_load_lds((const unsigned*)(list + (size_t)u.e * LCAP + u.pm * 256 + wid * 64 + lane), (LAS unsigned*)(lds + L_IDX + slot * 2048 + wid * 256), 4, 0, 0);
        else __builtin_amdgcn_global_load_lds((const unsigned*)(listg + (size_t)u.e * LCAP + u.pm * 256 + (wid - 4) * 64 + lane), (LAS unsigned*)(lds + L_IDX + slot * 2048 + 1024 + (wid - 4) * 256), 4, 0, 0);
    }
    __device__ __forceinline__ void a_off(const pg8::Unit& u, int, LAS unsigned char*, unsigned (&o)[2][2]) const {
        int Ra[2], Ca[2]; pg8::stage_rc((int)threadIdx.x * 16, Ra[0], Ca[0]); pg8::stage_rc((int)threadIdx.x * 16 + 8192, Ra[1], Ca[1]);
#pragma unroll
        for (int h = 0; h < 2; ++h)
#pragma unroll
            for (int i = 0; i < 2; ++i) o[h][i] = (unsigned)((u.ti * 256 + 128 * h + Ra[i]) * 1024 + Ca[i] * 2);
    }
    __device__ __forceinline__ void epi(const AccT& acc, const pg8::Unit& u, int slot, LAS unsigned char* lds, int wr, int wc, int fr, int fq) const {
        const LAS int* idx = (const LAS int*)(lds + L_IDX + slot * 2048);
        const int col0 = u.pn * 256 + wc * 32 + 8 * fq;
        const float* bd = bias + (size_t)u.e * 1024 + col0;
        f32x4 bv[2][2];
#pragma unroll
        for (int bj = 0; bj < 2; ++bj)
#pragma unroll
            for (int n = 0; n < 2; ++n) bv[bj][n] = *(const f32x4*)(bd + bj * 128 + 4 * n);
#pragma unroll
        for (int ai = 0; ai < 2; ++ai)
#pragma unroll
            for (int m = 0; m < 4; ++m) { const int r = ai * 128 + wr * 64 + m * 16 + fr;
                if (r < u.nvalid) { const int pr = idx[r]; const float gt = ((const LAS float*)idx)[256 + r]; bf16_t* rowp = O + (size_t)pr * D + col0;
#pragma unroll
                    for (int bj = 0; bj < 2; ++bj) { const f32x4 v0 = (acc[ai][bj][m][0] * WSC + bv[bj][0]) * gt, v1 = (acc[ai][bj][m][1] * WSC + bv[bj][1]) * gt;
                        u32x4 w; w.x = cvt_pk_bf16(v0[0], v0[1]); w.y = cvt_pk_bf16(v0[2], v0[3]); w.z = cvt_pk_bf16(v1[0], v1[1]); w.w = cvt_pk_bf16(v1[2], v1[3]);
                        __builtin_nontemporal_store(w, (u32x4*)(rowp + bj * 128)); } } }
    }
};

__device__ __forceinline__ void p_ada(Frame& F) {
    LAS float* sl = (LAS float*)F.lds;
    LAS float* red = sl + 3072;
    for (int i = F.tid; i < 3072; i += 512) { const int w = i >> 10, k = i & 1023; const float v = w < 2 ? F.c[w * D + k] : F.c_ctx[k]; sl[i] = v / (1.f + __expf(-v)); }
    __syncthreads();
    for (int slab = blockIdx.x; slab < 256; slab += F.G) {
        const int j0 = slab * 24, cg = F.tid % 6, kr = F.tid / 6;
        float a[3][4] = {};
        if (F.tid < 480) {
            for (int k = kr; k < D; k += 80) {
                const f32x4 w4 = __builtin_nontemporal_load((const f32x4*)(F.ada_w + (size_t)k * 6144 + j0 + 4 * cg));
                const float s0 = sl[k], s1 = sl[1024 + k], s2 = sl[2048 + k];
#pragma unroll
                for (int q = 0; q < 4; ++q) { a[0][q] += s0 * w4[q]; a[1][q] += s1 * w4[q]; a[2][q] += s2 * w4[q]; }
            }
#pragma unroll
            for (int w = 0; w < 3; ++w)
#pragma unroll
                for (int q = 0; q < 4; ++q) red[kr * 72 + cg * 12 + w * 4 + q] = a[w][q];
        }
        __syncthreads();
        if (F.tid < 72) {
            float s = 0.f;
            for (int r = 0; r < 80; ++r) s += red[r * 72 + F.tid];
            const int g = F.tid / 12, w = (F.tid % 12) >> 2, q = F.tid & 3, col = j0 + 4 * g + q;
            F.mod[w * 6144 + col] = s + F.ada_b[col];
        }
        __syncthreads();
    }
}

__device__ __forceinline__ void transpose_item(const float* W, int K, int N, bf16_t* WT, int item, bool gu_map, LAS float* scr, int lane) {
    const int nblk = N / 32, kb = item / nblk, nb = item % nblk, k0 = 64 * kb, n0 = 32 * nb;
#pragma unroll 8
    for (int i = 0; i < 32; ++i) { const int kk = 2 * i + (lane >> 5); scr[kk * 33 + (lane & 31)] = __builtin_nontemporal_load(W + (size_t)(k0 + kk) * N + n0 + (lane & 31)); }
    LDS_WAIT(); asm volatile("" ::: "memory");
    int d0 = n0;
    if (gu_map) { const int nn = n0 & 1023; d0 = (nn >> 7) * 256 + (nn & 127) + ((n0 >> 10) ? 128 : 0); }
    const int c = lane & 7;
#pragma unroll
    for (int j = 0; j < 4; ++j) { const int n = (lane >> 3) + 8 * j; const LAS float* s = scr + (8 * c) * 33 + n;
        u32x4 o; o.x = pk2(s[0 * 33], s[1 * 33]); o.y = pk2(s[2 * 33], s[3 * 33]); o.z = pk2(s[4 * 33], s[5 * 33]); o.w = pk2(s[6 * 33], s[7 * 33]);
        *(u32x4*)(WT + (size_t)(d0 + n) * K + k0 + 8 * c) = o; }
    LDS_WAIT(); asm volatile("" ::: "memory");
}
__device__ __forceinline__ unsigned pk4_fp8(float a, float b, float c, float d) { return (unsigned)__builtin_amdgcn_cvt_pk_fp8_f32(c, d, __builtin_amdgcn_cvt_pk_fp8_f32(a, b, 0, false), true); }
__device__ __forceinline__ void transpose_item8(const float* W, int K, int N, unsigned char* WT, int item, bool gu_map, LAS float* scr, int lane) {
    const int nblk = N / 32, kb = item / nblk, nb = item % nblk, k0 = 64 * kb, n0 = 32 * nb;
#pragma unroll 8
    for (int i = 0; i < 32; ++i) { const int kk = 2 * i + (lane >> 5); scr[kk * 33 + (lane & 31)] = __builtin_nontemporal_load(W + (size_t)(k0 + kk) * N + n0 + (lane & 31)); }
    LDS_WAIT(); asm volatile("" ::: "memory");
    int d0 = n0;
    if (gu_map) { const int nn = n0 & 1023; d0 = (nn >> 7) * 256 + (nn & 127) + ((n0 >> 10) ? 128 : 0); }
    const int c = lane & 7;
#pragma unroll
    for (int j = 0; j < 4; ++j) { const int n = (lane >> 3) + 8 * j; const LAS float* s = scr + (8 * c) * 33 + n;
        u32x2 o; o.x = pk4_fp8(s[0 * 33] * 64.f, s[1 * 33] * 64.f, s[2 * 33] * 64.f, s[3 * 33] * 64.f); o.y = pk4_fp8(s[4 * 33] * 64.f, s[5 * 33] * 64.f, s[6 * 33] * 64.f, s[7 * 33] * 64.f);
        __builtin_nontemporal_store(o, (u32x2*)(WT + (size_t)(d0 + n) * K + k0 + 8 * c)); }
    LDS_WAIT(); asm volatile("" ::: "memory");
}
__device__ __forceinline__ void p_weights(Frame& F, int it_lo, int n_items, int gw, int NGW, bool with_sgu) {
    LAS float* scr = (LAS float*)(F.lds + F.wave * 16384);
    constexpr int I_IN = 16 * 80, I_OUT = 16 * 32, I_GU = 16 * 64, I_DN = 16 * 32;
    constexpr int NITEMS = I_IN + I_OUT + NE * I_GU + NE * I_DN;
    for (int it0 = gw; it0 < n_items; it0 += NGW) {
        const int it = it_lo + it0; int r = it;
        if (r < I_IN) { transpose_item(F.w_in, D, DIN, F.Wt_in, r, false, scr, F.lane); continue; } r -= I_IN;
        if (r < I_OUT) { transpose_item(F.w_out, D, D, F.Wt_out, r, false, scr, F.lane); continue; } r -= I_OUT;
        if (r < NE * I_GU) { const int e = r / I_GU; transpose_item8(F.w_gu + (size_t)e * D * 2048, D, 2048, F.Wt_gu + (size_t)e * 2048 * D, r % I_GU, true, scr, F.lane); continue; } r -= NE * I_GU;
        { const int e = r / I_DN; transpose_item8(F.w_dn + (size_t)e * DFF * D, DFF, D, F.Wt_dn + (size_t)e * D * DFF, r % I_DN, false, scr, F.lane); }
    }
    if (with_sgu) for (int i = (blockIdx.x * 512 + F.tid) * 4; i < 4 * 128 * 128; i += F.G * 512 * 4) {
        const f32x4 v = *(const f32x4*)(F.sgu_w + i); u32x2 o; o.x = pk2(v[0], v[1]); o.y = pk2(v[2], v[3]); *(u32x2*)(F.sguw + i) = o; }
}
__device__ __forceinline__ void p_lnmod(Frame& F) {
    const int gw = F.vcu * 8 + F.wave, NGW = F.G * 8;
    for (int row = gw; row < MX; row += NGW) {
        const float* xr; const float* md;
        if (row < M) { xr = F.x + (size_t)row * D; md = F.mod + (row >> 13) * 6144; } else { xr = F.ctx + (size_t)(row - M) * D; md = F.mod + 2 * 6144; }
        const f32x4* xp = (const f32x4*)xr + F.lane;
        f32x4 v[4]; float s = 0.f;
#pragma unroll
        for (int j = 0; j < 4; ++j) { v[j] = __builtin_nontemporal_load(xp + 64 * j); s += (v[j][0] + v[j][1]) + (v[j][2] + v[j][3]); }
        const float mean = wsum(s) * (1.f / D); float q = 0.f;
#pragma unroll
        for (int j = 0; j < 4; ++j) { v[j] = v[j] - mean; q += (v[j][0] * v[j][0] + v[j][1] * v[j][1]) + (v[j][2] * v[j][2] + v[j][3] * v[j][3]); }
        const float rstd = rsqrtf(wsum(q) * (1.f / D) + EPS);
        u32x2* op = (u32x2*)(F.hxc + (size_t)row * D) + F.lane;
#pragma unroll
        for (int j = 0; j < 4; ++j) { const f32x4 sh = *((const f32x4*)md + F.lane + 64 * j), sc = *((const f32x4*)(md + 1024) + F.lane + 64 * j);
            const f32x4 o = v[j] * rstd * (sc + 1.f) + sh; u32x2 w; w.x = pk2(o[0], o[1]); w.y = pk2(o[2], o[3]); op[64 * j] = w; }
    }
}

__device__ __forceinline__ void p_attn_simple(Frame& F) {
    LAS float* sq = (LAS float*)(F.lds + F.wave * 4096);
    LAS float* sp = sq + 64;
    const int gw = F.vcu * 8 + F.wave, NGW = F.G * 8;
    for (int gid = gw; gid < M * NH; gid += NGW) {
        const int h = gid & 7, tok = gid >> 3, b = tok >> 13, t = tok & (S - 1), r = t >> 6, c = t & 63;
        const int rs = min(max(r - KH / 2, 0), ROWS - KH), cs = min(max(c - KW / 2, 0), GW - KW);
        sq[F.lane] = bf2f(F.proj[(size_t)tok * DIN + h * 64 + F.lane]);
        LDS_WAIT(); asm volatile("" ::: "memory");
        float sc[6]; float mx = -1e30f;
#pragma unroll
        for (int i = 0; i < 6; ++i) {
            const int kk = F.lane + 64 * i;
            const bf16_t* kp; float bias = 0.f;
            if (kk < 128) { const int ki = kk >> 4, kj = kk & 15;
                kp = F.proj + (size_t)(b * S + (rs + ki) * GW + cs + kj) * DIN + 512 + h * 64;
                bias = F.rpb[(h * 15 + (rs + ki - r + 7)) * 31 + (cs + kj - c + 15)];
            } else kp = F.proj + (size_t)(M + b * CTX + (kk - 128)) * DIN + 512 + h * 64;
            float d = 0.f;
#pragma unroll
            for (int dd = 0; dd < 64; dd += 8) { const u32x4 kv = *(const u32x4*)(kp + dd);
                d += sq[dd] * bflo(kv.x) + sq[dd + 1] * bfhi(kv.x) + sq[dd + 2] * bflo(kv.y) + sq[dd + 3] * bfhi(kv.y) + sq[dd + 4] * bflo(kv.z) + sq[dd + 5] * bfhi(kv.z) + sq[dd + 6] * bflo(kv.w) + sq[dd + 7] * bfhi(kv.w); }
            sc[i] = d * 0.125f + bias; mx = fmaxf(mx, sc[i]);
        }
        mx = wmax(mx);
        float sum = 0.f;
#pragma unroll
        for (int i = 0; i < 6; ++i) { const float p = __expf(sc[i] - mx); sum += p; sp[F.lane + 64 * i] = p; }
        sum = wsum(sum);
        LDS_WAIT(); asm volatile("" ::: "memory");
        float acc = 0.f;
        for (int kk = 0; kk < 384; ++kk) {
            const bf16_t* vp;
            if (kk < 128) { const int ki = kk >> 4, kj = kk & 15; vp = F.proj + (size_t)(b * S + (rs + ki) * GW + cs + kj) * DIN + 1024 + h * 64; }
            else vp = F.proj + (size_t)(M + b * CTX + (kk - 128)) * DIN + 1024 + h * 64;
            acc += sp[kk] * bf2f(vp[F.lane]);
        }
        F.mixin[(size_t)tok * D + h * 64 + F.lane] = (bf16_t)f2bf(acc / sum);
        LDS_WAIT(); asm volatile("" ::: "memory");
    }
}
__device__ __forceinline__ void p_sgu_simple(Frame& F) {
    LAS bf16_t* G = (LAS bf16_t*)F.lds;
    for (int u = blockIdx.x; u < M / 128; u += F.G) {
        const int base = u * 128;
        for (int tl = F.wave; tl < 128; tl += 8) {
            const bf16_t* zr = F.proj + (size_t)(base + tl) * DIN + 2048 + F.lane * 8;
            const u32x4 zv = *(const u32x4*)zr;
            float v[8] = {bflo(zv.x), bfhi(zv.x), bflo(zv.y), bfhi(zv.y), bflo(zv.z), bfhi(zv.z), bflo(zv.w), bfhi(zv.w)};
            float s = 0.f;
#pragma unroll
            for (int i = 0; i < 8; ++i) s += v[i];
            const float mean = wsum(s) * (1.f / 512.f); float q = 0.f;
#pragma unroll
            for (int i = 0; i < 8; ++i) { v[i] -= mean; q += v[i] * v[i]; }
            const float rstd = rsqrtf(wsum(q) * (1.f / 512.f) + EPS);
#pragma unroll
            for (int i = 0; i < 8; ++i) { const int ch = F.lane * 8 + i; G[tl * 512 + ch] = (bf16_t)f2bf(v[i] * rstd * F.sgu_ln_g[ch] + F.sgu_ln_b[ch]); }
        }
        __syncthreads();
        const int ch = F.tid, grp = ch >> 7;
        for (int i = 0; i < 128; ++i) {
            const float* wrow = F.sgu_w + (size_t)(grp * 128 + i) * 128;
            float acc = 0.f;
            for (int j = 0; j < 128; ++j) acc += wrow[j] * bf2f(G[j * 512 + ch]);
            acc += F.sgu_b[grp * 128 + i];
            const float uu = bf2f(F.proj[(size_t)(base + i) * DIN + 1536 + ch]);
            F.mixin[(size_t)(base + i) * D + 512 + ch] = (bf16_t)f2bf(uu * acc);
        }
        __syncthreads();
    }
}

namespace at {
typedef float f32x16 __attribute__((ext_vector_type(16)));
typedef short s16x4 __attribute__((ext_vector_type(4)));
typedef short v4i16_t __attribute__((ext_vector_type(4)));
constexpr int A_K = 0, A_V = 32768, A_STG = 65536, A_WSF = 98304, A_RPB = 100352;
constexpr float C2 = 0.125f * 1.4426950408889634f, L2E = 1.4426950408889634f;
__device__ __forceinline__ int crow(int r, int hi) { return (r & 3) + 8 * (r >> 2) + 4 * hi; }
__device__ __forceinline__ s16x4 vtr(const LAS unsigned char* p) { return __builtin_bit_cast(s16x4, __builtin_amdgcn_ds_read_tr16_b64_v4i16((LAS v4i16_t*)p)); }
__device__ __forceinline__ int rsf(int r) { return min(max(r - KH / 2, 0), ROWS - KH); }
#define AT_WAIT_BAR() asm volatile("s_waitcnt vmcnt(0) lgkmcnt(0)\n\ts_barrier" ::: "memory")
__device__ __forceinline__ void glds16(const void* gsrc, unsigned lds_dst) { unsigned keep;
    asm volatile("s_mov_b32 %0, m0\n\ts_mov_b32 m0, %2\n\ts_nop 0\n\tglobal_load_lds_dwordx4 %1, off\n\ts_mov_b32 m0, %0" : "=&s"(keep) : "v"(gsrc), "s"(lds_dst) : "memory"); }

template <int MODE> __device__ __forceinline__ constexpr bool act0(int rr) { return MODE != 2 || rr >= 12; }
template <int MODE> __device__ __forceinline__ constexpr bool act1(int rr) { return MODE != 1 || rr < 4; }
template <int MODE>
__device__ __forceinline__ void tile_compute(const LAS unsigned char* kp0, const LAS unsigned char* vp, const LAS float* tb, const bf16x8 (&qr)[4], f32x16 (&o)[2], float& m, float& l,
                                             LAS float* wsf, int r32, int hi, int cs) {
    f32x16 p0, p1;
#pragma unroll
    for (int i = 0; i < 16; ++i) { p0[i] = 0.f; p1[i] = 0.f; }
#pragma unroll
    for (int d0 = 0; d0 < 4; ++d0) {
        const bf16x8 b0 = *(const LAS bf16x8*)(kp0 + d0 * 2048), b1 = *(const LAS bf16x8*)(kp0 + d0 * 2048 + 512);
        p0 = __builtin_amdgcn_mfma_f32_32x32x16_bf16(b0, qr[d0], p0, 0, 0, 0);
        p1 = __builtin_amdgcn_mfma_f32_32x32x16_bf16(b1, qr[d0], p1, 0, 0, 0);
    }
    float tm = -INFINITY;
#pragma unroll
    for (int rr = 0; rr < 16; ++rr) { const int ko = (rr & 3) + 8 * (rr >> 2), kc = ko + 4 * hi;
        if (MODE == 0) { p0[rr] *= C2; p1[rr] *= C2; tm = fmaxf(tm, fmaxf(p0[rr], p1[rr])); }
        else {
            if (act0<MODE>(rr)) { const float t0 = p0[rr] * C2 + tb[ko]; p0[rr] = (unsigned)(kc - cs) < (unsigned)KW ? t0 : -INFINITY; tm = fmaxf(tm, p0[rr]); }
            if (act1<MODE>(rr)) { const float t1 = p1[rr] * C2 + tb[ko + 32]; p1[rr] = (unsigned)(kc + 32 - cs) < (unsigned)KW ? t1 : -INFINITY; tm = fmaxf(tm, p1[rr]); }
        } }
    { float a = tm, bq = tm; asm volatile("s_nop 1\n\tv_permlane32_swap_b32 %0, %1" : "+v"(a), "+v"(bq)); tm = fmaxf(a, bq); }
    const float mn = fmaxf(m, tm), alpha = __builtin_amdgcn_exp2f(m - mn);
    float rsum = 0.f;
#pragma unroll
    for (int rr = 0; rr < 16; ++rr) {
        if (act0<MODE>(rr)) { p0[rr] = __builtin_amdgcn_exp2f(p0[rr] - mn); rsum += p0[rr]; } else p0[rr] = 0.f;
        if (act1<MODE>(rr)) { p1[rr] = __builtin_amdgcn_exp2f(p1[rr] - mn); rsum += p1[rr]; } else p1[rr] = 0.f; }
    l = l * alpha + rsum; m = mn;
    if (__any(alpha != 1.f)) {
        if (hi == 0) wsf[r32] = alpha;
        LDS_WAIT();
#pragma unroll
        for (int rr = 0; rr < 16; ++rr) { const float a = wsf[crow(rr, hi)]; o[0][rr] *= a; o[1][rr] *= a; }
        LDS_WAIT();
    }
    u32x4 pw[4];
#pragma unroll
    for (int q = 0; q < 4; ++q) { pw[0][q] = cvt_pk_bf16(p0[2 * q], p0[2 * q + 1]); pw[1][q] = cvt_pk_bf16(p0[8 + 2 * q], p0[9 + 2 * q]);
                                  pw[2][q] = cvt_pk_bf16(p1[2 * q], p1[2 * q + 1]); pw[3][q] = cvt_pk_bf16(p1[8 + 2 * q], p1[9 + 2 * q]); }
#pragma unroll
    for (int d0 = 0; d0 < 2; ++d0)
#pragma unroll
        for (int ks = 0; ks < 4; ++ks) {
            if ((MODE == 1 && ks == 3) || (MODE == 2 && ks == 0)) continue;
            const s16x4 lo = vtr(vp + d0 * 4096 + ks * 1024), hh = vtr(vp + d0 * 4096 + ks * 1024 + 512);
            const bf16x8 vf = (bf16x8){lo[0], lo[1], lo[2], lo[3], hh[0], hh[1], hh[2], hh[3]};
            o[d0] = __builtin_amdgcn_mfma_f32_32x32x16_bf16(__builtin_bit_cast(bf16x8, pw[ks]), vf, o[d0], 0, 0, 0);
        }
}

__device__ __forceinline__ void attn_unit(Frame& F, int b, int h, int rg) {
    const int lane = F.lane, r32 = lane & 31, hi = lane >> 5, w = F.wave;
    const int r0 = 4 * rg, r = r0 + (w >> 1), c = 32 * (w & 1) + r32;
    const int krlo = rsf(r0), nnb = rsf(r0 + 3) + 7 - krlo + 1, nst = nnb + 4;
    const int rsw = rsf(r), cs = min(max(c - KW / 2, 0), GW - KW);
    LAS float* tbl = (LAS float*)(F.lds + A_RPB);
    LAS float* wsf = (LAS float*)(F.lds + A_WSF) + w * 64;
    for (int i = F.tid; i < 480; i += 512) { const int dr = i >> 5, dc = i & 31; tbl[64 + i] = dc < 31 ? F.rpb[(h * 15 + dr) * 31 + dc] * L2E : 0.f; }
    const bf16_t* qp = F.proj + (size_t)(b * S + r * GW + c) * DIN + h * 64 + hi * 8;
    bf16x8 qr[4];
#pragma unroll
    for (int d0 = 0; d0 < 4; ++d0) qr[d0] = *(const bf16x8*)(qp + d0 * 16);
    const bf16_t* kbase = F.proj + 512 + h * 64 + w * 8;
    const bf16_t* vbase = F.proj + 1024 + h * 64 + (w >> 2) * 32 + (lane & 3) * 8;
#define AT_DMA(st) do { const int _t0 = (st) < nnb ? b * S + (krlo + (st)) * GW : M + b * CTX + ((st) - nnb) * 64; const int _bf = ((st) & 3) * 8192; \
        __builtin_amdgcn_global_load_lds((const unsigned*)(kbase + (size_t)(_t0 + lane) * DIN), (LAS unsigned*)(F.lds + A_K + _bf + w * 1024), 16, 0, 0); \
        __builtin_amdgcn_global_load_lds((const unsigned*)(vbase + (size_t)(_t0 + 16 * (w & 3) + (lane >> 2)) * DIN), (LAS unsigned*)(F.lds + A_V + _bf + w * 1024), 16, 0, 0); } while (0)
    const unsigned lds0 = (unsigned)(size_t)F.lds;
    float m = -1e30f, l = 0.f;
    f32x16 o[2];
#pragma unroll
    for (int i = 0; i < 16; ++i) { o[0][i] = 0.f; o[1][i] = 0.f; }
    AT_DMA(0); AT_DMA(1); AT_DMA(2);
    for (int st = 0; st < nst; ++st) {
        if (st + 2 < nst) asm volatile("s_waitcnt vmcnt(4) lgkmcnt(0)\n\ts_barrier" ::: "memory");
        else if (st + 1 < nst) asm volatile("s_waitcnt vmcnt(2) lgkmcnt(0)\n\ts_barrier" ::: "memory");
        else AT_WAIT_BAR();
        if (st + 3 < nst) AT_DMA(st + 3);
        const bool isnb = st < nnb; const int kr = krlo + st;
        const bool act = !isnb || (kr >= rsw && kr < rsw + KH);
        if (act) {
            const LAS unsigned char* kp0 = F.lds + A_K + (st & 3) * 8192 + hi * 1024 + r32 * 16;
            const LAS unsigned char* vp = F.lds + A_V + (st & 3) * 8192 + ((lane >> 4) & 1) * 32 + (lane & 3) * 8 + (4 * hi + ((lane & 15) >> 2)) * 64;
            const LAS float* tb = tbl + 64 + (kr - r + 7) * 32 + 4 * hi - c + 15;
            if (!isnb) tile_compute<0>(kp0, vp, tb, qr, o, m, l, wsf, r32, hi, cs);
            else if ((w & 1) == 0) tile_compute<1>(kp0, vp, tb, qr, o, m, l, wsf, r32, hi, cs);
            else tile_compute<2>(kp0, vp, tb, qr, o, m, l, wsf, r32, hi, cs);
        }
    }
#undef AT_DMA
    l += __shfl_xor(l, 32);
    if (hi == 0) wsf[32 + r32] = l;
    LDS_WAIT();
    LAS bf16_t* stg = (LAS bf16_t*)(F.lds + A_STG) + w * 2048;
#pragma unroll
    for (int rr = 0; rr < 16; ++rr) { const int orow = crow(rr, hi); const float rl = __builtin_amdgcn_rcpf(wsf[32 + orow]);
        stg[orow * 64 + r32] = (bf16_t)f2bf(o[0][rr] * rl); stg[orow * 64 + 32 + r32] = (bf16_t)f2bf(o[1][rr] * rl); }
    LDS_WAIT();
    bf16_t* ow = F.mixin + (size_t)(b * S + r * GW + 32 * (w & 1)) * D + h * 64;
#pragma unroll
    for (int i = 0; i < 4; ++i) { const int row = i * 8 + (lane >> 3), ch = lane & 7; const u32x4 v = *(const LAS u32x4*)(stg + row * 64 + ch * 8); *(u32x4*)(ow + (size_t)row * D + ch * 8) = v; }
    AT_WAIT_BAR();
}

constexpr int G_IMG = 0, G_STG = 65536, G_STAT = 98304;
__device__ __forceinline__ void sgu_unit(Frame& F, int chunk, int gh) {
    const int lane = F.lane, r32 = lane & 31, hi = lane >> 5, w = F.wave;
    const int base = chunk * 128;
    LAS f32x2* stat = (LAS f32x2*)(F.lds + G_STAT);
    u32x4 zrow[16];
#pragma unroll
    for (int t = 0; t < 16; ++t) zrow[t] = *(const u32x4*)(F.proj + (size_t)(base + 16 * w + t) * DIN + 2048 + lane * 8);
    const int cb = w & 3, th = w >> 2, grp = 2 * gh + (cb >> 1);
    const bf16_t* wp = F.sguw + (size_t)(grp * 128 + 64 * th + r32) * 128 + 8 * hi;
    bf16x8 wf0[8], wf1[8];
#pragma unroll
    for (int ks = 0; ks < 8; ++ks) { wf0[ks] = *(const bf16x8*)(wp + ks * 16); wf1[ks] = *(const bf16x8*)(wp + 32 * 128 + ks * 16); }
#pragma unroll
    for (int t = 0; t < 16; ++t) {
        const int tok = 16 * w + t;
        const u32x4 zv = zrow[t];
        float v[8] = {bflo(zv.x), bfhi(zv.x), bflo(zv.y), bfhi(zv.y), bflo(zv.z), bfhi(zv.z), bflo(zv.w), bfhi(zv.w)};
        float s = 0.f;
#pragma unroll
        for (int i = 0; i < 8; ++i) s += v[i];
        const float mean = wsum(s) * (1.f / 512.f); float q = 0.f;
#pragma unroll
        for (int i = 0; i < 8; ++i) { const float d = v[i] - mean; q += d * d; }
        const float rstd = rsqrtf(wsum(q) * (1.f / 512.f) + EPS);
        if (lane == 0) stat[tok] = (f32x2){mean, rstd};
    }
    AT_WAIT_BAR();
    {
        const int ch0 = 256 * gh + 32 * w + 8 * (lane & 3);
        const f32x4 g0 = *(const f32x4*)(F.sgu_ln_g + ch0), g1 = *(const f32x4*)(F.sgu_ln_g + ch0 + 4), b0 = *(const f32x4*)(F.sgu_ln_b + ch0), b1 = *(const f32x4*)(F.sgu_ln_b + ch0 + 4);
#pragma unroll
        for (int i = 0; i < 8; ++i) {
            const int tok = 16 * i + (lane >> 2);
            const u32x4 zv = *(const u32x4*)(F.proj + (size_t)(base + tok) * DIN + 2048 + ch0);
            const f32x2 st = stat[tok];
            u32x4 o;
            o.x = pk2((bflo(zv.x) - st[0]) * st[1] * g0[0] + b0[0], (bfhi(zv.x) - st[0]) * st[1] * g0[1] + b0[1]);
            o.y = pk2((bflo(zv.y) - st[0]) * st[1] * g0[2] + b0[2], (bfhi(zv.y) - st[0]) * st[1] * g0[3] + b0[3]);
            o.z = pk2((bflo(zv.z) - st[0]) * st[1] * g1[0] + b1[0], (bfhi(zv.z) - st[0]) * st[1] * g1[1] + b1[1]);
            o.w = pk2((bflo(zv.w) - st[0]) * st[1] * g1[2] + b1[2], (bfhi(zv.w) - st[0]) * st[1] * g1[3] + b1[3]);
            *(LAS u32x4*)(F.lds + G_IMG + w * 8192 + i * 1024 + lane * 16) = o;
        }
    }
    AT_WAIT_BAR();
    f32x16 acc[2][2];
#pragma unroll
    for (int a = 0; a < 2; ++a)
#pragma unroll
        for (int q = 0; q < 2; ++q)
#pragma unroll
            for (int i = 0; i < 16; ++i) acc[a][q][i] = 0.f;
    const LAS unsigned char* gp = F.lds + G_IMG + (2 * cb) * 8192 + ((lane >> 4) & 1) * 32 + (lane & 3) * 8 + (8 * hi + ((lane & 15) >> 2)) * 64;
#pragma unroll
    for (int ks = 0; ks < 8; ++ks) {
        const bf16x8 w0 = wf0[ks], w1 = wf1[ks];
#pragma unroll
        for (int c32 = 0; c32 < 2; ++c32) {
            const s16x4 lo = vtr(gp + c32 * 8192 + ks * 1024), hh = vtr(gp + c32 * 8192 + ks * 1024 + 256);
            const bf16x8 gf = (bf16x8){lo[0], lo[1], lo[2], lo[3], hh[0], hh[1], hh[2], hh[3]};
            acc[0][c32] = __builtin_amdgcn_mfma_f32_32x32x16_bf16(gf, w0, acc[0][c32], 0, 0, 0);
            acc[1][c32] = __builtin_amdgcn_mfma_f32_32x32x16_bf16(gf, w1, acc[1][c32], 0, 0, 0);
        }
    }
    LAS unsigned char* stg = F.lds + G_STG + w * 4096;
#pragma unroll
    for (int ib = 0; ib < 2; ++ib) {
        const int i0 = 64 * th + 32 * ib;
        const float bi = F.sgu_b[grp * 128 + i0 + r32];
#pragma unroll
        for (int c32 = 0; c32 < 2; ++c32)
#pragma unroll
            for (int a = 0; a < 4; ++a) { u32x2 o; o.x = pk2(acc[ib][c32][4 * a] + bi, acc[ib][c32][4 * a + 1] + bi); o.y = pk2(acc[ib][c32][4 * a + 2] + bi, acc[ib][c32][4 * a + 3] + bi);
                *(LAS u32x2*)(stg + r32 * 128 + (((4 * c32 + a) ^ (r32 & 7)) << 4) + hi * 8) = o; }
        LDS_WAIT();
#pragma unroll
        for (int it = 0; it < 4; ++it) {
            const int row = 8 * it + (lane >> 3), chn = lane & 7;
            const u32x4 v = *(const LAS u32x4*)(stg + row * 128 + ((chn ^ (row & 7)) << 4));
            const size_t tok = (size_t)(base + i0 + row);
            const u32x4 uv = *(const u32x4*)(F.proj + tok * DIN + 1536 + 256 * gh + 64 * cb + 8 * chn);
            u32x4 o;
            o.x = pk2(bflo(v.x) * bflo(uv.x), bfhi(v.x) * bfhi(uv.x)); o.y = pk2(bflo(v.y) * bflo(uv.y), bfhi(v.y) * bfhi(uv.y));
            o.z = pk2(bflo(v.z) * bflo(uv.z), bfhi(v.z) * bfhi(uv.z)); o.w = pk2(bflo(v.w) * bflo(uv.w), bfhi(v.w) * bfhi(uv.w));
            *(u32x4*)(F.mixin + tok * D + 512 + 256 * gh + 64 * cb + 8 * chn) = o;
        }
        LDS_WAIT();
    }
    AT_WAIT_BAR();
}
__device__ __forceinline__ void p_mixer(Frame& F) {
#ifndef PROBE_MIX_A
#define PROBE_MIX_A 1
#endif
#ifndef PROBE_MIX_S
#define PROBE_MIX_S 1
#endif
#pragma unroll 1
    for (int rep = 0; rep < PROBE_MIX_A; ++rep)
    for (int uid = F.vcu; uid < NB * NH * 32; uid += F.G) attn_unit(F, uid >> 8, (uid >> 5) & 7, uid & 31);
#pragma unroll 1
    for (int rep = 0; rep < PROBE_MIX_S; ++rep)
    for (int uid = F.vcu; uid < (M / 128) * 2; uid += F.G) sgu_unit(F, uid >> 1, uid & 1);
}
#undef AT_WAIT_BAR
}

__device__ __forceinline__ void route_select(Frame& F, float lgt, int e, int lane, int tl, int tok, LAS int* lcnt, LAS int* sel, LAS float* selg) {
    int rank = 0; float mx = -3.0e38f;
#pragma unroll
    for (int e2 = 0; e2 < NE; ++e2) { const float o = rlane(lgt, ((e2 >> 4) << 5) | (((e2 >> 3) & 1) << 4) | (e2 & 7));
        rank += (o > lgt || (o == lgt && e2 < e)) ? 1 : 0; mx = fmaxf(mx, o); }
    const bool selq = rank < TOPK && !(lane & 8);
    const float pe = selq ? __expf(lgt - mx) : 0.f;
    const float den = wsum(pe);
    if (selq) {
        const int lp = __hip_atomic_fetch_add(lcnt + e, 1, __ATOMIC_RELAXED, __HIP_MEMORY_SCOPE_WORKGROUP);
        sel[tl * 4 + rank] = e | (lp << 8); selg[tl * 4 + rank] = pe / den;
        F.topg[tok * 4 + rank] = pe / den; F.topi[tok * 4 + rank] = e;
    }
}
__device__ __forceinline__ float route_reduce(const f32x2 (&lg2)[NE / 2], int lane) {
    float r16[16], r8[8];
#pragma unroll
    for (int e = 0; e < 16; ++e) { float a = lg2[e >> 1][e & 1], bq = lg2[(e + 16) >> 1][e & 1]; asm volatile("s_nop 1\n\tv_permlane32_swap_b32 %0, %1" : "+v"(a), "+v"(bq)); r16[e] = a + bq; }
#pragma unroll
    for (int e = 0; e < 8; ++e) { float a = r16[e], bq = r16[e + 8]; asm volatile("s_nop 1\n\tv_permlane16_swap_b32 %0, %1" : "+v"(a), "+v"(bq)); r8[e] = a + bq; }
    float r1 = 0.f;
#pragma unroll
    for (int e = 0; e < 8; ++e) { float t = r8[e]; t += dppf<0xB1>(t); t += dppf<0x4E>(t); t += dppf<0x141>(t); t += dppf<0x140>(t); r1 = ((lane & 7) == e) ? t : r1; }
    return r1;
}
__device__ __forceinline__ void p_route(Frame& F) {
    LAS int* lcnt = (LAS int*)(F.lds + L_ROUTE); LAS int* gbase = lcnt + 32; LAS int* sel = lcnt + 64; LAS float* selg = (LAS float*)(F.lds + L_RPB);
    for (int i = F.tid; i < 8192; i += 512) { const int c = i >> 3, q = i & 7; *(LAS f32x4*)(F.lds + c * 128 + ((q ^ ((c >> 1) & 7)) << 4)) = *(const f32x4*)(F.router_w + c * 32 + q * 4); }
    if (F.tid < 32) lcnt[F.tid] = 0;
    __syncthreads();
    const int lane = F.lane;
    const LAS unsigned char* wbase = F.lds + lane * 128;
    const int sw = (lane >> 1) & 7;
    LAS unsigned char* hrowA = F.lds + L_WSCR + F.wave * 2048; LAS unsigned char* hrowB = hrowA + 1024;
    const int e = ((lane >> 5) << 4) | (((lane >> 4) & 1) << 3) | (lane & 7);
    const float rbias = F.router_b[e];
    for (int tb = blockIdx.x; tb < M / 64; tb += F.G) {
        const int b = (tb * 64) >> 13;
        float ps[16], ph[16];
#pragma unroll
        for (int i = 0; i < 16; ++i) { const int col = lane + 64 * i; ps[i] = 1.f + F.mod[b * 6144 + 4 * 1024 + col]; ph[i] = F.mod[b * 6144 + 3 * 1024 + col]; }
#pragma unroll 1
        for (int k = 0; k < 4; ++k) {
            const int tlA = F.wave + 8 * k, tlB = tlA + 32, tokA = tb * 64 + tlA, tokB = tb * 64 + tlB;
            float vA[16], vB[16]; float sA = 0.f, sB = 0.f;
            float pg[16], pb[16];
#pragma unroll
            for (int i = 0; i < 16; ++i) { pg[i] = F.ln1_g[lane + 64 * i]; pb[i] = F.ln1_b[lane + 64 * i]; }
            { const bf16_t* ya = F.y1 + (size_t)tokA * D; const bf16_t* yb = F.y1 + (size_t)tokB * D;
#pragma unroll
              for (int i = 0; i < 16; ++i) { vA[i] = bf2f(ya[lane + 64 * i]); vB[i] = bf2f(yb[lane + 64 * i]); }
#pragma unroll
              for (int i = 0; i < 16; ++i) { sA += vA[i]; sB += vB[i]; } }
            float meanA = wsum(sA) * (1.f / D), meanB = wsum(sB) * (1.f / D), qA = 0.f, qB = 0.f;
#pragma unroll
            for (int i = 0; i < 16; ++i) { vA[i] -= meanA; qA += vA[i] * vA[i]; vB[i] -= meanB; qB += vB[i] * vB[i]; }
            float rstdA = rsqrtf(wsum(qA) * (1.f / D) + EPS), rstdB = rsqrtf(wsum(qB) * (1.f / D) + EPS);
            if (lane == 0) { F.stat[tokA] = (f32x2){meanA, rstdA}; F.stat[tokB] = (f32x2){meanB, rstdB}; }
            sA = 0.f; sB = 0.f;
#pragma unroll
            for (int i = 0; i < 16; ++i) { vA[i] = vA[i] * rstdA * pg[i] + pb[i]; sA += vA[i]; vB[i] = vB[i] * rstdB * pg[i] + pb[i]; sB += vB[i]; }
#ifdef MK_WRITE_X1
#pragma unroll
            for (int i = 0; i < 16; ++i) { F.x1[(size_t)tokA * D + lane + 64 * i] = vA[i]; F.x1[(size_t)tokB * D + lane + 64 * i] = vB[i]; }
#endif
            meanA = wsum(sA) * (1.f / D); meanB = wsum(sB) * (1.f / D); qA = 0.f; qB = 0.f;
#pragma unroll
            for (int i = 0; i < 16; ++i) { vA[i] -= meanA; qA += vA[i] * vA[i]; vB[i] -= meanB; qB += vB[i] * vB[i]; }
            rstdA = rsqrtf(wsum(qA) * (1.f / D) + EPS); rstdB = rsqrtf(wsum(qB) * (1.f / D) + EPS);
#pragma unroll
            for (int i = 0; i < 16; ++i) { vA[i] = vA[i] * rstdA * ps[i] + ph[i]; vB[i] = vB[i] * rstdB * ps[i] + ph[i];
                hrowA[lane + 64 * i] = (unsigned char)__builtin_amdgcn_cvt_pk_fp8_f32(vA[i], vA[i], 0, false); hrowB[lane + 64 * i] = (unsigned char)__builtin_amdgcn_cvt_pk_fp8_f32(vB[i], vB[i], 0, false); }
            f32x2 lgA[NE / 2], lgB[NE / 2];
#pragma unroll
            for (int q = 0; q < NE / 2; ++q) { lgA[q] = (f32x2){0.f, 0.f}; lgB[q] = (f32x2){0.f, 0.f}; }
#pragma unroll
            for (int i = 0; i < 16; ++i) {
                f32x4 wa[8];
#pragma unroll
                for (int qq = 0; qq < 8; ++qq) wa[qq] = *(const LAS f32x4*)(wbase + i * 8192 + ((qq ^ sw) << 4));
                __builtin_amdgcn_sched_barrier(0);
                const f32x2 ha = (f32x2){vA[i], vA[i]}, hb = (f32x2){vB[i], vB[i]};
#pragma unroll
                for (int qq = 0; qq < 8; ++qq) { const f32x2 w0 = (f32x2){wa[qq][0], wa[qq][1]}, w1 = (f32x2){wa[qq][2], wa[qq][3]};
                    lgA[2 * qq] = __builtin_elementwise_fma(ha, w0, lgA[2 * qq]); lgA[2 * qq + 1] = __builtin_elementwise_fma(ha, w1, lgA[2 * qq + 1]);
                    lgB[2 * qq] = __builtin_elementwise_fma(hb, w0, lgB[2 * qq]); lgB[2 * qq + 1] = __builtin_elementwise_fma(hb, w1, lgB[2 * qq + 1]); }
                __builtin_amdgcn_sched_barrier(0);
            }
            LDS_WAIT();
            *(u32x4*)(F.h2 + (size_t)tokA * D + lane * 16) = *(const LAS u32x4*)(hrowA + lane * 16);
            *(u32x4*)(F.h2 + (size_t)tokB * D + lane * 16) = *(const LAS u32x4*)(hrowB + lane * 16);
            const float lgtA = route_reduce(lgA, lane) + rbias, lgtB = route_reduce(lgB, lane) + rbias;
            route_select(F, lgtA, e, lane, tlA, tokA, lcnt, sel, selg);
            route_select(F, lgtB, e, lane, tlB, tokB, lcnt, sel, selg);
        }
        __syncthreads();
        if (F.tid < 32) { const int n = lcnt[F.tid]; gbase[F.tid] = n ? (int)__hip_atomic_fetch_add(F.cntw + 32 * F.tid, (unsigned)n, __ATOMIC_RELAXED, __HIP_MEMORY_SCOPE_AGENT) : 0; lcnt[F.tid] = 0; }
        __syncthreads();
        if (F.tid < 256) { const int sv = sel[F.tid], ee = sv & 255, lp = sv >> 8; F.list[(size_t)ee * LCAP + gbase[ee] + lp] = (tb * 64 + (F.tid >> 2)) * 4 + (F.tid & 3); F.listg[(size_t)ee * LCAP + gbase[ee] + lp] = selg[F.tid]; }
        __syncthreads();
    }
}

__device__ __forceinline__ void p_final(Frame& F) {
    const int gw = F.vcu * 8 + F.wave, NGW = F.G * 8;
    for (int tok = gw; tok < M; tok += NGW) {
        const float* g2 = F.mod + (tok >> 13) * 6144 + 5 * 1024;
        const u32x2* xp = (const u32x2*)(F.y1 + (size_t)tok * D) + F.lane;
        const f32x2 st = F.stat[tok];
        f32x4 v[4]; float s = 0.f;
#pragma unroll
        for (int j = 0; j < 4; ++j) {
            f32x4 f = (f32x4){0.f, 0.f, 0.f, 0.f};
#pragma unroll
            for (int k = 0; k < TOPK; ++k) { const u32x2 yv = __builtin_nontemporal_load((const u32x2*)(F.ybuf + (size_t)(tok * 4 + k) * D) + F.lane + 64 * j);
                f[0] += bflo(yv.x); f[1] += bfhi(yv.x); f[2] += bflo(yv.y); f[3] += bfhi(yv.y); }
            const f32x4 gv = *((const f32x4*)g2 + F.lane + 64 * j);
            const f32x4 l1g = *((const f32x4*)F.ln1_g + F.lane + 64 * j), l1b = *((const f32x4*)F.ln1_b + F.lane + 64 * j);
            const u32x2 yw = __builtin_nontemporal_load(xp + 64 * j); const f32x4 yv = (f32x4){bflo(yw.x), bfhi(yw.x), bflo(yw.y), bfhi(yw.y)};
            const f32x4 x1v = (yv - st[0]) * st[1] * l1g + l1b;
            v[j] = x1v * DN_ALPHA + gv * f; s += (v[j][0] + v[j][1]) + (v[j][2] + v[j][3]);
        }
        const float mean = wsum(s) * (1.f / D); float q = 0.f;
#pragma unroll
        for (int j = 0; j < 4; ++j) { v[j] = v[j] - mean; q += (v[j][0] * v[j][0] + v[j][1] * v[j][1]) + (v[j][2] * v[j][2] + v[j][3] * v[j][3]); }
        const float rstd = rsqrtf(wsum(q) * (1.f / D) + EPS);
        f32x4* op = (f32x4*)(F.out + (size_t)tok * D) + F.lane;
#pragma unroll
        for (int j = 0; j < 4; ++j) { const f32x4 gg = *((const f32x4*)F.ln2_g + F.lane + 64 * j), bb = *((const f32x4*)F.ln2_b + F.lane + 64 * j); op[64 * j] = v[j] * rstd * gg + bb; }
    }
}

struct Args { const float* in[23]; float* out; unsigned char* ws; int ph_lo, ph_hi, alt, pad; };
constexpr int N_PHASES = 9;
__global__ void __launch_bounds__(512, 2) mk_fwd(Args args) {
    extern __shared__ __attribute__((aligned(16))) unsigned char lds_raw[];
    Frame F;
    F.lds = (LAS unsigned char*)lds_raw;
    F.MISC = (volatile LAS unsigned*)(F.lds + L_MISC);
    F.tid = threadIdx.x; F.lane = F.tid & 63; F.wave = __builtin_amdgcn_readfirstlane(F.tid >> 6);
    F.G = gridDim.x; { const int bx = blockIdx.x; F.vcu = (F.G % 8 == 0) ? (bx % 8) * (F.G / 8) + bx / 8 : bx; }
    unsigned char* ws = args.ws;
    F.ctl = (unsigned*)(ws + WS_CTL);
    F.x = args.in[0]; F.c = args.in[1]; F.ctx = args.in[2]; F.c_ctx = args.in[3]; F.ada_w = args.in[4]; F.ada_b = args.in[5]; F.w_in = args.in[6]; F.rpb = args.in[7];
    F.sgu_ln_g = args.in[8]; F.sgu_ln_b = args.in[9]; F.sgu_w = args.in[10]; F.sgu_b = args.in[11]; F.w_out = args.in[12]; F.ln1_g = args.in[13]; F.ln1_b = args.in[14];
    F.ln2_g = args.in[15]; F.ln2_b = args.in[16]; F.router_w = args.in[17]; F.router_b = args.in[18]; F.w_gu = args.in[19]; F.b_gu = args.in[20]; F.w_dn = args.in[21]; F.b_dn = args.in[22];
    F.out = args.out;
    F.mod = (float*)(ws + WS_MOD); F.topg = (float*)(ws + WS_TOPG); F.topi = (int*)(ws + WS_TOPI); F.list = (int*)(ws + WS_LIST); F.listg = (float*)(ws + WS_LISTG); F.sguw = (bf16_t*)(ws + WS_SGUW);
    F.Wt_in = (bf16_t*)(ws + WS_WIN); F.Wt_out = (bf16_t*)(ws + WS_WOUT); F.Wt_gu = ws + WS_WGU; F.Wt_dn = ws + WS_WDN;
    F.hxc = (bf16_t*)(ws + WS_HXC); F.proj = (bf16_t*)(ws + WS_PROJ); F.mixin = (bf16_t*)(ws + WS_MIXIN); F.y1 = (bf16_t*)(ws + WS_Y1); F.x1 = (float*)(ws + WS_X1); F.stat = (f32x2*)(ws + WS_STAT); F.cntw = F.ctl + CW_CNT; F.h2 = ws + WS_H2;
    F.act = ws + WS_ACT; F.ybuf = (bf16_t*)(ws + WS_YBUF);
    for (int u = F.tid; u < (LDS_BYTES - L_MISC) / 4; u += 512) ((LAS unsigned*)(F.lds + L_MISC))[u] = 0u;
    __syncthreads();
    if (args.alt) { F.x1 = (float*)(ws + WS_ALT); F.h2 = ws + WS_ALT + 64 * MiB; F.list = (int*)(ws + WS_ALT + 80 * MiB); F.listg = (float*)(ws + WS_ALT + 84 * MiB); F.topg = (float*)(ws + WS_ALT + 82 * MiB); F.topi = (int*)(ws + WS_ALT + 82 * MiB + 512 * 1024); F.cntw = F.ctl + CW_CNT_ALT; F.stat = (f32x2*)(ws + WS_ALT + 83 * MiB); }
    const int lo = args.ph_lo, hi = args.ph_hi;
    const bool one = (hi - lo) > 1;
    XcdBarrier bar; bar.bar = (unsigned*)(F.ctl + CW_BAR); bar.x = 0; bar.st = nullptr;
    if (one) bar = xcd_barrier_post((unsigned*)(F.ctl + CW_BAR), F.MISC + 8);
#define IN(k) (lo <= (k) && (k) < hi)
#define SEAM(k) do { if (IN(k) && IN((k) + 1)) xcd_barrier(bar); } while (0)
#ifndef PROBE_REPS
#define PROBE_REPS {1, 1, 1, 1, 1, 1, 1, 1, 1}
#endif
    constexpr int REPS[N_PHASES] = PROBE_REPS;
#define REPEAT(k) _Pragma("unroll") for (int rep_ = 0; rep_ < REPS[k]; ++rep_)
#define RSEAM(k) do { if (rep_ + 1 < REPS[k]) xcd_barrier(bar); else SEAM(k); } while (0)
    constexpr int W_ITEMS = 16 * 80 + 16 * 32 + NE * 16 * 64 + NE * 16 * 32, W_TAIL = 7680;
    const bool tail_wg = (F.G == 256 && (int)blockIdx.x >= 136);
    if (IN(0)) REPEAT(0) { p_ada(F); p_weights(F, 0, (F.G == 256) ? W_ITEMS - W_TAIL : W_ITEMS, F.vcu * 8 + F.wave, F.G * 8, true); RSEAM(0); }
    if (IN(1)) REPEAT(1) { p_lnmod(F); RSEAM(1); }
    if (IN(2)) REPEAT(2) { PolProj P{F.hxc, F.Wt_in, F.proj, F.G, (int)blockIdx.x}; pg8::gemm_phase<PolProj>(F.lds, P);
        if (tail_wg) p_weights(F, W_ITEMS - W_TAIL, W_TAIL, ((int)blockIdx.x - 136) * 8 + F.wave, 120 * 8, false); RSEAM(2); }
    if (IN(3)) REPEAT(3) { at::p_mixer(F); RSEAM(3); }
    if (IN(4)) REPEAT(4) { PolOut P{F.mixin, F.Wt_out, F.x, F.mod, F.y1, F.G, (int)blockIdx.x}; pg8::gemm_phase<PolOut>(F.lds, P); RSEAM(4); }
    if (IN(5)) { p_route(F); SEAM(5); }
    if (IN(6)) REPEAT(6) { const int T = expert_tables(F); ExpTab tb{(const LAS int*)(F.lds + L_TILEE), (const LAS int*)(F.lds + L_TSTART), (const LAS int*)(F.lds + L_TSTART) + 64, T};
        PolGU P{F.h2, F.Wt_gu, F.b_gu, F.list, F.act, tb, F.G, (int)blockIdx.x}; pg8::gemm_phase<PolGU>(F.lds, P); RSEAM(6); }
    if (IN(7)) REPEAT(7) { const int T = expert_tables(F); ExpTab tb{(const LAS int*)(F.lds + L_TILEE), (const LAS int*)(F.lds + L_TSTART), (const LAS int*)(F.lds + L_TSTART) + 64, T};
        PolDN P{F.act, F.Wt_dn, F.b_dn, F.list, F.listg, F.ybuf, tb, F.G, (int)blockIdx.x}; pg8::gemm_phase<PolDN>(F.lds, P); RSEAM(7); }
    if (IN(8)) REPEAT(8) { p_final(F); if (rep_ + 1 < REPS[8]) xcd_barrier(bar); }
#undef IN
#undef SEAM
#undef REPEAT
#undef RSEAM
}

static inline void launch_forward(void* const* d_in, void* d_out, void* d_ws, hipStream_t stream, int n_launches) {
    static int grid = 0;
    if (grid == 0) {
        int dev = 0, cus = 0;
        if (hipGetDevice(&dev) != hipSuccess || hipDeviceGetAttribute(&cus, hipDeviceAttributeMultiprocessorCount, dev) != hipSuccess) { fprintf(stderr, "kernel_launch: device query failed\n"); grid = -1; return; }
        if (hipFuncSetAttribute((const void*)mk_fwd, hipFuncAttributeMaxDynamicSharedMemorySize, LDS_BYTES) != hipSuccess) { fprintf(stderr, "kernel_launch: hipFuncSetAttribute failed\n"); grid = -1; return; }
        int per_cu = 0;
        if (hipOccupancyMaxActiveBlocksPerMultiprocessor(&per_cu, (const void*)mk_fwd, 512, LDS_BYTES) != hipSuccess || per_cu < 1) fprintf(stderr, "kernel_launch: occupancy query says %d\n", per_cu);
        (void)hipGetLastError();
        grid = cus;
    }
    if (grid < 0) return;
    (void)hipMemsetAsync((char*)d_ws + WS_CTL, 0, CTL_ZERO_BYTES, stream);
    Args a{};
    for (int i = 0; i < 23; ++i) a.in[i] = (const float*)d_in[i];
    a.out = (float*)d_out; a.ws = (unsigned char*)d_ws;
    if (n_launches == 1) { a.ph_lo = 0; a.ph_hi = N_PHASES; hipLaunchKernelGGL(mk_fwd, dim3(grid), dim3(512), LDS_BYTES, stream, a); }
    else for (int p = 0; p < N_PHASES; ++p) { a.ph_lo = p; a.ph_hi = p + 1; hipLaunchKernelGGL(mk_fwd, dim3(grid), dim3(512), LDS_BYTES, stream, a); }
#ifdef PROBE_EXTRA
    { const int extra[] = PROBE_EXTRA; for (int p : extra) { a.ph_lo = p; a.ph_hi = p + 1; a.alt = (p == 5); hipLaunchKernelGGL(mk_fwd, dim3(grid), dim3(512), LDS_BYTES, stream, a); } }
#endif
}
}
extern "C" void kernel_launch(void* const* d_in, const int* in_sizes, int n_in, void* d_out, int out_size, void* d_ws, size_t ws_size, hipStream_t stream) {
    if (ws_size < mk::WS_END || n_in != 23) { fprintf(stderr, "kernel_launch: unexpected workspace / inputs (%zu, %d)\n", ws_size, n_in); return; }
    mk::launch_forward(d_in, d_out, d_ws, stream, 1);
}
```

```cpp
#include <hip/hip_runtime.h>
#include <stdint.h>
#include <stdio.h>

#define GAS __attribute__((address_space(1)))
#define LAS __attribute__((address_space(3)))
typedef unsigned short bf16_t;
typedef short bf16x8 __attribute__((ext_vector_type(8)));
typedef float f32x4 __attribute__((ext_vector_type(4)));
typedef float f32x2 __attribute__((ext_vector_type(2)));
typedef unsigned u32x4 __attribute__((ext_vector_type(4)));
typedef unsigned u32x2 __attribute__((ext_vector_type(2)));

namespace mk {
constexpr int D = 1024, NB = 2, S = 8192, M = NB * S, GW = 64, ROWS = 128, CTX = 256, NH = 8, KH = 8, KW = 16;
constexpr int NE = 32, TOPK = 4, DFF = 1024, DIN = 2560, NPAIR = M * TOPK, MX = M + NB * CTX;
constexpr int LCAP = 16384, MAXT = 288, ACT_ROWS = MAXT * 256;
constexpr float EPS = 1e-5f;
constexpr float DN_ALPHA = 1.189207115002721f;
constexpr size_t MiB = 1u << 20;
constexpr size_t WS_CTL = 0, CTL_ZERO_BYTES = 1 * MiB;
constexpr size_t WS_MOD = 1 * MiB;
constexpr size_t WS_TOPG = 2 * MiB;
constexpr size_t WS_TOPI = 2 * MiB + 512 * 1024;
constexpr size_t WS_STAT = 5 * MiB + 512 * 1024;
constexpr size_t WS_LIST = 3 * MiB;
constexpr size_t WS_SGUW = 5 * MiB;
constexpr size_t WS_LISTG = 14 * MiB;
constexpr size_t WS_WIN = 6 * MiB;
constexpr size_t WS_WOUT = 11 * MiB;
constexpr size_t WS_WGU = 16 * MiB;
constexpr size_t WS_WDN = 144 * MiB;
constexpr size_t WS_HXC = 208 * MiB;
constexpr size_t WS_PROJ = 241 * MiB;
constexpr size_t WS_MIXIN = 324 * MiB;
constexpr size_t WS_Y1 = 356 * MiB;
constexpr size_t WS_H2 = 420 * MiB;
constexpr size_t WS_ACT = 452 * MiB;
constexpr size_t WS_YBUF = 596 * MiB;
constexpr size_t WS_X1 = 724 * MiB;
constexpr size_t WS_END = 788 * MiB;
constexpr size_t WS_ALT = 788 * MiB;
constexpr int CW_CNT_ALT = 12288;
constexpr int CW_BAR = 4096;
constexpr int CW_CNT = 8192;
constexpr int RING_BYTES = 131072;
constexpr int L_MISC = RING_BYTES;
constexpr int L_IDX = L_MISC + 1024;
constexpr int L_TILEE = L_IDX + 6144;
constexpr int L_TSTART = L_TILEE + 1280;
constexpr int L_ROUTE = L_TSTART + 512;
constexpr int L_RPB = L_ROUTE + 256 + 1024;
constexpr int L_WSCR = L_RPB + 2048;
constexpr int LDS_BYTES = 163840;
static_assert(L_WSCR + 8 * 2048 <= LDS_BYTES, "LDS map");

template <int CTRL> __device__ __forceinline__ float dppf(float v) { return __builtin_bit_cast(float, __builtin_amdgcn_update_dpp(0, __builtin_bit_cast(int, v), CTRL, 0xF, 0xF, true)); }
__device__ __forceinline__ float rlane(float v, int l) { return __builtin_bit_cast(float, __builtin_amdgcn_readlane(__builtin_bit_cast(int, v), l)); }
__device__ __forceinline__ float wsum(float v) {
    v += dppf<0xB1>(v); v += dppf<0x4E>(v); v += dppf<0x141>(v); v += dppf<0x140>(v);
    return (rlane(v, 0) + rlane(v, 16)) + (rlane(v, 32) + rlane(v, 48));
}
__device__ __forceinline__ float wmax(float v) {
    v = fmaxf(v, dppf<0xB1>(v)); v = fmaxf(v, dppf<0x4E>(v)); v = fmaxf(v, dppf<0x141>(v)); v = fmaxf(v, dppf<0x140>(v));
    return fmaxf(fmaxf(rlane(v, 0), rlane(v, 16)), fmaxf(rlane(v, 32), rlane(v, 48)));
}
__device__ __forceinline__ unsigned f2bf(float f) { unsigned u = __builtin_bit_cast(unsigned, f); return (u + 0x7fffu + ((u >> 16) & 1u)) >> 16; }
__device__ __forceinline__ unsigned pk2(float lo, float hi) { return f2bf(lo) | (f2bf(hi) << 16); }
__device__ __forceinline__ float bf2f(unsigned short b) { return __builtin_bit_cast(float, ((unsigned)b) << 16); }
__device__ __forceinline__ float bflo(unsigned w) { return __builtin_bit_cast(float, w << 16); }
__device__ __forceinline__ float bfhi(unsigned w) { return __builtin_bit_cast(float, w & 0xffff0000u); }
__device__ __forceinline__ void store16_sc1(void* p, u32x4 v) { asm volatile("global_store_dwordx4 %0, %1, off sc1\n\ts_nop 1" :: "v"(p), "v"(v) : "memory"); }
__device__ __forceinline__ unsigned cvt_pk_bf16(float lo, float hi) { unsigned r; asm volatile("v_cvt_pk_bf16_f32 %0, %1, %2" : "=v"(r) : "v"(lo), "v"(hi)); return r; }
__device__ __forceinline__ unsigned pk4_fp8(float a, float b, float c, float d) { return (unsigned)__builtin_amdgcn_cvt_pk_fp8_f32(c, d, __builtin_amdgcn_cvt_pk_fp8_f32(a, b, 0, false), true); }
__device__ __forceinline__ float gelu_fast(float x) {
    const float c1 = -2.302208198f;
    const float c3 = c1 * 0.044715f;
    const float x2 = x * x;
    const float t = x * (c1 + c3 * x2);
    return x * __builtin_amdgcn_rcpf(1.f + __builtin_amdgcn_exp2f(t));
}

#define XB_TMO      128
#define XB_XCNT(j)  (256  + 64 * (j))
#define XB_XSUB(j)  (1280 + 64 * (j))
#define XB_XGEN(j)  (2304 + 64 * (j))
#define XB_TOP      3328
#define XB_TOPGEN   3392
#define XCD_BAR_WORDS 3456
#define XB_SPIN_CAP (1u << 18)
__device__ __forceinline__ unsigned xb_ld(unsigned* p)              { return __hip_atomic_load(p, __ATOMIC_RELAXED, __HIP_MEMORY_SCOPE_AGENT); }
__device__ __forceinline__ unsigned xb_add(unsigned* p, unsigned v) { return __hip_atomic_fetch_add(p, v, __ATOMIC_RELAXED, __HIP_MEMORY_SCOPE_AGENT); }
__device__ __forceinline__ unsigned xb_xcc_id() { return (unsigned)__builtin_amdgcn_s_getreg((3 << 11) | 20) & 0xFu; }
#define XB_SPIN(cond, bar) do { unsigned _sp = 0; while (cond) { __builtin_amdgcn_s_sleep(1); \
    if ((++_sp & 255u) == 0u) { if (xb_ld(&(bar)[XB_TMO])) break; if (_sp > XB_SPIN_CAP) { atomicAdd(&(bar)[XB_TMO], 1u); break; } } } } while (0)
struct XcdBarrier { unsigned* bar; unsigned x; volatile LAS unsigned* st; };
__device__ __forceinline__ XcdBarrier xcd_barrier_post(unsigned* bar, volatile LAS unsigned* st) {
    XcdBarrier b; b.bar = bar; b.x = xb_xcc_id(); b.st = st;
    if (threadIdx.x == 0) (void)xb_add(&bar[XB_XCNT(b.x)], 1u);
    return b;
}
__device__ __forceinline__ void xcd_barrier_complete(unsigned* bar, unsigned x, unsigned& nloc, unsigned& nx) {
    const unsigned G = gridDim.x * gridDim.y * gridDim.z;
    unsigned sum, cnt, mine, sp = 0u;
    for (;;) {
        sum = 0u; cnt = 0u; mine = 0u;
#pragma unroll
        for (unsigned j = 0; j < 16; ++j) { const unsigned c = xb_ld(&bar[XB_XCNT(j)]); sum += c; cnt += (c > 0u) ? 1u : 0u; mine = (j == x) ? c : mine; }
        if (sum == G) break;
        __builtin_amdgcn_s_sleep(1);
        if ((++sp & 255u) == 0u) { if (xb_ld(&bar[XB_TMO])) break; if (sp > XB_SPIN_CAP) { atomicAdd(&bar[XB_TMO], 1u); break; } }
    }
    nloc = mine > 0u ? mine : 1u; nx = cnt > 0u ? cnt : 1u;
}
__device__ __forceinline__ void xcd_barrier(const XcdBarrier& b) {
    asm volatile("s_waitcnt vmcnt(0)" ::: "memory");
    __syncthreads();
    if (threadIdx.x == 0) {
        unsigned* bar = b.bar;
        __builtin_amdgcn_s_waitcnt(0);
        unsigned nloc = b.st[0], nx = b.st[1];
        if (nloc == 0u) { xcd_barrier_complete(bar, b.x, nloc, nx); b.st[0] = nloc; b.st[1] = nx; }
        const unsigned old = xb_add(&bar[XB_XSUB(b.x)], 1u);
        const unsigned gen = old / nloc;
        if (old + 1u == (gen + 1u) * nloc) {
            __builtin_amdgcn_fence(__ATOMIC_RELEASE, "agent");
            asm volatile("s_waitcnt vmcnt(0)" ::: "memory");
            const unsigned og = xb_add(&bar[XB_TOP], 1u);
            const unsigned tg = og / nx;
            if (og + 1u == (tg + 1u) * nx) xb_add(&bar[XB_TOPGEN], 1u);
            else XB_SPIN(xb_ld(&bar[XB_TOPGEN]) == tg, bar);
            __builtin_amdgcn_fence(__ATOMIC_ACQUIRE, "agent");
            xb_add(&bar[XB_XGEN(b.x)], 1u);
            asm volatile("s_waitcnt vmcnt(0)" ::: "memory");
        } else {
            XB_SPIN(xb_ld(&bar[XB_XGEN(b.x)]) == gen, bar);
            __builtin_amdgcn_fence(__ATOMIC_ACQUIRE, "agent");
            asm volatile("s_waitcnt vmcnt(0)" ::: "memory");
        }
    }
    __syncthreads();
}

struct Frame {
    LAS unsigned char* lds;
    volatile LAS unsigned* MISC;
    unsigned* ctl;
    int tid, lane, wave, vcu, G;
    const float *x, *c, *ctx, *c_ctx, *ada_w, *ada_b, *w_in, *rpb, *sgu_ln_g, *sgu_ln_b, *sgu_w, *sgu_b, *w_out, *ln1_g, *ln1_b, *ln2_g, *ln2_b, *router_w, *router_b, *w_gu, *b_gu, *w_dn, *b_dn;
    float* out;
    float* mod; float* topg; int* topi; int* list; float* listg; bf16_t* sguw; bf16_t* Wt_in; bf16_t* Wt_out; unsigned char* Wt_gu; unsigned char* Wt_dn;
    bf16_t* hxc; bf16_t* proj; bf16_t* mixin; bf16_t* y1; float* x1; f32x2* stat; unsigned* cntw; unsigned char* h2; unsigned char* act; unsigned char* ybuf;
};
#define LDS_WAIT() asm volatile("s_waitcnt lgkmcnt(0)" ::: "memory")
#define VM_WAIT() asm volatile("s_waitcnt vmcnt(0)" ::: "memory")

namespace pg8 {
constexpr int BM = 256, BK = 64, HALF = 128, HTB = HALF * BK * 2, STAGE_BYTES = 8 * HTB, NXCD = 8, WGM = 8, KD = 1024, NKT = KD / BK;
__device__ __forceinline__ int lds_byte(int r, int c) { const int st = (r >> 4) * 2 + (c >> 5), rr = r & 15, cc = c & 31, ob = rr * 64 + cc * 2; return st * 1024 + (ob ^ (((ob >> 9) & 1) << 5)); }
__device__ __forceinline__ void stage_rc(int b, int& R, int& C) { const int st = b / 1024, sb = b % 1024, swz = sb ^ (((sb >> 9) & 1) << 5); R = (st >> 1) * 16 + swz / 64; C = (st & 1) * 32 + (swz % 64) / 2; }
__device__ __forceinline__ int perm32(int rho) { const int n = rho >> 4, i = rho & 15; return 8 * (i >> 2) + 4 * n + (i & 3); }
struct Unit { int pm, pn, e, nvalid, ti; };
__device__ __forceinline__ void static_tile(int L, int nM, int nN, int& pm, int& pn) {
    const int nwg = nM * nN; int wgid = L;
    { const int q = nwg / NXCD, r = nwg % NXCD, xcd = wgid % NXCD, off = wgid / NXCD; wgid = (xcd < r ? xcd * (q + 1) : r * (q + 1) + (xcd - r) * q) + off; }
    const int nig = WGM * nN, gid = wgid / nig, fm = gid * WGM, gsz = (nM - fm) < WGM ? (nM - fm) : WGM;
    pm = fm + ((wgid % nig) % gsz); pn = (wgid % nig) / gsz;
}

typedef int v8i __attribute__((ext_vector_type(8)));
template <bool FP8> struct Frags;
template <> struct Frags<false> { bf16x8 At[4][2], B0[2][2], B1[2][2]; };
template <> struct Frags<true> { v8i At[4], B0[2], B1[2]; };
template <class P>
__device__ __forceinline__ void gemm_phase(LAS unsigned char* lds, const P& pol) {
    const int tid = threadIdx.x, wid = __builtin_amdgcn_readfirstlane(tid >> 6), lane = tid & 63, wr = wid >> 2, wc = wid & 3, fr = lane & 15, fq = lane >> 4;
    constexpr int KDB = P::FP8 ? 1024 : 2048, NKT_ = KDB / 128;
    unsigned voffB[2];
#pragma unroll
    for (int i = 0; i < 2; ++i) { int R, C; stage_rc(tid * 16 + i * 8192, R, C);
        int Rb = P::PERM ? ((R & ~31) + perm32(R & 31)) : R;
        if constexpr (P::BMAP16) { const int n = (R >> 4) & 1, q = R & 15; Rb = 64 * (R >> 5) + 16 * (q >> 2) + 4 * n + (q & 3); }
        voffB[i] = (unsigned)(Rb * KDB + C * 2); }
    const size_t kstep = (size_t)(BK * 2);
    const size_t hstep = (size_t)(P::BMAP16 ? 8 : HALF) * KDB;
    const unsigned ldsw = (unsigned)wid * 1024u;
    const int aoff = lds_byte(wr * 64 + fr, fq * 8), boff = lds_byte(wc * 32 + fr, fq * 8);
#define PG8_SA(b, h) (((b) * 2 + (h)) * HTB)
#define PG8_SB(b, h) ((4 + (b) * 2 + (h)) * HTB)
#define PG8_STAGE(bufoff, gbase, voff) do { _Pragma("unroll") for (int _i = 0; _i < 2; ++_i) \
        __builtin_amdgcn_global_load_lds((const unsigned*)((const char*)(gbase) + (voff)[_i]), (LAS unsigned*)(lds + (bufoff) + ldsw + _i * 8192), 16, 0, 0); } while (0)
#define PG8_RD8(p) __builtin_shufflevector(*(const LAS u32x4*)(p), *(const LAS u32x4*)((p) + 1024), 0, 1, 2, 3, 4, 5, 6, 7)
#define PG8_LDA(dst, b, h) do { if constexpr (P::FP8) { _Pragma("unroll") for (int m = 0; m < 4; ++m) fg.dst[m] = __builtin_bit_cast(v8i, PG8_RD8(lds + PG8_SA(b, h) + aoff + m * 2048)); } \
        else { _Pragma("unroll") for (int m = 0; m < 4; ++m) _Pragma("unroll") for (int k = 0; k < 2; ++k) fg.dst[m][k] = *(const LAS bf16x8*)(lds + PG8_SA(b, h) + aoff + m * 2048 + k * 1024); } } while (0)
#define PG8_LDB(dst, b, h) do { if constexpr (P::FP8) { _Pragma("unroll") for (int n = 0; n < 2; ++n) fg.dst[n] = __builtin_bit_cast(v8i, PG8_RD8(lds + PG8_SB(b, h) + boff + n * 2048)); } \
        else { _Pragma("unroll") for (int n = 0; n < 2; ++n) _Pragma("unroll") for (int k = 0; k < 2; ++k) fg.dst[n][k] = *(const LAS bf16x8*)(lds + PG8_SB(b, h) + boff + n * 2048 + k * 1024); } } while (0)
#define PG8_MMA(ai, bj, At, Bt) do { __builtin_amdgcn_s_setprio(1); \
        if constexpr (P::FP8) { _Pragma("unroll") for (int m = 0; m < 4; ++m) _Pragma("unroll") for (int n = 0; n < 2; ++n) \
            acc[ai][bj][m][n] = __builtin_amdgcn_mfma_scale_f32_16x16x128_f8f6f4(fg.Bt[n], fg.At[m], acc[ai][bj][m][n], 0, 0, 0, 0, 0, 0); } \
        else { _Pragma("unroll") for (int m = 0; m < 4; ++m) _Pragma("unroll") for (int n = 0; n < 2; ++n) _Pragma("unroll") for (int k = 0; k < 2; ++k) \
            acc[ai][bj][m][n] = __builtin_amdgcn_mfma_f32_16x16x32_bf16(fg.Bt[n][k], fg.At[m][k], acc[ai][bj][m][n], 0, 0, 0); } \
        __builtin_amdgcn_s_setprio(0); } while (0)
#define PG8_WAIT_V(n) asm volatile("s_waitcnt vmcnt(" #n ")" ::: "memory")
#define PG8_WAIT_L(n) asm volatile("s_waitcnt lgkmcnt(" #n ")" ::: "memory")
#define PG8_BAR __builtin_amdgcn_s_barrier()
#define PG8_SCHED __builtin_amdgcn_sched_barrier(0)
    Unit cur, nxt; int ui = 0;
    if (!pol.next(0, cur)) return;
    f32x4 acc[2][2][4][2];
#pragma unroll
    for (int a = 0; a < 2; ++a)
#pragma unroll
        for (int b = 0; b < 2; ++b)
#pragma unroll
            for (int m = 0; m < 4; ++m)
#pragma unroll
                for (int n = 0; n < 2; ++n) acc[a][b][m][n] = (f32x4){0.f, 0.f, 0.f, 0.f};
    Frags<P::FP8> fg;
    int slot = 0;
    if (P::META) { pol.meta_issue(cur, 0, lds, wid, lane); PG8_WAIT_V(0); asm volatile("" ::: "memory"); PG8_BAR; asm volatile("" ::: "memory"); }
    unsigned aC[2][2];
    pol.a_off(cur, 0, lds, aC);
    const char* const Ab = (const char*)pol.A;
    const char* cB = pol.b_ptr(cur);
    PG8_STAGE(PG8_SB(0, 0), cB, voffB); PG8_STAGE(PG8_SB(0, 1), cB + hstep, voffB); PG8_STAGE(PG8_SA(0, 0), Ab, aC[0]); PG8_STAGE(PG8_SA(0, 1), Ab, aC[1]);
    if (wr == 1) PG8_BAR;
    PG8_WAIT_V(2); PG8_BAR;
    PG8_STAGE(PG8_SB(1, 0), cB + kstep, voffB); PG8_STAGE(PG8_SA(1, 0), Ab + kstep, aC[0]); PG8_STAGE(PG8_SB(1, 1), cB + hstep + kstep, voffB);
    PG8_WAIT_V(6); PG8_BAR;
    for (;;) {
        const bool has_next = pol.next(ui + 1, nxt);
        const int nslot = slot == 2 ? 0 : slot + 1;
        if (P::META) { if (has_next) pol.meta_issue(nxt, nslot, lds, wid, lane); }
        const char* nB = has_next ? pol.b_ptr(nxt) : cB;
#pragma unroll 1
        for (int t = 0; t < NKT_; t += 2) {
            const bool last = (t == NKT_ - 2);
            const char* a1 = Ab + (size_t)(t + 1) * kstep;
            const char* a2 = last ? Ab : Ab + (size_t)(t + 2) * kstep; const char* b2 = last ? nB : cB + (size_t)(t + 2) * kstep;
            const char* a3 = a2 + kstep; const char* b3 = b2 + kstep;
            PG8_LDB(B0, 0, 0); PG8_LDB(B1, 0, 1); PG8_SCHED; PG8_LDA(At, 0, 0); PG8_STAGE(PG8_SA(1, 1), a1, aC[1]);
            if (last && has_next) pol.a_off(nxt, nslot, lds, aC);
            PG8_WAIT_V(8); PG8_WAIT_L(0); PG8_BAR; PG8_MMA(0, 0, At, B0); PG8_MMA(0, 1, At, B1); PG8_BAR; PG8_SCHED;
            PG8_LDA(At, 0, 1); PG8_STAGE(PG8_SB(0, 0), b2, voffB); PG8_STAGE(PG8_SB(0, 1), b2 + hstep, voffB); PG8_STAGE(PG8_SA(0, 0), a2, aC[0]);
            PG8_WAIT_V(8); PG8_WAIT_L(0); PG8_BAR; PG8_MMA(1, 0, At, B0); PG8_MMA(1, 1, At, B1); PG8_BAR; PG8_SCHED;
            PG8_LDB(B0, 1, 0); PG8_LDB(B1, 1, 1); PG8_SCHED; PG8_LDA(At, 1, 0); PG8_STAGE(PG8_SA(0, 1), a2, aC[1]);
            PG8_WAIT_V(8); PG8_WAIT_L(0); PG8_BAR; PG8_MMA(0, 0, At, B0); PG8_MMA(0, 1, At, B1); PG8_BAR; PG8_SCHED;
            PG8_LDA(At, 1, 1); PG8_STAGE(PG8_SB(1, 0), b3, voffB); PG8_STAGE(PG8_SB(1, 1), b3 + hstep, voffB); PG8_STAGE(PG8_SA(1, 0), a3, aC[0]);
            PG8_WAIT_V(8); PG8_WAIT_L(0); PG8_BAR; PG8_MMA(1, 0, At, B0); PG8_MMA(1, 1, At, B1); PG8_BAR; PG8_SCHED;
        }
        if (wr == 0) PG8_BAR;
#ifdef PROBE_KLOOP2
        const bool do_epi = !(P::FP8 && P::KIND == PROBE_KLOOP2) || (ui & 1);
        if (do_epi) {
            if (P::FP8 && P::KIND == PROBE_KLOOP2) {
#pragma unroll
                for (int a = 0; a < 2; ++a)
#pragma unroll
                    for (int b = 0; b < 2; ++b)
#pragma unroll
                        for (int m = 0; m < 4; ++m)
#pragma unroll
                            for (int n = 0; n < 2; ++n) acc[a][b][m][n] *= 0.5f; }
            pol.epi(acc, cur, slot, lds, wr, wc, fr, fq); }
#else
        constexpr bool do_epi = true;
        pol.epi(acc, cur, slot, lds, wr, wc, fr, fq);
#endif
#ifdef PROBE_EPI2
        if (P::KIND == PROBE_EPI2) { asm volatile("" ::: "memory");
#pragma unroll
            for (int a = 0; a < 2; ++a)
#pragma unroll
                for (int b = 0; b < 2; ++b)
#pragma unroll
                    for (int m = 0; m < 4; ++m)
#pragma unroll
                        for (int n = 0; n < 2; ++n) asm volatile("" : "+v"(acc[a][b][m][n]));
            pol.epi(acc, cur, slot, lds, wr, wc, fr, fq); }
#endif
        if (!has_next) break;
        if (do_epi) {
#pragma unroll
        for (int a = 0; a < 2; ++a)
#pragma unroll
            for (int b = 0; b < 2; ++b)
#pragma unroll
                for (int m = 0; m < 4; ++m)
#pragma unroll
                    for (int n = 0; n < 2; ++n) acc[a][b][m][n] = (f32x4){0.f, 0.f, 0.f, 0.f};
        }
        cur = nxt; cB = nB; ++ui; slot = nslot;
        if (wr == 1) PG8_BAR;
    }
    PG8_WAIT_V(0);
    PG8_BAR;
#undef PG8_SA
#undef PG8_SB
#undef PG8_STAGE
#undef PG8_LDA
#undef PG8_LDB
#undef PG8_MMA
#undef PG8_RD8
#undef PG8_WAIT_V
#undef PG8_WAIT_L
#undef PG8_BAR
#undef PG8_SCHED
}
}

typedef f32x4 AccT[2][2][4][2];

struct PolProj {
    static constexpr bool BMAP16 = false; static constexpr int KIND = 0; static constexpr bool PERM = true, META = false, FP8 = false; static constexpr int SCALE_W = 0x7f7f7f7f;
    const bf16_t* A; const bf16_t* Bt; bf16_t* O; int G, c;
    __device__ __forceinline__ bool next(int i, pg8::Unit& u) const {
        const int L = i * G + c;
        if (L < 640) { pg8::static_tile(L, 64, 10, u.pm, u.pn); return true; }
        if (L < 648) { const int j = L - 640; u.pm = 64 + (j >> 2); u.pn = 2 + (j & 3); return true; }
        return false;
    }
    __device__ __forceinline__ const char* b_ptr(const pg8::Unit& u) const { return (const char*)Bt + (size_t)u.pn * 256 * 1024 * 2; }
    __device__ __forceinline__ void meta_issue(const pg8::Unit&, int, LAS unsigned char*, int, int) const {}
    __device__ __forceinline__ void a_off(const pg8::Unit& u, int, LAS unsigned char*, unsigned (&o)[2][2]) const {
        int Ra[2], Ca[2]; pg8::stage_rc((int)threadIdx.x * 16, Ra[0], Ca[0]); pg8::stage_rc((int)threadIdx.x * 16 + 8192, Ra[1], Ca[1]);
#pragma unroll
        for (int h = 0; h < 2; ++h)
#pragma unroll
            for (int i = 0; i < 2; ++i) o[h][i] = (unsigned)((u.pm * 256 + 128 * h + Ra[i]) * 1024 + Ca[i]) * 2u;
    }
    __device__ __forceinline__ void epi(const AccT& acc, const pg8::Unit& u, int, LAS unsigned char*, int wr, int wc, int fr, int fq) const {
        const int row0 = u.pm * 256 + wr * 64 + fr, col0 = u.pn * 256 + wc * 32 + 8 * fq;
        const bool act = u.pn >= 6;
#pragma unroll
        for (int ai = 0; ai < 2; ++ai)
#pragma unroll
            for (int m = 0; m < 4; ++m) { bf16_t* rowp = O + (size_t)(row0 + ai * 128 + m * 16) * DIN + col0;
#pragma unroll
                for (int bj = 0; bj < 2; ++bj) { f32x4 v0 = acc[ai][bj][m][0], v1 = acc[ai][bj][m][1];
                    if (act) {
#pragma unroll
                        for (int j = 0; j < 4; ++j) { v0[j] = gelu_fast(v0[j]); v1[j] = gelu_fast(v1[j]); } }
                    u32x4 w; w.x = cvt_pk_bf16(v0[0], v0[1]); w.y = cvt_pk_bf16(v0[2], v0[3]); w.z = cvt_pk_bf16(v1[0], v1[1]); w.w = cvt_pk_bf16(v1[2], v1[3]);
                    store16_sc1(rowp + bj * 128, w); } }
    }
};

struct PolOut {
    static constexpr bool BMAP16 = false; static constexpr int KIND = 0; static constexpr bool PERM = true, META = false, FP8 = false; static constexpr int SCALE_W = 0x7f7f7f7f;
    const bf16_t* A; const bf16_t* Bt; const float* x; const float* mod; bf16_t* Y; int G, c;
    __device__ __forceinline__ bool next(int i, pg8::Unit& u) const { const int L = i * G + c; if (L >= 256) return false; pg8::static_tile(L, 64, 4, u.pm, u.pn); return true; }
    __device__ __forceinline__ const char* b_ptr(const pg8::Unit& u) const { return (const char*)Bt + (size_t)u.pn * 256 * 1024 * 2; }
    __device__ __forceinline__ void meta_issue(const pg8::Unit&, int, LAS unsigned char*, int, int) const {}
    __device__ __forceinline__ void a_off(const pg8::Unit& u, int, LAS unsigned char*, unsigned (&o)[2][2]) const {
        int Ra[2], Ca[2]; pg8::stage_rc((int)threadIdx.x * 16, Ra[0], Ca[0]); pg8::stage_rc((int)threadIdx.x * 16 + 8192, Ra[1], Ca[1]);
#pragma unroll
        for (int h = 0; h < 2; ++h)
#pragma unroll
            for (int i = 0; i < 2; ++i) o[h][i] = (unsigned)((u.pm * 256 + 128 * h + Ra[i]) * 1024 + Ca[i]) * 2u;
    }
    __device__ __forceinline__ void epi(const AccT& acc, const pg8::Unit& u, int, LAS unsigned char*, int wr, int wc, int fr, int fq) const {
        const int row0 = u.pm * 256 + wr * 64 + fr, col0 = u.pn * 256 + wc * 32 + 8 * fq;
        const float* g1 = mod + (u.pm >= 32 ? 6144 : 0) + 2 * 1024;
        f32x4 gv[2][2];
#pragma unroll
        for (int bj = 0; bj < 2; ++bj)
#pragma unroll
            for (int n = 0; n < 2; ++n) gv[bj][n] = *(const f32x4*)(g1 + col0 + bj * 128 + 4 * n);
#pragma unroll
        for (int ai = 0; ai < 2; ++ai)
#pragma unroll
            for (int m = 0; m < 4; ++m) { const size_t off = (size_t)(row0 + ai * 128 + m * 16) * D + col0;
#pragma unroll
                for (int bj = 0; bj < 2; ++bj) { const f32x4 x0 = __builtin_nontemporal_load((const f32x4*)(x + off + bj * 128)), x1v = __builtin_nontemporal_load((const f32x4*)(x + off + bj * 128 + 4));
                    const f32x4 v0 = x0 * DN_ALPHA + gv[bj][0] * acc[ai][bj][m][0], v1 = x1v * DN_ALPHA + gv[bj][1] * acc[ai][bj][m][1];
                    u32x4 w; w.x = cvt_pk_bf16(v0[0], v0[1]); w.y = cvt_pk_bf16(v0[2], v0[3]); w.z = cvt_pk_bf16(v1[0], v1[1]); w.w = cvt_pk_bf16(v1[2], v1[3]);
                    *(u32x4*)(Y + off + bj * 128) = w; }
                asm volatile("" ::: "memory"); }
    }
};

struct ExpTab { const LAS int* tile_e; const LAS int* tstart; const LAS int* cnt; int T; };
__device__ __forceinline__ int expert_tables(Frame& F) {
    LAS int* tile_e = (LAS int*)(F.lds + L_TILEE); LAS int* tstart = (LAS int*)(F.lds + L_TSTART); LAS int* cn = tstart + 64;
    if (F.tid < 32) cn[F.tid] = (int)__hip_atomic_load(F.ctl + CW_CNT + 32 * F.tid, __ATOMIC_RELAXED, __HIP_MEMORY_SCOPE_AGENT);
    __syncthreads();
    if (F.tid == 0) { int run = 0; for (int e = 0; e < NE; ++e) { tstart[e] = run; run += (cn[e] + 255) >> 8; } tstart[NE] = run; }
    __syncthreads();
    const int T = tstart[NE];
    if (F.tid < MAXT && F.tid < T) { int e = 0; while (e < NE - 1 && tstart[e + 1] <= F.tid) ++e; tile_e[F.tid] = e; }
    __syncthreads();
    return T < MAXT ? T : MAXT;
}
__device__ __forceinline__ int rfl(int v) { return __builtin_amdgcn_readfirstlane(v); }

struct PolGU {
    static constexpr bool BMAP16 = false; static constexpr int KIND = 1; static constexpr bool PERM = true, META = true, FP8 = true; static constexpr int SCALE_W = 0; static constexpr float WSC = 1.f / 64.f;
    const unsigned char* A; const unsigned char* Bt; const float* bias; const int* list; unsigned char* O; ExpTab tb; int G, c;
    __device__ __forceinline__ bool next(int i, pg8::Unit& u) const {
#if defined(PROBE_KLOOP2) && PROBE_KLOOP2 == 1
        const int L = (i >> 1) * G + c; if (L >= tb.T * 8) return false;
#else
        const int L = i * G + c; if (L >= tb.T * 8) return false;
#endif
        u.ti = L >> 3; u.pn = L & 7; u.e = rfl(tb.tile_e[u.ti]); u.pm = u.ti - rfl(tb.tstart[u.e]);
        const int rem = rfl(tb.cnt[u.e]) - u.pm * 256; u.nvalid = rem < 256 ? rem : 256; return true;
    }
    __device__ __forceinline__ const char* b_ptr(const pg8::Unit& u) const { return (const char*)Bt + ((size_t)u.e * 2048 + (size_t)u.pn * 256) * 1024; }
    __device__ __forceinline__ void meta_issue(const pg8::Unit& u, int slot, LAS unsigned char* lds, int wid, int lane) const {
        if (wid < 4) __builtin_amdgcn_global_load_lds((const unsigned*)(list + (size_t)u.e * LCAP + u.pm * 256 + wid * 64 + lane), (LAS unsigned*)(lds + L_IDX + slot * 2048 + wid * 256), 4, 0, 0);
    }
    __device__ __forceinline__ void a_off(const pg8::Unit& u, int slot, LAS unsigned char* lds, unsigned (&o)[2][2]) const {
        int Ra[2], Ca[2]; pg8::stage_rc((int)threadIdx.x * 16, Ra[0], Ca[0]); pg8::stage_rc((int)threadIdx.x * 16 + 8192, Ra[1], Ca[1]);
        const LAS int* idx = (const LAS int*)(lds + L_IDX + slot * 2048);
#pragma unroll
        for (int h = 0; h < 2; ++h)
#pragma unroll
            for (int i = 0; i < 2; ++i) { const int r = 128 * h + Ra[i]; int pr = idx[r]; pr = r < u.nvalid ? pr : 0; o[h][i] = (unsigned)((pr >> 2) * 1024 + Ca[i] * 2); }
    }
    __device__ __forceinline__ void epi(const AccT& acc, const pg8::Unit& u, int, LAS unsigned char*, int wr, int wc, int fr, int fq) const {
        const int row0 = u.ti * 256 + wr * 64 + fr, col0 = u.pn * 128 + wc * 32 + 8 * fq;
        const float* bg = bias + (size_t)u.e * 2048 + col0;
        const f32x4 g0 = *(const f32x4*)(bg), g1 = *(const f32x4*)(bg + 4), l0 = *(const f32x4*)(bg + 1024) + 1.f, l1 = *(const f32x4*)(bg + 1028) + 1.f;
#pragma unroll
        for (int ai = 0; ai < 2; ++ai)
#pragma unroll
            for (int m = 0; m < 4; ++m) {
                f32x4 r0, r1;
#pragma unroll
                for (int hp = 0; hp < 2; ++hp) {
                    const f32x2 ga0 = (f32x2){acc[ai][0][m][0][2 * hp], acc[ai][0][m][0][2 * hp + 1]} * WSC + (f32x2){g0[2 * hp], g0[2 * hp + 1]};
                    const f32x2 ga1 = (f32x2){acc[ai][0][m][1][2 * hp], acc[ai][0][m][1][2 * hp + 1]} * WSC + (f32x2){g1[2 * hp], g1[2 * hp + 1]};
                    const f32x2 lb0 = (f32x2){acc[ai][1][m][0][2 * hp], acc[ai][1][m][0][2 * hp + 1]} * WSC + (f32x2){l0[2 * hp], l0[2 * hp + 1]};
                    const f32x2 lb1 = (f32x2){acc[ai][1][m][1][2 * hp], acc[ai][1][m][1][2 * hp + 1]} * WSC + (f32x2){l1[2 * hp], l1[2 * hp + 1]};
                    f32x2 gg0, gg1, ll0, ll1, e0, e1;
                    gg0[0] = fminf(ga0[0], 7.f); gg0[1] = fminf(ga0[1], 7.f); gg1[0] = fminf(ga1[0], 7.f); gg1[1] = fminf(ga1[1], 7.f);
                    ll0[0] = __builtin_amdgcn_fmed3f(lb0[0], -6.f, 8.f); ll0[1] = __builtin_amdgcn_fmed3f(lb0[1], -6.f, 8.f); ll1[0] = __builtin_amdgcn_fmed3f(lb1[0], -6.f, 8.f); ll1[1] = __builtin_amdgcn_fmed3f(lb1[1], -6.f, 8.f);
                    const f32x2 x0 = gg0 * -2.45546696f, x1 = gg1 * -2.45546696f;
                    e0[0] = __builtin_amdgcn_exp2f(x0[0]); e0[1] = __builtin_amdgcn_exp2f(x0[1]); e1[0] = __builtin_amdgcn_exp2f(x1[0]); e1[1] = __builtin_amdgcn_exp2f(x1[1]);
                    const f32x2 d0 = e0 + 1.f, d1 = e1 + 1.f;
                    f32x2 q0, q1; q0[0] = __builtin_amdgcn_rcpf(d0[0]); q0[1] = __builtin_amdgcn_rcpf(d0[1]); q1[0] = __builtin_amdgcn_rcpf(d1[0]); q1[1] = __builtin_amdgcn_rcpf(d1[1]);
                    const f32x2 o0 = (ll0 * gg0) * q0, o1 = (ll1 * gg1) * q1;
                    r0[2 * hp] = o0[0]; r0[2 * hp + 1] = o0[1]; r1[2 * hp] = o1[0]; r1[2 * hp + 1] = o1[1];
                }
                u32x2 w; w.x = (unsigned)__builtin_amdgcn_cvt_pk_fp8_f32(r0[2], r0[3], __builtin_amdgcn_cvt_pk_fp8_f32(r0[0], r0[1], 0, false), true);
                w.y = (unsigned)__builtin_amdgcn_cvt_pk_fp8_f32(r1[2], r1[3], __builtin_amdgcn_cvt_pk_fp8_f32(r1[0], r1[1], 0, false), true);
                *(u32x2*)(O + (size_t)(row0 + ai * 128 + m * 16) * DFF + col0) = w; }
    }
};

struct PolDN {
    static constexpr float YSC = 16.f; static constexpr bool BMAP16 = true; static constexpr int KIND = 2; static constexpr bool PERM = true, META = true, FP8 = true; static constexpr int SCALE_W = 0; static constexpr float WSC = 1.f / 64.f;
    const unsigned char* A; const unsigned char* Bt; const float* bias; const int* list; const float* listg; unsigned char* O; ExpTab tb; int G, c;
    __device__ __forceinline__ bool next(int i, pg8::Unit& u) const {
#if defined(PROBE_KLOOP2) && PROBE_KLOOP2 == 2
        const int L = (i >> 1) * G + c; if (L >= tb.T * 4) return false;
#else
        const int L = i * G + c; if (L >= tb.T * 4) return false;
#endif
        u.ti = L >> 2; u.pn = L & 3; u.e = rfl(tb.tile_e[u.ti]); u.pm = u.ti - rfl(tb.tstart[u.e]);
        const int rem = rfl(tb.cnt[u.e]) - u.pm * 256; u.nvalid = rem < 256 ? rem : 256; return true;
    }
    __device__ __forceinline__ const char* b_ptr(const pg8::Unit& u) const { return (const char*)Bt + ((size_t)u.e * 1024 + (size_t)u.pn * 256) * 1024; }
    __device__ __forceinline__ void meta_issue(const pg8::Unit& u, int slot, LAS unsigned char* lds, int wid, int lane) const {
        if (wid < 4) __builtin_amdgcn_global_load_lds((const unsigned*)(list + (size_t)u.e * LCAP + u.pm * 256 + wid * 64 + lane), (LAS unsigned*)(lds + L_IDX + slot * 2048 + wid * 256), 4, 0, 0);
        else __builtin_amdgcn_global_load_lds((const unsigned*)(listg + (size_t)u.e * LCAP + u.pm * 256 + (wid - 4) * 64 + lane), (LAS unsigned*)(lds + L_IDX + slot * 2048 + 1024 + (wid - 4) * 256), 4, 0, 0);
    }
    __device__ __forceinline__ void a_off(const pg8::Unit& u, int, LAS unsigned char*, unsigned (&o)[2][2]) const {
        int Ra[2], Ca[2]; pg8::stage_rc((int)threadIdx.x * 16, Ra[0], Ca[0]); pg8::stage_rc((int)threadIdx.x * 16 + 8192, Ra[1], Ca[1]);
#pragma unroll
        for (int h = 0; h < 2; ++h)
#pragma unroll
            for (int i = 0; i < 2; ++i) o[h][i] = (unsigned)((u.ti * 256 + 128 * h + Ra[i]) * 1024 + Ca[i] * 2);
    }
    __device__ __forceinline__ void epi(const AccT& acc, const pg8::Unit& u, int slot, LAS unsigned char* lds, int wr, int wc, int fr, int fq) const {
        const LAS int* idx = (const LAS int*)(lds + L_IDX + slot * 2048);
        const int col0 = u.pn * 256 + wc * 64 + 16 * fq;
        const float* bd = bias + (size_t)u.e * 1024 + col0;
        f32x4 bv[2][2];
#pragma unroll
        for (int bj = 0; bj < 2; ++bj)
#pragma unroll
            for (int n = 0; n < 2; ++n) bv[bj][n] = *(const f32x4*)(bd + 8 * bj + 4 * n);
#pragma unroll
        for (int ai = 0; ai < 2; ++ai)
#pragma unroll
            for (int m = 0; m < 4; ++m) { const int r = ai * 128 + wr * 64 + m * 16 + fr;
                if (r < u.nvalid) { const int pr = idx[r]; const float gt = ((const LAS float*)idx)[256 + r] * YSC;
                    u32x4 w;
#pragma unroll
                    for (int bj = 0; bj < 2; ++bj) { const f32x4 v0 = (acc[ai][bj][m][0] * WSC + bv[bj][0]) * gt, v1 = (acc[ai][bj][m][1] * WSC + bv[bj][1]) * gt;
                        w[2 * bj] = pk4_fp8(v0[0], v0[1], v0[2], v0[3]); w[2 * bj + 1] = pk4_fp8(v1[0], v1[1], v1[2], v1[3]); }
                    __builtin_nontemporal_store(w, (u32x4*)(O + (size_t)pr * D + col0)); } }
    }
};

__device__ __forceinline__ void p_ada(Frame& F) {
    LAS float* sl = (LAS float*)F.lds;
    LAS float* red = sl + 3072;
    for (int i = F.tid; i < 3072; i += 512) { const int w = i >> 10, k = i & 1023; const float v = w < 2 ? F.c[w * D + k] : F.c_ctx[k]; sl[i] = v / (1.f + __expf(-v)); }
    __syncthreads();
    for (int slab = blockIdx.x; slab < 256; slab += F.G) {
        const int j0 = slab * 24, cg = F.tid % 6, kr = F.tid / 6;
        float a[3][4] = {};
        if (F.tid < 480) {
            for (int k = kr; k < D; k += 80) {
                const f32x4 w4 = __builtin_nontemporal_load((const f32x4*)(F.ada_w + (size_t)k * 6144 + j0 + 4 * cg));
                const float s0 = sl[k], s1 = sl[1024 + k], s2 = sl[2048 + k];
#pragma unroll
                for (int q = 0; q < 4; ++q) { a[0][q] += s0 * w4[q]; a[1][q] += s1 * w4[q]; a[2][q] += s2 * w4[q]; }
            }
#pragma unroll
            for (int w = 0; w < 3; ++w)
#pragma unroll
                for (int q = 0; q < 4; ++q) red[kr * 72 + cg * 12 + w * 4 + q] = a[w][q];
        }
        __syncthreads();
        if (F.tid < 72) {
            float s = 0.f;
            for (int r = 0; r < 80; ++r) s += red[r * 72 + F.tid];
            const int g = F.tid / 12, w = (F.tid % 12) >> 2, q = F.tid & 3, col = j0 + 4 * g + q;
            F.mod[w * 6144 + col] = s + F.ada_b[col];
        }
        __syncthreads();
    }
}

__device__ __forceinline__ void transpose_item(const float* W, int K, int N, bf16_t* WT, int item, bool gu_map, LAS float* scr, int lane) {
    const int nblk = N / 32, kb = item / nblk, nb = item % nblk, k0 = 64 * kb, n0 = 32 * nb;
#pragma unroll 8
    for (int i = 0; i < 32; ++i) { const int kk = 2 * i + (lane >> 5); scr[kk * 33 + (lane & 31)] = __builtin_nontemporal_load(W + (size_t)(k0 + kk) * N + n0 + (lane & 31)); }
    LDS_WAIT(); asm volatile("" ::: "memory");
    int d0 = n0;
    if (gu_map) { const int nn = n0 & 1023; d0 = (nn >> 7) * 256 + (nn & 127) + ((n0 >> 10) ? 128 : 0); }
    const int c = lane & 7;
#pragma unroll
    for (int j = 0; j < 4; ++j) { const int n = (lane >> 3) + 8 * j; const LAS float* s = scr + (8 * c) * 33 + n;
        u32x4 o; o.x = pk2(s[0 * 33], s[1 * 33]); o.y = pk2(s[2 * 33], s[3 * 33]); o.z = pk2(s[4 * 33], s[5 * 33]); o.w = pk2(s[6 * 33], s[7 * 33]);
        *(u32x4*)(WT + (size_t)(d0 + n) * K + k0 + 8 * c) = o; }
    LDS_WAIT(); asm volatile("" ::: "memory");
}
__device__ __forceinline__ void transpose_item8(const float* W, int K, int N, unsigned char* WT, int item, bool gu_map, LAS float* scr, int lane) {
    const int nblk = N / 32, kb = item / nblk, nb = item % nblk, k0 = 64 * kb, n0 = 32 * nb;
#pragma unroll 8
    for (int i = 0; i < 32; ++i) { const int kk = 2 * i + (lane >> 5); scr[kk * 33 + (lane & 31)] = __builtin_nontemporal_load(W + (size_t)(k0 + kk) * N + n0 + (lane & 31)); }
    LDS_WAIT(); asm volatile("" ::: "memory");
    int d0 = n0;
    if (gu_map) { const int nn = n0 & 1023; d0 = (nn >> 7) * 256 + (nn & 127) + ((n0 >> 10) ? 128 : 0); }
    const int c = lane & 7;
#pragma unroll
    for (int j = 0; j < 4; ++j) { const int n = (lane >> 3) + 8 * j; const LAS float* s = scr + (8 * c) * 33 + n;
        u32x2 o; o.x = pk4_fp8(s[0 * 33] * 64.f, s[1 * 33] * 64.f, s[2 * 33] * 64.f, s[3 * 33] * 64.f); o.y = pk4_fp8(s[4 * 33] * 64.f, s[5 * 33] * 64.f, s[6 * 33] * 64.f, s[7 * 33] * 64.f);
        __builtin_nontemporal_store(o, (u32x2*)(WT + (size_t)(d0 + n) * K + k0 + 8 * c)); }
    LDS_WAIT(); asm volatile("" ::: "memory");
}
__device__ __forceinline__ void p_weights(Frame& F, int it_lo, int n_items, int gw, int NGW, bool with_sgu) {
    LAS float* scr = (LAS float*)(F.lds + F.wave * 16384);
    constexpr int I_IN = 16 * 80, I_OUT = 16 * 32, I_GU = 16 * 64, I_DN = 16 * 32;
    constexpr int NITEMS = I_IN + I_OUT + NE * I_GU + NE * I_DN;
    for (int it0 = gw; it0 < n_items; it0 += NGW) {
        const int it = it_lo + it0; int r = it;
        if (r < I_IN) { transpose_item(F.w_in, D, DIN, F.Wt_in, r, false, scr, F.lane); continue; } r -= I_IN;
        if (r < I_OUT) { transpose_item(F.w_out, D, D, F.Wt_out, r, false, scr, F.lane); continue; } r -= I_OUT;
        if (r < NE * I_GU) { const int e = r / I_GU; transpose_item8(F.w_gu + (size_t)e * D * 2048, D, 2048, F.Wt_gu + (size_t)e * 2048 * D, r % I_GU, true, scr, F.lane); continue; } r -= NE * I_GU;
        { const int e = r / I_DN; transpose_item8(F.w_dn + (size_t)e * DFF * D, DFF, D, F.Wt_dn + (size_t)e * D * DFF, r % I_DN, false, scr, F.lane); }
    }
    if (with_sgu) for (int i = (blockIdx.x * 512 + F.tid) * 4; i < 4 * 128 * 128; i += F.G * 512 * 4) {
        const f32x4 v = *(const f32x4*)(F.sgu_w + i); u32x2 o; o.x = pk2(v[0], v[1]); o.y = pk2(v[2], v[3]); *(u32x2*)(F.sguw + i) = o; }
}
__device__ __forceinline__ void p_lnmod(Frame& F) {
    const int gw = F.vcu * 8 + F.wave, NGW = F.G * 8;
    for (int row = gw; row < MX; row += NGW) {
        const float* xr; const float* md;
        if (row < M) { xr = F.x + (size_t)row * D; md = F.mod + (row >> 13) * 6144; } else { xr = F.ctx + (size_t)(row - M) * D; md = F.mod + 2 * 6144; }
        const f32x4* xp = (const f32x4*)xr + F.lane;
        f32x4 v[4]; float s = 0.f;
#pragma unroll
        for (int j = 0; j < 4; ++j) { v[j] = __builtin_nontemporal_load(xp + 64 * j); s += (v[j][0] + v[j][1]) + (v[j][2] + v[j][3]); }
        const float mean = wsum(s) * (1.f / D); float q = 0.f;
#pragma unroll
        for (int j = 0; j < 4; ++j) { v[j] = v[j] - mean; q += (v[j][0] * v[j][0] + v[j][1] * v[j][1]) + (v[j][2] * v[j][2] + v[j][3] * v[j][3]); }
        const float rstd = rsqrtf(wsum(q) * (1.f / D) + EPS);
        u32x2* op = (u32x2*)(F.hxc + (size_t)row * D) + F.lane;
#pragma unroll
        for (int j = 0; j < 4; ++j) { const f32x4 sh = *((const f32x4*)md + F.lane + 64 * j), sc = *((const f32x4*)(md + 1024) + F.lane + 64 * j);
            const f32x4 o = v[j] * rstd * (sc + 1.f) + sh; u32x2 w; w.x = pk2(o[0], o[1]); w.y = pk2(o[2], o[3]); op[64 * j] = w; }
    }
}

__device__ __forceinline__ void p_attn_simple(Frame& F) {
    LAS float* sq = (LAS float*)(F.lds + F.wave * 4096);
    LAS float* sp = sq + 64;
    const int gw = F.vcu * 8 + F.wave, NGW = F.G * 8;
    for (int gid = gw; gid < M * NH; gid += NGW) {
        const int h = gid & 7, tok = gid >> 3, b = tok >> 13, t = tok & (S - 1), r = t >> 6, c = t & 63;
        const int rs = min(max(r - KH / 2, 0), ROWS - KH), cs = min(max(c - KW / 2, 0), GW - KW);
        sq[F.lane] = bf2f(F.proj[(size_t)tok * DIN + h * 64 + F.lane]);
        LDS_WAIT(); asm volatile("" ::: "memory");
        float sc[6]; float mx = -1e30f;
#pragma unroll
        for (int i = 0; i < 6; ++i) {
            const int kk = F.lane + 64 * i;
            const bf16_t* kp; float bias = 0.f;
            if (kk < 128) { const int ki = kk >> 4, kj = kk & 15;
                kp = F.proj + (size_t)(b * S + (rs + ki) * GW + cs + kj) * DIN + 512 + h * 64;
                bias = F.rpb[(h * 15 + (rs + ki - r + 7)) * 31 + (cs + kj - c + 15)];
            } else kp = F.proj + (size_t)(M + b * CTX + (kk - 128)) * DIN + 512 + h * 64;
            float d = 0.f;
#pragma unroll
            for (int dd = 0; dd < 64; dd += 8) { const u32x4 kv = *(const u32x4*)(kp + dd);
                d += sq[dd] * bflo(kv.x) + sq[dd + 1] * bfhi(kv.x) + sq[dd + 2] * bflo(kv.y) + sq[dd + 3] * bfhi(kv.y) + sq[dd + 4] * bflo(kv.z) + sq[dd + 5] * bfhi(kv.z) + sq[dd + 6] * bflo(kv.w) + sq[dd + 7] * bfhi(kv.w); }
            sc[i] = d * 0.125f + bias; mx = fmaxf(mx, sc[i]);
        }
        mx = wmax(mx);
        float sum = 0.f;
#pragma unroll
        for (int i = 0; i < 6; ++i) { const float p = __expf(sc[i] - mx); sum += p; sp[F.lane + 64 * i] = p; }
        sum = wsum(sum);
        LDS_WAIT(); asm volatile("" ::: "memory");
        float acc = 0.f;
        for (int kk = 0; kk < 384; ++kk) {
            const bf16_t* vp;
            if (kk < 128) { const int ki = kk >> 4, kj = kk & 15; vp = F.proj + (size_t)(b * S + (rs + ki) * GW + cs + kj) * DIN + 1024 + h * 64; }
            else vp = F.proj + (size_t)(M + b * CTX + (kk - 128)) * DIN + 1024 + h * 64;
            acc += sp[kk] * bf2f(vp[F.lane]);
        }
        F.mixin[(size_t)tok * D + h * 64 + F.lane] = (bf16_t)f2bf(acc / sum);
        LDS_WAIT(); asm volatile("" ::: "memory");
    }
}
__device__ __forceinline__ void p_sgu_simple(Frame& F) {
    LAS bf16_t* G = (LAS bf16_t*)F.lds;
    for (int u = blockIdx.x; u < M / 128; u += F.G) {
        const int base = u * 128;
        for (int tl = F.wave; tl < 128; tl += 8) {
            const bf16_t* zr = F.proj + (size_t)(base + tl) * DIN + 2048 + F.lane * 8;
            const u32x4 zv = *(const u32x4*)zr;
            float v[8] = {bflo(zv.x), bfhi(zv.x), bflo(zv.y), bfhi(zv.y), bflo(zv.z), bfhi(zv.z), bflo(zv.w), bfhi(zv.w)};
            float s = 0.f;
#pragma unroll
            for (int i = 0; i < 8; ++i) s += v[i];
            const float mean = wsum(s) * (1.f / 512.f); float q = 0.f;
#pragma unroll
            for (int i = 0; i < 8; ++i) { v[i] -= mean; q += v[i] * v[i]; }
            const float rstd = rsqrtf(wsum(q) * (1.f / 512.f) + EPS);
#pragma unroll
            for (int i = 0; i < 8; ++i) { const int ch = F.lane * 8 + i; G[tl * 512 + ch] = (bf16_t)f2bf(v[i] * rstd * F.sgu_ln_g[ch] + F.sgu_ln_b[ch]); }
        }
        __syncthreads();
        const int ch = F.tid, grp = ch >> 7;
        for (int i = 0; i < 128; ++i) {
            const float* wrow = F.sgu_w + (size_t)(grp * 128 + i) * 128;
            float acc = 0.f;
            for (int j = 0; j < 128; ++j) acc += wrow[j] * bf2f(G[j * 512 + ch]);
            acc += F.sgu_b[grp * 128 + i];
            const float uu = bf2f(F.proj[(size_t)(base + i) * DIN + 1536 + ch]);
            F.mixin[(size_t)(base + i) * D + 512 + ch] = (bf16_t)f2bf(uu * acc);
        }
        __syncthreads();
    }
}

namespace at {
typedef float f32x16 __attribute__((ext_vector_type(16)));
typedef short s16x4 __attribute__((ext_vector_type(4)));
typedef short v4i16_t __attribute__((ext_vector_type(4)));
constexpr int A_K = 0, A_V = 32768, A_STG = 65536, A_WSF = 98304, A_RPB = 100352;
constexpr float C2 = 0.125f * 1.4426950408889634f, L2E = 1.4426950408889634f;
__device__ __forceinline__ int crow(int r, int hi) { return (r & 3) + 8 * (r >> 2) + 4 * hi; }
__device__ __forceinline__ s16x4 vtr(const LAS unsigned char* p) { return __builtin_bit_cast(s16x4, __builtin_amdgcn_ds_read_tr16_b64_v4i16((LAS v4i16_t*)p)); }
__device__ __forceinline__ int rsf(int r) { return min(max(r - KH / 2, 0), ROWS - KH); }
#define AT_WAIT_BAR() asm volatile("s_waitcnt vmcnt(0) lgkmcnt(0)\n\ts_barrier" ::: "memory")
__device__ __forceinline__ void glds16(const void* gsrc, unsigned lds_dst) { unsigned keep;
    asm volatile("s_mov_b32 %0, m0\n\ts_mov_b32 m0, %2\n\ts_nop 0\n\tglobal_load_lds_dwordx4 %1, off\n\ts_mov_b32 m0, %0" : "=&s"(keep) : "v"(gsrc), "s"(lds_dst) : "memory"); }

template <int MODE> __device__ __forceinline__ constexpr bool act0(int rr) { return MODE != 2 || rr >= 12; }
template <int MODE> __device__ __forceinline__ constexpr bool act1(int rr) { return MODE != 1 || rr < 4; }
template <int MODE>
__device__ __forceinline__ void tile_compute(const LAS unsigned char* kp0, const LAS unsigned char* vp, const LAS float* tb, const bf16x8 (&qr)[4], f32x16 (&o)[2], float& m, float& l,
                                             LAS float* wsf, int r32, int hi, int cs) {
    f32x16 p0, p1;
#pragma unroll
    for (int i = 0; i < 16; ++i) { p0[i] = 0.f; p1[i] = 0.f; }
#pragma unroll
    for (int d0 = 0; d0 < 4; ++d0) {
        const bf16x8 b0 = *(const LAS bf16x8*)(kp0 + d0 * 2048), b1 = *(const LAS bf16x8*)(kp0 + d0 * 2048 + 512);
        p0 = __builtin_amdgcn_mfma_f32_32x32x16_bf16(b0, qr[d0], p0, 0, 0, 0);
        p1 = __builtin_amdgcn_mfma_f32_32x32x16_bf16(b1, qr[d0], p1, 0, 0, 0);
    }
    float tm = -INFINITY;
#pragma unroll
    for (int rr = 0; rr < 16; ++rr) { const int ko = (rr & 3) + 8 * (rr >> 2), kc = ko + 4 * hi;
        if (MODE == 0) { p0[rr] *= C2; p1[rr] *= C2; tm = fmaxf(tm, fmaxf(p0[rr], p1[rr])); }
        else {
            if (act0<MODE>(rr)) { const float t0 = p0[rr] * C2 + tb[ko]; p0[rr] = (unsigned)(kc - cs) < (unsigned)KW ? t0 : -INFINITY; tm = fmaxf(tm, p0[rr]); }
            if (act1<MODE>(rr)) { const float t1 = p1[rr] * C2 + tb[ko + 32]; p1[rr] = (unsigned)(kc + 32 - cs) < (unsigned)KW ? t1 : -INFINITY; tm = fmaxf(tm, p1[rr]); }
        } }
    { float a = tm, bq = tm; asm volatile("s_nop 1\n\tv_permlane32_swap_b32 %0, %1" : "+v"(a), "+v"(bq)); tm = fmaxf(a, bq); }
    const float mn = fmaxf(m, tm), alpha = __builtin_amdgcn_exp2f(m - mn);
    float rsum = 0.f;
#pragma unroll
    for (int rr = 0; rr < 16; ++rr) {
        if (act0<MODE>(rr)) { p0[rr] = __builtin_amdgcn_exp2f(p0[rr] - mn); rsum += p0[rr]; } else p0[rr] = 0.f;
        if (act1<MODE>(rr)) { p1[rr] = __builtin_amdgcn_exp2f(p1[rr] - mn); rsum += p1[rr]; } else p1[rr] = 0.f; }
    l = l * alpha + rsum; m = mn;
    if (__any(alpha != 1.f)) {
        if (hi == 0) wsf[r32] = alpha;
        LDS_WAIT();
#pragma unroll
        for (int rr = 0; rr < 16; ++rr) { const float a = wsf[crow(rr, hi)]; o[0][rr] *= a; o[1][rr] *= a; }
        LDS_WAIT();
    }
    u32x4 pw[4];
#pragma unroll
    for (int q = 0; q < 4; ++q) { pw[0][q] = cvt_pk_bf16(p0[2 * q], p0[2 * q + 1]); pw[1][q] = cvt_pk_bf16(p0[8 + 2 * q], p0[9 + 2 * q]);
                                  pw[2][q] = cvt_pk_bf16(p1[2 * q], p1[2 * q + 1]); pw[3][q] = cvt_pk_bf16(p1[8 + 2 * q], p1[9 + 2 * q]); }
#pragma unroll
    for (int d0 = 0; d0 < 2; ++d0)
#pragma unroll
        for (int ks = 0; ks < 4; ++ks) {
            if ((MODE == 1 && ks == 3) || (MODE == 2 && ks == 0)) continue;
            const s16x4 lo = vtr(vp + d0 * 4096 + ks * 1024), hh = vtr(vp + d0 * 4096 + ks * 1024 + 512);
            const bf16x8 vf = (bf16x8){lo[0], lo[1], lo[2], lo[3], hh[0], hh[1], hh[2], hh[3]};
            o[d0] = __builtin_amdgcn_mfma_f32_32x32x16_bf16(__builtin_bit_cast(bf16x8, pw[ks]), vf, o[d0], 0, 0, 0);
        }
}

__device__ __forceinline__ void attn_unit(Frame& F, int b, int h, int rg) {
    const int lane = F.lane, r32 = lane & 31, hi = lane >> 5, w = F.wave;
    const int r0 = 4 * rg, r = r0 + (w >> 1), c = 32 * (w & 1) + r32;
    const int krlo = rsf(r0), nnb = rsf(r0 + 3) + 7 - krlo + 1, nst = nnb + 4;
    const int rsw = rsf(r), cs = min(max(c - KW / 2, 0), GW - KW);
    LAS float* tbl = (LAS float*)(F.lds + A_RPB);
    LAS float* wsf = (LAS float*)(F.lds + A_WSF) + w * 64;
    for (int i = F.tid; i < 480; i += 512) { const int dr = i >> 5, dc = i & 31; tbl[64 + i] = dc < 31 ? F.rpb[(h * 15 + dr) * 31 + dc] * L2E : 0.f; }
    const bf16_t* qp = F.proj + (size_t)(b * S + r * GW + c) * DIN + h * 64 + hi * 8;
    bf16x8 qr[4];
#pragma unroll
    for (int d0 = 0; d0 < 4; ++d0) qr[d0] = *(const bf16x8*)(qp + d0 * 16);
    const bf16_t* kbase = F.proj + 512 + h * 64 + w * 8;
    const bf16_t* vbase = F.proj + 1024 + h * 64 + (w >> 2) * 32 + (lane & 3) * 8;
#define AT_DMA(st) do { const int _t0 = (st) < nnb ? b * S + (krlo + (st)) * GW : M + b * CTX + ((st) - nnb) * 64; const int _bf = ((st) & 3) * 8192; \
        __builtin_amdgcn_global_load_lds((const unsigned*)(kbase + (size_t)(_t0 + lane) * DIN), (LAS unsigned*)(F.lds + A_K + _bf + w * 1024), 16, 0, 0); \
        __builtin_amdgcn_global_load_lds((const unsigned*)(vbase + (size_t)(_t0 + 16 * (w & 3) + (lane >> 2)) * DIN), (LAS unsigned*)(F.lds + A_V + _bf + w * 1024), 16, 0, 0); } while (0)
    const unsigned lds0 = (unsigned)(size_t)F.lds;
    float m = -1e30f, l = 0.f;
    f32x16 o[2];
#pragma unroll
    for (int i = 0; i < 16; ++i) { o[0][i] = 0.f; o[1][i] = 0.f; }
    AT_DMA(0); AT_DMA(1); AT_DMA(2);
    for (int st = 0; st < nst; ++st) {
        if (st + 2 < nst) asm volatile("s_waitcnt vmcnt(4) lgkmcnt(0)\n\ts_barrier" ::: "memory");
        else if (st + 1 < nst) asm volatile("s_waitcnt vmcnt(2) lgkmcnt(0)\n\ts_barrier" ::: "memory");
        else AT_WAIT_BAR();
        if (st + 3 < nst) AT_DMA(st + 3);
        const bool isnb = st < nnb; const int kr = krlo + st;
        const bool act = !isnb || (kr >= rsw && kr < rsw + KH);
        if (act) {
            const LAS unsigned char* kp0 = F.lds + A_K + (st & 3) * 8192 + hi * 1024 + r32 * 16;
            const LAS unsigned char* vp = F.lds + A_V + (st & 3) * 8192 + ((lane >> 4) & 1) * 32 + (lane & 3) * 8 + (4 * hi + ((lane & 15) >> 2)) * 64;
            const LAS float* tb = tbl + 64 + (kr - r + 7) * 32 + 4 * hi - c + 15;
            if (!isnb) tile_compute<0>(kp0, vp, tb, qr, o, m, l, wsf, r32, hi, cs);
            else if ((w & 1) == 0) tile_compute<1>(kp0, vp, tb, qr, o, m, l, wsf, r32, hi, cs);
            else tile_compute<2>(kp0, vp, tb, qr, o, m, l, wsf, r32, hi, cs);
        }
    }
#undef AT_DMA
    l += __shfl_xor(l, 32);
    if (hi == 0) wsf[32 + r32] = l;
    LDS_WAIT();
    LAS bf16_t* stg = (LAS bf16_t*)(F.lds + A_STG) + w * 2048;
#pragma unroll
    for (int rr = 0; rr < 16; ++rr) { const int orow = crow(rr, hi); const float rl = __builtin_amdgcn_rcpf(wsf[32 + orow]);
        stg[orow * 64 + r32] = (bf16_t)f2bf(o[0][rr] * rl); stg[orow * 64 + 32 + r32] = (bf16_t)f2bf(o[1][rr] * rl); }
    LDS_WAIT();
    bf16_t* ow = F.mixin + (size_t)(b * S + r * GW + 32 * (w & 1)) * D + h * 64;
#pragma unroll
    for (int i = 0; i < 4; ++i) { const int row = i * 8 + (lane >> 3), ch = lane & 7; const u32x4 v = *(const LAS u32x4*)(stg + row * 64 + ch * 8); *(u32x4*)(ow + (size_t)row * D + ch * 8) = v; }
    AT_WAIT_BAR();
}

constexpr int G_IMG = 0, G_STG = 65536, G_STAT = 98304;
__device__ __forceinline__ void sgu_unit(Frame& F, int chunk, int gh) {
    const int lane = F.lane, r32 = lane & 31, hi = lane >> 5, w = F.wave;
    const int base = chunk * 128;
    LAS f32x2* stat = (LAS f32x2*)(F.lds + G_STAT);
    u32x4 zrow[16];
#pragma unroll
    for (int t = 0; t < 16; ++t) zrow[t] = *(const u32x4*)(F.proj + (size_t)(base + 16 * w + t) * DIN + 2048 + lane * 8);
    const int cb = w & 3, th = w >> 2, grp = 2 * gh + (cb >> 1);
    const bf16_t* wp = F.sguw + (size_t)(grp * 128 + 64 * th + r32) * 128 + 8 * hi;
    bf16x8 wf0[8], wf1[8];
#pragma unroll
    for (int ks = 0; ks < 8; ++ks) { wf0[ks] = *(const bf16x8*)(wp + ks * 16); wf1[ks] = *(const bf16x8*)(wp + 32 * 128 + ks * 16); }
#pragma unroll
    for (int t = 0; t < 16; ++t) {
        const int tok = 16 * w + t;
        const u32x4 zv = zrow[t];
        float v[8] = {bflo(zv.x), bfhi(zv.x), bflo(zv.y), bfhi(zv.y), bflo(zv.z), bfhi(zv.z), bflo(zv.w), bfhi(zv.w)};
        float s = 0.f;
#pragma unroll
        for (int i = 0; i < 8; ++i) s += v[i];
        const float mean = wsum(s) * (1.f / 512.f); float q = 0.f;
#pragma unroll
        for (int i = 0; i < 8; ++i) { const float d = v[i] - mean; q += d * d; }
        const float rstd = rsqrtf(wsum(q) * (1.f / 512.f) + EPS);
        if (lane == 0) stat[tok] = (f32x2){mean, rstd};
    }
    AT_WAIT_BAR();
    {
        const int ch0 = 256 * gh + 32 * w + 8 * (lane & 3);
        const f32x4 g0 = *(const f32x4*)(F.sgu_ln_g + ch0), g1 = *(const f32x4*)(F.sgu_ln_g + ch0 + 4), b0 = *(const f32x4*)(F.sgu_ln_b + ch0), b1 = *(const f32x4*)(F.sgu_ln_b + ch0 + 4);
#pragma unroll
        for (int i = 0; i < 8; ++i) {
            const int tok = 16 * i + (lane >> 2);
            const u32x4 zv = *(const u32x4*)(F.proj + (size_t)(base + tok) * DIN + 2048 + ch0);
            const f32x2 st = stat[tok];
            u32x4 o;
            o.x = pk2((bflo(zv.x) - st[0]) * st[1] * g0[0] + b0[0], (bfhi(zv.x) - st[0]) * st[1] * g0[1] + b0[1]);
            o.y = pk2((bflo(zv.y) - st[0]) * st[1] * g0[2] + b0[2], (bfhi(zv.y) - st[0]) * st[1] * g0[3] + b0[3]);
            o.z = pk2((bflo(zv.z) - st[0]) * st[1] * g1[0] + b1[0], (bfhi(zv.z) - st[0]) * st[1] * g1[1] + b1[1]);
            o.w = pk2((bflo(zv.w) - st[0]) * st[1] * g1[2] + b1[2], (bfhi(zv.w) - st[0]) * st[1] * g1[3] + b1[3]);
            *(LAS u32x4*)(F.lds + G_IMG + w * 8192 + i * 1024 + lane * 16) = o;
        }
    }
    AT_WAIT_BAR();
    f32x16 acc[2][2];
#pragma unroll
    for (int a = 0; a < 2; ++a)
#pragma unroll
        for (int q = 0; q < 2; ++q)
#pragma unroll
            for (int i = 0; i < 16; ++i) acc[a][q][i] = 0.f;
    const LAS unsigned char* gp = F.lds + G_IMG + (2 * cb) * 8192 + ((lane >> 4) & 1) * 32 + (lane & 3) * 8 + (8 * hi + ((lane & 15) >> 2)) * 64;
#pragma unroll
    for (int ks = 0; ks < 8; ++ks) {
        const bf16x8 w0 = wf0[ks], w1 = wf1[ks];
#pragma unroll
        for (int c32 = 0; c32 < 2; ++c32) {
            const s16x4 lo = vtr(gp + c32 * 8192 + ks * 1024), hh = vtr(gp + c32 * 8192 + ks * 1024 + 256);
            const bf16x8 gf = (bf16x8){lo[0], lo[1], lo[2], lo[3], hh[0], hh[1], hh[2], hh[3]};
            acc[0][c32] = __builtin_amdgcn_mfma_f32_32x32x16_bf16(gf, w0, acc[0][c32], 0, 0, 0);
            acc[1][c32] = __builtin_amdgcn_mfma_f32_32x32x16_bf16(gf, w1, acc[1][c32], 0, 0, 0);
        }
    }
    LAS unsigned char* stg = F.lds + G_STG + w * 4096;
#pragma unroll
    for (int ib = 0; ib < 2; ++ib) {
        const int i0 = 64 * th + 32 * ib;
        const float bi = F.sgu_b[grp * 128 + i0 + r32];
#pragma unroll
        for (int c32 = 0; c32 < 2; ++c32)
#pragma unroll
            for (int a = 0; a < 4; ++a) { u32x2 o; o.x = pk2(acc[ib][c32][4 * a] + bi, acc[ib][c32][4 * a + 1] + bi); o.y = pk2(acc[ib][c32][4 * a + 2] + bi, acc[ib][c32][4 * a + 3] + bi);
                *(LAS u32x2*)(stg + r32 * 128 + (((4 * c32 + a) ^ (r32 & 7)) << 4) + hi * 8) = o; }
        LDS_WAIT();
#pragma unroll
        for (int it = 0; it < 4; ++it) {
            const int row = 8 * it + (lane >> 3), chn = lane & 7;
            const u32x4 v = *(const LAS u32x4*)(stg + row * 128 + ((chn ^ (row & 7)) << 4));
            const size_t tok = (size_t)(base + i0 + row);
            const u32x4 uv = *(const u32x4*)(F.proj + tok * DIN + 1536 + 256 * gh + 64 * cb + 8 * chn);
            u32x4 o;
            o.x = pk2(bflo(v.x) * bflo(uv.x), bfhi(v.x) * bfhi(uv.x)); o.y = pk2(bflo(v.y) * bflo(uv.y), bfhi(v.y) * bfhi(uv.y));
            o.z = pk2(bflo(v.z) * bflo(uv.z), bfhi(v.z) * bfhi(uv.z)); o.w = pk2(bflo(v.w) * bflo(uv.w), bfhi(v.w) * bfhi(uv.w));
            *(u32x4*)(F.mixin + tok * D + 512 + 256 * gh + 64 * cb + 8 * chn) = o;
        }
        LDS_WAIT();
    }
    AT_WAIT_BAR();
}
__device__ __forceinline__ void p_mixer(Frame& F) {
#ifndef PROBE_MIX_A
#define PROBE_MIX_A 1
#endif
#ifndef PROBE_MIX_S
#define PROBE_MIX_S 1
#endif
#pragma unroll 1
    for (int rep = 0; rep < PROBE_MIX_A; ++rep)
    for (int uid = F.vcu; uid < NB * NH * 32; uid += F.G) attn_unit(F, uid >> 8, (uid >> 5) & 7, uid & 31);
#pragma unroll 1
    for (int rep = 0; rep < PROBE_MIX_S; ++rep)
    for (int uid = F.vcu; uid < (M / 128) * 2; uid += F.G) sgu_unit(F, uid >> 1, uid & 1);
}
#undef AT_WAIT_BAR
}

__device__ __forceinline__ void route_select(Frame& F, float lgt, int e, int lane, int tl, int tok, LAS int* lcnt, LAS int* sel, LAS float* selg) {
    int rank = 0; float mx = -3.0e38f;
#pragma unroll
    for (int e2 = 0; e2 < NE; ++e2) { const float o = rlane(lgt, ((e2 >> 4) << 5) | (((e2 >> 3) & 1) << 4) | (e2 & 7));
        rank += (o > lgt || (o == lgt && e2 < e)) ? 1 : 0; mx = fmaxf(mx, o); }
    const bool selq = rank < TOPK && !(lane & 8);
    const float pe = selq ? __expf(lgt - mx) : 0.f;
    const float den = wsum(pe);
    if (selq) {
        const int lp = __hip_atomic_fetch_add(lcnt + e, 1, __ATOMIC_RELAXED, __HIP_MEMORY_SCOPE_WORKGROUP);
        sel[tl * 4 + rank] = e | (lp << 8); selg[tl * 4 + rank] = pe / den;
        F.topg[tok * 4 + rank] = pe / den; F.topi[tok * 4 + rank] = e;
    }
}
__device__ __forceinline__ float route_reduce(const f32x2 (&lg2)[NE / 2], int lane) {
    float r16[16], r8[8];
#pragma unroll
    for (int e = 0; e < 16; ++e) { float a = lg2[e >> 1][e & 1], bq = lg2[(e + 16) >> 1][e & 1]; asm volatile("s_nop 1\n\tv_permlane32_swap_b32 %0, %1" : "+v"(a), "+v"(bq)); r16[e] = a + bq; }
#pragma unroll
    for (int e = 0; e < 8; ++e) { float a = r16[e], bq = r16[e + 8]; asm volatile("s_nop 1\n\tv_permlane16_swap_b32 %0, %1" : "+v"(a), "+v"(bq)); r8[e] = a + bq; }
    float r1 = 0.f;
#pragma unroll
    for (int e = 0; e < 8; ++e) { float t = r8[e]; t += dppf<0xB1>(t); t += dppf<0x4E>(t); t += dppf<0x141>(t); t += dppf<0x140>(t); r1 = ((lane & 7) == e) ? t : r1; }
    return r1;
}
__device__ __forceinline__ void p_route(Frame& F) {
    LAS int* lcnt = (LAS int*)(F.lds + L_ROUTE); LAS int* gbase = lcnt + 32; LAS int* sel = lcnt + 64; LAS float* selg = (LAS float*)(F.lds + L_RPB);
    for (int i = F.tid; i < 8192; i += 512) { const int c = i >> 3, q = i & 7; *(LAS f32x4*)(F.lds + c * 128 + ((q ^ ((c >> 1) & 7)) << 4)) = *(const f32x4*)(F.router_w + c * 32 + q * 4); }
    if (F.tid < 32) lcnt[F.tid] = 0;
    __syncthreads();
    const int lane = F.lane;
    const LAS unsigned char* wbase = F.lds + lane * 128;
    const int sw = (lane >> 1) & 7;
    LAS unsigned char* hrowA = F.lds + L_WSCR + F.wave * 2048; LAS unsigned char* hrowB = hrowA + 1024;
    const int e = ((lane >> 5) << 4) | (((lane >> 4) & 1) << 3) | (lane & 7);
    const float rbias = F.router_b[e];
    for (int tb = blockIdx.x; tb < M / 64; tb += F.G) {
        const int b = (tb * 64) >> 13;
        float ps[16], ph[16];
#pragma unroll
        for (int i = 0; i < 16; ++i) { const int col = lane + 64 * i; ps[i] = 1.f + F.mod[b * 6144 + 4 * 1024 + col]; ph[i] = F.mod[b * 6144 + 3 * 1024 + col]; }
#pragma unroll 1
        for (int k = 0; k < 4; ++k) {
            const int tlA = F.wave + 8 * k, tlB = tlA + 32, tokA = tb * 64 + tlA, tokB = tb * 64 + tlB;
            float vA[16], vB[16]; float sA = 0.f, sB = 0.f;
            float pg[16], pb[16];
#pragma unroll
            for (int i = 0; i < 16; ++i) { pg[i] = F.ln1_g[lane + 64 * i]; pb[i] = F.ln1_b[lane + 64 * i]; }
            { const bf16_t* ya = F.y1 + (size_t)tokA * D; const bf16_t* yb = F.y1 + (size_t)tokB * D;
#pragma unroll
              for (int i = 0; i < 16; ++i) { vA[i] = bf2f(ya[lane + 64 * i]); vB[i] = bf2f(yb[lane + 64 * i]); }
#pragma unroll
              for (int i = 0; i < 16; ++i) { sA += vA[i]; sB += vB[i]; } }
            float meanA = wsum(sA) * (1.f / D), meanB = wsum(sB) * (1.f / D), qA = 0.f, qB = 0.f;
#pragma unroll
            for (int i = 0; i < 16; ++i) { vA[i] -= meanA; qA += vA[i] * vA[i]; vB[i] -= meanB; qB += vB[i] * vB[i]; }
            float rstdA = rsqrtf(wsum(qA) * (1.f / D) + EPS), rstdB = rsqrtf(wsum(qB) * (1.f / D) + EPS);
            if (lane == 0) { F.stat[tokA] = (f32x2){meanA, rstdA}; F.stat[tokB] = (f32x2){meanB, rstdB}; }
            sA = 0.f; sB = 0.f;
#pragma unroll
            for (int i = 0; i < 16; ++i) { vA[i] = vA[i] * rstdA * pg[i] + pb[i]; sA += vA[i]; vB[i] = vB[i] * rstdB * pg[i] + pb[i]; sB += vB[i]; }
#ifdef MK_WRITE_X1
#pragma unroll
            for (int i = 0; i < 16; ++i) { F.x1[(size_t)tokA * D + lane + 64 * i] = vA[i]; F.x1[(size_t)tokB * D + lane + 64 * i] = vB[i]; }
#endif
            meanA = wsum(sA) * (1.f / D); meanB = wsum(sB) * (1.f / D); qA = 0.f; qB = 0.f;
#pragma unroll
            for (int i = 0; i < 16; ++i) { vA[i] -= meanA; qA += vA[i] * vA[i]; vB[i] -= meanB; qB += vB[i] * vB[i]; }
            rstdA = rsqrtf(wsum(qA) * (1.f / D) + EPS); rstdB = rsqrtf(wsum(qB) * (1.f / D) + EPS);
#pragma unroll
            for (int i = 0; i < 16; ++i) { vA[i] = vA[i] * rstdA * ps[i] + ph[i]; vB[i] = vB[i] * rstdB * ps[i] + ph[i];
                hrowA[lane + 64 * i] = (unsigned char)__builtin_amdgcn_cvt_pk_fp8_f32(vA[i], vA[i], 0, false); hrowB[lane + 64 * i] = (unsigned char)__builtin_amdgcn_cvt_pk_fp8_f32(vB[i], vB[i], 0, false); }
            f32x2 lgA[NE / 2], lgB[NE / 2];
#pragma unroll
            for (int q = 0; q < NE / 2; ++q) { lgA[q] = (f32x2){0.f, 0.f}; lgB[q] = (f32x2){0.f, 0.f}; }
#pragma unroll
            for (int i = 0; i < 16; ++i) {
                f32x4 wa[8];
#pragma unroll
                for (int qq = 0; qq < 8; ++qq) wa[qq] = *(const LAS f32x4*)(wbase + i * 8192 + ((qq ^ sw) << 4));
                __builtin_amdgcn_sched_barrier(0);
                const f32x2 ha = (f32x2){vA[i], vA[i]}, hb = (f32x2){vB[i], vB[i]};
#pragma unroll
                for (int qq = 0; qq < 8; ++qq) { const f32x2 w0 = (f32x2){wa[qq][0], wa[qq][1]}, w1 = (f32x2){wa[qq][2], wa[qq][3]};
                    lgA[2 * qq] = __builtin_elementwise_fma(ha, w0, lgA[2 * qq]); lgA[2 * qq + 1] = __builtin_elementwise_fma(ha, w1, lgA[2 * qq + 1]);
                    lgB[2 * qq] = __builtin_elementwise_fma(hb, w0, lgB[2 * qq]); lgB[2 * qq + 1] = __builtin_elementwise_fma(hb, w1, lgB[2 * qq + 1]); }
                __builtin_amdgcn_sched_barrier(0);
            }
            LDS_WAIT();
            *(u32x4*)(F.h2 + (size_t)tokA * D + lane * 16) = *(const LAS u32x4*)(hrowA + lane * 16);
            *(u32x4*)(F.h2 + (size_t)tokB * D + lane * 16) = *(const LAS u32x4*)(hrowB + lane * 16);
            const float lgtA = route_reduce(lgA, lane) + rbias, lgtB = route_reduce(lgB, lane) + rbias;
            route_select(F, lgtA, e, lane, tlA, tokA, lcnt, sel, selg);
            route_select(F, lgtB, e, lane, tlB, tokB, lcnt, sel, selg);
        }
        __syncthreads();
        if (F.tid < 32) { const int n = lcnt[F.tid]; gbase[F.tid] = n ? (int)__hip_atomic_fetch_add(F.cntw + 32 * F.tid, (unsigned)n, __ATOMIC_RELAXED, __HIP_MEMORY_SCOPE_AGENT) : 0; lcnt[F.tid] = 0; }
        __syncthreads();
        if (F.tid < 256) { const int sv = sel[F.tid], ee = sv & 255, lp = sv >> 8; F.list[(size_t)ee * LCAP + gbase[ee] + lp] = (tb * 64 + (F.tid >> 2)) * 4 + (F.tid & 3); F.listg[(size_t)ee * LCAP + gbase[ee] + lp] = selg[F.tid]; }
        __syncthreads();
    }
}

__device__ __forceinline__ void p_final(Frame& F) {
    const int gw = F.vcu * 8 + F.wave, NGW = F.G * 8;
    for (int tok = gw; tok < M; tok += NGW) {
        const float* g2 = F.mod + (tok >> 13) * 6144 + 5 * 1024;
        const u32x2* xp = (const u32x2*)(F.y1 + (size_t)tok * D) + F.lane;
        const f32x2 st = F.stat[tok];
        f32x4 v[4]; float s = 0.f;
#pragma unroll
        for (int j = 0; j < 4; ++j) {
            f32x4 f = (f32x4){0.f, 0.f, 0.f, 0.f};
#pragma unroll
            for (int k = 0; k < TOPK; ++k) { const int yv = (int)__builtin_nontemporal_load((const unsigned*)(F.ybuf + (size_t)(tok * 4 + k) * D) + F.lane + 64 * j);
                f[0] += __builtin_amdgcn_cvt_f32_fp8(yv, 0); f[1] += __builtin_amdgcn_cvt_f32_fp8(yv, 1); f[2] += __builtin_amdgcn_cvt_f32_fp8(yv, 2); f[3] += __builtin_amdgcn_cvt_f32_fp8(yv, 3); }
            f = f * (1.f / PolDN::YSC);
            const f32x4 gv = *((const f32x4*)g2 + F.lane + 64 * j);
            const f32x4 l1g = *((const f32x4*)F.ln1_g + F.lane + 64 * j), l1b = *((const f32x4*)F.ln1_b + F.lane + 64 * j);
            const u32x2 yw = __builtin_nontemporal_load(xp + 64 * j); const f32x4 yv = (f32x4){bflo(yw.x), bfhi(yw.x), bflo(yw.y), bfhi(yw.y)};
            const f32x4 x1v = (yv - st[0]) * st[1] * l1g + l1b;
            v[j] = x1v * DN_ALPHA + gv * f; s += (v[j][0] + v[j][1]) + (v[j][2] + v[j][3]);
        }
        const float mean = wsum(s) * (1.f / D); float q = 0.f;
#pragma unroll
        for (int j = 0; j < 4; ++j) { v[j] = v[j] - mean; q += (v[j][0] * v[j][0] + v[j][1] * v[j][1]) + (v[j][2] * v[j][2] + v[j][3] * v[j][3]); }
        const float rstd = rsqrtf(wsum(q) * (1.f / D) + EPS);
        f32x4* op = (f32x4*)(F.out + (size_t)tok * D) + F.lane;
#pragma unroll
        for (int j = 0; j < 4; ++j) { const f32x4 gg = *((const f32x4*)F.ln2_g + F.lane + 64 * j), bb = *((const f32x4*)F.ln2_b + F.lane + 64 * j); op[64 * j] = v[j] * rstd * gg + bb; }
    }
}

struct Args { const float* in[23]; float* out; unsigned char* ws; int ph_lo, ph_hi, alt, pad; };
constexpr int N_PHASES = 9;
__global__ void __launch_bounds__(512, 2) mk_fwd(Args args) {
    extern __shared__ __attribute__((aligned(16))) unsigned char lds_raw[];
    Frame F;
    F.lds = (LAS unsigned char*)lds_raw;
    F.MISC = (volatile LAS unsigned*)(F.lds + L_MISC);
    F.tid = threadIdx.x; F.lane = F.tid & 63; F.wave = __builtin_amdgcn_readfirstlane(F.tid >> 6);
    F.G = gridDim.x; { const int bx = blockIdx.x; F.vcu = (F.G % 8 == 0) ? (bx % 8) * (F.G / 8) + bx / 8 : bx; }
    unsigned char* ws = args.ws;
    F.ctl = (unsigned*)(ws + WS_CTL);
    F.x = args.in[0]; F.c = args.in[1]; F.ctx = args.in[2]; F.c_ctx = args.in[3]; F.ada_w = args.in[4]; F.ada_b = args.in[5]; F.w_in = args.in[6]; F.rpb = args.in[7];
    F.sgu_ln_g = args.in[8]; F.sgu_ln_b = args.in[9]; F.sgu_w = args.in[10]; F.sgu_b = args.in[11]; F.w_out = args.in[12]; F.ln1_g = args.in[13]; F.ln1_b = args.in[14];
    F.ln2_g = args.in[15]; F.ln2_b = args.in[16]; F.router_w = args.in[17]; F.router_b = args.in[18]; F.w_gu = args.in[19]; F.b_gu = args.in[20]; F.w_dn = args.in[21]; F.b_dn = args.in[22];
    F.out = args.out;
    F.mod = (float*)(ws + WS_MOD); F.topg = (float*)(ws + WS_TOPG); F.topi = (int*)(ws + WS_TOPI); F.list = (int*)(ws + WS_LIST); F.listg = (float*)(ws + WS_LISTG); F.sguw = (bf16_t*)(ws + WS_SGUW);
    F.Wt_in = (bf16_t*)(ws + WS_WIN); F.Wt_out = (bf16_t*)(ws + WS_WOUT); F.Wt_gu = ws + WS_WGU; F.Wt_dn = ws + WS_WDN;
    F.hxc = (bf16_t*)(ws + WS_HXC); F.proj = (bf16_t*)(ws + WS_PROJ); F.mixin = (bf16_t*)(ws + WS_MIXIN); F.y1 = (bf16_t*)(ws + WS_Y1); F.x1 = (float*)(ws + WS_X1); F.stat = (f32x2*)(ws + WS_STAT); F.cntw = F.ctl + CW_CNT; F.h2 = ws + WS_H2;
    F.act = ws + WS_ACT; F.ybuf = ws + WS_YBUF;
    for (int u = F.tid; u < (LDS_BYTES - L_MISC) / 4; u += 512) ((LAS unsigned*)(F.lds + L_MISC))[u] = 0u;
    __syncthreads();
    if (args.alt) { F.x1 = (float*)(ws + WS_ALT); F.h2 = ws + WS_ALT + 64 * MiB; F.list = (int*)(ws + WS_ALT + 80 * MiB); F.listg = (float*)(ws + WS_ALT + 84 * MiB); F.topg = (float*)(ws + WS_ALT + 82 * MiB); F.topi = (int*)(ws + WS_ALT + 82 * MiB + 512 * 1024); F.cntw = F.ctl + CW_CNT_ALT; F.stat = (f32x2*)(ws + WS_ALT + 83 * MiB); }
    const int lo = args.ph_lo, hi = args.ph_hi;
    const bool one = (hi - lo) > 1;
    XcdBarrier bar; bar.bar = (unsigned*)(F.ctl + CW_BAR); bar.x = 0; bar.st = nullptr;
    if (one) bar = xcd_barrier_post((unsigned*)(F.ctl + CW_BAR), F.MISC + 8);
#define IN(k) (lo <= (k) && (k) < hi)
#define SEAM(k) do { if (IN(k) && IN((k) + 1)) xcd_barrier(bar); } while (0)
#ifndef PROBE_REPS
#define PROBE_REPS {1, 1, 1, 1, 1, 1, 1, 1, 1}
#endif
    constexpr int REPS[N_PHASES] = PROBE_REPS;
#define REPEAT(k) _Pragma("unroll") for (int rep_ = 0; rep_ < REPS[k]; ++rep_)
#define RSEAM(k) do { if (rep_ + 1 < REPS[k]) xcd_barrier(bar); else SEAM(k); } while (0)
    constexpr int W_ITEMS = 16 * 80 + 16 * 32 + NE * 16 * 64 + NE * 16 * 32, W_TAIL = 7680;
    const bool tail_wg = (F.G == 256 && (int)blockIdx.x >= 136);
    if (IN(0)) REPEAT(0) { p_ada(F); p_weights(F, 0, (F.G == 256) ? W_ITEMS - W_TAIL : W_ITEMS, F.vcu * 8 + F.wave, F.G * 8, true); RSEAM(0); }
    if (IN(1)) REPEAT(1) { p_lnmod(F); RSEAM(1); }
    if (IN(2)) REPEAT(2) { PolProj P{F.hxc, F.Wt_in, F.proj, F.G, (int)blockIdx.x}; pg8::gemm_phase<PolProj>(F.lds, P);
        if (tail_wg) p_weights(F, W_ITEMS - W_TAIL, W_TAIL, ((int)blockIdx.x - 136) * 8 + F.wave, 120 * 8, false); RSEAM(2); }
    if (IN(3)) REPEAT(3) { at::p_mixer(F); RSEAM(3); }
    if (IN(4)) REPEAT(4) { PolOut P{F.mixin, F.Wt_out, F.x, F.mod, F.y1, F.G, (int)blockIdx.x}; pg8::gemm_phase<PolOut>(F.lds, P); RSEAM(4); }
    if (IN(5)) { p_route(F); SEAM(5); }
    if (IN(6)) REPEAT(6) { const int T = expert_tables(F); ExpTab tb{(const LAS int*)(F.lds + L_TILEE), (const LAS int*)(F.lds + L_TSTART), (const LAS int*)(F.lds + L_TSTART) + 64, T};
        PolGU P{F.h2, F.Wt_gu, F.b_gu, F.list, F.act, tb, F.G, (int)blockIdx.x}; pg8::gemm_phase<PolGU>(F.lds, P); RSEAM(6); }
    if (IN(7)) REPEAT(7) { const int T = expert_tables(F); ExpTab tb{(const LAS int*)(F.lds + L_TILEE), (const LAS int*)(F.lds + L_TSTART), (const LAS int*)(F.lds + L_TSTART) + 64, T};
        PolDN P{F.act, F.Wt_dn, F.b_dn, F.list, F.listg, F.ybuf, tb, F.G, (int)blockIdx.x}; pg8::gemm_phase<PolDN>(F.lds, P); RSEAM(7); }
    if (IN(8)) REPEAT(8) { p_final(F); if (rep_ + 1 < REPS[8]) xcd_barrier(bar); }
#undef IN
#undef SEAM
#undef REPEAT
#undef RSEAM
}

static inline void launch_forward(void* const* d_in, void* d_out, void* d_ws, hipStream_t stream, int n_launches) {
    static int grid = 0;
    if (grid == 0) {
        int dev = 0, cus = 0;
        if (hipGetDevice(&dev) != hipSuccess || hipDeviceGetAttribute(&cus, hipDeviceAttributeMultiprocessorCount, dev) != hipSuccess) { fprintf(stderr, "kernel_launch: device query failed\n"); grid = -1; return; }
        if (hipFuncSetAttribute((const void*)mk_fwd, hipFuncAttributeMaxDynamicSharedMemorySize, LDS_BYTES) != hipSuccess) { fprintf(stderr, "kernel_launch: hipFuncSetAttribute failed\n"); grid = -1; return; }
        int per_cu = 0;
        if (hipOccupancyMaxActiveBlocksPerMultiprocessor(&per_cu, (const void*)mk_fwd, 512, LDS_BYTES) != hipSuccess || per_cu < 1) fprintf(stderr, "kernel_launch: occupancy query says %d\n", per_cu);
        (void)hipGetLastError();
        grid = cus;
    }
    if (grid < 0) return;
    (void)hipMemsetAsync((char*)d_ws + WS_CTL, 0, CTL_ZERO_BYTES, stream);
    Args a{};
    for (int i = 0; i < 23; ++i) a.in[i] = (const float*)d_in[i];
    a.out = (float*)d_out; a.ws = (unsigned char*)d_ws;
    if (n_launches == 1) { a.ph_lo = 0; a.ph_hi = N_PHASES; hipLaunchKernelGGL(mk_fwd, dim3(grid), dim3(512), LDS_BYTES, stream, a); }
    else for (int p = 0; p < N_PHASES; ++p) { a.ph_lo = p; a.ph_hi = p + 1; hipLaunchKernelGGL(mk_fwd, dim3(grid), dim3(512), LDS_BYTES, stream, a); }
#ifdef PROBE_EXTRA
    { const int extra[] = PROBE_EXTRA; for (int p : extra) { a.ph_lo = p; a.ph_hi = p + 1; a.alt = (p == 5); hipLaunchKernelGGL(mk_fwd, dim3(grid), dim3(512), LDS_BYTES, stream, a); } }
#endif
}
}
extern "C" void kernel_launch(void* const* d_in, const int* in_sizes, int n_in, void* d_out, int out_size, void* d_ws, size_t ws_size, hipStream_t stream) {
    if (ws_size < mk::WS_END || n_in != 23) { fprintf(stderr, "kernel_launch: unexpected workspace / inputs (%zu, %d)\n", ws_size, n_in); return; }
    mk::launch_forward(d_in, d_out, d_ws, stream, 1);
}
```

```cpp
#include <hip/hip_runtime.h>
#include <stdint.h>
#include <stdio.h>

#define GAS __attribute__((address_space(1)))
#define LAS __attribute__((address_space(3)))
typedef unsigned short bf16_t;
typedef short bf16x8 __attribute__((ext_vector_type(8)));
typedef float f32x4 __attribute__((ext_vector_type(4)));
typedef float f32x2 __attribute__((ext_vector_type(2)));
typedef unsigned u32x4 __attribute__((ext_vector_type(4)));
typedef unsigned u32x2 __attribute__((ext_vector_type(2)));

namespace mk {
constexpr int D = 1024, NB = 2, S = 8192, M = NB * S, GW = 64, ROWS = 128, CTX = 256, NH = 8, KH = 8, KW = 16;
constexpr int NE = 32, TOPK = 4, DFF = 1024, DIN = 2560, NPAIR = M * TOPK, MX = M + NB * CTX;
constexpr int LCAP = 16384, MAXT = 288, ACT_ROWS = MAXT * 256;
constexpr float EPS = 1e-5f;
constexpr float DN_ALPHA = 1.189207115002721f;
constexpr size_t MiB = 1u << 20;
constexpr size_t WS_CTL = 0, CTL_ZERO_BYTES = 1 * MiB;
constexpr size_t WS_MOD = 1 * MiB;
constexpr size_t WS_TOPG = 2 * MiB;
constexpr size_t WS_TOPI = 2 * MiB + 512 * 1024;
constexpr size_t WS_STAT = 5 * MiB + 512 * 1024;
constexpr size_t WS_LIST = 3 * MiB;
constexpr size_t WS_SGUW = 5 * MiB;
constexpr size_t WS_LISTG = 14 * MiB;
constexpr size_t WS_WIN = 6 * MiB;
constexpr size_t WS_WOUT = 11 * MiB;
constexpr size_t WS_WGU = 16 * MiB;
constexpr size_t WS_WDN = 144 * MiB;
constexpr size_t WS_HXC = 208 * MiB;
constexpr size_t WS_PROJ = 241 * MiB;
constexpr size_t WS_MIXIN = 324 * MiB;
constexpr size_t WS_Y1 = 356 * MiB;
constexpr size_t WS_H2 = 420 * MiB;
constexpr size_t WS_ACT = 452 * MiB;
constexpr size_t WS_YBUF = 596 * MiB;
constexpr size_t WS_X1 = 724 * MiB;
constexpr size_t WS_END = 788 * MiB;
constexpr size_t WS_ALT = 788 * MiB;
constexpr int CW_CNT_ALT = 12288;
constexpr int CW_BAR = 4096;
constexpr int CW_CNT = 8192;
constexpr int RING_BYTES = 131072;
constexpr int L_MISC = RING_BYTES;
constexpr int L_IDX = L_MISC + 1024;
constexpr int L_TILEE = L_IDX + 6144;
constexpr int L_TSTART = L_TILEE + 1280;
constexpr int L_ROUTE = L_TSTART + 512;
constexpr int L_RPB = L_ROUTE + 256 + 1024;
constexpr int L_WSCR = L_RPB + 2048;
constexpr int LDS_BYTES = 163840;
static_assert(L_WSCR + 8 * 2048 <= LDS_BYTES, "LDS map");

template <int CTRL> __device__ __forceinline__ float dppf(float v) { return __builtin_bit_cast(float, __builtin_amdgcn_update_dpp(0, __builtin_bit_cast(int, v), CTRL, 0xF, 0xF, true)); }
__device__ __forceinline__ float rlane(float v, int l) { return __builtin_bit_cast(float, __builtin_amdgcn_readlane(__builtin_bit_cast(int, v), l)); }
__device__ __forceinline__ float wsum(float v) {
    v += dppf<0xB1>(v); v += dppf<0x4E>(v); v += dppf<0x141>(v); v += dppf<0x140>(v);
    return (rlane(v, 0) + rlane(v, 16)) + (rlane(v, 32) + rlane(v, 48));
}
__device__ __forceinline__ float wmax(float v) {
    v = fmaxf(v, dppf<0xB1>(v)); v = fmaxf(v, dppf<0x4E>(v)); v = fmaxf(v, dppf<0x141>(v)); v = fmaxf(v, dppf<0x140>(v));
    return fmaxf(fmaxf(rlane(v, 0), rlane(v, 16)), fmaxf(rlane(v, 32), rlane(v, 48)));
}
__device__ __forceinline__ unsigned f2bf(float f) { unsigned u = __builtin_bit_cast(unsigned, f); return (u + 0x7fffu + ((u >> 16) & 1u)) >> 16; }
__device__ __forceinline__ unsigned pk2(float lo, float hi) { return f2bf(lo) | (f2bf(hi) << 16); }
__device__ __forceinline__ float bf2f(unsigned short b) { return __builtin_bit_cast(float, ((unsigned)b) << 16); }
__device__ __forceinline__ float bflo(unsigned w) { return __builtin_bit_cast(float, w << 16); }
__device__ __forceinline__ float bfhi(unsigned w) { return __builtin_bit_cast(float, w & 0xffff0000u); }
__device__ __forceinline__ void store16_sc1(void* p, u32x4 v) { asm volatile("global_store_dwordx4 %0, %1, off sc1\n\ts_nop 1" :: "v"(p), "v"(v) : "memory"); }
__device__ __forceinline__ unsigned cvt_pk_bf16(float lo, float hi) { unsigned r; asm volatile("v_cvt_pk_bf16_f32 %0, %1, %2" : "=v"(r) : "v"(lo), "v"(hi)); return r; }
__device__ __forceinline__ unsigned pk4_fp8(float a, float b, float c, float d) { return (unsigned)__builtin_amdgcn_cvt_pk_fp8_f32(c, d, __builtin_amdgcn_cvt_pk_fp8_f32(a, b, 0, false), true); }
__device__ __forceinline__ float gelu_fast(float x) {
    const float c1 = -2.302208198f;
    const float c3 = c1 * 0.044715f;
    const float x2 = x * x;
    const float t = x * (c1 + c3 * x2);
    return x * __builtin_amdgcn_rcpf(1.f + __builtin_amdgcn_exp2f(t));
}

#define XB_TMO      128
#define XB_XCNT(j)  (256  + 64 * (j))
#define XB_XSUB(j)  (1280 + 64 * (j))
#define XB_XGEN(j)  (2304 + 64 * (j))
#define XB_TOP      3328
#define XB_TOPGEN   3392
#define XCD_BAR_WORDS 3456
#define XB_SPIN_CAP (1u << 18)
__device__ __forceinline__ unsigned xb_ld(unsigned* p)              { return __hip_atomic_load(p, __ATOMIC_RELAXED, __HIP_MEMORY_SCOPE_AGENT); }
__device__ __forceinline__ unsigned xb_add(unsigned* p, unsigned v) { return __hip_atomic_fetch_add(p, v, __ATOMIC_RELAXED, __HIP_MEMORY_SCOPE_AGENT); }
__device__ __forceinline__ unsigned xb_xcc_id() { return (unsigned)__builtin_amdgcn_s_getreg((3 << 11) | 20) & 0xFu; }
#define XB_SPIN(cond, bar) do { unsigned _sp = 0; while (cond) { __builtin_amdgcn_s_sleep(1); \
    if ((++_sp & 255u) == 0u) { if (xb_ld(&(bar)[XB_TMO])) break; if (_sp > XB_SPIN_CAP) { atomicAdd(&(bar)[XB_TMO], 1u); break; } } } } while (0)
struct XcdBarrier { unsigned* bar; unsigned x; volatile LAS unsigned* st; };
__device__ __forceinline__ XcdBarrier xcd_barrier_post(unsigned* bar, volatile LAS unsigned* st) {
    XcdBarrier b; b.bar = bar; b.x = xb_xcc_id(); b.st = st;
    if (threadIdx.x == 0) (void)xb_add(&bar[XB_XCNT(b.x)], 1u);
    return b;
}
__device__ __forceinline__ void xcd_barrier_complete(unsigned* bar, unsigned x, unsigned& nloc, unsigned& nx) {
    const unsigned G = gridDim.x * gridDim.y * gridDim.z;
    unsigned sum, cnt, mine, sp = 0u;
    for (;;) {
        sum = 0u; cnt = 0u; mine = 0u;
#pragma unroll
        for (unsigned j = 0; j < 16; ++j) { const unsigned c = xb_ld(&bar[XB_XCNT(j)]); sum += c; cnt += (c > 0u) ? 1u : 0u; mine = (j == x) ? c : mine; }
        if (sum == G) break;
        __builtin_amdgcn_s_sleep(1);
        if ((++sp & 255u) == 0u) { if (xb_ld(&bar[XB_TMO])) break; if (sp > XB_SPIN_CAP) { atomicAdd(&bar[XB_TMO], 1u); break; } }
    }
    nloc = mine > 0u ? mine : 1u; nx = cnt > 0u ? cnt : 1u;
}
__device__ __forceinline__ void xcd_barrier(const XcdBarrier& b) {
    asm volatile("s_waitcnt vmcnt(0)" ::: "memory");
    __syncthreads();
    if (threadIdx.x == 0) {
        unsigned* bar = b.bar;
        __builtin_amdgcn_s_waitcnt(0);
        unsigned nloc = b.st[0], nx = b.st[1];
        if (nloc == 0u) { xcd_barrier_complete(bar, b.x, nloc, nx); b.st[0] = nloc; b.st[1] = nx; }
        const unsigned old = xb_add(&bar[XB_XSUB(b.x)], 1u);
        const unsigned gen = old / nloc;
        if (old + 1u == (gen + 1u) * nloc) {
            __builtin_amdgcn_fence(__ATOMIC_RELEASE, "agent");
            asm volatile("s_waitcnt vmcnt(0)" ::: "memory");
            const unsigned og = xb_add(&bar[XB_TOP], 1u);
            const unsigned tg = og / nx;
            if (og + 1u == (tg + 1u) * nx) xb_add(&bar[XB_TOPGEN], 1u);
            else XB_SPIN(xb_ld(&bar[XB_TOPGEN]) == tg, bar);
            __builtin_amdgcn_fence(__ATOMIC_ACQUIRE, "agent");
            xb_add(&bar[XB_XGEN(b.x)], 1u);
            asm volatile("s_waitcnt vmcnt(0)" ::: "memory");
        } else {
            XB_SPIN(xb_ld(&bar[XB_XGEN(b.x)]) == gen, bar);
            __builtin_amdgcn_fence(__ATOMIC_ACQUIRE, "agent");
            asm volatile("s_waitcnt vmcnt(0)" ::: "memory");
        }
    }
    __syncthreads();
}

struct Frame {
    LAS unsigned char* lds;
    volatile LAS unsigned* MISC;
    unsigned* ctl;
    int tid, lane, wave, vcu, G;
    const float *x, *c, *ctx, *c_ctx, *ada_w, *ada_b, *w_in, *rpb, *sgu_ln_g, *sgu_ln_b, *sgu_w, *sgu_b, *w_out, *ln1_g, *ln1_b, *ln2_g, *ln2_b, *router_w, *router_b, *w_gu, *b_gu, *w_dn, *b_dn;
    float* out;
    float* mod; float* topg; int* topi; int* list; float* listg; bf16_t* sguw; bf16_t* Wt_in; bf16_t* Wt_out; unsigned char* Wt_gu; unsigned char* Wt_dn;
    bf16_t* hxc; bf16_t* proj; bf16_t* mixin; bf16_t* y1; float* x1; f32x2* stat; unsigned* cntw; unsigned char* h2; unsigned char* act; unsigned char* ybuf;
};
#define LDS_WAIT() asm volatile("s_waitcnt lgkmcnt(0)" ::: "memory")
#define VM_WAIT() asm volatile("s_waitcnt vmcnt(0)" ::: "memory")

namespace pg8 {
constexpr int BM = 256, BK = 64, HALF = 128, HTB = HALF * BK * 2, STAGE_BYTES = 8 * HTB, NXCD = 8, WGM = 8, KD = 1024, NKT = KD / BK;
__device__ __forceinline__ int lds_byte(int r, int c) { const int st = (r >> 4) * 2 + (c >> 5), rr = r & 15, cc = c & 31, ob = rr * 64 + cc * 2; return st * 1024 + (ob ^ (((ob >> 9) & 1) << 5)); }
__device__ __forceinline__ void stage_rc(int b, int& R, int& C) { const int st = b / 1024, sb = b % 1024, swz = sb ^ (((sb >> 9) & 1) << 5); R = (st >> 1) * 16 + swz / 64; C = (st & 1) * 32 + (swz % 64) / 2; }
__device__ __forceinline__ int perm32(int rho) { const int n = rho >> 4, i = rho & 15; return 8 * (i >> 2) + 4 * n + (i & 3); }
struct Unit { int pm, pn, e, nvalid, ti; };
__device__ __forceinline__ void static_tile(int L, int nM, int nN, int& pm, int& pn) {
    const int nwg = nM * nN; int wgid = L;
    { const int q = nwg / NXCD, r = nwg % NXCD, xcd = wgid % NXCD, off = wgid / NXCD; wgid = (xcd < r ? xcd * (q + 1) : r * (q + 1) + (xcd - r) * q) + off; }
    const int nig = WGM * nN, gid = wgid / nig, fm = gid * WGM, gsz = (nM - fm) < WGM ? (nM - fm) : WGM;
    pm = fm + ((wgid % nig) % gsz); pn = (wgid % nig) / gsz;
}

typedef int v8i __attribute__((ext_vector_type(8)));
template <bool FP8> struct Frags;
template <> struct Frags<false> { bf16x8 At[4][2], B0[2][2], B1[2][2]; };
template <> struct Frags<true> { v8i At[4], B0[2], B1[2]; };
template <class P>
__device__ __forceinline__ void gemm_phase(LAS unsigned char* lds, const P& pol) {
    const int tid = threadIdx.x, wid = __builtin_amdgcn_readfirstlane(tid >> 6), lane = tid & 63, wr = wid >> 2, wc = wid & 3, fr = lane & 15, fq = lane >> 4;
    constexpr int KDB = P::FP8 ? 1024 : 2048, NKT_ = KDB / 128;
    unsigned voffB[2];
#pragma unroll
    for (int i = 0; i < 2; ++i) { int R, C; stage_rc(tid * 16 + i * 8192, R, C);
        int Rb = P::PERM ? ((R & ~31) + perm32(R & 31)) : R;
        if constexpr (P::BMAP16) { const int n = (R >> 4) & 1, q = R & 15; Rb = 64 * (R >> 5) + 16 * (q >> 2) + 4 * n + (q & 3); }
        voffB[i] = (unsigned)(Rb * KDB + C * 2); }
    const size_t kstep = (size_t)(BK * 2);
    const size_t hstep = (size_t)(P::BMAP16 ? 8 : HALF) * KDB;
    const unsigned ldsw = (unsigned)wid * 1024u;
    const int aoff = lds_byte(wr * 64 + fr, fq * 8), boff = lds_byte(wc * 32 + fr, fq * 8);
#define PG8_SA(b, h) (((b) * 2 + (h)) * HTB)
#define PG8_SB(b, h) ((4 + (b) * 2 + (h)) * HTB)
#define PG8_STAGE(bufoff, gbase, voff) do { _Pragma("unroll") for (int _i = 0; _i < 2; ++_i) \
        __builtin_amdgcn_global_load_lds((const unsigned*)((const char*)(gbase) + (voff)[_i]), (LAS unsigned*)(lds + (bufoff) + ldsw + _i * 8192), 16, 0, 0); } while (0)
#define PG8_RD8(p) __builtin_shufflevector(*(const LAS u32x4*)(p), *(const LAS u32x4*)((p) + 1024), 0, 1, 2, 3, 4, 5, 6, 7)
#define PG8_LDA(dst, b, h) do { if constexpr (P::FP8) { _Pragma("unroll") for (int m = 0; m < 4; ++m) fg.dst[m] = __builtin_bit_cast(v8i, PG8_RD8(lds + PG8_SA(b, h) + aoff + m * 2048)); } \
        else { _Pragma("unroll") for (int m = 0; m < 4; ++m) _Pragma("unroll") for (int k = 0; k < 2; ++k) fg.dst[m][k] = *(const LAS bf16x8*)(lds + PG8_SA(b, h) + aoff + m * 2048 + k * 1024); } } while (0)
#define PG8_LDB(dst, b, h) do { if constexpr (P::FP8) { _Pragma("unroll") for (int n = 0; n < 2; ++n) fg.dst[n] = __builtin_bit_cast(v8i, PG8_RD8(lds + PG8_SB(b, h) + boff + n * 2048)); } \
        else { _Pragma("unroll") for (int n = 0; n < 2; ++n) _Pragma("unroll") for (int k = 0; k < 2; ++k) fg.dst[n][k] = *(const LAS bf16x8*)(lds + PG8_SB(b, h) + boff + n * 2048 + k * 1024); } } while (0)
#define PG8_MMA(ai, bj, At, Bt) do { __builtin_amdgcn_s_setprio(1); \
        if constexpr (P::FP8) { _Pragma("unroll") for (int m = 0; m < 4; ++m) _Pragma("unroll") for (int n = 0; n < 2; ++n) \
            acc[ai][bj][m][n] = __builtin_amdgcn_mfma_scale_f32_16x16x128_f8f6f4(fg.Bt[n], fg.At[m], acc[ai][bj][m][n], 0, 0, 0, 0, 0, 0); } \
        else { _Pragma("unroll") for (int m = 0; m < 4; ++m) _Pragma("unroll") for (int n = 0; n < 2; ++n) _Pragma("unroll") for (int k = 0; k < 2; ++k) \
            acc[ai][bj][m][n] = __builtin_amdgcn_mfma_f32_16x16x32_bf16(fg.Bt[n][k], fg.At[m][k], acc[ai][bj][m][n], 0, 0, 0); } \
        __builtin_amdgcn_s_setprio(0); } while (0)
#define PG8_WAIT_V(n) asm volatile("s_waitcnt vmcnt(" #n ")" ::: "memory")
#define PG8_WAIT_L(n) asm volatile("s_waitcnt lgkmcnt(" #n ")" ::: "memory")
#define PG8_BAR __builtin_amdgcn_s_barrier()
#define PG8_SCHED __builtin_amdgcn_sched_barrier(0)
    Unit cur, nxt; int ui = 0;
    if (!pol.next(0, cur)) return;
    f32x4 acc[2][2][4][2];
#pragma unroll
    for (int a = 0; a < 2; ++a)
#pragma unroll
        for (int b = 0; b < 2; ++b)
#pragma unroll
            for (int m = 0; m < 4; ++m)
#pragma unroll
                for (int n = 0; n < 2; ++n) acc[a][b][m][n] = (f32x4){0.f, 0.f, 0.f, 0.f};
    Frags<P::FP8> fg;
    int slot = 0;
    if (P::META) { pol.meta_issue(cur, 0, lds, wid, lane); PG8_WAIT_V(0); asm volatile("" ::: "memory"); PG8_BAR; asm volatile("" ::: "memory"); }
    unsigned aC[2][2];
    pol.a_off(cur, 0, lds, aC);
    const char* const Ab = (const char*)pol.A;
    const char* cB = pol.b_ptr(cur);
    PG8_STAGE(PG8_SB(0, 0), cB, voffB); PG8_STAGE(PG8_SB(0, 1), cB + hstep, voffB); PG8_STAGE(PG8_SA(0, 0), Ab, aC[0]); PG8_STAGE(PG8_SA(0, 1), Ab, aC[1]);
    if (wr == 1) PG8_BAR;
    PG8_WAIT_V(2); PG8_BAR;
    PG8_STAGE(PG8_SB(1, 0), cB + kstep, voffB); PG8_STAGE(PG8_SA(1, 0), Ab + kstep, aC[0]); PG8_STAGE(PG8_SB(1, 1), cB + hstep + kstep, voffB);
    PG8_WAIT_V(6); PG8_BAR;
    for (;;) {
        const bool has_next = pol.next(ui + 1, nxt);
        const int nslot = slot == 2 ? 0 : slot + 1;
        if (P::META) { if (has_next) pol.meta_issue(nxt, nslot, lds, wid, lane); }
        const char* nB = has_next ? pol.b_ptr(nxt) : cB;
#pragma unroll 1
        for (int t = 0; t < NKT_; t += 2) {
            const bool last = (t == NKT_ - 2);
            const char* a1 = Ab + (size_t)(t + 1) * kstep;
            const char* a2 = last ? Ab : Ab + (size_t)(t + 2) * kstep; const char* b2 = last ? nB : cB + (size_t)(t + 2) * kstep;
            const char* a3 = a2 + kstep; const char* b3 = b2 + kstep;
            PG8_LDB(B0, 0, 0); PG8_LDB(B1, 0, 1); PG8_SCHED; PG8_LDA(At, 0, 0); PG8_STAGE(PG8_SA(1, 1), a1, aC[1]);
            if (last && has_next) pol.a_off(nxt, nslot, lds, aC);
            PG8_WAIT_V(8); PG8_WAIT_L(0); PG8_BAR; PG8_MMA(0, 0, At, B0); PG8_MMA(0, 1, At, B1); PG8_BAR; PG8_SCHED;
            PG8_LDA(At, 0, 1); PG8_STAGE(PG8_SB(0, 0), b2, voffB); PG8_STAGE(PG8_SB(0, 1), b2 + hstep, voffB); PG8_STAGE(PG8_SA(0, 0), a2, aC[0]);
            PG8_WAIT_V(8); PG8_WAIT_L(0); PG8_BAR; PG8_MMA(1, 0, At, B0); PG8_MMA(1, 1, At, B1); PG8_BAR; PG8_SCHED;
            PG8_LDB(B0, 1, 0); PG8_LDB(B1, 1, 1); PG8_SCHED; PG8_LDA(At, 1, 0); PG8_STAGE(PG8_SA(0, 1), a2, aC[1]);
            PG8_WAIT_V(8); PG8_WAIT_L(0); PG8_BAR; PG8_MMA(0, 0, At, B0); PG8_MMA(0, 1, At, B1); PG8_BAR; PG8_SCHED;
            PG8_LDA(At, 1, 1); PG8_STAGE(PG8_SB(1, 0), b3, voffB); PG8_STAGE(PG8_SB(1, 1), b3 + hstep, voffB); PG8_STAGE(PG8_SA(1, 0), a3, aC[0]);
            PG8_WAIT_V(8); PG8_WAIT_L(0); PG8_BAR; PG8_MMA(1, 0, At, B0); PG8_MMA(1, 1, At, B1); PG8_BAR; PG8_SCHED;
        }
        if (wr == 0) PG8_BAR;
#ifdef PROBE_KLOOP2
        const bool do_epi = !(P::FP8 && P::KIND == PROBE_KLOOP2) || (ui & 1);
        if (do_epi) {
            if (P::FP8 && P::KIND == PROBE_KLOOP2) {
#pragma unroll
                for (int a = 0; a < 2; ++a)
#pragma unroll
                    for (int b = 0; b < 2; ++b)
#pragma unroll
                        for (int m = 0; m < 4; ++m)
#pragma unroll
                            for (int n = 0; n < 2; ++n) acc[a][b][m][n] *= 0.5f; }
            pol.epi(acc, cur, slot, lds, wr, wc, fr, fq); }
#else
        constexpr bool do_epi = true;
        pol.epi(acc, cur, slot, lds, wr, wc, fr, fq);
#endif
#ifdef PROBE_EPI2
        if (P::KIND == PROBE_EPI2) { asm volatile("" ::: "memory");
#pragma unroll
            for (int a = 0; a < 2; ++a)
#pragma unroll
                for (int b = 0; b < 2; ++b)
#pragma unroll
                    for (int m = 0; m < 4; ++m)
#pragma unroll
                        for (int n = 0; n < 2; ++n) asm volatile("" : "+v"(acc[a][b][m][n]));
            pol.epi(acc, cur, slot, lds, wr, wc, fr, fq); }
#endif
        if (!has_next) break;
        if (do_epi) {
#pragma unroll
        for (int a = 0; a < 2; ++a)
#pragma unroll
            for (int b = 0; b < 2; ++b)
#pragma unroll
                for (int m = 0; m < 4; ++m)
#pragma unroll
                    for (int n = 0; n < 2; ++n) acc[a][b][m][n] = (f32x4){0.f, 0.f, 0.f, 0.f};
        }
        cur = nxt; cB = nB; ++ui; slot = nslot;
        if (wr == 1) PG8_BAR;
    }
    PG8_WAIT_V(0);
    PG8_BAR;
#undef PG8_SA
#undef PG8_SB
#undef PG8_STAGE
#undef PG8_LDA
#undef PG8_LDB
#undef PG8_MMA
#undef PG8_RD8
#undef PG8_WAIT_V
#undef PG8_WAIT_L
#undef PG8_BAR
#undef PG8_SCHED
}
}

typedef f32x4 AccT[2][2][4][2];

struct PolProj {
    static constexpr bool BMAP16 = false; static constexpr int KIND = 0; static constexpr bool PERM = true, META = false, FP8 = false; static constexpr int SCALE_W = 0x7f7f7f7f;
    const bf16_t* A; const bf16_t* Bt; bf16_t* O; int G, c;
    __device__ __forceinline__ bool next(int i, pg8::Unit& u) const {
        const int L = i * G + c;
        if (L < 640) { pg8::static_tile(L, 64, 10, u.pm, u.pn); return true; }
        if (L < 648) { const int j = L - 640; u.pm = 64 + (j >> 2); u.pn = 2 + (j & 3); return true; }
        return false;
    }
    __device__ __forceinline__ const char* b_ptr(const pg8::Unit& u) const { return (const char*)Bt + (size_t)u.pn * 256 * 1024 * 2; }
    __device__ __forceinline__ void meta_issue(const pg8::Unit&, int, LAS unsigned char*, int, int) const {}
    __device__ __forceinline__ void a_off(const pg8::Unit& u, int, LAS unsigned char*, unsigned (&o)[2][2]) const {
        int Ra[2], Ca[2]; pg8::stage_rc((int)threadIdx.x * 16, Ra[0], Ca[0]); pg8::stage_rc((int)threadIdx.x * 16 + 8192, Ra[1], Ca[1]);
#pragma unroll
        for (int h = 0; h < 2; ++h)
#pragma unroll
            for (int i = 0; i < 2; ++i) o[h][i] = (unsigned)((u.pm * 256 + 128 * h + Ra[i]) * 1024 + Ca[i]) * 2u;
    }
    __device__ __forceinline__ void epi(const AccT& acc, const pg8::Unit& u, int, LAS unsigned char*, int wr, int wc, int fr, int fq) const {
        const int row0 = u.pm * 256 + wr * 64 + fr, col0 = u.pn * 256 + wc * 32 + 8 * fq;
        const bool act = u.pn >= 6;
#pragma unroll
        for (int ai = 0; ai < 2; ++ai)
#pragma unroll
            for (int m = 0; m < 4; ++m) { bf16_t* rowp = O + (size_t)(row0 + ai * 128 + m * 16) * DIN + col0;
#pragma unroll
                for (int bj = 0; bj < 2; ++bj) { f32x4 v0 = acc[ai][bj][m][0], v1 = acc[ai][bj][m][1];
                    if (act) {
#pragma unroll
                        for (int j = 0; j < 4; ++j) { v0[j] = gelu_fast(v0[j]); v1[j] = gelu_fast(v1[j]); } }
                    u32x4 w; w.x = cvt_pk_bf16(v0[0], v0[1]); w.y = cvt_pk_bf16(v0[2], v0[3]); w.z = cvt_pk_bf16(v1[0], v1[1]); w.w = cvt_pk_bf16(v1[2], v1[3]);
                    store16_sc1(rowp + bj * 128, w); } }
    }
};

struct PolOut {
    static constexpr bool BMAP16 = false; static constexpr int KIND = 0; static constexpr bool PERM = true, META = false, FP8 = false; static constexpr int SCALE_W = 0x7f7f7f7f;
    const bf16_t* A; const bf16_t* Bt; const float* x; const float* mod; bf16_t* Y; int G, c;
    __device__ __forceinline__ bool next(int i, pg8::Unit& u) const { const int L = i * G + c; if (L >= 256) return false; pg8::static_tile(L, 64, 4, u.pm, u.pn); return true; }
    __device__ __forceinline__ const char* b_ptr(const pg8::Unit& u) const { return (const char*)Bt + (size_t)u.pn * 256 * 1024 * 2; }
    __device__ __forceinline__ void meta_issue(const pg8::Unit&, int, LAS unsigned char*, int, int) const {}
    __device__ __forceinline__ void a_off(const pg8::Unit& u, int, LAS unsigned char*, unsigned (&o)[2][2]) const {
        int Ra[2], Ca[2]; pg8::stage_rc((int)threadIdx.x * 16, Ra[0], Ca[0]); pg8::stage_rc((int)threadIdx.x * 16 + 8192, Ra[1], Ca[1]);
#pragma unroll
        for (int h = 0; h < 2; ++h)
#pragma unroll
            for (int i = 0; i < 2; ++i) o[h][i] = (unsigned)((u.pm * 256 + 128 * h + Ra[i]) * 1024 + Ca[i]) * 2u;
    }
    __device__ __forceinline__ void epi(const AccT& acc, const pg8::Unit& u, int, LAS unsigned char*, int wr, int wc, int fr, int fq) const {
        const int row0 = u.pm * 256 + wr * 64 + fr, col0 = u.pn * 256 + wc * 32 + 8 * fq;
        const float* g1 = mod + (u.pm >= 32 ? 6144 : 0) + 2 * 1024;
        f32x4 gv[2][2];
#pragma unroll
        for (int bj = 0; bj < 2; ++bj)
#pragma unroll
            for (int n = 0; n < 2; ++n) gv[bj][n] = *(const f32x4*)(g1 + col0 + bj * 128 + 4 * n);
#pragma unroll
        for (int ai = 0; ai < 2; ++ai)
#pragma unroll
            for (int m = 0; m < 4; ++m) { const size_t off = (size_t)(row0 + ai * 128 + m * 16) * D + col0;
#pragma unroll
                for (int bj = 0; bj < 2; ++bj) { const f32x4 x0 = __builtin_nontemporal_load((const f32x4*)(x + off + bj * 128)), x1v = __builtin_nontemporal_load((const f32x4*)(x + off + bj * 128 + 4));
                    const f32x4 v0 = x0 * DN_ALPHA + gv[bj][0] * acc[ai][bj][m][0], v1 = x1v * DN_ALPHA + gv[bj][1] * acc[ai][bj][m][1];
                    u32x4 w; w.x = cvt_pk_bf16(v0[0], v0[1]); w.y = cvt_pk_bf16(v0[2], v0[3]); w.z = cvt_pk_bf16(v1[0], v1[1]); w.w = cvt_pk_bf16(v1[2], v1[3]);
                    *(u32x4*)(Y + off + bj * 128) = w; }
                asm volatile("" ::: "memory"); }
    }
};

struct ExpTab { const LAS int* tile_e; const LAS int* tstart; const LAS int* cnt; int T; };
__device__ __forceinline__ int expert_tables(Frame& F) {
    LAS int* tile_e = (LAS int*)(F.lds + L_TILEE); LAS int* tstart = (LAS int*)(F.lds + L_TSTART); LAS int* cn = tstart + 64;
    if (F.tid < 32) cn[F.tid] = (int)__hip_atomic_load(F.ctl + CW_CNT + 32 * F.tid, __ATOMIC_RELAXED, __HIP_MEMORY_SCOPE_AGENT);
    __syncthreads();
    if (F.tid == 0) { int run = 0; for (int e = 0; e < NE; ++e) { tstart[e] = run; run += (cn[e] + 255) >> 8; } tstart[NE] = run; }
    __syncthreads();
    const int T = tstart[NE];
    if (F.tid < MAXT && F.tid < T) { int e = 0; while (e < NE - 1 && tstart[e + 1] <= F.tid) ++e; tile_e[F.tid] = e; }
    __syncthreads();
    return T < MAXT ? T : MAXT;
}
__device__ __forceinline__ int rfl(int v) { return __builtin_amdgcn_readfirstlane(v); }

struct PolGU {
    static constexpr bool BMAP16 = false; static constexpr int KIND = 1; static constexpr bool PERM = true, META = true, FP8 = true; static constexpr int SCALE_W = 0; static constexpr float WSC = 1.f / 64.f;
    const unsigned char* A; const unsigned char* Bt; const float* bias; const int* list; unsigned char* O; ExpTab tb; int G, c;
    __device__ __forceinline__ bool next(int i, pg8::Unit& u) const {
#if defined(PROBE_KLOOP2) && PROBE_KLOOP2 == 1
        const int L = (i >> 1) * G + c; if (L >= tb.T * 8) return false;
#else
        const int L = i * G + c; if (L >= tb.T * 8) return false;
#endif
        u.ti = L >> 3; u.pn = L & 7; u.e = rfl(tb.tile_e[u.ti]); u.pm = u.ti - rfl(tb.tstart[u.e]);
        const int rem = rfl(tb.cnt[u.e]) - u.pm * 256; u.nvalid = rem < 256 ? rem : 256; return true;
    }
    __device__ __forceinline__ const char* b_ptr(const pg8::Unit& u) const { return (const char*)Bt + ((size_t)u.e * 2048 + (size_t)u.pn * 256) * 1024; }
    __device__ __forceinline__ void meta_issue(const pg8::Unit& u, int slot, LAS unsigned char* lds, int wid, int lane) const {
        if (wid < 4) __builtin_amdgcn_global_load_lds((const unsigned*)(list + (size_t)u.e * LCAP + u.pm * 256 + wid * 64 + lane), (LAS unsigned*)(lds + L_IDX + slot * 2048 + wid * 256), 4, 0, 0);
    }
    __device__ __forceinline__ void a_off(const pg8::Unit& u, int slot, LAS unsigned char* lds, unsigned (&o)[2][2]) const {
        int Ra[2], Ca[2]; pg8::stage_rc((int)threadIdx.x * 16, Ra[0], Ca[0]); pg8::stage_rc((int)threadIdx.x * 16 + 8192, Ra[1], Ca[1]);
        const LAS int* idx = (const LAS int*)(lds + L_IDX + slot * 2048);
#pragma unroll
        for (int h = 0; h < 2; ++h)
#pragma unroll
            for (int i = 0; i < 2; ++i) { const int r = 128 * h + Ra[i]; int pr = idx[r]; pr = r < u.nvalid ? pr : 0; o[h][i] = (unsigned)((pr >> 2) * 1024 + Ca[i] * 2); }
    }
    __device__ __forceinline__ void epi(const AccT& acc, const pg8::Unit& u, int, LAS unsigned char*, int wr, int wc, int fr, int fq) const {
        const int row0 = u.ti * 256 + wr * 64 + fr, col0 = u.pn * 128 + wc * 32 + 8 * fq;
        const float* bg = bias + (size_t)u.e * 2048 + col0;
        const f32x4 g0 = *(const f32x4*)(bg), g1 = *(const f32x4*)(bg + 4), l0 = *(const f32x4*)(bg + 1024) + 1.f, l1 = *(const f32x4*)(bg + 1028) + 1.f;
#pragma unroll
        for (int ai = 0; ai < 2; ++ai)
#pragma unroll
            for (int m = 0; m < 4; ++m) {
                f32x4 r0, r1;
#pragma unroll
                for (int hp = 0; hp < 2; ++hp) {
                    const f32x2 ga0 = (f32x2){acc[ai][0][m][0][2 * hp], acc[ai][0][m][0][2 * hp + 1]} * WSC + (f32x2){g0[2 * hp], g0[2 * hp + 1]};
                    const f32x2 ga1 = (f32x2){acc[ai][0][m][1][2 * hp], acc[ai][0][m][1][2 * hp + 1]} * WSC + (f32x2){g1[2 * hp], g1[2 * hp + 1]};
                    const f32x2 lb0 = (f32x2){acc[ai][1][m][0][2 * hp], acc[ai][1][m][0][2 * hp + 1]} * WSC + (f32x2){l0[2 * hp], l0[2 * hp + 1]};
                    const f32x2 lb1 = (f32x2){acc[ai][1][m][1][2 * hp], acc[ai][1][m][1][2 * hp + 1]} * WSC + (f32x2){l1[2 * hp], l1[2 * hp + 1]};
                    f32x2 gg0, gg1, ll0, ll1, e0, e1;
                    gg0[0] = fminf(ga0[0], 7.f); gg0[1] = fminf(ga0[1], 7.f); gg1[0] = fminf(ga1[0], 7.f); gg1[1] = fminf(ga1[1], 7.f);
                    ll0[0] = __builtin_amdgcn_fmed3f(lb0[0], -6.f, 8.f); ll0[1] = __builtin_amdgcn_fmed3f(lb0[1], -6.f, 8.f); ll1[0] = __builtin_amdgcn_fmed3f(lb1[0], -6.f, 8.f); ll1[1] = __builtin_amdgcn_fmed3f(lb1[1], -6.f, 8.f);
                    const f32x2 x0 = gg0 * -2.45546696f, x1 = gg1 * -2.45546696f;
                    e0[0] = __builtin_amdgcn_exp2f(x0[0]); e0[1] = __builtin_amdgcn_exp2f(x0[1]); e1[0] = __builtin_amdgcn_exp2f(x1[0]); e1[1] = __builtin_amdgcn_exp2f(x1[1]);
                    const f32x2 d0 = e0 + 1.f, d1 = e1 + 1.f;
                    f32x2 q0, q1; q0[0] = __builtin_amdgcn_rcpf(d0[0]); q0[1] = __builtin_amdgcn_rcpf(d0[1]); q1[0] = __builtin_amdgcn_rcpf(d1[0]); q1[1] = __builtin_amdgcn_rcpf(d1[1]);
                    const f32x2 o0 = (ll0 * gg0) * q0, o1 = (ll1 * gg1) * q1;
                    r0[2 * hp] = o0[0]; r0[2 * hp + 1] = o0[1]; r1[2 * hp] = o1[0]; r1[2 * hp + 1] = o1[1];
                }
                u32x2 w; w.x = (unsigned)__builtin_amdgcn_cvt_pk_fp8_f32(r0[2], r0[3], __builtin_amdgcn_cvt_pk_fp8_f32(r0[0], r0[1], 0, false), true);
                w.y = (unsigned)__builtin_amdgcn_cvt_pk_fp8_f32(r1[2], r1[3], __builtin_amdgcn_cvt_pk_fp8_f32(r1[0], r1[1], 0, false), true);
                *(u32x2*)(O + (size_t)(row0 + ai * 128 + m * 16) * DFF + col0) = w; }
    }
};

struct PolDN {
    static constexpr float YSC = 16.f; static constexpr bool BMAP16 = true; static constexpr int KIND = 2; static constexpr bool PERM = true, META = true, FP8 = true; static constexpr int SCALE_W = 0; static constexpr float WSC = 1.f / 64.f;
    const unsigned char* A; const unsigned char* Bt; const float* bias; const int* list; const float* listg; unsigned char* O; ExpTab tb; int G, c;
    __device__ __forceinline__ bool next(int i, pg8::Unit& u) const {
#if defined(PROBE_KLOOP2) && PROBE_KLOOP2 == 2
        const int L = (i >> 1) * G + c; if (L >= tb.T * 4) return false;
#else
        const int L = i * G + c; if (L >= tb.T * 4) return false;
#endif
        u.ti = L >> 2; u.pn = L & 3; u.e = rfl(tb.tile_e[u.ti]); u.pm = u.ti - rfl(tb.tstart[u.e]);
        const int rem = rfl(tb.cnt[u.e]) - u.pm * 256; u.nvalid = rem < 256 ? rem : 256; return true;
    }
    __device__ __forceinline__ const char* b_ptr(const pg8::Unit& u) const { return (const char*)Bt + ((size_t)u.e * 1024 + (size_t)u.pn * 256) * 1024; }
    __device__ __forceinline__ void meta_issue(const pg8::Unit& u, int slot, LAS unsigned char* lds, int wid, int lane) const {
        if (wid < 4) __builtin_amdgcn_global_load_lds((const unsigned*)(list + (size_t)u.e * LCAP + u.pm * 256 + wid * 64 + lane), (LAS unsigned*)(lds + L_IDX + slot * 2048 + wid * 256), 4, 0, 0);
        else __builtin_amdgcn_global_load_lds((const unsigned*)(listg + (size_t)u.e * LCAP + u.pm * 256 + (wid - 4) * 64 + lane), (LAS unsigned*)(lds + L_IDX + slot * 2048 + 1024 + (wid - 4) * 256), 4, 0, 0);
    }
    __device__ __forceinline__ void a_off(const pg8::Unit& u, int, LAS unsigned char*, unsigned (&o)[2][2]) const {
        int Ra[2], Ca[2]; pg8::stage_rc((int)threadIdx.x * 16, Ra[0], Ca[0]); pg8::stage_rc((int)threadIdx.x * 16 + 8192, Ra[1], Ca[1]);
#pragma unroll
        for (int h = 0; h < 2; ++h)
#pragma unroll
            for (int i = 0; i < 2; ++i) o[h][i] = (unsigned)((u.ti * 256 + 128 * h + Ra[i]) * 1024 + Ca[i] * 2);
    }
    __device__ __forceinline__ void epi(const AccT& acc, const pg8::Unit& u, int slot, LAS unsigned char* lds, int wr, int wc, int fr, int fq) const {
        const LAS int* idx = (const LAS int*)(lds + L_IDX + slot * 2048);
        const int col0 = u.pn * 256 + wc * 64 + 16 * fq;
        const float* bd = bias + (size_t)u.e * 1024 + col0;
        f32x4 bv[2][2];
#pragma unroll
        for (int bj = 0; bj < 2; ++bj)
#pragma unroll
            for (int n = 0; n < 2; ++n) bv[bj][n] = *(const f32x4*)(bd + 8 * bj + 4 * n);
#pragma unroll
        for (int ai = 0; ai < 2; ++ai)
#pragma unroll
            for (int m = 0; m < 4; ++m) { const int r = ai * 128 + wr * 64 + m * 16 + fr;
                if (r < u.nvalid) { const int pr = idx[r]; const float gt = ((const LAS float*)idx)[256 + r] * YSC;
                    u32x4 w;
#pragma unroll
                    for (int bj = 0; bj < 2; ++bj) { const f32x4 v0 = (acc[ai][bj][m][0] * WSC + bv[bj][0]) * gt, v1 = (acc[ai][bj][m][1] * WSC + bv[bj][1]) * gt;
                        w[2 * bj] = pk4_fp8(v0[0], v0[1], v0[2], v0[3]); w[2 * bj + 1] = pk4_fp8(v1[0], v1[1], v1[2], v1[3]); }
                    __builtin_nontemporal_store(w, (u32x4*)(O + (size_t)pr * D + col0)); } }
    }
};

__device__ __forceinline__ void p_ada(Frame& F) {
    LAS float* sl = (LAS float*)F.lds;
    LAS float* red = sl + 3072;
    for (int i = F.tid; i < 3072; i += 512) { const int w = i >> 10, k = i & 1023; const float v = w < 2 ? F.c[w * D + k] : F.c_ctx[k]; sl[i] = v / (1.f + __expf(-v)); }
    __syncthreads();
    for (int slab = blockIdx.x; slab < 256; slab += F.G) {
        const int j0 = slab * 24, cg = F.tid % 6, kr = F.tid / 6;
        float a[3][4] = {};
        if (F.tid < 480) {
            for (int k = kr; k < D; k += 80) {
                const f32x4 w4 = __builtin_nontemporal_load((const f32x4*)(F.ada_w + (size_t)k * 6144 + j0 + 4 * cg));
                const float s0 = sl[k], s1 = sl[1024 + k], s2 = sl[2048 + k];
#pragma unroll
                for (int q = 0; q < 4; ++q) { a[0][q] += s0 * w4[q]; a[1][q] += s1 * w4[q]; a[2][q] += s2 * w4[q]; }
            }
#pragma unroll
            for (int w = 0; w < 3; ++w)
#pragma unroll
                for (int q = 0; q < 4; ++q) red[kr * 72 + cg * 12 + w * 4 + q] = a[w][q];
        }
        __syncthreads();
        if (F.tid < 72) {
            float s = 0.f;
            for (int r = 0; r < 80; ++r) s += red[r * 72 + F.tid];
            const int g = F.tid / 12, w = (F.tid % 12) >> 2, q = F.tid & 3, col = j0 + 4 * g + q;
            F.mod[w * 6144 + col] = s + F.ada_b[col];
        }
        __syncthreads();
    }
}

__device__ __forceinline__ void transpose_item(const float* W, int K, int N, bf16_t* WT, int item, bool gu_map, LAS float* scr, int lane) {
    const int nblk = N / 32, kb = item / nblk, nb = item % nblk, k0 = 64 * kb, n0 = 32 * nb;
#pragma unroll 8
    for (int i = 0; i < 32; ++i) { const int kk = 2 * i + (lane >> 5); scr[kk * 33 + (lane & 31)] = __builtin_nontemporal_load(W + (size_t)(k0 + kk) * N + n0 + (lane & 31)); }
    LDS_WAIT(); asm volatile("" ::: "memory");
    int d0 = n0;
    if (gu_map) { const int nn = n0 & 1023; d0 = (nn >> 7) * 256 + (nn & 127) + ((n0 >> 10) ? 128 : 0); }
    const int c = lane & 7;
#pragma unroll
    for (int j = 0; j < 4; ++j) { const int n = (lane >> 3) + 8 * j; const LAS float* s = scr + (8 * c) * 33 + n;
        u32x4 o; o.x = pk2(s[0 * 33], s[1 * 33]); o.y = pk2(s[2 * 33], s[3 * 33]); o.z = pk2(s[4 * 33], s[5 * 33]); o.w = pk2(s[6 * 33], s[7 * 33]);
        *(u32x4*)(WT + (size_t)(d0 + n) * K + k0 + 8 * c) = o; }
    LDS_WAIT(); asm volatile("" ::: "memory");
}
__device__ __forceinline__ void transpose_item8(const float* W, int K, int N, unsigned char* WT, int item, bool gu_map, LAS float* scr, int lane) {
    const int nblk = N / 32, kb = item / nblk, nb = item % nblk, k0 = 64 * kb, n0 = 32 * nb;
#pragma unroll 8
    for (int i = 0; i < 32; ++i) { const int kk = 2 * i + (lane >> 5); scr[kk * 33 + (lane & 31)] = __builtin_nontemporal_load(W + (size_t)(k0 + kk) * N + n0 + (lane & 31)); }
    LDS_WAIT(); asm volatile("" ::: "memory");
    int d0 = n0;
    if (gu_map) { const int nn = n0 & 1023; d0 = (nn >> 7) * 256 + (nn & 127) + ((n0 >> 10) ? 128 : 0); }
    const int c = lane & 7;
#pragma unroll
    for (int j = 0; j < 4; ++j) { const int n = (lane >> 3) + 8 * j; const LAS float* s = scr + (8 * c) * 33 + n;
        u32x2 o; o.x = pk4_fp8(s[0 * 33] * 64.f, s[1 * 33] * 64.f, s[2 * 33] * 64.f, s[3 * 33] * 64.f); o.y = pk4_fp8(s[4 * 33] * 64.f, s[5 * 33] * 64.f, s[6 * 33] * 64.f, s[7 * 33] * 64.f);
        __builtin_nontemporal_store(o, (u32x2*)(WT + (size_t)(d0 + n) * K + k0 + 8 * c)); }
    LDS_WAIT(); asm volatile("" ::: "memory");
}
__device__ __forceinline__ void p_weights(Frame& F, int it_lo, int n_items, int gw, int NGW, bool with_sgu) {
    LAS float* scr = (LAS float*)(F.lds + F.wave * 16384);
    constexpr int I_IN = 16 * 80, I_OUT = 16 * 32, I_GU = 16 * 64, I_DN = 16 * 32;
    constexpr int NITEMS = I_IN + I_OUT + NE * I_GU + NE * I_DN;
    for (int it0 = gw; it0 < n_items; it0 += NGW) {
        const int it = it_lo + it0; int r = it;
        if (r < I_IN) { transpose_item(F.w_in, D, DIN, F.Wt_in, r, false, scr, F.lane); continue; } r -= I_IN;
        if (r < I_OUT) { transpose_item(F.w_out, D, D, F.Wt_out, r, false, scr, F.lane); continue; } r -= I_OUT;
        if (r < NE * I_GU) { const int e = r / I_GU; transpose_item8(F.w_gu + (size_t)e * D * 2048, D, 2048, F.Wt_gu + (size_t)e * 2048 * D, r % I_GU, true, scr, F.lane); continue; } r -= NE * I_GU;
        { const int e = r / I_DN; transpose_item8(F.w_dn + (size_t)e * DFF * D, DFF, D, F.Wt_dn + (size_t)e * D * DFF, r % I_DN, false, scr, F.lane); }
    }
    if (with_sgu) for (int i = (blockIdx.x * 512 + F.tid) * 4; i < 4 * 128 * 128; i += F.G * 512 * 4) {
        const f32x4 v = *(const f32x4*)(F.sgu_w + i); u32x2 o; o.x = pk2(v[0], v[1]); o.y = pk2(v[2], v[3]); *(u32x2*)(F.sguw + i) = o; }
}
__device__ __forceinline__ void p_lnmod(Frame& F) {
    const int gw = F.vcu * 8 + F.wave, NGW = F.G * 8;
    for (int row = gw; row < MX; row += NGW) {
        const float* xr; const float* md;
        if (row < M) { xr = F.x + (size_t)row * D; md = F.mod + (row >> 13) * 6144; } else { xr = F.ctx + (size_t)(row - M) * D; md = F.mod + 2 * 6144; }
        const f32x4* xp = (const f32x4*)xr + F.lane;
        f32x4 v[4]; float s = 0.f;
#pragma unroll
        for (int j = 0; j < 4; ++j) { v[j] = __builtin_nontemporal_load(xp + 64 * j); s += (v[j][0] + v[j][1]) + (v[j][2] + v[j][3]); }
        const float mean = wsum(s) * (1.f / D); float q = 0.f;
#pragma unroll
        for (int j = 0; j < 4; ++j) { v[j] = v[j] - mean; q += (v[j][0] * v[j][0] + v[j][1] * v[j][1]) + (v[j][2] * v[j][2] + v[j][3] * v[j][3]); }
        const float rstd = rsqrtf(wsum(q) * (1.f / D) + EPS);
        u32x2* op = (u32x2*)(F.hxc + (size_t)row * D) + F.lane;
#pragma unroll
        for (int j = 0; j < 4; ++j) { const f32x4 sh = *((const f32x4*)md + F.lane + 64 * j), sc = *((const f32x4*)(md + 1024) + F.lane + 64 * j);
            const f32x4 o = v[j] * rstd * (sc + 1.f) + sh; u32x2 w; w.x = pk2(o[0], o[1]); w.y = pk2(o[2], o[3]); op[64 * j] = w; }
    }
}

__device__ __forceinline__ void p_attn_simple(Frame& F) {
    LAS float* sq = (LAS float*)(F.lds + F.wave * 4096);
    LAS float* sp = sq + 64;
    const int gw = F.vcu * 8 + F.wave, NGW = F.G * 8;
    for (int gid = gw; gid < M * NH; gid += NGW) {
        const int h = gid & 7, tok = gid >> 3, b = tok >> 13, t = tok & (S - 1), r = t >> 6, c = t & 63;
        const int rs = min(max(r - KH / 2, 0), ROWS - KH), cs = min(max(c - KW / 2, 0), GW - KW);
        sq[F.lane] = bf2f(F.proj[(size_t)tok * DIN + h * 64 + F.lane]);
        LDS_WAIT(); asm volatile("" ::: "memory");
        float sc[6]; float mx = -1e30f;
#pragma unroll
        for (int i = 0; i < 6; ++i) {
            const int kk = F.lane + 64 * i;
            const bf16_t* kp; float bias = 0.f;
            if (kk < 128) { const int ki = kk >> 4, kj = kk & 15;
                kp = F.proj + (size_t)(b * S + (rs + ki) * GW + cs + kj) * DIN + 512 + h * 64;
                bias = F.rpb[(h * 15 + (rs + ki - r + 7)) * 31 + (cs + kj - c + 15)];
            } else kp = F.proj + (size_t)(M + b * CTX + (kk - 128)) * DIN + 512 + h * 64;
            float d = 0.f;
#pragma unroll
            for (int dd = 0; dd < 64; dd += 8) { const u32x4 kv = *(const u32x4*)(kp + dd);
                d += sq[dd] * bflo(kv.x) + sq[dd + 1] * bfhi(kv.x) + sq[dd + 2] * bflo(kv.y) + sq[dd + 3] * bfhi(kv.y) + sq[dd + 4] * bflo(kv.z) + sq[dd + 5] * bfhi(kv.z) + sq[dd + 6] * bflo(kv.w) + sq[dd + 7] * bfhi(kv.w); }
            sc[i] = d * 0.125f + bias; mx = fmaxf(mx, sc[i]);
        }
        mx = wmax(mx);
        float sum = 0.f;
#pragma unroll
        for (int i = 0; i < 6; ++i) { const float p = __expf(sc[i] - mx); sum += p; sp[F.lane + 64 * i] = p; }
        sum = wsum(sum);
        LDS_WAIT(); asm volatile("" ::: "memory");
        float acc = 0.f;
        for (int kk = 0; kk < 384; ++kk) {
            const bf16_t* vp;
            if (kk < 128) { const int ki = kk >> 4, kj = kk & 15; vp = F.proj + (size_t)(b * S + (rs + ki) * GW + cs + kj) * DIN + 1024 + h * 64; }
            else vp = F.proj + (size_t)(M + b * CTX + (kk - 128)) * DIN + 1024 + h * 64;
            acc += sp[kk] * bf2f(vp[F.lane]);
        }
        F.mixin[(size_t)tok * D + h * 64 + F.lane] = (bf16_t)f2bf(acc / sum);
        LDS_WAIT(); asm volatile("" ::: "memory");
    }
}
__device__ __forceinline__ void p_sgu_simple(Frame& F) {
    LAS bf16_t* G = (LAS bf16_t*)F.lds;
    for (int u = blockIdx.x; u < M / 128; u += F.G) {
        const int base = u * 128;
        for (int tl = F.wave; tl < 128; tl += 8) {
            const bf16_t* zr = F.proj + (size_t)(base + tl) * DIN + 2048 + F.lane * 8;
            const u32x4 zv = *(const u32x4*)zr;
            float v[8] = {bflo(zv.x), bfhi(zv.x), bflo(zv.y), bfhi(zv.y), bflo(zv.z), bfhi(zv.z), bflo(zv.w), bfhi(zv.w)};
            float s = 0.f;
#pragma unroll
            for (int i = 0; i < 8; ++i) s += v[i];
            const float mean = wsum(s) * (1.f / 512.f); float q = 0.f;
#pragma unroll
            for (int i = 0; i < 8; ++i) { v[i] -= mean; q += v[i] * v[i]; }
            const float rstd = rsqrtf(wsum(q) * (1.f / 512.f) + EPS);
#pragma unroll
            for (int i = 0; i < 8; ++i) { const int ch = F.lane * 8 + i; G[tl * 512 + ch] = (bf16_t)f2bf(v[i] * rstd * F.sgu_ln_g[ch] + F.sgu_ln_b[ch]); }
        }
        __syncthreads();
        const int ch = F.tid, grp = ch >> 7;
        for (int i = 0; i < 128; ++i) {
            const float* wrow = F.sgu_w + (size_t)(grp * 128 + i) * 128;
            float acc = 0.f;
            for (int j = 0; j < 128; ++j) acc += wrow[j] * bf2f(G[j * 512 + ch]);
            acc += F.sgu_b[grp * 128 + i];
            const float uu = bf2f(F.proj[(size_t)(base + i) * DIN + 1536 + ch]);
            F.mixin[(size_t)(base + i) * D + 512 + ch] = (bf16_t)f2bf(uu * acc);
        }
        __syncthreads();
    }
}

namespace at {
typedef float f32x16 __attribute__((ext_vector_type(16)));
typedef short s16x4 __attribute__((ext_vector_type(4)));
typedef short v4i16_t __attribute__((ext_vector_type(4)));
constexpr int A_K = 0, A_V = 32768, A_STG = 65536, A_WSF = 98304, A_RPB = 100352;
constexpr float C2 = 0.125f * 1.4426950408889634f, L2E = 1.4426950408889634f;
__device__ __forceinline__ int crow(int r, int hi) { return (r & 3) + 8 * (r >> 2) + 4 * hi; }
__device__ __forceinline__ s16x4 vtr(const LAS unsigned char* p) { return __builtin_bit_cast(s16x4, __builtin_amdgcn_ds_read_tr16_b64_v4i16((LAS v4i16_t*)p)); }
__device__ __forceinline__ int rsf(int r) { return min(max(r - KH / 2, 0), ROWS - KH); }
#define AT_WAIT_BAR() asm volatile("s_waitcnt vmcnt(0) lgkmcnt(0)\n\ts_barrier" ::: "memory")
__device__ __forceinline__ void glds16(const void* gsrc, unsigned lds_dst) { unsigned keep;
    asm volatile("s_mov_b32 %0, m0\n\ts_mov_b32 m0, %2\n\ts_nop 0\n\tglobal_load_lds_dwordx4 %1, off\n\ts_mov_b32 m0, %0" : "=&s"(keep) : "v"(gsrc), "s"(lds_dst) : "memory"); }

template <int MODE> __device__ __forceinline__ constexpr bool act0(int rr) { return MODE != 2 || rr >= 12; }
template <int MODE> __device__ __forceinline__ constexpr bool act1(int rr) { return MODE != 1 || rr < 4; }
template <int MODE>
__device__ __forceinline__ void tile_compute(const LAS unsigned char* kp0, const LAS unsigned char* vp, const LAS float* tb, const bf16x8 (&qr)[4], f32x16 (&o)[2], float& m, float& l,
                                             LAS float* wsf, int r32, int hi, int cs) {
    f32x16 p0, p1;
#pragma unroll
    for (int i = 0; i < 16; ++i) { p0[i] = 0.f; p1[i] = 0.f; }
#pragma unroll
    for (int d0 = 0; d0 < 4; ++d0) {
        const bf16x8 b0 = *(const LAS bf16x8*)(kp0 + d0 * 2048), b1 = *(const LAS bf16x8*)(kp0 + d0 * 2048 + 512);
        p0 = __builtin_amdgcn_mfma_f32_32x32x16_bf16(b0, qr[d0], p0, 0, 0, 0);
        p1 = __builtin_amdgcn_mfma_f32_32x32x16_bf16(b1, qr[d0], p1, 0, 0, 0);
    }
    float tm = -INFINITY;
#pragma unroll
    for (int rr = 0; rr < 16; ++rr) { const int ko = (rr & 3) + 8 * (rr >> 2), kc = ko + 4 * hi;
        if (MODE == 0) { p0[rr] *= C2; p1[rr] *= C2; tm = fmaxf(tm, fmaxf(p0[rr], p1[rr])); }
        else {
            if (act0<MODE>(rr)) { const float t0 = p0[rr] * C2 + tb[ko]; p0[rr] = (unsigned)(kc - cs) < (unsigned)KW ? t0 : -INFINITY; tm = fmaxf(tm, p0[rr]); }
            if (act1<MODE>(rr)) { const float t1 = p1[rr] * C2 + tb[ko + 32]; p1[rr] = (unsigned)(kc + 32 - cs) < (unsigned)KW ? t1 : -INFINITY; tm = fmaxf(tm, p1[rr]); }
        } }
    { float a = tm, bq = tm; asm volatile("s_nop 1\n\tv_permlane32_swap_b32 %0, %1" : "+v"(a), "+v"(bq)); tm = fmaxf(a, bq); }
    const float mn = fmaxf(m, tm), alpha = __builtin_amdgcn_exp2f(m - mn);
    float rsum = 0.f;
#pragma unroll
    for (int rr = 0; rr < 16; ++rr) {
        if (act0<MODE>(rr)) { p0[rr] = __builtin_amdgcn_exp2f(p0[rr] - mn); rsum += p0[rr]; } else p0[rr] = 0.f;
        if (act1<MODE>(rr)) { p1[rr] = __builtin_amdgcn_exp2f(p1[rr] - mn); rsum += p1[rr]; } else p1[rr] = 0.f; }
    l = l * alpha + rsum; m = mn;
    if (__any(alpha != 1.f)) {
        if (hi == 0) wsf[r32] = alpha;
        LDS_WAIT();
#pragma unroll
        for (int rr = 0; rr < 16; ++rr) { const float a = wsf[crow(rr, hi)]; o[0][rr] *= a; o[1][rr] *= a; }
        LDS_WAIT();
    }
    u32x4 pw[4];
#pragma unroll
    for (int q = 0; q < 4; ++q) { pw[0][q] = cvt_pk_bf16(p0[2 * q], p0[2 * q + 1]); pw[1][q] = cvt_pk_bf16(p0[8 + 2 * q], p0[9 + 2 * q]);
                                  pw[2][q] = cvt_pk_bf16(p1[2 * q], p1[2 * q + 1]); pw[3][q] = cvt_pk_bf16(p1[8 + 2 * q], p1[9 + 2 * q]); }
#pragma unroll
    for (int d0 = 0; d0 < 2; ++d0)
#pragma unroll
        for (int ks = 0; ks < 4; ++ks) {
            if ((MODE == 1 && ks == 3) || (MODE == 2 && ks == 0)) continue;
            const s16x4 lo = vtr(vp + d0 * 4096 + ks * 1024), hh = vtr(vp + d0 * 4096 + ks * 1024 + 512);
            const bf16x8 vf = (bf16x8){lo[0], lo[1], lo[2], lo[3], hh[0], hh[1], hh[2], hh[3]};
            o[d0] = __builtin_amdgcn_mfma_f32_32x32x16_bf16(__builtin_bit_cast(bf16x8, pw[ks]), vf, o[d0], 0, 0, 0);
        }
}

__device__ __forceinline__ void attn_unit(Frame& F, int b, int h, int rg) {
    const int lane = F.lane, r32 = lane & 31, hi = lane >> 5, w = F.wave;
    const int r0 = 4 * rg, r = r0 + (w >> 1), c = 32 * (w & 1) + r32;
    const int krlo = rsf(r0), nnb = rsf(r0 + 3) + 7 - krlo + 1, nst = nnb + 4;
    const int rsw = rsf(r), cs = min(max(c - KW / 2, 0), GW - KW);
    LAS float* tbl = (LAS float*)(F.lds + A_RPB);
    LAS float* wsf = (LAS float*)(F.lds + A_WSF) + w * 64;
    for (int i = F.tid; i < 480; i += 512) { const int dr = i >> 5, dc = i & 31; tbl[64 + i] = dc < 31 ? F.rpb[(h * 15 + dr) * 31 + dc] * L2E : 0.f; }
    const bf16_t* qp = F.proj + (size_t)(b * S + r * GW + c) * DIN + h * 64 + hi * 8;
    bf16x8 qr[4];
#pragma unroll
    for (int d0 = 0; d0 < 4; ++d0) qr[d0] = *(const bf16x8*)(qp + d0 * 16);
    const bf16_t* kbase = F.proj + 512 + h * 64 + w * 8;
    const bf16_t* vbase = F.proj + 1024 + h * 64 + (w >> 2) * 32 + (lane & 3) * 8;
#define AT_DMA(st) do { const int _t0 = (st) < nnb ? b * S + (krlo + (st)) * GW : M + b * CTX + ((st) - nnb) * 64; const int _bf = ((st) & 3) * 8192; \
        __builtin_amdgcn_global_load_lds((const unsigned*)(kbase + (size_t)(_t0 + lane) * DIN), (LAS unsigned*)(F.lds + A_K + _bf + w * 1024), 16, 0, 0); \
        __builtin_amdgcn_global_load_lds((const unsigned*)(vbase + (size_t)(_t0 + 16 * (w & 3) + (lane >> 2)) * DIN), (LAS unsigned*)(F.lds + A_V + _bf + w * 1024), 16, 0, 0); } while (0)
    const unsigned lds0 = (unsigned)(size_t)F.lds;
    float m = -1e30f, l = 0.f;
    f32x16 o[2];
#pragma unroll
    for (int i = 0; i < 16; ++i) { o[0][i] = 0.f; o[1][i] = 0.f; }
    AT_DMA(0); AT_DMA(1); AT_DMA(2);
    for (int st = 0; st < nst; ++st) {
        if (st + 2 < nst) asm volatile("s_waitcnt vmcnt(4) lgkmcnt(0)\n\ts_barrier" ::: "memory");
        else if (st + 1 < nst) asm volatile("s_waitcnt vmcnt(2) lgkmcnt(0)\n\ts_barrier" ::: "memory");
        else AT_WAIT_BAR();
        if (st + 3 < nst) AT_DMA(st + 3);
        const bool isnb = st < nnb; const int kr = krlo + st;
        const bool act = !isnb || (kr >= rsw && kr < rsw + KH);
        if (act) {
            const LAS unsigned char* kp0 = F.lds + A_K + (st & 3) * 8192 + hi * 1024 + r32 * 16;
            const LAS unsigned char* vp = F.lds + A_V + (st & 3) * 8192 + ((lane >> 4) & 1) * 32 + (lane & 3) * 8 + (4 * hi + ((lane & 15) >> 2)) * 64;
            const LAS float* tb = tbl + 64 + (kr - r + 7) * 32 + 4 * hi - c + 15;
            if (!isnb) tile_compute<0>(kp0, vp, tb, qr, o, m, l, wsf, r32, hi, cs);
            else if ((w & 1) == 0) tile_compute<1>(kp0, vp, tb, qr, o, m, l, wsf, r32, hi, cs);
            else tile_compute<2>(kp0, vp, tb, qr, o, m, l, wsf, r32, hi, cs);
        }
    }
#undef AT_DMA
    l += __shfl_xor(l, 32);
    if (hi == 0) wsf[32 + r32] = l;
    LDS_WAIT();
    LAS bf16_t* stg = (LAS bf16_t*)(F.lds + A_STG) + w * 2048;
#pragma unroll
    for (int rr = 0; rr < 16; ++rr) { const int orow = crow(rr, hi); const float rl = __builtin_amdgcn_rcpf(wsf[32 + orow]);
        stg[orow * 64 + r32] = (bf16_t)f2bf(o[0][rr] * rl); stg[orow * 64 + 32 + r32] = (bf16_t)f2bf(o[1][rr] * rl); }
    LDS_WAIT();
    bf16_t* ow = F.mixin + (size_t)(b * S + r * GW + 32 * (w & 1)) * D + h * 64;
#pragma unroll
    for (int i = 0; i < 4; ++i) { const int row = i * 8 + (lane >> 3), ch = lane & 7; const u32x4 v = *(const LAS u32x4*)(stg + row * 64 + ch * 8); *(u32x4*)(ow + (size_t)row * D + ch * 8) = v; }
    AT_WAIT_BAR();
}

constexpr int G_IMG = 0, G_STG = 65536, G_STAT = 98304;
__device__ __forceinline__ void sgu_unit(Frame& F, int chunk, int gh) {
    const int lane = F.lane, r32 = lane & 31, hi = lane >> 5, w = F.wave;
    const int base = chunk * 128;
    LAS f32x2* stat = (LAS f32x2*)(F.lds + G_STAT);
    u32x4 zrow[16];
#pragma unroll
    for (int t = 0; t < 16; ++t) zrow[t] = *(const u32x4*)(F.proj + (size_t)(base + 16 * w + t) * DIN + 2048 + lane * 8);
    const int cb = w & 3, th = w >> 2, grp = 2 * gh + (cb >> 1);
    const bf16_t* wp = F.sguw + (size_t)(grp * 128 + 64 * th + r32) * 128 + 8 * hi;
    bf16x8 wf0[8], wf1[8];
#pragma unroll
    for (int ks = 0; ks < 8; ++ks) { wf0[ks] = *(const bf16x8*)(wp + ks * 16); wf1[ks] = *(const bf16x8*)(wp + 32 * 128 + ks * 16); }
#pragma unroll
    for (int t = 0; t < 16; ++t) {
        const int tok = 16 * w + t;
        const u32x4 zv = zrow[t];
        float v[8] = {bflo(zv.x), bfhi(zv.x), bflo(zv.y), bfhi(zv.y), bflo(zv.z), bfhi(zv.z), bflo(zv.w), bfhi(zv.w)};
        float s = 0.f;
#pragma unroll
        for (int i = 0; i < 8; ++i) s += v[i];
        const float mean = wsum(s) * (1.f / 512.f); float q = 0.f;
#pragma unroll
        for (int i = 0; i < 8; ++i) { const float d = v[i] - mean; q += d * d; }
        const float rstd = rsqrtf(wsum(q) * (1.f / 512.f) + EPS);
        if (lane == 0) stat[tok] = (f32x2){mean, rstd};
    }
    AT_WAIT_BAR();
    {
        const int ch0 = 256 * gh + 32 * w + 8 * (lane & 3);
        const f32x4 g0 = *(const f32x4*)(F.sgu_ln_g + ch0), g1 = *(const f32x4*)(F.sgu_ln_g + ch0 + 4), b0 = *(const f32x4*)(F.sgu_ln_b + ch0), b1 = *(const f32x4*)(F.sgu_ln_b + ch0 + 4);
#pragma unroll
        for (int i = 0; i < 8; ++i) {
            const int tok = 16 * i + (lane >> 2);
            const u32x4 zv = *(const u32x4*)(F.proj + (size_t)(base + tok) * DIN + 2048 + ch0);
            const f32x2 st = stat[tok];
            u32x4 o;
            o.x = pk2((bflo(zv.x) - st[0]) * st[1] * g0[0] + b0[0], (bfhi(zv.x) - st[0]) * st[1] * g0[1] + b0[1]);
            o.y = pk2((bflo(zv.y) - st[0]) * st[1] * g0[2] + b0[2], (bfhi(zv.y) - st[0]) * st[1] * g0[3] + b0[3]);
            o.z = pk2((bflo(zv.z) - st[0]) * st[1] * g1[0] + b1[0], (bfhi(zv.z) - st[0]) * st[1] * g1[1] + b1[1]);
            o.w = pk2((bflo(zv.w) - st[0]) * st[1] * g1[2] + b1[2], (bfhi(zv.w) - st[0]) * st[1] * g1[3] + b1[3]);
            *(LAS u32x4*)(F.lds + G_IMG + w * 8192 + i * 1024 + lane * 16) = o;
        }
    }
    AT_WAIT_BAR();
    f32x16 acc[2][2];
#pragma unroll
    for (int a = 0; a < 2; ++a)
#pragma unroll
        for (int q = 0; q < 2; ++q)
#pragma unroll
            for (int i = 0; i < 16; ++i) acc[a][q][i] = 0.f;
    const LAS unsigned char* gp = F.lds + G_IMG + (2 * cb) * 8192 + ((lane >> 4) & 1) * 32 + (lane & 3) * 8 + (8 * hi + ((lane & 15) >> 2)) * 64;
#pragma unroll
    for (int ks = 0; ks < 8; ++ks) {
        const bf16x8 w0 = wf0[ks], w1 = wf1[ks];
#pragma unroll
        for (int c32 = 0; c32 < 2; ++c32) {
            const s16x4 lo = vtr(gp + c32 * 8192 + ks * 1024), hh = vtr(gp + c32 * 8192 + ks * 1024 + 256);
            const bf16x8 gf = (bf16x8){lo[0], lo[1], lo[2], lo[3], hh[0], hh[1], hh[2], hh[3]};
            acc[0][c32] = __builtin_amdgcn_mfma_f32_32x32x16_bf16(gf, w0, acc[0][c32], 0, 0, 0);
            acc[1][c32] = __builtin_amdgcn_mfma_f32_32x32x16_bf16(gf, w1, acc[1][c32], 0, 0, 0);
        }
    }
    LAS unsigned char* stg = F.lds + G_STG + w * 4096;
#pragma unroll
    for (int ib = 0; ib < 2; ++ib) {
        const int i0 = 64 * th + 32 * ib;
        const float bi = F.sgu_b[grp * 128 + i0 + r32];
#pragma unroll
        for (int c32 = 0; c32 < 2; ++c32)
#pragma unroll
            for (int a = 0; a < 4; ++a) { u32x2 o; o.x = pk2(acc[ib][c32][4 * a] + bi, acc[ib][c32][4 * a + 1] + bi); o.y = pk2(acc[ib][c32][4 * a + 2] + bi, acc[ib][c32][4 * a + 3] + bi);
                *(LAS u32x2*)(stg + r32 * 128 + (((4 * c32 + a) ^ (r32 & 7)) << 4) + hi * 8) = o; }
        LDS_WAIT();
#pragma unroll
        for (int it = 0; it < 4; ++it) {
            const int row = 8 * it + (lane >> 3), chn = lane & 7;
            const u32x4 v = *(const LAS u32x4*)(stg + row * 128 + ((chn ^ (row & 7)) << 4));
            const size_t tok = (size_t)(base + i0 + row);
            const u32x4 uv = *(const u32x4*)(F.proj + tok * DIN + 1536 + 256 * gh + 64 * cb + 8 * chn);
            u32x4 o;
            o.x = pk2(bflo(v.x) * bflo(uv.x), bfhi(v.x) * bfhi(uv.x)); o.y = pk2(bflo(v.y) * bflo(uv.y), bfhi(v.y) * bfhi(uv.y));
            o.z = pk2(bflo(v.z) * bflo(uv.z), bfhi(v.z) * bfhi(uv.z)); o.w = pk2(bflo(v.w) * bflo(uv.w), bfhi(v.w) * bfhi(uv.w));
            *(u32x4*)(F.mixin + tok * D + 512 + 256 * gh + 64 * cb + 8 * chn) = o;
        }
        LDS_WAIT();
    }
    AT_WAIT_BAR();
}
__device__ __forceinline__ void p_mixer(Frame& F) {
#ifndef PROBE_MIX_A
#define PROBE_MIX_A 1
#endif
#ifndef PROBE_MIX_S
#define PROBE_MIX_S 1
#endif
#pragma unroll 1
    for (int rep = 0; rep < PROBE_MIX_A; ++rep)
    for (int uid = F.vcu; uid < NB * NH * 32; uid += F.G) attn_unit(F, uid >> 8, (uid >> 5) & 7, uid & 31);
#pragma unroll 1
    for (int rep = 0; rep < PROBE_MIX_S; ++rep)
    for (int uid = F.vcu; uid < (M / 128) * 2; uid += F.G) sgu_unit(F, uid >> 1, uid & 1);
}
#undef AT_WAIT_BAR
}

__device__ __forceinline__ void route_select(Frame& F, float lgt, int lane, int tl, int tok, LAS int* lcnt, LAS int* sel, LAS float* selg) {
    float v = lgt, mr[TOPK]; int er[TOPK];
    const int lane8 = lane & ~8;
#pragma unroll
    for (int r = 0; r < TOPK; ++r) {
        mr[r] = wmax(v);
        const int wl = (int)__builtin_ctzll(__ballot(v == mr[r])) & 63;
        er[r] = ((wl >> 5) << 4) | (((wl >> 4) & 1) << 3) | (wl & 7);
        v = (lane8 == (wl & ~8)) ? -INFINITY : v;
    }
    const float p1 = __expf(mr[1] - mr[0]), p2 = __expf(mr[2] - mr[0]), p3 = __expf(mr[3] - mr[0]);
    const float rden = 1.f / (((1.f + p1) + p2) + p3);
    if (lane < TOPK) {
        const int es = lane == 0 ? er[0] : lane == 1 ? er[1] : lane == 2 ? er[2] : er[3];
        const float gs = (lane == 0 ? 1.f : lane == 1 ? p1 : lane == 2 ? p2 : p3) * rden;
        const int lp = __hip_atomic_fetch_add(lcnt + es, 1, __ATOMIC_RELAXED, __HIP_MEMORY_SCOPE_WORKGROUP);
        sel[tl * 4 + lane] = es | (lp << 8); selg[tl * 4 + lane] = gs;
#ifdef MK_WRITE_X1
        F.topg[tok * 4 + lane] = gs; F.topi[tok * 4 + lane] = es;
#endif
    }
}
__device__ __forceinline__ float route_reduce(const f32x2 (&lg2)[NE / 2], int lane) {
    float r16[16], r8[8];
#pragma unroll
    for (int e = 0; e < 16; ++e) { float a = lg2[e >> 1][e & 1], bq = lg2[(e + 16) >> 1][e & 1]; asm volatile("s_nop 1\n\tv_permlane32_swap_b32 %0, %1" : "+v"(a), "+v"(bq)); r16[e] = a + bq; }
#pragma unroll
    for (int e = 0; e < 8; ++e) { float a = r16[e], bq = r16[e + 8]; asm volatile("s_nop 1\n\tv_permlane16_swap_b32 %0, %1" : "+v"(a), "+v"(bq)); r8[e] = a + bq; }
    float r1 = 0.f;
#pragma unroll
    for (int e = 0; e < 8; ++e) { float t = r8[e]; t += dppf<0xB1>(t); t += dppf<0x4E>(t); t += dppf<0x141>(t); t += dppf<0x140>(t); r1 = ((lane & 7) == e) ? t : r1; }
    return r1;
}
__device__ __forceinline__ void p_route(Frame& F) {
    LAS int* lcnt = (LAS int*)(F.lds + L_ROUTE); LAS int* gbase = lcnt + 32; LAS int* sel = lcnt + 64; LAS float* selg = (LAS float*)(F.lds + L_RPB);
    for (int i = F.tid; i < 8192; i += 512) { const int c = i >> 3, q = i & 7; *(LAS f32x4*)(F.lds + c * 128 + ((q ^ ((c >> 1) & 7)) << 4)) = *(const f32x4*)(F.router_w + c * 32 + q * 4); }
    if (F.tid < 32) lcnt[F.tid] = 0;
    __syncthreads();
    const int lane = F.lane;
    const LAS unsigned char* wbase = F.lds + lane * 128;
    const int sw = (lane >> 1) & 7;
    LAS unsigned char* hrowA = F.lds + L_WSCR + F.wave * 2048; LAS unsigned char* hrowB = hrowA + 1024;
    const int e = ((lane >> 5) << 4) | (((lane >> 4) & 1) << 3) | (lane & 7);
    const float rbias = F.router_b[e];
    for (int tb = blockIdx.x; tb < M / 64; tb += F.G) {
        const int b = (tb * 64) >> 13;
        float ps[16], ph[16];
#pragma unroll
        for (int i = 0; i < 16; ++i) { const int col = lane + 64 * i; ps[i] = 1.f + F.mod[b * 6144 + 4 * 1024 + col]; ph[i] = F.mod[b * 6144 + 3 * 1024 + col]; }
#pragma unroll 1
        for (int k = 0; k < 4; ++k) {
            const int tlA = F.wave + 8 * k, tlB = tlA + 32, tokA = tb * 64 + tlA, tokB = tb * 64 + tlB;
            float vA[16], vB[16]; float sA = 0.f, sB = 0.f;
            float pg[16], pb[16];
#pragma unroll
            for (int i = 0; i < 16; ++i) { pg[i] = F.ln1_g[lane + 64 * i]; pb[i] = F.ln1_b[lane + 64 * i]; }
            { const bf16_t* ya = F.y1 + (size_t)tokA * D; const bf16_t* yb = F.y1 + (size_t)tokB * D;
#pragma unroll
              for (int i = 0; i < 16; ++i) { vA[i] = bf2f(ya[lane + 64 * i]); vB[i] = bf2f(yb[lane + 64 * i]); }
#pragma unroll
              for (int i = 0; i < 16; ++i) { sA += vA[i]; sB += vB[i]; } }
            float meanA = wsum(sA) * (1.f / D), meanB = wsum(sB) * (1.f / D), qA = 0.f, qB = 0.f;
#pragma unroll
            for (int i = 0; i < 16; ++i) { vA[i] -= meanA; qA += vA[i] * vA[i]; vB[i] -= meanB; qB += vB[i] * vB[i]; }
            float rstdA = rsqrtf(wsum(qA) * (1.f / D) + EPS), rstdB = rsqrtf(wsum(qB) * (1.f / D) + EPS);
            if (lane == 0) { F.stat[tokA] = (f32x2){meanA, rstdA}; F.stat[tokB] = (f32x2){meanB, rstdB}; }
            sA = 0.f; sB = 0.f;
#pragma unroll
            for (int i = 0; i < 16; ++i) { vA[i] = vA[i] * rstdA * pg[i] + pb[i]; sA += vA[i]; vB[i] = vB[i] * rstdB * pg[i] + pb[i]; sB += vB[i]; }
#ifdef MK_WRITE_X1
#pragma unroll
            for (int i = 0; i < 16; ++i) { F.x1[(size_t)tokA * D + lane + 64 * i] = vA[i]; F.x1[(size_t)tokB * D + lane + 64 * i] = vB[i]; }
#endif
            meanA = wsum(sA) * (1.f / D); meanB = wsum(sB) * (1.f / D); qA = 0.f; qB = 0.f;
#pragma unroll
            for (int i = 0; i < 16; ++i) { vA[i] -= meanA; qA += vA[i] * vA[i]; vB[i] -= meanB; qB += vB[i] * vB[i]; }
            rstdA = rsqrtf(wsum(qA) * (1.f / D) + EPS); rstdB = rsqrtf(wsum(qB) * (1.f / D) + EPS);
#pragma unroll
            for (int i = 0; i < 16; ++i) { vA[i] = vA[i] * rstdA * ps[i] + ph[i]; vB[i] = vB[i] * rstdB * ps[i] + ph[i];
                hrowA[lane + 64 * i] = (unsigned char)__builtin_amdgcn_cvt_pk_fp8_f32(vA[i], vA[i], 0, false); hrowB[lane + 64 * i] = (unsigned char)__builtin_amdgcn_cvt_pk_fp8_f32(vB[i], vB[i], 0, false); }
            f32x2 lgA[NE / 2], lgB[NE / 2];
#pragma unroll
            for (int q = 0; q < NE / 2; ++q) { lgA[q] = (f32x2){0.f, 0.f}; lgB[q] = (f32x2){0.f, 0.f}; }
#pragma unroll
            for (int i = 0; i < 16; ++i) {
                f32x4 wa[8];
#pragma unroll
                for (int qq = 0; qq < 8; ++qq) wa[qq] = *(const LAS f32x4*)(wbase + i * 8192 + ((qq ^ sw) << 4));
                __builtin_amdgcn_sched_barrier(0);
                const f32x2 ha = (f32x2){vA[i], vA[i]}, hb = (f32x2){vB[i], vB[i]};
#pragma unroll
                for (int qq = 0; qq < 8; ++qq) { const f32x2 w0 = (f32x2){wa[qq][0], wa[qq][1]}, w1 = (f32x2){wa[qq][2], wa[qq][3]};
                    lgA[2 * qq] = __builtin_elementwise_fma(ha, w0, lgA[2 * qq]); lgA[2 * qq + 1] = __builtin_elementwise_fma(ha, w1, lgA[2 * qq + 1]);
                    lgB[2 * qq] = __builtin_elementwise_fma(hb, w0, lgB[2 * qq]); lgB[2 * qq + 1] = __builtin_elementwise_fma(hb, w1, lgB[2 * qq + 1]); }
                __builtin_amdgcn_sched_barrier(0);
            }
            LDS_WAIT();
            *(u32x4*)(F.h2 + (size_t)tokA * D + lane * 16) = *(const LAS u32x4*)(hrowA + lane * 16);
            *(u32x4*)(F.h2 + (size_t)tokB * D + lane * 16) = *(const LAS u32x4*)(hrowB + lane * 16);
            const float lgtA = route_reduce(lgA, lane) + rbias, lgtB = route_reduce(lgB, lane) + rbias;
            route_select(F, lgtA, lane, tlA, tokA, lcnt, sel, selg);
            route_select(F, lgtB, lane, tlB, tokB, lcnt, sel, selg);
        }
        __syncthreads();
        if (F.tid < 32) { const int n = lcnt[F.tid]; gbase[F.tid] = n ? (int)__hip_atomic_fetch_add(F.cntw + 32 * F.tid, (unsigned)n, __ATOMIC_RELAXED, __HIP_MEMORY_SCOPE_AGENT) : 0; lcnt[F.tid] = 0; }
        __syncthreads();
        if (F.tid < 256) { const int sv = sel[F.tid], ee = sv & 255, lp = sv >> 8; F.list[(size_t)ee * LCAP + gbase[ee] + lp] = (tb * 64 + (F.tid >> 2)) * 4 + (F.tid & 3); F.listg[(size_t)ee * LCAP + gbase[ee] + lp] = selg[F.tid]; }
        __syncthreads();
    }
}

__device__ __forceinline__ void p_final(Frame& F) {
    const int gw = F.vcu * 8 + F.wave, NGW = F.G * 8;
    for (int tok = gw; tok < M; tok += NGW) {
        const float* g2 = F.mod + (tok >> 13) * 6144 + 5 * 1024;
        const u32x2* xp = (const u32x2*)(F.y1 + (size_t)tok * D) + F.lane;
        const f32x2 st = F.stat[tok];
        f32x4 v[4]; float s = 0.f;
#pragma unroll
        for (int j = 0; j < 4; ++j) {
            f32x4 f = (f32x4){0.f, 0.f, 0.f, 0.f};
#pragma unroll
            for (int k = 0; k < TOPK; ++k) { const int yv = (int)__builtin_nontemporal_load((const unsigned*)(F.ybuf + (size_t)(tok * 4 + k) * D) + F.lane + 64 * j);
                f[0] += __builtin_amdgcn_cvt_f32_fp8(yv, 0); f[1] += __builtin_amdgcn_cvt_f32_fp8(yv, 1); f[2] += __builtin_amdgcn_cvt_f32_fp8(yv, 2); f[3] += __builtin_amdgcn_cvt_f32_fp8(yv, 3); }
            f = f * (1.f / PolDN::YSC);
            const f32x4 gv = *((const f32x4*)g2 + F.lane + 64 * j);
            const f32x4 l1g = *((const f32x4*)F.ln1_g + F.lane + 64 * j), l1b = *((const f32x4*)F.ln1_b + F.lane + 64 * j);
            const u32x2 yw = __builtin_nontemporal_load(xp + 64 * j); const f32x4 yv = (f32x4){bflo(yw.x), bfhi(yw.x), bflo(yw.y), bfhi(yw.y)};
            const f32x4 x1v = (yv - st[0]) * st[1] * l1g + l1b;
            v[j] = x1v * DN_ALPHA + gv * f; s += (v[j][0] + v[j][1]) + (v[j][2] + v[j][3]);
        }
        const float mean = wsum(s) * (1.f / D); float q = 0.f;
#pragma unroll
        for (int j = 0; j < 4; ++j) { v[j] = v[j] - mean; q += (v[j][0] * v[j][0] + v[j][1] * v[j][1]) + (v[j][2] * v[j][2] + v[j][3] * v[j][3]); }
        const float rstd = rsqrtf(wsum(q) * (1.f / D) + EPS);
        f32x4* op = (f32x4*)(F.out + (size_t)tok * D) + F.lane;
#pragma unroll
        for (int j = 0; j < 4; ++j) { const f32x4 gg = *((const f32x4*)F.ln2_g + F.lane + 64 * j), bb = *((const f32x4*)F.ln2_b + F.lane + 64 * j); op[64 * j] = v[j] * rstd * gg + bb; }
    }
}

struct Args { const float* in[23]; float* out; unsigned char* ws; int ph_lo, ph_hi, alt, pad; };
constexpr int N_PHASES = 9;
__global__ void __launch_bounds__(512, 2) mk_fwd(Args args) {
    extern __shared__ __attribute__((aligned(16))) unsigned char lds_raw[];
    Frame F;
    F.lds = (LAS unsigned char*)lds_raw;
    F.MISC = (volatile LAS unsigned*)(F.lds + L_MISC);
    F.tid = threadIdx.x; F.lane = F.tid & 63; F.wave = __builtin_amdgcn_readfirstlane(F.tid >> 6);
    F.G = gridDim.x; { const int bx = blockIdx.x; F.vcu = (F.G % 8 == 0) ? (bx % 8) * (F.G / 8) + bx / 8 : bx; }
    unsigned char* ws = args.ws;
    F.ctl = (unsigned*)(ws + WS_CTL);
    F.x = args.in[0]; F.c = args.in[1]; F.ctx = args.in[2]; F.c_ctx = args.in[3]; F.ada_w = args.in[4]; F.ada_b = args.in[5]; F.w_in = args.in[6]; F.rpb = args.in[7];
    F.sgu_ln_g = args.in[8]; F.sgu_ln_b = args.in[9]; F.sgu_w = args.in[10]; F.sgu_b = args.in[11]; F.w_out = args.in[12]; F.ln1_g = args.in[13]; F.ln1_b = args.in[14];
    F.ln2_g = args.in[15]; F.ln2_b = args.in[16]; F.router_w = args.in[17]; F.router_b = args.in[18]; F.w_gu = args.in[19]; F.b_gu = args.in[20]; F.w_dn = args.in[21]; F.b_dn = args.in[22];
    F.out = args.out;
    F.mod = (float*)(ws + WS_MOD); F.topg = (float*)(ws + WS_TOPG); F.topi = (int*)(ws + WS_TOPI); F.list = (int*)(ws + WS_LIST); F.listg = (float*)(ws + WS_LISTG); F.sguw = (bf16_t*)(ws + WS_SGUW);
    F.Wt_in = (bf16_t*)(ws + WS_WIN); F.Wt_out = (bf16_t*)(ws + WS_WOUT); F.Wt_gu = ws + WS_WGU; F.Wt_dn = ws + WS_WDN;
    F.hxc = (bf16_t*)(ws + WS_HXC); F.proj = (bf16_t*)(ws + WS_PROJ); F.mixin = (bf16_t*)(ws + WS_MIXIN); F.y1 = (bf16_t*)(ws + WS_Y1); F.x1 = (float*)(ws + WS_X1); F.stat = (f32x2*)(ws + WS_STAT); F.cntw = F.ctl + CW_CNT; F.h2 = ws + WS_H2;
    F.act = ws + WS_ACT; F.ybuf = ws + WS_YBUF;
    for (int u = F.tid; u < (LDS_BYTES - L_MISC) / 4; u += 512) ((LAS unsigned*)(F.lds + L_MISC))[u] = 0u;
    __syncthreads();
    if (args.alt) { F.x1 = (float*)(ws + WS_ALT); F.h2 = ws + WS_ALT + 64 * MiB; F.list = (int*)(ws + WS_ALT + 80 * MiB); F.listg = (float*)(ws + WS_ALT + 84 * MiB); F.topg = (float*)(ws + WS_ALT + 82 * MiB); F.topi = (int*)(ws + WS_ALT + 82 * MiB + 512 * 1024); F.cntw = F.ctl + CW_CNT_ALT; F.stat = (f32x2*)(ws + WS_ALT + 83 * MiB); }
    const int lo = args.ph_lo, hi = args.ph_hi;
    const bool one = (hi - lo) > 1;
    XcdBarrier bar; bar.bar = (unsigned*)(F.ctl + CW_BAR); bar.x = 0; bar.st = nullptr;
    if (one) bar = xcd_barrier_post((unsigned*)(F.ctl + CW_BAR), F.MISC + 8);
#define IN(k) (lo <= (k) && (k) < hi)
#define SEAM(k) do { if (IN(k) && IN((k) + 1)) xcd_barrier(bar); } while (0)
#ifndef PROBE_REPS
#define PROBE_REPS {1, 1, 1, 1, 1, 1, 1, 1, 1}
#endif
    constexpr int REPS[N_PHASES] = PROBE_REPS;
#define REPEAT(k) _Pragma("unroll") for (int rep_ = 0; rep_ < REPS[k]; ++rep_)
#define RSEAM(k) do { if (rep_ + 1 < REPS[k]) xcd_barrier(bar); else SEAM(k); } while (0)
    constexpr int W_ITEMS = 16 * 80 + 16 * 32 + NE * 16 * 64 + NE * 16 * 32, W_TAIL = 7680;
    const bool tail_wg = (F.G == 256 && (int)blockIdx.x >= 136);
    if (IN(0)) REPEAT(0) { p_ada(F); p_weights(F, 0, (F.G == 256) ? W_ITEMS - W_TAIL : W_ITEMS, F.vcu * 8 + F.wave, F.G * 8, true); RSEAM(0); }
    if (IN(1)) REPEAT(1) { p_lnmod(F); RSEAM(1); }
    if (IN(2)) REPEAT(2) { PolProj P{F.hxc, F.Wt_in, F.proj, F.G, (int)blockIdx.x}; pg8::gemm_phase<PolProj>(F.lds, P);
        if (tail_wg) p_weights(F, W_ITEMS - W_TAIL, W_TAIL, ((int)blockIdx.x - 136) * 8 + F.wave, 120 * 8, false); RSEAM(2); }
    if (IN(3)) REPEAT(3) { at::p_mixer(F); RSEAM(3); }
    if (IN(4)) REPEAT(4) { PolOut P{F.mixin, F.Wt_out, F.x, F.mod, F.y1, F.G, (int)blockIdx.x}; pg8::gemm_phase<PolOut>(F.lds, P); RSEAM(4); }
    if (IN(5)) { p_route(F); SEAM(5); }
    if (IN(6)) REPEAT(6) { const int T = expert_tables(F); ExpTab tb{(const LAS int*)(F.lds + L_TILEE), (const LAS int*)(F.lds + L_TSTART), (const LAS int*)(F.lds + L_TSTART) + 64, T};
        PolGU P{F.h2, F.Wt_gu, F.b_gu, F.list, F.act, tb, F.G, (int)blockIdx.x}; pg8::gemm_phase<PolGU>(F.lds, P); RSEAM(6); }
    if (IN(7)) REPEAT(7) { const int T = expert_tables(F); ExpTab tb{(const LAS int*)(F.lds + L_TILEE), (const LAS int*)(F.lds + L_TSTART), (const LAS int*)(F.lds + L_TSTART) + 64, T};
        PolDN P{F.act, F.Wt_dn, F.b_dn, F.list, F.listg, F.ybuf, tb, F.G, (int)blockIdx.x}; pg8::gemm_phase<PolDN>(F.lds, P); RSEAM(7); }
    if (IN(8)) REPEAT(8) { p_final(F); if (rep_ + 1 < REPS[8]) xcd_barrier(bar); }
#undef IN
#undef SEAM
#undef REPEAT
#undef RSEAM
}

static inline void launch_forward(void* const* d_in, void* d_out, void* d_ws, hipStream_t stream, int n_launches) {
    static int grid = 0;
    if (grid == 0) {
        int dev = 0, cus = 0;
        if (hipGetDevice(&dev) != hipSuccess || hipDeviceGetAttribute(&cus, hipDeviceAttributeMultiprocessorCount, dev) != hipSuccess) { fprintf(stderr, "kernel_launch: device query failed\n"); grid = -1; return; }
        if (hipFuncSetAttribute((const void*)mk_fwd, hipFuncAttributeMaxDynamicSharedMemorySize, LDS_BYTES) != hipSuccess) { fprintf(stderr, "kernel_launch: hipFuncSetAttribute failed\n"); grid = -1; return; }
        int per_cu = 0;
        if (hipOccupancyMaxActiveBlocksPerMultiprocessor(&per_cu, (const void*)mk_fwd, 512, LDS_BYTES) != hipSuccess || per_cu < 1) fprintf(stderr, "kernel_launch: occupancy query says %d\n", per_cu);
        (void)hipGetLastError();
        grid = cus;
    }
    if (grid < 0) return;
    (void)hipMemsetAsync((char*)d_ws + WS_CTL, 0, CTL_ZERO_BYTES, stream);
    Args a{};
    for (int i = 0; i < 23; ++i) a.in[i] = (const float*)d_in[i];
    a.out = (float*)d_out; a.ws = (unsigned char*)d_ws;
    if (n_launches == 1) { a.ph_lo = 0; a.ph_hi = N_PHASES; hipLaunchKernelGGL(mk_fwd, dim3(grid), dim3(512), LDS_BYTES, stream, a); }
    else for (int p = 0; p < N_PHASES; ++p) { a.ph_lo = p; a.ph_hi = p + 1; hipLaunchKernelGGL(mk_fwd, dim3(grid), dim3(512), LDS_BYTES, stream, a); }
#ifdef PROBE_EXTRA
    { const int extra[] = PROBE_EXTRA; for (int p : extra) { a.ph_lo = p; a.ph_hi = p + 1; a.alt = (p == 5); hipLaunchKernelGGL(mk_fwd, dim3(grid), dim3(512), LDS_BYTES, stream, a); } }
#endif
}
}
extern "C" void kernel_launch(void* const* d_in, const int* in_sizes, int n_in, void* d_out, int out_size, void* d_ws, size_t ws_size, hipStream_t stream) {
    if (ws_size < mk::WS_END || n_in != 23) { fprintf(stderr, "kernel_launch: unexpected workspace / inputs (%zu, %d)\n", ws_size, n_in); return; }
    mk::launch_forward(d_in, d_out, d_ws, stream, 1);
}
```

```cpp
#include <hip/hip_runtime.h>
#include <stdint.h>
#include <stdio.h>

#define GAS __attribute__((address_space(1)))
#define LAS __attribute__((address_space(3)))
typedef unsigned short bf16_t;
typedef short bf16x8 __attribute__((ext_vector_type(8)));
typedef float f32x4 __attribute__((ext_vector_type(4)));
typedef float f32x2 __attribute__((ext_vector_type(2)));
typedef unsigned u32x4 __attribute__((ext_vector_type(4)));
typedef unsigned u32x2 __attribute__((ext_vector_type(2)));

namespace mk {
constexpr int D = 1024, NB = 2, S = 8192, M = NB * S, GW = 64, ROWS = 128, CTX = 256, NH = 8, KH = 8, KW = 16;
constexpr int NE = 32, TOPK = 4, DFF = 1024, DIN = 2560, NPAIR = M * TOPK, MX = M + NB * CTX;
constexpr int LCAP = 16384, MAXT = 288, ACT_ROWS = MAXT * 256;
constexpr float EPS = 1e-5f;
constexpr float DN_ALPHA = 1.189207115002721f;
constexpr size_t MiB = 1u << 20;
constexpr size_t WS_CTL = 0, CTL_ZERO_BYTES = 1 * MiB;
constexpr size_t WS_MOD = 1 * MiB;
constexpr size_t WS_TOPG = 2 * MiB;
constexpr size_t WS_TOPI = 2 * MiB + 512 * 1024;
constexpr size_t WS_STAT = 5 * MiB + 512 * 1024;
constexpr size_t WS_LIST = 3 * MiB;
constexpr size_t WS_SGUW = 5 * MiB;
constexpr size_t WS_LISTG = 14 * MiB;
constexpr size_t WS_WIN = 6 * MiB;
constexpr size_t WS_WOUT = 11 * MiB;
constexpr size_t WS_WGU = 16 * MiB;
constexpr size_t WS_WDN = 144 * MiB;
constexpr size_t WS_HXC = 208 * MiB;
constexpr size_t WS_PROJ = 241 * MiB;
constexpr size_t WS_MIXIN = 324 * MiB;
constexpr size_t WS_Y1 = 356 * MiB;
constexpr size_t WS_H2 = 420 * MiB;
constexpr size_t WS_ACT = 452 * MiB;
constexpr size_t WS_YBUF = 596 * MiB;
constexpr size_t WS_X1 = 724 * MiB;
constexpr size_t WS_END = 788 * MiB;
constexpr size_t WS_ALT = 788 * MiB;
constexpr int CW_CNT_ALT = 12288;
constexpr int CW_BAR = 4096;
constexpr int CW_CNT = 8192;
constexpr int RING_BYTES = 131072;
constexpr int L_MISC = RING_BYTES;
constexpr int L_IDX = L_MISC + 1024;
constexpr int L_TILEE = L_IDX + 6144;
constexpr int L_TSTART = L_TILEE + 1280;
constexpr int L_ROUTE = L_TSTART + 512;
constexpr int L_RPB = L_ROUTE + 256 + 1024;
constexpr int L_WSCR = L_RPB + 2048;
constexpr int LDS_BYTES = 163840;
static_assert(L_WSCR + 8 * 2048 <= LDS_BYTES, "LDS map");

template <int CTRL> __device__ __forceinline__ float dppf(float v) { return __builtin_bit_cast(float, __builtin_amdgcn_update_dpp(0, __builtin_bit_cast(int, v), CTRL, 0xF, 0xF, true)); }
__device__ __forceinline__ float rlane(float v, int l) { return __builtin_bit_cast(float, __builtin_amdgcn_readlane(__builtin_bit_cast(int, v), l)); }
__device__ __forceinline__ float wsum(float v) {
    v += dppf<0xB1>(v); v += dppf<0x4E>(v); v += dppf<0x141>(v); v += dppf<0x140>(v);
    return (rlane(v, 0) + rlane(v, 16)) + (rlane(v, 32) + rlane(v, 48));
}
__device__ __forceinline__ float wmax(float v) {
    v = fmaxf(v, dppf<0xB1>(v)); v = fmaxf(v, dppf<0x4E>(v)); v = fmaxf(v, dppf<0x141>(v)); v = fmaxf(v, dppf<0x140>(v));
    return fmaxf(fmaxf(rlane(v, 0), rlane(v, 16)), fmaxf(rlane(v, 32), rlane(v, 48)));
}
__device__ __forceinline__ unsigned f2bf(float f) { unsigned u = __builtin_bit_cast(unsigned, f); return (u + 0x7fffu + ((u >> 16) & 1u)) >> 16; }
__device__ __forceinline__ unsigned pk2(float lo, float hi) { return f2bf(lo) | (f2bf(hi) << 16); }
__device__ __forceinline__ float bf2f(unsigned short b) { return __builtin_bit_cast(float, ((unsigned)b) << 16); }
__device__ __forceinline__ float bflo(unsigned w) { return __builtin_bit_cast(float, w << 16); }
__device__ __forceinline__ float bfhi(unsigned w) { return __builtin_bit_cast(float, w & 0xffff0000u); }
__device__ __forceinline__ void store16_sc1(void* p, u32x4 v) { asm volatile("global_store_dwordx4 %0, %1, off sc1\n\ts_nop 1" :: "v"(p), "v"(v) : "memory"); }
__device__ __forceinline__ unsigned cvt_pk_bf16(float lo, float hi) { unsigned r; asm volatile("v_cvt_pk_bf16_f32 %0, %1, %2" : "=v"(r) : "v"(lo), "v"(hi)); return r; }
__device__ __forceinline__ unsigned pk4_fp8(float a, float b, float c, float d) { return (unsigned)__builtin_amdgcn_cvt_pk_fp8_f32(c, d, __builtin_amdgcn_cvt_pk_fp8_f32(a, b, 0, false), true); }
__device__ __forceinline__ float gelu_fast(float x) {
    const float c1 = -2.302208198f;
    const float c3 = c1 * 0.044715f;
    const float x2 = x * x;
    const float t = x * (c1 + c3 * x2);
    return x * __builtin_amdgcn_rcpf(1.f + __builtin_amdgcn_exp2f(t));
}

#define XB_TMO      128
#define XB_XCNT(j)  (256  + 64 * (j))
#define XB_XSUB(j)  (1280 + 64 * (j))
#define XB_XGEN(j)  (2304 + 64 * (j))
#define XB_TOP      3328
#define XB_TOPGEN   3392
#define XCD_BAR_WORDS 3456
#define XB_SPIN_CAP (1u << 18)
__device__ __forceinline__ unsigned xb_ld(unsigned* p)              { return __hip_atomic_load(p, __ATOMIC_RELAXED, __HIP_MEMORY_SCOPE_AGENT); }
__device__ __forceinline__ unsigned xb_add(unsigned* p, unsigned v) { return __hip_atomic_fetch_add(p, v, __ATOMIC_RELAXED, __HIP_MEMORY_SCOPE_AGENT); }
__device__ __forceinline__ unsigned xb_xcc_id() { return (unsigned)__builtin_amdgcn_s_getreg((3 << 11) | 20) & 0xFu; }
#define XB_SPIN(cond, bar) do { unsigned _sp = 0; while (cond) { __builtin_amdgcn_s_sleep(1); \
    if ((++_sp & 255u) == 0u) { if (xb_ld(&(bar)[XB_TMO])) break; if (_sp > XB_SPIN_CAP) { atomicAdd(&(bar)[XB_TMO], 1u); break; } } } } while (0)
struct XcdBarrier { unsigned* bar; unsigned x; volatile LAS unsigned* st; };
__device__ __forceinline__ XcdBarrier xcd_barrier_post(unsigned* bar, volatile LAS unsigned* st) {
    XcdBarrier b; b.bar = bar; b.x = xb_xcc_id(); b.st = st;
    if (threadIdx.x == 0) (void)xb_add(&bar[XB_XCNT(b.x)], 1u);
    return b;
}
__device__ __forceinline__ void xcd_barrier_complete(unsigned* bar, unsigned x, unsigned& nloc, unsigned& nx) {
    const unsigned G = gridDim.x * gridDim.y * gridDim.z;
    unsigned sum, cnt, mine, sp = 0u;
    for (;;) {
        sum = 0u; cnt = 0u; mine = 0u;
#pragma unroll
        for (unsigned j = 0; j < 16; ++j) { const unsigned c = xb_ld(&bar[XB_XCNT(j)]); sum += c; cnt += (c > 0u) ? 1u : 0u; mine = (j == x) ? c : mine; }
        if (sum == G) break;
        __builtin_amdgcn_s_sleep(1);
        if ((++sp & 255u) == 0u) { if (xb_ld(&bar[XB_TMO])) break; if (sp > XB_SPIN_CAP) { atomicAdd(&bar[XB_TMO], 1u); break; } }
    }
    nloc = mine > 0u ? mine : 1u; nx = cnt > 0u ? cnt : 1u;
}
__device__ __forceinline__ void xcd_barrier(const XcdBarrier& b) {
    asm volatile("s_waitcnt vmcnt(0)" ::: "memory");
    __syncthreads();
    if (threadIdx.x == 0) {
        unsigned* bar = b.bar;
        __builtin_amdgcn_s_waitcnt(0);
        unsigned nloc = b.st[0], nx = b.st[1];
        if (nloc == 0u) { xcd_barrier_complete(bar, b.x, nloc, nx); b.st[0] = nloc; b.st[1] = nx; }
        const unsigned old = xb_add(&bar[XB_XSUB(b.x)], 1u);
        const unsigned gen = old / nloc;
        if (old + 1u == (gen + 1u) * nloc) {
            __builtin_amdgcn_fence(__ATOMIC_RELEASE, "agent");
            asm volatile("s_waitcnt vmcnt(0)" ::: "memory");
            const unsigned og = xb_add(&bar[XB_TOP], 1u);
            const unsigned tg = og / nx;
            if (og + 1u == (tg + 1u) * nx) xb_add(&bar[XB_TOPGEN], 1u);
            else XB_SPIN(xb_ld(&bar[XB_TOPGEN]) == tg, bar);
            __builtin_amdgcn_fence(__ATOMIC_ACQUIRE, "agent");
            xb_add(&bar[XB_XGEN(b.x)], 1u);
            asm volatile("s_waitcnt vmcnt(0)" ::: "memory");
        } else {
            XB_SPIN(xb_ld(&bar[XB_XGEN(b.x)]) == gen, bar);
            __builtin_amdgcn_fence(__ATOMIC_ACQUIRE, "agent");
            asm volatile("s_waitcnt vmcnt(0)" ::: "memory");
        }
    }
    __syncthreads();
}

struct Frame {
    LAS unsigned char* lds;
    volatile LAS unsigned* MISC;
    unsigned* ctl;
    int tid, lane, wave, vcu, G;
    const float *x, *c, *ctx, *c_ctx, *ada_w, *ada_b, *w_in, *rpb, *sgu_ln_g, *sgu_ln_b, *sgu_w, *sgu_b, *w_out, *ln1_g, *ln1_b, *ln2_g, *ln2_b, *router_w, *router_b, *w_gu, *b_gu, *w_dn, *b_dn;
    float* out;
    float* mod; float* topg; int* topi; int* list; float* listg; bf16_t* sguw; bf16_t* Wt_in; bf16_t* Wt_out; unsigned char* Wt_gu; unsigned char* Wt_dn;
    bf16_t* hxc; bf16_t* proj; bf16_t* mixin; bf16_t* y1; float* x1; f32x2* stat; unsigned* cntw; unsigned char* h2; unsigned char* act; unsigned char* ybuf;
};
#define LDS_WAIT() asm volatile("s_waitcnt lgkmcnt(0)" ::: "memory")
#define VM_WAIT() asm volatile("s_waitcnt vmcnt(0)" ::: "memory")

namespace pg8 {
constexpr int BM = 256, BK = 64, HALF = 128, HTB = HALF * BK * 2, STAGE_BYTES = 8 * HTB, NXCD = 8, WGM = 8, KD = 1024, NKT = KD / BK;
__device__ __forceinline__ int lds_byte(int r, int c) { const int st = (r >> 4) * 2 + (c >> 5), rr = r & 15, cc = c & 31, ob = rr * 64 + cc * 2; return st * 1024 + (ob ^ (((ob >> 9) & 1) << 5)); }
__device__ __forceinline__ void stage_rc(int b, int& R, int& C) { const int st = b / 1024, sb = b % 1024, swz = sb ^ (((sb >> 9) & 1) << 5); R = (st >> 1) * 16 + swz / 64; C = (st & 1) * 32 + (swz % 64) / 2; }
__device__ __forceinline__ int perm32(int rho) { const int n = rho >> 4, i = rho & 15; return 8 * (i >> 2) + 4 * n + (i & 3); }
struct Unit { int pm, pn, e, nvalid, ti; };
__device__ __forceinline__ void static_tile(int L, int nM, int nN, int& pm, int& pn) {
    const int nwg = nM * nN; int wgid = L;
    { const int q = nwg / NXCD, r = nwg % NXCD, xcd = wgid % NXCD, off = wgid / NXCD; wgid = (xcd < r ? xcd * (q + 1) : r * (q + 1) + (xcd - r) * q) + off; }
    const int nig = WGM * nN, gid = wgid / nig, fm = gid * WGM, gsz = (nM - fm) < WGM ? (nM - fm) : WGM;
    pm = fm + ((wgid % nig) % gsz); pn = (wgid % nig) / gsz;
}

typedef int v8i __attribute__((ext_vector_type(8)));
template <bool FP8> struct Frags;
template <> struct Frags<false> { bf16x8 At[4][2], B0[2][2], B1[2][2]; };
template <> struct Frags<true> { v8i At[4], B0[2], B1[2]; };
template <class P>
__device__ __forceinline__ void gemm_phase(LAS unsigned char* lds, const P& pol) {
    const int tid = threadIdx.x, wid = __builtin_amdgcn_readfirstlane(tid >> 6), lane = tid & 63, wr = wid >> 2, wc = wid & 3, fr = lane & 15, fq = lane >> 4;
    constexpr int KDB = P::FP8 ? 1024 : 2048, NKT_ = KDB / 128;
    unsigned voffB[2];
#pragma unroll
    for (int i = 0; i < 2; ++i) { int R, C; stage_rc(tid * 16 + i * 8192, R, C);
        int Rb = P::PERM ? ((R & ~31) + perm32(R & 31)) : R;
        if constexpr (P::BMAP16) { const int n = (R >> 4) & 1, q = R & 15; Rb = 64 * (R >> 5) + 16 * (q >> 2) + 4 * n + (q & 3); }
        voffB[i] = (unsigned)(Rb * KDB + C * 2); }
    const size_t kstep = (size_t)(BK * 2);
    const size_t hstep = (size_t)(P::BMAP16 ? 8 : HALF) * KDB;
    const unsigned ldsw = (unsigned)wid * 1024u;
    const int aoff = lds_byte(wr * 64 + fr, fq * 8), boff = lds_byte(wc * 32 + fr, fq * 8);
#define PG8_SA(b, h) (((b) * 2 + (h)) * HTB)
#define PG8_SB(b, h) ((4 + (b) * 2 + (h)) * HTB)
#define PG8_STAGE(bufoff, gbase, voff) do { _Pragma("unroll") for (int _i = 0; _i < 2; ++_i) \
        __builtin_amdgcn_global_load_lds((const unsigned*)((const char*)(gbase) + (voff)[_i]), (LAS unsigned*)(lds + (bufoff) + ldsw + _i * 8192), 16, 0, 0); } while (0)
#define PG8_RD8(p) __builtin_shufflevector(*(const LAS u32x4*)(p), *(const LAS u32x4*)((p) + 1024), 0, 1, 2, 3, 4, 5, 6, 7)
#define PG8_LDA(dst, b, h) do { if constexpr (P::FP8) { _Pragma("unroll") for (int m = 0; m < 4; ++m) fg.dst[m] = __builtin_bit_cast(v8i, PG8_RD8(lds + PG8_SA(b, h) + aoff + m * 2048)); } \
        else { _Pragma("unroll") for (int m = 0; m < 4; ++m) _Pragma("unroll") for (int k = 0; k < 2; ++k) fg.dst[m][k] = *(const LAS bf16x8*)(lds + PG8_SA(b, h) + aoff + m * 2048 + k * 1024); } } while (0)
#define PG8_LDB(dst, b, h) do { if constexpr (P::FP8) { _Pragma("unroll") for (int n = 0; n < 2; ++n) fg.dst[n] = __builtin_bit_cast(v8i, PG8_RD8(lds + PG8_SB(b, h) + boff + n * 2048)); } \
        else { _Pragma("unroll") for (int n = 0; n < 2; ++n) _Pragma("unroll") for (int k = 0; k < 2; ++k) fg.dst[n][k] = *(const LAS bf16x8*)(lds + PG8_SB(b, h) + boff + n * 2048 + k * 1024); } } while (0)
#define PG8_MMA(ai, bj, At, Bt) do { __builtin_amdgcn_s_setprio(1); \
        if constexpr (P::FP8) { _Pragma("unroll") for (int m = 0; m < 4; ++m) _Pragma("unroll") for (int n = 0; n < 2; ++n) \
            acc[ai][bj][m][n] = __builtin_amdgcn_mfma_scale_f32_16x16x128_f8f6f4(fg.Bt[n], fg.At[m], acc[ai][bj][m][n], 0, 0, 0, 0, 0, 0); } \
        else { _Pragma("unroll") for (int m = 0; m < 4; ++m) _Pragma("unroll") for (int n = 0; n < 2; ++n) _Pragma("unroll") for (int k = 0; k < 2; ++k) \
            acc[ai][bj][m][n] = __builtin_amdgcn_mfma_f32_16x16x32_bf16(fg.Bt[n][k], fg.At[m][k], acc[ai][bj][m][n], 0, 0, 0); } \
        __builtin_amdgcn_s_setprio(0); } while (0)
#define PG8_WAIT_V(n) asm volatile("s_waitcnt vmcnt(" #n ")" ::: "memory")
#define PG8_WAIT_L(n) asm volatile("s_waitcnt lgkmcnt(" #n ")" ::: "memory")
#define PG8_BAR __builtin_amdgcn_s_barrier()
#define PG8_SCHED __builtin_amdgcn_sched_barrier(0)
    Unit cur, nxt; int ui = 0;
    if (!pol.next(0, cur)) return;
    f32x4 acc[2][2][4][2];
#pragma unroll
    for (int a = 0; a < 2; ++a)
#pragma unroll
        for (int b = 0; b < 2; ++b)
#pragma unroll
            for (int m = 0; m < 4; ++m)
#pragma unroll
                for (int n = 0; n < 2; ++n) acc[a][b][m][n] = (f32x4){0.f, 0.f, 0.f, 0.f};
    Frags<P::FP8> fg;
    int slot = 0;
    if (P::META) { pol.meta_issue(cur, 0, lds, wid, lane); PG8_WAIT_V(0); asm volatile("" ::: "memory"); PG8_BAR; asm volatile("" ::: "memory"); }
    unsigned aC[2][2];
    pol.a_off(cur, 0, lds, aC);
    const char* const Ab = (const char*)pol.A;
    const char* cB = pol.b_ptr(cur);
    PG8_STAGE(PG8_SB(0, 0), cB, voffB); PG8_STAGE(PG8_SB(0, 1), cB + hstep, voffB); PG8_STAGE(PG8_SA(0, 0), Ab, aC[0]); PG8_STAGE(PG8_SA(0, 1), Ab, aC[1]);
    if (wr == 1) PG8_BAR;
    PG8_WAIT_V(2); PG8_BAR;
    PG8_STAGE(PG8_SB(1, 0), cB + kstep, voffB); PG8_STAGE(PG8_SA(1, 0), Ab + kstep, aC[0]); PG8_STAGE(PG8_SB(1, 1), cB + hstep + kstep, voffB);
    PG8_WAIT_V(6); PG8_BAR;
    for (;;) {
        const bool has_next = pol.next(ui + 1, nxt);
        const int nslot = slot == 2 ? 0 : slot + 1;
        if (P::META) { if (has_next) pol.meta_issue(nxt, nslot, lds, wid, lane); }
        const char* nB = has_next ? pol.b_ptr(nxt) : cB;
#pragma unroll 1
        for (int t = 0; t < NKT_; t += 2) {
            const bool last = (t == NKT_ - 2);
            const char* a1 = Ab + (size_t)(t + 1) * kstep;
            const char* a2 = last ? Ab : Ab + (size_t)(t + 2) * kstep; const char* b2 = last ? nB : cB + (size_t)(t + 2) * kstep;
            const char* a3 = a2 + kstep; const char* b3 = b2 + kstep;
            PG8_LDB(B0, 0, 0); PG8_LDB(B1, 0, 1); PG8_SCHED; PG8_LDA(At, 0, 0); PG8_STAGE(PG8_SA(1, 1), a1, aC[1]);
            if (last && has_next) pol.a_off(nxt, nslot, lds, aC);
            PG8_WAIT_V(8); PG8_WAIT_L(0); PG8_BAR; PG8_MMA(0, 0, At, B0); PG8_MMA(0, 1, At, B1); PG8_BAR; PG8_SCHED;
            PG8_LDA(At, 0, 1); PG8_STAGE(PG8_SB(0, 0), b2, voffB); PG8_STAGE(PG8_SB(0, 1), b2 + hstep, voffB); PG8_STAGE(PG8_SA(0, 0), a2, aC[0]);
            PG8_WAIT_V(8); PG8_WAIT_L(0); PG8_BAR; PG8_MMA(1, 0, At, B0); PG8_MMA(1, 1, At, B1); PG8_BAR; PG8_SCHED;
            PG8_LDB(B0, 1, 0); PG8_LDB(B1, 1, 1); PG8_SCHED; PG8_LDA(At, 1, 0); PG8_STAGE(PG8_SA(0, 1), a2, aC[1]);
            PG8_WAIT_V(8); PG8_WAIT_L(0); PG8_BAR; PG8_MMA(0, 0, At, B0); PG8_MMA(0, 1, At, B1); PG8_BAR; PG8_SCHED;
            PG8_LDA(At, 1, 1); PG8_STAGE(PG8_SB(1, 0), b3, voffB); PG8_STAGE(PG8_SB(1, 1), b3 + hstep, voffB); PG8_STAGE(PG8_SA(1, 0), a3, aC[0]);
            PG8_WAIT_V(8); PG8_WAIT_L(0); PG8_BAR; PG8_MMA(1, 0, At, B0); PG8_MMA(1, 1, At, B1); PG8_BAR; PG8_SCHED;
        }
        if (wr == 0) PG8_BAR;
#ifdef PROBE_KLOOP2
        const bool do_epi = !(P::FP8 && P::KIND == PROBE_KLOOP2) || (ui & 1);
        if (do_epi) {
            if (P::FP8 && P::KIND == PROBE_KLOOP2) {
#pragma unroll
                for (int a = 0; a < 2; ++a)
#pragma unroll
                    for (int b = 0; b < 2; ++b)
#pragma unroll
                        for (int m = 0; m < 4; ++m)
#pragma unroll
                            for (int n = 0; n < 2; ++n) acc[a][b][m][n] *= 0.5f; }
            pol.epi(acc, cur, slot, lds, wr, wc, fr, fq); }
#else
        constexpr bool do_epi = true;
        pol.epi(acc, cur, slot, lds, wr, wc, fr, fq);
#endif
#ifdef PROBE_EPI2
        if (P::KIND == PROBE_EPI2) { asm volatile("" ::: "memory");
#pragma unroll
            for (int a = 0; a < 2; ++a)
#pragma unroll
                for (int b = 0; b < 2; ++b)
#pragma unroll
                    for (int m = 0; m < 4; ++m)
#pragma unroll
                        for (int n = 0; n < 2; ++n) asm volatile("" : "+v"(acc[a][b][m][n]));
            pol.epi(acc, cur, slot, lds, wr, wc, fr, fq); }
#endif
        if (!has_next) break;
        if (do_epi) {
#pragma unroll
        for (int a = 0; a < 2; ++a)
#pragma unroll
            for (int b = 0; b < 2; ++b)
#pragma unroll
                for (int m = 0; m < 4; ++m)
#pragma unroll
                    for (int n = 0; n < 2; ++n) acc[a][b][m][n] = (f32x4){0.f, 0.f, 0.f, 0.f};
        }
        cur = nxt; cB = nB; ++ui; slot = nslot;
        if (wr == 1) PG8_BAR;
    }
    PG8_WAIT_V(0);
    PG8_BAR;
#undef PG8_SA
#undef PG8_SB
#undef PG8_STAGE
#undef PG8_LDA
#undef PG8_LDB
#undef PG8_MMA
#undef PG8_RD8
#undef PG8_WAIT_V
#undef PG8_WAIT_L
#undef PG8_BAR
#undef PG8_SCHED
}
}

typedef f32x4 AccT[2][2][4][2];

struct PolProj {
    static constexpr bool BMAP16 = false; static constexpr int KIND = 0; static constexpr bool PERM = true, META = false, FP8 = false; static constexpr int SCALE_W = 0x7f7f7f7f;
    const bf16_t* A; const bf16_t* Bt; bf16_t* O; int G, c;
    __device__ __forceinline__ bool next(int i, pg8::Unit& u) const {
        const int L = i * G + c;
        if (L < 640) { pg8::static_tile(L, 64, 10, u.pm, u.pn); return true; }
        if (L < 648) { const int j = L - 640; u.pm = 64 + (j >> 2); u.pn = 2 + (j & 3); return true; }
        return false;
    }
    __device__ __forceinline__ const char* b_ptr(const pg8::Unit& u) const { return (const char*)Bt + (size_t)u.pn * 256 * 1024 * 2; }
    __device__ __forceinline__ void meta_issue(const pg8::Unit&, int, LAS unsigned char*, int, int) const {}
    __device__ __forceinline__ void a_off(const pg8::Unit& u, int, LAS unsigned char*, unsigned (&o)[2][2]) const {
        int Ra[2], Ca[2]; pg8::stage_rc((int)threadIdx.x * 16, Ra[0], Ca[0]); pg8::stage_rc((int)threadIdx.x * 16 + 8192, Ra[1], Ca[1]);
#pragma unroll
        for (int h = 0; h < 2; ++h)
#pragma unroll
            for (int i = 0; i < 2; ++i) o[h][i] = (unsigned)((u.pm * 256 + 128 * h + Ra[i]) * 1024 + Ca[i]) * 2u;
    }
    __device__ __forceinline__ void epi(const AccT& acc, const pg8::Unit& u, int, LAS unsigned char*, int wr, int wc, int fr, int fq) const {
        const int row0 = u.pm * 256 + wr * 64 + fr, col0 = u.pn * 256 + wc * 32 + 8 * fq;
        const bool act = u.pn >= 6;
#pragma unroll
        for (int ai = 0; ai < 2; ++ai)
#pragma unroll
            for (int m = 0; m < 4; ++m) { bf16_t* rowp = O + (size_t)(row0 + ai * 128 + m * 16) * DIN + col0;
#pragma unroll
                for (int bj = 0; bj < 2; ++bj) { f32x4 v0 = acc[ai][bj][m][0], v1 = acc[ai][bj][m][1];
                    if (act) {
#pragma unroll
                        for (int j = 0; j < 4; ++j) { v0[j] = gelu_fast(v0[j]); v1[j] = gelu_fast(v1[j]); } }
                    u32x4 w; w.x = cvt_pk_bf16(v0[0], v0[1]); w.y = cvt_pk_bf16(v0[2], v0[3]); w.z = cvt_pk_bf16(v1[0], v1[1]); w.w = cvt_pk_bf16(v1[2], v1[3]);
                    store16_sc1(rowp + bj * 128, w); } }
    }
};

struct PolOut {
    static constexpr bool BMAP16 = false; static constexpr int KIND = 0; static constexpr bool PERM = true, META = false, FP8 = false; static constexpr int SCALE_W = 0x7f7f7f7f;
    const bf16_t* A; const bf16_t* Bt; const float* x; const float* mod; bf16_t* Y; int G, c;
    __device__ __forceinline__ bool next(int i, pg8::Unit& u) const { const int L = i * G + c; if (L >= 256) return false; pg8::static_tile(L, 64, 4, u.pm, u.pn); return true; }
    __device__ __forceinline__ const char* b_ptr(const pg8::Unit& u) const { return (const char*)Bt + (size_t)u.pn * 256 * 1024 * 2; }
    __device__ __forceinline__ void meta_issue(const pg8::Unit&, int, LAS unsigned char*, int, int) const {}
    __device__ __forceinline__ void a_off(const pg8::Unit& u, int, LAS unsigned char*, unsigned (&o)[2][2]) const {
        int Ra[2], Ca[2]; pg8::stage_rc((int)threadIdx.x * 16, Ra[0], Ca[0]); pg8::stage_rc((int)threadIdx.x * 16 + 8192, Ra[1], Ca[1]);
#pragma unroll
        for (int h = 0; h < 2; ++h)
#pragma unroll
            for (int i = 0; i < 2; ++i) o[h][i] = (unsigned)((u.pm * 256 + 128 * h + Ra[i]) * 1024 + Ca[i]) * 2u;
    }
    __device__ __forceinline__ void epi(const AccT& acc, const pg8::Unit& u, int, LAS unsigned char*, int wr, int wc, int fr, int fq) const {
        const int row0 = u.pm * 256 + wr * 64 + fr, col0 = u.pn * 256 + wc * 32 + 8 * fq;
        const float* g1 = mod + (u.pm >= 32 ? 6144 : 0) + 2 * 1024;
        f32x4 gv[2][2];
#pragma unroll
        for (int bj = 0; bj < 2; ++bj)
#pragma unroll
            for (int n = 0; n < 2; ++n) gv[bj][n] = *(const f32x4*)(g1 + col0 + bj * 128 + 4 * n);
#pragma unroll
        for (int ai = 0; ai < 2; ++ai)
#pragma unroll
            for (int m = 0; m < 4; ++m) { const size_t off = (size_t)(row0 + ai * 128 + m * 16) * D + col0;
#pragma unroll
                for (int bj = 0; bj < 2; ++bj) { const f32x4 x0 = __builtin_nontemporal_load((const f32x4*)(x + off + bj * 128)), x1v = __builtin_nontemporal_load((const f32x4*)(x + off + bj * 128 + 4));
                    const f32x4 v0 = x0 * DN_ALPHA + gv[bj][0] * acc[ai][bj][m][0], v1 = x1v * DN_ALPHA + gv[bj][1] * acc[ai][bj][m][1];
                    u32x4 w; w.x = cvt_pk_bf16(v0[0], v0[1]); w.y = cvt_pk_bf16(v0[2], v0[3]); w.z = cvt_pk_bf16(v1[0], v1[1]); w.w = cvt_pk_bf16(v1[2], v1[3]);
                    *(u32x4*)(Y + off + bj * 128) = w; }
                asm volatile("" ::: "memory"); }
    }
};

struct ExpTab { const LAS int* tile_e; const LAS int* tstart; const LAS int* cnt; int T; };
__device__ __forceinline__ int expert_tables(Frame& F) {
    LAS int* tile_e = (LAS int*)(F.lds + L_TILEE); LAS int* tstart = (LAS int*)(F.lds + L_TSTART); LAS int* cn = tstart + 64;
    if (F.tid < 32) cn[F.tid] = (int)__hip_atomic_load(F.ctl + CW_CNT + 32 * F.tid, __ATOMIC_RELAXED, __HIP_MEMORY_SCOPE_AGENT);
    __syncthreads();
    if (F.tid == 0) { int run = 0; for (int e = 0; e < NE; ++e) { tstart[e] = run; run += (cn[e] + 255) >> 8; } tstart[NE] = run; }
    __syncthreads();
    const int T = tstart[NE];
    if (F.tid < MAXT && F.tid < T) { int e = 0; while (e < NE - 1 && tstart[e + 1] <= F.tid) ++e; tile_e[F.tid] = e; }
    __syncthreads();
    return T < MAXT ? T : MAXT;
}
__device__ __forceinline__ int rfl(int v) { return __builtin_amdgcn_readfirstlane(v); }

struct PolGU {
    static constexpr bool BMAP16 = false; static constexpr int KIND = 1; static constexpr bool PERM = true, META = true, FP8 = true; static constexpr int SCALE_W = 0; static constexpr float WSC = 1.f / 64.f;
    const unsigned char* A; const unsigned char* Bt; const float* bias; const int* list; unsigned char* O; ExpTab tb; int G, c;
    __device__ __forceinline__ bool next(int i, pg8::Unit& u) const {
#if defined(PROBE_KLOOP2) && PROBE_KLOOP2 == 1
        const int L = (i >> 1) * G + c; if (L >= tb.T * 8) return false;
#else
        const int L = i * G + c; if (L >= tb.T * 8) return false;
#endif
        u.ti = L >> 3; u.pn = L & 7; u.e = rfl(tb.tile_e[u.ti]); u.pm = u.ti - rfl(tb.tstart[u.e]);
        const int rem = rfl(tb.cnt[u.e]) - u.pm * 256; u.nvalid = rem < 256 ? rem : 256; return true;
    }
    __device__ __forceinline__ const char* b_ptr(const pg8::Unit& u) const { return (const char*)Bt + ((size_t)u.e * 2048 + (size_t)u.pn * 256) * 1024; }
    __device__ __forceinline__ void meta_issue(const pg8::Unit& u, int slot, LAS unsigned char* lds, int wid, int lane) const {
        if (wid < 4) __builtin_amdgcn_global_load_lds((const unsigned*)(list + (size_t)u.e * LCAP + u.pm * 256 + wid * 64 + lane), (LAS unsigned*)(lds + L_IDX + slot * 2048 + wid * 256), 4, 0, 0);
    }
    __device__ __forceinline__ void a_off(const pg8::Unit& u, int slot, LAS unsigned char* lds, unsigned (&o)[2][2]) const {
        int Ra[2], Ca[2]; pg8::stage_rc((int)threadIdx.x * 16, Ra[0], Ca[0]); pg8::stage_rc((int)threadIdx.x * 16 + 8192, Ra[1], Ca[1]);
        const LAS int* idx = (const LAS int*)(lds + L_IDX + slot * 2048);
#pragma unroll
        for (int h = 0; h < 2; ++h)
#pragma unroll
            for (int i = 0; i < 2; ++i) { const int r = 128 * h + Ra[i]; int pr = idx[r]; pr = r < u.nvalid ? pr : 0; o[h][i] = (unsigned)((pr >> 2) * 1024 + Ca[i] * 2); }
    }
    __device__ __forceinline__ void epi(const AccT& acc, const pg8::Unit& u, int, LAS unsigned char*, int wr, int wc, int fr, int fq) const {
        const int row0 = u.ti * 256 + wr * 64 + fr, col0 = u.pn * 128 + wc * 32 + 8 * fq;
        const float* bg = bias + (size_t)u.e * 2048 + col0;
        const f32x4 g0 = *(const f32x4*)(bg), g1 = *(const f32x4*)(bg + 4), l0 = *(const f32x4*)(bg + 1024) + 1.f, l1 = *(const f32x4*)(bg + 1028) + 1.f;
#pragma unroll
        for (int ai = 0; ai < 2; ++ai)
#pragma unroll
            for (int m = 0; m < 4; ++m) {
                f32x4 r0, r1;
#pragma unroll
                for (int hp = 0; hp < 2; ++hp) {
                    const f32x2 ga0 = (f32x2){acc[ai][0][m][0][2 * hp], acc[ai][0][m][0][2 * hp + 1]} * WSC + (f32x2){g0[2 * hp], g0[2 * hp + 1]};
                    const f32x2 ga1 = (f32x2){acc[ai][0][m][1][2 * hp], acc[ai][0][m][1][2 * hp + 1]} * WSC + (f32x2){g1[2 * hp], g1[2 * hp + 1]};
                    const f32x2 lb0 = (f32x2){acc[ai][1][m][0][2 * hp], acc[ai][1][m][0][2 * hp + 1]} * WSC + (f32x2){l0[2 * hp], l0[2 * hp + 1]};
                    const f32x2 lb1 = (f32x2){acc[ai][1][m][1][2 * hp], acc[ai][1][m][1][2 * hp + 1]} * WSC + (f32x2){l1[2 * hp], l1[2 * hp + 1]};
                    f32x2 gg0, gg1, ll0, ll1, e0, e1;
                    gg0[0] = fminf(ga0[0], 7.f); gg0[1] = fminf(ga0[1], 7.f); gg1[0] = fminf(ga1[0], 7.f); gg1[1] = fminf(ga1[1], 7.f);
                    ll0[0] = __builtin_amdgcn_fmed3f(lb0[0], -6.f, 8.f); ll0[1] = __builtin_amdgcn_fmed3f(lb0[1], -6.f, 8.f); ll1[0] = __builtin_amdgcn_fmed3f(lb1[0], -6.f, 8.f); ll1[1] = __builtin_amdgcn_fmed3f(lb1[1], -6.f, 8.f);
                    const f32x2 x0 = gg0 * -2.45546696f, x1 = gg1 * -2.45546696f;
                    e0[0] = __builtin_amdgcn_exp2f(x0[0]); e0[1] = __builtin_amdgcn_exp2f(x0[1]); e1[0] = __builtin_amdgcn_exp2f(x1[0]); e1[1] = __builtin_amdgcn_exp2f(x1[1]);
                    const f32x2 d0 = e0 + 1.f, d1 = e1 + 1.f;
                    f32x2 q0, q1; q0[0] = __builtin_amdgcn_rcpf(d0[0]); q0[1] = __builtin_amdgcn_rcpf(d0[1]); q1[0] = __builtin_amdgcn_rcpf(d1[0]); q1[1] = __builtin_amdgcn_rcpf(d1[1]);
                    const f32x2 o0 = (ll0 * gg0) * q0, o1 = (ll1 * gg1) * q1;
                    r0[2 * hp] = o0[0]; r0[2 * hp + 1] = o0[1]; r1[2 * hp] = o1[0]; r1[2 * hp + 1] = o1[1];
                }
                u32x2 w; w.x = (unsigned)__builtin_amdgcn_cvt_pk_fp8_f32(r0[2], r0[3], __builtin_amdgcn_cvt_pk_fp8_f32(r0[0], r0[1], 0, false), true);
                w.y = (unsigned)__builtin_amdgcn_cvt_pk_fp8_f32(r1[2], r1[3], __builtin_amdgcn_cvt_pk_fp8_f32(r1[0], r1[1], 0, false), true);
                *(u32x2*)(O + (size_t)(row0 + ai * 128 + m * 16) * DFF + col0) = w; }
    }
};

struct PolDN {
    static constexpr float YSC = 16.f; static constexpr bool BMAP16 = true; static constexpr int KIND = 2; static constexpr bool PERM = true, META = true, FP8 = true; static constexpr int SCALE_W = 0; static constexpr float WSC = 1.f / 64.f;
    const unsigned char* A; const unsigned char* Bt; const float* bias; const int* list; const float* listg; unsigned char* O; ExpTab tb; int G, c;
    __device__ __forceinline__ bool next(int i, pg8::Unit& u) const {
#if defined(PROBE_KLOOP2) && PROBE_KLOOP2 == 2
        const int L = (i >> 1) * G + c; if (L >= tb.T * 4) return false;
#else
        const int L = i * G + c; if (L >= tb.T * 4) return false;
#endif
        u.ti = L >> 2; u.pn = L & 3; u.e = rfl(tb.tile_e[u.ti]); u.pm = u.ti - rfl(tb.tstart[u.e]);
        const int rem = rfl(tb.cnt[u.e]) - u.pm * 256; u.nvalid = rem < 256 ? rem : 256; return true;
    }
    __device__ __forceinline__ const char* b_ptr(const pg8::Unit& u) const { return (const char*)Bt + ((size_t)u.e * 1024 + (size_t)u.pn * 256) * 1024; }
    __device__ __forceinline__ void meta_issue(const pg8::Unit& u, int slot, LAS unsigned char* lds, int wid, int lane) const {
        if (wid < 4) __builtin_amdgcn_global_load_lds((const unsigned*)(list + (size_t)u.e * LCAP + u.pm * 256 + wid * 64 + lane), (LAS unsigned*)(lds + L_IDX + slot * 2048 + wid * 256), 4, 0, 0);
        else __builtin_amdgcn_global_load_lds((const unsigned*)(listg + (size_t)u.e * LCAP + u.pm * 256 + (wid - 4) * 64 + lane), (LAS unsigned*)(lds + L_IDX + slot * 2048 + 1024 + (wid - 4) * 256), 4, 0, 0);
    }
    __device__ __forceinline__ void a_off(const pg8::Unit& u, int, LAS unsigned char*, unsigned (&o)[2][2]) const {
        int Ra[2], Ca[2]; pg8::stage_rc((int)threadIdx.x * 16, Ra[0], Ca[0]); pg8::stage_rc((int)threadIdx.x * 16 + 8192, Ra[1], Ca[1]);
#pragma unroll
        for (int h = 0; h < 2; ++h)
#pragma unroll
            for (int i = 0; i < 2; ++i) o[h][i] = (unsigned)((u.ti * 256 + 128 * h + Ra[i]) * 1024 + Ca[i] * 2);
    }
    __device__ __forceinline__ void epi(const AccT& acc, const pg8::Unit& u, int slot, LAS unsigned char* lds, int wr, int wc, int fr, int fq) const {
        const LAS int* idx = (const LAS int*)(lds + L_IDX + slot * 2048);
        const int col0 = u.pn * 256 + wc * 64 + 16 * fq;
        const float* bd = bias + (size_t)u.e * 1024 + col0;
        f32x4 bv[2][2];
#pragma unroll
        for (int bj = 0; bj < 2; ++bj)
#pragma unroll
            for (int n = 0; n < 2; ++n) bv[bj][n] = *(const f32x4*)(bd + 8 * bj + 4 * n);
#pragma unroll
        for (int ai = 0; ai < 2; ++ai)
#pragma unroll
            for (int m = 0; m < 4; ++m) { const int r = ai * 128 + wr * 64 + m * 16 + fr;
                if (r < u.nvalid) { const int pr = idx[r]; const float gt = ((const LAS float*)idx)[256 + r] * YSC;
                    u32x4 w;
#pragma unroll
                    for (int bj = 0; bj < 2; ++bj) { const f32x4 v0 = (acc[ai][bj][m][0] * WSC + bv[bj][0]) * gt, v1 = (acc[ai][bj][m][1] * WSC + bv[bj][1]) * gt;
                        w[2 * bj] = pk4_fp8(v0[0], v0[1], v0[2], v0[3]); w[2 * bj + 1] = pk4_fp8(v1[0], v1[1], v1[2], v1[3]); }
                    __builtin_nontemporal_store(w, (u32x4*)(O + (size_t)pr * D + col0)); } }
    }
};

__device__ __forceinline__ void p_ada(Frame& F) {
    LAS float* sl = (LAS float*)F.lds;
    LAS float* red = sl + 3072;
    for (int i = F.tid; i < 3072; i += 512) { const int w = i >> 10, k = i & 1023; const float v = w < 2 ? F.c[w * D + k] : F.c_ctx[k]; sl[i] = v / (1.f + __expf(-v)); }
    __syncthreads();
    for (int slab = blockIdx.x; slab < 256; slab += F.G) {
        const int j0 = slab * 24, cg = F.tid % 6, kr = F.tid / 6;
        float a[3][4] = {};
        if (F.tid < 480) {
            for (int k = kr; k < D; k += 80) {
                const f32x4 w4 = __builtin_nontemporal_load((const f32x4*)(F.ada_w + (size_t)k * 6144 + j0 + 4 * cg));
                const float s0 = sl[k], s1 = sl[1024 + k], s2 = sl[2048 + k];
#pragma unroll
                for (int q = 0; q < 4; ++q) { a[0][q] += s0 * w4[q]; a[1][q] += s1 * w4[q]; a[2][q] += s2 * w4[q]; }
            }
#pragma unroll
            for (int w = 0; w < 3; ++w)
#pragma unroll
                for (int q = 0; q < 4; ++q) red[kr * 72 + cg * 12 + w * 4 + q] = a[w][q];
        }
        __syncthreads();
        if (F.tid < 72) {
            float s = 0.f;
            for (int r = 0; r < 80; ++r) s += red[r * 72 + F.tid];
            const int g = F.tid / 12, w = (F.tid % 12) >> 2, q = F.tid & 3, col = j0 + 4 * g + q;
            F.mod[w * 6144 + col] = s + F.ada_b[col];
        }
        __syncthreads();
    }
}

__device__ __forceinline__ void transpose_item(const float* W, int K, int N, bf16_t* WT, int item, bool gu_map, LAS float* scr, int lane) {
    const int nblk = N / 32, kb = item / nblk, nb = item % nblk, k0 = 64 * kb, n0 = 32 * nb;
#pragma unroll 8
    for (int i = 0; i < 32; ++i) { const int kk = 2 * i + (lane >> 5); scr[kk * 33 + (lane & 31)] = __builtin_nontemporal_load(W + (size_t)(k0 + kk) * N + n0 + (lane & 31)); }
    LDS_WAIT(); asm volatile("" ::: "memory");
    int d0 = n0;
    if (gu_map) { const int nn = n0 & 1023; d0 = (nn >> 7) * 256 + (nn & 127) + ((n0 >> 10) ? 128 : 0); }
    const int c = lane & 7;
#pragma unroll
    for (int j = 0; j < 4; ++j) { const int n = (lane >> 3) + 8 * j; const LAS float* s = scr + (8 * c) * 33 + n;
        u32x4 o; o.x = pk2(s[0 * 33], s[1 * 33]); o.y = pk2(s[2 * 33], s[3 * 33]); o.z = pk2(s[4 * 33], s[5 * 33]); o.w = pk2(s[6 * 33], s[7 * 33]);
        *(u32x4*)(WT + (size_t)(d0 + n) * K + k0 + 8 * c) = o; }
    LDS_WAIT(); asm volatile("" ::: "memory");
}
__device__ __forceinline__ void transpose_item8(const float* W, int K, int N, unsigned char* WT, int item, bool gu_map, LAS float* scr, int lane) {
    const int nblk = N / 32, kb = item / nblk, nb = item % nblk, k0 = 64 * kb, n0 = 32 * nb;
#pragma unroll 8
    for (int i = 0; i < 32; ++i) { const int kk = 2 * i + (lane >> 5); scr[kk * 33 + (lane & 31)] = __builtin_nontemporal_load(W + (size_t)(k0 + kk) * N + n0 + (lane & 31)); }
    LDS_WAIT(); asm volatile("" ::: "memory");
    int d0 = n0;
    if (gu_map) { const int nn = n0 & 1023; d0 = (nn >> 7) * 256 + (nn & 127) + ((n0 >> 10) ? 128 : 0); }
    const int c = lane & 7;
#pragma unroll
    for (int j = 0; j < 4; ++j) { const int n = (lane >> 3) + 8 * j; const LAS float* s = scr + (8 * c) * 33 + n;
        u32x2 o; o.x = pk4_fp8(s[0 * 33] * 64.f, s[1 * 33] * 64.f, s[2 * 33] * 64.f, s[3 * 33] * 64.f); o.y = pk4_fp8(s[4 * 33] * 64.f, s[5 * 33] * 64.f, s[6 * 33] * 64.f, s[7 * 33] * 64.f);
        __builtin_nontemporal_store(o, (u32x2*)(WT + (size_t)(d0 + n) * K + k0 + 8 * c)); }
    LDS_WAIT(); asm volatile("" ::: "memory");
}
__device__ __forceinline__ void p_weights(Frame& F, int it_lo, int n_items, int gw, int NGW, bool with_sgu) {
    LAS float* scr = (LAS float*)(F.lds + F.wave * 16384);
    constexpr int I_IN = 16 * 80, I_OUT = 16 * 32, I_GU = 16 * 64, I_DN = 16 * 32;
    constexpr int NITEMS = I_IN + I_OUT + NE * I_GU + NE * I_DN;
    for (int it0 = gw; it0 < n_items; it0 += NGW) {
        const int it = it_lo + it0; int r = it;
        if (r < I_IN) { transpose_item(F.w_in, D, DIN, F.Wt_in, r, false, scr, F.lane); continue; } r -= I_IN;
        if (r < I_OUT) { transpose_item(F.w_out, D, D, F.Wt_out, r, false, scr, F.lane); continue; } r -= I_OUT;
        if (r < NE * I_GU) { const int e = r / I_GU; transpose_item8(F.w_gu + (size_t)e * D * 2048, D, 2048, F.Wt_gu + (size_t)e * 2048 * D, r % I_GU, true, scr, F.lane); continue; } r -= NE * I_GU;
        { const int e = r / I_DN; transpose_item8(F.w_dn + (size_t)e * DFF * D, DFF, D, F.Wt_dn + (size_t)e * D * DFF, r % I_DN, false, scr, F.lane); }
    }
    if (with_sgu) for (int i = (blockIdx.x * 512 + F.tid) * 4; i < 4 * 128 * 128; i += F.G * 512 * 4) {
        const f32x4 v = *(const f32x4*)(F.sgu_w + i); u32x2 o; o.x = pk2(v[0], v[1]); o.y = pk2(v[2], v[3]); *(u32x2*)(F.sguw + i) = o; }
}
__device__ __forceinline__ void p_lnmod(Frame& F) {
    const int gw = F.vcu * 8 + F.wave, NGW = F.G * 8;
    for (int row = gw; row < MX; row += NGW) {
        const float* xr; const float* md;
        if (row < M) { xr = F.x + (size_t)row * D; md = F.mod + (row >> 13) * 6144; } else { xr = F.ctx + (size_t)(row - M) * D; md = F.mod + 2 * 6144; }
        const f32x4* xp = (const f32x4*)xr + F.lane;
        f32x4 v[4]; float s = 0.f;
#pragma unroll
        for (int j = 0; j < 4; ++j) { v[j] = __builtin_nontemporal_load(xp + 64 * j); s += (v[j][0] + v[j][1]) + (v[j][2] + v[j][3]); }
        const float mean = wsum(s) * (1.f / D); float q = 0.f;
#pragma unroll
        for (int j = 0; j < 4; ++j) { v[j] = v[j] - mean; q += (v[j][0] * v[j][0] + v[j][1] * v[j][1]) + (v[j][2] * v[j][2] + v[j][3] * v[j][3]); }
        const float rstd = rsqrtf(wsum(q) * (1.f / D) + EPS);
        u32x2* op = (u32x2*)(F.hxc + (size_t)row * D) + F.lane;
#pragma unroll
        for (int j = 0; j < 4; ++j) { const f32x4 sh = *((const f32x4*)md + F.lane + 64 * j), sc = *((const f32x4*)(md + 1024) + F.lane + 64 * j);
            const f32x4 o = v[j] * rstd * (sc + 1.f) + sh; u32x2 w; w.x = pk2(o[0], o[1]); w.y = pk2(o[2], o[3]); op[64 * j] = w; }
    }
}

__device__ __forceinline__ void p_attn_simple(Frame& F) {
    LAS float* sq = (LAS float*)(F.lds + F.wave * 4096);
    LAS float* sp = sq + 64;
    const int gw = F.vcu * 8 + F.wave, NGW = F.G * 8;
    for (int gid = gw; gid < M * NH; gid += NGW) {
        const int h = gid & 7, tok = gid >> 3, b = tok >> 13, t = tok & (S - 1), r = t >> 6, c = t & 63;
        const int rs = min(max(r - KH / 2, 0), ROWS - KH), cs = min(max(c - KW / 2, 0), GW - KW);
        sq[F.lane] = bf2f(F.proj[(size_t)tok * DIN + h * 64 + F.lane]);
        LDS_WAIT(); asm volatile("" ::: "memory");
        float sc[6]; float mx = -1e30f;
#pragma unroll
        for (int i = 0; i < 6; ++i) {
            const int kk = F.lane + 64 * i;
            const bf16_t* kp; float bias = 0.f;
            if (kk < 128) { const int ki = kk >> 4, kj = kk & 15;
                kp = F.proj + (size_t)(b * S + (rs + ki) * GW + cs + kj) * DIN + 512 + h * 64;
                bias = F.rpb[(h * 15 + (rs + ki - r + 7)) * 31 + (cs + kj - c + 15)];
            } else kp = F.proj + (size_t)(M + b * CTX + (kk - 128)) * DIN + 512 + h * 64;
            float d = 0.f;
#pragma unroll
            for (int dd = 0; dd < 64; dd += 8) { const u32x4 kv = *(const u32x4*)(kp + dd);
                d += sq[dd] * bflo(kv.x) + sq[dd + 1] * bfhi(kv.x) + sq[dd + 2] * bflo(kv.y) + sq[dd + 3] * bfhi(kv.y) + sq[dd + 4] * bflo(kv.z) + sq[dd + 5] * bfhi(kv.z) + sq[dd + 6] * bflo(kv.w) + sq[dd + 7] * bfhi(kv.w); }
            sc[i] = d * 0.125f + bias; mx = fmaxf(mx, sc[i]);
        }
        mx = wmax(mx);
        float sum = 0.f;
#pragma unroll
        for (int i = 0; i < 6; ++i) { const float p = __expf(sc[i] - mx); sum += p; sp[F.lane + 64 * i] = p; }
        sum = wsum(sum);
        LDS_WAIT(); asm volatile("" ::: "memory");
        float acc = 0.f;
        for (int kk = 0; kk < 384; ++kk) {
            const bf16_t* vp;
            if (kk < 128) { const int ki = kk >> 4, kj = kk & 15; vp = F.proj + (size_t)(b * S + (rs + ki) * GW + cs + kj) * DIN + 1024 + h * 64; }
            else vp = F.proj + (size_t)(M + b * CTX + (kk - 128)) * DIN + 1024 + h * 64;
            acc += sp[kk] * bf2f(vp[F.lane]);
        }
        F.mixin[(size_t)tok * D + h * 64 + F.lane] = (bf16_t)f2bf(acc / sum);
        LDS_WAIT(); asm volatile("" ::: "memory");
    }
}
__device__ __forceinline__ void p_sgu_simple(Frame& F) {
    LAS bf16_t* G = (LAS bf16_t*)F.lds;
    for (int u = blockIdx.x; u < M / 128; u += F.G) {
        const int base = u * 128;
        for (int tl = F.wave; tl < 128; tl += 8) {
            const bf16_t* zr = F.proj + (size_t)(base + tl) * DIN + 2048 + F.lane * 8;
            const u32x4 zv = *(const u32x4*)zr;
            float v[8] = {bflo(zv.x), bfhi(zv.x), bflo(zv.y), bfhi(zv.y), bflo(zv.z), bfhi(zv.z), bflo(zv.w), bfhi(zv.w)};
            float s = 0.f;
#pragma unroll
            for (int i = 0; i < 8; ++i) s += v[i];
            const float mean = wsum(s) * (1.f / 512.f); float q = 0.f;
#pragma unroll
            for (int i = 0; i < 8; ++i) { v[i] -= mean; q += v[i] * v[i]; }
            const float rstd = rsqrtf(wsum(q) * (1.f / 512.f) + EPS);
#pragma unroll
            for (int i = 0; i < 8; ++i) { const int ch = F.lane * 8 + i; G[tl * 512 + ch] = (bf16_t)f2bf(v[i] * rstd * F.sgu_ln_g[ch] + F.sgu_ln_b[ch]); }
        }
        __syncthreads();
        const int ch = F.tid, grp = ch >> 7;
        for (int i = 0; i < 128; ++i) {
            const float* wrow = F.sgu_w + (size_t)(grp * 128 + i) * 128;
            float acc = 0.f;
            for (int j = 0; j < 128; ++j) acc += wrow[j] * bf2f(G[j * 512 + ch]);
            acc += F.sgu_b[grp * 128 + i];
            const float uu = bf2f(F.proj[(size_t)(base + i) * DIN + 1536 + ch]);
            F.mixin[(size_t)(base + i) * D + 512 + ch] = (bf16_t)f2bf(uu * acc);
        }
        __syncthreads();
    }
}

namespace at {
typedef float f32x16 __attribute__((ext_vector_type(16)));
typedef short s16x4 __attribute__((ext_vector_type(4)));
typedef short v4i16_t __attribute__((ext_vector_type(4)));
constexpr int A_K = 0, A_V = 32768, A_STG = 65536, A_WSF = 98304, A_RPB = 100352;
constexpr float C2 = 0.125f * 1.4426950408889634f, L2E = 1.4426950408889634f;
__device__ __forceinline__ int crow(int r, int hi) { return (r & 3) + 8 * (r >> 2) + 4 * hi; }
__device__ __forceinline__ s16x4 vtr(const LAS unsigned char* p) { return __builtin_bit_cast(s16x4, __builtin_amdgcn_ds_read_tr16_b64_v4i16((LAS v4i16_t*)p)); }
__device__ __forceinline__ int rsf(int r) { return min(max(r - KH / 2, 0), ROWS - KH); }
#define AT_WAIT_BAR() asm volatile("s_waitcnt vmcnt(0) lgkmcnt(0)\n\ts_barrier" ::: "memory")
__device__ __forceinline__ void glds16(const void* gsrc, unsigned lds_dst) { unsigned keep;
    asm volatile("s_mov_b32 %0, m0\n\ts_mov_b32 m0, %2\n\ts_nop 0\n\tglobal_load_lds_dwordx4 %1, off\n\ts_mov_b32 m0, %0" : "=&s"(keep) : "v"(gsrc), "s"(lds_dst) : "memory"); }

template <int MODE> __device__ __forceinline__ constexpr bool act0(int rr) { return MODE != 2 || rr >= 12; }
template <int MODE> __device__ __forceinline__ constexpr bool act1(int rr) { return MODE != 1 || rr < 4; }
template <int MODE>
__device__ __forceinline__ void tile_compute(const LAS unsigned char* kp0, const LAS unsigned char* vp, const LAS float* tb, const bf16x8 (&qr)[4], f32x16 (&o)[2], float& m, float& l,
                                             LAS float* wsf, int r32, int hi, int cs) {
    f32x16 p0, p1;
#pragma unroll
    for (int i = 0; i < 16; ++i) { p0[i] = 0.f; p1[i] = 0.f; }
#pragma unroll
    for (int d0 = 0; d0 < 4; ++d0) {
        const bf16x8 b0 = *(const LAS bf16x8*)(kp0 + d0 * 2048), b1 = *(const LAS bf16x8*)(kp0 + d0 * 2048 + 512);
        p0 = __builtin_amdgcn_mfma_f32_32x32x16_bf16(b0, qr[d0], p0, 0, 0, 0);
        p1 = __builtin_amdgcn_mfma_f32_32x32x16_bf16(b1, qr[d0], p1, 0, 0, 0);
    }
    float tm = -INFINITY;
#pragma unroll
    for (int rr = 0; rr < 16; ++rr) { const int ko = (rr & 3) + 8 * (rr >> 2), kc = ko + 4 * hi;
        if (MODE == 0) { p0[rr] *= C2; p1[rr] *= C2; tm = fmaxf(tm, fmaxf(p0[rr], p1[rr])); }
        else {
            if (act0<MODE>(rr)) { const float t0 = p0[rr] * C2 + tb[ko]; p0[rr] = (unsigned)(kc - cs) < (unsigned)KW ? t0 : -INFINITY; tm = fmaxf(tm, p0[rr]); }
            if (act1<MODE>(rr)) { const float t1 = p1[rr] * C2 + tb[ko + 32]; p1[rr] = (unsigned)(kc + 32 - cs) < (unsigned)KW ? t1 : -INFINITY; tm = fmaxf(tm, p1[rr]); }
        } }
    { float a = tm, bq = tm; asm volatile("s_nop 1\n\tv_permlane32_swap_b32 %0, %1" : "+v"(a), "+v"(bq)); tm = fmaxf(a, bq); }
    const float mn = fmaxf(m, tm), alpha = __builtin_amdgcn_exp2f(m - mn);
    float rsum = 0.f;
#pragma unroll
    for (int rr = 0; rr < 16; ++rr) {
        if (act0<MODE>(rr)) { p0[rr] = __builtin_amdgcn_exp2f(p0[rr] - mn); rsum += p0[rr]; } else p0[rr] = 0.f;
        if (act1<MODE>(rr)) { p1[rr] = __builtin_amdgcn_exp2f(p1[rr] - mn); rsum += p1[rr]; } else p1[rr] = 0.f; }
    l = l * alpha + rsum; m = mn;
    if (__any(alpha != 1.f)) {
        if (hi == 0) wsf[r32] = alpha;
        LDS_WAIT();
#pragma unroll
        for (int rr = 0; rr < 16; ++rr) { const float a = wsf[crow(rr, hi)]; o[0][rr] *= a; o[1][rr] *= a; }
        LDS_WAIT();
    }
    u32x4 pw[4];
#pragma unroll
    for (int q = 0; q < 4; ++q) { pw[0][q] = cvt_pk_bf16(p0[2 * q], p0[2 * q + 1]); pw[1][q] = cvt_pk_bf16(p0[8 + 2 * q], p0[9 + 2 * q]);
                                  pw[2][q] = cvt_pk_bf16(p1[2 * q], p1[2 * q + 1]); pw[3][q] = cvt_pk_bf16(p1[8 + 2 * q], p1[9 + 2 * q]); }
#pragma unroll
    for (int d0 = 0; d0 < 2; ++d0)
#pragma unroll
        for (int ks = 0; ks < 4; ++ks) {
            if ((MODE == 1 && ks == 3) || (MODE == 2 && ks == 0)) continue;
            const s16x4 lo = vtr(vp + d0 * 4096 + ks * 1024), hh = vtr(vp + d0 * 4096 + ks * 1024 + 512);
            const bf16x8 vf = (bf16x8){lo[0], lo[1], lo[2], lo[3], hh[0], hh[1], hh[2], hh[3]};
            o[d0] = __builtin_amdgcn_mfma_f32_32x32x16_bf16(__builtin_bit_cast(bf16x8, pw[ks]), vf, o[d0], 0, 0, 0);
        }
}

__device__ __forceinline__ void attn_unit(Frame& F, int b, int h, int rg) {
    const int lane = F.lane, r32 = lane & 31, hi = lane >> 5, w = F.wave;
    const int r0 = 4 * rg, r = r0 + (w >> 1), c = 32 * (w & 1) + r32;
    const int krlo = rsf(r0), nnb = rsf(r0 + 3) + 7 - krlo + 1, nst = nnb + 4;
    const int rsw = rsf(r), cs = min(max(c - KW / 2, 0), GW - KW);
    LAS float* tbl = (LAS float*)(F.lds + A_RPB);
    LAS float* wsf = (LAS float*)(F.lds + A_WSF) + w * 64;
    for (int i = F.tid; i < 480; i += 512) { const int dr = i >> 5, dc = i & 31; tbl[64 + i] = dc < 31 ? F.rpb[(h * 15 + dr) * 31 + dc] * L2E : 0.f; }
    const bf16_t* qp = F.proj + (size_t)(b * S + r * GW + c) * DIN + h * 64 + hi * 8;
    bf16x8 qr[4];
#pragma unroll
    for (int d0 = 0; d0 < 4; ++d0) qr[d0] = *(const bf16x8*)(qp + d0 * 16);
    const bf16_t* kbase = F.proj + 512 + h * 64 + w * 8;
    const bf16_t* vbase = F.proj + 1024 + h * 64 + (w >> 2) * 32 + (lane & 3) * 8;
#define AT_DMA(st) do { const int _t0 = (st) < nnb ? b * S + (krlo + (st)) * GW : M + b * CTX + ((st) - nnb) * 64; const int _bf = ((st) & 3) * 8192; \
        __builtin_amdgcn_global_load_lds((const unsigned*)(kbase + (size_t)(_t0 + lane) * DIN), (LAS unsigned*)(F.lds + A_K + _bf + w * 1024), 16, 0, 0); \
        __builtin_amdgcn_global_load_lds((const unsigned*)(vbase + (size_t)(_t0 + 16 * (w & 3) + (lane >> 2)) * DIN), (LAS unsigned*)(F.lds + A_V + _bf + w * 1024), 16, 0, 0); } while (0)
    const unsigned lds0 = (unsigned)(size_t)F.lds;
    float m = -1e30f, l = 0.f;
    f32x16 o[2];
#pragma unroll
    for (int i = 0; i < 16; ++i) { o[0][i] = 0.f; o[1][i] = 0.f; }
    AT_DMA(0); AT_DMA(1); AT_DMA(2);
    for (int st = 0; st < nst; ++st) {
        if (st + 2 < nst) asm volatile("s_waitcnt vmcnt(4) lgkmcnt(0)\n\ts_barrier" ::: "memory");
        else if (st + 1 < nst) asm volatile("s_waitcnt vmcnt(2) lgkmcnt(0)\n\ts_barrier" ::: "memory");
        else AT_WAIT_BAR();
        if (st + 3 < nst) AT_DMA(st + 3);
        const bool isnb = st < nnb; const int kr = krlo + st;
        const bool act = !isnb || (kr >= rsw && kr < rsw + KH);
        if (act) {
            const LAS unsigned char* kp0 = F.lds + A_K + (st & 3) * 8192 + hi * 1024 + r32 * 16;
            const LAS unsigned char* vp = F.lds + A_V + (st & 3) * 8192 + ((lane >> 4) & 1) * 32 + (lane & 3) * 8 + (4 * hi + ((lane & 15) >> 2)) * 64;
            const LAS float* tb = tbl + 64 + (kr - r + 7) * 32 + 4 * hi - c + 15;
            if (!isnb) tile_compute<0>(kp0, vp, tb, qr, o, m, l, wsf, r32, hi, cs);
            else if ((w & 1) == 0) tile_compute<1>(kp0, vp, tb, qr, o, m, l, wsf, r32, hi, cs);
            else tile_compute<2>(kp0, vp, tb, qr, o, m, l, wsf, r32, hi, cs);
        }
    }
#undef AT_DMA
    l += __shfl_xor(l, 32);
    if (hi == 0) wsf[32 + r32] = l;
    LDS_WAIT();
    LAS bf16_t* stg = (LAS bf16_t*)(F.lds + A_STG) + w * 2048;
#pragma unroll
    for (int rr = 0; rr < 16; ++rr) { const int orow = crow(rr, hi); const float rl = __builtin_amdgcn_rcpf(wsf[32 + orow]);
        stg[orow * 64 + r32] = (bf16_t)f2bf(o[0][rr] * rl); stg[orow * 64 + 32 + r32] = (bf16_t)f2bf(o[1][rr] * rl); }
    LDS_WAIT();
    bf16_t* ow = F.mixin + (size_t)(b * S + r * GW + 32 * (w & 1)) * D + h * 64;
#pragma unroll
    for (int i = 0; i < 4; ++i) { const int row = i * 8 + (lane >> 3), ch = lane & 7; const u32x4 v = *(const LAS u32x4*)(stg + row * 64 + ch * 8); *(u32x4*)(ow + (size_t)row * D + ch * 8) = v; }
    AT_WAIT_BAR();
}

constexpr int G_IMG = 0, G_STG = 65536, G_STAT = 98304;
__device__ __forceinline__ void sgu_unit(Frame& F, int chunk, int gh) {
    const int lane = F.lane, r32 = lane & 31, hi = lane >> 5, w = F.wave;
    const int base = chunk * 128;
    LAS f32x2* stat = (LAS f32x2*)(F.lds + G_STAT);
    u32x4 zrow[16];
#pragma unroll
    for (int t = 0; t < 16; ++t) zrow[t] = *(const u32x4*)(F.proj + (size_t)(base + 16 * w + t) * DIN + 2048 + lane * 8);
    const int cb = w & 3, th = w >> 2, grp = 2 * gh + (cb >> 1);
    const bf16_t* wp = F.sguw + (size_t)(grp * 128 + 64 * th + r32) * 128 + 8 * hi;
    bf16x8 wf0[8], wf1[8];
#pragma unroll
    for (int ks = 0; ks < 8; ++ks) { wf0[ks] = *(const bf16x8*)(wp + ks * 16); wf1[ks] = *(const bf16x8*)(wp + 32 * 128 + ks * 16); }
#pragma unroll
    for (int t = 0; t < 16; ++t) {
        const int tok = 16 * w + t;
        const u32x4 zv = zrow[t];
        float v[8] = {bflo(zv.x), bfhi(zv.x), bflo(zv.y), bfhi(zv.y), bflo(zv.z), bfhi(zv.z), bflo(zv.w), bfhi(zv.w)};
        float s = 0.f;
#pragma unroll
        for (int i = 0; i < 8; ++i) s += v[i];
        const float mean = wsum(s) * (1.f / 512.f); float q = 0.f;
#pragma unroll
        for (int i = 0; i < 8; ++i) { const float d = v[i] - mean; q += d * d; }
        const float rstd = rsqrtf(wsum(q) * (1.f / 512.f) + EPS);
        if (lane == 0) stat[tok] = (f32x2){mean, rstd};
    }
    AT_WAIT_BAR();
    {
        const int ch0 = 256 * gh + 32 * w + 8 * (lane & 3);
        const f32x4 g0 = *(const f32x4*)(F.sgu_ln_g + ch0), g1 = *(const f32x4*)(F.sgu_ln_g + ch0 + 4), b0 = *(const f32x4*)(F.sgu_ln_b + ch0), b1 = *(const f32x4*)(F.sgu_ln_b + ch0 + 4);
#pragma unroll
        for (int i = 0; i < 8; ++i) {
            const int tok = 16 * i + (lane >> 2);
            const u32x4 zv = *(const u32x4*)(F.proj + (size_t)(base + tok) * DIN + 2048 + ch0);
            const f32x2 st = stat[tok];
            u32x4 o;
            o.x = pk2((bflo(zv.x) - st[0]) * st[1] * g0[0] + b0[0], (bfhi(zv.x) - st[0]) * st[1] * g0[1] + b0[1]);
            o.y = pk2((bflo(zv.y) - st[0]) * st[1] * g0[2] + b0[2], (bfhi(zv.y) - st[0]) * st[1] * g0[3] + b0[3]);
            o.z = pk2((bflo(zv.z) - st[0]) * st[1] * g1[0] + b1[0], (bfhi(zv.z) - st[0]) * st[1] * g1[1] + b1[1]);
            o.w = pk2((bflo(zv.w) - st[0]) * st[1] * g1[2] + b1[2], (bfhi(zv.w) - st[0]) * st[1] * g1[3] + b1[3]);
            *(LAS u32x4*)(F.lds + G_IMG + w * 8192 + i * 1024 + lane * 16) = o;
        }
    }
    AT_WAIT_BAR();
    f32x16 acc[2][2];
#pragma unroll
    for (int a = 0; a < 2; ++a)
#pragma unroll
        for (int q = 0; q < 2; ++q)
#pragma unroll
            for (int i = 0; i < 16; ++i) acc[a][q][i] = 0.f;
    const LAS unsigned char* gp = F.lds + G_IMG + (2 * cb) * 8192 + ((lane >> 4) & 1) * 32 + (lane & 3) * 8 + (8 * hi + ((lane & 15) >> 2)) * 64;
#pragma unroll
    for (int ks = 0; ks < 8; ++ks) {
        const bf16x8 w0 = wf0[ks], w1 = wf1[ks];
#pragma unroll
        for (int c32 = 0; c32 < 2; ++c32) {
            const s16x4 lo = vtr(gp + c32 * 8192 + ks * 1024), hh = vtr(gp + c32 * 8192 + ks * 1024 + 256);
            const bf16x8 gf = (bf16x8){lo[0], lo[1], lo[2], lo[3], hh[0], hh[1], hh[2], hh[3]};
            acc[0][c32] = __builtin_amdgcn_mfma_f32_32x32x16_bf16(gf, w0, acc[0][c32], 0, 0, 0);
            acc[1][c32] = __builtin_amdgcn_mfma_f32_32x32x16_bf16(gf, w1, acc[1][c32], 0, 0, 0);
        }
    }
    LAS unsigned char* stg = F.lds + G_STG + w * 4096;
#pragma unroll
    for (int ib = 0; ib < 2; ++ib) {
        const int i0 = 64 * th + 32 * ib;
        const float bi = F.sgu_b[grp * 128 + i0 + r32];
#pragma unroll
        for (int c32 = 0; c32 < 2; ++c32)
#pragma unroll
            for (int a = 0; a < 4; ++a) { u32x2 o; o.x = pk2(acc[ib][c32][4 * a] + bi, acc[ib][c32][4 * a + 1] + bi); o.y = pk2(acc[ib][c32][4 * a + 2] + bi, acc[ib][c32][4 * a + 3] + bi);
                *(LAS u32x2*)(stg + r32 * 128 + (((4 * c32 + a) ^ (r32 & 7)) << 4) + hi * 8) = o; }
        LDS_WAIT();
#pragma unroll
        for (int it = 0; it < 4; ++it) {
            const int row = 8 * it + (lane >> 3), chn = lane & 7;
            const u32x4 v = *(const LAS u32x4*)(stg + row * 128 + ((chn ^ (row & 7)) << 4));
            const size_t tok = (size_t)(base + i0 + row);
            const u32x4 uv = *(const u32x4*)(F.proj + tok * DIN + 1536 + 256 * gh + 64 * cb + 8 * chn);
            u32x4 o;
            o.x = pk2(bflo(v.x) * bflo(uv.x), bfhi(v.x) * bfhi(uv.x)); o.y = pk2(bflo(v.y) * bflo(uv.y), bfhi(v.y) * bfhi(uv.y));
            o.z = pk2(bflo(v.z) * bflo(uv.z), bfhi(v.z) * bfhi(uv.z)); o.w = pk2(bflo(v.w) * bflo(uv.w), bfhi(v.w) * bfhi(uv.w));
            *(u32x4*)(F.mixin + tok * D + 512 + 256 * gh + 64 * cb + 8 * chn) = o;
        }
        LDS_WAIT();
    }
    AT_WAIT_BAR();
}
__device__ __forceinline__ void p_mixer(Frame& F) {
#ifndef PROBE_MIX_A
#define PROBE_MIX_A 1
#endif
#ifndef PROBE_MIX_S
#define PROBE_MIX_S 1
#endif
#pragma unroll 1
    for (int rep = 0; rep < PROBE_MIX_A; ++rep)
    for (int uid = F.vcu; uid < NB * NH * 32; uid += F.G) attn_unit(F, uid >> 8, (uid >> 5) & 7, uid & 31);
#pragma unroll 1
    for (int rep = 0; rep < PROBE_MIX_S; ++rep)
    for (int uid = F.vcu; uid < (M / 128) * 2; uid += F.G) sgu_unit(F, uid >> 1, uid & 1);
}
#undef AT_WAIT_BAR
}

template <int CTRL> __device__ __forceinline__ float halve(bool up, float lo, float hi) { const float keep = up ? hi : lo, send = up ? lo : hi; return keep + dppf<CTRL>(send); }
__device__ __forceinline__ float route_reduce2(const f32x2 (&lgA)[NE / 2], const f32x2 (&lgB)[NE / 2], int lane) {
    float r8A[8], r8B[8];
#define SWAP4(INS, a, b) asm volatile("s_nop 1\n\t" INS " %0, %4\n\t" INS " %1, %5\n\t" INS " %2, %6\n\t" INS " %3, %7" : "+v"(a[0]), "+v"(a[1]), "+v"(a[2]), "+v"(a[3]), "+v"(b[0]), "+v"(b[1]), "+v"(b[2]), "+v"(b[3]))
#pragma unroll
    for (int t = 0; t < 2; ++t) { const f32x2 (&lg)[NE / 2] = t ? lgB : lgA; float r16[16];
#pragma unroll
      for (int g = 0; g < 4; ++g) { float a[4], bq[4];
#pragma unroll
          for (int j = 0; j < 4; ++j) { const int e = 4 * g + j; a[j] = lg[e >> 1][e & 1]; bq[j] = lg[(e + 16) >> 1][e & 1]; }
          SWAP4("v_permlane32_swap_b32", a, bq);
#pragma unroll
          for (int j = 0; j < 4; ++j) r16[4 * g + j] = a[j] + bq[j]; }
#pragma unroll
      for (int g = 0; g < 2; ++g) { float a[4], bq[4];
#pragma unroll
          for (int j = 0; j < 4; ++j) { a[j] = r16[4 * g + j]; bq[j] = r16[4 * g + j + 8]; }
          SWAP4("v_permlane16_swap_b32", a, bq);
#pragma unroll
          for (int j = 0; j < 4; ++j) { if (t) r8B[4 * g + j] = a[j] + bq[j]; else r8A[4 * g + j] = a[j] + bq[j]; } } }
#undef SWAP4
    const bool b3 = lane & 8, b2 = lane & 4, b1 = lane & 2, b0 = lane & 1;
    float r8[8], r4[4], r2[2];
#pragma unroll
    for (int e = 0; e < 8; ++e) r8[e] = halve<0x128>(b3, r8A[e], r8B[e]);
#pragma unroll
    for (int j = 0; j < 4; ++j) r4[j] = halve<0x141>(b2, r8[j], r8[j + 4]);
#pragma unroll
    for (int j = 0; j < 2; ++j) r2[j] = halve<0x4E>(b1, r4[j], r4[j + 2]);
    return halve<0xB1>(b0, r2[0], r2[1]);
}
__device__ __forceinline__ int dppmax(int k, int d) { return k > d ? k : d; }
__device__ __forceinline__ void route_select2(Frame& F, float lgt, int e, int lane, int tl, int tok, LAS int* lcnt, LAS int* sel, LAS float* selg) {
    const int ub = __builtin_bit_cast(int, lgt);
    int key = ub ^ ((ub >> 31) & 0x7fffffff);
    int myrank = -1, kr[TOPK];
    const int kmin = (int)0x80000000;
#pragma unroll
    for (int r = 0; r < TOPK; ++r) {
        int m = key;
        m = dppmax(m, __builtin_amdgcn_update_dpp(0, m, 0xB1, 0xF, 0xF, true)); m = dppmax(m, __builtin_amdgcn_update_dpp(0, m, 0x4E, 0xF, 0xF, true)); m = dppmax(m, __builtin_amdgcn_update_dpp(0, m, 0x141, 0xF, 0xF, true));
        { int a = m, bq = m; asm volatile("s_nop 1\n\tv_permlane16_swap_b32 %0, %1" : "+v"(a), "+v"(bq)); m = dppmax(a, bq); }
        { int a = m, bq = m; asm volatile("s_nop 1\n\tv_permlane32_swap_b32 %0, %1" : "+v"(a), "+v"(bq)); m = dppmax(a, bq); }
        kr[r] = m;
        const unsigned long long eq = __ballot(key == m), eA = eq & 0x00FF00FF00FF00FFull, eB = eq & 0xFF00FF00FF00FF00ull;
        const unsigned long long win = (eA & (0ull - eA)) | (eB & (0ull - eB));
        int nk, nr;
        asm("v_cndmask_b32_e64 %0, %1, %2, %3" : "=v"(nk) : "v"(key), "v"(kmin), "s"(win));
        asm("v_cndmask_b32_e64 %0, %1, %2, %3" : "=v"(nr) : "v"(myrank), "v"(r), "s"(win));
        key = nk; myrank = nr;
    }
    float mf[TOPK];
#pragma unroll
    for (int r = 0; r < TOPK; ++r) mf[r] = __builtin_bit_cast(float, kr[r] ^ ((kr[r] >> 31) & 0x7fffffff));
    const float p1 = __expf(mf[1] - mf[0]), p2 = __expf(mf[2] - mf[0]), p3 = __expf(mf[3] - mf[0]);
    const float rden = 1.f / (((1.f + p1) + p2) + p3);
    if (myrank >= 0) {
        const float gs = (myrank == 0 ? 1.f : myrank == 1 ? p1 : myrank == 2 ? p2 : p3) * rden;
        const int lp = __hip_atomic_fetch_add(lcnt + e, 1, __ATOMIC_RELAXED, __HIP_MEMORY_SCOPE_WORKGROUP);
        sel[tl * 4 + myrank] = e | (lp << 8); selg[tl * 4 + myrank] = gs;
#ifdef MK_WRITE_X1
        F.topg[tok * 4 + myrank] = gs; F.topi[tok * 4 + myrank] = e;
#endif
    }
}
__device__ __forceinline__ void p_route(Frame& F) {
    LAS int* lcnt = (LAS int*)(F.lds + L_ROUTE); LAS int* gbase = lcnt + 32; LAS int* sel = lcnt + 64; LAS float* selg = (LAS float*)(F.lds + L_RPB);
    for (int i = F.tid; i < 8192; i += 512) { const int R = i >> 3, q = i & 7, t = R >> 6, c = 2 * (R & 63) + (t & 1) + 128 * (t >> 1);
        *(LAS f32x4*)(F.lds + R * 128 + ((q ^ ((R >> 1) & 7)) << 4)) = *(const f32x4*)(F.router_w + c * 32 + q * 4); }
    if (F.tid < 32) lcnt[F.tid] = 0;
    __syncthreads();
    const int lane = F.lane;
    const LAS unsigned char* wbase = F.lds + lane * 128;
    const int sw = (lane >> 1) & 7;
    unsigned wq0[8], wq1[8];
#pragma unroll
    for (int qq = 0; qq < 8; ++qq) { wq0[qq] = (unsigned)(size_t)(wbase + ((qq ^ sw) << 4)); wq1[qq] = wq0[qq] + 65536u; asm volatile("" : "+v"(wq1[qq])); }
    LAS unsigned char* hrowA = F.lds + L_WSCR + F.wave * 2048; LAS unsigned char* hrowB = hrowA + 1024;
    const int e = ((lane >> 5) << 4) | (((lane >> 4) & 1) << 3) | (lane & 7);
    const float rbias = F.router_b[e];
    for (int tb = blockIdx.x; tb < M / 64; tb += F.G) {
        const int b = (tb * 64) >> 13;
        f32x2 ps[8], ph[8];
#pragma unroll
        for (int i = 0; i < 8; ++i) { const int col = 2 * lane + 128 * i; ps[i] = *(const f32x2*)(F.mod + b * 6144 + 4 * 1024 + col) + 1.f; ph[i] = *(const f32x2*)(F.mod + b * 6144 + 3 * 1024 + col); }
        unsigned nyA[8], nyB[8];
#pragma unroll
        for (int i = 0; i < 8; ++i) { nyA[i] = *(const unsigned*)(F.y1 + (size_t)(tb * 64 + F.wave) * D + 2 * lane + 128 * i); nyB[i] = *(const unsigned*)(F.y1 + (size_t)(tb * 64 + F.wave + 32) * D + 2 * lane + 128 * i); }
#pragma unroll 1
        for (int k = 0; k < 4; ++k) {
            const int tlA = F.wave + 8 * k, tlB = tlA + 32, tokA = tb * 64 + tlA, tokB = tb * 64 + tlB;
            f32x2 vA[8], vB[8], pg[8], pb[8];
#pragma unroll
            for (int i = 0; i < 8; ++i) { pg[i] = *(const f32x2*)(F.ln1_g + 2 * lane + 128 * i); pb[i] = *(const f32x2*)(F.ln1_b + 2 * lane + 128 * i); }
            f32x2 s2A = (f32x2){0.f, 0.f}, s2B = (f32x2){0.f, 0.f};
            { const int kn = k < 3 ? k + 1 : 3;
              const bf16_t* ya = F.y1 + (size_t)(tb * 64 + F.wave + 8 * kn) * D; const bf16_t* yb = ya + (size_t)32 * D;
#pragma unroll
              for (int i = 0; i < 8; ++i) { vA[i] = (f32x2){bflo(nyA[i]), bfhi(nyA[i])}; vB[i] = (f32x2){bflo(nyB[i]), bfhi(nyB[i])}; }
#pragma unroll
              for (int i = 0; i < 8; ++i) { nyA[i] = *(const unsigned*)(ya + 2 * lane + 128 * i); nyB[i] = *(const unsigned*)(yb + 2 * lane + 128 * i); }
#pragma unroll
              for (int i = 0; i < 8; ++i) { s2A += vA[i]; s2B += vB[i]; } }
            float meanA = wsum(s2A[0] + s2A[1]) * (1.f / D), meanB = wsum(s2B[0] + s2B[1]) * (1.f / D);
            f32x2 q2A = (f32x2){0.f, 0.f}, q2B = (f32x2){0.f, 0.f};
#pragma unroll
            for (int i = 0; i < 8; ++i) { vA[i] -= meanA; q2A = __builtin_elementwise_fma(vA[i], vA[i], q2A); vB[i] -= meanB; q2B = __builtin_elementwise_fma(vB[i], vB[i], q2B); }
            float rstdA = rsqrtf(wsum(q2A[0] + q2A[1]) * (1.f / D) + EPS), rstdB = rsqrtf(wsum(q2B[0] + q2B[1]) * (1.f / D) + EPS);
            if (lane == 0) { F.stat[tokA] = (f32x2){meanA, rstdA}; F.stat[tokB] = (f32x2){meanB, rstdB}; }
            s2A = (f32x2){0.f, 0.f}; s2B = (f32x2){0.f, 0.f};
#pragma unroll
            for (int i = 0; i < 8; ++i) { vA[i] = __builtin_elementwise_fma(vA[i] * rstdA, pg[i], pb[i]); s2A += vA[i]; vB[i] = __builtin_elementwise_fma(vB[i] * rstdB, pg[i], pb[i]); s2B += vB[i]; }
            meanA = wsum(s2A[0] + s2A[1]) * (1.f / D); meanB = wsum(s2B[0] + s2B[1]) * (1.f / D); q2A = (f32x2){0.f, 0.f}; q2B = (f32x2){0.f, 0.f};
#pragma unroll
            for (int i = 0; i < 8; ++i) { vA[i] -= meanA; q2A = __builtin_elementwise_fma(vA[i], vA[i], q2A); vB[i] -= meanB; q2B = __builtin_elementwise_fma(vB[i], vB[i], q2B); }
            rstdA = rsqrtf(wsum(q2A[0] + q2A[1]) * (1.f / D) + EPS); rstdB = rsqrtf(wsum(q2B[0] + q2B[1]) * (1.f / D) + EPS);
#pragma unroll
            for (int i = 0; i < 8; ++i) { vA[i] = __builtin_elementwise_fma(vA[i] * rstdA, ps[i], ph[i]); vB[i] = __builtin_elementwise_fma(vB[i] * rstdB, ps[i], ph[i]); }
#pragma unroll
            for (int i = 0; i < 8; ++i) { *(LAS unsigned short*)(hrowA + 2 * lane + 128 * i) = (unsigned short)__builtin_amdgcn_cvt_pk_fp8_f32(vA[i][0], vA[i][1], 0, false);
                                          *(LAS unsigned short*)(hrowB + 2 * lane + 128 * i) = (unsigned short)__builtin_amdgcn_cvt_pk_fp8_f32(vB[i][0], vB[i][1], 0, false); }
            f32x2 lgA[NE / 2], lgB[NE / 2];
#pragma unroll
            for (int q = 0; q < NE / 2; ++q) { lgA[q] = (f32x2){0.f, 0.f}; lgB[q] = (f32x2){0.f, 0.f}; }
#pragma unroll
            for (int i = 0; i < 16; ++i) {
                f32x4 wa[8];
#pragma unroll
                for (int qq = 0; qq < 8; ++qq) wa[qq] = *(const LAS f32x4*)(size_t)((i < 8 ? wq0[qq] : wq1[qq]) + (unsigned)(i & 7) * 8192u);
                __builtin_amdgcn_sched_barrier(0);
                const f32x2 ha = (f32x2){vA[i >> 1][i & 1], vA[i >> 1][i & 1]}, hb = (f32x2){vB[i >> 1][i & 1], vB[i >> 1][i & 1]};
#pragma unroll
                for (int qq = 0; qq < 8; ++qq) { const f32x2 w0 = (f32x2){wa[qq][0], wa[qq][1]}, w1 = (f32x2){wa[qq][2], wa[qq][3]};
                    lgA[2 * qq] = __builtin_elementwise_fma(ha, w0, lgA[2 * qq]); lgA[2 * qq + 1] = __builtin_elementwise_fma(ha, w1, lgA[2 * qq + 1]);
                    lgB[2 * qq] = __builtin_elementwise_fma(hb, w0, lgB[2 * qq]); lgB[2 * qq + 1] = __builtin_elementwise_fma(hb, w1, lgB[2 * qq + 1]); }
                __builtin_amdgcn_sched_barrier(0);
            }
            LDS_WAIT();
            *(u32x4*)(F.h2 + (size_t)tokA * D + lane * 16) = *(const LAS u32x4*)(hrowA + lane * 16);
            *(u32x4*)(F.h2 + (size_t)tokB * D + lane * 16) = *(const LAS u32x4*)(hrowB + lane * 16);
            const float lgt = route_reduce2(lgA, lgB, lane) + rbias;
            route_select2(F, lgt, e, lane, (lane & 8) ? tlB : tlA, (lane & 8) ? tokB : tokA, lcnt, sel, selg);
        }
        __syncthreads();
        if (F.tid < 32) { const int n = lcnt[F.tid]; gbase[F.tid] = n ? (int)__hip_atomic_fetch_add(F.cntw + 32 * F.tid, (unsigned)n, __ATOMIC_RELAXED, __HIP_MEMORY_SCOPE_AGENT) : 0; lcnt[F.tid] = 0; }
        __syncthreads();
        if (F.tid < 256) { const int sv = sel[F.tid], ee = sv & 255, lp = sv >> 8; F.list[(size_t)ee * LCAP + gbase[ee] + lp] = (tb * 64 + (F.tid >> 2)) * 4 + (F.tid & 3); F.listg[(size_t)ee * LCAP + gbase[ee] + lp] = selg[F.tid]; }
        __syncthreads();
    }
}

__device__ __forceinline__ void p_final(Frame& F) {
    const int gw = F.vcu * 8 + F.wave, NGW = F.G * 8;
    for (int tok = gw; tok < M; tok += NGW) {
        const float* g2 = F.mod + (tok >> 13) * 6144 + 5 * 1024;
        const u32x2* xp = (const u32x2*)(F.y1 + (size_t)tok * D) + F.lane;
        const f32x2 st = F.stat[tok];
        f32x4 v[4]; float s = 0.f;
#pragma unroll
        for (int j = 0; j < 4; ++j) {
            f32x4 f = (f32x4){0.f, 0.f, 0.f, 0.f};
#pragma unroll
            for (int k = 0; k < TOPK; ++k) { const int yv = (int)__builtin_nontemporal_load((const unsigned*)(F.ybuf + (size_t)(tok * 4 + k) * D) + F.lane + 64 * j);
                f[0] += __builtin_amdgcn_cvt_f32_fp8(yv, 0); f[1] += __builtin_amdgcn_cvt_f32_fp8(yv, 1); f[2] += __builtin_amdgcn_cvt_f32_fp8(yv, 2); f[3] += __builtin_amdgcn_cvt_f32_fp8(yv, 3); }
            f = f * (1.f / PolDN::YSC);
            const f32x4 gv = *((const f32x4*)g2 + F.lane + 64 * j);
            const f32x4 l1g = *((const f32x4*)F.ln1_g + F.lane + 64 * j), l1b = *((const f32x4*)F.ln1_b + F.lane + 64 * j);
            const u32x2 yw = __builtin_nontemporal_load(xp + 64 * j); const f32x4 yv = (f32x4){bflo(yw.x), bfhi(yw.x), bflo(yw.y), bfhi(yw.y)};
            const f32x4 x1v = (yv - st[0]) * st[1] * l1g + l1b;
#ifdef MK_WRITE_X1
            *((f32x4*)(F.x1 + (size_t)tok * D) + F.lane + 64 * j) = x1v;
#endif
            v[j] = x1v * DN_ALPHA + gv * f; s += (v[j][0] + v[j][1]) + (v[j][2] + v[j][3]);
        }
        const float mean = wsum(s) * (1.f / D); float q = 0.f;
#pragma unroll
        for (int j = 0; j < 4; ++j) { v[j] = v[j] - mean; q += (v[j][0] * v[j][0] + v[j][1] * v[j][1]) + (v[j][2] * v[j][2] + v[j][3] * v[j][3]); }
        const float rstd = rsqrtf(wsum(q) * (1.f / D) + EPS);
        f32x4* op = (f32x4*)(F.out + (size_t)tok * D) + F.lane;
#pragma unroll
        for (int j = 0; j < 4; ++j) { const f32x4 gg = *((const f32x4*)F.ln2_g + F.lane + 64 * j), bb = *((const f32x4*)F.ln2_b + F.lane + 64 * j); op[64 * j] = v[j] * rstd * gg + bb; }
    }
}

struct Args { const float* in[23]; float* out; unsigned char* ws; int ph_lo, ph_hi, alt, pad; };
constexpr int N_PHASES = 9;
__global__ void __launch_bounds__(512, 2) mk_fwd(Args args) {
    extern __shared__ __attribute__((aligned(16))) unsigned char lds_raw[];
    Frame F;
    F.lds = (LAS unsigned char*)lds_raw;
    F.MISC = (volatile LAS unsigned*)(F.lds + L_MISC);
    F.tid = threadIdx.x; F.lane = F.tid & 63; F.wave = __builtin_amdgcn_readfirstlane(F.tid >> 6);
    F.G = gridDim.x; { const int bx = blockIdx.x; F.vcu = (F.G % 8 == 0) ? (bx % 8) * (F.G / 8) + bx / 8 : bx; }
    unsigned char* ws = args.ws;
    F.ctl = (unsigned*)(ws + WS_CTL);
    F.x = args.in[0]; F.c = args.in[1]; F.ctx = args.in[2]; F.c_ctx = args.in[3]; F.ada_w = args.in[4]; F.ada_b = args.in[5]; F.w_in = args.in[6]; F.rpb = args.in[7];
    F.sgu_ln_g = args.in[8]; F.sgu_ln_b = args.in[9]; F.sgu_w = args.in[10]; F.sgu_b = args.in[11]; F.w_out = args.in[12]; F.ln1_g = args.in[13]; F.ln1_b = args.in[14];
    F.ln2_g = args.in[15]; F.ln2_b = args.in[16]; F.router_w = args.in[17]; F.router_b = args.in[18]; F.w_gu = args.in[19]; F.b_gu = args.in[20]; F.w_dn = args.in[21]; F.b_dn = args.in[22];
    F.out = args.out;
    F.mod = (float*)(ws + WS_MOD); F.topg = (float*)(ws + WS_TOPG); F.topi = (int*)(ws + WS_TOPI); F.list = (int*)(ws + WS_LIST); F.listg = (float*)(ws + WS_LISTG); F.sguw = (bf16_t*)(ws + WS_SGUW);
    F.Wt_in = (bf16_t*)(ws + WS_WIN); F.Wt_out = (bf16_t*)(ws + WS_WOUT); F.Wt_gu = ws + WS_WGU; F.Wt_dn = ws + WS_WDN;
    F.hxc = (bf16_t*)(ws + WS_HXC); F.proj = (bf16_t*)(ws + WS_PROJ); F.mixin = (bf16_t*)(ws + WS_MIXIN); F.y1 = (bf16_t*)(ws + WS_Y1); F.x1 = (float*)(ws + WS_X1); F.stat = (f32x2*)(ws + WS_STAT); F.cntw = F.ctl + CW_CNT; F.h2 = ws + WS_H2;
    F.act = ws + WS_ACT; F.ybuf = ws + WS_YBUF;
    for (int u = F.tid; u < (LDS_BYTES - L_MISC) / 4; u += 512) ((LAS unsigned*)(F.lds + L_MISC))[u] = 0u;
    __syncthreads();
    if (args.alt) { F.x1 = (float*)(ws + WS_ALT); F.h2 = ws + WS_ALT + 64 * MiB; F.list = (int*)(ws + WS_ALT + 80 * MiB); F.listg = (float*)(ws + WS_ALT + 84 * MiB); F.topg = (float*)(ws + WS_ALT + 82 * MiB); F.topi = (int*)(ws + WS_ALT + 82 * MiB + 512 * 1024); F.cntw = F.ctl + CW_CNT_ALT; F.stat = (f32x2*)(ws + WS_ALT + 83 * MiB); }
    const int lo = args.ph_lo, hi = args.ph_hi;
    const bool one = (hi - lo) > 1;
    XcdBarrier bar; bar.bar = (unsigned*)(F.ctl + CW_BAR); bar.x = 0; bar.st = nullptr;
    if (one) bar = xcd_barrier_post((unsigned*)(F.ctl + CW_BAR), F.MISC + 8);
#define IN(k) (lo <= (k) && (k) < hi)
#define SEAM(k) do { if (IN(k) && IN((k) + 1)) xcd_barrier(bar); } while (0)
#ifndef PROBE_REPS
#define PROBE_REPS {1, 1, 1, 1, 1, 1, 1, 1, 1}
#endif
    constexpr int REPS[N_PHASES] = PROBE_REPS;
#define REPEAT(k) _Pragma("unroll") for (int rep_ = 0; rep_ < REPS[k]; ++rep_)
#define RSEAM(k) do { if (rep_ + 1 < REPS[k]) xcd_barrier(bar); else SEAM(k); } while (0)
    constexpr int W_ITEMS = 16 * 80 + 16 * 32 + NE * 16 * 64 + NE * 16 * 32, W_TAIL = 7680;
    const bool tail_wg = (F.G == 256 && (int)blockIdx.x >= 136);
    if (IN(0)) REPEAT(0) { p_ada(F); p_weights(F, 0, (F.G == 256) ? W_ITEMS - W_TAIL : W_ITEMS, F.vcu * 8 + F.wave, F.G * 8, true); RSEAM(0); }
    if (IN(1)) REPEAT(1) { p_lnmod(F); RSEAM(1); }
    if (IN(2)) REPEAT(2) { PolProj P{F.hxc, F.Wt_in, F.proj, F.G, (int)blockIdx.x}; pg8::gemm_phase<PolProj>(F.lds, P);
        if (tail_wg) p_weights(F, W_ITEMS - W_TAIL, W_TAIL, ((int)blockIdx.x - 136) * 8 + F.wave, 120 * 8, false); RSEAM(2); }
    if (IN(3)) REPEAT(3) { at::p_mixer(F); RSEAM(3); }
    if (IN(4)) REPEAT(4) { PolOut P{F.mixin, F.Wt_out, F.x, F.mod, F.y1, F.G, (int)blockIdx.x}; pg8::gemm_phase<PolOut>(F.lds, P); RSEAM(4); }
    if (IN(5)) { p_route(F); SEAM(5); }
    if (IN(6)) REPEAT(6) { const int T = expert_tables(F); ExpTab tb{(const LAS int*)(F.lds + L_TILEE), (const LAS int*)(F.lds + L_TSTART), (const LAS int*)(F.lds + L_TSTART) + 64, T};
        PolGU P{F.h2, F.Wt_gu, F.b_gu, F.list, F.act, tb, F.G, (int)blockIdx.x}; pg8::gemm_phase<PolGU>(F.lds, P); RSEAM(6); }
    if (IN(7)) REPEAT(7) { const int T = expert_tables(F); ExpTab tb{(const LAS int*)(F.lds + L_TILEE), (const LAS int*)(F.lds + L_TSTART), (const LAS int*)(F.lds + L_TSTART) + 64, T};
        PolDN P{F.act, F.Wt_dn, F.b_dn, F.list, F.listg, F.ybuf, tb, F.G, (int)blockIdx.x}; pg8::gemm_phase<PolDN>(F.lds, P); RSEAM(7); }
    if (IN(8)) REPEAT(8) { p_final(F); if (rep_ + 1 < REPS[8]) xcd_barrier(bar); }
#undef IN
#undef SEAM
#undef REPEAT
#undef RSEAM
}

static inline void launch_forward(void* const* d_in, void* d_out, void* d_ws, hipStream_t stream, int n_launches) {
    static int grid = 0;
    if (grid == 0) {
        int dev = 0, cus = 0;
        if (hipGetDevice(&dev) != hipSuccess || hipDeviceGetAttribute(&cus, hipDeviceAttributeMultiprocessorCount, dev) != hipSuccess) { fprintf(stderr, "kernel_launch: device query failed\n"); grid = -1; return; }
        if (hipFuncSetAttribute((const void*)mk_fwd, hipFuncAttributeMaxDynamicSharedMemorySize, LDS_BYTES) != hipSuccess) { fprintf(stderr, "kernel_launch: hipFuncSetAttribute failed\n"); grid = -1; return; }
        int per_cu = 0;
        if (hipOccupancyMaxActiveBlocksPerMultiprocessor(&per_cu, (const void*)mk_fwd, 512, LDS_BYTES) != hipSuccess || per_cu < 1) fprintf(stderr, "kernel_launch: occupancy query says %d\n", per_cu);
        (void)hipGetLastError();
        grid = cus;
    }
    if (grid < 0) return;
    (void)hipMemsetAsync((char*)d_ws + WS_CTL, 0, CTL_ZERO_BYTES, stream);
    Args a{};
    for (int i = 0; i < 23; ++i) a.in[i] = (const float*)d_in[i];
    a.out = (float*)d_out; a.ws = (unsigned char*)d_ws;
    if (n_launches == 1) { a.ph_lo = 0; a.ph_hi = N_PHASES; hipLaunchKernelGGL(mk_fwd, dim3(grid), dim3(512), LDS_BYTES, stream, a); }
    else for (int p = 0; p < N_PHASES; ++p) { a.ph_lo = p; a.ph_hi = p + 1; hipLaunchKernelGGL(mk_fwd, dim3(grid), dim3(512), LDS_BYTES, stream, a); }
#ifdef PROBE_EXTRA
    { const int extra[] = PROBE_EXTRA; for (int p : extra) { a.ph_lo = p; a.ph_hi = p + 1; a.alt = (p == 5); hipLaunchKernelGGL(mk_fwd, dim3(grid), dim3(512), LDS_BYTES, stream, a); } }
#endif
}
}
extern "C" void kernel_launch(void* const* d_in, const int* in_sizes, int n_in, void* d_out, int out_size, void* d_ws, size_t ws_size, hipStream_t stream) {
    if (ws_size < mk::WS_END || n_in != 23) { fprintf(stderr, "kernel_launch: unexpected workspace / inputs (%zu, %d)\n", ws_size, n_in); return; }
    mk::launch_forward(d_in, d_out, d_ws, stream, 1);
}
```

```cpp
#include <hip/hip_runtime.h>
#include <stdint.h>
#include <stdio.h>

#define GAS __attribute__((address_space(1)))
#define LAS __attribute__((address_space(3)))
typedef unsigned short bf16_t;
typedef short bf16x8 __attribute__((ext_vector_type(8)));
typedef float f32x4 __attribute__((ext_vector_type(4)));
typedef float f32x2 __attribute__((ext_vector_type(2)));
typedef unsigned u32x4 __attribute__((ext_vector_type(4)));
typedef unsigned u32x2 __attribute__((ext_vector_type(2)));

namespace mk {
constexpr int D = 1024, NB = 2, S = 8192, M = NB * S, GW = 64, ROWS = 128, CTX = 256, NH = 8, KH = 8, KW = 16;
constexpr int NE = 32, TOPK = 4, DFF = 1024, DIN = 2560, NPAIR = M * TOPK, MX = M + NB * CTX;
constexpr int LCAP = 16384, MAXT = 288, ACT_ROWS = MAXT * 256;
constexpr float EPS = 1e-5f;
constexpr float DN_ALPHA = 1.189207115002721f;
constexpr size_t MiB = 1u << 20;
constexpr size_t WS_CTL = 0, CTL_ZERO_BYTES = 1 * MiB;
constexpr size_t WS_MOD = 1 * MiB;
constexpr size_t WS_TOPG = 2 * MiB;
constexpr size_t WS_TOPI = 2 * MiB + 512 * 1024;
constexpr size_t WS_STAT = 5 * MiB + 512 * 1024;
constexpr size_t WS_LIST = 3 * MiB;
constexpr size_t WS_SGUW = 5 * MiB;
constexpr size_t WS_LISTG = 14 * MiB;
constexpr size_t WS_WIN = 6 * MiB;
constexpr size_t WS_WOUT = 11 * MiB;
constexpr size_t WS_WGU = 16 * MiB;
constexpr size_t WS_WDN = 144 * MiB;
constexpr size_t WS_HXC = 208 * MiB;
constexpr size_t WS_PROJ = 241 * MiB;
constexpr size_t WS_MIXIN = 324 * MiB;
constexpr size_t WS_Y1 = 356 * MiB;
constexpr size_t WS_H2 = 420 * MiB;
constexpr size_t WS_ACT = 452 * MiB;
constexpr size_t WS_YBUF = 596 * MiB;
constexpr size_t WS_X1 = 724 * MiB;
constexpr size_t WS_END = 788 * MiB;
constexpr size_t WS_ALT = 788 * MiB;
constexpr int CW_CNT_ALT = 12288;
constexpr int CW_BAR = 4096;
constexpr int CW_CNT = 8192;
constexpr int CW_RDY = 16384;
constexpr int RING_BYTES = 131072;
constexpr int L_MISC = RING_BYTES;
constexpr int L_RDY = L_MISC + 128;
constexpr int L_IDX = L_MISC + 1024;
constexpr int L_TILEE = L_IDX + 6144;
constexpr int L_TSTART = L_TILEE + 1280;
constexpr int L_ROUTE = L_TSTART + 512;
constexpr int L_RPB = L_ROUTE + 256 + 1024;
constexpr int L_WSCR = L_RPB + 2048;
constexpr int LDS_BYTES = 163840;
static_assert(L_WSCR + 8 * 2048 <= LDS_BYTES, "LDS map");

template <int CTRL> __device__ __forceinline__ float dppf(float v) { return __builtin_bit_cast(float, __builtin_amdgcn_update_dpp(0, __builtin_bit_cast(int, v), CTRL, 0xF, 0xF, true)); }
__device__ __forceinline__ float rlane(float v, int l) { return __builtin_bit_cast(float, __builtin_amdgcn_readlane(__builtin_bit_cast(int, v), l)); }
__device__ __forceinline__ float wsum(float v) {
    v += dppf<0xB1>(v); v += dppf<0x4E>(v); v += dppf<0x141>(v); v += dppf<0x140>(v);
    return (rlane(v, 0) + rlane(v, 16)) + (rlane(v, 32) + rlane(v, 48));
}
__device__ __forceinline__ float wmax(float v) {
    v = fmaxf(v, dppf<0xB1>(v)); v = fmaxf(v, dppf<0x4E>(v)); v = fmaxf(v, dppf<0x141>(v)); v = fmaxf(v, dppf<0x140>(v));
    return fmaxf(fmaxf(rlane(v, 0), rlane(v, 16)), fmaxf(rlane(v, 32), rlane(v, 48)));
}
__device__ __forceinline__ unsigned pk2(float lo, float hi) { unsigned r; asm("v_cvt_pk_bf16_f32 %0, %1, %2" : "=v"(r) : "v"(lo), "v"(hi)); return r; }
__device__ __forceinline__ unsigned f2bf(float f) { return pk2(f, f) & 0xffffu; }
__device__ __forceinline__ float bf2f(unsigned short b) { return __builtin_bit_cast(float, ((unsigned)b) << 16); }
__device__ __forceinline__ float bflo(unsigned w) { return __builtin_bit_cast(float, w << 16); }
__device__ __forceinline__ float bfhi(unsigned w) { return __builtin_bit_cast(float, w & 0xffff0000u); }
__device__ __forceinline__ void store8_sc1(void* p, u32x2 v) { asm volatile("global_store_dwordx2 %0, %1, off sc1\n\ts_nop 1" :: "v"(p), "v"(v) : "memory"); }
__device__ __forceinline__ void store16_sc1(void* p, u32x4 v) { asm volatile("global_store_dwordx4 %0, %1, off sc1\n\ts_nop 1" :: "v"(p), "v"(v) : "memory"); }
__device__ __forceinline__ unsigned cvt_pk_bf16(float lo, float hi) { unsigned r; asm volatile("v_cvt_pk_bf16_f32 %0, %1, %2" : "=v"(r) : "v"(lo), "v"(hi)); return r; }
__device__ __forceinline__ unsigned pk4_fp8(float a, float b, float c, float d) { return (unsigned)__builtin_amdgcn_cvt_pk_fp8_f32(c, d, __builtin_amdgcn_cvt_pk_fp8_f32(a, b, 0, false), true); }
__device__ __forceinline__ float gelu_fast(float x) {
    const float c1 = -2.302208198f;
    const float c3 = c1 * 0.044715f;
    const float x2 = x * x;
    const float t = x * (c1 + c3 * x2);
    return x * __builtin_amdgcn_rcpf(1.f + __builtin_amdgcn_exp2f(t));
}

#define XB_TMO      128
#define XB_XCNT(j)  (256  + 64 * (j))
#define XB_XSUB(j)  (1280 + 64 * (j))
#define XB_XGEN(j)  (2304 + 64 * (j))
#define XB_TOP      3328
#define XB_TOPGEN   3392
#define XCD_BAR_WORDS 3456
#define XB_SPIN_CAP (1u << 18)
__device__ __forceinline__ unsigned xb_ld(unsigned* p)              { return __hip_atomic_load(p, __ATOMIC_RELAXED, __HIP_MEMORY_SCOPE_AGENT); }
__device__ __forceinline__ unsigned xb_add(unsigned* p, unsigned v) { return __hip_atomic_fetch_add(p, v, __ATOMIC_RELAXED, __HIP_MEMORY_SCOPE_AGENT); }
__device__ __forceinline__ unsigned xb_xcc_id() { return (unsigned)__builtin_amdgcn_s_getreg((3 << 11) | 20) & 0xFu; }
#define XB_SPIN(cond, bar) do { unsigned _sp = 0; while (cond) { __builtin_amdgcn_s_sleep(1); \
    if ((++_sp & 255u) == 0u) { if (xb_ld(&(bar)[XB_TMO])) break; if (_sp > XB_SPIN_CAP) { atomicAdd(&(bar)[XB_TMO], 1u); break; } } } } while (0)
struct XcdBarrier { unsigned* bar; unsigned x; volatile LAS unsigned* st; };
__device__ __forceinline__ XcdBarrier xcd_barrier_post(unsigned* bar, volatile LAS unsigned* st) {
    XcdBarrier b; b.bar = bar; b.x = xb_xcc_id(); b.st = st;
    if (threadIdx.x == 0) (void)xb_add(&bar[XB_XCNT(b.x)], 1u);
    return b;
}
__device__ __forceinline__ void xcd_barrier_complete(unsigned* bar, unsigned x, unsigned& nloc, unsigned& nx) {
    const unsigned G = gridDim.x * gridDim.y * gridDim.z;
    unsigned sum, cnt, mine, sp = 0u;
    for (;;) {
        sum = 0u; cnt = 0u; mine = 0u;
#pragma unroll
        for (unsigned j = 0; j < 16; ++j) { const unsigned c = xb_ld(&bar[XB_XCNT(j)]); sum += c; cnt += (c > 0u) ? 1u : 0u; mine = (j == x) ? c : mine; }
        if (sum == G) break;
        __builtin_amdgcn_s_sleep(1);
        if ((++sp & 255u) == 0u) { if (xb_ld(&bar[XB_TMO])) break; if (sp > XB_SPIN_CAP) { atomicAdd(&bar[XB_TMO], 1u); break; } }
    }
    nloc = mine > 0u ? mine : 1u; nx = cnt > 0u ? cnt : 1u;
}
__device__ __forceinline__ void xcd_barrier(const XcdBarrier& b) {
    asm volatile("s_waitcnt vmcnt(0)" ::: "memory");
    __syncthreads();
    if (threadIdx.x == 0) {
        unsigned* bar = b.bar;
        __builtin_amdgcn_s_waitcnt(0);
        unsigned nloc = b.st[0], nx = b.st[1];
        if (nloc == 0u) { xcd_barrier_complete(bar, b.x, nloc, nx); b.st[0] = nloc; b.st[1] = nx; }
        const unsigned old = xb_add(&bar[XB_XSUB(b.x)], 1u);
        const unsigned gen = old / nloc;
        if (old + 1u == (gen + 1u) * nloc) {
            __builtin_amdgcn_fence(__ATOMIC_RELEASE, "agent");
            asm volatile("s_waitcnt vmcnt(0)" ::: "memory");
            const unsigned og = xb_add(&bar[XB_TOP], 1u);
            const unsigned tg = og / nx;
            if (og + 1u == (tg + 1u) * nx) xb_add(&bar[XB_TOPGEN], 1u);
            else XB_SPIN(xb_ld(&bar[XB_TOPGEN]) == tg, bar);
            __builtin_amdgcn_fence(__ATOMIC_ACQUIRE, "agent");
            xb_add(&bar[XB_XGEN(b.x)], 1u);
            asm volatile("s_waitcnt vmcnt(0)" ::: "memory");
        } else {
            XB_SPIN(xb_ld(&bar[XB_XGEN(b.x)]) == gen, bar);
            __builtin_amdgcn_fence(__ATOMIC_ACQUIRE, "agent");
            asm volatile("s_waitcnt vmcnt(0)" ::: "memory");
        }
    }
    __syncthreads();
}

struct Frame {
    LAS unsigned char* lds;
    volatile LAS unsigned* MISC;
    unsigned* ctl;
    int tid, lane, wave, vcu, G;
    const float *x, *c, *ctx, *c_ctx, *ada_w, *ada_b, *w_in, *rpb, *sgu_ln_g, *sgu_ln_b, *sgu_w, *sgu_b, *w_out, *ln1_g, *ln1_b, *ln2_g, *ln2_b, *router_w, *router_b, *w_gu, *b_gu, *w_dn, *b_dn;
    float* out;
    float* mod; float* topg; int* topi; int* list; float* listg; bf16_t* sguw; bf16_t* Wt_in; bf16_t* Wt_out; unsigned char* Wt_gu; unsigned char* Wt_dn;
    bf16_t* hxc; bf16_t* proj; bf16_t* mixin; bf16_t* y1; float* x1; f32x2* stat; unsigned* cntw; unsigned char* h2; unsigned char* act; unsigned char* ybuf;
};
#define LDS_WAIT() asm volatile("s_waitcnt lgkmcnt(0)" ::: "memory")
#define VM_WAIT() asm volatile("s_waitcnt vmcnt(0)" ::: "memory")

namespace pg8 {
constexpr int BM = 256, BK = 64, HALF = 128, HTB = HALF * BK * 2, STAGE_BYTES = 8 * HTB, NXCD = 8, WGM = 8, KD = 1024, NKT = KD / BK;
__device__ __forceinline__ int lds_byte(int r, int c) { const int st = (r >> 4) * 2 + (c >> 5), rr = r & 15, cc = c & 31, ob = rr * 64 + cc * 2; return st * 1024 + (ob ^ (((ob >> 9) & 1) << 5)); }
__device__ __forceinline__ void stage_rc(int b, int& R, int& C) { const int st = b / 1024, sb = b % 1024, swz = sb ^ (((sb >> 9) & 1) << 5); R = (st >> 1) * 16 + swz / 64; C = (st & 1) * 32 + (swz % 64) / 2; }
__device__ __forceinline__ int perm32(int rho) { const int n = rho >> 4, i = rho & 15; return 8 * (i >> 2) + 4 * n + (i & 3); }
struct Unit { int pm, pn, e, nvalid, ti, rot; };
__device__ __forceinline__ void static_tile(int L, int nM, int nN, int& pm, int& pn) {
    const int nwg = nM * nN; int wgid = L;
    { const int q = nwg / NXCD, r = nwg % NXCD, xcd = wgid % NXCD, off = wgid / NXCD; wgid = (xcd < r ? xcd * (q + 1) : r * (q + 1) + (xcd - r) * q) + off; }
    const int nig = WGM * nN, gid = wgid / nig, fm = gid * WGM, gsz = (nM - fm) < WGM ? (nM - fm) : WGM;
    pm = fm + ((wgid % nig) % gsz); pn = (wgid % nig) / gsz;
}

typedef int v8i __attribute__((ext_vector_type(8)));
template <bool FP8> struct Frags;
template <> struct Frags<false> { bf16x8 At[4][2], B0[2][2], B1[2][2]; };
template <> struct Frags<true> { v8i At[4], B0[2], B1[2]; };
template <class P>
__device__ __forceinline__ void gemm_phase(LAS unsigned char* lds, const P& pol) {
    const int tid = threadIdx.x, wid = __builtin_amdgcn_readfirstlane(tid >> 6), lane = tid & 63, wr = wid >> 2, wc = wid & 3, fr = lane & 15, fq = lane >> 4;
    constexpr int KDB = P::FP8 ? 1024 : 2048, NKT_ = KDB / 128;
    unsigned voffB[2];
#pragma unroll
    for (int i = 0; i < 2; ++i) { int R, C; stage_rc(tid * 16 + i * 8192, R, C);
        int Rb = P::PERM ? ((R & ~31) + perm32(R & 31)) : R;
        if constexpr (P::BMAP16) { const int n = (R >> 4) & 1, q = R & 15; Rb = 64 * (R >> 5) + 16 * (q >> 2) + 4 * n + (q & 3); }
        voffB[i] = (unsigned)(Rb * KDB + C * 2); }
    const size_t kstep = (size_t)(BK * 2);
    const size_t hstep = (size_t)(P::BMAP16 ? 8 : HALF) * KDB;
    const unsigned ldsw = (unsigned)wid * 1024u;
    const int aoff = lds_byte(wr * 64 + fr, fq * 8), boff = lds_byte(wc * 32 + fr, fq * 8);
#define PG8_SA(b, h) (((b) * 2 + (h)) * HTB)
#define PG8_SB(b, h) ((4 + (b) * 2 + (h)) * HTB)
#define PG8_STAGE(bufoff, gbase, voff) do { _Pragma("unroll") for (int _i = 0; _i < 2; ++_i) \
        __builtin_amdgcn_global_load_lds((const unsigned*)((const char*)(gbase) + (voff)[_i]), (LAS unsigned*)(lds + (bufoff) + ldsw + _i * 8192), 16, 0, 0); } while (0)
#define PG8_RD8(p) __builtin_shufflevector(*(const LAS u32x4*)(p), *(const LAS u32x4*)((p) + 1024), 0, 1, 2, 3, 4, 5, 6, 7)
#define PG8_LDA(dst, b, h) do { if constexpr (P::FP8) { _Pragma("unroll") for (int m = 0; m < 4; ++m) fg.dst[m] = __builtin_bit_cast(v8i, PG8_RD8(lds + PG8_SA(b, h) + aoff + m * 2048)); } \
        else { _Pragma("unroll") for (int m = 0; m < 4; ++m) _Pragma("unroll") for (int k = 0; k < 2; ++k) fg.dst[m][k] = *(const LAS bf16x8*)(lds + PG8_SA(b, h) + aoff + m * 2048 + k * 1024); } } while (0)
#define PG8_LDB(dst, b, h) do { if constexpr (P::FP8) { _Pragma("unroll") for (int n = 0; n < 2; ++n) fg.dst[n] = __builtin_bit_cast(v8i, PG8_RD8(lds + PG8_SB(b, h) + boff + n * 2048)); } \
        else { _Pragma("unroll") for (int n = 0; n < 2; ++n) _Pragma("unroll") for (int k = 0; k < 2; ++k) fg.dst[n][k] = *(const LAS bf16x8*)(lds + PG8_SB(b, h) + boff + n * 2048 + k * 1024); } } while (0)
#define PG8_MMA(ai, bj, At, Bt) do { __builtin_amdgcn_s_setprio(1); \
        if constexpr (P::FP8) { _Pragma("unroll") for (int m = 0; m < 4; ++m) _Pragma("unroll") for (int n = 0; n < 2; ++n) \
            acc[ai][bj][m][n] = __builtin_amdgcn_mfma_scale_f32_16x16x128_f8f6f4(fg.Bt[n], fg.At[m], acc[ai][bj][m][n], 0, 0, 0, 0, 0, 0); } \
        else { _Pragma("unroll") for (int m = 0; m < 4; ++m) _Pragma("unroll") for (int n = 0; n < 2; ++n) _Pragma("unroll") for (int k = 0; k < 2; ++k) \
            acc[ai][bj][m][n] = __builtin_amdgcn_mfma_f32_16x16x32_bf16(fg.Bt[n][k], fg.At[m][k], acc[ai][bj][m][n], 0, 0, 0); } \
        __builtin_amdgcn_s_setprio(0); } while (0)
#define PG8_WAIT_V(n) asm volatile("s_waitcnt vmcnt(" #n ")" ::: "memory")
#define PG8_WAIT_L(n) asm volatile("s_waitcnt lgkmcnt(" #n ")" ::: "memory")
#define PG8_BAR __builtin_amdgcn_s_barrier()
#define PG8_SCHED __builtin_amdgcn_sched_barrier(0)
    Unit cur, nxt; int ui = 0;
    if (!pol.next(0, cur)) return;
    f32x4 acc[2][2][4][2];
#pragma unroll
    for (int a = 0; a < 2; ++a)
#pragma unroll
        for (int b = 0; b < 2; ++b)
#pragma unroll
            for (int m = 0; m < 4; ++m)
#pragma unroll
                for (int n = 0; n < 2; ++n) acc[a][b][m][n] = (f32x4){0.f, 0.f, 0.f, 0.f};
    Frags<P::FP8> fg;
    int slot = 0;
    if (P::META) { pol.meta_issue(cur, 0, lds, wid, lane); PG8_WAIT_V(0); asm volatile("" ::: "memory"); PG8_BAR; asm volatile("" ::: "memory"); }
    if constexpr (P::KIND == 2) pol.ready_check(cur, 0, lds);
    int pti = -1;
    unsigned aC[2][2];
    pol.a_off(cur, 0, lds, aC);
    const char* const Ab = (const char*)pol.A;
    const char* cB = pol.b_ptr(cur);
#define PG8_KO(j, r) ((size_t)(P::ROT ? (((j) + (r)) & (NKT_ - 1)) : (j)) * kstep)
    int rc = P::ROT ? cur.rot : 0;
    PG8_STAGE(PG8_SB(0, 0), cB + PG8_KO(0, rc), voffB); PG8_STAGE(PG8_SB(0, 1), cB + hstep + PG8_KO(0, rc), voffB); PG8_STAGE(PG8_SA(0, 0), Ab + PG8_KO(0, rc), aC[0]); PG8_STAGE(PG8_SA(0, 1), Ab + PG8_KO(0, rc), aC[1]);
    if (wr == 1) PG8_BAR;
    PG8_WAIT_V(2); PG8_BAR;
    PG8_STAGE(PG8_SB(1, 0), cB + PG8_KO(1, rc), voffB); PG8_STAGE(PG8_SA(1, 0), Ab + PG8_KO(1, rc), aC[0]); PG8_STAGE(PG8_SB(1, 1), cB + hstep + PG8_KO(1, rc), voffB);
    PG8_WAIT_V(6); PG8_BAR;
    for (;;) {
        const bool has_next = pol.next(ui + 1, nxt);
        const int nslot = slot == 2 ? 0 : slot + 1;
        if (P::META) { if (has_next) pol.meta_issue(nxt, nslot, lds, wid, lane); }
        const char* nB = has_next ? pol.b_ptr(nxt) : cB;
#pragma unroll 1
        for (int t = 0; t < NKT_; t += 2) {
            const bool last = (t == NKT_ - 2);
            const int rn = (P::ROT && has_next) ? nxt.rot : 0;
            const char* a1 = Ab + PG8_KO(t + 1, rc);
            const char* a2 = last ? Ab + PG8_KO(0, rn) : Ab + PG8_KO(t + 2, rc); const char* b2 = last ? nB + PG8_KO(0, rn) : cB + PG8_KO(t + 2, rc);
            const char* a3 = last ? Ab + PG8_KO(1, rn) : Ab + PG8_KO(t + 3, rc); const char* b3 = last ? nB + PG8_KO(1, rn) : cB + PG8_KO(t + 3, rc);
            PG8_LDB(B0, 0, 0); PG8_LDB(B1, 0, 1); PG8_SCHED; PG8_LDA(At, 0, 0); PG8_STAGE(PG8_SA(1, 1), a1, aC[1]);
            if (last && has_next) { if constexpr (P::KIND == 2) pol.ready_check(nxt, nslot, lds);
                pol.a_off(nxt, nslot, lds, aC); }
            PG8_WAIT_V(8); PG8_WAIT_L(0); PG8_BAR; PG8_MMA(0, 0, At, B0); PG8_MMA(0, 1, At, B1); PG8_BAR; PG8_SCHED;
            PG8_LDA(At, 0, 1); PG8_STAGE(PG8_SB(0, 0), b2, voffB); PG8_STAGE(PG8_SB(0, 1), b2 + hstep, voffB); PG8_STAGE(PG8_SA(0, 0), a2, aC[0]);
            PG8_WAIT_V(8); PG8_WAIT_L(0); PG8_BAR; PG8_MMA(1, 0, At, B0); PG8_MMA(1, 1, At, B1); PG8_BAR; PG8_SCHED;
            PG8_LDB(B0, 1, 0); PG8_LDB(B1, 1, 1); PG8_SCHED; PG8_LDA(At, 1, 0); PG8_STAGE(PG8_SA(0, 1), a2, aC[1]);
            PG8_WAIT_V(8); PG8_WAIT_L(0); PG8_BAR; PG8_MMA(0, 0, At, B0); PG8_MMA(0, 1, At, B1); PG8_BAR; PG8_SCHED;
            PG8_LDA(At, 1, 1); PG8_STAGE(PG8_SB(1, 0), b3, voffB); PG8_STAGE(PG8_SB(1, 1), b3 + hstep, voffB); PG8_STAGE(PG8_SA(1, 0), a3, aC[0]);
            PG8_WAIT_V(8); PG8_WAIT_L(0); PG8_BAR; PG8_MMA(1, 0, At, B0); PG8_MMA(1, 1, At, B1); PG8_BAR; PG8_SCHED;
        }
        if (wr == 0) PG8_BAR;
#ifdef PROBE_KLOOP2
        const bool do_epi = !(P::FP8 && P::KIND == PROBE_KLOOP2) || (ui & 1);
        if (do_epi) {
            if (P::FP8 && P::KIND == PROBE_KLOOP2) {
#pragma unroll
                for (int a = 0; a < 2; ++a)
#pragma unroll
                    for (int b = 0; b < 2; ++b)
#pragma unroll
                        for (int m = 0; m < 4; ++m)
#pragma unroll
                            for (int n = 0; n < 2; ++n) acc[a][b][m][n] *= 0.5f; }
            pol.epi(acc, cur, slot, lds, wr, wc, fr, fq); }
#else
        constexpr bool do_epi = true;
        if constexpr (P::KIND == 1) { if (pti >= 0) pol.done(pti); pti = cur.ti; }
        pol.epi(acc, cur, slot, lds, wr, wc, fr, fq);
#endif
#ifdef PROBE_EPI2
        if (P::KIND == PROBE_EPI2) { asm volatile("" ::: "memory");
#pragma unroll
            for (int a = 0; a < 2; ++a)
#pragma unroll
                for (int b = 0; b < 2; ++b)
#pragma unroll
                    for (int m = 0; m < 4; ++m)
#pragma unroll
                        for (int n = 0; n < 2; ++n) asm volatile("" : "+v"(acc[a][b][m][n]));
            pol.epi(acc, cur, slot, lds, wr, wc, fr, fq); }
#endif
        if (!has_next) break;
        if (do_epi) {
#pragma unroll
        for (int a = 0; a < 2; ++a)
#pragma unroll
            for (int b = 0; b < 2; ++b)
#pragma unroll
                for (int m = 0; m < 4; ++m)
#pragma unroll
                    for (int n = 0; n < 2; ++n) acc[a][b][m][n] = (f32x4){0.f, 0.f, 0.f, 0.f};
        }
        cur = nxt; cB = nB; ++ui; slot = nslot; rc = P::ROT ? cur.rot : 0;
        if (wr == 1) PG8_BAR;
    }
    PG8_WAIT_V(0);
    PG8_BAR;
    if constexpr (P::KIND == 1) { if (pti >= 0) pol.done(pti); }
#undef PG8_KO
#undef PG8_SA
#undef PG8_SB
#undef PG8_STAGE
#undef PG8_LDA
#undef PG8_LDB
#undef PG8_MMA
#undef PG8_RD8
#undef PG8_WAIT_V
#undef PG8_WAIT_L
#undef PG8_BAR
#undef PG8_SCHED
}
}

typedef f32x4 AccT[2][2][4][2];

#ifndef INPROJ_FP8
#define INPROJ_FP8 1
#endif
struct PolProj {
    static constexpr bool ROT = false;
    static constexpr bool BMAP16 = false; static constexpr int KIND = 0; static constexpr bool PERM = true, META = false, FP8 = INPROJ_FP8 != 0; static constexpr int SCALE_W = 0x7f7f7f7f;
    static constexpr int ES = FP8 ? 1 : 2; static constexpr float WSC = FP8 ? 1.f / 64.f : 1.f;
    const unsigned char* A; const unsigned char* Bt; bf16_t* O; int G, c;
    __device__ __forceinline__ bool next(int i, pg8::Unit& u) const {
        const int L = i * G + c;
        if (L < 640) { pg8::static_tile(L, 64, 10, u.pm, u.pn); return true; }
        if (L < 648) { const int j = L - 640; u.pm = 64 + (j >> 2); u.pn = 2 + (j & 3); return true; }
        return false;
    }
    __device__ __forceinline__ const char* b_ptr(const pg8::Unit& u) const { return (const char*)Bt + (size_t)u.pn * 256 * 1024 * ES; }
    __device__ __forceinline__ void meta_issue(const pg8::Unit&, int, LAS unsigned char*, int, int) const {}
    __device__ __forceinline__ void a_off(const pg8::Unit& u, int, LAS unsigned char*, unsigned (&o)[2][2]) const {
        int Ra[2], Ca[2]; pg8::stage_rc((int)threadIdx.x * 16, Ra[0], Ca[0]); pg8::stage_rc((int)threadIdx.x * 16 + 8192, Ra[1], Ca[1]);
#pragma unroll
        for (int h = 0; h < 2; ++h)
#pragma unroll
            for (int i = 0; i < 2; ++i) o[h][i] = (unsigned)((u.pm * 256 + 128 * h + Ra[i]) * 1024 * ES + Ca[i] * 2);
    }
    __device__ __forceinline__ void epi(const AccT& acc, const pg8::Unit& u, int, LAS unsigned char*, int wr, int wc, int fr, int fq) const {
        const int row0 = u.pm * 256 + wr * 64 + fr, col0 = u.pn * 256 + wc * 32 + 8 * fq;
        const bool act = u.pn >= 6;
#pragma unroll
        for (int ai = 0; ai < 2; ++ai)
#pragma unroll
            for (int m = 0; m < 4; ++m) { bf16_t* rowp = O + (size_t)(row0 + ai * 128 + m * 16) * DIN + col0;
#pragma unroll
                for (int bj = 0; bj < 2; ++bj) { f32x4 v0 = acc[ai][bj][m][0], v1 = acc[ai][bj][m][1];
                    if (FP8) { v0 = v0 * WSC; v1 = v1 * WSC; }
                    if (act) {
#pragma unroll
                        for (int j = 0; j < 4; ++j) { v0[j] = gelu_fast(v0[j]); v1[j] = gelu_fast(v1[j]); } }
                    u32x4 w; w.x = cvt_pk_bf16(v0[0], v0[1]); w.y = cvt_pk_bf16(v0[2], v0[3]); w.z = cvt_pk_bf16(v1[0], v1[1]); w.w = cvt_pk_bf16(v1[2], v1[3]);
                    store16_sc1(rowp + bj * 128, w); } }
    }
};

struct PolOut {
    static constexpr bool ROT = false;
    static constexpr bool BMAP16 = false; static constexpr int KIND = 0; static constexpr bool PERM = true, META = false, FP8 = false; static constexpr int SCALE_W = 0x7f7f7f7f;
    const bf16_t* A; const bf16_t* Bt; const float* x; const float* mod; bf16_t* Y; int G, c;
    __device__ __forceinline__ bool next(int i, pg8::Unit& u) const { const int L = i * G + c; if (L >= 256) return false; pg8::static_tile(L, 64, 4, u.pm, u.pn); return true; }
    __device__ __forceinline__ const char* b_ptr(const pg8::Unit& u) const { return (const char*)Bt + (size_t)u.pn * 256 * 1024 * 2; }
    __device__ __forceinline__ void meta_issue(const pg8::Unit&, int, LAS unsigned char*, int, int) const {}
    __device__ __forceinline__ void a_off(const pg8::Unit& u, int, LAS unsigned char*, unsigned (&o)[2][2]) const {
        int Ra[2], Ca[2]; pg8::stage_rc((int)threadIdx.x * 16, Ra[0], Ca[0]); pg8::stage_rc((int)threadIdx.x * 16 + 8192, Ra[1], Ca[1]);
#pragma unroll
        for (int h = 0; h < 2; ++h)
#pragma unroll
            for (int i = 0; i < 2; ++i) o[h][i] = (unsigned)((u.pm * 256 + 128 * h + Ra[i]) * 1024 + Ca[i]) * 2u;
    }
    __device__ __forceinline__ void epi(const AccT& acc, const pg8::Unit& u, int, LAS unsigned char*, int wr, int wc, int fr, int fq) const {
        const int row0 = u.pm * 256 + wr * 64 + fr, col0 = u.pn * 256 + wc * 32 + 8 * fq;
        const float* g1 = mod + (u.pm >= 32 ? 6144 : 0) + 2 * 1024;
        f32x4 gv[2][2];
#pragma unroll
        for (int bj = 0; bj < 2; ++bj)
#pragma unroll
            for (int n = 0; n < 2; ++n) gv[bj][n] = *(const f32x4*)(g1 + col0 + bj * 128 + 4 * n);
        f32x4 xq[3][4];
#define OUT_LOADX(g, slot) do { const size_t o_ = (size_t)(row0 + ((g) >> 2) * 128 + ((g) & 3) * 16) * D + col0; \
        _Pragma("unroll") for (int bj = 0; bj < 2; ++bj) { xq[slot][2 * bj] = __builtin_nontemporal_load((const f32x4*)(x + o_ + bj * 128)); xq[slot][2 * bj + 1] = __builtin_nontemporal_load((const f32x4*)(x + o_ + bj * 128 + 4)); } } while (0)
        OUT_LOADX(0, 0); OUT_LOADX(1, 1);
#pragma unroll
        for (int g = 0; g < 8; ++g) { const int ai = g >> 2, m = g & 3; const size_t off = (size_t)(row0 + ai * 128 + m * 16) * D + col0;
            if (g + 2 < 8) OUT_LOADX(g + 2, (g + 2) % 3);
            asm volatile("" ::: "memory");
#pragma unroll
            for (int bj = 0; bj < 2; ++bj) { const f32x4 x0 = xq[g % 3][2 * bj], x1v = xq[g % 3][2 * bj + 1];
                const f32x4 v0 = x0 * DN_ALPHA + gv[bj][0] * acc[ai][bj][m][0], v1 = x1v * DN_ALPHA + gv[bj][1] * acc[ai][bj][m][1];
                u32x4 w; w.x = cvt_pk_bf16(v0[0], v0[1]); w.y = cvt_pk_bf16(v0[2], v0[3]); w.z = cvt_pk_bf16(v1[0], v1[1]); w.w = cvt_pk_bf16(v1[2], v1[3]);
                *(u32x4*)(Y + off + bj * 128) = w; }
            asm volatile("" ::: "memory"); }
#undef OUT_LOADX
    }
};

struct ExpTab { const LAS int* tile_e; const LAS int* tstart; const LAS int* cnt; int T; };
__device__ __forceinline__ int expert_tables(Frame& F) {
    LAS int* tile_e = (LAS int*)(F.lds + L_TILEE); LAS int* tstart = (LAS int*)(F.lds + L_TSTART); LAS int* cn = tstart + 64;
    if (F.tid < 64) {
        const int e = F.tid, c = e < NE ? (int)__hip_atomic_load(F.ctl + CW_CNT + 32 * e, __ATOMIC_RELAXED, __HIP_MEMORY_SCOPE_AGENT) : 0, nt = (c + 255) >> 8;
        int inc = nt;
#pragma unroll
        for (int d = 1; d < 32; d <<= 1) { const int o = __shfl_up(inc, d); if ((e & 31) >= d) inc += o; }
        if (e < NE) { cn[e] = c; tstart[e] = inc - nt; if (e == NE - 1) tstart[NE] = inc;
            for (int pm = 0; pm < nt; ++pm) { const int k = inc - nt + pm; if (k < MAXT) tile_e[k] = e; } }
    }
    __syncthreads();
    const int T = tstart[NE];
    return T < MAXT ? T : MAXT;
}
__device__ __forceinline__ int rfl(int v) { return __builtin_amdgcn_readfirstlane(v); }

struct PolGU {
    static constexpr bool ROT = true;
    static constexpr bool BMAP16 = false; static constexpr int KIND = 1; static constexpr bool PERM = true, META = true, FP8 = true; static constexpr int SCALE_W = 0; static constexpr float WSC = 1.f / 64.f;
    const unsigned char* A; const unsigned char* Bt; const float* bias; const int* list; unsigned char* O; ExpTab tb; int G, c; unsigned* ready;
    __device__ __forceinline__ void done(int ti) const { if (threadIdx.x == 0) __hip_atomic_fetch_add(ready + 16 * ti, 1u, __ATOMIC_RELAXED, __HIP_MEMORY_SCOPE_AGENT); }
    __device__ __forceinline__ bool next(int i, pg8::Unit& u) const {
#if defined(PROBE_KLOOP2) && PROBE_KLOOP2 == 1
        const int L = (i >> 1) * G + c; if (L >= tb.T * 8) return false;
#else
        int L = i * G + c, rot_ = 0;
        if (G == 256) { const int x = c & 7, j = c >> 3, sl = j >> 3, ti = 32 * i + 4 * x + sl; L = ti * 8 + (j & 7); rot_ = (2 * sl) & 7; }
        if (L >= tb.T * 8) return false;
#endif
        u.ti = L >> 3; u.pn = L & 7; u.rot = rot_; u.e = rfl(tb.tile_e[u.ti]); u.pm = u.ti - rfl(tb.tstart[u.e]);
        const int rem = rfl(tb.cnt[u.e]) - u.pm * 256; u.nvalid = rem < 256 ? rem : 256; return true;
    }
    __device__ __forceinline__ const char* b_ptr(const pg8::Unit& u) const { return (const char*)Bt + ((size_t)u.e * 2048 + (size_t)u.pn * 256) * 1024; }
    __device__ __forceinline__ void meta_issue(const pg8::Unit& u, int slot, LAS unsigned char* lds, int wid, int lane) const {
        if (wid < 4) __builtin_amdgcn_global_load_lds((const unsigned*)(list + (size_t)u.e * LCAP + u.pm * 256 + wid * 64 + lane), (LAS unsigned*)(lds + L_IDX + slot * 2048 + wid * 256), 4, 0, 0);
    }
    __device__ __forceinline__ void a_off(const pg8::Unit& u, int slot, LAS unsigned char* lds, unsigned (&o)[2][2]) const {
        int Ra[2], Ca[2]; pg8::stage_rc((int)threadIdx.x * 16, Ra[0], Ca[0]); pg8::stage_rc((int)threadIdx.x * 16 + 8192, Ra[1], Ca[1]);
        const LAS int* idx = (const LAS int*)(lds + L_IDX + slot * 2048);
#pragma unroll
        for (int h = 0; h < 2; ++h)
#pragma unroll
            for (int i = 0; i < 2; ++i) { const int r = 128 * h + Ra[i]; int pr = idx[r]; pr = r < u.nvalid ? pr : 0; o[h][i] = (unsigned)((pr >> 2) * 1024 + Ca[i] * 2); }
    }
    __device__ __forceinline__ void epi(const AccT& acc, const pg8::Unit& u, int, LAS unsigned char*, int wr, int wc, int fr, int fq) const {
        const int row0 = u.ti * 256 + wr * 64 + fr, col0 = u.pn * 128 + wc * 32 + 8 * fq;
        const float* bg = bias + (size_t)u.e * 2048 + col0;
        const f32x4 g0 = *(const f32x4*)(bg), g1 = *(const f32x4*)(bg + 4), l0 = *(const f32x4*)(bg + 1024) + 1.f, l1 = *(const f32x4*)(bg + 1028) + 1.f;
#pragma unroll
        for (int ai = 0; ai < 2; ++ai)
#pragma unroll
            for (int m = 0; m < 4; ++m) {
                f32x4 r0, r1;
#pragma unroll
                for (int hp = 0; hp < 2; ++hp) {
                    const f32x2 ga0 = (f32x2){acc[ai][0][m][0][2 * hp], acc[ai][0][m][0][2 * hp + 1]} * WSC + (f32x2){g0[2 * hp], g0[2 * hp + 1]};
                    const f32x2 ga1 = (f32x2){acc[ai][0][m][1][2 * hp], acc[ai][0][m][1][2 * hp + 1]} * WSC + (f32x2){g1[2 * hp], g1[2 * hp + 1]};
                    const f32x2 lb0 = (f32x2){acc[ai][1][m][0][2 * hp], acc[ai][1][m][0][2 * hp + 1]} * WSC + (f32x2){l0[2 * hp], l0[2 * hp + 1]};
                    const f32x2 lb1 = (f32x2){acc[ai][1][m][1][2 * hp], acc[ai][1][m][1][2 * hp + 1]} * WSC + (f32x2){l1[2 * hp], l1[2 * hp + 1]};
                    f32x2 gg0, gg1, ll0, ll1, e0, e1;
                    gg0[0] = fminf(ga0[0], 7.f); gg0[1] = fminf(ga0[1], 7.f); gg1[0] = fminf(ga1[0], 7.f); gg1[1] = fminf(ga1[1], 7.f);
                    ll0[0] = __builtin_amdgcn_fmed3f(lb0[0], -6.f, 8.f); ll0[1] = __builtin_amdgcn_fmed3f(lb0[1], -6.f, 8.f); ll1[0] = __builtin_amdgcn_fmed3f(lb1[0], -6.f, 8.f); ll1[1] = __builtin_amdgcn_fmed3f(lb1[1], -6.f, 8.f);
                    const f32x2 x0 = gg0 * -2.45546696f, x1 = gg1 * -2.45546696f;
                    e0[0] = __builtin_amdgcn_exp2f(x0[0]); e0[1] = __builtin_amdgcn_exp2f(x0[1]); e1[0] = __builtin_amdgcn_exp2f(x1[0]); e1[1] = __builtin_amdgcn_exp2f(x1[1]);
                    const f32x2 d0 = e0 + 1.f, d1 = e1 + 1.f;
                    f32x2 q0, q1; q0[0] = __builtin_amdgcn_rcpf(d0[0]); q0[1] = __builtin_amdgcn_rcpf(d0[1]); q1[0] = __builtin_amdgcn_rcpf(d1[0]); q1[1] = __builtin_amdgcn_rcpf(d1[1]);
                    const f32x2 o0 = (ll0 * gg0) * q0, o1 = (ll1 * gg1) * q1;
                    r0[2 * hp] = o0[0]; r0[2 * hp + 1] = o0[1]; r1[2 * hp] = o1[0]; r1[2 * hp + 1] = o1[1];
                }
                u32x2 w; w.x = (unsigned)__builtin_amdgcn_cvt_pk_fp8_f32(r0[2], r0[3], __builtin_amdgcn_cvt_pk_fp8_f32(r0[0], r0[1], 0, false), true);
                w.y = (unsigned)__builtin_amdgcn_cvt_pk_fp8_f32(r1[2], r1[3], __builtin_amdgcn_cvt_pk_fp8_f32(r1[0], r1[1], 0, false), true);
                store8_sc1(O + (size_t)(row0 + ai * 128 + m * 16) * DFF + col0, w); }
    }
};

struct PolDN {
    static constexpr bool ROT = true;
    static constexpr float YSC = 16.f; static constexpr bool BMAP16 = true; static constexpr int KIND = 2; static constexpr bool PERM = true, META = true, FP8 = true; static constexpr int SCALE_W = 0; static constexpr float WSC = 1.f / 64.f;
    const unsigned char* A; const unsigned char* Bt; const float* bias; const int* list; const float* listg; unsigned char* O; ExpTab tb; int G, c; const unsigned* ready; int i_off, bx;
    __device__ __forceinline__ bool next(int i, pg8::Unit& u) const {
#if defined(PROBE_KLOOP2) && PROBE_KLOOP2 == 2
        const int L = ((i >> 1) + i_off) * G + c - tb.T * 8; if (L >= tb.T * 4) return false;
#else
        int L = (i + i_off) * G + c - tb.T * 8, rot_ = 0;
        if (G == 256) { const int x = 7 - (bx & 7), j = bx >> 3, sl = j >> 2, ti = 64 * i + 8 * x + sl; L = ti * 4 + (j & 3); rot_ = (3 * sl) & 7; }
        if (L >= tb.T * 4) return false;
#endif
        u.ti = L >> 2; u.pn = L & 3; u.rot = rot_; u.e = rfl(tb.tile_e[u.ti]); u.pm = u.ti - rfl(tb.tstart[u.e]);
        const int rem = rfl(tb.cnt[u.e]) - u.pm * 256; u.nvalid = rem < 256 ? rem : 256; return true;
    }
    __device__ __forceinline__ const char* b_ptr(const pg8::Unit& u) const { return (const char*)Bt + ((size_t)u.e * 1024 + (size_t)u.pn * 256) * 1024; }
    __device__ __forceinline__ void meta_issue(const pg8::Unit& u, int slot, LAS unsigned char* lds, int wid, int lane) const {
        if (wid < 4) __builtin_amdgcn_global_load_lds((const unsigned*)(list + (size_t)u.e * LCAP + u.pm * 256 + wid * 64 + lane), (LAS unsigned*)(lds + L_IDX + slot * 2048 + wid * 256), 4, 0, 0);
        else __builtin_amdgcn_global_load_lds((const unsigned*)(listg + (size_t)u.e * LCAP + u.pm * 256 + (wid - 4) * 64 + lane), (LAS unsigned*)(lds + L_IDX + slot * 2048 + 1024 + (wid - 4) * 256), 4, 0, 0);
        if (wid == 0 && lane == 0) __builtin_amdgcn_global_load_lds(ready + 16 * u.ti, (LAS unsigned*)(lds + L_RDY + slot * 4), 4, 0, 16);
    }
    __device__ __forceinline__ void ready_check(const pg8::Unit& u, int slot, LAS unsigned char* lds) const {
        if (rfl((int)*(const LAS unsigned*)(lds + L_RDY + slot * 4)) >= 8) return;
        for (unsigned spins = 0; spins < (1u << 22); ++spins) {
            if (rfl((int)__hip_atomic_load(ready + 16 * u.ti, __ATOMIC_RELAXED, __HIP_MEMORY_SCOPE_AGENT)) >= 8) break;
            __builtin_amdgcn_s_sleep(2);
        }
    }
    __device__ __forceinline__ void a_off(const pg8::Unit& u, int, LAS unsigned char*, unsigned (&o)[2][2]) const {
        int Ra[2], Ca[2]; pg8::stage_rc((int)threadIdx.x * 16, Ra[0], Ca[0]); pg8::stage_rc((int)threadIdx.x * 16 + 8192, Ra[1], Ca[1]);
#pragma unroll
        for (int h = 0; h < 2; ++h)
#pragma unroll
            for (int i = 0; i < 2; ++i) o[h][i] = (unsigned)((u.ti * 256 + 128 * h + Ra[i]) * 1024 + Ca[i] * 2);
    }
    __device__ __forceinline__ void epi(const AccT& acc, const pg8::Unit& u, int slot, LAS unsigned char* lds, int wr, int wc, int fr, int fq) const {
        const LAS int* idx = (const LAS int*)(lds + L_IDX + slot * 2048);
        const int col0 = u.pn * 256 + wc * 64 + 16 * fq;
        const float* bd = bias + (size_t)u.e * 1024 + col0;
        f32x4 bv[2][2];
#pragma unroll
        for (int bj = 0; bj < 2; ++bj)
#pragma unroll
            for (int n = 0; n < 2; ++n) bv[bj][n] = *(const f32x4*)(bd + 8 * bj + 4 * n);
#pragma unroll
        for (int ai = 0; ai < 2; ++ai)
#pragma unroll
            for (int m = 0; m < 4; ++m) { const int r = ai * 128 + wr * 64 + m * 16 + fr;
                if (r < u.nvalid) { const int pr = idx[r]; const float gt = ((const LAS float*)idx)[256 + r] * YSC;
                    u32x4 w;
#pragma unroll
                    for (int bj = 0; bj < 2; ++bj) { const f32x4 v0 = (acc[ai][bj][m][0] * WSC + bv[bj][0]) * gt, v1 = (acc[ai][bj][m][1] * WSC + bv[bj][1]) * gt;
                        w[2 * bj] = pk4_fp8(v0[0], v0[1], v0[2], v0[3]); w[2 * bj + 1] = pk4_fp8(v1[0], v1[1], v1[2], v1[3]); }
                    __builtin_nontemporal_store(w, (u32x4*)(O + (size_t)pr * D + col0)); } }
    }
};

__device__ __forceinline__ void p_ada(Frame& F) {
    LAS float* sl = (LAS float*)F.lds;
    LAS float* red = sl + 3072;
    { float cv[6];
#pragma unroll
      for (int it = 0; it < 6; ++it) { const int i = F.tid + 512 * it, w = i >> 10, k = i & 1023; cv[it] = w < 2 ? F.c[w * D + k] : F.c_ctx[k]; }
#pragma unroll
      for (int it = 0; it < 6; ++it) sl[F.tid + 512 * it] = cv[it] / (1.f + __expf(-cv[it])); }
    __syncthreads();
    for (int slab = blockIdx.x; slab < 256; slab += F.G) {
        const int j0 = slab * 24, cg = F.tid % 6, kr = F.tid / 6;
        float a[3][4] = {};
        if (F.tid < 480) {
            f32x4 wq[13];
#pragma unroll
            for (int i = 0; i < 13; ++i) { const int k = kr + 80 * i; wq[i] = __builtin_nontemporal_load((const f32x4*)(F.ada_w + (size_t)(k < D ? k : kr) * 6144 + j0 + 4 * cg)); }
#pragma unroll
            for (int i = 0; i < 13; ++i) { const int k = kr + 80 * i; const bool in = k < D; const int kk = in ? k : kr;
                const float s0 = in ? sl[kk] : 0.f, s1 = in ? sl[1024 + kk] : 0.f, s2 = in ? sl[2048 + kk] : 0.f;
#pragma unroll
                for (int q = 0; q < 4; ++q) { a[0][q] += s0 * wq[i][q]; a[1][q] += s1 * wq[i][q]; a[2][q] += s2 * wq[i][q]; }
            }
#pragma unroll
            for (int w = 0; w < 3; ++w)
#pragma unroll
                for (int q = 0; q < 4; ++q) red[kr * 72 + cg * 12 + w * 4 + q] = a[w][q];
        }
        __syncthreads();
        if (F.tid < 72) {
            float s = 0.f;
            for (int r = 0; r < 80; ++r) s += red[r * 72 + F.tid];
            const int g = F.tid / 12, w = (F.tid % 12) >> 2, q = F.tid & 3, col = j0 + 4 * g + q;
            F.mod[w * 6144 + col] = s + F.ada_b[col];
        }
        __syncthreads();
    }
}

__device__ __forceinline__ void transpose_item(const float* W, int K, int N, bf16_t* WT, int item, bool gu_map, LAS float* scr, int lane) {
    const int nblk = N / 32, kb = item / nblk, nb = item % nblk, k0 = 64 * kb, n0 = 32 * nb;
#pragma unroll 8
    for (int i = 0; i < 32; ++i) { const int kk = 2 * i + (lane >> 5); scr[kk * 33 + (lane & 31)] = __builtin_nontemporal_load(W + (size_t)(k0 + kk) * N + n0 + (lane & 31)); }
    LDS_WAIT(); asm volatile("" ::: "memory");
    int d0 = n0;
    if (gu_map) { const int nn = n0 & 1023; d0 = (nn >> 7) * 256 + (nn & 127) + ((n0 >> 10) ? 128 : 0); }
    const int c = lane & 7;
#pragma unroll
    for (int j = 0; j < 4; ++j) { const int n = (lane >> 3) + 8 * j; const LAS float* s = scr + (8 * c) * 33 + n;
        u32x4 o; o.x = pk2(s[0 * 33], s[1 * 33]); o.y = pk2(s[2 * 33], s[3 * 33]); o.z = pk2(s[4 * 33], s[5 * 33]); o.w = pk2(s[6 * 33], s[7 * 33]);
        *(u32x4*)(WT + (size_t)(d0 + n) * K + k0 + 8 * c) = o; }
    LDS_WAIT(); asm volatile("" ::: "memory");
}
__device__ __forceinline__ void transpose_item8(const float* W, int K, int N, unsigned char* WT, int item, bool gu_map, LAS float* scr, int lane) {
    const int nblk = N / 32, kb = item / nblk, nb = item % nblk, k0 = 64 * kb, n0 = 32 * nb;
#pragma unroll 8
    for (int i = 0; i < 32; ++i) { const int kk = 2 * i + (lane >> 5); scr[kk * 33 + (lane & 31)] = __builtin_nontemporal_load(W + (size_t)(k0 + kk) * N + n0 + (lane & 31)); }
    LDS_WAIT(); asm volatile("" ::: "memory");
    int d0 = n0;
    if (gu_map) { const int nn = n0 & 1023; d0 = (nn >> 7) * 256 + (nn & 127) + ((n0 >> 10) ? 128 : 0); }
    const int c = lane & 7;
#pragma unroll
    for (int j = 0; j < 4; ++j) { const int n = (lane >> 3) + 8 * j; const LAS float* s = scr + (8 * c) * 33 + n;
        u32x2 o; o.x = pk4_fp8(s[0 * 33] * 64.f, s[1 * 33] * 64.f, s[2 * 33] * 64.f, s[3 * 33] * 64.f); o.y = pk4_fp8(s[4 * 33] * 64.f, s[5 * 33] * 64.f, s[6 * 33] * 64.f, s[7 * 33] * 64.f);
        __builtin_nontemporal_store(o, (u32x2*)(WT + (size_t)(d0 + n) * K + k0 + 8 * c)); }
    LDS_WAIT(); asm volatile("" ::: "memory");
}
__device__ __forceinline__ void p_weights(Frame& F, int it_lo, int n_items, int gw, int NGW, bool with_sgu) {
    LAS float* scr = (LAS float*)(F.lds + F.wave * 16384);
    constexpr int I_IN = 16 * 80, I_OUT = 16 * 32, I_GU = 16 * 64, I_DN = 16 * 32;
    constexpr int NITEMS = I_IN + I_OUT + NE * I_GU + NE * I_DN;
    for (int it0 = gw; it0 < n_items; it0 += NGW) {
        const int it = it_lo + it0; int r = it;
        if (r < I_IN) { if (PolProj::FP8) transpose_item8(F.w_in, D, DIN, (unsigned char*)F.Wt_in, r, false, scr, F.lane); else transpose_item(F.w_in, D, DIN, F.Wt_in, r, false, scr, F.lane); continue; } r -= I_IN;
        if (r < I_OUT) { transpose_item(F.w_out, D, D, F.Wt_out, r, false, scr, F.lane); continue; } r -= I_OUT;
        if (r < NE * I_GU) { const int e = r / I_GU; transpose_item8(F.w_gu + (size_t)e * D * 2048, D, 2048, F.Wt_gu + (size_t)e * 2048 * D, r % I_GU, true, scr, F.lane); continue; } r -= NE * I_GU;
        { const int e = r / I_DN; transpose_item8(F.w_dn + (size_t)e * DFF * D, DFF, D, F.Wt_dn + (size_t)e * D * DFF, r % I_DN, false, scr, F.lane); }
    }
    if (with_sgu) for (int i = (blockIdx.x * 512 + F.tid) * 4; i < 4 * 128 * 128; i += F.G * 512 * 4) {
        const f32x4 v = *(const f32x4*)(F.sgu_w + i); u32x2 o; o.x = pk2(v[0], v[1]); o.y = pk2(v[2], v[3]); *(u32x2*)(F.sguw + i) = o; }
}
__device__ __forceinline__ void p_lnmod(Frame& F) {
    const int gw = F.vcu * 8 + F.wave, NGW = F.G * 8;
    f32x4 nv[4], sh[4], sc1[4];
    int cur_src = -1;
    if (gw < MX) { const f32x4* xp = (const f32x4*)(gw < M ? F.x + (size_t)gw * D : F.ctx + (size_t)(gw - M) * D) + F.lane;
#pragma unroll
        for (int j = 0; j < 4; ++j) nv[j] = __builtin_nontemporal_load(xp + 64 * j); }
    for (int row = gw; row < MX; row += NGW) {
        const int src = row < M ? (row >> 13) : 2;
        if (src != cur_src) { cur_src = src; const float* md = F.mod + src * 6144;
#pragma unroll
            for (int j = 0; j < 4; ++j) { sh[j] = *((const f32x4*)md + F.lane + 64 * j); sc1[j] = *((const f32x4*)(md + 1024) + F.lane + 64 * j) + 1.f; } }
        f32x4 v[4]; float s = 0.f;
#pragma unroll
        for (int j = 0; j < 4; ++j) { v[j] = nv[j]; s += (v[j][0] + v[j][1]) + (v[j][2] + v[j][3]); }
        { const int nrow = row + NGW;
          if (nrow < MX) { const f32x4* xp = (const f32x4*)(nrow < M ? F.x + (size_t)nrow * D : F.ctx + (size_t)(nrow - M) * D) + F.lane;
#pragma unroll
              for (int j = 0; j < 4; ++j) nv[j] = __builtin_nontemporal_load(xp + 64 * j); } }
        const float mean = wsum(s) * (1.f / D); float q = 0.f;
#pragma unroll
        for (int j = 0; j < 4; ++j) { v[j] = v[j] - mean; q += (v[j][0] * v[j][0] + v[j][1] * v[j][1]) + (v[j][2] * v[j][2] + v[j][3] * v[j][3]); }
        const float rstd = rsqrtf(wsum(q) * (1.f / D) + EPS);
        u32x2* op = (u32x2*)(F.hxc + (size_t)row * D) + F.lane; unsigned* op8 = (unsigned*)((unsigned char*)F.hxc + (size_t)row * D) + F.lane;
#pragma unroll
        for (int j = 0; j < 4; ++j) { const f32x4 o = v[j] * rstd * sc1[j] + sh[j];
            if (PolProj::FP8) op8[64 * j] = pk4_fp8(o[0], o[1], o[2], o[3]);
            else { u32x2 w; w.x = pk2(o[0], o[1]); w.y = pk2(o[2], o[3]); op[64 * j] = w; } }
    }
}

__device__ __forceinline__ void p_attn_simple(Frame& F) {
    LAS float* sq = (LAS float*)(F.lds + F.wave * 4096);
    LAS float* sp = sq + 64;
    const int gw = F.vcu * 8 + F.wave, NGW = F.G * 8;
    for (int gid = gw; gid < M * NH; gid += NGW) {
        const int h = gid & 7, tok = gid >> 3, b = tok >> 13, t = tok & (S - 1), r = t >> 6, c = t & 63;
        const int rs = min(max(r - KH / 2, 0), ROWS - KH), cs = min(max(c - KW / 2, 0), GW - KW);
        sq[F.lane] = bf2f(F.proj[(size_t)tok * DIN + h * 64 + F.lane]);
        LDS_WAIT(); asm volatile("" ::: "memory");
        float sc[6]; float mx = -1e30f;
#pragma unroll
        for (int i = 0; i < 6; ++i) {
            const int kk = F.lane + 64 * i;
            const bf16_t* kp; float bias = 0.f;
            if (kk < 128) { const int ki = kk >> 4, kj = kk & 15;
                kp = F.proj + (size_t)(b * S + (rs + ki) * GW + cs + kj) * DIN + 512 + h * 64;
                bias = F.rpb[(h * 15 + (rs + ki - r + 7)) * 31 + (cs + kj - c + 15)];
            } else kp = F.proj + (size_t)(M + b * CTX + (kk - 128)) * DIN + 512 + h * 64;
            float d = 0.f;
#pragma unroll
            for (int dd = 0; dd < 64; dd += 8) { const u32x4 kv = *(const u32x4*)(kp + dd);
                d += sq[dd] * bflo(kv.x) + sq[dd + 1] * bfhi(kv.x) + sq[dd + 2] * bflo(kv.y) + sq[dd + 3] * bfhi(kv.y) + sq[dd + 4] * bflo(kv.z) + sq[dd + 5] * bfhi(kv.z) + sq[dd + 6] * bflo(kv.w) + sq[dd + 7] * bfhi(kv.w); }
            sc[i] = d * 0.125f + bias; mx = fmaxf(mx, sc[i]);
        }
        mx = wmax(mx);
        float sum = 0.f;
#pragma unroll
        for (int i = 0; i < 6; ++i) { const float p = __expf(sc[i] - mx); sum += p; sp[F.lane + 64 * i] = p; }
        sum = wsum(sum);
        LDS_WAIT(); asm volatile("" ::: "memory");
        float acc = 0.f;
        for (int kk = 0; kk < 384; ++kk) {
            const bf16_t* vp;
            if (kk < 128) { const int ki = kk >> 4, kj = kk & 15; vp = F.proj + (size_t)(b * S + (rs + ki) * GW + cs + kj) * DIN + 1024 + h * 64; }
            else vp = F.proj + (size_t)(M + b * CTX + (kk - 128)) * DIN + 1024 + h * 64;
            acc += sp[kk] * bf2f(vp[F.lane]);
        }
        F.mixin[(size_t)tok * D + h * 64 + F.lane] = (bf16_t)f2bf(acc / sum);
        LDS_WAIT(); asm volatile("" ::: "memory");
    }
}
__device__ __forceinline__ void p_sgu_simple(Frame& F) {
    LAS bf16_t* G = (LAS bf16_t*)F.lds;
    for (int u = blockIdx.x; u < M / 128; u += F.G) {
        const int base = u * 128;
        for (int tl = F.wave; tl < 128; tl += 8) {
            const bf16_t* zr = F.proj + (size_t)(base + tl) * DIN + 2048 + F.lane * 8;
            const u32x4 zv = *(const u32x4*)zr;
            float v[8] = {bflo(zv.x), bfhi(zv.x), bflo(zv.y), bfhi(zv.y), bflo(zv.z), bfhi(zv.z), bflo(zv.w), bfhi(zv.w)};
            float s = 0.f;
#pragma unroll
            for (int i = 0; i < 8; ++i) s += v[i];
            const float mean = wsum(s) * (1.f / 512.f); float q = 0.f;
#pragma unroll
            for (int i = 0; i < 8; ++i) { v[i] -= mean; q += v[i] * v[i]; }
            const float rstd = rsqrtf(wsum(q) * (1.f / 512.f) + EPS);
#pragma unroll
            for (int i = 0; i < 8; ++i) { const int ch = F.lane * 8 + i; G[tl * 512 + ch] = (bf16_t)f2bf(v[i] * rstd * F.sgu_ln_g[ch] + F.sgu_ln_b[ch]); }
        }
        __syncthreads();
        const int ch = F.tid, grp = ch >> 7;
        for (int i = 0; i < 128; ++i) {
            const float* wrow = F.sgu_w + (size_t)(grp * 128 + i) * 128;
            float acc = 0.f;
            for (int j = 0; j < 128; ++j) acc += wrow[j] * bf2f(G[j * 512 + ch]);
            acc += F.sgu_b[grp * 128 + i];
            const float uu = bf2f(F.proj[(size_t)(base + i) * DIN + 1536 + ch]);
            F.mixin[(size_t)(base + i) * D + 512 + ch] = (bf16_t)f2bf(uu * acc);
        }
        __syncthreads();
    }
}

namespace at {
typedef float f32x16 __attribute__((ext_vector_type(16)));
typedef short s16x4 __attribute__((ext_vector_type(4)));
typedef short v4i16_t __attribute__((ext_vector_type(4)));
constexpr int A_K = 0, A_V = 32768, A_STG = 65536, A_WSF = 98304, A_RPB = 100352;
constexpr float C2 = 0.125f * 1.4426950408889634f, L2E = 1.4426950408889634f;
__device__ __forceinline__ int crow(int r, int hi) { return (r & 3) + 8 * (r >> 2) + 4 * hi; }
__device__ __forceinline__ s16x4 vtr(const LAS unsigned char* p) { return __builtin_bit_cast(s16x4, __builtin_amdgcn_ds_read_tr16_b64_v4i16((LAS v4i16_t*)p)); }
__device__ __forceinline__ int rsf(int r) { return min(max(r - KH / 2, 0), ROWS - KH); }
#define AT_WAIT_BAR() asm volatile("s_waitcnt vmcnt(0) lgkmcnt(0)\n\ts_barrier" ::: "memory")
__device__ __forceinline__ void glds16(const void* gsrc, unsigned lds_dst) { unsigned keep;
    asm volatile("s_mov_b32 %0, m0\n\ts_mov_b32 m0, %2\n\ts_nop 0\n\tglobal_load_lds_dwordx4 %1, off\n\ts_mov_b32 m0, %0" : "=&s"(keep) : "v"(gsrc), "s"(lds_dst) : "memory"); }

template <int MODE> __device__ __forceinline__ constexpr bool act0(int rr) { return MODE != 2 || rr >= 12; }
template <int MODE> __device__ __forceinline__ constexpr bool act1(int rr) { return MODE != 1 || rr < 4; }
template <int MODE> __device__ __forceinline__ constexpr int mki0(int rr) { return MODE == 1 ? rr : rr - 12; }
template <int MODE> __device__ __forceinline__ constexpr int mki1(int rr) { return MODE == 1 ? 16 + rr : 4 + rr; }
template <int MODE>
__device__ __forceinline__ void tile_compute(const LAS unsigned char* kp0, const LAS unsigned char* vp, const LAS float* tb, const bf16x8 (&qr)[4], f32x16 (&o)[2], float& m, float& l,
                                             LAS float* wsf, int r32, int hi, const float (&mk)[20]) {
    f32x16 p0, p1;
#pragma unroll
    for (int i = 0; i < 16; ++i) { p0[i] = 0.f; p1[i] = 0.f; }
#pragma unroll
    for (int d0 = 0; d0 < 4; ++d0) {
        const bf16x8 b0 = *(const LAS bf16x8*)(kp0 + d0 * 2048), b1 = *(const LAS bf16x8*)(kp0 + d0 * 2048 + 512);
        p0 = __builtin_amdgcn_mfma_f32_32x32x16_bf16(b0, qr[d0], p0, 0, 0, 0);
        p1 = __builtin_amdgcn_mfma_f32_32x32x16_bf16(b1, qr[d0], p1, 0, 0, 0);
    }
    float tm = -INFINITY;
#pragma unroll
    for (int rr = 0; rr < 16; ++rr) { const int ko = (rr & 3) + 8 * (rr >> 2);
        if (MODE == 0) { p0[rr] *= C2; p1[rr] *= C2; tm = fmaxf(tm, fmaxf(p0[rr], p1[rr])); }
        else {
            if (act0<MODE>(rr)) { p0[rr] = (p0[rr] * C2 + tb[ko]) + mk[mki0<MODE>(rr)]; tm = fmaxf(tm, p0[rr]); }
            if (act1<MODE>(rr)) { p1[rr] = (p1[rr] * C2 + tb[ko + 32]) + mk[mki1<MODE>(rr)]; tm = fmaxf(tm, p1[rr]); }
        } }
    { float a = tm, bq = tm; asm volatile("s_nop 1\n\tv_permlane32_swap_b32 %0, %1" : "+v"(a), "+v"(bq)); tm = fmaxf(a, bq); }
    const float mn = fmaxf(m, tm), alpha = __builtin_amdgcn_exp2f(m - mn);
    float rsum = 0.f;
#pragma unroll
    for (int rr = 0; rr < 16; ++rr) {
        if (act0<MODE>(rr)) { p0[rr] = __builtin_amdgcn_exp2f(p0[rr] - mn); rsum += p0[rr]; } else p0[rr] = 0.f;
        if (act1<MODE>(rr)) { p1[rr] = __builtin_amdgcn_exp2f(p1[rr] - mn); rsum += p1[rr]; } else p1[rr] = 0.f; }
    l = l * alpha + rsum; m = mn;
    if (__any(alpha != 1.f)) {
        if (hi == 0) wsf[r32] = alpha;
        LDS_WAIT();
#pragma unroll
        for (int rr = 0; rr < 16; ++rr) { const float a = wsf[crow(rr, hi)]; o[0][rr] *= a; o[1][rr] *= a; }
        LDS_WAIT();
    }
    u32x4 pw[4];
#pragma unroll
    for (int q = 0; q < 4; ++q) { pw[0][q] = cvt_pk_bf16(p0[2 * q], p0[2 * q + 1]); pw[1][q] = cvt_pk_bf16(p0[8 + 2 * q], p0[9 + 2 * q]);
                                  pw[2][q] = cvt_pk_bf16(p1[2 * q], p1[2 * q + 1]); pw[3][q] = cvt_pk_bf16(p1[8 + 2 * q], p1[9 + 2 * q]); }
#pragma unroll
    for (int d0 = 0; d0 < 2; ++d0)
#pragma unroll
        for (int ks = 0; ks < 4; ++ks) {
            if ((MODE == 1 && ks == 3) || (MODE == 2 && ks == 0)) continue;
            const s16x4 lo = vtr(vp + d0 * 4096 + ks * 1024), hh = vtr(vp + d0 * 4096 + ks * 1024 + 512);
            const bf16x8 vf = (bf16x8){lo[0], lo[1], lo[2], lo[3], hh[0], hh[1], hh[2], hh[3]};
            o[d0] = __builtin_amdgcn_mfma_f32_32x32x16_bf16(__builtin_bit_cast(bf16x8, pw[ks]), vf, o[d0], 0, 0, 0);
        }
}

__device__ __forceinline__ void attn_unit(Frame& F, int b, int h, int rg, int& tbl_h) {
    const int lane = F.lane, r32 = lane & 31, hi = lane >> 5, w = F.wave;
    const int r0 = 4 * rg, r = r0 + (w >> 1), c = 32 * (w & 1) + r32;
    const int krlo = rsf(r0), nnb = rsf(r0 + 3) + 7 - krlo + 1, nst = nnb + 4;
    const int rsw = rsf(r), cs = min(max(c - KW / 2, 0), GW - KW);
    LAS float* tbl = (LAS float*)(F.lds + A_RPB);
    LAS float* wsf = (LAS float*)(F.lds + A_WSF) + w * 64;
    if (tbl_h != h) { tbl_h = h;
        for (int i = F.tid; i < 480; i += 512) { const int dr = i >> 5, dc = i & 31; tbl[64 + i] = dc < 31 ? F.rpb[(h * 15 + dr) * 31 + dc] * L2E : 0.f; } }
    const bf16_t* qp = F.proj + (size_t)(b * S + r * GW + c) * DIN + h * 64 + hi * 8;
    bf16x8 qr[4];
#pragma unroll
    for (int d0 = 0; d0 < 4; ++d0) qr[d0] = *(const bf16x8*)(qp + d0 * 16);
    const bf16_t* kbase = F.proj + 512 + h * 64 + w * 8;
    const bf16_t* vbase = F.proj + 1024 + h * 64 + (w >> 2) * 32 + (lane & 3) * 8;
#define AT_DMA(st) do { const int _t0 = (st) < nnb ? b * S + (krlo + (st)) * GW : M + b * CTX + ((st) - nnb) * 64; const int _bf = ((st) & 3) * 8192; \
        __builtin_amdgcn_global_load_lds((const unsigned*)(kbase + (size_t)(_t0 + lane) * DIN), (LAS unsigned*)(F.lds + A_K + _bf + w * 1024), 16, 0, 0); \
        __builtin_amdgcn_global_load_lds((const unsigned*)(vbase + (size_t)(_t0 + 16 * (w & 3) + (lane >> 2)) * DIN), (LAS unsigned*)(F.lds + A_V + _bf + w * 1024), 16, 0, 0); } while (0)
    const unsigned lds0 = (unsigned)(size_t)F.lds;
    float m = -1e30f, l = 0.f;
    f32x16 o[2];
#pragma unroll
    for (int i = 0; i < 16; ++i) { o[0][i] = 0.f; o[1][i] = 0.f; }
    float mk[20];
#pragma unroll
    for (int i = 0; i < 20; ++i) { int rr, add32;
        if ((w & 1) == 0) { rr = i < 16 ? i : i - 16; add32 = i < 16 ? 0 : 32; } else { rr = i < 4 ? 12 + i : i - 4; add32 = i < 4 ? 0 : 32; }
        const int kc = (rr & 3) + 8 * (rr >> 2) + 4 * hi + add32;
        mk[i] = (unsigned)(kc - cs) < (unsigned)KW ? 0.f : -INFINITY; asm volatile("" : "+v"(mk[i])); }
    AT_DMA(0); AT_DMA(1); AT_DMA(2);
    for (int st = 0; st < nst; ++st) {
        if (st + 2 < nst) asm volatile("s_waitcnt vmcnt(4) lgkmcnt(0)\n\ts_barrier" ::: "memory");
        else if (st + 1 < nst) asm volatile("s_waitcnt vmcnt(2) lgkmcnt(0)\n\ts_barrier" ::: "memory");
        else AT_WAIT_BAR();
        if (st + 3 < nst) AT_DMA(st + 3);
        const bool isnb = st < nnb; const int kr = krlo + st;
        const bool act = !isnb || (kr >= rsw && kr < rsw + KH);
        if (act) {
            const LAS unsigned char* kp0 = F.lds + A_K + (st & 3) * 8192 + hi * 1024 + r32 * 16;
            const LAS unsigned char* vp = F.lds + A_V + (st & 3) * 8192 + ((lane >> 4) & 1) * 32 + (lane & 3) * 8 + (4 * hi + ((lane & 15) >> 2)) * 64;
            const LAS float* tb = tbl + 64 + (kr - r + 7) * 32 + 4 * hi - c + 15;
            if (!isnb) tile_compute<0>(kp0, vp, tb, qr, o, m, l, wsf, r32, hi, mk);
            else if ((w & 1) == 0) tile_compute<1>(kp0, vp, tb, qr, o, m, l, wsf, r32, hi, mk);
            else tile_compute<2>(kp0, vp, tb, qr, o, m, l, wsf, r32, hi, mk);
        }
    }
#undef AT_DMA
    l += __shfl_xor(l, 32);
    if (hi == 0) wsf[32 + r32] = l;
    LDS_WAIT();
    LAS bf16_t* stg = (LAS bf16_t*)(F.lds + A_STG) + w * 2048;
#pragma unroll
    for (int rr = 0; rr < 16; ++rr) { const int orow = crow(rr, hi); const float rl = __builtin_amdgcn_rcpf(wsf[32 + orow]);
        stg[orow * 64 + r32] = (bf16_t)f2bf(o[0][rr] * rl); stg[orow * 64 + 32 + r32] = (bf16_t)f2bf(o[1][rr] * rl); }
    LDS_WAIT();
    bf16_t* ow = F.mixin + (size_t)(b * S + r * GW + 32 * (w & 1)) * D + h * 64;
#pragma unroll
    for (int i = 0; i < 4; ++i) { const int row = i * 8 + (lane >> 3), ch = lane & 7; const u32x4 v = *(const LAS u32x4*)(stg + row * 64 + ch * 8); *(u32x4*)(ow + (size_t)row * D + ch * 8) = v; }
    asm volatile("s_waitcnt lgkmcnt(0)\n\ts_barrier" ::: "memory");
}

constexpr int G_IMG = 0, G_STG = 65536, G_STAT = 98304;
__device__ __forceinline__ void sgu_unit(Frame& F, int chunk, int gh) {
    const int lane = F.lane, r32 = lane & 31, hi = lane >> 5, w = F.wave;
    const int base = chunk * 128;
    LAS f32x2* stat = (LAS f32x2*)(F.lds + G_STAT);
    u32x4 zrow[16];
#pragma unroll
    for (int t = 0; t < 16; ++t) zrow[t] = *(const u32x4*)(F.proj + (size_t)(base + 16 * w + t) * DIN + 2048 + lane * 8);
    const int cb = w & 3, th = w >> 2, grp = 2 * gh + (cb >> 1);
    const bf16_t* wp = F.sguw + (size_t)(grp * 128 + 64 * th + r32) * 128 + 8 * hi;
    bf16x8 wf0[8], wf1[8];
#pragma unroll
    for (int ks = 0; ks < 8; ++ks) { wf0[ks] = *(const bf16x8*)(wp + ks * 16); wf1[ks] = *(const bf16x8*)(wp + 32 * 128 + ks * 16); }
    {
        const int chl = 8 * (lane & 31), ch0 = 256 * gh + chl;
        const f32x4 g0 = *(const f32x4*)(F.sgu_ln_g + ch0), g1 = *(const f32x4*)(F.sgu_ln_g + ch0 + 4), b0 = *(const f32x4*)(F.sgu_ln_b + ch0), b1 = *(const f32x4*)(F.sgu_ln_b + ch0 + 4);
        LAS unsigned char* img = F.lds + G_IMG + (chl >> 5) * 8192 + ((chl & 31) >> 3) * 16;
#pragma unroll
        for (int t = 0; t < 16; ++t) {
            const int tok = 16 * w + t;
            const u32x4 zv = zrow[t];
            float v[8] = {bflo(zv.x), bfhi(zv.x), bflo(zv.y), bfhi(zv.y), bflo(zv.z), bfhi(zv.z), bflo(zv.w), bfhi(zv.w)};
            float s = 0.f;
#pragma unroll
            for (int i = 0; i < 8; ++i) s += v[i];
            const float mean = wsum(s) * (1.f / 512.f); float q = 0.f;
#pragma unroll
            for (int i = 0; i < 8; ++i) { v[i] -= mean; q += v[i] * v[i]; }
            const float rstd = rsqrtf(wsum(q) * (1.f / 512.f) + EPS);
            if ((lane >> 5) == gh) {
                u32x4 o;
                o.x = pk2(v[0] * rstd * g0[0] + b0[0], v[1] * rstd * g0[1] + b0[1]); o.y = pk2(v[2] * rstd * g0[2] + b0[2], v[3] * rstd * g0[3] + b0[3]);
                o.z = pk2(v[4] * rstd * g1[0] + b1[0], v[5] * rstd * g1[1] + b1[1]); o.w = pk2(v[6] * rstd * g1[2] + b1[2], v[7] * rstd * g1[3] + b1[3]);
                *(LAS u32x4*)(img + tok * 64) = o;
            }
        }
    }
    AT_WAIT_BAR();
    f32x16 acc[2][2];
#pragma unroll
    for (int a = 0; a < 2; ++a)
#pragma unroll
        for (int q = 0; q < 2; ++q)
#pragma unroll
            for (int i = 0; i < 16; ++i) acc[a][q][i] = 0.f;
    const LAS unsigned char* gp = F.lds + G_IMG + (2 * cb) * 8192 + ((lane >> 4) & 1) * 32 + (lane & 3) * 8 + (8 * hi + ((lane & 15) >> 2)) * 64;
#pragma unroll
    for (int ks = 0; ks < 8; ++ks) {
        const bf16x8 w0 = wf0[ks], w1 = wf1[ks];
#pragma unroll
        for (int c32 = 0; c32 < 2; ++c32) {
            const s16x4 lo = vtr(gp + c32 * 8192 + ks * 1024), hh = vtr(gp + c32 * 8192 + ks * 1024 + 256);
            const bf16x8 gf = (bf16x8){lo[0], lo[1], lo[2], lo[3], hh[0], hh[1], hh[2], hh[3]};
            acc[0][c32] = __builtin_amdgcn_mfma_f32_32x32x16_bf16(gf, w0, acc[0][c32], 0, 0, 0);
            acc[1][c32] = __builtin_amdgcn_mfma_f32_32x32x16_bf16(gf, w1, acc[1][c32], 0, 0, 0);
        }
    }
    LAS unsigned char* stg = F.lds + G_STG + w * 4096;
#pragma unroll
    for (int ib = 0; ib < 2; ++ib) {
        const int i0 = 64 * th + 32 * ib;
        const float bi = F.sgu_b[grp * 128 + i0 + r32];
#pragma unroll
        for (int c32 = 0; c32 < 2; ++c32)
#pragma unroll
            for (int a = 0; a < 4; ++a) { u32x2 o; o.x = pk2(acc[ib][c32][4 * a] + bi, acc[ib][c32][4 * a + 1] + bi); o.y = pk2(acc[ib][c32][4 * a + 2] + bi, acc[ib][c32][4 * a + 3] + bi);
                *(LAS u32x2*)(stg + r32 * 128 + (((4 * c32 + a) ^ (r32 & 7)) << 4) + hi * 8) = o; }
        LDS_WAIT();
#pragma unroll
        for (int it = 0; it < 4; ++it) {
            const int row = 8 * it + (lane >> 3), chn = lane & 7;
            const u32x4 v = *(const LAS u32x4*)(stg + row * 128 + ((chn ^ (row & 7)) << 4));
            const size_t tok = (size_t)(base + i0 + row);
            const u32x4 uv = *(const u32x4*)(F.proj + tok * DIN + 1536 + 256 * gh + 64 * cb + 8 * chn);
            u32x4 o;
            o.x = pk2(bflo(v.x) * bflo(uv.x), bfhi(v.x) * bfhi(uv.x)); o.y = pk2(bflo(v.y) * bflo(uv.y), bfhi(v.y) * bfhi(uv.y));
            o.z = pk2(bflo(v.z) * bflo(uv.z), bfhi(v.z) * bfhi(uv.z)); o.w = pk2(bflo(v.w) * bflo(uv.w), bfhi(v.w) * bfhi(uv.w));
            *(u32x4*)(F.mixin + tok * D + 512 + 256 * gh + 64 * cb + 8 * chn) = o;
        }
        LDS_WAIT();
    }
    AT_WAIT_BAR();
}
__device__ __forceinline__ void p_mixer(Frame& F) {
#ifndef PROBE_MIX_A
#define PROBE_MIX_A 1
#endif
#ifndef PROBE_MIX_S
#define PROBE_MIX_S 1
#endif
    int tbl_h = -1;
#pragma unroll 1
    for (int rep = 0; rep < PROBE_MIX_A; ++rep)
    for (int uid = F.vcu; uid < NB * NH * 32; uid += F.G) attn_unit(F, uid >> 8, (uid >> 5) & 7, uid & 31, tbl_h);
#pragma unroll 1
    for (int rep = 0; rep < PROBE_MIX_S; ++rep)
    for (int uid = F.vcu; uid < (M / 128) * 2; uid += F.G) sgu_unit(F, uid >> 1, uid & 1);
}
#undef AT_WAIT_BAR
}

template <int CTRL> __device__ __forceinline__ float halve(bool up, float lo, float hi) { const float keep = up ? hi : lo, send = up ? lo : hi; return keep + dppf<CTRL>(send); }
__device__ __forceinline__ float route_reduce2(const f32x2 (&lgA)[NE / 2], const f32x2 (&lgB)[NE / 2], int lane) {
    float r8A[8], r8B[8];
#define SWAP4(INS, a, b) asm volatile("s_nop 1\n\t" INS " %0, %4\n\t" INS " %1, %5\n\t" INS " %2, %6\n\t" INS " %3, %7" : "+v"(a[0]), "+v"(a[1]), "+v"(a[2]), "+v"(a[3]), "+v"(b[0]), "+v"(b[1]), "+v"(b[2]), "+v"(b[3]))
#pragma unroll
    for (int t = 0; t < 2; ++t) { const f32x2 (&lg)[NE / 2] = t ? lgB : lgA; float r16[16];
#pragma unroll
      for (int g = 0; g < 4; ++g) { float a[4], bq[4];
#pragma unroll
          for (int j = 0; j < 4; ++j) { const int e = 4 * g + j; a[j] = lg[e >> 1][e & 1]; bq[j] = lg[(e + 16) >> 1][e & 1]; }
          SWAP4("v_permlane32_swap_b32", a, bq);
#pragma unroll
          for (int j = 0; j < 4; ++j) r16[4 * g + j] = a[j] + bq[j]; }
#pragma unroll
      for (int g = 0; g < 2; ++g) { float a[4], bq[4];
#pragma unroll
          for (int j = 0; j < 4; ++j) { a[j] = r16[4 * g + j]; bq[j] = r16[4 * g + j + 8]; }
          SWAP4("v_permlane16_swap_b32", a, bq);
#pragma unroll
          for (int j = 0; j < 4; ++j) { if (t) r8B[4 * g + j] = a[j] + bq[j]; else r8A[4 * g + j] = a[j] + bq[j]; } } }
#undef SWAP4
    const bool b3 = lane & 8, b2 = lane & 4, b1 = lane & 2, b0 = lane & 1;
    float r8[8], r4[4], r2[2];
#pragma unroll
    for (int e = 0; e < 8; ++e) r8[e] = halve<0x128>(b3, r8A[e], r8B[e]);
#pragma unroll
    for (int j = 0; j < 4; ++j) r4[j] = halve<0x141>(b2, r8[j], r8[j + 4]);
#pragma unroll
    for (int j = 0; j < 2; ++j) r2[j] = halve<0x4E>(b1, r4[j], r4[j + 2]);
    return halve<0xB1>(b0, r2[0], r2[1]);
}
__device__ __forceinline__ int dppmax(int k, int d) { return k > d ? k : d; }
__device__ __forceinline__ void route_select2(Frame& F, float lgt, int e, int lane, int tl, int tok, LAS int* lcnt, LAS int* sel, LAS float* selg) {
    const int ub = __builtin_bit_cast(int, lgt);
    int key = ub ^ ((ub >> 31) & 0x7fffffff);
    int myrank = -1, kr[TOPK];
    const int kmin = (int)0x80000000;
#pragma unroll
    for (int r = 0; r < TOPK; ++r) {
        int m = key;
        m = dppmax(m, __builtin_amdgcn_update_dpp(0, m, 0xB1, 0xF, 0xF, true)); m = dppmax(m, __builtin_amdgcn_update_dpp(0, m, 0x4E, 0xF, 0xF, true)); m = dppmax(m, __builtin_amdgcn_update_dpp(0, m, 0x141, 0xF, 0xF, true));
        { int a = m, bq = m; asm volatile("s_nop 1\n\tv_permlane16_swap_b32 %0, %1" : "+v"(a), "+v"(bq)); m = dppmax(a, bq); }
        { int a = m, bq = m; asm volatile("s_nop 1\n\tv_permlane32_swap_b32 %0, %1" : "+v"(a), "+v"(bq)); m = dppmax(a, bq); }
        kr[r] = m;
        const unsigned long long eq = __ballot(key == m), eA = eq & 0x00FF00FF00FF00FFull, eB = eq & 0xFF00FF00FF00FF00ull;
        const unsigned long long win = (eA & (0ull - eA)) | (eB & (0ull - eB));
        int nk, nr;
        asm("v_cndmask_b32_e64 %0, %1, %2, %3" : "=v"(nk) : "v"(key), "v"(kmin), "s"(win));
        asm("v_cndmask_b32_e64 %0, %1, %2, %3" : "=v"(nr) : "v"(myrank), "v"(r), "s"(win));
        key = nk; myrank = nr;
    }
    float mf[TOPK];
#pragma unroll
    for (int r = 0; r < TOPK; ++r) mf[r] = __builtin_bit_cast(float, kr[r] ^ ((kr[r] >> 31) & 0x7fffffff));
    const float p1 = __expf(mf[1] - mf[0]), p2 = __expf(mf[2] - mf[0]), p3 = __expf(mf[3] - mf[0]);
    const float rden = 1.f / (((1.f + p1) + p2) + p3);
    if (myrank >= 0) {
        const float gs = (myrank == 0 ? 1.f : myrank == 1 ? p1 : myrank == 2 ? p2 : p3) * rden;
        const int lp = __hip_atomic_fetch_add(lcnt + e, 1, __ATOMIC_RELAXED, __HIP_MEMORY_SCOPE_WORKGROUP);
        sel[tl * 4 + myrank] = e | (lp << 8); selg[tl * 4 + myrank] = gs;
#ifdef MK_WRITE_X1
        F.topg[tok * 4 + myrank] = gs; F.topi[tok * 4 + myrank] = e;
#endif
    }
}
__device__ __forceinline__ void p_route(Frame& F) {
    LAS int* lcnt = (LAS int*)(F.lds + L_ROUTE); LAS int* gbase = lcnt + 32; LAS int* sel = lcnt + 64; LAS float* selg = (LAS float*)(F.lds + L_RPB);
    { f32x4 rw[16];
#pragma unroll
      for (int it = 0; it < 16; ++it) { const int i = F.tid + 512 * it, R = i >> 3, q = i & 7, t = R >> 6, c = 2 * (R & 63) + (t & 1) + 128 * (t >> 1); rw[it] = *(const f32x4*)(F.router_w + c * 32 + q * 4); }
#pragma unroll
      for (int it = 0; it < 16; ++it) { const int i = F.tid + 512 * it, R = i >> 3, q = i & 7; *(LAS f32x4*)(F.lds + R * 128 + ((q ^ ((R >> 1) & 7)) << 4)) = rw[it]; } }
    if (F.tid < 32) lcnt[F.tid] = 0;
    __syncthreads();
    const int lane = F.lane;
    const LAS unsigned char* wbase = F.lds + lane * 128;
    const int sw = (lane >> 1) & 7;
    unsigned wq0[8], wq1[8];
#pragma unroll
    for (int qq = 0; qq < 8; ++qq) { wq0[qq] = (unsigned)(size_t)(wbase + ((qq ^ sw) << 4)); wq1[qq] = wq0[qq] + 65536u; asm volatile("" : "+v"(wq1[qq])); }
    LAS unsigned char* hrowA = F.lds + L_WSCR + F.wave * 2048; LAS unsigned char* hrowB = hrowA + 1024;
    const int e = ((lane >> 5) << 4) | (((lane >> 4) & 1) << 3) | (lane & 7);
    const float rbias = F.router_b[e];
    for (int tb = blockIdx.x; tb < M / 64; tb += F.G) {
        const int b = (tb * 64) >> 13;
        f32x2 ps[8], ph[8];
#pragma unroll
        for (int i = 0; i < 8; ++i) { const int col = 2 * lane + 128 * i; ps[i] = *(const f32x2*)(F.mod + b * 6144 + 4 * 1024 + col) + 1.f; ph[i] = *(const f32x2*)(F.mod + b * 6144 + 3 * 1024 + col); }
        unsigned nyA[8], nyB[8];
#pragma unroll
        for (int i = 0; i < 8; ++i) { nyA[i] = *(const unsigned*)(F.y1 + (size_t)(tb * 64 + F.wave) * D + 2 * lane + 128 * i); nyB[i] = *(const unsigned*)(F.y1 + (size_t)(tb * 64 + F.wave + 32) * D + 2 * lane + 128 * i); }
#pragma unroll 1
        for (int k = 0; k < 4; ++k) {
            const int tlA = F.wave + 8 * k, tlB = tlA + 32, tokA = tb * 64 + tlA, tokB = tb * 64 + tlB;
            f32x2 vA[8], vB[8], pg[8], pb[8];
#pragma unroll
            for (int i = 0; i < 8; ++i) { pg[i] = *(const f32x2*)(F.ln1_g + 2 * lane + 128 * i); pb[i] = *(const f32x2*)(F.ln1_b + 2 * lane + 128 * i); }
            f32x2 s2A = (f32x2){0.f, 0.f}, s2B = (f32x2){0.f, 0.f};
            { const int kn = k < 3 ? k + 1 : 3;
              const bf16_t* ya = F.y1 + (size_t)(tb * 64 + F.wave + 8 * kn) * D; const bf16_t* yb = ya + (size_t)32 * D;
#pragma unroll
              for (int i = 0; i < 8; ++i) { vA[i] = (f32x2){bflo(nyA[i]), bfhi(nyA[i])}; vB[i] = (f32x2){bflo(nyB[i]), bfhi(nyB[i])}; }
#pragma unroll
              for (int i = 0; i < 8; ++i) { nyA[i] = *(const unsigned*)(ya + 2 * lane + 128 * i); nyB[i] = *(const unsigned*)(yb + 2 * lane + 128 * i); }
#pragma unroll
              for (int i = 0; i < 8; ++i) { s2A += vA[i]; s2B += vB[i]; } }
            float meanA = wsum(s2A[0] + s2A[1]) * (1.f / D), meanB = wsum(s2B[0] + s2B[1]) * (1.f / D);
            f32x2 q2A = (f32x2){0.f, 0.f}, q2B = (f32x2){0.f, 0.f};
#pragma unroll
            for (int i = 0; i < 8; ++i) { vA[i] -= meanA; q2A = __builtin_elementwise_fma(vA[i], vA[i], q2A); vB[i] -= meanB; q2B = __builtin_elementwise_fma(vB[i], vB[i], q2B); }
            float rstdA = rsqrtf(wsum(q2A[0] + q2A[1]) * (1.f / D) + EPS), rstdB = rsqrtf(wsum(q2B[0] + q2B[1]) * (1.f / D) + EPS);
            if (lane == 0) { F.stat[tokA] = (f32x2){meanA, rstdA}; F.stat[tokB] = (f32x2){meanB, rstdB}; }
            s2A = (f32x2){0.f, 0.f}; s2B = (f32x2){0.f, 0.f};
#pragma unroll
            for (int i = 0; i < 8; ++i) { vA[i] = __builtin_elementwise_fma(vA[i] * rstdA, pg[i], pb[i]); s2A += vA[i]; vB[i] = __builtin_elementwise_fma(vB[i] * rstdB, pg[i], pb[i]); s2B += vB[i]; }
            meanA = wsum(s2A[0] + s2A[1]) * (1.f / D); meanB = wsum(s2B[0] + s2B[1]) * (1.f / D); q2A = (f32x2){0.f, 0.f}; q2B = (f32x2){0.f, 0.f};
#pragma unroll
            for (int i = 0; i < 8; ++i) { vA[i] -= meanA; q2A = __builtin_elementwise_fma(vA[i], vA[i], q2A); vB[i] -= meanB; q2B = __builtin_elementwise_fma(vB[i], vB[i], q2B); }
            rstdA = rsqrtf(wsum(q2A[0] + q2A[1]) * (1.f / D) + EPS); rstdB = rsqrtf(wsum(q2B[0] + q2B[1]) * (1.f / D) + EPS);
#pragma unroll
            for (int i = 0; i < 8; ++i) { vA[i] = __builtin_elementwise_fma(vA[i] * rstdA, ps[i], ph[i]); vB[i] = __builtin_elementwise_fma(vB[i] * rstdB, ps[i], ph[i]); }
#pragma unroll
            for (int i = 0; i < 8; ++i) { *(LAS unsigned short*)(hrowA + 2 * lane + 128 * i) = (unsigned short)__builtin_amdgcn_cvt_pk_fp8_f32(vA[i][0], vA[i][1], 0, false);
                                          *(LAS unsigned short*)(hrowB + 2 * lane + 128 * i) = (unsigned short)__builtin_amdgcn_cvt_pk_fp8_f32(vB[i][0], vB[i][1], 0, false); }
            f32x2 lgA[NE / 2], lgB[NE / 2];
#pragma unroll
            for (int q = 0; q < NE / 2; ++q) { lgA[q] = (f32x2){0.f, 0.f}; lgB[q] = (f32x2){0.f, 0.f}; }
#pragma unroll
            for (int i = 0; i < 16; ++i) {
                f32x4 wa[8];
#pragma unroll
                for (int qq = 0; qq < 8; ++qq) wa[qq] = *(const LAS f32x4*)(size_t)((i < 8 ? wq0[qq] : wq1[qq]) + (unsigned)(i & 7) * 8192u);
                __builtin_amdgcn_sched_barrier(0);
                const f32x2 ha = (f32x2){vA[i >> 1][i & 1], vA[i >> 1][i & 1]}, hb = (f32x2){vB[i >> 1][i & 1], vB[i >> 1][i & 1]};
#pragma unroll
                for (int qq = 0; qq < 8; ++qq) { const f32x2 w0 = (f32x2){wa[qq][0], wa[qq][1]}, w1 = (f32x2){wa[qq][2], wa[qq][3]};
                    lgA[2 * qq] = __builtin_elementwise_fma(ha, w0, lgA[2 * qq]); lgA[2 * qq + 1] = __builtin_elementwise_fma(ha, w1, lgA[2 * qq + 1]);
                    lgB[2 * qq] = __builtin_elementwise_fma(hb, w0, lgB[2 * qq]); lgB[2 * qq + 1] = __builtin_elementwise_fma(hb, w1, lgB[2 * qq + 1]); }
                __builtin_amdgcn_sched_barrier(0);
            }
            LDS_WAIT();
            *(u32x4*)(F.h2 + (size_t)tokA * D + lane * 16) = *(const LAS u32x4*)(hrowA + lane * 16);
            *(u32x4*)(F.h2 + (size_t)tokB * D + lane * 16) = *(const LAS u32x4*)(hrowB + lane * 16);
            const float lgt = route_reduce2(lgA, lgB, lane) + rbias;
            route_select2(F, lgt, e, lane, (lane & 8) ? tlB : tlA, (lane & 8) ? tokB : tokA, lcnt, sel, selg);
        }
        __syncthreads();
        if (F.tid < 32) { const int n = lcnt[F.tid]; gbase[F.tid] = n ? (int)__hip_atomic_fetch_add(F.cntw + 32 * F.tid, (unsigned)n, __ATOMIC_RELAXED, __HIP_MEMORY_SCOPE_AGENT) : 0; lcnt[F.tid] = 0; }
        __syncthreads();
        if (F.tid < 256) { const int sv = sel[F.tid], ee = sv & 255, lp = sv >> 8; F.list[(size_t)ee * LCAP + gbase[ee] + lp] = (tb * 64 + (F.tid >> 2)) * 4 + (F.tid & 3); F.listg[(size_t)ee * LCAP + gbase[ee] + lp] = selg[F.tid]; }
        __syncthreads();
    }
}

__device__ __forceinline__ void p_final(Frame& F) {
    const int gw = F.vcu * 8 + F.wave, NGW = F.G * 8;
    f32x4 gv[4], l1g[4], l1b[4], l2g[4], l2b[4];
#pragma unroll
    for (int j = 0; j < 4; ++j) { l1g[j] = *((const f32x4*)F.ln1_g + F.lane + 64 * j); l1b[j] = *((const f32x4*)F.ln1_b + F.lane + 64 * j);
                                  l2g[j] = *((const f32x4*)F.ln2_g + F.lane + 64 * j); l2b[j] = *((const f32x4*)F.ln2_b + F.lane + 64 * j); }
    int cur_b = -1;
    unsigned nyq[4][TOPK]; u32x2 nyw[4]; f32x2 nst;
#define FIN_LOAD(tok_) do { const int t_ = (tok_); nst = F.stat[t_]; const u32x2* xp_ = (const u32x2*)(F.y1 + (size_t)t_ * D) + F.lane; \
        _Pragma("unroll") for (int j = 0; j < 4; ++j) { nyw[j] = __builtin_nontemporal_load(xp_ + 64 * j); \
            _Pragma("unroll") for (int k = 0; k < TOPK; ++k) nyq[j][k] = __builtin_nontemporal_load((const unsigned*)(F.ybuf + (size_t)(t_ * 4 + k) * D) + F.lane + 64 * j); } } while (0)
    if (gw < M) FIN_LOAD(gw);
    f32x4 ov[4]; int otok = -1;
    for (int tok = gw; tok < M; tok += NGW) {
        const int b = tok >> 13;
        if (b != cur_b) { cur_b = b;
#pragma unroll
            for (int j = 0; j < 4; ++j) gv[j] = *((const f32x4*)(F.mod + b * 6144 + 5 * 1024) + F.lane + 64 * j); }
        unsigned yq[4][TOPK]; u32x2 yw[4]; const f32x2 st = nst;
#pragma unroll
        for (int j = 0; j < 4; ++j) { yw[j] = nyw[j];
#pragma unroll
            for (int k = 0; k < TOPK; ++k) yq[j][k] = nyq[j][k]; }
        if (otok >= 0) { asm volatile("" :: "v"(yq[3][3]), "v"(yw[3].y), "v"(st[1]) : "memory"); f32x4* op_ = (f32x4*)(F.out + (size_t)otok * D) + F.lane;
#pragma unroll
            for (int j = 0; j < 4; ++j) op_[64 * j] = ov[j]; }
        if (tok + NGW < M) FIN_LOAD(tok + NGW);
        f32x4 v[4]; float s = 0.f;
#pragma unroll
        for (int j = 0; j < 4; ++j) {
            f32x4 f = (f32x4){0.f, 0.f, 0.f, 0.f};
#pragma unroll
            for (int k = 0; k < TOPK; ++k) { const int yv = (int)yq[j][k];
                f[0] += __builtin_amdgcn_cvt_f32_fp8(yv, 0); f[1] += __builtin_amdgcn_cvt_f32_fp8(yv, 1); f[2] += __builtin_amdgcn_cvt_f32_fp8(yv, 2); f[3] += __builtin_amdgcn_cvt_f32_fp8(yv, 3); }
            f = f * (1.f / PolDN::YSC);
            const f32x4 yv = (f32x4){bflo(yw[j].x), bfhi(yw[j].x), bflo(yw[j].y), bfhi(yw[j].y)};
            const f32x4 x1v = (yv - st[0]) * st[1] * l1g[j] + l1b[j];
#ifdef MK_WRITE_X1
            *((f32x4*)(F.x1 + (size_t)tok * D) + F.lane + 64 * j) = x1v;
#endif
            v[j] = x1v * DN_ALPHA + gv[j] * f; s += (v[j][0] + v[j][1]) + (v[j][2] + v[j][3]);
        }
        const float mean = wsum(s) * (1.f / D); float q = 0.f;
#pragma unroll
        for (int j = 0; j < 4; ++j) { v[j] = v[j] - mean; q += (v[j][0] * v[j][0] + v[j][1] * v[j][1]) + (v[j][2] * v[j][2] + v[j][3] * v[j][3]); }
        const float rstd = rsqrtf(wsum(q) * (1.f / D) + EPS);
#pragma unroll
        for (int j = 0; j < 4; ++j) ov[j] = v[j] * rstd * l2g[j] + l2b[j];
        otok = tok;
    }
    if (otok >= 0) { f32x4* op_ = (f32x4*)(F.out + (size_t)otok * D) + F.lane;
#pragma unroll
        for (int j = 0; j < 4; ++j) op_[64 * j] = ov[j]; }
#undef FIN_LOAD
}

struct Args { const float* in[23]; float* out; unsigned char* ws; int ph_lo, ph_hi, alt, pad; };
constexpr int N_PHASES = 8;
__global__ void __launch_bounds__(512, 2) mk_fwd(Args args) {
    extern __shared__ __attribute__((aligned(16))) unsigned char lds_raw[];
    Frame F;
    F.lds = (LAS unsigned char*)lds_raw;
    F.MISC = (volatile LAS unsigned*)(F.lds + L_MISC);
    F.tid = threadIdx.x; F.lane = F.tid & 63; F.wave = __builtin_amdgcn_readfirstlane(F.tid >> 6);
    F.G = gridDim.x; { const int bx = blockIdx.x; F.vcu = (F.G % 8 == 0) ? (bx % 8) * (F.G / 8) + bx / 8 : bx; }
    unsigned char* ws = args.ws;
    F.ctl = (unsigned*)(ws + WS_CTL);
    F.x = args.in[0]; F.c = args.in[1]; F.ctx = args.in[2]; F.c_ctx = args.in[3]; F.ada_w = args.in[4]; F.ada_b = args.in[5]; F.w_in = args.in[6]; F.rpb = args.in[7];
    F.sgu_ln_g = args.in[8]; F.sgu_ln_b = args.in[9]; F.sgu_w = args.in[10]; F.sgu_b = args.in[11]; F.w_out = args.in[12]; F.ln1_g = args.in[13]; F.ln1_b = args.in[14];
    F.ln2_g = args.in[15]; F.ln2_b = args.in[16]; F.router_w = args.in[17]; F.router_b = args.in[18]; F.w_gu = args.in[19]; F.b_gu = args.in[20]; F.w_dn = args.in[21]; F.b_dn = args.in[22];
    F.out = args.out;
    F.mod = (float*)(ws + WS_MOD); F.topg = (float*)(ws + WS_TOPG); F.topi = (int*)(ws + WS_TOPI); F.list = (int*)(ws + WS_LIST); F.listg = (float*)(ws + WS_LISTG); F.sguw = (bf16_t*)(ws + WS_SGUW);
    F.Wt_in = (bf16_t*)(ws + WS_WIN); F.Wt_out = (bf16_t*)(ws + WS_WOUT); F.Wt_gu = ws + WS_WGU; F.Wt_dn = ws + WS_WDN;
    F.hxc = (bf16_t*)(ws + WS_HXC); F.proj = (bf16_t*)(ws + WS_PROJ); F.mixin = (bf16_t*)(ws + WS_MIXIN); F.y1 = (bf16_t*)(ws + WS_Y1); F.x1 = (float*)(ws + WS_X1); F.stat = (f32x2*)(ws + WS_STAT); F.cntw = F.ctl + CW_CNT; F.h2 = ws + WS_H2;
    F.act = ws + WS_ACT; F.ybuf = ws + WS_YBUF;
    for (int u = F.tid; u < (LDS_BYTES - L_MISC) / 4; u += 512) ((LAS unsigned*)(F.lds + L_MISC))[u] = 0u;
    __syncthreads();
    if (args.alt) { F.x1 = (float*)(ws + WS_ALT); F.h2 = ws + WS_ALT + 64 * MiB; F.list = (int*)(ws + WS_ALT + 80 * MiB); F.listg = (float*)(ws + WS_ALT + 84 * MiB); F.topg = (float*)(ws + WS_ALT + 82 * MiB); F.topi = (int*)(ws + WS_ALT + 82 * MiB + 512 * 1024); F.cntw = F.ctl + CW_CNT_ALT; F.stat = (f32x2*)(ws + WS_ALT + 83 * MiB); }
    const int lo = args.ph_lo, hi = args.ph_hi;
    const bool one = (hi - lo) > 1;
    XcdBarrier bar; bar.bar = (unsigned*)(F.ctl + CW_BAR); bar.x = 0; bar.st = nullptr;
    if (one) bar = xcd_barrier_post((unsigned*)(F.ctl + CW_BAR), F.MISC + 8);
#define IN(k) (lo <= (k) && (k) < hi)
#define SEAM(k) do { if (IN(k) && IN((k) + 1)) xcd_barrier(bar); } while (0)
#ifndef PROBE_REPS
#define PROBE_REPS {1, 1, 1, 1, 1, 1, 1, 1}
#endif
    constexpr int REPS[N_PHASES] = PROBE_REPS;
#define REPEAT(k) _Pragma("unroll") for (int rep_ = 0; rep_ < REPS[k]; ++rep_)
#define RSEAM(k) do { if (rep_ + 1 < REPS[k]) xcd_barrier(bar); else SEAM(k); } while (0)
    constexpr int W_ITEMS = 16 * 80 + 16 * 32 + NE * 16 * 64 + NE * 16 * 32, W_TAIL = PolProj::FP8 ? 4800 : 7680;
    const bool tail_wg = (F.G == 256 && (int)blockIdx.x >= 136);
    if (IN(0)) REPEAT(0) { p_ada(F); p_weights(F, 0, (F.G == 256) ? W_ITEMS - W_TAIL : W_ITEMS, F.vcu * 8 + F.wave, F.G * 8, true); RSEAM(0); }
    if (IN(1)) REPEAT(1) { p_lnmod(F); RSEAM(1); }
    if (IN(2)) REPEAT(2) { PolProj P{(const unsigned char*)F.hxc, (const unsigned char*)F.Wt_in, F.proj, F.G, (int)blockIdx.x}; pg8::gemm_phase<PolProj>(F.lds, P);
        if (tail_wg) p_weights(F, W_ITEMS - W_TAIL, W_TAIL, ((int)blockIdx.x - 136) * 8 + F.wave, 120 * 8, false); RSEAM(2); }
    if (IN(3)) REPEAT(3) { at::p_mixer(F); RSEAM(3); }
    if (IN(4)) REPEAT(4) { PolOut P{F.mixin, F.Wt_out, F.x, F.mod, F.y1, F.G, (int)blockIdx.x}; pg8::gemm_phase<PolOut>(F.lds, P); RSEAM(4); }
    if (IN(5)) { p_route(F); SEAM(5); }
    if (IN(6)) REPEAT(6) { const int T = expert_tables(F); ExpTab tb{(const LAS int*)(F.lds + L_TILEE), (const LAS int*)(F.lds + L_TSTART), (const LAS int*)(F.lds + L_TSTART) + 64, T};
        { PolGU P{F.h2, F.Wt_gu, F.b_gu, F.list, F.act, tb, F.G, (int)blockIdx.x, F.ctl + CW_RDY}; pg8::gemm_phase<PolGU>(F.lds, P); }
        { const int c = (int)blockIdx.x, ioff = 8 * T > c ? (8 * T - c + F.G - 1) / F.G : 0;
          PolDN P{F.act, F.Wt_dn, F.b_dn, F.list, F.listg, F.ybuf, tb, F.G, c, F.ctl + CW_RDY, ioff, c}; pg8::gemm_phase<PolDN>(F.lds, P); }
        RSEAM(6); }
    if (IN(7)) REPEAT(7) { p_final(F); if (rep_ + 1 < REPS[7]) xcd_barrier(bar); }
#undef IN
#undef SEAM
#undef REPEAT
#undef RSEAM
}

static inline void launch_forward(void* const* d_in, void* d_out, void* d_ws, hipStream_t stream, int n_launches) {
    static int grid = 0;
    if (grid == 0) {
        int dev = 0, cus = 0;
        if (hipGetDevice(&dev) != hipSuccess || hipDeviceGetAttribute(&cus, hipDeviceAttributeMultiprocessorCount, dev) != hipSuccess) { fprintf(stderr, "kernel_launch: device query failed\n"); grid = -1; return; }
        if (hipFuncSetAttribute((const void*)mk_fwd, hipFuncAttributeMaxDynamicSharedMemorySize, LDS_BYTES) != hipSuccess) { fprintf(stderr, "kernel_launch: hipFuncSetAttribute failed\n"); grid = -1; return; }
        int per_cu = 0;
        if (hipOccupancyMaxActiveBlocksPerMultiprocessor(&per_cu, (const void*)mk_fwd, 512, LDS_BYTES) != hipSuccess || per_cu < 1) fprintf(stderr, "kernel_launch: occupancy query says %d\n", per_cu);
        (void)hipGetLastError();
        grid = cus;
    }
    if (grid < 0) return;
    (void)hipMemsetAsync((char*)d_ws + WS_CTL, 0, CTL_ZERO_BYTES, stream);
    Args a{};
    for (int i = 0; i < 23; ++i) a.in[i] = (const float*)d_in[i];
    a.out = (float*)d_out; a.ws = (unsigned char*)d_ws;
    if (n_launches == 1) { a.ph_lo = 0; a.ph_hi = N_PHASES; hipLaunchKernelGGL(mk_fwd, dim3(grid), dim3(512), LDS_BYTES, stream, a); }
    else for (int p = 0; p < N_PHASES; ++p) { a.ph_lo = p; a.ph_hi = p + 1; hipLaunchKernelGGL(mk_fwd, dim3(grid), dim3(512), LDS_BYTES, stream, a); }
#ifdef PROBE_EXTRA
    { const int extra[] = PROBE_EXTRA; for (int p : extra) { a.ph_lo = p; a.ph_hi = p + 1; a.alt = (p == 5); hipLaunchKernelGGL(mk_fwd, dim3(grid), dim3(512), LDS_BYTES, stream, a); } }
#endif
}
}
extern "C" void kernel_launch(void* const* d_in, const int* in_sizes, int n_in, void* d_out, int out_size, void* d_ws, size_t ws_size, hipStream_t stream) {
    if (ws_size < mk::WS_END || n_in != 23) { fprintf(stderr, "kernel_launch: unexpected workspace / inputs (%zu, %d)\n", ws_size, n_in); return; }
    mk::launch_forward(d_in, d_out, d_ws, stream, 1);
}
```
